# Optimizing an MI355X kernel written in HIP

```python
import math
import jax, jax.numpy as jnp
from jax import lax
import numpy as np

D_MODEL = 1024
BATCH = 8
SEQ = 4096
DEPTH = 2

CTX_LEN = 256
GRID_W = 64
N_BRANCH = 4
N_HEADS = 4
HEAD_DIM = 64
CONV_CH = 256
CONV_WIDTH = 31
Q_LORA = 192
KV_LORA = 128
QK_NOPE = 64
QK_ROPE = 32
V_HEAD = 64
DIFF_DIM = 32
DIFF_V = 2 * DIFF_DIM
NA_KH = 8
NA_KW = 16
NA_QB = 16
ROPE_DIM = 32
ROPE_BASE = 10000.0
QBLOCK = 128
N_EXPERTS = 32
TOP_K = 4
D_FF = 1024
SWIGLU_LIMIT = 7.0
SWIGLU_ALPHA = 1.702
EPS = 1e-6
NEG_INF = -1e30

A_IN = 2 * CONV_CH
B_IN = Q_LORA + KV_LORA + QK_ROPE
C_IN = N_HEADS * (4 * DIFF_DIM + DIFF_V)
D_IN = N_HEADS * 3 * HEAD_DIM
OFF_B = A_IN
OFF_C = OFF_B + B_IN
OFF_D = OFF_C + C_IN
IN_WIDTH = OFF_D + D_IN

kernel_name = 'hybrid_gated_mixer_moe_dit'

F32 = jnp.float32


def rmsnorm(x, g):
    xf = x.astype(F32)
    y = xf * lax.rsqrt(jnp.mean(xf * xf, axis=-1, keepdims=True) + EPS)
    return (y * g.astype(F32)).astype(x.dtype)


def layernorm(x, g, b):
    xf = x.astype(F32)
    mu = jnp.mean(xf, axis=-1, keepdims=True)
    var = jnp.mean(jnp.square(xf - mu), axis=-1, keepdims=True)
    y = (xf - mu) * lax.rsqrt(var + EPS)
    return (y * g.astype(F32) + b.astype(F32)).astype(x.dtype)


def rope(x, cos, sin):
    half = x.shape[-1] // 2
    x1, x2 = x[..., :half], x[..., half:]
    return jnp.concatenate([x1 * cos - x2 * sin, x2 * cos + x1 * sin], axis=-1)


def axial_rope_tables(n_tokens, dtype):
    t = jnp.arange(n_tokens, dtype=jnp.int32)
    rows = (t // GRID_W).astype(F32)
    cols = (t % GRID_W).astype(F32)
    axis_dim = ROPE_DIM // 2
    inv = ROPE_BASE ** (-jnp.arange(0, axis_dim, 2, dtype=F32) / axis_dim)
    theta = jnp.concatenate([rows[:, None] * inv, cols[:, None] * inv], axis=-1)
    return jnp.cos(theta).astype(dtype), jnp.sin(theta).astype(dtype)


def merge_heads(o):
    b, h, n, d = o.shape
    return o.transpose(0, 2, 1, 3).reshape(b, n, h * d)


def sweep_query_blocks(fn, q):
    b, h, n = q.shape[:3]
    nb = n // QBLOCK
    qb = jnp.moveaxis(q.reshape(b, h, nb, QBLOCK, *q.shape[3:]), 2, 0)
    out = lax.map(fn, qb)
    return jnp.moveaxis(out, 0, 2).reshape(b, h, n, out.shape[-1])


def softmax_attend(q, k, v):
    s = jnp.einsum('bhqd,bhkd->bhqk', q, k).astype(F32) * (q.shape[-1] ** -0.5)
    p = jax.nn.softmax(s, axis=-1).astype(v.dtype)
    return jnp.einsum('bhqk,bhkd->bhqd', p, v)


def dense_attention(q, k, v):
    return sweep_query_blocks(lambda qb: softmax_attend(qb, k, v), q)


def diff_attend(q, k, v, lam):
    s = jnp.einsum('bhqcd,bhkcd->bhcqk', q, k).astype(F32) * (q.shape[-1] ** -0.5)
    p = jax.nn.softmax(s, axis=-1)
    w = (p[:, :, 0] - lam * p[:, :, 1]).astype(v.dtype)
    return jnp.einsum('bhqk,bhkd->bhqd', w, v)


def conformer_branch(pa, p):
    u = pa[..., :CONV_CH] * jax.nn.sigmoid(pa[..., CONV_CH:])
    u = lax.conv_general_dilated(
        u, p['conv_w'][:, None, :], window_strides=(1,),
        padding=[(CONV_WIDTH // 2, CONV_WIDTH // 2)],
        dimension_numbers=('NWC', 'WIO', 'NWC'), feature_group_count=CONV_CH) + p['conv_b']
    u = jax.nn.silu(layernorm(u, p['conv_ln_g'], p['conv_ln_b']))
    return u @ p['conv_out']


def mla_qkv(pb, p, cos, sin):
    b, n = pb.shape[:2]
    c_q = rmsnorm(pb[..., :Q_LORA], p['mla_cq_g'])
    c_kv = rmsnorm(pb[..., Q_LORA:Q_LORA + KV_LORA], p['mla_ckv_g'])
    k_pe = pb[..., Q_LORA + KV_LORA:]
    q = (c_q @ p['mla_w_uq']).reshape(b, n, N_HEADS, QK_NOPE + QK_ROPE)
    kv = (c_kv @ p['mla_w_ukv']).reshape(b, n, N_HEADS, QK_NOPE + V_HEAD)
    k = jnp.concatenate(
        [kv[..., :QK_NOPE], jnp.broadcast_to(k_pe[:, :, None, :], (b, n, N_HEADS, QK_ROPE))], axis=-1)
    q = rmsnorm(q, p['mla_qn_g']).transpose(0, 2, 1, 3)
    k = rmsnorm(k, p['mla_kn_g']).transpose(0, 2, 1, 3)
    v = kv[..., QK_NOPE:].transpose(0, 2, 1, 3)
    if cos is not None:
        q = jnp.concatenate([q[..., :QK_NOPE], rope(q[..., QK_NOPE:], cos, sin)], axis=-1)
        k = jnp.concatenate([k[..., :QK_NOPE], rope(k[..., QK_NOPE:], cos, sin)], axis=-1)
    return q, k, v


def diff_qkv(pc, p, cos, sin):
    b, n = pc.shape[:2]
    t = pc.reshape(b, n, N_HEADS, 4 * DIFF_DIM + DIFF_V)
    q = t[..., :2 * DIFF_DIM].reshape(b, n, N_HEADS, 2, DIFF_DIM)
    k = t[..., 2 * DIFF_DIM:4 * DIFF_DIM].reshape(b, n, N_HEADS, 2, DIFF_DIM)
    v = t[..., 4 * DIFF_DIM:].transpose(0, 2, 1, 3)
    q = rmsnorm(q, p['diff_qn_g']).transpose(0, 2, 1, 3, 4)
    k = rmsnorm(k, p['diff_kn_g']).transpose(0, 2, 1, 3, 4)
    if cos is not None:
        q = rope(q, cos[:, None], sin[:, None])
        k = rope(k, cos[:, None], sin[:, None])
    return q, k, v


def diff_project(o, p, lam_init):
    o = rmsnorm(o, p['diff_subln_g']) * (1.0 - lam_init)
    return merge_heads(o) @ p['diff_out']


def na_qkv(pd, p):
    b, n = pd.shape[:2]
    t = pd.reshape(b, n, N_HEADS, 3 * HEAD_DIM)
    q = rmsnorm(t[..., :HEAD_DIM], p['na_qn_g']).transpose(0, 2, 1, 3)
    k = rmsnorm(t[..., HEAD_DIM:2 * HEAD_DIM], p['na_kn_g']).transpose(0, 2, 1, 3)
    v = t[..., 2 * HEAD_DIM:].transpose(0, 2, 1, 3)
    return q, k, v


def na_index_tables(rows):
    kh = min(NA_KH, rows)
    ncb = GRID_W // NA_QB
    band_w = NA_QB + NA_KW
    r = np.arange(rows)
    row_start = np.clip(r - kh // 2, 0, rows - kh)
    key_rows = row_start[:, None] + np.arange(kh)
    row_off = key_rows - r[:, None] + NA_KH - 1
    cb = np.arange(ncb)
    col_start = np.clip(cb * NA_QB - NA_KW // 2, 0, GRID_W - band_w)
    key_cols = col_start[:, None] + np.arange(band_w)
    q_cols = cb[:, None] * NA_QB + np.arange(NA_QB)
    win_start = np.clip(q_cols - NA_KW // 2, 0, GRID_W - NA_KW)
    d = key_cols[:, None, :] - win_start[:, :, None]
    col_valid = (d >= 0) & (d < NA_KW)
    col_off = np.clip(key_cols[:, None, :] - q_cols[:, :, None] + NA_KW - 1, 0, 2 * NA_KW - 2)
    return key_rows.astype(np.int32), row_off, key_cols, col_off, col_valid


def neighbourhood_attention(q, k, v, kc, vc, rpb):
    b, h, n, d = q.shape
    rows = n // GRID_W
    key_rows, row_off, key_cols, col_off, col_valid = na_index_tables(rows)
    kh = key_rows.shape[1]
    ncb, band_w = key_cols.shape
    bias = rpb.astype(F32)[:, row_off[:, None, None, :, None], col_off[None, :, :, None, :]]
    bias = jnp.where(col_valid[None, None, :, :, None, :], bias, NEG_INF)
    bias = jnp.moveaxis(bias.reshape(h, rows, ncb, NA_QB, kh * band_w), 1, 0)
    scale = d ** -0.5
    kg = k.reshape(b, h, rows, GRID_W, d)
    vg = v.reshape(b, h, rows, GRID_W, v.shape[-1])
    qr = jnp.moveaxis(q.reshape(b, h, rows, ncb, NA_QB, d), 2, 0)
    n_ctx = kc.shape[2]

    def gather_band(t, rows_r):
        t = jnp.take(t, rows_r, axis=2)[:, :, :, key_cols]
        return t.transpose(0, 1, 3, 2, 4, 5).reshape(b, h, ncb, kh * band_w, t.shape[-1])

    def row_block(args):
        q_r, rows_r, bias_r = args
        k_band = gather_band(kg, rows_r)
        v_band = gather_band(vg, rows_r)
        s_loc = jnp.einsum('bhnqd,bhnkd->bhnqk', q_r, k_band).astype(F32) * scale + bias_r
        s_ctx = jnp.einsum('bhnqd,bhcd->bhnqc', q_r, kc).astype(F32) * scale
        pr = jax.nn.softmax(jnp.concatenate([s_ctx, s_loc], axis=-1), axis=-1).astype(v.dtype)
        return (jnp.einsum('bhnqc,bhcd->bhnqd', pr[..., :n_ctx], vc)
                + jnp.einsum('bhnqk,bhnkd->bhnqd', pr[..., n_ctx:], v_band))

    out = lax.map(row_block, (qr, jnp.asarray(key_rows), bias))
    return jnp.moveaxis(out, 0, 2).reshape(b, h, n, out.shape[-1])


def gated_merge(h, y_conv, y_mla, y_diff, y_na, p):
    g = jax.nn.sigmoid((h @ p['gate_w'] + p['gate_b']).astype(F32)).astype(h.dtype)
    g = g.reshape(*h.shape[:-1], N_BRANCH, D_MODEL)
    y = (g[..., 0, :] * y_conv + g[..., 1, :] * y_mla
         + g[..., 2, :] * y_diff + g[..., 3, :] * y_na)
    return y @ p['w_o']


def token_mixer(h, hc, p, lam_init, cos, sin, with_ctx_out):
    proj = h @ p['w_in']
    projc = hc @ p['w_in']
    lam_vec = p['diff_lam'].astype(F32)
    lam = jnp.exp(jnp.sum(lam_vec[0] * lam_vec[1])) - jnp.exp(jnp.sum(lam_vec[2] * lam_vec[3])) + lam_init

    y_conv = conformer_branch(proj[..., :OFF_B], p)

    q_b, k_b, v_b = mla_qkv(proj[..., OFF_B:OFF_C], p, cos, sin)
    qc_b, kc_b, vc_b = mla_qkv(projc[..., OFF_B:OFF_C], p, None, None)
    y_mla = merge_heads(dense_attention(
        q_b, jnp.concatenate([kc_b, k_b], axis=2), jnp.concatenate([vc_b, v_b], axis=2))) @ p['mla_out']

    q_c, k_c, v_c = diff_qkv(proj[..., OFF_C:OFF_D], p, cos, sin)
    qc_c, kc_c, vc_c = diff_qkv(projc[..., OFF_C:OFF_D], p, None, None)
    k_all = jnp.concatenate([kc_c, k_c], axis=2)
    v_all = jnp.concatenate([vc_c, v_c], axis=2)
    y_diff = diff_project(sweep_query_blocks(lambda qb: diff_attend(qb, k_all, v_all, lam), q_c), p, lam_init)

    q_d, k_d, v_d = na_qkv(proj[..., OFF_D:], p)
    qc_d, kc_d, vc_d = na_qkv(projc[..., OFF_D:], p)
    y_na = merge_heads(neighbourhood_attention(q_d, k_d, v_d, kc_d, vc_d, p['na_rpb'])) @ p['na_out']

    y = gated_merge(h, y_conv, y_mla, y_diff, y_na, p)
    if not with_ctx_out:
        return y, None
    yc_conv = conformer_branch(projc[..., :OFF_B], p)
    yc_mla = merge_heads(dense_attention(qc_b, kc_b, vc_b)) @ p['mla_out']
    yc_diff = diff_project(sweep_query_blocks(lambda qb: diff_attend(qb, kc_c, vc_c, lam), qc_c), p, lam_init)
    yc_na = merge_heads(dense_attention(qc_d, kc_d, vc_d)) @ p['na_out']
    return y, gated_merge(hc, yc_conv, yc_mla, yc_diff, yc_na, p)


def moe_ffn(h, p):
    shp = h.shape
    t = h.reshape(-1, shp[-1])
    logits = (t @ p['router_w'] + p['router_b']).astype(F32)
    top_val, top_idx = lax.top_k(logits, TOP_K)
    w = jax.nn.softmax(top_val, axis=-1)
    gates = jnp.einsum('nk,nke->ne', w, jax.nn.one_hot(top_idx, N_EXPERTS, dtype=F32)).astype(h.dtype)
    out = jnp.zeros_like(t)
    for e in range(N_EXPERTS):
        gu = t @ p['exp_w_gu'][e] + p['exp_b_gu'][e]
        g = jnp.minimum(gu[:, :D_FF], SWIGLU_LIMIT)
        u = jnp.clip(gu[:, D_FF:], -SWIGLU_LIMIT, SWIGLU_LIMIT)
        y = ((u + 1.0) * (g * jax.nn.sigmoid(SWIGLU_ALPHA * g))) @ p['exp_w_down'][e] + p['exp_b_down'][e]
        out = out + gates[:, e:e + 1] * y
    return out.reshape(shp)


def modulate(x, g, shift, scale):
    return rmsnorm(x, g) * (1.0 + scale) + shift


def setup_inputs(seed: int = 0) -> dict:
    key = jax.random.key(seed)
    ks = iter(jax.random.split(key, 64))
    L, D = DEPTH, D_MODEL

    def nrm(shape, scale):
        return jax.random.normal(next(ks), shape, F32) * scale

    def gain(shape):
        return 1.0 + nrm(shape, 0.02)

    return {
        'x': nrm((BATCH, SEQ, D), 1.0),
        'c': nrm((BATCH, D), 1.0),
        'ctx': nrm((BATCH, CTX_LEN, D), 1.0),
        'c_ctx': nrm((D,), 1.0),
        'ada_w': nrm((L, D, 6 * D), 0.5 * D ** -0.5),
        'ada_b': nrm((L, 6 * D), 0.02),
        'norm1_g': gain((L, D)),
        'norm2_g': gain((L, D)),
        'w_in': nrm((L, D, IN_WIDTH), D ** -0.5),
        'conv_w': nrm((L, CONV_WIDTH, CONV_CH), CONV_WIDTH ** -0.5),
        'conv_b': nrm((L, CONV_CH), 0.02),
        'conv_ln_g': gain((L, CONV_CH)),
        'conv_ln_b': nrm((L, CONV_CH), 0.02),
        'conv_out': nrm((L, CONV_CH, D), CONV_CH ** -0.5),
        'mla_cq_g': gain((L, Q_LORA)),
        'mla_ckv_g': gain((L, KV_LORA)),
        'mla_w_uq': nrm((L, Q_LORA, N_HEADS * (QK_NOPE + QK_ROPE)), Q_LORA ** -0.5),
        'mla_w_ukv': nrm((L, KV_LORA, N_HEADS * (QK_NOPE + V_HEAD)), KV_LORA ** -0.5),
        'mla_qn_g': gain((L, QK_NOPE + QK_ROPE)),
        'mla_kn_g': gain((L, QK_NOPE + QK_ROPE)),
        'mla_out': nrm((L, N_HEADS * V_HEAD, D), (N_HEADS * V_HEAD) ** -0.5),
        'diff_qn_g': gain((L, DIFF_DIM)),
        'diff_kn_g': gain((L, DIFF_DIM)),
        'diff_lam': nrm((L, 4, DIFF_DIM), 0.1),
        'diff_subln_g': gain((L, DIFF_V)),
        'diff_out': nrm((L, N_HEADS * DIFF_V, D), (N_HEADS * DIFF_V) ** -0.5),
        'na_qn_g': gain((L, HEAD_DIM)),
        'na_kn_g': gain((L, HEAD_DIM)),
        'na_rpb': nrm((L, N_HEADS, 2 * NA_KH - 1, 2 * NA_KW - 1), 0.1),
        'na_out': nrm((L, N_HEADS * HEAD_DIM, D), (N_HEADS * HEAD_DIM) ** -0.5),
        'gate_w': nrm((L, D, N_BRANCH * D), D ** -0.5),
        'gate_b': nrm((L, N_BRANCH * D), 0.02),
        'w_o': nrm((L, D, D), D ** -0.5),
        'router_w': nrm((L, D, N_EXPERTS), D ** -0.5),
        'router_b': nrm((L, N_EXPERTS), 0.01),
        'exp_w_gu': nrm((L, N_EXPERTS, D, 2 * D_FF), D ** -0.5),
        'exp_b_gu': nrm((L, N_EXPERTS, 2 * D_FF), 0.02),
        'exp_w_down': nrm((L, N_EXPERTS, D_FF, D), D_FF ** -0.5),
        'exp_b_down': nrm((L, N_EXPERTS, D), 0.02),
    }


def reference(x, c, ctx, c_ctx, ada_w, ada_b, norm1_g, norm2_g, w_in, conv_w, conv_b, conv_ln_g,
              conv_ln_b, conv_out, mla_cq_g, mla_ckv_g, mla_w_uq, mla_w_ukv, mla_qn_g, mla_kn_g,
              mla_out, diff_qn_g, diff_kn_g, diff_lam, diff_subln_g, diff_out, na_qn_g, na_kn_g,
              na_rpb, na_out, gate_w, gate_b, w_o, router_w, router_b, exp_w_gu, exp_b_gu,
              exp_w_down, exp_b_down):
    cos, sin = axial_rope_tables(x.shape[1], x.dtype)
    xc = ctx
    for l in range(DEPTH):
        p = dict(
            w_in=w_in[l], conv_w=conv_w[l], conv_b=conv_b[l], conv_ln_g=conv_ln_g[l],
            conv_ln_b=conv_ln_b[l], conv_out=conv_out[l], mla_cq_g=mla_cq_g[l],
            mla_ckv_g=mla_ckv_g[l], mla_w_uq=mla_w_uq[l], mla_w_ukv=mla_w_ukv[l],
            mla_qn_g=mla_qn_g[l], mla_kn_g=mla_kn_g[l], mla_out=mla_out[l],
            diff_qn_g=diff_qn_g[l], diff_kn_g=diff_kn_g[l], diff_lam=diff_lam[l],
            diff_subln_g=diff_subln_g[l], diff_out=diff_out[l], na_qn_g=na_qn_g[l],
            na_kn_g=na_kn_g[l], na_rpb=na_rpb[l], na_out=na_out[l], gate_w=gate_w[l],
            gate_b=gate_b[l], w_o=w_o[l], router_w=router_w[l], router_b=router_b[l],
            exp_w_gu=exp_w_gu[l], exp_b_gu=exp_b_gu[l], exp_w_down=exp_w_down[l],
            exp_b_down=exp_b_down[l])
        last = l == DEPTH - 1
        lam_init = 0.8 - 0.6 * math.exp(-0.3 * l)
        sh1, sc1, g1, sh2, sc2, g2 = jnp.split(jax.nn.silu(c) @ ada_w[l] + ada_b[l], 6, axis=-1)
        shc1, scc1, gc1, shc2, scc2, gc2 = jnp.split(jax.nn.silu(c_ctx) @ ada_w[l] + ada_b[l], 6, axis=-1)
        h = modulate(x, norm1_g[l], sh1[:, None], sc1[:, None])
        hc = modulate(xc, norm1_g[l], shc1, scc1)
        y, yc = token_mixer(h, hc, p, lam_init, cos, sin, not last)
        x = x + g1[:, None] * y
        x = x + g2[:, None] * moe_ffn(modulate(x, norm2_g[l], sh2[:, None], sc2[:, None]), p)
        if not last:
            xc = xc + gc1 * yc
            xc = xc + gc2 * moe_ffn(modulate(xc, norm2_g[l], shc2, scc2), p)
    return x
```

```cpp
#include <hip/hip_runtime.h>
#include <cstdio>
#include <cstdint>

typedef unsigned short bf16;
#define DI __device__ __forceinline__

constexpr int D = 1024, NB = 8, SEQ = 4096, CTX = 256, GW = 64;
constexpr int TL = NB * SEQ;
constexpr int TC = NB * CTX;
constexpr int T = TL + TC;
constexpr int NH = 4;
constexpr int INW = 2400, PLD = 2560;
constexpr int OFF_B = 512, OFF_C = 864, OFF_D = 1632;
constexpr int NE = 32, DFF = 1024;
constexpr int MAXROWS = 4 * T + NE * 256;
constexpr float EPS = 1e-6f;
constexpr float LOG2E = 1.4426950408889634f;

enum { I_X = 0, I_C, I_CTX, I_CCTX, I_ADAW, I_ADAB, I_N1G, I_N2G, I_WIN, I_CONVW, I_CONVB, I_CLNG, I_CLNB, I_CONVOUT,
       I_CQG, I_CKVG, I_WUQ, I_WUKV, I_QNG, I_KNG, I_MLAOUT, I_DQNG, I_DKNG, I_DLAM, I_DSUBG, I_DIFFOUT, I_NQNG, I_NKNG,
       I_RPB, I_NAOUT, I_GATEW, I_GATEB, I_WO, I_RW, I_RB, I_WGU, I_BGU, I_WDN, I_BDN, N_IN };

constexpr size_t MiB = 1u << 20;
constexpr size_t al(size_t x) { return (x + 255) / 256 * 256; }
constexpr size_t WS_CTL = 0;
constexpr size_t WS_MOD = 1 * MiB;
constexpr size_t WS_ROUTE = WS_MOD + al(2 * 9 * 6144 * 4);
constexpr size_t WS_ROWTOK = WS_ROUTE + al((size_t)T * 4 * 16);
constexpr size_t WS_H = WS_ROWTOK + al((size_t)MAXROWS * 4);
constexpr size_t WS_H2 = WS_H + al((size_t)T * D * 2);
constexpr size_t WS_XF = WS_H2 + al((size_t)T * D * 2);
constexpr size_t WS_SCR = WS_XF + al((size_t)T * D * 4);
constexpr size_t WS_PROJ = WS_SCR;
constexpr size_t WS_CU = WS_PROJ + al((size_t)T * PLD * 2);
constexpr size_t WS_CQ = WS_CU + al((size_t)T * 256 * 2);
constexpr size_t WS_CKV = WS_CQ + al((size_t)T * 192 * 2);
constexpr size_t WS_QKVRAW = WS_CKV + al((size_t)T * 128 * 2);
constexpr size_t WS_MQ = WS_QKVRAW + al((size_t)T * 896 * 2);
constexpr size_t WS_MK = WS_MQ + al((size_t)T * 384 * 2);
constexpr size_t WS_MV = WS_MK + al((size_t)T * 384 * 2);
constexpr size_t WS_DQ = WS_MV + al((size_t)T * 256 * 2);
constexpr size_t WS_DK = WS_DQ + al((size_t)T * 256 * 2);
constexpr size_t WS_DV = WS_DK + al((size_t)T * 256 * 2);
constexpr size_t WS_NQ = WS_DV + al((size_t)T * 256 * 2);
constexpr size_t WS_NK = WS_NQ + al((size_t)T * 256 * 2);
constexpr size_t WS_NV = WS_NK + al((size_t)T * 256 * 2);
constexpr size_t WS_BI = WS_NV + al((size_t)T * 256 * 2);
constexpr size_t WS_DO = WS_BI + al((size_t)T * D * 2);
constexpr size_t WS_YM = WS_DO + al((size_t)T * 512 * 2);
constexpr size_t WS_MIX_END = WS_YM + al((size_t)T * D * 2);
constexpr size_t WS_ACT = WS_SCR;
constexpr size_t WS_YE = WS_ACT + al((size_t)MAXROWS * D * 2);
constexpr size_t WS_MOE_END = WS_YE + al((size_t)MAXROWS * D * 2);
constexpr size_t WS_END = WS_MIX_END > WS_MOE_END ? WS_MIX_END : WS_MOE_END;
constexpr int CW_CNT = 1024;

struct Params {
  const float* in[N_IN];
  float* out;
  unsigned char* ws;
};

DI float bf2f(bf16 v) { return __uint_as_float(((unsigned)v) << 16); }
DI bf16 f2bf(float f) { unsigned u = __float_as_uint(f); u += 0x7fffu + ((u >> 16) & 1u); return (bf16)(u >> 16); }
DI float sigmoidf_(float x) { return 1.f / (1.f + __expf(-x)); }
DI float wave_sum(float v) {
#pragma unroll
  for (int o = 1; o < 64; o <<= 1) v += __shfl_xor(v, o);
  return v;
}
DI int modidx(int r) { return r < TL ? (r >> 12) : NB; }

__global__ void k_ada(Params p) {
  float* MOD = (float*)(p.ws + WS_MOD);
  const float* c = p.in[I_C]; const float* cc = p.in[I_CCTX];
  for (int idx = blockIdx.x * blockDim.x + threadIdx.x; idx < 2 * 6144; idx += gridDim.x * blockDim.x) {
    const int l = idx / 6144, n = idx % 6144;
    const float* W = p.in[I_ADAW] + (size_t)l * D * 6144;
    float acc[9];
#pragma unroll
    for (int i = 0; i < 9; ++i) acc[i] = 0.f;
    for (int k = 0; k < D; ++k) {
      const float w = W[(size_t)k * 6144 + n];
#pragma unroll
      for (int i = 0; i < 9; ++i) { const float v = (i < 8) ? c[i * D + k] : cc[k]; acc[i] += (v * sigmoidf_(v)) * w; }
    }
    const float b = p.in[I_ADAB][l * 6144 + n];
#pragma unroll
    for (int i = 0; i < 9; ++i) MOD[((size_t)l * 9 + i) * 6144 + n] = acc[i] + b;
  }
}

DI const float* stream_row(const Params& p, int l, int r, bool after_mixer) {
  if (l == 0 && !after_mixer) return r < TL ? p.in[I_X] + (size_t)r * D : p.in[I_CTX] + (size_t)(r - TL) * D;
  return (const float*)(p.ws + WS_XF) + (size_t)r * D;
}
__global__ void k_mod1(Params p, int l) {
  const int lane = threadIdx.x & 63, gw = (blockIdx.x * blockDim.x + threadIdx.x) >> 6, ngw = (gridDim.x * blockDim.x) >> 6;
  const float* MOD = (const float*)(p.ws + WS_MOD);
  bf16* H = (bf16*)(p.ws + WS_H);
  const float* g = p.in[I_N1G] + l * D;
  for (int r = gw; r < T; r += ngw) {
    const float* x = stream_row(p, l, r, false);
    float v[16]; float ss = 0.f;
#pragma unroll
    for (int j = 0; j < 4; ++j) { const float4 t = *(const float4*)(x + j * 256 + lane * 4); v[4 * j] = t.x; v[4 * j + 1] = t.y; v[4 * j + 2] = t.z; v[4 * j + 3] = t.w; ss += t.x * t.x + t.y * t.y + t.z * t.z + t.w * t.w; }
    ss = wave_sum(ss);
    const float rstd = rsqrtf(ss * (1.f / D) + EPS);
    const float* md = MOD + ((size_t)l * 9 + modidx(r)) * 6144;
#pragma unroll
    for (int j = 0; j < 4; ++j)
#pragma unroll
      for (int i = 0; i < 4; ++i) { const int c = j * 256 + lane * 4 + i; const float y = v[4 * j + i] * rstd * g[c] * (1.f + md[1024 + c]) + md[c]; H[(size_t)r * D + c] = f2bf(y); }
  }
}

struct RowId { DI int operator()(int m) const { return m; } };
struct RowGather { const int* idx; DI int operator()(int m) const { return idx[m]; } };
template <class RM>
DI void gemm_tile_acc(float (&acc)[4][4], const bf16* A, int lda, const RM& rm, int m0, const float* B, int ldb, int n0, int nmax, int K, float* As, float* Bs) {
  const int t = threadIdx.x, tx = t & 15, ty = t >> 4;
  const int ar = t >> 2, ak = (t & 3) * 4;
  const int bk = t >> 4, bn = (t & 15) * 4;
  const bf16* ap = A + (size_t)rm(m0 + ar) * lda + ak;
  for (int k0 = 0; k0 < K; k0 += 16) {
    const uint2 av = *(const uint2*)(ap + k0);
    As[(ak + 0) * 68 + ar] = __uint_as_float(av.x << 16); As[(ak + 1) * 68 + ar] = __uint_as_float(av.x & 0xffff0000u);
    As[(ak + 2) * 68 + ar] = __uint_as_float(av.y << 16); As[(ak + 3) * 68 + ar] = __uint_as_float(av.y & 0xffff0000u);
    float4 bv = make_float4(0.f, 0.f, 0.f, 0.f);
    if (n0 + bn < nmax) bv = *(const float4*)(B + (size_t)(k0 + bk) * ldb + n0 + bn);
    *(float4*)(Bs + bk * 64 + bn) = bv;
    __syncthreads();
#pragma unroll
    for (int kk = 0; kk < 16; ++kk) {
      const float4 a = *(const float4*)(As + kk * 68 + ty * 4);
      const float4 b = *(const float4*)(Bs + kk * 64 + tx * 4);
      const float aa[4] = {a.x, a.y, a.z, a.w}, bb[4] = {b.x, b.y, b.z, b.w};
#pragma unroll
      for (int i = 0; i < 4; ++i)
#pragma unroll
        for (int j = 0; j < 4; ++j) acc[i][j] += aa[i] * bb[j];
    }
    __syncthreads();
  }
}
#define ZERO_ACC(acc) do { _Pragma("unroll") for (int i_ = 0; i_ < 4; ++i_) _Pragma("unroll") for (int j_ = 0; j_ < 4; ++j_) acc[i_][j_] = 0.f; } while (0)

__global__ __launch_bounds__(256) void k_gemm_bf16out(const bf16* A, int lda, const float* B, int ldb, bf16* C, int ldc, int M, int N, int K) {
  __shared__ __attribute__((aligned(16))) float As[16 * 68]; __shared__ __attribute__((aligned(16))) float Bs[16 * 64];
  const int nt = (N + 63) / 64, mt = M / 64; const int tx = threadIdx.x & 15, ty = threadIdx.x >> 4;
  for (int u = blockIdx.x; u < mt * nt; u += gridDim.x) {
    const int m0 = (u / nt) * 64, n0 = (u % nt) * 64;
    float acc[4][4]; ZERO_ACC(acc);
    gemm_tile_acc(acc, A, lda, RowId(), m0, B, ldb, n0, N, K, As, Bs);
#pragma unroll
    for (int i = 0; i < 4; ++i)
#pragma unroll
      for (int j = 0; j < 4; ++j) { const int n = n0 + tx * 4 + j; if (n < N) C[(size_t)(m0 + ty * 4 + i) * ldc + n] = f2bf(acc[i][j]); }
  }
}

DI void rope_tables(int r, float* cs, float* sn) {
  const int s = r & (SEQ - 1); const float row = (float)(s >> 6), col = (float)(s & 63);
#pragma unroll
  for (int i = 0; i < 8; ++i) { const float inv = powf(10000.f, -(float)(2 * i) / 16.f); cs[i] = cosf(row * inv); sn[i] = sinf(row * inv); cs[8 + i] = cosf(col * inv); sn[8 + i] = sinf(col * inv); }
}
__global__ __launch_bounds__(256) void k_prep1(Params p, int l) {
  const bf16* PROJ = (const bf16*)(p.ws + WS_PROJ);
  bf16* CU = (bf16*)(p.ws + WS_CU); bf16* CQ = (bf16*)(p.ws + WS_CQ); bf16* CKV = (bf16*)(p.ws + WS_CKV);
  bf16* DQ = (bf16*)(p.ws + WS_DQ); bf16* DK = (bf16*)(p.ws + WS_DK); bf16* DV = (bf16*)(p.ws + WS_DV);
  bf16* NQ = (bf16*)(p.ws + WS_NQ); bf16* NK = (bf16*)(p.ws + WS_NK); bf16* NV = (bf16*)(p.ws + WS_NV);
  const long total = (long)T * 35;
  for (long idx = (long)blockIdx.x * blockDim.x + threadIdx.x; idx < total; idx += (long)gridDim.x * blockDim.x) {
    const int r = (int)(idx / 35), job = (int)(idx % 35);
    const bf16* pr = PROJ + (size_t)r * PLD;
    if (job == 0) {
      for (int c = 0; c < 256; ++c) { const float a = bf2f(pr[c]), g = bf2f(pr[256 + c]); CU[(size_t)r * 256 + c] = f2bf(a * sigmoidf_(g)); }
    } else if (job == 1) {
      float ss = 0.f; for (int c = 0; c < 192; ++c) { const float v = bf2f(pr[OFF_B + c]); ss += v * v; }
      const float rs = rsqrtf(ss / 192.f + EPS); const float* g = p.in[I_CQG] + l * 192;
      for (int c = 0; c < 192; ++c) CQ[(size_t)r * 192 + c] = f2bf(bf2f(pr[OFF_B + c]) * rs * g[c]);
    } else if (job == 2) {
      float ss = 0.f; for (int c = 0; c < 128; ++c) { const float v = bf2f(pr[OFF_B + 192 + c]); ss += v * v; }
      const float rs = rsqrtf(ss / 128.f + EPS); const float* g = p.in[I_CKVG] + l * 128;
      for (int c = 0; c < 128; ++c) CKV[(size_t)r * 128 + c] = f2bf(bf2f(pr[OFF_B + 192 + c]) * rs * g[c]);
    } else if (job < 19) {
      const bool isq = job < 11; const int hc = isq ? job - 3 : job - 11, h = hc >> 1, c = hc & 1;
      const bf16* src = pr + OFF_C + h * 192 + (isq ? 0 : 64) + c * 32;
      float v[32]; float ss = 0.f;
#pragma unroll
      for (int i = 0; i < 32; ++i) { v[i] = bf2f(src[i]); ss += v[i] * v[i]; }
      const float rs = rsqrtf(ss / 32.f + EPS); const float* g = p.in[isq ? I_DQNG : I_DKNG] + l * 32;
#pragma unroll
      for (int i = 0; i < 32; ++i) v[i] = v[i] * rs * g[i];
      if (r < TL) { float cs[16], sn[16]; rope_tables(r, cs, sn);
#pragma unroll
        for (int i = 0; i < 16; ++i) { const float x1 = v[i], x2 = v[16 + i]; v[i] = x1 * cs[i] - x2 * sn[i]; v[16 + i] = x2 * cs[i] + x1 * sn[i]; } }
      const float sc = isq ? (0.17677669529663687f * LOG2E) : 1.f;
      bf16* dst = (isq ? DQ : DK) + (size_t)r * 256 + hc * 32;
#pragma unroll
      for (int i = 0; i < 32; ++i) dst[i] = f2bf(v[i] * sc);
    } else if (job < 23) {
      const int h = job - 19; const bf16* src = pr + OFF_C + h * 192 + 128;
      for (int i = 0; i < 64; ++i) DV[(size_t)r * 256 + h * 64 + i] = src[i];
    } else if (job < 31) {
      const bool isq = job < 27; const int h = isq ? job - 23 : job - 27;
      const bf16* src = pr + OFF_D + h * 192 + (isq ? 0 : 64);
      float ss = 0.f; for (int i = 0; i < 64; ++i) { const float v = bf2f(src[i]); ss += v * v; }
      const float rs = rsqrtf(ss / 64.f + EPS); const float* g = p.in[isq ? I_NQNG : I_NKNG] + l * 64;
      const float sc = isq ? (0.125f * LOG2E) : 1.f;
      bf16* dst = (isq ? NQ : NK) + (size_t)r * 256 + h * 64;
      for (int i = 0; i < 64; ++i) dst[i] = f2bf(bf2f(src[i]) * rs * g[i] * sc);
    } else {
      const int h = job - 31; const bf16* src = pr + OFF_D + h * 192 + 128;
      for (int i = 0; i < 64; ++i) NV[(size_t)r * 256 + h * 64 + i] = src[i];
    }
  }
}
__global__ __launch_bounds__(256) void k_prep2(Params p, int l) {
  const bf16* PROJ = (const bf16*)(p.ws + WS_PROJ); const bf16* RAW = (const bf16*)(p.ws + WS_QKVRAW);
  bf16* MQ = (bf16*)(p.ws + WS_MQ); bf16* MK = (bf16*)(p.ws + WS_MK); bf16* MV = (bf16*)(p.ws + WS_MV);
  const long total = (long)T * 8;
  for (long idx = (long)blockIdx.x * blockDim.x + threadIdx.x; idx < total; idx += (long)gridDim.x * blockDim.x) {
    const int r = (int)(idx >> 3), job = (int)(idx & 7), h = job & 3; const bool isq = job < 4;
    float v[96];
    const bf16* s0 = isq ? RAW + (size_t)r * 896 + h * 96 : RAW + (size_t)r * 896 + 384 + h * 128;
    const bf16* s1 = isq ? s0 + 64 : PROJ + (size_t)r * PLD + OFF_B + 320;
#pragma unroll
    for (int i = 0; i < 64; ++i) v[i] = bf2f(s0[i]);
#pragma unroll
    for (int i = 0; i < 32; ++i) v[64 + i] = bf2f(s1[i]);
    if (!isq) { for (int i = 0; i < 64; ++i) MV[(size_t)r * 256 + h * 64 + i] = RAW[(size_t)r * 896 + 384 + h * 128 + 64 + i]; }
    float ss = 0.f;
#pragma unroll
    for (int i = 0; i < 96; ++i) ss += v[i] * v[i];
    const float rs = rsqrtf(ss / 96.f + EPS); const float* g = p.in[isq ? I_QNG : I_KNG] + l * 96;
#pragma unroll
    for (int i = 0; i < 96; ++i) v[i] = v[i] * rs * g[i];
    if (r < TL) { float cs[16], sn[16]; rope_tables(r, cs, sn);
#pragma unroll
      for (int i = 0; i < 16; ++i) { const float x1 = v[64 + i], x2 = v[80 + i]; v[64 + i] = x1 * cs[i] - x2 * sn[i]; v[80 + i] = x2 * cs[i] + x1 * sn[i]; } }
    const float sc = isq ? (0.10206207261596577f * LOG2E) : 1.f;
    bf16* dst = (isq ? MQ : MK) + (size_t)r * 384 + h * 96;
#pragma unroll
    for (int i = 0; i < 96; ++i) dst[i] = f2bf(v[i] * sc);
  }
}

__global__ void k_conv(Params p, int l, int nrows) {
  const int lane = threadIdx.x & 63, gw = (blockIdx.x * blockDim.x + threadIdx.x) >> 6, ngw = (gridDim.x * blockDim.x) >> 6;
  const bf16* CU = (const bf16*)(p.ws + WS_CU); bf16* BI = (bf16*)(p.ws + WS_BI);
  const float* cw = p.in[I_CONVW] + l * 31 * 256; const float* cb = p.in[I_CONVB] + l * 256;
  const float* lg = p.in[I_CLNG] + l * 256; const float* lb = p.in[I_CLNB] + l * 256;
  for (int r = gw; r < nrows; r += ngw) {
    int lo, hi; if (r < TL) { lo = r & ~(SEQ - 1); hi = lo + SEQ; } else { lo = TL + ((r - TL) & ~(CTX - 1)); hi = lo + CTX; }
    float a[4];
#pragma unroll
    for (int i = 0; i < 4; ++i) a[i] = cb[lane * 4 + i];
    for (int j = 0; j < 31; ++j) { const int rr = r + j - 15; if (rr < lo || rr >= hi) continue;
      const uint2 u = *(const uint2*)(CU + (size_t)rr * 256 + lane * 4); const float4 w = *(const float4*)(cw + j * 256 + lane * 4);
      a[0] += __uint_as_float(u.x << 16) * w.x; a[1] += __uint_as_float(u.x & 0xffff0000u) * w.y; a[2] += __uint_as_float(u.y << 16) * w.z; a[3] += __uint_as_float(u.y & 0xffff0000u) * w.w; }
    const float mu = wave_sum(a[0] + a[1] + a[2] + a[3]) * (1.f / 256.f);
    float q = 0.f;
#pragma unroll
    for (int i = 0; i < 4; ++i) { a[i] -= mu; q += a[i] * a[i]; }
    const float rs = rsqrtf(wave_sum(q) * (1.f / 256.f) + EPS);
#pragma unroll
    for (int i = 0; i < 4; ++i) { const int c = lane * 4 + i; const float y = a[i] * rs * lg[c] + lb[c]; BI[(size_t)r * D + c] = f2bf(y * sigmoidf_(y)); }
  }
}

template <int DQK>
__global__ __launch_bounds__(256) void k_attn_naive(const bf16* Q, const bf16* K, const bf16* V, int nhv, int vdiv, bf16* O, int ldo, int ooff, int qbase, int nq_per_b, bool with_latent) {
  const int chunks = nq_per_b / 256; const int nunits = NB * nhv * chunks;
  for (int u = blockIdx.x; u < nunits; u += gridDim.x) {
    const int ch = u % chunks, hv = (u / chunks) % nhv, b = u / (chunks * nhv);
    const int r = qbase + b * nq_per_b + ch * 256 + threadIdx.x;
    float q[DQK];
#pragma unroll
    for (int i = 0; i < DQK; ++i) q[i] = bf2f(Q[(size_t)r * (nhv * DQK) + hv * DQK + i]);
    float m = -1e30f, lsum = 0.f; float o[64];
#pragma unroll
    for (int i = 0; i < 64; ++i) o[i] = 0.f;
    const int hvv = hv / vdiv;
    for (int seg = 0; seg < (with_latent ? 2 : 1); ++seg) {
      const int k0 = seg == 0 ? TL + b * CTX : b * SEQ, nk = seg == 0 ? CTX : SEQ;
      for (int kk = 0; kk < nk; ++kk) {
        const bf16* kp = K + (size_t)(k0 + kk) * (nhv * DQK) + hv * DQK;
        float s = 0.f;
#pragma unroll
        for (int i = 0; i < DQK; ++i) s += q[i] * bf2f(kp[i]);
        const float mn = fmaxf(m, s); const float a = exp2f(m - mn), pe = exp2f(s - mn); m = mn; lsum = lsum * a + pe;
        const bf16* vp = V + (size_t)(k0 + kk) * 256 + hvv * 64;
#pragma unroll
        for (int i = 0; i < 64; ++i) o[i] = o[i] * a + pe * bf2f(vp[i]);
      }
    }
    const float il = 1.f / lsum;
#pragma unroll
    for (int i = 0; i < 64; ++i) O[(size_t)r * ldo + ooff + hv * 64 + i] = f2bf(o[i] * il);
  }
}

__global__ __launch_bounds__(256) void k_na_naive(Params p, int l) {
  const bf16* Q = (const bf16*)(p.ws + WS_NQ); const bf16* K = (const bf16*)(p.ws + WS_NK); const bf16* V = (const bf16*)(p.ws + WS_NV);
  bf16* BI = (bf16*)(p.ws + WS_BI);
  const float* rpb = p.in[I_RPB] + (size_t)l * NH * 15 * 31;
  const int nunits = NB * NH * (SEQ / 256);
  for (int u = blockIdx.x; u < nunits; u += gridDim.x) {
    const int ch = u % 16, h = (u / 16) % NH, b = u / 64;
    const int s = ch * 256 + threadIdx.x, r = b * SEQ + s, qr = s >> 6, qc = s & 63;
    float q[64];
#pragma unroll
    for (int i = 0; i < 64; ++i) q[i] = bf2f(Q[(size_t)r * 256 + h * 64 + i]);
    float m = -1e30f, lsum = 0.f; float o[64];
#pragma unroll
    for (int i = 0; i < 64; ++i) o[i] = 0.f;
    const int rs0 = min(max(qr - 4, 0), 56), ws0 = min(max(qc - 8, 0), 48);
    for (int kk = 0; kk < CTX + 128; ++kk) {
      int kr_; float bias = 0.f;
      if (kk < CTX) kr_ = TL + b * CTX + kk;
      else { const int i = (kk - CTX) >> 4, j = (kk - CTX) & 15; const int krow = rs0 + i, kcol = ws0 + j; kr_ = b * SEQ + krow * 64 + kcol;
             bias = rpb[(h * 15 + (krow - qr + 7)) * 31 + (kcol - qc + 15)] * LOG2E; }
      const bf16* kp = K + (size_t)kr_ * 256 + h * 64;
      float sc = 0.f;
#pragma unroll
      for (int i = 0; i < 64; ++i) sc += q[i] * bf2f(kp[i]);
      sc += bias;
      const float mn = fmaxf(m, sc); const float a = exp2f(m - mn), pe = exp2f(sc - mn); m = mn; lsum = lsum * a + pe;
      const bf16* vp = V + (size_t)kr_ * 256 + h * 64;
#pragma unroll
      for (int i = 0; i < 64; ++i) o[i] = o[i] * a + pe * bf2f(vp[i]);
    }
    const float il = 1.f / lsum;
#pragma unroll
    for (int i = 0; i < 64; ++i) BI[(size_t)r * D + 768 + h * 64 + i] = f2bf(o[i] * il);
  }
}

__global__ __launch_bounds__(256) void k_diffcombine(Params p, int l, int nrows, float lam_init) {
  const bf16* DO_ = (const bf16*)(p.ws + WS_DO); bf16* BI = (bf16*)(p.ws + WS_BI);
  const float* lv = p.in[I_DLAM] + l * 128;
  float s1 = 0.f, s2 = 0.f; for (int i = 0; i < 32; ++i) { s1 += lv[i] * lv[32 + i]; s2 += lv[64 + i] * lv[96 + i]; }
  const float lam = expf(s1) - expf(s2) + lam_init;
  const float* g = p.in[I_DSUBG] + l * 64;
  for (long idx = (long)blockIdx.x * blockDim.x + threadIdx.x; idx < (long)nrows * 4; idx += (long)gridDim.x * blockDim.x) {
    const int r = (int)(idx >> 2), h = (int)(idx & 3);
    float v[64]; float ss = 0.f;
#pragma unroll
    for (int i = 0; i < 64; ++i) { v[i] = bf2f(DO_[(size_t)r * 512 + (h * 2) * 64 + i]) - lam * bf2f(DO_[(size_t)r * 512 + (h * 2 + 1) * 64 + i]); ss += v[i] * v[i]; }
    const float rs = rsqrtf(ss / 64.f + EPS);
#pragma unroll
    for (int i = 0; i < 64; ++i) BI[(size_t)r * D + 512 + h * 64 + i] = f2bf(v[i] * rs * g[i] * (1.f - lam_init));
  }
}

__global__ __launch_bounds__(256) void k_merge(Params p, int l, int nrows) {
  __shared__ __attribute__((aligned(16))) float As[16 * 68]; __shared__ __attribute__((aligned(16))) float Bs[16 * 64];
  const bf16* H = (const bf16*)(p.ws + WS_H); const bf16* BI = (const bf16*)(p.ws + WS_BI); bf16* YM = (bf16*)(p.ws + WS_YM);
  const float* gw = p.in[I_GATEW] + (size_t)l * D * 4096; const float* gb = p.in[I_GATEB] + l * 4096;
  const float* Wb[4] = {p.in[I_CONVOUT] + (size_t)l * 256 * D, p.in[I_MLAOUT] + (size_t)l * 256 * D, p.in[I_DIFFOUT] + (size_t)l * 256 * D, p.in[I_NAOUT] + (size_t)l * 256 * D};
  const int tx = threadIdx.x & 15, ty = threadIdx.x >> 4; const int mt = nrows / 64, nt = D / 64;
  for (int u = blockIdx.x; u < mt * nt; u += gridDim.x) {
    const int m0 = (u / nt) * 64, n0 = (u % nt) * 64;
    float y[4][4]; ZERO_ACC(y);
    for (int b = 0; b < 4; ++b) {
      float ag[4][4], ay[4][4]; ZERO_ACC(ag); ZERO_ACC(ay);
      gemm_tile_acc(ag, H, D, RowId(), m0, gw, 4096, b * D + n0, 4096, D, As, Bs);
      gemm_tile_acc(ay, BI + b * 256, D, RowId(), m0, Wb[b], D, n0, D, 256, As, Bs);
#pragma unroll
      for (int i = 0; i < 4; ++i)
#pragma unroll
        for (int j = 0; j < 4; ++j) y[i][j] += sigmoidf_(ag[i][j] + gb[b * D + n0 + tx * 4 + j]) * ay[i][j];
    }
#pragma unroll
    for (int i = 0; i < 4; ++i)
#pragma unroll
      for (int j = 0; j < 4; ++j) YM[(size_t)(m0 + ty * 4 + i) * D + n0 + tx * 4 + j] = f2bf(y[i][j]);
  }
}

__global__ __launch_bounds__(256) void k_wo(Params p, int l, int nrows) {
  __shared__ __attribute__((aligned(16))) float As[16 * 68]; __shared__ __attribute__((aligned(16))) float Bs[16 * 64];
  const bf16* YM = (const bf16*)(p.ws + WS_YM); float* XF = (float*)(p.ws + WS_XF); const float* MOD = (const float*)(p.ws + WS_MOD);
  const float* W = p.in[I_WO] + (size_t)l * D * D;
  const int tx = threadIdx.x & 15, ty = threadIdx.x >> 4; const int mt = nrows / 64, nt = D / 64;
  for (int u = blockIdx.x; u < mt * nt; u += gridDim.x) {
    const int m0 = (u / nt) * 64, n0 = (u % nt) * 64;
    float acc[4][4]; ZERO_ACC(acc);
    gemm_tile_acc(acc, YM, D, RowId(), m0, W, D, n0, D, D, As, Bs);
#pragma unroll
    for (int i = 0; i < 4; ++i) { const int r = m0 + ty * 4 + i; const float* xs = stream_row(p, l, r, false); const float* md = MOD + ((size_t)l * 9 + modidx(r)) * 6144 + 2048;
#pragma unroll
      for (int j = 0; j < 4; ++j) { const int n = n0 + tx * 4 + j; XF[(size_t)r * D + n] = xs[n] + md[n] * acc[i][j]; } }
  }
}

__global__ __launch_bounds__(256) void k_mod2_router(Params p, int l, int nrows) {
  const int lane = threadIdx.x & 63, gw = (blockIdx.x * blockDim.x + threadIdx.x) >> 6, ngw = (gridDim.x * blockDim.x) >> 6;
  const float* MOD = (const float*)(p.ws + WS_MOD); const float* XF = (const float*)(p.ws + WS_XF);
  bf16* H2 = (bf16*)(p.ws + WS_H2); const float* g = p.in[I_N2G] + l * D;
  const float* rw = p.in[I_RW] + (size_t)l * D * NE; const float* rb = p.in[I_RB] + l * NE;
  int* ROUTE = (int*)(p.ws + WS_ROUTE); unsigned* cnt = (unsigned*)(p.ws + WS_CTL) + CW_CNT + l * 64;
  for (int r = gw; r < nrows; r += ngw) {
    const float* x = XF + (size_t)r * D;
    float v[16]; float ss = 0.f;
#pragma unroll
    for (int j = 0; j < 4; ++j) { const float4 t = *(const float4*)(x + j * 256 + lane * 4); v[4 * j] = t.x; v[4 * j + 1] = t.y; v[4 * j + 2] = t.z; v[4 * j + 3] = t.w; ss += t.x * t.x + t.y * t.y + t.z * t.z + t.w * t.w; }
    ss = wave_sum(ss);
    const float rstd = rsqrtf(ss * (1.f / D) + EPS);
    const float* md = MOD + ((size_t)l * 9 + modidx(r)) * 6144;
    float lg[NE];
#pragma unroll
    for (int e = 0; e < NE; ++e) lg[e] = 0.f;
#pragma unroll
    for (int j = 0; j < 4; ++j)
#pragma unroll
      for (int i = 0; i < 4; ++i) { const int c = j * 256 + lane * 4 + i; const float y = v[4 * j + i] * rstd * g[c] * (1.f + md[4 * 1024 + c]) + md[3 * 1024 + c];
        const bf16 yb = f2bf(y); H2[(size_t)r * D + c] = yb;
        const float yr = y;
        const float* w = rw + (size_t)c * NE;
#pragma unroll
        for (int e = 0; e < NE; ++e) lg[e] += yr * w[e]; }
#pragma unroll
    for (int e = 0; e < NE; ++e) lg[e] = wave_sum(lg[e]) + rb[e];
    int te[4]; float tv[4];
#pragma unroll
    for (int k = 0; k < 4; ++k) { float best = -3.4e38f; int bi = 0;
#pragma unroll
      for (int e = 0; e < NE; ++e) { const bool taken = (k > 0 && te[0] == e) || (k > 1 && te[1] == e) || (k > 2 && te[2] == e); if (!taken && lg[e] > best) { best = lg[e]; bi = e; } }
      te[k] = bi; tv[k] = best; }
    const float mx = tv[0]; float ex[4], se = 0.f;
#pragma unroll
    for (int k = 0; k < 4; ++k) { ex[k] = expf(tv[k] - mx); se += ex[k]; }
    if (lane == 0) {
#pragma unroll
      for (int k = 0; k < 4; ++k) { const unsigned pos = atomicAdd(&cnt[te[k]], 1u); int* rt = ROUTE + ((size_t)r * 4 + k) * 4; rt[0] = te[k]; rt[1] = (int)pos; rt[2] = __float_as_int(ex[k] / se); rt[3] = 0; }
    }
  }
}
DI void expert_offsets(const unsigned* cnt, int* off  ) { int a = 0; for (int e = 0; e < NE; ++e) { off[e] = a; a += ((int)cnt[e] + 255) & ~255; } off[NE] = a; }
__global__ void k_scatter(Params p, int l, int nrows) {
  __shared__ int off[NE + 1];
  const unsigned* cnt = (const unsigned*)(p.ws + WS_CTL) + CW_CNT + l * 64;
  if (threadIdx.x == 0) expert_offsets(cnt, off);
  __syncthreads();
  int* ROWTOK = (int*)(p.ws + WS_ROWTOK); const int* ROUTE = (const int*)(p.ws + WS_ROUTE);
  for (long idx = (long)blockIdx.x * blockDim.x + threadIdx.x; idx < (long)nrows * 4; idx += (long)gridDim.x * blockDim.x) {
    const int* rt = ROUTE + idx * 4; ROWTOK[off[rt[0]] + rt[1]] = (int)(idx >> 2);
  }
  for (int e = 0; e < NE; ++e) for (int i = off[e] + (int)cnt[e] + blockIdx.x * blockDim.x + threadIdx.x; i < off[e + 1]; i += gridDim.x * blockDim.x) ROWTOK[i] = 0;
}
__global__ __launch_bounds__(256) void k_moe1(Params p, int l) {
  __shared__ __attribute__((aligned(16))) float As[16 * 68]; __shared__ __attribute__((aligned(16))) float Bs[16 * 64]; __shared__ int off[NE + 1];
  const unsigned* cnt = (const unsigned*)(p.ws + WS_CTL) + CW_CNT + l * 64;
  if (threadIdx.x == 0) expert_offsets(cnt, off);
  __syncthreads();
  const bf16* H2 = (const bf16*)(p.ws + WS_H2); bf16* ACT = (bf16*)(p.ws + WS_ACT); const int* ROWTOK = (const int*)(p.ws + WS_ROWTOK);
  const int tx = threadIdx.x & 15, ty = threadIdx.x >> 4; const int mt = off[NE] / 64, nt = DFF / 64;
  for (int u = blockIdx.x; u < mt * nt; u += gridDim.x) {
    const int m0 = (u / nt) * 64, n0 = (u % nt) * 64;
    int e = 0; while (off[e + 1] <= m0) ++e;
    const float* W = p.in[I_WGU] + ((size_t)l * NE + e) * D * 2048; const float* bg = p.in[I_BGU] + ((size_t)l * NE + e) * 2048;
    float ag[4][4], au[4][4]; ZERO_ACC(ag); ZERO_ACC(au);
    RowGather rg{ROWTOK};
    gemm_tile_acc(ag, H2, D, rg, m0, W, 2048, n0, 2048, D, As, Bs);
    gemm_tile_acc(au, H2, D, rg, m0, W, 2048, 1024 + n0, 2048, D, As, Bs);
#pragma unroll
    for (int i = 0; i < 4; ++i)
#pragma unroll
      for (int j = 0; j < 4; ++j) { const int n = n0 + tx * 4 + j; const float g = fminf(ag[i][j] + bg[n], 7.f); const float uu = fminf(fmaxf(au[i][j] + bg[1024 + n], -7.f), 7.f);
        ACT[(size_t)(m0 + ty * 4 + i) * D + n] = f2bf((uu + 1.f) * (g * sigmoidf_(1.702f * g))); }
  }
}
__global__ __launch_bounds__(256) void k_moe2(Params p, int l) {
  __shared__ __attribute__((aligned(16))) float As[16 * 68]; __shared__ __attribute__((aligned(16))) float Bs[16 * 64]; __shared__ int off[NE + 1];
  const unsigned* cnt = (const unsigned*)(p.ws + WS_CTL) + CW_CNT + l * 64;
  if (threadIdx.x == 0) expert_offsets(cnt, off);
  __syncthreads();
  const bf16* ACT = (const bf16*)(p.ws + WS_ACT); bf16* YE = (bf16*)(p.ws + WS_YE);
  const int tx = threadIdx.x & 15, ty = threadIdx.x >> 4; const int mt = off[NE] / 64, nt = D / 64;
  for (int u = blockIdx.x; u < mt * nt; u += gridDim.x) {
    const int m0 = (u / nt) * 64, n0 = (u % nt) * 64;
    int e = 0; while (off[e + 1] <= m0) ++e;
    const float* W = p.in[I_WDN] + ((size_t)l * NE + e) * DFF * D; const float* bd = p.in[I_BDN] + ((size_t)l * NE + e) * D;
    float acc[4][4]; ZERO_ACC(acc);
    gemm_tile_acc(acc, ACT, D, RowId(), m0, W, D, n0, D, DFF, As, Bs);
#pragma unroll
    for (int i = 0; i < 4; ++i)
#pragma unroll
      for (int j = 0; j < 4; ++j) { const int n = n0 + tx * 4 + j; YE[(size_t)(m0 + ty * 4 + i) * D + n] = f2bf(acc[i][j] + bd[n]); }
  }
}
__global__ void k_combine(Params p, int l, int nrows) {
  __shared__ int off[NE + 1];
  const unsigned* cnt = (const unsigned*)(p.ws + WS_CTL) + CW_CNT + l * 64;
  if (threadIdx.x == 0) expert_offsets(cnt, off);
  __syncthreads();
  const int lane = threadIdx.x & 63, gw = (blockIdx.x * blockDim.x + threadIdx.x) >> 6, ngw = (gridDim.x * blockDim.x) >> 6;
  const float* MOD = (const float*)(p.ws + WS_MOD); float* XF = (float*)(p.ws + WS_XF); const bf16* YE = (const bf16*)(p.ws + WS_YE); const int* ROUTE = (const int*)(p.ws + WS_ROUTE);
  for (int r = gw; r < nrows; r += ngw) {
    const float* md = MOD + ((size_t)l * 9 + modidx(r)) * 6144 + 5 * 1024;
    float* dst = (l == 1) ? p.out + (size_t)r * D : XF + (size_t)r * D;
    const float* xs = XF + (size_t)r * D;
    float acc[16];
#pragma unroll
    for (int i = 0; i < 16; ++i) acc[i] = 0.f;
    for (int k = 0; k < 4; ++k) { const int* rt = ROUTE + ((size_t)r * 4 + k) * 4; const float w = __int_as_float(rt[2]); const bf16* y = YE + (size_t)(off[rt[0]] + rt[1]) * D;
#pragma unroll
      for (int j = 0; j < 4; ++j) { const uint2 u = *(const uint2*)(y + j * 256 + lane * 4);
        acc[4 * j] += w * __uint_as_float(u.x << 16); acc[4 * j + 1] += w * __uint_as_float(u.x & 0xffff0000u); acc[4 * j + 2] += w * __uint_as_float(u.y << 16); acc[4 * j + 3] += w * __uint_as_float(u.y & 0xffff0000u); } }
#pragma unroll
    for (int j = 0; j < 4; ++j)
#pragma unroll
      for (int i = 0; i < 4; ++i) { const int c = j * 256 + lane * 4 + i; dst[c] = xs[c] + md[c] * acc[4 * j + i]; }
  }
}

extern "C" void kernel_launch(void* const* d_in, const int* in_sizes, int n_in, void* d_out, int out_size, void* d_ws, size_t ws_size, hipStream_t stream) {
  if (n_in != N_IN || ws_size < WS_END) { fprintf(stderr, "kernel_launch: n_in %d ws %zu need %zu\n", n_in, ws_size, (size_t)WS_END); return; }
  Params p{};
  for (int i = 0; i < N_IN; ++i) p.in[i] = (const float*)d_in[i];
  p.out = (float*)d_out; p.ws = (unsigned char*)d_ws;
  (void)hipMemsetAsync((char*)d_ws + WS_CTL, 0, 1 * MiB, stream);
  unsigned char* ws = p.ws;
  const int G = 2048;
  k_ada<<<48, 256, 0, stream>>>(p);
  for (int l = 0; l < 2; ++l) {
    const bool last = (l == 1);
    const int nrows = last ? TL : T;
    const float lam_init = 0.8f - 0.6f * expf(-0.3f * (float)l);
    k_mod1<<<G, 256, 0, stream>>>(p, l);
    k_gemm_bf16out<<<G, 256, 0, stream>>>((const bf16*)(ws + WS_H), D, p.in[I_WIN] + (size_t)l * D * INW, INW, (bf16*)(ws + WS_PROJ), PLD, T, INW, D);
    k_prep1<<<G, 256, 0, stream>>>(p, l);
    k_gemm_bf16out<<<G, 256, 0, stream>>>((const bf16*)(ws + WS_CQ), 192, p.in[I_WUQ] + (size_t)l * 192 * 384, 384, (bf16*)(ws + WS_QKVRAW), 896, T, 384, 192);
    k_gemm_bf16out<<<G, 256, 0, stream>>>((const bf16*)(ws + WS_CKV), 128, p.in[I_WUKV] + (size_t)l * 128 * 512, 512, (bf16*)(ws + WS_QKVRAW) + 384, 896, T, 512, 128);
    k_prep2<<<G, 256, 0, stream>>>(p, l);
    k_conv<<<G, 256, 0, stream>>>(p, l, nrows);
    k_attn_naive<96><<<NB * 4 * 16, 256, 0, stream>>>((const bf16*)(ws + WS_MQ), (const bf16*)(ws + WS_MK), (const bf16*)(ws + WS_MV), 4, 1, (bf16*)(ws + WS_BI), D, 256, 0, SEQ, true);
    k_attn_naive<32><<<NB * 8 * 16, 256, 0, stream>>>((const bf16*)(ws + WS_DQ), (const bf16*)(ws + WS_DK), (const bf16*)(ws + WS_DV), 8, 2, (bf16*)(ws + WS_DO), 512, 0, 0, SEQ, true);
    k_na_naive<<<NB * 4 * 16, 256, 0, stream>>>(p, l);
    if (!last) {
      k_attn_naive<96><<<NB * 4, 256, 0, stream>>>((const bf16*)(ws + WS_MQ), (const bf16*)(ws + WS_MK), (const bf16*)(ws + WS_MV), 4, 1, (bf16*)(ws + WS_BI), D, 256, TL, CTX, false);
      k_attn_naive<32><<<NB * 8, 256, 0, stream>>>((const bf16*)(ws + WS_DQ), (const bf16*)(ws + WS_DK), (const bf16*)(ws + WS_DV), 8, 2, (bf16*)(ws + WS_DO), 512, 0, TL, CTX, false);
      k_attn_naive<64><<<NB * 4, 256, 0, stream>>>((const bf16*)(ws + WS_NQ), (const bf16*)(ws + WS_NK), (const bf16*)(ws + WS_NV), 4, 1, (bf16*)(ws + WS_BI), D, 768, TL, CTX, false);
    }
    k_diffcombine<<<G, 256, 0, stream>>>(p, l, nrows, lam_init);
    k_merge<<<G, 256, 0, stream>>>(p, l, nrows);
    k_wo<<<G, 256, 0, stream>>>(p, l, nrows);
    k_mod2_router<<<G, 256, 0, stream>>>(p, l, nrows);
    k_scatter<<<256, 256, 0, stream>>>(p, l, nrows);
    k_moe1<<<G, 256, 0, stream>>>(p, l);
    k_moe2<<<G, 256, 0, stream>>>(p, l);
    k_combine<<<G, 256, 0, stream>>>(p, l, nrows);
  }
}
```

```cpp
#include <hip/hip_runtime.h>
#include <cstdio>
#include <cstdint>

typedef unsigned short bf16;
#ifndef FAST_ATTN
#define FAST_ATTN 1
#endif
#if FAST_ATTN
#define ATTN_FN ph_attn_fast
#define ATTN_LDS , lds
#else
#define ATTN_FN ph_attn_naive
#define ATTN_LDS
#endif
#ifndef FAST_NA
#define FAST_NA 1
#endif
#ifndef FAST_SMALL
#define FAST_SMALL 1
#endif
#ifndef FAST_ROUTER
#define FAST_ROUTER 1
#endif
#ifndef FAST_PROJ
#define FAST_PROJ 1
#endif
#ifndef FAST_QKV
#define FAST_QKV 1
#endif
#ifndef FAST_MERGE
#define FAST_MERGE 1
#endif
#ifndef FAST_WO
#define FAST_WO 1
#endif
#ifndef FAST_MOE
#define FAST_MOE 1
#endif
#define DI __device__ __forceinline__

constexpr int D = 1024, NB = 8, SEQ = 4096, CTX = 256, GW = 64;
constexpr int TL = NB * SEQ;
constexpr int TC = NB * CTX;
constexpr int T = TL + TC;
constexpr int NH = 4;
constexpr int INW = 2400, PLD = 2560;
constexpr int OFF_B = 512, OFF_C = 864, OFF_D = 1632;
constexpr int NE = 32, DFF = 1024;
constexpr int MAXROWS = 4 * T + NE * 256;
constexpr float EPS = 1e-6f;
constexpr float LOG2E = 1.4426950408889634f;

enum { I_X = 0, I_C, I_CTX, I_CCTX, I_ADAW, I_ADAB, I_N1G, I_N2G, I_WIN, I_CONVW, I_CONVB, I_CLNG, I_CLNB, I_CONVOUT,
       I_CQG, I_CKVG, I_WUQ, I_WUKV, I_QNG, I_KNG, I_MLAOUT, I_DQNG, I_DKNG, I_DLAM, I_DSUBG, I_DIFFOUT, I_NQNG, I_NKNG,
       I_RPB, I_NAOUT, I_GATEW, I_GATEB, I_WO, I_RW, I_RB, I_WGU, I_BGU, I_WDN, I_BDN, N_IN };

constexpr size_t MiB = 1u << 20;
constexpr size_t al(size_t x) { return (x + 255) / 256 * 256; }
constexpr size_t WS_CTL = 0;
constexpr size_t WS_MOD = 1 * MiB;
constexpr size_t WS_ROPE = WS_MOD + al(2 * 9 * 6144 * 4);
constexpr size_t WS_ROUTE = WS_ROPE + al(4096 * 32 * 4);
constexpr size_t WS_ROWTOK = WS_ROUTE + al((size_t)T * 4 * 16);
constexpr size_t WS_HS = WS_ROWTOK + al((size_t)NE * T * 4);
constexpr size_t WS_WGUS = WS_HS + al((size_t)T * 4);
constexpr size_t WS_HS1 = WS_WGUS + al((size_t)2 * NE * 2048 * 4);
constexpr size_t WS_WINS = WS_HS1 + al((size_t)T * 4);
constexpr size_t WS_GATES = WS_WINS + al((size_t)2 * PLD * 4);
constexpr size_t WS_WIN_T = WS_GATES + al((size_t)2 * 4096 * 4);
constexpr size_t WS_QKV_T = WS_WIN_T + al((size_t)2 * PLD * D * 2);
constexpr size_t WS_WB_T = WS_QKV_T + al((size_t)2 * 1024 * 384 * 2);
constexpr size_t WS_GATE_T = WS_WB_T + al((size_t)2 * 4 * 1024 * 256 * 2);
constexpr size_t WS_WO_T = WS_GATE_T + al((size_t)2 * 4096 * D * 2);
constexpr size_t WS_WGU_T = WS_WO_T + al((size_t)2 * D * D * 2);
constexpr size_t WS_WDN_T = WS_WGU_T + al((size_t)2 * NE * 2048 * D * 2);
constexpr size_t WS_H = WS_WDN_T + al((size_t)2 * NE * D * DFF * 2);
constexpr size_t WS_H2 = WS_H + al((size_t)T * D * 2);
constexpr size_t WS_XF = WS_H2 + al((size_t)T * D * 2);
constexpr size_t WS_SCR = WS_XF + al((size_t)T * D * 4);
constexpr size_t WS_PROJ = WS_SCR;
constexpr size_t WS_CU = WS_PROJ + al((size_t)T * PLD * 2);
constexpr size_t WS_AQ = WS_CU + al((size_t)T * 256 * 2);
constexpr size_t WS_QKVRAW = WS_AQ + al((size_t)T * 384 * 2);
constexpr size_t WS_MQ = WS_QKVRAW + al((size_t)T * 1024 * 2);
constexpr size_t WS_MK = WS_MQ + al((size_t)T * 384 * 2);
constexpr size_t WS_MV = WS_MK + al((size_t)T * 384 * 2);
constexpr size_t WS_DQ = WS_MV + al((size_t)T * 256 * 2);
constexpr size_t WS_DK = WS_DQ + al((size_t)T * 256 * 2);
constexpr size_t WS_DV = WS_DK + al((size_t)T * 256 * 2);
constexpr size_t WS_NQ = WS_DV + al((size_t)T * 256 * 2);
constexpr size_t WS_NK = WS_NQ + al((size_t)T * 256 * 2);
constexpr size_t WS_NV = WS_NK + al((size_t)T * 256 * 2);
constexpr size_t WS_BI = WS_NV + al((size_t)T * 256 * 2);
constexpr size_t WS_DO = WS_BI + al((size_t)T * D * 2);
constexpr size_t WS_QBM = WS_DO + al((size_t)T * 512 * 2);
constexpr size_t WS_QBD = WS_QBM + al((size_t)T * 4 * 4);
constexpr size_t WS_QBN = WS_QBD + al((size_t)T * 8 * 4);
constexpr size_t WS_KPE = WS_QBN + al((size_t)T * 4 * 4);
constexpr size_t WS_YB = WS_KPE + al((size_t)T * 32 * 2);
constexpr size_t WS_YM = WS_YB + al((size_t)T * 4096 * 2);
constexpr size_t WS_MIX_END = WS_YM + al((size_t)T * D * 2);
constexpr size_t WS_ACT = WS_SCR;
constexpr size_t WS_YE = WS_ACT + al((size_t)MAXROWS * D * 2);
constexpr size_t WS_MOE_END = WS_YE + al((size_t)MAXROWS * D * 2);
constexpr size_t WS_END = WS_MIX_END > WS_MOE_END ? WS_MIX_END : WS_MOE_END;
static_assert(WS_END <= (size_t)2048 * MiB, "workspace budget (>= 2 GiB guaranteed)");
constexpr int CW_BIASMAX = 2048;
constexpr int CW_CNT = 1024;

struct Params {
  const float* in[N_IN];
  float* out;
  unsigned char* ws;
};
typedef const __attribute__((address_space(4))) Params& PRef;
typedef const __attribute__((address_space(4))) Params* PPtr;
__device__ __forceinline__ PPtr opq_params() { PPtr pp = (PPtr)__builtin_amdgcn_kernarg_segment_ptr(); asm volatile("" : "+s"(pp)); return pp; }
#define PP (*opq_params())

DI float bf2f(bf16 v) { return __uint_as_float(((unsigned)v) << 16); }
DI bf16 f2bf(float f) { unsigned u = __float_as_uint(f); u += 0x7fffu + ((u >> 16) & 1u); return (bf16)(u >> 16); }
DI float sigmoidf_(float x) { return 1.f / (1.f + __expf(-x)); }
DI float wave_sum_l(float v, int lane) {
#pragma unroll
  for (int o = 1; o < 64; o <<= 1) v += __int_as_float(__builtin_amdgcn_ds_bpermute((lane ^ o) << 2, __float_as_int(v)));
  return v;
}
#define wave_sum(v) wave_sum_l((v), lane)
DI unsigned cvt_pk_bf16_(float lo, float hi) { unsigned r; asm volatile("v_cvt_pk_bf16_f32 %0, %1, %2" : "=v"(r) : "v"(lo), "v"(hi)); return r; }
DI float seg_sum(float v, int lane, int width) {
#pragma unroll
  for (int o = 1; o < 64; o <<= 1) if (o < width) v += __int_as_float(__builtin_amdgcn_ds_bpermute((lane ^ o) << 2, __float_as_int(v)));
  return v;
}
DI float lane_xor(float v, int lane, int o) { return __int_as_float(__builtin_amdgcn_ds_bpermute((lane ^ o) << 2, __float_as_int(v))); }

DI void quant_row_i8(const float (&v)[16], signed char* dst, float* scale_out, int lane) {
  float mx = 0.f;
#pragma unroll
  for (int i = 0; i < 16; ++i) mx = fmaxf(mx, fabsf(v[i]));
#pragma unroll
  for (int o = 1; o < 64; o <<= 1) mx = fmaxf(mx, lane_xor(mx, lane, o));
  const float sc = mx > 0.f ? mx * (1.f / 127.f) : 1.f, inv = 1.f / sc; if (lane == 0) *scale_out = sc;
#pragma unroll
  for (int j = 0; j < 4; ++j) { unsigned b = 0;
#pragma unroll
    for (int i = 0; i < 4; ++i) b |= ((unsigned)(int)rintf(v[4 * j + i] * inv) & 255u) << (8 * i);
    *(unsigned*)(dst + j * 256 + lane * 4) = b; }
}
DI void ld4(const bf16* p, float (&x)[4]) { const uint2 u = *(const uint2*)p; x[0] = __uint_as_float(u.x << 16); x[1] = __uint_as_float(u.x & 0xffff0000u); x[2] = __uint_as_float(u.y << 16); x[3] = __uint_as_float(u.y & 0xffff0000u); }
DI void st4(bf16* p, const float (&x)[4]) { uint2 u; u.x = cvt_pk_bf16_(x[0], x[1]); u.y = cvt_pk_bf16_(x[2], x[3]); *(uint2*)p = u; }

DI int opq_bid() { int b = blockIdx.x; asm volatile("" : "+s"(b)); return b; }
DI int opq_nblk() { int g = gridDim.x; asm volatile("" : "+s"(g)); return g; }
DI int opq_tid() { int t = threadIdx.x; asm volatile("" : "+v"(t)); return t; }
#define GTID ((int)(bid_ * 512 + tid_))
#define NTHR ((int)(nblk_ * 512))
#define SUB ((int)(tid_ >> 8))
#define T256 ((int)(tid_ & 255))
DI int modidx(int r) { return r < TL ? (r >> 12) : NB; }


DI const float* stream_row(PRef p, int l, int r, bool after_mixer) {
  if (l == 0 && !after_mixer) return r < TL ? p.in[I_X] + (size_t)r * D : p.in[I_CTX] + (size_t)(r - TL) * D;
  return (const float*)(p.ws + WS_XF) + (size_t)r * D;
}
DI void ph_mod1(PRef p, int l) {
  const int tid_ = opq_tid(); const int bid_ = opq_bid(), nblk_ = opq_nblk(); (void)bid_; (void)nblk_;
  const int lane = tid_ & 63, gw = GTID >> 6, ngw = NTHR >> 6;
  const float* MOD = (const float*)(p.ws + WS_MOD);
  bf16* H = (bf16*)(p.ws + WS_H);
  const float* g = p.in[I_N1G] + l * D;
  for (int r = gw; r < T; r += ngw) {
    const float* x = stream_row(p, l, r, false);
    float v[16]; float ss = 0.f;
#pragma unroll
    for (int j = 0; j < 4; ++j) { const float4 t = *(const float4*)(x + j * 256 + lane * 4); v[4 * j] = t.x; v[4 * j + 1] = t.y; v[4 * j + 2] = t.z; v[4 * j + 3] = t.w; ss += t.x * t.x + t.y * t.y + t.z * t.z + t.w * t.w; }
    ss = wave_sum(ss);
    const float rstd = rsqrtf(ss * (1.f / D) + EPS);
    const float* md = MOD + ((size_t)l * 9 + modidx(r)) * 6144;
#pragma unroll
    for (int j = 0; j < 4; ++j)
#pragma unroll
      for (int i = 0; i < 4; ++i) { const int c = j * 256 + lane * 4 + i; v[4 * j + i] = v[4 * j + i] * rstd * g[c] * (1.f + md[1024 + c]) + md[c]; }
    quant_row_i8(v, (signed char*)H + (size_t)r * D, (float*)(p.ws + WS_HS1) + r, lane);
  }
}

struct RowId { DI int operator()(int m) const { return m; } };
struct RowGather { const int* idx; DI int operator()(int m) const { return idx[m]; } };
#define ZERO_ACC(acc) do { _Pragma("unroll") for (int i_ = 0; i_ < 4; ++i_) _Pragma("unroll") for (int j_ = 0; j_ < 4; ++j_) acc[i_][j_] = 0.f; } while (0)


DI void ph_conv(PRef p, int l, int nrows, unsigned char* lds) {
  const int tid_ = opq_tid(); const int bid_ = opq_bid(), nblk_ = opq_nblk(); (void)bid_; (void)nblk_;
  const int lane = tid_ & 63, gw = GTID >> 6, ngw = NTHR >> 6;
  const bf16* __restrict__ CU = (const bf16*)(p.ws + WS_CU); bf16* __restrict__ BI = (bf16*)(p.ws + WS_BI);
  const float* cw = p.in[I_CONVW] + l * 31 * 256; const float* cb = p.in[I_CONVB] + l * 256;
  float4* wl = (float4*)lds;
  for (int k = tid_; k < 31 * 64; k += 512) wl[k] = *(const float4*)(cw + 4 * k);
  __syncthreads();
  const float4 bias = *(const float4*)(cb + lane * 4), lg = *(const float4*)(p.in[I_CLNG] + l * 256 + lane * 4), lb = *(const float4*)(p.in[I_CLNB] + l * 256 + lane * 4);
  for (int r = gw; r < nrows; r += ngw) {
    int lo, hi; if (r < TL) { lo = r & ~(SEQ - 1); hi = lo + SEQ; } else { lo = TL + ((r - TL) & ~(CTX - 1)); hi = lo + CTX; }
    const bf16* up = CU + (long)(r - 15) * 256 + lane * 4; asm volatile("" : "+v"(up));
    uint2 u[31];
#pragma unroll
    for (int j = 0; j < 31; ++j) { const int rr = r + j - 15; u[j] = make_uint2(0u, 0u); if (rr >= lo && rr < hi) u[j] = *(const uint2*)(up + j * 256); }
    float a[4] = {bias.x, bias.y, bias.z, bias.w};
#pragma unroll
    for (int j = 0; j < 31; ++j) { const float4 w = wl[j * 64 + lane];
      a[0] += __uint_as_float(u[j].x << 16) * w.x; a[1] += __uint_as_float(u[j].x & 0xffff0000u) * w.y; a[2] += __uint_as_float(u[j].y << 16) * w.z; a[3] += __uint_as_float(u[j].y & 0xffff0000u) * w.w; }
    const float mu = seg_sum(a[0] + a[1] + a[2] + a[3], lane, 64) * (1.f / 256.f);
    float q2 = 0.f;
#pragma unroll
    for (int c = 0; c < 4; ++c) { a[c] -= mu; q2 += a[c] * a[c]; }
    const float rs = rsqrtf(seg_sum(q2, lane, 64) * (1.f / 256.f) + EPS);
    float y[4] = {a[0] * rs * lg.x + lb.x, a[1] * rs * lg.y + lb.y, a[2] * rs * lg.z + lb.z, a[3] * rs * lg.w + lb.w};
#pragma unroll
    for (int c = 0; c < 4; ++c) y[c] = y[c] * sigmoidf_(y[c]);
    st4(BI + (size_t)r * D + lane * 4, y);
  }
  __syncthreads();
}


DI void expert_offsets(const unsigned* cnt, int* off  ) { int a = 0; for (int e = 0; e < NE; ++e) { off[e] = a; a += ((int)cnt[e] + 255) & ~255; } off[NE] = a; }
DI void ph_combine(PRef p, int l, int nrows, unsigned char* lds) {
  const int tid_ = opq_tid(); const int bid_ = opq_bid(), nblk_ = opq_nblk();
  int* off = (int*)(lds + 32768);
  const unsigned* cnt = (const unsigned*)(p.ws + WS_CTL) + CW_CNT + l * 64;
  if (tid_ == 0) expert_offsets(cnt, off);
  __syncthreads();
  const int lane = tid_ & 63, gw = GTID >> 6, ngw = NTHR >> 6;
  const float* MOD = (const float*)(p.ws + WS_MOD); float* XF = (float*)(p.ws + WS_XF); const bf16* YE = (const bf16*)(p.ws + WS_YE); const int* ROUTE = (const int*)(p.ws + WS_ROUTE);
  bf16* H = (bf16*)(p.ws + WS_H); const float* g1n = p.in[I_N1G] + D;
  int4 rc0, rc1, rc2, rc3;
  { const int r = min(gw, nrows - 1); const int4* rp = (const int4*)(ROUTE + (size_t)r * 16); rc0 = rp[0]; rc1 = rp[1]; rc2 = rp[2]; rc3 = rp[3]; }
  for (int r = gw; r < nrows; r += ngw) {
    int4 rn0, rn1, rn2, rn3;
    { const int rn = min(r + ngw, nrows - 1); const int4* rp = (const int4*)(ROUTE + (size_t)rn * 16); rn0 = rp[0]; rn1 = rp[1]; rn2 = rp[2]; rn3 = rp[3]; }
    const float* md = MOD + ((size_t)l * 9 + modidx(r)) * 6144 + 5 * 1024;
    float* dst = (l == 1) ? p.out + (size_t)r * D : XF + (size_t)r * D;
    const float* xs = XF + (size_t)r * D;
    float acc[16];
#pragma unroll
    for (int i = 0; i < 16; ++i) acc[i] = 0.f;
    const int4 rts[4] = {rc0, rc1, rc2, rc3};
    rc0 = rn0; rc1 = rn1; rc2 = rn2; rc3 = rn3;
#pragma unroll
    for (int k = 0; k < 4; ++k) { const int4 rt4 = rts[k]; const int rt[3] = {rt4.x, rt4.y, rt4.z}; const float w = __int_as_float(rt[2]); const bf16* y = YE + (size_t)(off[rt[0]] + rt[1]) * D;
#pragma unroll
      for (int j = 0; j < 4; ++j) { const uint2 u = *(const uint2*)(y + j * 256 + lane * 4);
        acc[4 * j] += w * __uint_as_float(u.x << 16); acc[4 * j + 1] += w * __uint_as_float(u.x & 0xffff0000u); acc[4 * j + 2] += w * __uint_as_float(u.y << 16); acc[4 * j + 3] += w * __uint_as_float(u.y & 0xffff0000u); } }
    float ss = 0.f;
#pragma unroll
    for (int j = 0; j < 4; ++j) { const int c = j * 256 + lane * 4; const float4 x4 = *(const float4*)(xs + c), m4 = *(const float4*)(md + c);
      acc[4 * j] = x4.x + m4.x * acc[4 * j]; acc[4 * j + 1] = x4.y + m4.y * acc[4 * j + 1]; acc[4 * j + 2] = x4.z + m4.z * acc[4 * j + 2]; acc[4 * j + 3] = x4.w + m4.w * acc[4 * j + 3];
      *(float4*)(dst + c) = make_float4(acc[4 * j], acc[4 * j + 1], acc[4 * j + 2], acc[4 * j + 3]);
      ss += acc[4 * j] * acc[4 * j] + acc[4 * j + 1] * acc[4 * j + 1] + acc[4 * j + 2] * acc[4 * j + 2] + acc[4 * j + 3] * acc[4 * j + 3]; }
    if (l == 0) {
      ss = seg_sum(ss, lane, 64); const float rstd = rsqrtf(ss * (1.f / D) + EPS);
      const float* m1 = MOD + ((size_t)9 + modidx(r)) * 6144;
#pragma unroll
      for (int j = 0; j < 4; ++j) { const int c = j * 256 + lane * 4; const float4 gg = *(const float4*)(g1n + c), s4 = *(const float4*)(m1 + 1024 + c), h4 = *(const float4*)(m1 + c);
        acc[4 * j] = acc[4 * j] * rstd * gg.x * (1.f + s4.x) + h4.x; acc[4 * j + 1] = acc[4 * j + 1] * rstd * gg.y * (1.f + s4.y) + h4.y; acc[4 * j + 2] = acc[4 * j + 2] * rstd * gg.z * (1.f + s4.z) + h4.z; acc[4 * j + 3] = acc[4 * j + 3] * rstd * gg.w * (1.f + s4.w) + h4.w; }
      quant_row_i8(acc, (signed char*)H + (size_t)r * D, (float*)(p.ws + WS_HS1) + r, lane);
    }
  }
}

namespace pg8 {
#define PG8_LAS __attribute__((address_space(3)))
typedef unsigned short bf16_t;
typedef short bf16x8 __attribute__((ext_vector_type(8)));
typedef float f32x4 __attribute__((ext_vector_type(4)));
typedef unsigned u32x4 __attribute__((ext_vector_type(4)));
typedef unsigned u32x2 __attribute__((ext_vector_type(2)));
typedef int i32x4v __attribute__((ext_vector_type(4)));
constexpr int BM = 256, BK = 64, HALF = 128, HTB = HALF * BK * 2, STAGE_BYTES = 8 * HTB;
__host__ __device__ __forceinline__ int lds_byte(int r, int c) { const int st = (r >> 4) * 2 + (c >> 5), rr = r & 15, cc = c & 31, ob = rr * 64 + cc * 2; return st * 1024 + (ob ^ (((ob >> 9) & 1) << 5)); }
__host__ __device__ __forceinline__ void stage_rc(int b, int& R, int& C) { const int st = b / 1024, sb = b % 1024, swz = sb ^ (((sb >> 9) & 1) << 5); R = (st >> 1) * 16 + swz / 64; C = (st & 1) * 32 + (swz % 64) / 2; }
__host__ __device__ __forceinline__ int perm32(int rho) { const int n = rho >> 4, i = rho & 15; return 8 * (i >> 2) + 4 * n + (i & 3); }
__device__ __forceinline__ unsigned cvt_pk_bf16(float lo, float hi) { unsigned r; asm volatile("v_cvt_pk_bf16_f32 %0, %1, %2" : "=v"(r) : "v"(lo), "v"(hi)); return r; }

struct Unit { int pm, pn, aux, nvalid; const char* A; const char* B; const int* rows; };

template <class Epi, class Sched, bool GATHER, bool I8 = false>
__device__ __forceinline__ void gemm_phase(PG8_LAS unsigned char* lds, const int lda_, const int K_, const Sched& S, const Epi& E) {
    const int lda = I8 ? lda_ / 2 : lda_, K = I8 ? K_ / 2 : K_;
    const int tid = opq_tid(), wid = __builtin_amdgcn_readfirstlane(tid >> 6), lane = tid & 63, wr = wid >> 2, wc = wid & 3, fr = lane & 15, fq = lane >> 4;
    const int nt = K / BK;
    unsigned voffA[2], voffB[2];
#pragma unroll
    for (int i = 0; i < 2; ++i) { int R, C; stage_rc(tid * 16 + i * 8192, R, C); const int Rb = Epi::PERM ? ((R & ~31) + perm32(R & 31)) : R;
        voffA[i] = GATHER ? (unsigned)(R * 65536 + C * 2) : (unsigned)(R * lda + C) * 2u; voffB[i] = (unsigned)(Rb * K + C) * 2u; }
    const size_t kstep = (size_t)(BK * 2);
    const size_t hstepA = GATHER ? 0 : (size_t)HALF * lda * 2, hstepB = (size_t)HALF * K * 2;
    const unsigned ldsw = (unsigned)wid * 1024u;
    const int aoff = lds_byte(wr * 64 + fr, fq * 8), boff = lds_byte(wc * 32 + fr, fq * 8);
#define PG8_SA(b, h) (((b) * 2 + (h)) * HTB)
#define PG8_SB(b, h) ((4 + (b) * 2 + (h)) * HTB)
#define PG8_STAGE(bufoff, gbase, voff) do { _Pragma("unroll") for (int _i = 0; _i < 2; ++_i) \
        __builtin_amdgcn_global_load_lds((const unsigned*)((const char*)(gbase) + (voff)[_i]), (PG8_LAS unsigned*)(lds + (bufoff) + ldsw + _i * 8192), 16, 0, 0); } while (0)
#define PG8_LDA(dst, b, h) do { _Pragma("unroll") for (int m = 0; m < 4; ++m) _Pragma("unroll") for (int k = 0; k < 2; ++k) dst[m][k] = *(const PG8_LAS bf16x8*)(lds + PG8_SA(b, h) + aoff + m * 2048 + k * 1024); } while (0)
#define PG8_LDB(dst, b, h) do { _Pragma("unroll") for (int n = 0; n < 2; ++n) _Pragma("unroll") for (int k = 0; k < 2; ++k) dst[n][k] = *(const PG8_LAS bf16x8*)(lds + PG8_SB(b, h) + boff + n * 2048 + k * 1024); } while (0)
#define PG8_MMA(ai, bj, At, Bt) do { __builtin_amdgcn_s_setprio(1); _Pragma("unroll") for (int m = 0; m < 4; ++m) _Pragma("unroll") for (int n = 0; n < 2; ++n) _Pragma("unroll") for (int k = 0; k < 2; ++k) { \
        if constexpr (I8) acc[ai][bj][m][n] = __builtin_bit_cast(f32x4, __builtin_amdgcn_mfma_i32_16x16x64_i8(__builtin_bit_cast(i32x4v, Bt[n][k]), __builtin_bit_cast(i32x4v, At[m][k]), __builtin_bit_cast(i32x4v, acc[ai][bj][m][n]), 0, 0, 0)); \
        else acc[ai][bj][m][n] = __builtin_amdgcn_mfma_f32_16x16x32_bf16(Bt[n][k], At[m][k], acc[ai][bj][m][n], 0, 0, 0); } __builtin_amdgcn_s_setprio(0); } while (0)
#define PG8_WAIT_V(n) asm volatile("s_waitcnt vmcnt(" #n ")" ::: "memory")
#define PG8_WAIT_L(n) asm volatile("s_waitcnt lgkmcnt(" #n ")" ::: "memory")
#define PG8_BAR __builtin_amdgcn_s_barrier()
#define PG8_SCHED __builtin_amdgcn_sched_barrier(0)
#define PG8_LOADROWS(dst, u) do { _Pragma("unroll") for (int h_ = 0; h_ < 2; ++h_) _Pragma("unroll") for (int i_ = 0; i_ < 2; ++i_) \
        { const int ri_ = h_ * HALF + (int)(voffA[i_] >> 16); dst[h_][i_] = (unsigned)(ri_ < (u).nvalid ? (u).rows[ri_] : 0) * (unsigned)(lda * 2) + (voffA[i_] & 0xffffu); } } while (0)
#define PG8_STAGE_A(bufoff, gbase, h, NEXT) do { if constexpr (GATHER) { PG8_STAGE(bufoff, gbase, ((NEXT) ? vn[h] : vc[h])); } else { PG8_STAGE(bufoff, (gbase) + (h) * hstepA, voffA); } } while (0)
    Unit cur, nxt; int ui = 0;
    if (!S.next(0, cur)) return;
    f32x4 acc[2][2][4][2];
#pragma unroll
    for (int a = 0; a < 2; ++a)
#pragma unroll
        for (int b = 0; b < 2; ++b)
#pragma unroll
            for (int m = 0; m < 4; ++m)
#pragma unroll
                for (int n = 0; n < 2; ++n) acc[a][b][m][n] = (f32x4){0.f, 0.f, 0.f, 0.f};
    bf16x8 At[4][2], B0[2][2], B1[2][2];
    unsigned vc[2][2], vn[2][2];
    if constexpr (GATHER) { PG8_LOADROWS(vc, cur);
#pragma unroll
        for (int h = 0; h < 2; ++h) { vn[h][0] = vc[h][0]; vn[h][1] = vc[h][1]; } }
    const char* cA = cur.A; const char* cB = cur.B;
    PG8_STAGE(PG8_SB(0, 0), cB, voffB); PG8_STAGE(PG8_SB(0, 1), cB + hstepB, voffB); PG8_STAGE_A(PG8_SA(0, 0), cA, 0, false); PG8_STAGE_A(PG8_SA(0, 1), cA, 1, false);
    if (wr == 1) PG8_BAR;
    PG8_WAIT_V(2); PG8_BAR;
    PG8_STAGE(PG8_SB(1, 0), cB + kstep, voffB); PG8_STAGE_A(PG8_SA(1, 0), cA + kstep, 0, false); PG8_STAGE(PG8_SB(1, 1), cB + hstepB + kstep, voffB);
    PG8_WAIT_V(6); PG8_BAR;
    for (;;) {
        const bool has_next = S.next(ui + 1, nxt);
        const char* nA = has_next ? nxt.A : cA; const char* nB = has_next ? nxt.B : cB;
        if constexpr (GATHER) { if (has_next) { PG8_LOADROWS(vn, nxt); } }
#pragma unroll 1
        for (int t = 0; t < nt; t += 2) {
            const bool last = (t == nt - 2);
            const char* a1 = cA + (size_t)(t + 1) * kstep;
            const char* a2 = last ? nA : cA + (size_t)(t + 2) * kstep; const char* b2 = last ? nB : cB + (size_t)(t + 2) * kstep;
            const char* a3 = a2 + kstep; const char* b3 = b2 + kstep;
            PG8_LDB(B0, 0, 0); PG8_LDB(B1, 0, 1); PG8_SCHED; PG8_LDA(At, 0, 0); PG8_STAGE_A(PG8_SA(1, 1), a1, 1, false);
            PG8_WAIT_V(8); PG8_WAIT_L(0); PG8_BAR; PG8_MMA(0, 0, At, B0); PG8_MMA(0, 1, At, B1); PG8_BAR; PG8_SCHED;
            PG8_LDA(At, 0, 1); PG8_STAGE(PG8_SB(0, 0), b2, voffB); PG8_STAGE(PG8_SB(0, 1), b2 + hstepB, voffB); PG8_STAGE_A(PG8_SA(0, 0), a2, 0, last);
            PG8_WAIT_V(8); PG8_WAIT_L(0); PG8_BAR; PG8_MMA(1, 0, At, B0); PG8_MMA(1, 1, At, B1); PG8_BAR; PG8_SCHED;
            PG8_LDB(B0, 1, 0); PG8_LDB(B1, 1, 1); PG8_SCHED; PG8_LDA(At, 1, 0); PG8_STAGE_A(PG8_SA(0, 1), a2, 1, last);
            PG8_WAIT_V(8); PG8_WAIT_L(0); PG8_BAR; PG8_MMA(0, 0, At, B0); PG8_MMA(0, 1, At, B1); PG8_BAR; PG8_SCHED;
            PG8_LDA(At, 1, 1); PG8_STAGE(PG8_SB(1, 0), b3, voffB); PG8_STAGE(PG8_SB(1, 1), b3 + hstepB, voffB); PG8_STAGE_A(PG8_SA(1, 0), a3, 0, last);
            PG8_WAIT_V(8); PG8_WAIT_L(0); PG8_BAR; PG8_MMA(1, 0, At, B0); PG8_MMA(1, 1, At, B1); PG8_BAR; PG8_SCHED;
        }
        if (wr == 0) PG8_BAR;
        { const int l2 = opq_tid() & 63; E(acc, cur, wr, wc, l2 & 15, l2 >> 4); }
        if (!has_next) break;
#pragma unroll
        for (int a = 0; a < 2; ++a)
#pragma unroll
            for (int b = 0; b < 2; ++b)
#pragma unroll
                for (int m = 0; m < 4; ++m)
#pragma unroll
                    for (int n = 0; n < 2; ++n) acc[a][b][m][n] = (f32x4){0.f, 0.f, 0.f, 0.f};
        cur = nxt; cA = nA; cB = nB; ++ui;
        if constexpr (GATHER) {
#pragma unroll
            for (int h = 0; h < 2; ++h) { vc[h][0] = vn[h][0]; vc[h][1] = vn[h][1]; } }
        if (wr == 1) PG8_BAR;
    }
    PG8_WAIT_V(0);
    PG8_BAR;
#undef PG8_STAGE_A
#undef PG8_SA
#undef PG8_SB
#undef PG8_STAGE
#undef PG8_LDA
#undef PG8_LDB
#undef PG8_MMA
#undef PG8_WAIT_V
#undef PG8_WAIT_L
#undef PG8_BAR
#undef PG8_SCHED
#undef PG8_LOADROWS
}
}

struct SchedDense {
    const char* A; const char* Bt; int nM, nN, G, c; size_t tstepA, tstepB; bool rev = false;
    DI void init(const void* A_, int lda, const void* Bt_, int K, int M, int N, int G_, int c_) { A = (const char*)A_; Bt = (const char*)Bt_; nM = M / 256; nN = N / 256; G = G_; c = c_; tstepA = (size_t)256 * lda * 2; tstepB = (size_t)256 * K * 2; }
    DI bool next(int i, pg8::Unit& u) const {
        const int L = i * G + c; if (L >= nM * nN) return false;
        const int nig = 8 * nN, gid = L / nig, fm = gid * 8, gsz = (nM - fm) < 8 ? (nM - fm) : 8, w = L - gid * nig;
        u.pm = fm + (w % gsz); if (rev) u.pm = nM - 1 - u.pm; u.pn = w / gsz; u.aux = 0; u.nvalid = 256; u.A = A + (size_t)u.pm * tstepA; u.B = Bt + (size_t)u.pn * tstepB; u.rows = nullptr; return true; }
};
struct SchedBranch {
    const char* A; const char* Bt; int nM, G, c;
    DI void init(const void* A_, const void* Bt_, int M, int G_, int c_) { A = (const char*)A_; Bt = (const char*)Bt_; nM = M / 256; G = G_; c = c_; }
    DI bool next(int i, pg8::Unit& u) const {
        const int L = i * G + c; if (L >= nM * 16) return false;
        u.pm = L >> 4; const int b = (L >> 2) & 3; u.pn = L & 3; u.aux = b; u.nvalid = 256;
        u.A = A + (size_t)u.pm * 256 * (D * 2) + b * 512; u.B = Bt + ((size_t)b * 1024 + u.pn * 256) * 512; u.rows = nullptr; return true; }
};
struct SchedMoe {
    bool rev = false; const char* A; const char* Bt; const int* rowtok; const int* off; const int* cnt; int nN, G, c, ntiles; size_t tstepA, estepB, tstepB; bool gather;
    DI bool next(int i, pg8::Unit& u) const {
        int rt, pn;
        if (G == 256) {
            const int v = i * 32 + (c >> 3), rl = v / nN; pn = v - rl * nN; rt = rl * 8 + (c & 7); if (rt >= ntiles) return false; }
        else { const int L = i * G + c; if (L >= ntiles * nN) return false; rt = L / nN; pn = L - rt * nN; }
        if (rev) rt = ntiles - 1 - rt;
        u.pm = rt; u.pn = pn; const int r0 = rt * 256; int e = 0;
#pragma unroll 1
        for (int k = 1; k < NE; ++k) e += (off[k] <= r0) ? 1 : 0;
        u.aux = e; u.A = gather ? A : A + (size_t)rt * tstepA; u.B = Bt + (size_t)e * estepB + (size_t)u.pn * tstepB;
        const int rin = r0 - off[e]; u.rows = rowtok + (size_t)e * T + rin; u.nvalid = cnt[e] - rin; return true; }
};

struct EpiStoreBf16 {
    static constexpr bool PERM = true;
    bf16* O; int ldc; int auxstride; const float* bias; int biasstride;
    DI void operator()(const pg8::f32x4 (&acc)[2][2][4][2], const pg8::Unit& u, int wr, int wc, int fr, int fq) const {
        const int row0 = u.pm * 256 + wr * 64 + fr, col0 = u.aux * auxstride + u.pn * 256 + wc * 32 + 8 * fq, bcol0 = u.pn * 256 + wc * 32 + 8 * fq;
        pg8::f32x4 bv[2][2];
#pragma unroll
        for (int bj = 0; bj < 2; ++bj)
#pragma unroll
            for (int n = 0; n < 2; ++n) bv[bj][n] = bias ? *(const pg8::f32x4*)(bias + (size_t)u.aux * biasstride + bcol0 + bj * 128 + 4 * n) : (pg8::f32x4){0.f, 0.f, 0.f, 0.f};
#pragma unroll
        for (int ai = 0; ai < 2; ++ai)
#pragma unroll
            for (int m = 0; m < 4; ++m) { bf16* rowp = O + (size_t)(row0 + ai * 128 + m * 16) * ldc + col0;
#pragma unroll
                for (int bj = 0; bj < 2; ++bj) { const pg8::f32x4 v0 = acc[ai][bj][m][0] + bv[bj][0], v1 = acc[ai][bj][m][1] + bv[bj][1];
                    pg8::u32x4 w; w.x = pg8::cvt_pk_bf16(v0[0], v0[1]); w.y = pg8::cvt_pk_bf16(v0[2], v0[3]); w.z = pg8::cvt_pk_bf16(v1[0], v1[1]); w.w = pg8::cvt_pk_bf16(v1[2], v1[3]);
                    *(pg8::u32x4*)(rowp + bj * 128) = w; } }
    }
};
DI float sigm_fast(float x) { return __builtin_amdgcn_rcpf(1.f + __builtin_amdgcn_exp2f(-LOG2E * x)); }
struct EpiMerge {
    static constexpr bool PERM = false;
    const bf16* YB; bf16* YM; const float* gb; const float* HS1; const float* GATES;
    DI void operator()(const pg8::f32x4 (&acc)[2][2][4][2], const pg8::Unit& u, int wr, int wc, int fr, int fq) const {
        const int row0 = u.pm * 256 + wr * 64 + fr, col = u.pn * 64 + wc * 16 + fq * 4;
        pg8::f32x4 bv[2][2];
#pragma unroll
        for (int bj = 0; bj < 2; ++bj)
#pragma unroll
            for (int n = 0; n < 2; ++n) bv[bj][n] = *(const pg8::f32x4*)(gb + (2 * bj + n) * 1024 + col);
#pragma unroll
        for (int ai = 0; ai < 2; ++ai)
#pragma unroll
            for (int m = 0; m < 4; ++m) { const size_t r = (size_t)(row0 + ai * 128 + m * 16); const float sa = HS1[r]; pg8::f32x4 y = (pg8::f32x4){0.f, 0.f, 0.f, 0.f};
#pragma unroll
                for (int bj = 0; bj < 2; ++bj)
#pragma unroll
                    for (int n = 0; n < 2; ++n) { const pg8::u32x2 yb = *(const pg8::u32x2*)(YB + r * 4096 + (2 * bj + n) * 1024 + col); const pg8::i32x4v iv = __builtin_bit_cast(pg8::i32x4v, acc[ai][bj][m][n]);
                        const pg8::f32x4 cs = *(const pg8::f32x4*)(GATES + u.pn * 256 + 128 * bj + 32 * wc + 16 * n + 4 * fq);
                        const pg8::f32x4 g = (pg8::f32x4){(float)iv[0] * sa * cs[0], (float)iv[1] * sa * cs[1], (float)iv[2] * sa * cs[2], (float)iv[3] * sa * cs[3]} + bv[bj][n];
                        y[0] += sigm_fast(g[0]) * __uint_as_float(yb.x << 16); y[1] += sigm_fast(g[1]) * __uint_as_float(yb.x & 0xffff0000u);
                        y[2] += sigm_fast(g[2]) * __uint_as_float(yb.y << 16); y[3] += sigm_fast(g[3]) * __uint_as_float(yb.y & 0xffff0000u); }
                pg8::u32x2 w; w.x = pg8::cvt_pk_bf16(y[0], y[1]); w.y = pg8::cvt_pk_bf16(y[2], y[3]); *(pg8::u32x2*)(YM + r * 1024 + col) = w; }
    }
};
struct EpiWo {
    static constexpr bool PERM = false;
    const float* xlat; const float* xctx; float* XF; const float* modg;
    DI void operator()(const pg8::f32x4 (&acc)[2][2][4][2], const pg8::Unit& u, int wr, int wc, int fr, int fq) const {
        const int row0 = u.pm * 256 + wr * 64 + fr, col0 = u.pn * 256 + wc * 32 + 4 * fq;
        const float* g = modg + (size_t)modidx(u.pm * 256) * 6144 + col0;
        pg8::f32x4 gv[2][2];
#pragma unroll
        for (int bj = 0; bj < 2; ++bj)
#pragma unroll
            for (int n = 0; n < 2; ++n) gv[bj][n] = *(const pg8::f32x4*)(g + bj * 128 + n * 16);
#pragma unroll
        for (int ai = 0; ai < 2; ++ai)
#pragma unroll
            for (int mp = 0; mp < 2; ++mp) { pg8::f32x4 t[2][2][2];
#pragma unroll
                for (int mm = 0; mm < 2; ++mm) { const int r = row0 + ai * 128 + (2 * mp + mm) * 16; const float* xs = (r < TL ? xlat + (size_t)r * D : xctx + (size_t)(r - TL) * D) + col0;
#pragma unroll
                    for (int bj = 0; bj < 2; ++bj)
#pragma unroll
                        for (int n = 0; n < 2; ++n) t[mm][bj][n] = *(const pg8::f32x4*)(xs + bj * 128 + n * 16); }
#pragma unroll
                for (int mm = 0; mm < 2; ++mm) { const int m = 2 * mp + mm; const int r = row0 + ai * 128 + m * 16; float* xo = XF + (size_t)r * D + col0;
#pragma unroll
                    for (int bj = 0; bj < 2; ++bj)
#pragma unroll
                        for (int n = 0; n < 2; ++n) *(pg8::f32x4*)(xo + bj * 128 + n * 16) = t[mm][bj][n] + gv[bj][n] * acc[ai][bj][m][n]; } }
    }
};
struct EpiProjFused {
    static constexpr bool PERM = true;
    bf16 *CU, *AQ, *DQ, *DK, *DV, *NQ, *NK, *NV, *KPE; float *QBD, *QBN; const float* ROPE;
    const float *cqg, *ckvg, *dqg, *dkg, *nqg, *nkg;
    float kbd, kbn, nbias; float* P;
    const float* HS1; const float* WINS;
    DI static float red4(float v, int lane) { v += lane_xor(v, lane, 16); v += lane_xor(v, lane, 32); return v; }
    DI static void st8(bf16* dst, const float (&x)[8]) { pg8::u32x4 w; w.x = pg8::cvt_pk_bf16(x[0], x[1]); w.y = pg8::cvt_pk_bf16(x[2], x[3]); w.z = pg8::cvt_pk_bf16(x[4], x[5]); w.w = pg8::cvt_pk_bf16(x[6], x[7]); *(pg8::u32x4*)dst = w; }
    DI void operator()(const pg8::f32x4 (&acc)[2][2][4][2], const pg8::Unit& u, int wr, int wc, int fr, int fq) const {
        const int t = u.pn, lane = fr + 16 * fq, row0 = u.pm * 256 + wr * 64 + fr; const bool lat = u.pm < TL / 256;
        const float* sap = HS1 + row0; const float* sbp = WINS + 256 * t + 32 * wc + 8 * fq; asm volatile("" : "+v"(sap), "+v"(sbp));
#define GET8(ai, bj, m, x) do { const float sa_ = sap[(ai) * 128 + (m) * 16]; _Pragma("unroll") for (int n_ = 0; n_ < 2; ++n_) { const pg8::i32x4v iv_ = __builtin_bit_cast(pg8::i32x4v, acc[ai][bj][m][n_]); \
        const pg8::f32x4 sb_ = *(const pg8::f32x4*)(sbp + 128 * (bj) + 4 * n_); _Pragma("unroll") for (int j_ = 0; j_ < 4; ++j_) x[4 * n_ + j_] = (float)iv_[j_] * sa_ * sb_[j_]; } } while (0)
        if (t < 2) {
#pragma unroll
            for (int ai = 0; ai < 2; ++ai)
#pragma unroll
                for (int m = 0; m < 4; ++m) { float a[8], g[8], o[8]; GET8(ai, 0, m, a); GET8(ai, 1, m, g);
#pragma unroll
                    for (int i = 0; i < 8; ++i) o[i] = a[i] * sigm_fast(g[i]);
                    st8(CU + (size_t)(row0 + ai * 128 + m * 16) * 256 + 128 * t + 32 * wc + 8 * fq, o); }
        } else if (t < 5) {
#pragma unroll
            for (int bj = 0; bj < 2; ++bj) { const int ds = (t - 2) * 8 + bj * 4 + wc, head = ds / 6, kind = ds - head * 6;
                const bool isq = kind < 2, isv = kind >= 4; const float* gp = (isq ? dqg : dkg) + 8 * fq; float gg[8];
#pragma unroll
                for (int i = 0; i < 8; ++i) gg[i] = gp[i];
#pragma unroll
                for (int ai = 0; ai < 2; ++ai)
#pragma unroll
                    for (int m = 0; m < 4; ++m) { const int r = row0 + ai * 128 + m * 16; float x[8]; GET8(ai, bj, m, x);
                        if (isv) { st8(DV + (size_t)r * 256 + head * 64 + (kind - 4) * 32 + 8 * fq, x); continue; }
                        float ss = 0.f;
#pragma unroll
                        for (int i = 0; i < 8; ++i) ss += x[i] * x[i];
                        const float rs = rsqrtf(red4(ss, lane) * (1.f / 32.f) + EPS);
#pragma unroll
                        for (int i = 0; i < 8; ++i) x[i] = x[i] * rs * gg[i];
                        float pt[8];
#pragma unroll
                        for (int i = 0; i < 8; ++i) pt[i] = lane_xor(x[i], lane, 32);
                        if (lat) { const float* rp = ROPE + (size_t)(r & (SEQ - 1)) * 32 + 8 * (fq & 1); const bool first = fq < 2;
                            const pg8::f32x4 c0 = *(const pg8::f32x4*)rp, c1 = *(const pg8::f32x4*)(rp + 4), s0 = *(const pg8::f32x4*)(rp + 16), s1 = *(const pg8::f32x4*)(rp + 20);
#pragma unroll
                            for (int i = 0; i < 8; ++i) { const float cs = i < 4 ? c0[i & 3] : c1[i & 3], sn = i < 4 ? s0[i & 3] : s1[i & 3]; x[i] = first ? x[i] * cs - pt[i] * sn : x[i] * cs + pt[i] * sn; } }
                        if (isq) { float qn = 0.f;
#pragma unroll
                            for (int i = 0; i < 8; ++i) { x[i] *= 0.17677669529663687f * LOG2E; qn += x[i] * x[i]; }
                            qn = red4(qn, lane); if (fq == 0) QBD[(size_t)r * 8 + head * 2 + kind] = -(sqrtf(qn) * kbd + 0.05f); }
                        st8((isq ? DQ : DK) + (size_t)r * 256 + head * 64 + (kind & 1) * 32 + 8 * fq, x); } }
        } else if (t < 7) {
            const int pi = (t - 5) * 4 + wc, head = pi >> 1; const bool isq = (pi & 1) == 0; const float* gp = (isq ? nqg : nkg) + 8 * fq; float g0[8], g1[8];
#pragma unroll
            for (int i = 0; i < 8; ++i) { g0[i] = gp[i]; g1[i] = gp[32 + i]; }
#pragma unroll
            for (int ai = 0; ai < 2; ++ai)
#pragma unroll
                for (int m = 0; m < 4; ++m) { const int r = row0 + ai * 128 + m * 16; float x0[8], x1[8]; GET8(ai, 0, m, x0); GET8(ai, 1, m, x1); float ss = 0.f;
#pragma unroll
                    for (int i = 0; i < 8; ++i) ss += x0[i] * x0[i] + x1[i] * x1[i];
                    const float rs = rsqrtf(red4(ss, lane) * (1.f / 64.f) + EPS) * (isq ? 0.125f * LOG2E : 1.f); float qn = 0.f;
#pragma unroll
                    for (int i = 0; i < 8; ++i) { x0[i] = x0[i] * rs * g0[i]; x1[i] = x1[i] * rs * g1[i]; qn += x0[i] * x0[i] + x1[i] * x1[i]; }
                    if (isq) { qn = red4(qn, lane); if (fq == 0) QBN[(size_t)r * 4 + head] = -(sqrtf(qn) * kbn + nbias); }
                    bf16* dst = (isq ? NQ : NK) + (size_t)r * 256 + head * 64 + 8 * fq; st8(dst, x0); st8(dst + 32, x1); }
        } else if (t == 7) {
#pragma unroll
            for (int bj = 0; bj < 2; ++bj) { const int sl = bj * 4 + wc, head = sl >> 1, half = sl & 1;
#pragma unroll
                for (int ai = 0; ai < 2; ++ai)
#pragma unroll
                    for (int m = 0; m < 4; ++m) { float x[8]; GET8(ai, bj, m, x); st8(NV + (size_t)(row0 + ai * 128 + m * 16) * 256 + head * 64 + half * 32 + 8 * fq, x); } }
        } else {
            const int nsl = t == 8 ? 6 : 4;
#pragma unroll
            for (int bj = 0; bj < 2; ++bj) { const int sl = bj * 4 + wc;
#pragma unroll
                for (int ai = 0; ai < 2; ++ai)
#pragma unroll
                    for (int m = 0; m < 4; ++m) { float x[8]; GET8(ai, bj, m, x); float ss = 0.f;
#pragma unroll
                        for (int i = 0; i < 8; ++i) ss += x[i] * x[i];
                        ss = red4(ss, lane); if (fq == 0) P[(ai * 128 + wr * 64 + m * 16 + fr) * 8 + sl] = sl < nsl ? ss : 0.f; } }
            asm volatile("s_waitcnt lgkmcnt(0)" ::: "memory"); __builtin_amdgcn_s_barrier(); asm volatile("" ::: "memory");
#pragma unroll
            for (int bj = 0; bj < 2; ++bj) { const int sl = bj * 4 + wc; const float* gp = (t == 8 ? cqg : ckvg) + 32 * (sl < nsl ? sl : 0) + 8 * fq; float gg[8];
#pragma unroll
                for (int i = 0; i < 8; ++i) gg[i] = gp[i];
#pragma unroll
                for (int ai = 0; ai < 2; ++ai)
#pragma unroll
                    for (int m = 0; m < 4; ++m) { const int rl = ai * 128 + wr * 64 + m * 16 + fr, r = u.pm * 256 + rl; float x[8]; GET8(ai, bj, m, x);
                        const pg8::f32x4 p0 = *(const pg8::f32x4*)(P + rl * 8), p1 = *(const pg8::f32x4*)(P + rl * 8 + 4);
                        const float tot = (p0[0] + p0[1]) + (p0[2] + p0[3]) + (p1[0] + p1[1]) + (p1[2] + p1[3]);
                        const float rs = rsqrtf(tot * (t == 8 ? 1.f / 192.f : 1.f / 128.f) + EPS);
                        if (sl < nsl) {
#pragma unroll
                            for (int i = 0; i < 8; ++i) x[i] = x[i] * rs * gg[i];
                            st8(AQ + (size_t)r * 384 + (t == 8 ? 0 : 192) + 32 * sl + 8 * fq, x); }
                        else if (t == 8 && sl == 6) st8(KPE + (size_t)r * 32 + 8 * fq, x);
                        else if (t == 9 && sl < 6) {
#pragma unroll
                            for (int i = 0; i < 8; ++i) x[i] = 0.f;
                            st8(AQ + (size_t)r * 384 + 320 + 32 * (sl - 4) + 8 * fq, x); } } }
            asm volatile("s_waitcnt lgkmcnt(0)" ::: "memory"); __builtin_amdgcn_s_barrier(); asm volatile("" ::: "memory");
        }
#undef GET8
    }
};
struct EpiQkvFused {
    static constexpr bool PERM = true;
    bf16 *MQ, *MK, *MV; const bf16* KPE; float* QBM; const float* ROPE; const float *gq, *gk; float nbconst; float* P;
    DI static float red4(float v, int lane) { v += lane_xor(v, lane, 16); v += lane_xor(v, lane, 32); return v; }
    DI static void st8(bf16* dst, const float (&x)[8]) { pg8::u32x4 w; w.x = pg8::cvt_pk_bf16(x[0], x[1]); w.y = pg8::cvt_pk_bf16(x[2], x[3]); w.z = pg8::cvt_pk_bf16(x[4], x[5]); w.w = pg8::cvt_pk_bf16(x[6], x[7]); *(pg8::u32x4*)dst = w; }
    DI void rope8(float (&x)[8], int r, int fq, int lane) const {
        float pt[8];
#pragma unroll
        for (int i = 0; i < 8; ++i) pt[i] = lane_xor(x[i], lane, 32);
        const float* rp = ROPE + (size_t)(r & (SEQ - 1)) * 32 + 8 * (fq & 1); const bool first = fq < 2;
        const pg8::f32x4 c0 = *(const pg8::f32x4*)rp, c1 = *(const pg8::f32x4*)(rp + 4), s0 = *(const pg8::f32x4*)(rp + 16), s1 = *(const pg8::f32x4*)(rp + 20);
#pragma unroll
        for (int i = 0; i < 8; ++i) { const float cs = i < 4 ? c0[i & 3] : c1[i & 3], sn = i < 4 ? s0[i & 3] : s1[i & 3]; x[i] = first ? x[i] * cs - pt[i] * sn : x[i] * cs + pt[i] * sn; }
    }
    DI void operator()(const pg8::f32x4 (&acc)[2][2][4][2], const pg8::Unit& u, int wr, int wc, int fr, int fq) const {
        const int t = u.pn, lane = fr + 16 * fq, row0 = u.pm * 256 + wr * 64 + fr; const bool lat = u.pm < TL / 256;
#define GET8(ai, bj, m, x) do { _Pragma("unroll") for (int n_ = 0; n_ < 2; ++n_) _Pragma("unroll") for (int j_ = 0; j_ < 4; ++j_) x[4 * n_ + j_] = acc[ai][bj][m][n_][j_]; } while (0)
        if (t < 2) {
#pragma unroll
            for (int bj = 0; bj < 2; ++bj)
#pragma unroll
                for (int ai = 0; ai < 2; ++ai)
#pragma unroll
                    for (int m = 0; m < 4; ++m) { float x[8]; GET8(ai, bj, m, x); float ss = 0.f;
#pragma unroll
                        for (int i = 0; i < 8; ++i) ss += x[i] * x[i];
                        ss = red4(ss, lane); if (fq == 0) P[(ai * 128 + wr * 64 + m * 16 + fr) * 8 + bj * 4 + wc] = wc < 3 ? ss : 0.f; }
            asm volatile("s_waitcnt lgkmcnt(0)" ::: "memory"); __builtin_amdgcn_s_barrier(); asm volatile("" ::: "memory");
            if (wc < 3) {
#pragma unroll
                for (int bj = 0; bj < 2; ++bj) { const int head = 2 * t + bj; const float* gp = gq + 32 * wc + 8 * fq; asm volatile("" : "+v"(gp)); float gg[8];
#pragma unroll
                    for (int i = 0; i < 8; ++i) gg[i] = gp[i];
#pragma unroll
                    for (int ai = 0; ai < 2; ++ai)
#pragma unroll
                        for (int m = 0; m < 4; ++m) { const int rl = ai * 128 + wr * 64 + m * 16 + fr, r = u.pm * 256 + rl; float x[8]; GET8(ai, bj, m, x);
                            const pg8::f32x4 pp = *(const pg8::f32x4*)(P + rl * 8 + bj * 4);
                            const float rs = rsqrtf((pp[0] + pp[1] + pp[2]) * (1.f / 96.f) + EPS);
#pragma unroll
                            for (int i = 0; i < 8; ++i) x[i] = x[i] * rs * gg[i];
                            if (wc == 2 && lat) rope8(x, r, fq, lane);
#pragma unroll
                            for (int i = 0; i < 8; ++i) x[i] *= 0.10206207261596577f * LOG2E;
                            st8(MQ + (size_t)r * 384 + head * 96 + 32 * wc + 8 * fq, x);
                            if (wc == 0 && fq == 0) QBM[(size_t)r * 4 + head] = nbconst; } }
            }
            asm volatile("s_waitcnt lgkmcnt(0)" ::: "memory"); __builtin_amdgcn_s_barrier(); asm volatile("" ::: "memory");
        } else if (wc < 2) {
            const int head = 2 * (t - 2) + wc;
#pragma unroll
            for (int ai = 0; ai < 2; ++ai)
#pragma unroll
                for (int m = 0; m < 4; ++m) { const int r = row0 + ai * 128 + m * 16; float xp[8];
                    { const uint4 kq = *(const uint4*)(KPE + (size_t)r * 32 + 8 * fq); const unsigned w[4] = {kq.x, kq.y, kq.z, kq.w};
#pragma unroll
                      for (int i = 0; i < 4; ++i) { xp[2 * i] = __uint_as_float(w[i] << 16); xp[2 * i + 1] = __uint_as_float(w[i] & 0xffff0000u); } }
                    float ss = 0.f;
#pragma unroll
                    for (int n = 0; n < 2; ++n)
#pragma unroll
                        for (int j = 0; j < 4; ++j) ss += acc[ai][0][m][n][j] * acc[ai][0][m][n][j] + acc[ai][1][m][n][j] * acc[ai][1][m][n][j] + xp[4 * n + j] * xp[4 * n + j];
                    const float rs = rsqrtf(red4(ss, lane) * (1.f / 96.f) + EPS);
                    const float* gp = gk + 8 * fq; asm volatile("" : "+v"(gp));
                    bf16* dst = MK + (size_t)r * 384 + head * 96 + 8 * fq;
#pragma unroll
                    for (int bj = 0; bj < 2; ++bj) { float x[8]; GET8(ai, bj, m, x);
#pragma unroll
                        for (int i = 0; i < 8; ++i) x[i] = x[i] * rs * gp[32 * bj + i];
                        st8(dst + 32 * bj, x); }
#pragma unroll
                    for (int i = 0; i < 8; ++i) xp[i] = xp[i] * rs * gp[64 + i];
                    if (lat) rope8(xp, r, fq, lane);
                    st8(dst + 64, xp); }
        } else {
            const int head = 2 * (t - 2) + wc - 2;
#pragma unroll
            for (int bj = 0; bj < 2; ++bj)
#pragma unroll
                for (int ai = 0; ai < 2; ++ai)
#pragma unroll
                    for (int m = 0; m < 4; ++m) { float x[8]; GET8(ai, bj, m, x); st8(MV + (size_t)(row0 + ai * 128 + m * 16) * 256 + head * 64 + 32 * bj + 8 * fq, x); }
        }
#undef GET8
    }
};
struct EpiMoeActI8 {
    static constexpr bool PERM = true;
    bf16* ACT; const float* bgu; const float* HS; const float* WGUS;
    DI void operator()(const pg8::f32x4 (&acc)[2][2][4][2], const pg8::Unit& u, int wr, int wc, int fr, int fq) const {
        const int rl0 = wr * 64 + fr, row0 = u.pm * 256 + rl0, col0 = u.pn * 128 + wc * 32 + 8 * fq;
        const float* b = bgu + (size_t)u.aux * 2048 + col0;
        const pg8::f32x4 bg0 = *(const pg8::f32x4*)(b), bg1 = *(const pg8::f32x4*)(b + 4), bu0 = *(const pg8::f32x4*)(b + 1024), bu1 = *(const pg8::f32x4*)(b + 1028);
        const float* cs = WGUS + (size_t)u.aux * 2048 + u.pn * 256 + wc * 32 + 8 * fq;
        const pg8::f32x4 sg0 = *(const pg8::f32x4*)(cs), sg1 = *(const pg8::f32x4*)(cs + 4), su0 = *(const pg8::f32x4*)(cs + 128), su1 = *(const pg8::f32x4*)(cs + 132);
#pragma unroll
        for (int ai = 0; ai < 2; ++ai)
#pragma unroll
            for (int m = 0; m < 4; ++m) { const int rl = rl0 + ai * 128 + m * 16; const float sa = HS[rl < u.nvalid ? u.rows[rl] : 0]; float a[8];
#pragma unroll
                for (int n = 0; n < 2; ++n) { const pg8::i32x4v ig = __builtin_bit_cast(pg8::i32x4v, acc[ai][0][m][n]), iu = __builtin_bit_cast(pg8::i32x4v, acc[ai][1][m][n]);
#pragma unroll
                    for (int j = 0; j < 4; ++j) { const float gg = (float)ig[j] * sa * (n ? sg1[j] : sg0[j]) + (n ? bg1[j] : bg0[j]), uu = (float)iu[j] * sa * (n ? su1[j] : su0[j]) + (n ? bu1[j] : bu0[j]);
                        const float g = fminf(gg, 7.f), uc = fminf(fmaxf(uu, -7.f), 7.f); a[4 * n + j] = (uc + 1.f) * (g * sigm_fast(1.702f * g)); } }
                pg8::u32x4 w; w.x = pg8::cvt_pk_bf16(a[0], a[1]); w.y = pg8::cvt_pk_bf16(a[2], a[3]); w.z = pg8::cvt_pk_bf16(a[4], a[5]); w.w = pg8::cvt_pk_bf16(a[6], a[7]);
                *(pg8::u32x4*)(ACT + (size_t)(row0 + ai * 128 + m * 16) * D + col0) = w; }
    }
};
struct EpiMoeAct {
    static constexpr bool PERM = true;
    bf16* ACT; const float* bgu;
    DI void operator()(const pg8::f32x4 (&acc)[2][2][4][2], const pg8::Unit& u, int wr, int wc, int fr, int fq) const {
        const int row0 = u.pm * 256 + wr * 64 + fr, col0 = u.pn * 128 + wc * 32 + 8 * fq;
        const float* b = bgu + (size_t)u.aux * 2048 + col0;
        const pg8::f32x4 bg0 = *(const pg8::f32x4*)(b), bg1 = *(const pg8::f32x4*)(b + 4), bu0 = *(const pg8::f32x4*)(b + 1024), bu1 = *(const pg8::f32x4*)(b + 1028);
#pragma unroll
        for (int ai = 0; ai < 2; ++ai)
#pragma unroll
            for (int m = 0; m < 4; ++m) { float a[8];
#pragma unroll
                for (int n = 0; n < 2; ++n) { const pg8::f32x4 gg = acc[ai][0][m][n] + (n ? bg1 : bg0), uu = acc[ai][1][m][n] + (n ? bu1 : bu0);
#pragma unroll
                    for (int j = 0; j < 4; ++j) { const float g = fminf(gg[j], 7.f), uc = fminf(fmaxf(uu[j], -7.f), 7.f); a[4 * n + j] = (uc + 1.f) * (g * sigm_fast(1.702f * g)); } }
                pg8::u32x4 w; w.x = pg8::cvt_pk_bf16(a[0], a[1]); w.y = pg8::cvt_pk_bf16(a[2], a[3]); w.z = pg8::cvt_pk_bf16(a[4], a[5]); w.w = pg8::cvt_pk_bf16(a[6], a[7]);
                *(pg8::u32x4*)(ACT + (size_t)(row0 + ai * 128 + m * 16) * D + col0) = w; }
    }
};

struct MapId { int off; DI int operator()(int n) const { return n + off; } };
struct MapProj { DI int operator()(int s) const {
    int t, slot;
    if (s < 512) { const int isg = s >> 8, ch = s & 255; t = ch >> 7; slot = isg * 4 + ((ch >> 5) & 3); }
    else if (s < OFF_C) { const int m = s - OFF_B; if (m < 192) { t = 8; slot = m >> 5; } else if (m < 320) { t = 9; slot = (m - 192) >> 5; } else { t = 8; slot = 6; } }
    else if (s < OFF_D) { const int m = s - OFF_C, head = m / 192, w = m - head * 192, ds = head * 6 + (w >> 5); t = 2 + (ds >> 3); slot = ds & 7; }
    else { const int m = s - OFF_D, head = m / 192, w = m - head * 192;
      if (w < 128) { const int pi = head * 2 + (w >> 6); t = 5 + (pi >> 2); slot = ((w >> 5) & 1) * 4 + (pi & 3); } else { t = 7; slot = head * 2 + ((w - 128) >> 5); } }
    return 256 * t + (slot >> 2) * 128 + (slot & 3) * 32 + (s & 31); } };
struct MapQ  { DI int operator()(int s) const { const int head = s / 96, w = s - head * 96; return 256 * (head >> 1) + 128 * (head & 1) + 32 * (w >> 5) + (s & 31); } };
struct MapKV { DI int operator()(int s) const { const int head = s >> 7, w = s & 127, isv = w >> 6, half = (w >> 5) & 1; return 256 * (2 + (head >> 1)) + 128 * half + 32 * (2 * isv + (head & 1)) + (s & 31); } };
struct MapGate { DI int operator()(int s) const { const int b = s >> 10, w = s & 1023, pn = w >> 6, lc = w & 63; return 256 * pn + 128 * (b >> 1) + 32 * (lc >> 4) + 16 * (b & 1) + (lc & 15); } };
struct MapGu { DI int operator()(int s) const { const int isu = s >> 10, c = s & 1023; return 256 * (c >> 7) + 128 * isu + (c & 127); } };
struct CvtItem { const float* W; bf16* WT; int N, ldk, kdst0, mapt, mapoff, item; };
DI CvtItem cvt_decode(PRef p, int it) {
    constexpr int I_WIN_ = (D / 64) * (INW / 32), I_UQ_ = 3 * 12, I_UKV_ = 2 * 16, I_BR_ = 4 * 32, I_GATE_ = 16 * 128, I_WO_ = 16 * 32, I_GU_ = 16 * 64, I_DN_ = 16 * 32;
    constexpr int PER_L = I_UQ_ + I_UKV_ + 4 * I_BR_ + I_WO_ + NE * I_DN_;
    unsigned char* ws = p.ws; CvtItem c; (void)I_WIN_; (void)I_GATE_; c.mapt = 0; c.mapoff = 0; c.kdst0 = 0;
    const int l = it / PER_L; int r = it - l * PER_L;
    if (r < I_UQ_) { c.W = p.in[I_WUQ] + (size_t)l * 192 * 384; c.N = 384; c.WT = (bf16*)(ws + WS_QKV_T) + (size_t)l * 1024 * 384; c.ldk = 384; c.mapt = 4; c.item = r; return c; } r -= I_UQ_;
    if (r < I_UKV_) { c.W = p.in[I_WUKV] + (size_t)l * 128 * 512; c.N = 512; c.WT = (bf16*)(ws + WS_QKV_T) + (size_t)l * 1024 * 384; c.ldk = 384; c.kdst0 = 192; c.mapt = 5; c.item = r; return c; } r -= I_UKV_;
    if (r < 4 * I_BR_) { const int b = r / I_BR_; c.W = (b == 0 ? p.in[I_CONVOUT] : b == 1 ? p.in[I_MLAOUT] : b == 2 ? p.in[I_DIFFOUT] : p.in[I_NAOUT]) + (size_t)l * 256 * D; c.N = D;
        c.WT = (bf16*)(ws + WS_WB_T) + ((size_t)l * 4 + b) * 1024 * 256; c.ldk = 256; c.item = r - b * I_BR_; return c; } r -= 4 * I_BR_;
    if (r < I_WO_) { c.W = p.in[I_WO] + (size_t)l * D * D; c.N = D; c.WT = (bf16*)(ws + WS_WO_T) + (size_t)l * D * D; c.ldk = D; c.item = r; return c; } r -= I_WO_;
    const int e = r / I_DN_; r -= e * I_DN_; (void)I_GU_;
    c.W = p.in[I_WDN] + ((size_t)l * NE + e) * DFF * D; c.N = D; c.WT = (bf16*)(ws + WS_WDN_T) + ((size_t)l * NE + e) * D * DFF; c.ldk = DFF; c.item = r; return c;
}
DI void cvt_load(const CvtItem& c, float (&v)[32], int lane) {
    const int nblk = c.N / 32, kb = c.item / nblk, nb = c.item - kb * nblk;
    const float* src = c.W + (size_t)(64 * kb + (lane >> 5)) * c.N + 32 * nb + (lane & 31);
#pragma unroll
    for (int i = 0; i < 32; ++i) v[i] = src[(size_t)(2 * i) * c.N];
}
DI void cvt_store(const CvtItem& c, const float (&v)[32], float* scr, int lane) {
    const int nblk = c.N / 32, kb = c.item / nblk, nb = c.item - kb * nblk, k0 = 64 * kb, n0 = 32 * nb;
#pragma unroll
    for (int i = 0; i < 32; ++i) scr[(2 * i + (lane >> 5)) * 33 + (lane & 31)] = v[i];
    asm volatile("s_waitcnt lgkmcnt(0)" ::: "memory");
    const int cc = lane & 7;
#pragma unroll
    for (int j = 0; j < 4; ++j) { const int n = (lane >> 3) + 8 * j; const float* s = scr + (8 * cc) * 33 + n;
        pg8::u32x4 o; o.x = pg8::cvt_pk_bf16(s[0 * 33], s[1 * 33]); o.y = pg8::cvt_pk_bf16(s[2 * 33], s[3 * 33]); o.z = pg8::cvt_pk_bf16(s[4 * 33], s[5 * 33]); o.w = pg8::cvt_pk_bf16(s[6 * 33], s[7 * 33]);
        const int sn = n0 + n; const int row = c.mapt == 0 ? sn + c.mapoff : (c.mapt == 1 ? MapGate()(sn) : (c.mapt == 2 ? MapGu()(sn) : (c.mapt == 3 ? MapProj()(sn) : (c.mapt == 4 ? MapQ()(sn) : MapKV()(sn)))));
        *(pg8::u32x4*)(c.WT + (size_t)row * c.ldk + c.kdst0 + k0 + 8 * cc) = o; }
    asm volatile("s_waitcnt lgkmcnt(0)" ::: "memory");
}
DI void ph_convert(PRef p, unsigned char* lds) {
    const int tid_ = opq_tid(); const int bid_ = opq_bid(), nblk_ = opq_nblk(); const int lane = tid_ & 63, wave = __builtin_amdgcn_readfirstlane(tid_ >> 6);
    float* scr = (float*)(lds + wave * 8704);
    const int gw = bid_ * 8 + wave, ngw = nblk_ * 8;
    constexpr int PER_L = 3 * 12 + 2 * 16 + 4 * 4 * 32 + 16 * 32 + NE * (16 * 32);
    const int total = 2 * PER_L;
    float va[32], vb[32];
    int it = gw;
    CvtItem ca, cb;
    if (it < total) { ca = cvt_decode(p, it); cvt_load(ca, va, lane); }
    for (; it < total; it += 2 * ngw) {
        const int i1 = it + ngw, i2 = it + 2 * ngw;
        if (i1 < total) { cb = cvt_decode(p, i1); cvt_load(cb, vb, lane); }
        cvt_store(ca, va, scr, lane);
        if (i2 < total) { ca = cvt_decode(p, i2); cvt_load(ca, va, lane); }
        if (i1 < total) cvt_store(cb, vb, scr, lane);
    }
    __syncthreads();
    { float* red = (float*)lds;
      const int n = tid_ & 31, kg = tid_ >> 5; signed char* W8 = (signed char*)(p.ws + WS_WGU_T); float* WS_ = (float*)(p.ws + WS_WGUS);
      float xa[64], xb[64];
#define I8_DECODE(it, src_, N_, dst_, sca_, kind_, nb_) const float* src_; int N_, kind_, nb_; signed char* dst_; float* sca_; \
        if ((it) < 4096) { const int le_ = (it) >> 6; nb_ = (it) & 63; src_ = p.in[I_WGU] + (size_t)le_ * D * 2048; N_ = 2048; dst_ = W8 + (size_t)le_ * 2048 * D * 2; sca_ = WS_ + (size_t)le_ * 2048; kind_ = 0; } \
        else if ((it) < 4096 + 150) { const int l_ = ((it) - 4096) / 75; nb_ = ((it) - 4096) - l_ * 75; src_ = p.in[I_WIN] + (size_t)l_ * D * INW; N_ = INW; dst_ = (signed char*)(p.ws + WS_WIN_T) + (size_t)l_ * PLD * D * 2; sca_ = (float*)(p.ws + WS_WINS) + l_ * PLD; kind_ = 1; } \
        else { const int l_ = ((it) - 4246) >> 7; nb_ = ((it) - 4246) & 127; src_ = p.in[I_GATEW] + (size_t)l_ * D * 4096; N_ = 4096; dst_ = (signed char*)(p.ws + WS_GATE_T) + (size_t)l_ * 4096 * D * 2; sca_ = (float*)(p.ws + WS_GATES) + l_ * 4096; kind_ = 2; }
#define GU_LOAD(dst, it) do { I8_DECODE(it, src_, N_, d8_, sc8_, kind_, nb_); (void)d8_; (void)sc8_; (void)kind_; const float* s2_ = src_ + (size_t)(64 * kg) * N_ + 32 * nb_ + n; \
        _Pragma("unroll") for (int i = 0; i < 64; ++i) dst[i] = s2_[(size_t)i * N_]; } while (0)
#define GU_EMIT(src, it) do { I8_DECODE(it, src_, N_, d8_, sc8_, kind_, nb_); (void)src_; float m_ = 0.f; _Pragma("unroll") for (int i = 0; i < 64; ++i) m_ = fmaxf(m_, fabsf(src[i])); \
        red[kg * 32 + n] = m_; __syncthreads(); \
        if (tid_ < 32) { float mm_ = 0.f; _Pragma("unroll") for (int g = 0; g < 16; ++g) mm_ = fmaxf(mm_, red[g * 32 + tid_]); red[512 + tid_] = mm_ > 0.f ? mm_ * (1.f / 127.f) : 1.f; } \
        __syncthreads(); const float sc_ = red[512 + n], inv_ = 1.f / sc_; const int col_ = 32 * nb_ + n; const int row_ = kind_ == 0 ? MapGu()(col_) : (kind_ == 1 ? MapProj()(col_) : MapGate()(col_)); \
        if (kg == 0) sc8_[row_] = sc_; \
        signed char* dst_ = d8_ + (size_t)row_ * D + 64 * kg; \
        _Pragma("unroll") for (int q = 0; q < 4; ++q) { unsigned w_[4]; _Pragma("unroll") for (int d = 0; d < 4; ++d) { unsigned b_ = 0; _Pragma("unroll") for (int i = 0; i < 4; ++i) { \
            const int v_ = (int)rintf(src[16 * q + 4 * d + i] * inv_); b_ |= ((unsigned)v_ & 255u) << (8 * i); } w_[d] = b_; } \
            *(uint4*)(dst_ + 16 * q) = make_uint4(w_[0], w_[1], w_[2], w_[3]); } \
        __syncthreads(); } while (0)
      const int nit = 2 * NE * 64 + 150 + 256; int it2 = bid_;
      if (it2 < nit) GU_LOAD(xa, it2);
      for (; it2 < nit; it2 += 2 * nblk_) { const int j1 = it2 + nblk_, j2 = it2 + 2 * nblk_;
        if (j1 < nit) GU_LOAD(xb, j1);
        GU_EMIT(xa, it2);
        if (j2 < nit) GU_LOAD(xa, j2);
        if (j1 < nit) GU_EMIT(xb, j1); }
#undef GU_LOAD
#undef GU_EMIT
#undef I8_DECODE
    }
}

#define LDSP ((PG8_LAS unsigned char*)lds)
DI void ph_proj_fast(PRef p, int l, unsigned char* lds) {
    const int bid_ = opq_bid(), nblk_ = opq_nblk(); const int tid0 = opq_tid(), lane0 = tid0 & 63;
    SchedDense S; S.init(p.ws + WS_H, D / 2, (const bf16*)(p.ws + WS_WIN_T) + (size_t)l * PLD * D, D / 2, T, PLD, nblk_, bid_);
    EpiProjFused E;
    E.CU = (bf16*)(p.ws + WS_CU); E.AQ = (bf16*)(p.ws + WS_AQ); E.DQ = (bf16*)(p.ws + WS_DQ); E.DK = (bf16*)(p.ws + WS_DK); E.DV = (bf16*)(p.ws + WS_DV);
    E.NQ = (bf16*)(p.ws + WS_NQ); E.NK = (bf16*)(p.ws + WS_NK); E.NV = (bf16*)(p.ws + WS_NV); E.KPE = (bf16*)(p.ws + WS_KPE);
    E.QBD = (float*)(p.ws + WS_QBD); E.QBN = (float*)(p.ws + WS_QBN); E.ROPE = (const float*)(p.ws + WS_ROPE);
    E.cqg = p.in[I_CQG] + l * 192; E.ckvg = p.in[I_CKVG] + l * 128; E.dqg = p.in[I_DQNG] + l * 32; E.dkg = p.in[I_DKNG] + l * 32; E.nqg = p.in[I_NQNG] + l * 64; E.nkg = p.in[I_NKNG] + l * 64;
    { float m = lane0 < 32 ? fabsf(p.in[I_DKNG][l * 32 + lane0]) : 0.f;
#pragma unroll
      for (int o = 1; o < 64; o <<= 1) m = fmaxf(m, lane_xor(m, lane0, o));
      float m2 = fabsf(p.in[I_NKNG][l * 64 + lane0]);
#pragma unroll
      for (int o = 1; o < 64; o <<= 1) m2 = fmaxf(m2, lane_xor(m2, lane0, o));
      float t0 = 5.656854249f * 1.004f * m, t1 = 8.f * 1.004f * m2, t2 = __int_as_float(((const int*)(p.ws + WS_CTL))[CW_BIASMAX + l]) * LOG2E + 0.05f;
      asm volatile("" : "+v"(t0), "+v"(t1), "+v"(t2));
      const int b0 = __builtin_amdgcn_readfirstlane(__float_as_int(t0)), b1 = __builtin_amdgcn_readfirstlane(__float_as_int(t1)), b2 = __builtin_amdgcn_readfirstlane(__float_as_int(t2));
      E.kbd = __int_as_float(b0); E.kbn = __int_as_float(b1); E.nbias = __int_as_float(b2); }
    E.P = (float*)(lds + 131072 + 4096); E.HS1 = (const float*)(p.ws + WS_HS1); E.WINS = (const float*)(p.ws + WS_WINS) + l * PLD;
    pg8::gemm_phase<EpiProjFused, SchedDense, false, true>(LDSP, D, D, S, E);
}
DI void ph_qkvraw_fast(PRef p, int l, unsigned char* lds) {
    const int bid_ = opq_bid(), nblk_ = opq_nblk(); const int lane0 = opq_tid() & 63;
    SchedDense S; S.init(p.ws + WS_AQ, 384, (const bf16*)(p.ws + WS_QKV_T) + (size_t)l * 1024 * 384, 384, T, 1024, nblk_, bid_);
    EpiQkvFused E; E.MQ = (bf16*)(p.ws + WS_MQ); E.MK = (bf16*)(p.ws + WS_MK); E.MV = (bf16*)(p.ws + WS_MV); E.KPE = (const bf16*)(p.ws + WS_KPE); E.QBM = (float*)(p.ws + WS_QBM);
    E.ROPE = (const float*)(p.ws + WS_ROPE); E.gq = p.in[I_QNG] + l * 96; E.gk = p.in[I_KNG] + l * 96; E.P = (float*)(lds + 131072 + 4096);
    { float mq = 0.f, mk = 0.f;
      for (int i = lane0; i < 96; i += 64) { mq = fmaxf(mq, fabsf(E.gq[i])); mk = fmaxf(mk, fabsf(E.gk[i])); }
#pragma unroll
      for (int o = 1; o < 64; o <<= 1) { mq = fmaxf(mq, lane_xor(mq, lane0, o)); mk = fmaxf(mk, lane_xor(mk, lane0, o)); }
      E.nbconst = __int_as_float(__builtin_amdgcn_readfirstlane(__float_as_int(-(96.f * 0.10206207261596577f * LOG2E * mq * mk * 1.004f + 0.05f)))); }
    pg8::gemm_phase<EpiQkvFused, SchedDense, false>(LDSP, 384, 384, S, E);
}
DI void ph_branch_fast(PRef p, int l, int nrows, unsigned char* lds) {
    const int bid_ = opq_bid(), nblk_ = opq_nblk();
    SchedBranch S; S.init(p.ws + WS_BI, (const bf16*)(p.ws + WS_WB_T) + (size_t)l * 4 * 1024 * 256, nrows, nblk_, bid_);
    EpiStoreBf16 E{(bf16*)(p.ws + WS_YB), 4096, 1024, nullptr, 0};
    pg8::gemm_phase<EpiStoreBf16, SchedBranch, false>(LDSP, D, 256, S, E);
}
DI void ph_merge_fast(PRef p, int l, int nrows, unsigned char* lds) {
    const int bid_ = opq_bid(), nblk_ = opq_nblk();
    SchedDense S; S.init(p.ws + WS_H, D / 2, (const bf16*)(p.ws + WS_GATE_T) + (size_t)l * 4096 * D, D / 2, nrows, 4096, nblk_, bid_);
    S.rev = true;
    EpiMerge E{(const bf16*)(p.ws + WS_YB), (bf16*)(p.ws + WS_YM), p.in[I_GATEB] + l * 4096, (const float*)(p.ws + WS_HS1), (const float*)(p.ws + WS_GATES) + l * 4096};
    pg8::gemm_phase<EpiMerge, SchedDense, false, true>(LDSP, D, D, S, E);
}
DI void ph_wo_fast(PRef p, int l, int nrows, unsigned char* lds) {
    const int bid_ = opq_bid(), nblk_ = opq_nblk();
    SchedDense S; S.init(p.ws + WS_YM, D, (const bf16*)(p.ws + WS_WO_T) + (size_t)l * D * D, D, nrows, D, nblk_, bid_);
    const float* XFc = (const float*)(p.ws + WS_XF);
    EpiWo E{l == 0 ? p.in[I_X] : XFc, l == 0 ? p.in[I_CTX] : XFc + (size_t)TL * D, (float*)(p.ws + WS_XF), (const float*)(p.ws + WS_MOD) + (size_t)l * 9 * 6144 + 2048};
    pg8::gemm_phase<EpiWo, SchedDense, false>(LDSP, D, D, S, E);
}
DI void moe_offsets(PRef p, int l, int* off, int tid) {
    const unsigned* cnt = (const unsigned*)(p.ws + WS_CTL) + CW_CNT + l * 64;
    if (tid == 0) expert_offsets(cnt, off);
    if (tid < NE) off[40 + tid] = (int)cnt[tid];
    __syncthreads();
}
DI void ph_moe1_fast(PRef p, int l, unsigned char* lds) {
    const int tid_ = opq_tid(); const int bid_ = opq_bid(), nblk_ = opq_nblk(); (void)bid_; (void)nblk_; int* off = (int*)(lds + 131072 + 1024); moe_offsets(p, l, off, tid_);
    SchedMoe S; S.A = (const char*)(p.ws + WS_H2); S.Bt = (const char*)((const bf16*)(p.ws + WS_WGU_T) + (size_t)l * NE * 2048 * D); S.rowtok = (const int*)(p.ws + WS_ROWTOK); S.off = off; S.cnt = off + 40;
    S.nN = 8; S.G = nblk_; S.c = bid_; S.ntiles = off[NE] >> 8; S.tstepA = 0; S.estepB = (size_t)2048 * D * 2  ; S.tstepB = (size_t)256 * D  ; S.gather = true;
    EpiMoeActI8 E{(bf16*)(p.ws + WS_ACT), p.in[I_BGU] + (size_t)l * NE * 2048, (const float*)(p.ws + WS_HS), (const float*)(p.ws + WS_WGUS) + (size_t)l * NE * 2048};
    pg8::gemm_phase<EpiMoeActI8, SchedMoe, true, true>(LDSP, D, D, S, E);
}
DI void ph_moe2_fast(PRef p, int l, unsigned char* lds) {
    const int tid_ = opq_tid(); const int bid_ = opq_bid(), nblk_ = opq_nblk(); (void)bid_; (void)nblk_; int* off = (int*)(lds + 131072 + 1024); moe_offsets(p, l, off, tid_);
    SchedMoe S; S.A = (const char*)(p.ws + WS_ACT); S.Bt = (const char*)((const bf16*)(p.ws + WS_WDN_T) + (size_t)l * NE * D * DFF); S.rowtok = (const int*)(p.ws + WS_ROWTOK); S.off = off; S.cnt = off + 40;
    S.nN = 4; S.G = nblk_; S.c = bid_; S.ntiles = off[NE] >> 8; S.tstepA = (size_t)256 * D * 2; S.estepB = (size_t)D * DFF * 2; S.tstepB = (size_t)256 * DFF * 2; S.gather = false;
    S.rev = true;
    EpiStoreBf16 E{(bf16*)(p.ws + WS_YE), D, 0, p.in[I_BDN] + (size_t)l * NE * D, D};
    pg8::gemm_phase<EpiStoreBf16, SchedMoe, false>(LDSP, DFF, DFF, S, E);
}

namespace fa {
using bf16x8 = __attribute__((ext_vector_type(8))) short;
using s16x4  = __attribute__((ext_vector_type(4))) short;
using f32x16 = __attribute__((ext_vector_type(16))) float;
using u32x4  = __attribute__((ext_vector_type(4))) unsigned;
constexpr int SHM_K = 64 * 256, SHM_V = 64 * 256;
constexpr float THR2 = 11.5f;
#define FA_KSWZ(row, colB) ((row) * 256 + ((colB) ^ (((row) & 7) << 4)))
#define FA_SBAR() __builtin_amdgcn_sched_barrier(0)
DI int crow(int r, int hi) { return (r & 3) + 8 * (r >> 2) + 4 * hi; }
DI unsigned cvtpk(float lo, float hi) { unsigned r; asm volatile("v_cvt_pk_bf16_f32 %0, %1, %2" : "=v"(r) : "v"(lo), "v"(hi)); return r; }
DI int v_st(int k, int c) { const int kk = k;        return ((kk >> 3) * 4 + (c >> 5)) * 512 + ((kk & 7) * 32 + (c & 31)) * 2; }
DI int v_rd_base(int lane) { return ((lane & 3) << 3) | (((lane >> 2) & 3) << 6) | (((lane >> 4) & 1) << 5) | (((lane >> 5) & 1) << 8); }
constexpr int v_rd_off(int d0, int ks, int half) { return d0 * 512 + ks * 4096 + half * 2048; }
template <int OFF> DI s16x4 tr_read(int vb) { s16x4 r; asm volatile("ds_read_b64_tr_b16 %0, %1 offset:%2" : "=&v"(r) : "v"(vb), "i"(OFF) : "memory"); return r; }
template <int D0> DI void pv_one(f32x16& od, int vb, bf16x8 pa0, bf16x8 pa1, bf16x8 pa2, bf16x8 pa3) {
  const s16x4 l0 = tr_read<v_rd_off(D0, 0, 0)>(vb), h0 = tr_read<v_rd_off(D0, 0, 1)>(vb), l1 = tr_read<v_rd_off(D0, 1, 0)>(vb), h1 = tr_read<v_rd_off(D0, 1, 1)>(vb);
  const s16x4 l2 = tr_read<v_rd_off(D0, 2, 0)>(vb), h2 = tr_read<v_rd_off(D0, 2, 1)>(vb), l3 = tr_read<v_rd_off(D0, 3, 0)>(vb), h3 = tr_read<v_rd_off(D0, 3, 1)>(vb);
  asm volatile("s_waitcnt lgkmcnt(0)" ::: "memory"); FA_SBAR();
#define FA_PK(L, H) (bf16x8){L[0], L[1], L[2], L[3], H[0], H[1], H[2], H[3]}
  od = __builtin_amdgcn_mfma_f32_32x32x16_bf16(pa0, FA_PK(l0, h0), od, 0, 0, 0);
  od = __builtin_amdgcn_mfma_f32_32x32x16_bf16(pa1, FA_PK(l1, h1), od, 0, 0, 0);
  od = __builtin_amdgcn_mfma_f32_32x32x16_bf16(pa2, FA_PK(l2, h2), od, 0, 0, 0);
  od = __builtin_amdgcn_mfma_f32_32x32x16_bf16(pa3, FA_PK(l3, h3), od, 0, 0, 0);
#undef FA_PK
}

}


DI void ph_ada_fast(PRef p, unsigned char* lds) {
  const int tid_ = opq_tid(); const int bid_ = opq_bid(), nblk_ = opq_nblk();
  float* MOD = (float*)(p.ws + WS_MOD);
  { float* ROPE = (float*)(p.ws + WS_ROPE);
    for (int idx = GTID; idx < SEQ * 16; idx += NTHR) { const int sq = idx >> 4, i = idx & 15; const float pos = (i < 8) ? (float)(sq >> 6) : (float)(sq & 63);
      const float inv = powf(10000.f, -(float)(2 * (i & 7)) / 16.f); const float th = pos * inv; ROPE[sq * 32 + i] = cosf(th); ROPE[sq * 32 + 16 + i] = sinf(th); } }
  if (bid_ == 0) { for (int k = tid_; k < 2 * NH * 15 * 31; k += 512) { const float v = fmaxf(p.in[I_RPB][k], 0.f); atomicMax((int*)(p.ws + WS_CTL) + CW_BIASMAX + k / (NH * 15 * 31), __float_as_int(v)); } }
  float* sc = (float*)lds;
  float* red = (float*)(lds + 40960);
  for (int k = tid_; k < 9 * D; k += 512) { const int i = k >> 10, kk = k & 1023; const float v = i < 8 ? p.in[I_C][i * D + kk] : p.in[I_CCTX][kk]; sc[k] = v * sigmoidf_(v); }
  __syncthreads();
  const int nn = tid_ & 63, kg = tid_ >> 6;
  for (int it = bid_; it < 2 * 96; it += nblk_) {
    const int l = it / 96, n0 = (it - l * 96) * 64;
    const float* W = p.in[I_ADAW] + (size_t)l * D * 6144 + n0 + nn;
    float acc[9];
#pragma unroll
    for (int i = 0; i < 9; ++i) acc[i] = 0.f;
#pragma unroll 8
    for (int k = kg * 128; k < kg * 128 + 128; ++k) { const float w = W[(size_t)k * 6144];
#pragma unroll
      for (int i = 0; i < 9; ++i) acc[i] += sc[i * D + k] * w; }
#pragma unroll
    for (int i = 0; i < 9; ++i) red[(kg * 9 + i) * 64 + nn] = acc[i];
    __syncthreads();
    for (int o = tid_; o < 9 * 64; o += 512) { const int i = o >> 6, n = o & 63; float s = 0.f;
#pragma unroll
      for (int g = 0; g < 8; ++g) s += red[(g * 9 + i) * 64 + n];
      MOD[((size_t)l * 9 + i) * 6144 + n0 + n] = s + p.in[I_ADAB][l * 6144 + n0 + n]; }
    __syncthreads();
  }
}


DI void ld32(const bf16* __restrict__ src, float (&x)[32]) {
#pragma unroll
  for (int q = 0; q < 4; ++q) { const uint4 u = *(const uint4*)(src + 8 * q); const unsigned w[4] = {u.x, u.y, u.z, u.w};
#pragma unroll
    for (int i = 0; i < 4; ++i) { x[8 * q + 2 * i] = __uint_as_float(w[i] << 16); x[8 * q + 2 * i + 1] = __uint_as_float(w[i] & 0xffff0000u); } }
}
DI void st32(bf16* __restrict__ dst, const float (&x)[32]) {
#pragma unroll
  for (int q = 0; q < 4; ++q) { uint4 u; u.x = cvt_pk_bf16_(x[8 * q], x[8 * q + 1]); u.y = cvt_pk_bf16_(x[8 * q + 2], x[8 * q + 3]); u.z = cvt_pk_bf16_(x[8 * q + 4], x[8 * q + 5]); u.w = cvt_pk_bf16_(x[8 * q + 6], x[8 * q + 7]); *(uint4*)(dst + 8 * q) = u; }
}


DI void ph_diffcombine_fast(PRef p, int l, int nrows, float lam_init) {
  const int tid_ = opq_tid(); const int bid_ = opq_bid(), nblk_ = opq_nblk();
  const int lane = tid_ & 63, gw = GTID >> 6, ngw = NTHR >> 6;
  const bf16* __restrict__ DO_ = (const bf16*)(p.ws + WS_DO); bf16* __restrict__ BI = (bf16*)(p.ws + WS_BI);
  const float* lv = p.in[I_DLAM] + l * 128;
  const float t1 = seg_sum(lane < 32 ? lv[lane] * lv[32 + lane] : 0.f, lane, 64), t2 = seg_sum(lane < 32 ? lv[64 + lane] * lv[96 + lane] : 0.f, lane, 64);
  const float lam = expf(t1) - expf(t2) + lam_init;
  const int h = lane >> 4, d = 4 * (lane & 15);
  float g[4];
#pragma unroll
  for (int i = 0; i < 4; ++i) g[i] = p.in[I_DSUBG][l * 64 + d + i] * (1.f - lam_init);
#pragma unroll 4
  for (int r = gw; r < nrows; r += ngw) {
    float a[4], b[4], v[4]; ld4(DO_ + (size_t)r * 512 + (2 * h) * 64 + d, a); ld4(DO_ + (size_t)r * 512 + (2 * h + 1) * 64 + d, b);
#pragma unroll
    for (int i = 0; i < 4; ++i) v[i] = a[i] - lam * b[i];
    const float ss = seg_sum(v[0] * v[0] + v[1] * v[1] + v[2] * v[2] + v[3] * v[3], lane, 16); const float rs = rsqrtf(ss * (1.f / 64.f) + EPS);
#pragma unroll
    for (int i = 0; i < 4; ++i) v[i] = v[i] * rs * g[i];
    st4(BI + (size_t)r * D + 512 + h * 64 + d, v);
  }
}

DI void ph_mod2_router_fast(PRef p, int l, int nrows, unsigned char* lds) {
  const int tid_ = opq_tid(); const int bid_ = opq_bid(), nblk_ = opq_nblk();
  const int lane = tid_ & 63, wave = tid_ >> 6;
  float* rwT = (float*)lds;
  unsigned* lcnt = (unsigned*)(lds + 131072 + 2048);
  int* rbuf = (int*)(lds + 131072 + 4096);
  const float* rw = p.in[I_RW] + (size_t)l * D * NE;
  for (int q = tid_; q < D * NE / 4; q += 512) { const float4 v = *(const float4*)(rw + (size_t)q * 4); const int c = q >> 3, e = (q & 7) * 4;
    rwT[(e + 0) * D + c] = v.x; rwT[(e + 1) * D + c] = v.y; rwT[(e + 2) * D + c] = v.z; rwT[(e + 3) * D + c] = v.w; }
  if (tid_ < 64) lcnt[tid_] = 0u;
  __syncthreads();
  const float* MOD = (const float*)(p.ws + WS_MOD); const float* XF = (const float*)(p.ws + WS_XF);
  bf16* H2 = (bf16*)(p.ws + WS_H2); float* HS = (float*)(p.ws + WS_HS); const float* g = p.in[I_N2G] + l * D; const float* rb = p.in[I_RB] + l * NE;
  int* ROUTE = (int*)(p.ws + WS_ROUTE); unsigned* cnt = (unsigned*)(p.ws + WS_CTL) + CW_CNT + l * 64; int* ROWTOK = (int*)(p.ws + WS_ROWTOK);
  const int per = (nrows + nblk_ - 1) / nblk_, rlo = bid_ * per, rhi = min(rlo + per, nrows);
  float4 cx0, cx1, cx2, cx3;
  { const int r = min(rlo + wave, nrows - 1); const float* x = XF + (size_t)r * D + lane * 4; cx0 = *(const float4*)(x); cx1 = *(const float4*)(x + 256); cx2 = *(const float4*)(x + 512); cx3 = *(const float4*)(x + 768); }
  for (int r = rlo + wave; r < rhi; r += 8) {
    float4 nx0, nx1, nx2, nx3;
    { const int rn = min(r + 8, nrows - 1); const float* x = XF + (size_t)rn * D + lane * 4; nx0 = *(const float4*)(x); nx1 = *(const float4*)(x + 256); nx2 = *(const float4*)(x + 512); nx3 = *(const float4*)(x + 768); }
    float v[16]; float ss = 0.f;
    { const float4 t4[4] = {cx0, cx1, cx2, cx3};
#pragma unroll
    for (int j = 0; j < 4; ++j) { const float4 t = t4[j]; v[4 * j] = t.x; v[4 * j + 1] = t.y; v[4 * j + 2] = t.z; v[4 * j + 3] = t.w; ss += t.x * t.x + t.y * t.y + t.z * t.z + t.w * t.w; } }
    cx0 = nx0; cx1 = nx1; cx2 = nx2; cx3 = nx3;
    ss = seg_sum(ss, lane, 64);
    const float rstd = rsqrtf(ss * (1.f / D) + EPS);
    const float* md = MOD + ((size_t)l * 9 + modidx(r)) * 6144;
#pragma unroll
    for (int j = 0; j < 4; ++j) { const int c = j * 256 + lane * 4; const float4 gg = *(const float4*)(g + c), s4 = *(const float4*)(md + 4 * 1024 + c), h4 = *(const float4*)(md + 3 * 1024 + c);
      v[4 * j] = v[4 * j] * rstd * gg.x * (1.f + s4.x) + h4.x; v[4 * j + 1] = v[4 * j + 1] * rstd * gg.y * (1.f + s4.y) + h4.y;
      v[4 * j + 2] = v[4 * j + 2] * rstd * gg.z * (1.f + s4.z) + h4.z; v[4 * j + 3] = v[4 * j + 3] * rstd * gg.w * (1.f + s4.w) + h4.w;
      }
    { float mx = 0.f;
#pragma unroll
      for (int i = 0; i < 16; ++i) mx = fmaxf(mx, fabsf(v[i]));
#pragma unroll
      for (int o = 1; o < 64; o <<= 1) mx = fmaxf(mx, lane_xor(mx, lane, o));
      const float sc = mx > 0.f ? mx * (1.f / 127.f) : 1.f, inv = 1.f / sc; if (lane == 0) HS[r] = sc;
#pragma unroll
      for (int j = 0; j < 4; ++j) { unsigned b = 0;
#pragma unroll
        for (int i = 0; i < 4; ++i) b |= ((unsigned)(int)rintf(v[4 * j + i] * inv) & 255u) << (8 * i);
        *(unsigned*)((signed char*)H2 + (size_t)r * D + j * 256 + lane * 4) = b; } }
    float lg[NE];
#pragma unroll
    for (int e = 0; e < NE; ++e) { float s = 0.f;
#pragma unroll
      for (int j = 0; j < 4; ++j) { const float4 w = *(const float4*)(rwT + e * D + j * 256 + lane * 4); s += v[4 * j] * w.x + v[4 * j + 1] * w.y + v[4 * j + 2] * w.z + v[4 * j + 3] * w.w; }
      lg[e] = s; }
#pragma unroll
    for (int e = 0; e < NE; ++e) lg[e] = seg_sum(lg[e], lane, 64) + rb[e];
    int te[4]; float tv[4];
#pragma unroll
    for (int k = 0; k < 4; ++k) { float best = -3.4e38f; int bi = 0;
#pragma unroll
      for (int e = 0; e < NE; ++e) { const bool taken = (k > 0 && te[0] == e) || (k > 1 && te[1] == e) || (k > 2 && te[2] == e); if (!taken && lg[e] > best) { best = lg[e]; bi = e; } }
      te[k] = bi; tv[k] = best; }
    const float mx = tv[0]; float ex[4], se = 0.f;
#pragma unroll
    for (int k = 0; k < 4; ++k) { ex[k] = expf(tv[k] - mx); se += ex[k]; }
    if (lane == 0) { int* rt = rbuf + (r - rlo) * 12;
#pragma unroll
      for (int k = 0; k < 4; ++k) { rt[3 * k] = te[k]; rt[3 * k + 1] = (int)atomicAdd(&lcnt[te[k]], 1u); rt[3 * k + 2] = __float_as_int(ex[k] / se); } }
  }
  __syncthreads();
  if (tid_ < NE) lcnt[32 + tid_] = lcnt[tid_] ? atomicAdd(&cnt[tid_], lcnt[tid_]) : 0u;
  __syncthreads();
  for (int q = tid_; q < (rhi - rlo) * 4; q += 512) { const int lr = q >> 2, k = q & 3; const int* rt = rbuf + lr * 12 + 3 * k; int* o = ROUTE + ((size_t)(rlo + lr) * 4 + k) * 4;
    const int pos = rt[1] + (int)lcnt[32 + rt[0]];
    o[0] = rt[0]; o[1] = pos; o[2] = rt[2]; o[3] = 0; ROWTOK[(size_t)rt[0] * T + pos] = rlo + lr; }
}


namespace fa {
DI void expcvt(f32x16& p0, f32x16& p1, bf16x8& pa0, bf16x8& pa1, bf16x8& pa2, bf16x8& pa3) {
#pragma unroll
  for (int r = 0; r < 16; ++r) p0[r] = __builtin_amdgcn_exp2f(p0[r]);
#pragma unroll
  for (int r = 0; r < 16; ++r) p1[r] = __builtin_amdgcn_exp2f(p1[r]);
#define FA_PK4(P, BASE, OUT) do { unsigned a0 = cvtpk(P[BASE + 0], P[BASE + 1]), a1 = cvtpk(P[BASE + 2], P[BASE + 3]);   \
    unsigned b0 = cvtpk(P[BASE + 4], P[BASE + 5]), b1 = cvtpk(P[BASE + 6], P[BASE + 7]);                              \
    u32x4 w = {a0, a1, b0, b1}; OUT = *reinterpret_cast<bf16x8*>(&w); } while (0)
  FA_PK4(p0, 0, pa0); FA_PK4(p0, 8, pa1); FA_PK4(p1, 0, pa2); FA_PK4(p1, 8, pa3);
#undef FA_PK4
}
template <int ND0, int KST = 0>
DI void qkt2(f32x16& p0, f32x16& p1, const char* Ks, const bf16x8* qr, const f32x16& nbt, int r32, int hi) {
#pragma unroll
  for (int d0 = 0; d0 < ND0; ++d0) { const int cb = (d0 * 16 + hi * 8) * 2;
    bf16x8 b0 = *reinterpret_cast<const bf16x8*>(Ks + (KST ? r32 * KST + cb : FA_KSWZ(r32, cb)));
    bf16x8 b1 = *reinterpret_cast<const bf16x8*>(Ks + (KST ? (32 + r32) * KST + cb : FA_KSWZ(32 + r32, cb)));
    p0 = __builtin_amdgcn_mfma_f32_32x32x16_bf16(b0, qr[d0], d0 == 0 ? nbt : p0, 0, 0, 0);
    p1 = __builtin_amdgcn_mfma_f32_32x32x16_bf16(b1, qr[d0], d0 == 0 ? nbt : p1, 0, 0, 0); }
}
DI void pv3(f32x16* o, int vb, bf16x8 pa0, bf16x8 pa1, bf16x8 pa2, bf16x8 pa3) { pv_one<0>(o[0], vb, pa0, pa1, pa2, pa3); pv_one<1>(o[1], vb, pa0, pa1, pa2, pa3); pv_one<2>(o[2], vb, pa0, pa1, pa2, pa3); }
DI void fill_ones(char* V_lds, int tid) {
  const int b = tid >> 8, t = tid & 255, key = t >> 2, c8 = (t & 3) * 8;
  u32x4 w = {c8 == 0 ? 0x00003F80u : 0u, 0u, 0u, 0u};
  *(u32x4*)(V_lds + b * SHM_V + v_st(key, 64 + c8)) = w;
}
template <int DQK>
DI void attn_unit2(const bf16* __restrict__ Qb, int ldq, const bf16* __restrict__ Kh, int ldk, const bf16* __restrict__ Vh, const float* __restrict__ nbp, int nbs, int kva, int kvb, int NT,
                   bf16* __restrict__ Ob, int ldo, char* lds, int tid) {
  constexpr int ND0 = DQK / 16;
  const int wid = tid >> 6, lane = tid & 63, r32 = lane & 31, hi = lane >> 5;
  char* V_lds = lds; char* K_lds = lds + 2 * SHM_V;
  f32x16 o[3] = {}; bf16x8 qr[ND0];
  const bf16* Qw = Qb + (long)(wid * 32 + r32) * ldq + hi * 8;
#pragma unroll
  for (int d0 = 0; d0 < ND0; ++d0) qr[d0] = *reinterpret_cast<const bf16x8*>(Qw + d0 * 16);
  const float nb = nbp[(long)(wid * 32 + r32) * nbs];
  f32x16 nbt;
#pragma unroll
  for (int r = 0; r < 16; ++r) nbt[r] = nb;
  const int sr = tid >> 4, sc = (tid & 15) * 8; const bool kact = sc < DQK, vact = sc < 64;
  const int vst0 = v_st(sr, sc & 63), vst1 = v_st(32 + sr, sc & 63);
  const int vb0 = (int)(uintptr_t)V_lds + v_rd_base(lane);
  struct { bf16x8 vs0, vs1, ks0, ks1; } sr_[2];
#define FA_KROW(j) ((j) < 4 ? kva + 64 * (j) : kvb + 64 * ((j) - 4))
#define FA_SLOAD(i, j) do { const long kr_ = FA_KROW(j); \
    if (vact) { sr_[i].vs0 = *reinterpret_cast<const bf16x8*>(&Vh[(kr_ + sr) * 256 + sc]); sr_[i].vs1 = *reinterpret_cast<const bf16x8*>(&Vh[(kr_ + 32 + sr) * 256 + sc]); } \
    if (kact) { sr_[i].ks0 = *reinterpret_cast<const bf16x8*>(&Kh[(kr_ + sr) * ldk + sc]); sr_[i].ks1 = *reinterpret_cast<const bf16x8*>(&Kh[(kr_ + 32 + sr) * ldk + sc]); } } while (0)
#define FA_SWRITE(b, i) do { if (vact) { *(bf16x8*)(V_lds + (b) * SHM_V + vst0) = sr_[i].vs0; *(bf16x8*)(V_lds + (b) * SHM_V + vst1) = sr_[i].vs1; } \
    if (kact) { const int kc = sc * 2; *(bf16x8*)(K_lds + (b) * SHM_K + FA_KSWZ(sr, kc)) = sr_[i].ks0; *(bf16x8*)(K_lds + (b) * SHM_K + FA_KSWZ(32 + sr, kc)) = sr_[i].ks1; } } while (0)
  f32x16 pA0, pA1, pB0, pB1; bf16x8 pa0, pa1, pa2, pa3;
  FA_SLOAD(0, 0); asm volatile("s_waitcnt vmcnt(0)" ::: "memory"); FA_SWRITE(0, 0); __syncthreads();
  qkt2<ND0>(pA0, pA1, K_lds, qr, nbt, r32, hi);
  FA_SLOAD(1, 1); if (2 < NT) FA_SLOAD(0, 2);
  FA_SWRITE(1, 1); __syncthreads();
  for (int j = 1; j + 1 < NT; j += 2) {
    FA_SBAR(); qkt2<ND0>(pB0, pB1, K_lds + SHM_K, qr, nbt, r32, hi);
    expcvt(pA0, pA1, pa0, pa1, pa2, pa3); FA_SBAR();
    FA_SLOAD(1, j + 2); FA_SBAR();
    pv3(o, vb0, pa0, pa1, pa2, pa3);
    __syncthreads(); FA_SWRITE(0, 0); __syncthreads();
    FA_SBAR(); qkt2<ND0>(pA0, pA1, K_lds, qr, nbt, r32, hi);
    expcvt(pB0, pB1, pa0, pa1, pa2, pa3); FA_SBAR();
    if (j + 3 < NT) FA_SLOAD(0, j + 3); FA_SBAR();
    pv3(o, vb0 + SHM_V, pa0, pa1, pa2, pa3);
    __syncthreads(); FA_SWRITE(1, 1); __syncthreads();
  }
  FA_SBAR(); qkt2<ND0>(pB0, pB1, K_lds + SHM_K, qr, nbt, r32, hi);
  expcvt(pA0, pA1, pa0, pa1, pa2, pa3); FA_SBAR();
  pv3(o, vb0, pa0, pa1, pa2, pa3);
  expcvt(pB0, pB1, pa0, pa1, pa2, pa3); FA_SBAR();
  pv3(o, vb0 + SHM_V, pa0, pa1, pa2, pa3);
  bf16* Ow = Ob + (long)(wid * 32) * ldo;
#pragma unroll
  for (int r = 0; r < 16; ++r) { const int orow = crow(r, hi);
    const float lsum = __int_as_float(__builtin_amdgcn_ds_bpermute((hi * 32) << 2, __float_as_int(o[2][r]))); const float rl = __builtin_amdgcn_rcpf(lsum);
#pragma unroll
    for (int d0 = 0; d0 < 2; ++d0) Ow[(long)orow * ldo + d0 * 32 + r32] = f2bf(o[d0][r] * rl); }
  __syncthreads();
#undef FA_KROW
#undef FA_SLOAD
#undef FA_SWRITE
}
typedef float f32x2v __attribute__((ext_vector_type(2)));
typedef __bf16 bf16x2v __attribute__((ext_vector_type(2)));
DI unsigned cvtpk_b(float lo, float hi) { f32x2v v = {lo, hi}; bf16x2v b = __builtin_convertvector(v, bf16x2v); return __builtin_bit_cast(unsigned, b); }
DI void expcvt_b(f32x16& p0, f32x16& p1, bf16x8& pa0, bf16x8& pa1, bf16x8& pa2, bf16x8& pa3) {
#pragma unroll
  for (int r = 0; r < 16; ++r) p0[r] = __builtin_amdgcn_exp2f(p0[r]);
#pragma unroll
  for (int r = 0; r < 16; ++r) p1[r] = __builtin_amdgcn_exp2f(p1[r]);
#define FA_PK4(P, BASE, OUT) do { u32x4 w = {cvtpk_b(P[BASE + 0], P[BASE + 1]), cvtpk_b(P[BASE + 2], P[BASE + 3]), cvtpk_b(P[BASE + 4], P[BASE + 5]), cvtpk_b(P[BASE + 6], P[BASE + 7])}; \
    OUT = *reinterpret_cast<bf16x8*>(&w); } while (0)
  FA_PK4(p0, 0, pa0); FA_PK4(p0, 8, pa1); FA_PK4(p1, 0, pa2); FA_PK4(p1, 8, pa3);
#undef FA_PK4
}
template <int NM> DI void step_pipeline() {
  __builtin_amdgcn_sched_group_barrier(0x100, 4, 0);
#pragma unroll
  for (int i = 0; i < NM; ++i) {
    __builtin_amdgcn_sched_group_barrier(0x008, 1, 0);
    __builtin_amdgcn_sched_group_barrier(0x400, 2, 0);
    __builtin_amdgcn_sched_group_barrier(0x002, 2, 0);
    __builtin_amdgcn_sched_group_barrier(0x100, 2, 0);
  }
}
template <int OFF> DI s16x4 tr_rd(int vb) { return __builtin_amdgcn_ds_read_tr16_b64_v4i16((__attribute__((address_space(3))) s16x4*)(vb + OFF)); }
template <int D0> DI void pv_one_b(f32x16& od, int vb, bf16x8 pa0, bf16x8 pa1, bf16x8 pa2, bf16x8 pa3) {
  const s16x4 l0 = tr_rd<v_rd_off(D0, 0, 0)>(vb), h0 = tr_rd<v_rd_off(D0, 0, 1)>(vb), l1 = tr_rd<v_rd_off(D0, 1, 0)>(vb), h1 = tr_rd<v_rd_off(D0, 1, 1)>(vb);
  const s16x4 l2 = tr_rd<v_rd_off(D0, 2, 0)>(vb), h2 = tr_rd<v_rd_off(D0, 2, 1)>(vb), l3 = tr_rd<v_rd_off(D0, 3, 0)>(vb), h3 = tr_rd<v_rd_off(D0, 3, 1)>(vb);
#define FA_PK(L, H) (bf16x8){L[0], L[1], L[2], L[3], H[0], H[1], H[2], H[3]}
  od = __builtin_amdgcn_mfma_f32_32x32x16_bf16(pa0, FA_PK(l0, h0), od, 0, 0, 0);
  od = __builtin_amdgcn_mfma_f32_32x32x16_bf16(pa1, FA_PK(l1, h1), od, 0, 0, 0);
  od = __builtin_amdgcn_mfma_f32_32x32x16_bf16(pa2, FA_PK(l2, h2), od, 0, 0, 0);
  od = __builtin_amdgcn_mfma_f32_32x32x16_bf16(pa3, FA_PK(l3, h3), od, 0, 0, 0);
#undef FA_PK
}
DI void pv3b(f32x16* o, int vb, bf16x8 pa0, bf16x8 pa1, bf16x8 pa2, bf16x8 pa3, bf16x8 onesB) { pv_one_b<0>(o[0], vb, pa0, pa1, pa2, pa3); pv_one_b<1>(o[1], vb, pa0, pa1, pa2, pa3);
  o[2] = __builtin_amdgcn_mfma_f32_32x32x16_bf16(pa0, onesB, o[2], 0, 0, 0); o[2] = __builtin_amdgcn_mfma_f32_32x32x16_bf16(pa1, onesB, o[2], 0, 0, 0);
  o[2] = __builtin_amdgcn_mfma_f32_32x32x16_bf16(pa2, onesB, o[2], 0, 0, 0); o[2] = __builtin_amdgcn_mfma_f32_32x32x16_bf16(pa3, onesB, o[2], 0, 0, 0); }
#ifndef FS_SPREAD
#define FS_SPREAD 1
#endif
#ifndef FS_AH
#define FS_AH 2
#endif
template <int NM> constexpr int fs_ec(int s) { const int e = (FS_SPREAD && NM >= 24) ? s + (s + 2) / 3 : 2 * s; return e < 32 ? e : 32; }
template <int NM> constexpr int fs_cc(int s) { const int c = s >= 1 ? fs_ec<NM>(s - 1) / 2 : 0; return c < 16 ? c : 16; }
DI s16x4 tr_rd2(int vb, int off) { return __builtin_amdgcn_ds_read_tr16_b64_v4i16((__attribute__((address_space(3))) s16x4*)(vb + off)); }
template <int ND0, int WI, int KST = 0>
DI void fused_step(f32x16& pn0, f32x16& pn1, f32x16& pc0, f32x16& pc1, bf16x8& an0, bf16x8& an1, bf16x8& an2, bf16x8& an3, bf16x8 ac0, bf16x8 ac1, bf16x8 ac2, bf16x8 ac3,
                   f32x16* o, const char* Ks, int vb, const bf16x8* qr, const f32x16& nbt, int r32, int hi, bf16x8 onesB) {
  constexpr int NQ = 2 * ND0, NM = NQ + 12, AH = FS_AH;
  bf16x8 kf[NQ]; s16x4 vl[8], vh[8]; unsigned w[16];
  bf16x8 kz_; s16x4 vz_; if (WI & (4 | 16 | 32)) { asm volatile("v_mov_b32 %0, 0" : "=v"(vz_[0])); u32x4 z4_ = {0u, 0u, 0u, 0u}; asm volatile("" : "+v"(z4_)); kz_ = *reinterpret_cast<bf16x8*>(&z4_); vz_ = (s16x4){0, 0, 0, 0}; asm volatile("" : "+v"(vz_)); }
#define FS_ISSUE(m) do { if ((WI & 4) || ((WI & 16) && (m) < NQ) || ((WI & 32) && (m) >= NQ)) { if ((m) < NQ) kf[(m) < NQ ? (m) : 0] = kz_; else if ((m) - NQ < 8) { const int q_ = (m) - NQ; vl[q_ >= 0 ? q_ : 0] = vz_; vh[q_ >= 0 ? q_ : 0] = vz_; } } else if ((m) < NQ) { kf[(m) < NQ ? (m) : 0] = *reinterpret_cast<const bf16x8*>(Ks + (KST ? (((m) & 1) * 32 + r32) * KST + ((((m) >> 1) * 16 + hi * 8) * 2) : FA_KSWZ(((m) & 1) * 32 + r32, ((((m) >> 1) * 16 + hi * 8) * 2)))); } \
    else if ((m) - NQ < 8) { const int q_ = (m) - NQ; vl[q_ >= 0 ? q_ : 0] = tr_rd2(vb, v_rd_off(q_ >> 2, q_ & 3, 0)); vh[q_ >= 0 ? q_ : 0] = tr_rd2(vb, v_rd_off(q_ >> 2, q_ & 3, 1)); } } while (0)
#define FS_PC(v) ((v) < 16 ? pc0[(v) & 15] : pc1[(v) & 15])
#pragma unroll
  for (int m = 0; m < AH; ++m) FS_ISSUE(m);
#pragma unroll
  for (int s_ = 0; s_ < NM; ++s_) {
    if (s_ + AH < NM) FS_ISSUE(s_ + AH);
    if (s_ < NQ) { const int d0 = s_ >> 1;
      if ((s_ & 1) == 0) pn0 = __builtin_amdgcn_mfma_f32_32x32x16_bf16(kf[s_ < NQ ? s_ : 0], qr[d0 < ND0 ? d0 : 0], d0 == 0 ? nbt : pn0, 0, 0, 0);
      else pn1 = __builtin_amdgcn_mfma_f32_32x32x16_bf16(kf[s_ < NQ ? s_ : 0], qr[d0 < ND0 ? d0 : 0], d0 == 0 ? nbt : pn1, 0, 0, 0);
    } else { const int q = s_ - NQ, blk = q >> 2, ks = q & 3; const int qi = (q >= 0 && q < 8) ? q : 0; const s16x4 L = vl[qi], H = vh[qi];
      const bf16x8 B = blk == 2 ? onesB : (bf16x8){L[0], L[1], L[2], L[3], H[0], H[1], H[2], H[3]};       const bf16x8 A = ks == 0 ? ac0 : (ks == 1 ? ac1 : (ks == 2 ? ac2 : ac3));
      o[blk >= 0 ? blk : 0] = __builtin_amdgcn_mfma_f32_32x32x16_bf16(A, B, o[blk >= 0 ? blk : 0], 0, 0, 0); }
#pragma unroll
    for (int v = fs_ec<NM>(s_); v < ((WI & 2) ? 0 : fs_ec<NM>(s_ + 1)); ++v) { float e0 = FS_PC(v); asm volatile("" : "+v"(e0)); e0 = __builtin_amdgcn_exp2f(e0); asm volatile("" : "+v"(e0));
      if (v < 16) pc0[v & 15] = e0; else pc1[v & 15] = e0; }
#pragma unroll
    for (int k = fs_cc<NM>(s_); k < ((WI & 2) ? 0 : fs_cc<NM>(s_ + 1)); ++k) { unsigned wk = cvtpk_b(FS_PC(2 * k), FS_PC(2 * k + 1)); asm volatile("" : "+v"(wk)); w[k & 15] = wk; }
    FA_SBAR();
  }
#pragma unroll
  for (int k = fs_cc<NM>(NM); k < ((WI & 2) ? 0 : 16); ++k) w[k] = cvtpk_b(FS_PC(2 * k), FS_PC(2 * k + 1));
  if (WI & 2) { an0 = ac0; an1 = ac1; an2 = ac2; an3 = ac3; } else
  { u32x4 t0 = {w[0], w[1], w[2], w[3]}, t1 = {w[4], w[5], w[6], w[7]}, t2 = {w[8], w[9], w[10], w[11]}, t3 = {w[12], w[13], w[14], w[15]};
    an0 = *reinterpret_cast<bf16x8*>(&t0); an1 = *reinterpret_cast<bf16x8*>(&t1); an2 = *reinterpret_cast<bf16x8*>(&t2); an3 = *reinterpret_cast<bf16x8*>(&t3); }
#undef FS_ISSUE
#undef FS_PC
}
template <int DQK, int WI>
DI void attn_unit3(const bf16* __restrict__ Qb, int ldq, const bf16* __restrict__ Kh, int ldk, const bf16* __restrict__ Vh, const float* __restrict__ nbp, int nbs, int kva, int kvb, int NT,
                   bf16* __restrict__ Ob, int ldo, char* lds, int tid) {
  constexpr int ND0 = DQK / 16;
  const int wid = tid >> 6, lane = tid & 63, r32 = lane & 31, hi = lane >> 5;
  char* V_lds = lds; char* K_lds = lds + 2 * SHM_V;
  f32x16 o[3] = {}; bf16x8 qr[ND0];
  const bf16* Qw = Qb + (long)(wid * 32 + r32) * ldq + hi * 8;
#pragma unroll
  for (int d0 = 0; d0 < ND0; ++d0) qr[d0] = *reinterpret_cast<const bf16x8*>(Qw + d0 * 16);
  const float nb = nbp[(long)(wid * 32 + r32) * nbs];
  f32x16 nbt;
#pragma unroll
  for (int r = 0; r < 16; ++r) nbt[r] = nb;
  const int sr = tid >> 4, sc = (tid & 15) * 8; const bool kact = sc < DQK, vact = sc < 64;
  const int vst0 = v_st(sr, sc & 63), vst1 = v_st(32 + sr, sc & 63);
  const int vb0 = (int)(uintptr_t)V_lds + v_rd_base(lane);
  bf16x8 vs0, vs1, ks0, ks1;
#define FA_KROW(j) ((j) < 4 ? kva + 64 * (j) : kvb + 64 * ((j) - 4))
#define FA_LOADK(j) do { if (kact) { const long kr_ = FA_KROW(j); ks0 = *reinterpret_cast<const bf16x8*>(&Kh[(kr_ + sr) * ldk + sc]); ks1 = *reinterpret_cast<const bf16x8*>(&Kh[(kr_ + 32 + sr) * ldk + sc]); } } while (0)
#define FA_LOADV(j) do { if (vact) { const long kr_ = FA_KROW(j); vs0 = *reinterpret_cast<const bf16x8*>(&Vh[(kr_ + sr) * 256 + sc]); vs1 = *reinterpret_cast<const bf16x8*>(&Vh[(kr_ + 32 + sr) * 256 + sc]); } } while (0)
#define FA_WRITEK(b) do { if (kact) { const int kc = sc * 2; *(bf16x8*)(K_lds + (b) * SHM_K + FA_KSWZ(sr, kc)) = ks0; *(bf16x8*)(K_lds + (b) * SHM_K + FA_KSWZ(32 + sr, kc)) = ks1; } } while (0)
#define FA_WRITEV(b) do { if (vact) { *(bf16x8*)(V_lds + (b) * SHM_V + vst0) = vs0; *(bf16x8*)(V_lds + (b) * SHM_V + vst1) = vs1; } } while (0)
  f32x16 pE0, pE1, pO0, pO1; bf16x8 ae0, ae1, ae2, ae3, ao0, ao1, ao2, ao3;
  bf16x8 onesB; { const unsigned ov = r32 == 0 ? 0x3F803F80u : 0u; u32x4 t = {ov, ov, ov, ov}; onesB = *reinterpret_cast<bf16x8*>(&t); }
  FA_LOADK(0); asm volatile("s_waitcnt vmcnt(0)" ::: "memory"); FA_WRITEK(0); __syncthreads();
  FA_LOADK(1);
  qkt2<ND0>(pE0, pE1, K_lds, qr, nbt, r32, hi);
  __syncthreads(); FA_WRITEK(1); __syncthreads(); FA_LOADK(2); FA_LOADV(0);
  FA_SBAR(); qkt2<ND0>(pO0, pO1, K_lds + SHM_K, qr, nbt, r32, hi); expcvt(pE0, pE1, ae0, ae1, ae2, ae3); FA_SBAR();
  __syncthreads(); FA_WRITEK(0); FA_WRITEV(0); __syncthreads(); if (3 < NT) FA_LOADK(3); FA_LOADV(1);
#define FA_SY() do { if (!(WI & 1)) __syncthreads(); } while (0)
#define FA_IO(x) do { if (!(WI & 8)) { x; } } while (0)
  for (int j = 1; j + 2 < NT; j += 2) {
    FA_SBAR(); asm volatile("" : "+v"(pO0), "+v"(pO1));
    fused_step<ND0, WI>(pE0, pE1, pO0, pO1, ao0, ao1, ao2, ao3, ae0, ae1, ae2, ae3, o, K_lds, vb0, qr, nbt, r32, hi, onesB);
    FA_SY(); FA_IO(FA_WRITEK(1); FA_WRITEV(1)); FA_SY(); FA_IO(if (j + 3 < NT) FA_LOADK(j + 3); FA_LOADV(j + 1));
    FA_SBAR(); asm volatile("" : "+v"(pE0), "+v"(pE1));
    fused_step<ND0, WI>(pO0, pO1, pE0, pE1, ae0, ae1, ae2, ae3, ao0, ao1, ao2, ao3, o, K_lds + SHM_K, vb0 + SHM_V, qr, nbt, r32, hi, onesB);
    FA_SY(); FA_IO(if (j + 3 < NT) FA_WRITEK(0); FA_WRITEV(0)); FA_SY(); FA_IO(if (j + 4 < NT) FA_LOADK(j + 4); if (j + 2 < NT) FA_LOADV(j + 2));
  }
#undef FA_SY
#undef FA_IO
  FA_SBAR(); expcvt(pO0, pO1, ao0, ao1, ao2, ao3); pv3b(o, vb0, ae0, ae1, ae2, ae3, onesB); FA_SBAR();
  __syncthreads(); FA_WRITEV(1); __syncthreads();
  pv3b(o, vb0 + SHM_V, ao0, ao1, ao2, ao3, onesB);
  bf16* Ow = Ob + (long)(wid * 32) * ldo;
#pragma unroll
  for (int r = 0; r < 16; ++r) { const int orow = crow(r, hi);
    const float lsum = __int_as_float(__builtin_amdgcn_ds_bpermute((hi * 32) << 2, __float_as_int(o[2][r]))); const float rl = __builtin_amdgcn_rcpf(lsum);
#pragma unroll
    for (int d0 = 0; d0 < 2; ++d0) Ow[(long)orow * ldo + d0 * 32 + r32] = f2bf(o[d0][r] * rl); }
  __syncthreads();
#undef FA_KROW
#undef FA_LOADK
#undef FA_LOADV
#undef FA_WRITEK
#undef FA_WRITEV
}
template <int DQK>
DI void attn_unit4(const bf16* __restrict__ Qb, int ldq, const bf16* __restrict__ Kh, int ldk, const bf16* __restrict__ Vh, const float* __restrict__ nbp, int nbs, int kva, int kvb, int NT,
                   bf16* __restrict__ Ob, int ldo, char* lds, int tid, bool prefetched, const bf16* Knext) {
  constexpr int ND0 = DQK / 16, CPR = DQK / 8 + 1, KST = CPR * 16, KSZ = 64 * KST;
  const int wid = __builtin_amdgcn_readfirstlane(tid >> 6), lane = tid & 63, r32 = lane & 31, hi = lane >> 5;
  char* V_lds = lds; char* K_lds = lds + 3 * SHM_V;
  f32x16 o[3] = {}; bf16x8 qr[ND0];
  const bf16* Qw = Qb + (long)(wid * 32 + r32) * ldq + hi * 8;
#pragma unroll
  for (int d0 = 0; d0 < ND0; ++d0) qr[d0] = *reinterpret_cast<const bf16x8*>(Qw + d0 * 16);
  const float nb = nbp[(long)(wid * 32 + r32) * nbs];
  f32x16 nbt;
#pragma unroll
  for (int r = 0; r < 16; ++r) nbt[r] = nb;
  const int vb0 = (int)(uintptr_t)V_lds + v_rd_base(lane);
  bf16x8 onesB; { const unsigned ov = r32 == 0 ? 0x3F803F80u : 0u; u32x4 t = {ov, ov, ov, ov}; onesB = *reinterpret_cast<bf16x8*>(&t); }
  unsigned kof0, kof1, vof;
  { const int c0 = 64 * wid + lane, c1 = c0 + 512; const int ra = c0 / CPR, ca = c0 - ra * CPR, rb = c1 / CPR, cb = c1 - rb * CPR;
    kof0 = (unsigned)(ra * ldk + (ca < CPR - 1 ? ca : 0) * 8) * 2u; kof1 = (unsigned)(rb * ldk + (cb < CPR - 1 ? cb : 0) * 8) * 2u;
    vof = (unsigned)((wid * 8 + ((lane & 31) >> 2)) * 256 + (lane >> 5) * 32 + (lane & 3) * 8) * 2u; }
  const bool k0act = wid < CPR, k1act = wid + 8 < CPR;
  const unsigned kl0 = (unsigned)(uintptr_t)K_lds + (unsigned)wid * 1024u, vl0 = (unsigned)(uintptr_t)V_lds + (unsigned)wid * 2048u;
#define FA_LAS __attribute__((address_space(3)))
#define FA_KROW(j) ((j) < 4 ? kva + 64 * (j) : kvb + 64 * ((j) - 4))
#define FA_DMAK(t, slot) do { const char* kb_ = (const char*)(Kh + (long)FA_KROW(t) * ldk); const unsigned kd_ = kl0 + (unsigned)(slot) * (unsigned)KSZ; \
    if (k0act) __builtin_amdgcn_global_load_lds((const unsigned*)(kb_ + kof0), (FA_LAS unsigned*)kd_, 16, 0, 0); \
    if (k1act) __builtin_amdgcn_global_load_lds((const unsigned*)(kb_ + kof1), (FA_LAS unsigned*)(kd_ + 8192u), 16, 0, 0); } while (0)
#define FA_DMAV(t, slot) do { const char* vb_ = (const char*)(Vh + (long)FA_KROW(t) * 256); \
    __builtin_amdgcn_global_load_lds((const unsigned*)(vb_ + vof), (FA_LAS unsigned*)(vl0 + (unsigned)(slot) * (unsigned)SHM_V), 16, 0, 0); } while (0)
#define FA_NX(s) ((s) == 2 ? 0 : (s) + 1)
#define FA_END(n) do { asm volatile("s_waitcnt vmcnt(" #n ")" ::: "memory"); __builtin_amdgcn_s_barrier(); } while (0)
  f32x16 pE0, pE1, pO0, pO1; bf16x8 ae0, ae1, ae2, ae3, ao0, ao1, ao2, ao3;
  if (!prefetched) { FA_DMAK(0, 0); FA_DMAK(1, 1); }
  FA_END(0);
#pragma unroll
  for (int d0 = 0; d0 < ND0; ++d0) asm volatile("" : "+v"(qr[d0]));
  asm volatile("" : "+v"(nbt));
  if (2 < NT) FA_DMAK(2, 2); FA_DMAV(0, 0);
  qkt2<ND0, KST>(pE0, pE1, K_lds, qr, nbt, r32, hi);
  FA_END(1);
  if (3 < NT) FA_DMAK(3, 0); FA_DMAV(1, 1);
  FA_SBAR(); qkt2<ND0, KST>(pO0, pO1, K_lds + KSZ, qr, nbt, r32, hi); expcvt(pE0, pE1, ae0, ae1, ae2, ae3); FA_SBAR();
  FA_END(1);
  int sj = 1;
  for (int j = 1; j + 2 < NT; j += 2) {
    { const int s1 = FA_NX(sj), s2 = FA_NX(s1);
      if (j + 3 < NT) FA_DMAK(j + 3, sj); FA_DMAV(j + 1, s1);
      FA_SBAR(); asm volatile("" : "+v"(pO0), "+v"(pO1));
      fused_step<ND0, 0, KST>(pE0, pE1, pO0, pO1, ao0, ao1, ao2, ao3, ae0, ae1, ae2, ae3, o, K_lds + s1 * KSZ, vb0 + s2 * SHM_V, qr, nbt, r32, hi, onesB);
      FA_END(1); sj = s1; }
    { const int s1 = FA_NX(sj), s2 = FA_NX(s1);
      if (j + 4 < NT) FA_DMAK(j + 4, sj); if (j + 2 < NT) FA_DMAV(j + 2, s1);
      FA_SBAR(); asm volatile("" : "+v"(pE0), "+v"(pE1));
      fused_step<ND0, 0, KST>(pO0, pO1, pE0, pE1, ae0, ae1, ae2, ae3, ao0, ao1, ao2, ao3, o, K_lds + s1 * KSZ, vb0 + s2 * SHM_V, qr, nbt, r32, hi, onesB);
      FA_END(1); sj = s1; }
  }
  { const int s2 = FA_NX(FA_NX(sj));
    if (Knext) { const char* kb_ = (const char*)Knext;
      if (k0act) __builtin_amdgcn_global_load_lds((const unsigned*)(kb_ + kof0), (FA_LAS unsigned*)kl0, 16, 0, 0);
      if (k1act) __builtin_amdgcn_global_load_lds((const unsigned*)(kb_ + kof1), (FA_LAS unsigned*)(kl0 + 8192u), 16, 0, 0);
      kb_ += (size_t)64 * ldk * 2;
      if (k0act) __builtin_amdgcn_global_load_lds((const unsigned*)(kb_ + kof0), (FA_LAS unsigned*)(kl0 + (unsigned)KSZ), 16, 0, 0);
      if (k1act) __builtin_amdgcn_global_load_lds((const unsigned*)(kb_ + kof1), (FA_LAS unsigned*)(kl0 + (unsigned)KSZ + 8192u), 16, 0, 0); }
    FA_SBAR(); expcvt(pO0, pO1, ao0, ao1, ao2, ao3); pv3b(o, vb0 + s2 * SHM_V, ae0, ae1, ae2, ae3, onesB); FA_SBAR();
    if (!Knext || !k0act) { FA_END(0); } else if (k1act) { FA_END(4); } else { FA_END(2); }
    sj = FA_NX(sj); }
  { const int s2 = FA_NX(FA_NX(sj)); pv3b(o, vb0 + s2 * SHM_V, ao0, ao1, ao2, ao3, onesB); }
  bf16* Ow = Ob + (long)(wid * 32) * ldo;
#pragma unroll
  for (int r = 0; r < 16; ++r) { const int orow = crow(r, hi);
    const float lsum = __int_as_float(__builtin_amdgcn_ds_bpermute((hi * 32) << 2, __float_as_int(o[2][r]))); const float rl = __builtin_amdgcn_rcpf(lsum);
#pragma unroll
    for (int d0 = 0; d0 < 2; ++d0) Ow[(long)orow * ldo + d0 * 32 + r32] = f2bf(o[d0][r] * rl); }
  __syncthreads();
#undef FA_KROW
#undef FA_DMAK
#undef FA_DMAV
#undef FA_NX
#undef FA_END
}
}

template <int DQK, int WI = 0>
DI void ph_attn_fast2(const bf16* Q, const bf16* K, const bf16* V, const float* QB, int nhv, int vdiv, bf16* O, int ldo, int ooff, int qbase, int nq_per_b, bool with_latent, unsigned char* lds) {
  const int tid_ = opq_tid(); const int bid_ = opq_bid(), nblk_ = opq_nblk();
  const int chunks = nq_per_b / 256, npairs = NB * nhv, nunits = npairs * chunks;
  const bool xmap = (nblk_ == 256) && (chunks == 16);
#define AT_DECODE(i, ok, pair, ch) do { if (xmap) { const int v = (i) * 32 + (bid_ >> 3); ok = v < nhv * 16; pair = (v >> 4) * 8 + (bid_ & 7); ch = v & 15; } \
    else { const int u = (i) * nblk_ + bid_; ok = u < nunits; pair = u / chunks; ch = u - pair * chunks; } } while (0)
  bool ok, pre = false; int pair, ch;
  AT_DECODE(0, ok, pair, ch);
  for (int i = 0; ok; ++i) {
    bool okn; int pairn, chn;
    AT_DECODE(i + 1, okn, pairn, chn); (void)chn;
    const int b = pair / nhv, hv = pair - b * nhv;
    const int r0 = qbase + b * nq_per_b + ch * 256;
    int tu_ = tid_; asm volatile("" : "+v"(tu_));
    if constexpr (WI == 0) {
      const int bn = pairn / nhv, hvn = pairn - bn * nhv;
      const bf16* Kn = okn ? K + hvn * DQK + (size_t)(TL + bn * CTX) * (nhv * DQK) : nullptr;
      fa::attn_unit4<DQK>(Q + (size_t)r0 * (nhv * DQK) + hv * DQK, nhv * DQK, K + hv * DQK, nhv * DQK, V + (hv / vdiv) * 64, QB + (size_t)r0 * nhv + hv, nhv, TL + b * CTX, b * SEQ, with_latent ? 68 : 4,
                        O + (size_t)r0 * ldo + ooff + hv * 64, ldo, (char*)lds, tu_, pre, Kn);
      pre = okn;
    } else {
      fa::attn_unit3<DQK, WI>(Q + (size_t)r0 * (nhv * DQK) + hv * DQK, nhv * DQK, K + hv * DQK, nhv * DQK, V + (hv / vdiv) * 64, QB + (size_t)r0 * nhv + hv, nhv, TL + b * CTX, b * SEQ, with_latent ? 68 : 4,
                        O + (size_t)r0 * ldo + ooff + hv * 64, ldo, (char*)lds, tu_);
    }
    ok = okn; pair = pairn; ch = chn;
  }
#undef AT_DECODE
}

DI void ph_na_fast2(PRef p, int l, unsigned char* lds8) {
  using namespace fa;
  const int tid_ = opq_tid(); const int bid_ = opq_bid(), nblk_ = opq_nblk();
  char* lds = (char*)lds8;
  const bf16* __restrict__ Q = (const bf16*)(p.ws + WS_NQ); const bf16* __restrict__ K = (const bf16*)(p.ws + WS_NK); const bf16* __restrict__ V = (const bf16*)(p.ws + WS_NV); bf16* __restrict__ BI = (bf16*)(p.ws + WS_BI);
  const float* __restrict__ QB = (const float*)(p.ws + WS_QBN);
  const float* rpb = p.in[I_RPB] + (size_t)l * NH * 15 * 31;
  const int wid = __builtin_amdgcn_readfirstlane(tid_ >> 6), lane = tid_ & 63, r32 = lane & 31, hi = lane >> 5;
  char* V_lds = lds; char* K_lds = lds + 2 * SHM_V;
  float* tbl = (float*)(lds + 2 * SHM_V + 2 * SHM_K + 2048);
  bf16x8 onesB; { const unsigned ov = r32 == 0 ? 0x3F803F80u : 0u; u32x4 t = {ov, ov, ov, ov}; onesB = *reinterpret_cast<bf16x8*>(&t); }
  const int sr = tid_ >> 4, sc = (tid_ & 15) * 8; const bool act = sc < 64;
  const int vst0 = v_st(sr, sc & 63), vst1 = v_st(32 + sr, sc & 63);
  const int vb0 = (int)(uintptr_t)V_lds + v_rd_base(lane);
  const bool xmap = (nblk_ == 256);
  for (int i = 0;; ++i) {
    int pair, g;
    if (xmap) { const int v = i * 32 + (bid_ >> 3); if (v >= 64) break; pair = (v >> 4) * 8 + (bid_ & 7); g = v & 15; }
    else { const int u = i * nblk_ + bid_; if (u >= NB * NH * 16) break; pair = u >> 4; g = u & 15; }
    const int b = pair >> 2, h = pair & 3;
    for (int k = tid_; k < 15 * 32; k += 512) { const int ii = k >> 5, jj = k & 31; tbl[k] = jj < 31 ? rpb[(h * 15 + ii) * 31 + jj] * LOG2E : 0.f; }
    const int lo = min(max(4 * g - 4, 0), 56), hiR = min(max(4 * g + 3 - 4, 0), 56) + 7, NT = 4 + (hiR - lo + 1);
    const int qrow = 4 * g + (wid >> 1), rs_w = min(max(qrow - 4, 0), 56), qc = 32 * (wid & 1) + r32, ws0 = min(max(qc - 8, 0), 48);
    const int r0 = b * SEQ + g * 256;
    const bf16* Kh = K + h * 64; const bf16* Vh = V + h * 64;
    unsigned vmask = 0u;
#pragma unroll
    for (int r = 0; r < 16; ++r) { const int kc = crow(r, hi); vmask |= ((unsigned)(kc - ws0) < 16u ? 1u : 0u) << r; vmask |= ((unsigned)(kc + 32 - ws0) < 16u ? 1u : 0u) << (16 + r); }
    const int bbase = 4 * hi - qc + 15;
    f32x16 o[3] = {}; bf16x8 qr[4];
    const bf16* Qw = Q + (size_t)(r0 + wid * 32 + r32) * 256 + h * 64 + hi * 8;
#pragma unroll
    for (int d0 = 0; d0 < 4; ++d0) qr[d0] = *reinterpret_cast<const bf16x8*>(Qw + d0 * 16);
    const float nb = QB[(size_t)(r0 + wid * 32 + r32) * 4 + h];
    f32x16 nbt;
#pragma unroll
    for (int r = 0; r < 16; ++r) nbt[r] = nb;
    bf16x8 vs0, vs1, ks0, ks1;
#define NA_KROW(j) ((j) < 4 ? TL + b * CTX + 64 * (j) : b * SEQ + (lo + (j) - 4) * 64)
#define NA_SLOAD(j) do { if (act) { const long kr_ = NA_KROW(j); vs0 = *reinterpret_cast<const bf16x8*>(&Vh[(kr_ + sr) * 256 + sc]); vs1 = *reinterpret_cast<const bf16x8*>(&Vh[(kr_ + 32 + sr) * 256 + sc]); \
      ks0 = *reinterpret_cast<const bf16x8*>(&Kh[(kr_ + sr) * 256 + sc]); ks1 = *reinterpret_cast<const bf16x8*>(&Kh[(kr_ + 32 + sr) * 256 + sc]); } } while (0)
#define NA_SWRITE(bb) do { if (act) { *(bf16x8*)(V_lds + (bb) * SHM_V + vst0) = vs0; *(bf16x8*)(V_lds + (bb) * SHM_V + vst1) = vs1; const int kc_ = sc * 2; \
      *(bf16x8*)(K_lds + (bb) * SHM_K + FA_KSWZ(sr, kc_)) = ks0; *(bf16x8*)(K_lds + (bb) * SHM_K + FA_KSWZ(32 + sr, kc_)) = ks1; } } while (0)
    NA_SLOAD(0); NA_SWRITE(0); __syncthreads();
    for (int j = 0; j < NT; ++j) {
      const int bb = j & 1;
      if (j + 1 < NT) NA_SLOAD(j + 1);
      const int kr = lo + j - 4;
      const bool wvalid = (j < 4) || (kr >= rs_w && kr < rs_w + 8);
      if (wvalid) {
        f32x16 p0, p1; bf16x8 pa0, pa1, pa2, pa3;
        qkt2<4>(p0, p1, K_lds + bb * SHM_K, qr, nbt, r32, hi);
        if (j >= 4) {
          const float* brow = tbl + (kr - qrow + 7) * 32 + bbase;
#pragma unroll
          for (int r = 0; r < 16; ++r) { const int co = (r & 3) + 8 * (r >> 2);
            p0[r] = ((vmask >> r) & 1u) ? p0[r] + brow[co] : -1e30f; p1[r] = ((vmask >> (16 + r)) & 1u) ? p1[r] + brow[co + 32] : -1e30f; }
        }
        expcvt_b(p0, p1, pa0, pa1, pa2, pa3);
        pv3b(o, vb0 + bb * SHM_V, pa0, pa1, pa2, pa3, onesB);
      }
      if (j + 1 < NT) NA_SWRITE(bb ^ 1);
      __syncthreads();
    }
    bf16* Ow = BI + (size_t)(r0 + wid * 32) * D + 768 + h * 64;
#pragma unroll
    for (int r = 0; r < 16; ++r) { const int orow = crow(r, hi);
      const float lsum = __int_as_float(__builtin_amdgcn_ds_bpermute((hi * 32) << 2, __float_as_int(o[2][r]))); const float rl = __builtin_amdgcn_rcpf(lsum);
#pragma unroll
      for (int d0 = 0; d0 < 2; ++d0) Ow[(size_t)orow * D + d0 * 32 + r32] = f2bf(o[d0][r] * rl); }
    __syncthreads();
#undef NA_KROW
#undef NA_SLOAD
#undef NA_SWRITE
  }
}

#define LAS __attribute__((address_space(3)))
#define XB_TMO      128
#define XB_XCNT(j)  (256  + 64 * (j))
#define XB_XSUB(j)  (1280 + 64 * (j))
#define XB_XGEN(j)  (2304 + 64 * (j))
#define XB_TOP      3328
#define XB_TOPGEN   3392
#define XCD_BAR_WORDS 3456
#define XB_SPIN_CAP (1u << 24)
__device__ __forceinline__ unsigned xb_ld(unsigned* p)              { return __hip_atomic_load(p, __ATOMIC_RELAXED, __HIP_MEMORY_SCOPE_AGENT); }
__device__ __forceinline__ unsigned xb_add(unsigned* p, unsigned v) { return __hip_atomic_fetch_add(p, v, __ATOMIC_RELAXED, __HIP_MEMORY_SCOPE_AGENT); }
__device__ __forceinline__ unsigned xb_xcc_id() { return (unsigned)__builtin_amdgcn_s_getreg((3 << 11) | 20) & 0xFu; }
#define XB_SPIN(cond, bar) do { unsigned _sp = 0; while (cond) { __builtin_amdgcn_s_sleep(1); \
    if ((++_sp & 255u) == 0u) { if (xb_ld(&(bar)[XB_TMO])) break; if (_sp > XB_SPIN_CAP) { atomicAdd(&(bar)[XB_TMO], 1u); break; } } } } while (0)
struct XcdBarrier { unsigned* bar; unsigned x; volatile LAS unsigned* st; };
__device__ __forceinline__ XcdBarrier xcd_barrier_post(unsigned* bar, volatile LAS unsigned* st) {
    XcdBarrier b; b.bar = bar; b.x = xb_xcc_id(); b.st = st;
    if (threadIdx.x == 0) (void)xb_add(&bar[XB_XCNT(b.x)], 1u);
    return b;
}
__device__ __forceinline__ void xcd_barrier_complete(unsigned* bar, unsigned x, unsigned& nloc, unsigned& nx) {
    const unsigned G = gridDim.x * gridDim.y * gridDim.z;
    unsigned sum, cnt, mine, sp = 0u;
    for (;;) {
        sum = 0u; cnt = 0u; mine = 0u;
#pragma unroll
        for (unsigned j = 0; j < 16; ++j) { const unsigned c = xb_ld(&bar[XB_XCNT(j)]); sum += c; cnt += (c > 0u) ? 1u : 0u; }
        mine = xb_ld(&bar[XB_XCNT(x)]);
        if (sum == G) break;
        __builtin_amdgcn_s_sleep(1);
        if ((++sp & 255u) == 0u) { if (xb_ld(&bar[XB_TMO])) break; if (sp > XB_SPIN_CAP) { atomicAdd(&bar[XB_TMO], 1u); break; } }
    }
    nloc = mine > 0u ? mine : 1u; nx = cnt > 0u ? cnt : 1u;
}
__device__ __forceinline__ void xcd_barrier(const XcdBarrier& b) {
    asm volatile("s_waitcnt vmcnt(0)" ::: "memory");
    __syncthreads();
    if (threadIdx.x == 0) {
        unsigned* bar = b.bar; unsigned bx = b.x; asm volatile("" : "+s"(bar), "+s"(bx));
        __builtin_amdgcn_s_waitcnt(0);
        unsigned nloc = b.st[0], nx = b.st[1];
        if (nloc == 0u) { xcd_barrier_complete(bar, bx, nloc, nx); b.st[0] = nloc; b.st[1] = nx; }
        const unsigned old = xb_add(&bar[XB_XSUB(bx)], 1u);
        const unsigned gen = old / nloc;
        if (old + 1u == (gen + 1u) * nloc) {
            __builtin_amdgcn_fence(__ATOMIC_RELEASE, "agent");
            asm volatile("s_waitcnt vmcnt(0)" ::: "memory");
            const unsigned og = xb_add(&bar[XB_TOP], 1u);
            const unsigned tg = og / nx;
            if (og + 1u == (tg + 1u) * nx) xb_add(&bar[XB_TOPGEN], 1u);
            else XB_SPIN(xb_ld(&bar[XB_TOPGEN]) == tg, bar);
            __builtin_amdgcn_fence(__ATOMIC_ACQUIRE, "agent");
            xb_add(&bar[XB_XGEN(bx)], 1u);
            asm volatile("s_waitcnt vmcnt(0)" ::: "memory");
        } else {
            XB_SPIN(xb_ld(&bar[XB_XGEN(bx)]) == gen, bar);
            __builtin_amdgcn_fence(__ATOMIC_ACQUIRE, "agent");
            asm volatile("s_waitcnt vmcnt(0)" ::: "memory");
        }
    }
    __syncthreads();
}

constexpr int LDS_BYTES = 147456;
constexpr int BARW_OFF = 131072 + 512;
constexpr int CW_BAR = 4096;

#ifndef ATTN_V2
#define ATTN_V2 1
#endif
#ifndef REP_GEMM
#define REP_GEMM 1
#endif
#ifndef REP_ATTN
#define REP_ATTN 1
#endif
#ifndef REP_SMALL
#define REP_SMALL 1
#endif
#ifndef REP_CVT
#define REP_CVT 1
#endif
#ifndef REP_MD
#define REP_MD 1
#endif
#ifndef FA_WI
#define FA_WI 0
#endif
#define REPEAT_L(n, stmt) do { if ((n) == 1) { stmt; } else { int n_ = (n); asm volatile("" : "+s"(n_)); for (int rep_ = 0; rep_ < n_; ++rep_) { stmt; __syncthreads(); } } } while (0)
#define REPEAT(n, stmt) do { _Pragma("unroll") for (int rep_ = 0; rep_ < (n); ++rep_) { stmt; if ((n) > 1) __syncthreads(); } } while (0)
template <int l>
DI void layer_program(const XcdBarrier& bar, unsigned char* lds) {
#define GBAR() xcd_barrier(bar)
    const bool last = (l == 1);
    const int nrows = last ? TL : T;
    const float lam_init = last ? 0.35550906759096924f : 0.2f;
    if (l == 0) { REPEAT(REP_SMALL, ph_mod1(PP, l)); GBAR(); }
    REPEAT(REP_GEMM, ph_proj_fast(PP, l, lds));
    GBAR();
    REPEAT(REP_GEMM, ph_qkvraw_fast(PP, l, lds));
    REPEAT(REP_SMALL, ph_conv(PP, l, nrows, lds));
    GBAR();
#if ATTN_V2
#if REP_MD > 1
    { int n_ = REP_MD; asm volatile("" : "+s"(n_)); for (int rep_ = 0; rep_ < n_ - 1; ++rep_) { ph_attn_fast2<96, FA_WI>((const bf16*)(PP.ws + WS_MQ), (const bf16*)(PP.ws + WS_MK), (const bf16*)(PP.ws + WS_MV), (const float*)(PP.ws + WS_QBM), 4, 1, (bf16*)(PP.ws + WS_BI), D, 256, 0, SEQ, true, lds); __syncthreads(); ph_attn_fast2<32, FA_WI>((const bf16*)(PP.ws + WS_DQ), (const bf16*)(PP.ws + WS_DK), (const bf16*)(PP.ws + WS_DV), (const float*)(PP.ws + WS_QBD), 8, 2, (bf16*)(PP.ws + WS_DO), 512, 0, 0, SEQ, true, lds); __syncthreads(); } }
#endif
    ph_attn_fast2<96>((const bf16*)(PP.ws + WS_MQ), (const bf16*)(PP.ws + WS_MK), (const bf16*)(PP.ws + WS_MV), (const float*)(PP.ws + WS_QBM), 4, 1, (bf16*)(PP.ws + WS_BI), D, 256, 0, SEQ, true, lds);
    ph_attn_fast2<32>((const bf16*)(PP.ws + WS_DQ), (const bf16*)(PP.ws + WS_DK), (const bf16*)(PP.ws + WS_DV), (const float*)(PP.ws + WS_QBD), 8, 2, (bf16*)(PP.ws + WS_DO), 512, 0, 0, SEQ, true, lds);
    REPEAT(REP_ATTN, ph_na_fast2(PP, l, lds));
    if (!last) {
      ph_attn_fast2<96>((const bf16*)(PP.ws + WS_MQ), (const bf16*)(PP.ws + WS_MK), (const bf16*)(PP.ws + WS_MV), (const float*)(PP.ws + WS_QBM), 4, 1, (bf16*)(PP.ws + WS_BI), D, 256, TL, CTX, false, lds);
      ph_attn_fast2<32>((const bf16*)(PP.ws + WS_DQ), (const bf16*)(PP.ws + WS_DK), (const bf16*)(PP.ws + WS_DV), (const float*)(PP.ws + WS_QBD), 8, 2, (bf16*)(PP.ws + WS_DO), 512, 0, TL, CTX, false, lds);
      ph_attn_fast2<64>((const bf16*)(PP.ws + WS_NQ), (const bf16*)(PP.ws + WS_NK), (const bf16*)(PP.ws + WS_NV), (const float*)(PP.ws + WS_QBN), 4, 1, (bf16*)(PP.ws + WS_BI), D, 768, TL, CTX, false, lds);
    }
    GBAR();
#else
    REPEAT(REP_ATTN, ph_attn_fast<96>((const bf16*)(PP.ws + WS_MQ), (const bf16*)(PP.ws + WS_MK), (const bf16*)(PP.ws + WS_MV), 4, 1, (bf16*)(PP.ws + WS_BI), D, 256, 0, SEQ, true, lds));
    REPEAT(REP_ATTN, ph_attn_fast<32>((const bf16*)(PP.ws + WS_DQ), (const bf16*)(PP.ws + WS_DK), (const bf16*)(PP.ws + WS_DV), 8, 2, (bf16*)(PP.ws + WS_DO), 512, 0, 0, SEQ, true, lds));
    REPEAT(REP_ATTN, ph_na_fast(PP, l, lds));
    if (!last) {
      ph_attn_fast<96>((const bf16*)(PP.ws + WS_MQ), (const bf16*)(PP.ws + WS_MK), (const bf16*)(PP.ws + WS_MV), 4, 1, (bf16*)(PP.ws + WS_BI), D, 256, TL, CTX, false, lds);
      ph_attn_fast<32>((const bf16*)(PP.ws + WS_DQ), (const bf16*)(PP.ws + WS_DK), (const bf16*)(PP.ws + WS_DV), 8, 2, (bf16*)(PP.ws + WS_DO), 512, 0, TL, CTX, false, lds);
      ph_attn_fast<64>((const bf16*)(PP.ws + WS_NQ), (const bf16*)(PP.ws + WS_NK), (const bf16*)(PP.ws + WS_NV), 4, 1, (bf16*)(PP.ws + WS_BI), D, 768, TL, CTX, false, lds);
    }
    GBAR();
#endif
    REPEAT(REP_SMALL, ph_diffcombine_fast(PP, l, nrows, lam_init));
    GBAR();
    REPEAT(REP_GEMM, ph_branch_fast(PP, l, nrows, lds));
    GBAR();
    REPEAT(REP_GEMM, ph_merge_fast(PP, l, nrows, lds));
    GBAR();
    REPEAT((l == 0 ? REP_GEMM : 1), ph_wo_fast(PP, l, nrows, lds));
    GBAR();
    ph_mod2_router_fast(PP, l, nrows, lds);
    GBAR();
    REPEAT(REP_GEMM, ph_moe1_fast(PP, l, lds));
    GBAR();
    REPEAT(REP_GEMM, ph_moe2_fast(PP, l, lds));
    GBAR();
    ph_combine(PP, l, nrows, lds);
    if (l == 0) GBAR();
}

__global__ void __launch_bounds__(512, 2) fwd(Params p) {
  extern __shared__ __attribute__((aligned(16))) unsigned char lds[];
  if (threadIdx.x < 4) ((unsigned*)(lds + BARW_OFF))[threadIdx.x] = 0u;
  __syncthreads();
  XcdBarrier bar = xcd_barrier_post((unsigned*)(PP.ws + WS_CTL) + CW_BAR, (volatile LAS unsigned*)(lds + BARW_OFF));
  ph_ada_fast(PP, lds);
  __syncthreads();
  REPEAT(REP_CVT, ph_convert(PP, lds));
  GBAR();
  layer_program<0>(bar, lds);
  layer_program<1>(bar, lds);
}

extern "C" void kernel_launch(void* const* d_in, const int* in_sizes, int n_in, void* d_out, int out_size, void* d_ws, size_t ws_size, hipStream_t stream) {
  static int grid = 0;
  if (grid == 0) {
    if (n_in != N_IN || ws_size < WS_END) { fprintf(stderr, "kernel_launch: n_in %d ws %zu need %zu\n", n_in, ws_size, (size_t)WS_END); grid = -1; return; }
    int dev = 0, cus = 0;
    if (hipGetDevice(&dev) != hipSuccess || hipDeviceGetAttribute(&cus, hipDeviceAttributeMultiprocessorCount, dev) != hipSuccess) { grid = -1; return; }
    if (hipFuncSetAttribute((const void*)fwd, hipFuncAttributeMaxDynamicSharedMemorySize, LDS_BYTES) != hipSuccess) { fprintf(stderr, "kernel_launch: hipFuncSetAttribute failed\n"); grid = -1; return; }
    int per_cu = 0;
    if (hipOccupancyMaxActiveBlocksPerMultiprocessor(&per_cu, (const void*)fwd, 512, LDS_BYTES) != hipSuccess || per_cu < 1) fprintf(stderr, "kernel_launch: occupancy query says %d\n", per_cu);
    (void)hipGetLastError();
    grid = cus;
  }
  if (grid < 0) return;
  Params p{};
  for (int i = 0; i < N_IN; ++i) p.in[i] = (const float*)d_in[i];
  p.out = (float*)d_out; p.ws = (unsigned char*)d_ws;
  (void)hipMemsetAsync((char*)d_ws + WS_CTL, 0, 1 * MiB, stream);
  (void)hipMemsetAsync((char*)d_ws + WS_QKV_T, 0, (size_t)2 * 1024 * 384 * 2, stream);
  (void)hipMemsetAsync((char*)d_ws + WS_WIN_T, 0, (size_t)2 * PLD * D * 2, stream);
  hipLaunchKernelGGL(fwd, dim3(grid), dim3(512), LDS_BYTES, stream, p);
}
```

```cpp
#include <hip/hip_runtime.h>
#include <cstdio>
#include <cstdint>

typedef unsigned short bf16;
#ifndef FAST_ATTN
#define FAST_ATTN 1
#endif
#if FAST_ATTN
#define ATTN_FN ph_attn_fast
#define ATTN_LDS , lds
#else
#define ATTN_FN ph_attn_naive
#define ATTN_LDS
#endif
#ifndef FAST_NA
#define FAST_NA 1
#endif
#ifndef FAST_SMALL
#define FAST_SMALL 1
#endif
#ifndef FAST_ROUTER
#define FAST_ROUTER 1
#endif
#ifndef FAST_PROJ
#define FAST_PROJ 1
#endif
#ifndef FAST_QKV
#define FAST_QKV 1
#endif
#ifndef FAST_MERGE
#define FAST_MERGE 1
#endif
#ifndef FAST_WO
#define FAST_WO 1
#endif
#ifndef FAST_MOE
#define FAST_MOE 1
#endif
#define DI __device__ __forceinline__

constexpr int D = 1024, NB = 8, SEQ = 4096, CTX = 256, GW = 64;
constexpr int TL = NB * SEQ;
constexpr int TC = NB * CTX;
constexpr int T = TL + TC;
constexpr int NH = 4;
constexpr int INW = 2400, PLD = 2560;
constexpr int OFF_B = 512, OFF_C = 864, OFF_D = 1632;
constexpr int NE = 32, DFF = 1024;
constexpr int MAXROWS = 4 * T + NE * 256;
constexpr float EPS = 1e-6f;
constexpr float LOG2E = 1.4426950408889634f;

enum { I_X = 0, I_C, I_CTX, I_CCTX, I_ADAW, I_ADAB, I_N1G, I_N2G, I_WIN, I_CONVW, I_CONVB, I_CLNG, I_CLNB, I_CONVOUT,
       I_CQG, I_CKVG, I_WUQ, I_WUKV, I_QNG, I_KNG, I_MLAOUT, I_DQNG, I_DKNG, I_DLAM, I_DSUBG, I_DIFFOUT, I_NQNG, I_NKNG,
       I_RPB, I_NAOUT, I_GATEW, I_GATEB, I_WO, I_RW, I_RB, I_WGU, I_BGU, I_WDN, I_BDN, N_IN };

constexpr size_t MiB = 1u << 20;
constexpr size_t al(size_t x) { return (x + 255) / 256 * 256; }
constexpr size_t WS_CTL = 0;
constexpr size_t WS_MOD = 1 * MiB;
constexpr size_t WS_ROPE = WS_MOD + al(2 * 9 * 6144 * 4);
constexpr size_t WS_ROUTE = WS_ROPE + al(4096 * 32 * 4);
constexpr size_t WS_ROWTOK = WS_ROUTE + al((size_t)T * 4 * 16);
constexpr size_t WS_HS = WS_ROWTOK + al((size_t)NE * T * 4);
constexpr size_t WS_WGUS = WS_HS + al((size_t)T * 4);
constexpr size_t WS_HS1 = WS_WGUS + al((size_t)2 * NE * 2048 * 4);
constexpr size_t WS_WINS = WS_HS1 + al((size_t)T * 4);
constexpr size_t WS_GATES = WS_WINS + al((size_t)2 * PLD * 4);
constexpr size_t WS_WIN_T = WS_GATES + al((size_t)2 * 4096 * 4);
constexpr size_t WS_QKV_T = WS_WIN_T + al((size_t)2 * PLD * D * 2);
constexpr size_t WS_WB_T = WS_QKV_T + al((size_t)2 * 1024 * 384 * 2);
constexpr size_t WS_GATE_T = WS_WB_T + al((size_t)2 * 4 * 1024 * 256 * 2);
constexpr size_t WS_WO_T = WS_GATE_T + al((size_t)2 * 4096 * D * 2);
constexpr size_t WS_WGU_T = WS_WO_T + al((size_t)2 * D * D * 2);
constexpr size_t WS_WDN_T = WS_WGU_T + al((size_t)2 * NE * 2048 * D * 2);
constexpr size_t WS_H = WS_WDN_T + al((size_t)2 * NE * D * DFF * 2);
constexpr size_t WS_H2 = WS_H + al((size_t)T * D * 2);
constexpr size_t WS_XF = WS_H2 + al((size_t)T * D * 2);
constexpr size_t WS_SCR = WS_XF + al((size_t)T * D * 4);
constexpr size_t WS_PROJ = WS_SCR;
constexpr size_t WS_CU = WS_PROJ + al((size_t)T * PLD * 2);
constexpr size_t WS_AQ = WS_CU + al((size_t)T * 256 * 2);
constexpr size_t WS_QKVRAW = WS_AQ + al((size_t)T * 384 * 2);
constexpr size_t WS_MQ = WS_QKVRAW + al((size_t)T * 1024 * 2);
constexpr size_t WS_MK = WS_MQ + al((size_t)T * 384 * 2);
constexpr size_t WS_MV = WS_MK + al((size_t)T * 384 * 2);
constexpr size_t WS_DQ = WS_MV + al((size_t)T * 256 * 2);
constexpr size_t WS_DK = WS_DQ + al((size_t)T * 256 * 2);
constexpr size_t WS_DV = WS_DK + al((size_t)T * 256 * 2);
constexpr size_t WS_NQ = WS_DV + al((size_t)T * 256 * 2);
constexpr size_t WS_NK = WS_NQ + al((size_t)T * 256 * 2);
constexpr size_t WS_NV = WS_NK + al((size_t)T * 256 * 2);
constexpr size_t WS_BI = WS_NV + al((size_t)T * 256 * 2);
constexpr size_t WS_DO = WS_BI + al((size_t)T * D * 2);
constexpr size_t WS_QBM = WS_DO + al((size_t)T * 512 * 2);
constexpr size_t WS_QBD = WS_QBM + al((size_t)T * 4 * 4);
constexpr size_t WS_QBN = WS_QBD + al((size_t)T * 8 * 4);
constexpr size_t WS_KPE = WS_QBN + al((size_t)T * 4 * 4);
constexpr size_t WS_YB = WS_KPE + al((size_t)T * 32 * 2);
constexpr size_t WS_YM = WS_YB + al((size_t)T * 4096 * 2);
constexpr size_t WS_MIX_END = WS_YM + al((size_t)T * D * 2);
constexpr size_t WS_ACT = WS_SCR;
constexpr size_t WS_YE = WS_ACT + al((size_t)MAXROWS * D * 2);
constexpr size_t WS_MOE_END = WS_YE + al((size_t)MAXROWS * D * 2);
constexpr size_t WS_END = WS_MIX_END > WS_MOE_END ? WS_MIX_END : WS_MOE_END;
static_assert(WS_END <= (size_t)2048 * MiB, "workspace budget (>= 2 GiB guaranteed)");
constexpr int CW_BIASMAX = 2048;
constexpr int CW_CNT = 1024;

struct Params {
  const float* in[N_IN];
  float* out;
  unsigned char* ws;
};
typedef const __attribute__((address_space(4))) Params& PRef;
typedef const __attribute__((address_space(4))) Params* PPtr;
__device__ __forceinline__ PPtr opq_params() { PPtr pp = (PPtr)__builtin_amdgcn_kernarg_segment_ptr(); asm volatile("" : "+s"(pp)); return pp; }
#define PP (*opq_params())

DI float bf2f(bf16 v) { return __uint_as_float(((unsigned)v) << 16); }
DI bf16 f2bf(float f) { unsigned u = __float_as_uint(f); u += 0x7fffu + ((u >> 16) & 1u); return (bf16)(u >> 16); }
DI float sigmoidf_(float x) { return 1.f / (1.f + __expf(-x)); }
DI float wave_sum_l(float v, int lane) {
#pragma unroll
  for (int o = 1; o < 64; o <<= 1) v += __int_as_float(__builtin_amdgcn_ds_bpermute((lane ^ o) << 2, __float_as_int(v)));
  return v;
}
#define wave_sum(v) wave_sum_l((v), lane)
DI unsigned cvt_pk_bf16_(float lo, float hi) { unsigned r; asm volatile("v_cvt_pk_bf16_f32 %0, %1, %2" : "=v"(r) : "v"(lo), "v"(hi)); return r; }
DI float seg_sum(float v, int lane, int width) {
#pragma unroll
  for (int o = 1; o < 64; o <<= 1) if (o < width) v += __int_as_float(__builtin_amdgcn_ds_bpermute((lane ^ o) << 2, __float_as_int(v)));
  return v;
}
DI float lane_xor(float v, int lane, int o) { return __int_as_float(__builtin_amdgcn_ds_bpermute((lane ^ o) << 2, __float_as_int(v))); }

DI void quant_row_i8(const float (&v)[16], signed char* dst, float* scale_out, int lane) {
  float mx = 0.f;
#pragma unroll
  for (int i = 0; i < 16; ++i) mx = fmaxf(mx, fabsf(v[i]));
#pragma unroll
  for (int o = 1; o < 64; o <<= 1) mx = fmaxf(mx, lane_xor(mx, lane, o));
  const float sc = mx > 0.f ? mx * (1.f / 127.f) : 1.f, inv = 1.f / sc; if (lane == 0) *scale_out = sc;
#pragma unroll
  for (int j = 0; j < 4; ++j) { unsigned b = 0;
#pragma unroll
    for (int i = 0; i < 4; ++i) b |= ((unsigned)(int)rintf(v[4 * j + i] * inv) & 255u) << (8 * i);
    *(unsigned*)(dst + j * 256 + lane * 4) = b; }
}
DI void ld4(const bf16* p, float (&x)[4]) { const uint2 u = *(const uint2*)p; x[0] = __uint_as_float(u.x << 16); x[1] = __uint_as_float(u.x & 0xffff0000u); x[2] = __uint_as_float(u.y << 16); x[3] = __uint_as_float(u.y & 0xffff0000u); }
DI void st4(bf16* p, const float (&x)[4]) { uint2 u; u.x = cvt_pk_bf16_(x[0], x[1]); u.y = cvt_pk_bf16_(x[2], x[3]); *(uint2*)p = u; }

DI int opq_bid() { int b = blockIdx.x; asm volatile("" : "+s"(b)); return b; }
DI int opq_nblk() { int g = gridDim.x; asm volatile("" : "+s"(g)); return g; }
DI int opq_tid() { int t = threadIdx.x; asm volatile("" : "+v"(t)); return t; }
#define GTID ((int)(bid_ * 512 + tid_))
#define NTHR ((int)(nblk_ * 512))
#define SUB ((int)(tid_ >> 8))
#define T256 ((int)(tid_ & 255))
DI int modidx(int r) { return r < TL ? (r >> 12) : NB; }


DI const float* stream_row(PRef p, int l, int r, bool after_mixer) {
  if (l == 0 && !after_mixer) return r < TL ? p.in[I_X] + (size_t)r * D : p.in[I_CTX] + (size_t)(r - TL) * D;
  return (const float*)(p.ws + WS_XF) + (size_t)r * D;
}
DI void ph_mod1(PRef p, int l) {
  const int tid_ = opq_tid(); const int bid_ = opq_bid(), nblk_ = opq_nblk(); (void)bid_; (void)nblk_;
  const int lane = tid_ & 63, gw = GTID >> 6, ngw = NTHR >> 6;
  const float* MOD = (const float*)(p.ws + WS_MOD);
  bf16* H = (bf16*)(p.ws + WS_H);
  const float* g = p.in[I_N1G] + l * D;
  float4 c0, c1, c2, c3;
  { const float* x = stream_row(p, l, min(gw, T - 1), false) + lane * 4; c0 = *(const float4*)(x); c1 = *(const float4*)(x + 256); c2 = *(const float4*)(x + 512); c3 = *(const float4*)(x + 768); }
  for (int r = gw; r < T; r += ngw) {
    float4 n0, n1, n2, n3;
    { const float* x = stream_row(p, l, min(r + ngw, T - 1), false) + lane * 4; n0 = *(const float4*)(x); n1 = *(const float4*)(x + 256); n2 = *(const float4*)(x + 512); n3 = *(const float4*)(x + 768); }
    float v[16]; float ss = 0.f;
    { const float4 t4[4] = {c0, c1, c2, c3};
#pragma unroll
    for (int j = 0; j < 4; ++j) { const float4 t = t4[j]; v[4 * j] = t.x; v[4 * j + 1] = t.y; v[4 * j + 2] = t.z; v[4 * j + 3] = t.w; ss += t.x * t.x + t.y * t.y + t.z * t.z + t.w * t.w; } }
    c0 = n0; c1 = n1; c2 = n2; c3 = n3;
    ss = wave_sum(ss);
    const float rstd = rsqrtf(ss * (1.f / D) + EPS);
    const float* md = MOD + ((size_t)l * 9 + modidx(r)) * 6144;
#pragma unroll
    for (int j = 0; j < 4; ++j)
#pragma unroll
      for (int i = 0; i < 4; ++i) { const int c = j * 256 + lane * 4 + i; v[4 * j + i] = v[4 * j + i] * rstd * g[c] * (1.f + md[1024 + c]) + md[c]; }
    quant_row_i8(v, (signed char*)H + (size_t)r * D, (float*)(p.ws + WS_HS1) + r, lane);
  }
}

struct RowId { DI int operator()(int m) const { return m; } };
struct RowGather { const int* idx; DI int operator()(int m) const { return idx[m]; } };
#define ZERO_ACC(acc) do { _Pragma("unroll") for (int i_ = 0; i_ < 4; ++i_) _Pragma("unroll") for (int j_ = 0; j_ < 4; ++j_) acc[i_][j_] = 0.f; } while (0)


DI void ph_conv(PRef p, int l, int nrows, unsigned char* lds) {
  const int tid_ = opq_tid(); const int bid_ = opq_bid(), nblk_ = opq_nblk(); (void)bid_; (void)nblk_;
  const int lane = tid_ & 63, gw = GTID >> 6, ngw = NTHR >> 6;
  const bf16* __restrict__ CU = (const bf16*)(p.ws + WS_CU); bf16* __restrict__ BI = (bf16*)(p.ws + WS_BI);
  const float* cw = p.in[I_CONVW] + l * 31 * 256; const float* cb = p.in[I_CONVB] + l * 256;
  float4* wl = (float4*)lds;
  for (int k = tid_; k < 31 * 64; k += 512) wl[k] = *(const float4*)(cw + 4 * k);
  __syncthreads();
  const float4 bias = *(const float4*)(cb + lane * 4), lg = *(const float4*)(p.in[I_CLNG] + l * 256 + lane * 4), lb = *(const float4*)(p.in[I_CLNB] + l * 256 + lane * 4);
  for (int r = gw; r < nrows; r += ngw) {
    int lo, hi; if (r < TL) { lo = r & ~(SEQ - 1); hi = lo + SEQ; } else { lo = TL + ((r - TL) & ~(CTX - 1)); hi = lo + CTX; }
    const bf16* up = CU + (long)(r - 15) * 256 + lane * 4; asm volatile("" : "+v"(up));
    uint2 u[31];
#pragma unroll
    for (int j = 0; j < 31; ++j) { const int rr = r + j - 15; u[j] = make_uint2(0u, 0u); if (rr >= lo && rr < hi) u[j] = *(const uint2*)(up + j * 256); }
    float a[4] = {bias.x, bias.y, bias.z, bias.w};
#pragma unroll
    for (int j = 0; j < 31; ++j) { const float4 w = wl[j * 64 + lane];
      a[0] += __uint_as_float(u[j].x << 16) * w.x; a[1] += __uint_as_float(u[j].x & 0xffff0000u) * w.y; a[2] += __uint_as_float(u[j].y << 16) * w.z; a[3] += __uint_as_float(u[j].y & 0xffff0000u) * w.w; }
    const float mu = seg_sum(a[0] + a[1] + a[2] + a[3], lane, 64) * (1.f / 256.f);
    float q2 = 0.f;
#pragma unroll
    for (int c = 0; c < 4; ++c) { a[c] -= mu; q2 += a[c] * a[c]; }
    const float rs = rsqrtf(seg_sum(q2, lane, 64) * (1.f / 256.f) + EPS);
    float y[4] = {a[0] * rs * lg.x + lb.x, a[1] * rs * lg.y + lb.y, a[2] * rs * lg.z + lb.z, a[3] * rs * lg.w + lb.w};
#pragma unroll
    for (int c = 0; c < 4; ++c) y[c] = y[c] * sigmoidf_(y[c]);
    st4(BI + (size_t)r * D + lane * 4, y);
  }
  __syncthreads();
}


DI void expert_offsets(const unsigned* cnt, int* off  ) { int a = 0; for (int e = 0; e < NE; ++e) { off[e] = a; a += ((int)cnt[e] + 255) & ~255; } off[NE] = a; }
DI void ph_combine(PRef p, int l, int nrows, unsigned char* lds) {
  const int tid_ = opq_tid(); const int bid_ = opq_bid(), nblk_ = opq_nblk();
  int* off = (int*)(lds + 32768);
  const unsigned* cnt = (const unsigned*)(p.ws + WS_CTL) + CW_CNT + l * 64;
  if (tid_ == 0) expert_offsets(cnt, off);
  __syncthreads();
  const int lane = tid_ & 63, gw = GTID >> 6, ngw = NTHR >> 6;
  const float* MOD = (const float*)(p.ws + WS_MOD); float* XF = (float*)(p.ws + WS_XF); const bf16* YE = (const bf16*)(p.ws + WS_YE); const int* ROUTE = (const int*)(p.ws + WS_ROUTE);
  bf16* H = (bf16*)(p.ws + WS_H); const float* g1n = p.in[I_N1G] + D;
  for (int r = gw; r < nrows; r += ngw) {
    const float* md = MOD + ((size_t)l * 9 + modidx(r)) * 6144 + 5 * 1024;
    float* dst = (l == 1) ? p.out + (size_t)r * D : XF + (size_t)r * D;
    const float* xs = XF + (size_t)r * D;
    float acc[16];
#pragma unroll
    for (int i = 0; i < 16; ++i) acc[i] = 0.f;
#pragma unroll
    for (int k = 0; k < 4; ++k) { const int* rt = ROUTE + ((size_t)r * 4 + k) * 4; const float w = __int_as_float(rt[2]); const bf16* y = YE + (size_t)(off[rt[0]] + rt[1]) * D;
#pragma unroll
      for (int j = 0; j < 4; ++j) { const uint2 u = *(const uint2*)(y + j * 256 + lane * 4);
        acc[4 * j] += w * __uint_as_float(u.x << 16); acc[4 * j + 1] += w * __uint_as_float(u.x & 0xffff0000u); acc[4 * j + 2] += w * __uint_as_float(u.y << 16); acc[4 * j + 3] += w * __uint_as_float(u.y & 0xffff0000u); } }
    float ss = 0.f;
#pragma unroll
    for (int j = 0; j < 4; ++j) { const int c = j * 256 + lane * 4; const float4 x4 = *(const float4*)(xs + c), m4 = *(const float4*)(md + c);
      acc[4 * j] = x4.x + m4.x * acc[4 * j]; acc[4 * j + 1] = x4.y + m4.y * acc[4 * j + 1]; acc[4 * j + 2] = x4.z + m4.z * acc[4 * j + 2]; acc[4 * j + 3] = x4.w + m4.w * acc[4 * j + 3];
      *(float4*)(dst + c) = make_float4(acc[4 * j], acc[4 * j + 1], acc[4 * j + 2], acc[4 * j + 3]);
      ss += acc[4 * j] * acc[4 * j] + acc[4 * j + 1] * acc[4 * j + 1] + acc[4 * j + 2] * acc[4 * j + 2] + acc[4 * j + 3] * acc[4 * j + 3]; }
    if (l == 0) {
      ss = seg_sum(ss, lane, 64); const float rstd = rsqrtf(ss * (1.f / D) + EPS);
      const float* m1 = MOD + ((size_t)9 + modidx(r)) * 6144;
#pragma unroll
      for (int j = 0; j < 4; ++j) { const int c = j * 256 + lane * 4; const float4 gg = *(const float4*)(g1n + c), s4 = *(const float4*)(m1 + 1024 + c), h4 = *(const float4*)(m1 + c);
        acc[4 * j] = acc[4 * j] * rstd * gg.x * (1.f + s4.x) + h4.x; acc[4 * j + 1] = acc[4 * j + 1] * rstd * gg.y * (1.f + s4.y) + h4.y; acc[4 * j + 2] = acc[4 * j + 2] * rstd * gg.z * (1.f + s4.z) + h4.z; acc[4 * j + 3] = acc[4 * j + 3] * rstd * gg.w * (1.f + s4.w) + h4.w; }
      quant_row_i8(acc, (signed char*)H + (size_t)r * D, (float*)(p.ws + WS_HS1) + r, lane);
    }
  }
}

namespace pg8 {
#define PG8_LAS __attribute__((address_space(3)))
typedef unsigned short bf16_t;
typedef short bf16x8 __attribute__((ext_vector_type(8)));
typedef float f32x4 __attribute__((ext_vector_type(4)));
typedef unsigned u32x4 __attribute__((ext_vector_type(4)));
typedef unsigned u32x2 __attribute__((ext_vector_type(2)));
typedef int i32x4v __attribute__((ext_vector_type(4)));
constexpr int BM = 256, BK = 64, HALF = 128, HTB = HALF * BK * 2, STAGE_BYTES = 8 * HTB;
__host__ __device__ __forceinline__ int lds_byte(int r, int c) { const int st = (r >> 4) * 2 + (c >> 5), rr = r & 15, cc = c & 31, ob = rr * 64 + cc * 2; return st * 1024 + (ob ^ (((ob >> 9) & 1) << 5)); }
__host__ __device__ __forceinline__ void stage_rc(int b, int& R, int& C) { const int st = b / 1024, sb = b % 1024, swz = sb ^ (((sb >> 9) & 1) << 5); R = (st >> 1) * 16 + swz / 64; C = (st & 1) * 32 + (swz % 64) / 2; }
__host__ __device__ __forceinline__ int perm32(int rho) { const int n = rho >> 4, i = rho & 15; return 8 * (i >> 2) + 4 * n + (i & 3); }
__device__ __forceinline__ unsigned cvt_pk_bf16(float lo, float hi) { unsigned r; asm volatile("v_cvt_pk_bf16_f32 %0, %1, %2" : "=v"(r) : "v"(lo), "v"(hi)); return r; }

struct Unit { int pm, pn, aux, nvalid; const char* A; const char* B; const int* rows; };

template <class Epi, class Sched, bool GATHER, bool I8 = false>
__device__ __forceinline__ void gemm_phase(PG8_LAS unsigned char* lds, const int lda_, const int K_, const Sched& S, const Epi& E) {
    const int lda = I8 ? lda_ / 2 : lda_, K = I8 ? K_ / 2 : K_;
    const int tid = opq_tid(), wid = __builtin_amdgcn_readfirstlane(tid >> 6), lane = tid & 63, wr = wid >> 2, wc = wid & 3, fr = lane & 15, fq = lane >> 4;
    const int nt = K / BK;
    unsigned voffA[2], voffB[2];
#pragma unroll
    for (int i = 0; i < 2; ++i) { int R, C; stage_rc(tid * 16 + i * 8192, R, C); const int Rb = Epi::PERM ? ((R & ~31) + perm32(R & 31)) : R;
        voffA[i] = GATHER ? (unsigned)(R * 65536 + C * 2) : (unsigned)(R * lda + C) * 2u; voffB[i] = (unsigned)(Rb * K + C) * 2u; }
    const size_t kstep = (size_t)(BK * 2);
    const size_t hstepA = GATHER ? 0 : (size_t)HALF * lda * 2, hstepB = (size_t)HALF * K * 2;
    const unsigned ldsw = (unsigned)wid * 1024u;
    const int aoff = lds_byte(wr * 64 + fr, fq * 8), boff = lds_byte(wc * 32 + fr, fq * 8);
#define PG8_SA(b, h) (((b) * 2 + (h)) * HTB)
#define PG8_SB(b, h) ((4 + (b) * 2 + (h)) * HTB)
#define PG8_STAGE(bufoff, gbase, voff) do { _Pragma("unroll") for (int _i = 0; _i < 2; ++_i) \
        __builtin_amdgcn_global_load_lds((const unsigned*)((const char*)(gbase) + (voff)[_i]), (PG8_LAS unsigned*)(lds + (bufoff) + ldsw + _i * 8192), 16, 0, 0); } while (0)
#define PG8_LDA(dst, b, h) do { _Pragma("unroll") for (int m = 0; m < 4; ++m) _Pragma("unroll") for (int k = 0; k < 2; ++k) dst[m][k] = *(const PG8_LAS bf16x8*)(lds + PG8_SA(b, h) + aoff + m * 2048 + k * 1024); } while (0)
#define PG8_LDB(dst, b, h) do { _Pragma("unroll") for (int n = 0; n < 2; ++n) _Pragma("unroll") for (int k = 0; k < 2; ++k) dst[n][k] = *(const PG8_LAS bf16x8*)(lds + PG8_SB(b, h) + boff + n * 2048 + k * 1024); } while (0)
#define PG8_MMA(ai, bj, At, Bt) do { __builtin_amdgcn_s_setprio(1); _Pragma("unroll") for (int m = 0; m < 4; ++m) _Pragma("unroll") for (int n = 0; n < 2; ++n) _Pragma("unroll") for (int k = 0; k < 2; ++k) { \
        if constexpr (I8) acc[ai][bj][m][n] = __builtin_bit_cast(f32x4, __builtin_amdgcn_mfma_i32_16x16x64_i8(__builtin_bit_cast(i32x4v, Bt[n][k]), __builtin_bit_cast(i32x4v, At[m][k]), __builtin_bit_cast(i32x4v, acc[ai][bj][m][n]), 0, 0, 0)); \
        else acc[ai][bj][m][n] = __builtin_amdgcn_mfma_f32_16x16x32_bf16(Bt[n][k], At[m][k], acc[ai][bj][m][n], 0, 0, 0); } __builtin_amdgcn_s_setprio(0); } while (0)
#define PG8_WAIT_V(n) asm volatile("s_waitcnt vmcnt(" #n ")" ::: "memory")
#define PG8_WAIT_L(n) asm volatile("s_waitcnt lgkmcnt(" #n ")" ::: "memory")
#define PG8_BAR __builtin_amdgcn_s_barrier()
#define PG8_SCHED __builtin_amdgcn_sched_barrier(0)
#define PG8_LOADROWS(dst, u) do { _Pragma("unroll") for (int h_ = 0; h_ < 2; ++h_) _Pragma("unroll") for (int i_ = 0; i_ < 2; ++i_) \
        { const int ri_ = h_ * HALF + (int)(voffA[i_] >> 16); dst[h_][i_] = (unsigned)(ri_ < (u).nvalid ? (u).rows[ri_] : 0) * (unsigned)(lda * 2) + (voffA[i_] & 0xffffu); } } while (0)
#define PG8_STAGE_A(bufoff, gbase, h, NEXT) do { if constexpr (GATHER) { PG8_STAGE(bufoff, gbase, ((NEXT) ? vn[h] : vc[h])); } else { PG8_STAGE(bufoff, (gbase) + (h) * hstepA, voffA); } } while (0)
    Unit cur, nxt; int ui = 0;
    if (!S.next(0, cur)) return;
    f32x4 acc[2][2][4][2];
#pragma unroll
    for (int a = 0; a < 2; ++a)
#pragma unroll
        for (int b = 0; b < 2; ++b)
#pragma unroll
            for (int m = 0; m < 4; ++m)
#pragma unroll
                for (int n = 0; n < 2; ++n) acc[a][b][m][n] = (f32x4){0.f, 0.f, 0.f, 0.f};
    bf16x8 At[4][2], B0[2][2], B1[2][2];
    unsigned vc[2][2], vn[2][2];
    if constexpr (GATHER) { PG8_LOADROWS(vc, cur);
#pragma unroll
        for (int h = 0; h < 2; ++h) { vn[h][0] = vc[h][0]; vn[h][1] = vc[h][1]; } }
    const char* cA = cur.A; const char* cB = cur.B;
    PG8_STAGE(PG8_SB(0, 0), cB, voffB); PG8_STAGE(PG8_SB(0, 1), cB + hstepB, voffB); PG8_STAGE_A(PG8_SA(0, 0), cA, 0, false); PG8_STAGE_A(PG8_SA(0, 1), cA, 1, false);
    if (wr == 1) PG8_BAR;
    PG8_WAIT_V(2); PG8_BAR;
    PG8_STAGE(PG8_SB(1, 0), cB + kstep, voffB); PG8_STAGE_A(PG8_SA(1, 0), cA + kstep, 0, false); PG8_STAGE(PG8_SB(1, 1), cB + hstepB + kstep, voffB);
    PG8_WAIT_V(6); PG8_BAR;
    for (;;) {
        const bool has_next = S.next(ui + 1, nxt);
        const char* nA = has_next ? nxt.A : cA; const char* nB = has_next ? nxt.B : cB;
        if constexpr (GATHER) { if (has_next) { PG8_LOADROWS(vn, nxt); } }
#pragma unroll 1
        for (int t = 0; t < nt; t += 2) {
            const bool last = (t == nt - 2);
            const char* a1 = cA + (size_t)(t + 1) * kstep;
            const char* a2 = last ? nA : cA + (size_t)(t + 2) * kstep; const char* b2 = last ? nB : cB + (size_t)(t + 2) * kstep;
            const char* a3 = a2 + kstep; const char* b3 = b2 + kstep;
            PG8_LDB(B0, 0, 0); PG8_LDB(B1, 0, 1); PG8_SCHED; PG8_LDA(At, 0, 0); PG8_STAGE_A(PG8_SA(1, 1), a1, 1, false);
            PG8_WAIT_V(8); PG8_WAIT_L(0); PG8_BAR; PG8_MMA(0, 0, At, B0); PG8_MMA(0, 1, At, B1); PG8_BAR; PG8_SCHED;
            PG8_LDA(At, 0, 1); PG8_STAGE(PG8_SB(0, 0), b2, voffB); PG8_STAGE(PG8_SB(0, 1), b2 + hstepB, voffB); PG8_STAGE_A(PG8_SA(0, 0), a2, 0, last);
            PG8_WAIT_V(8); PG8_WAIT_L(0); PG8_BAR; PG8_MMA(1, 0, At, B0); PG8_MMA(1, 1, At, B1); PG8_BAR; PG8_SCHED;
            PG8_LDB(B0, 1, 0); PG8_LDB(B1, 1, 1); PG8_SCHED; PG8_LDA(At, 1, 0); PG8_STAGE_A(PG8_SA(0, 1), a2, 1, last);
            PG8_WAIT_V(8); PG8_WAIT_L(0); PG8_BAR; PG8_MMA(0, 0, At, B0); PG8_MMA(0, 1, At, B1); PG8_BAR; PG8_SCHED;
            PG8_LDA(At, 1, 1); PG8_STAGE(PG8_SB(1, 0), b3, voffB); PG8_STAGE(PG8_SB(1, 1), b3 + hstepB, voffB); PG8_STAGE_A(PG8_SA(1, 0), a3, 0, last);
            PG8_WAIT_V(8); PG8_WAIT_L(0); PG8_BAR; PG8_MMA(1, 0, At, B0); PG8_MMA(1, 1, At, B1); PG8_BAR; PG8_SCHED;
        }
        if (wr == 0) PG8_BAR;
        { const int l2 = opq_tid() & 63; E(acc, cur, wr, wc, l2 & 15, l2 >> 4); }
        if (!has_next) break;
#pragma unroll
        for (int a = 0; a < 2; ++a)
#pragma unroll
            for (int b = 0; b < 2; ++b)
#pragma unroll
                for (int m = 0; m < 4; ++m)
#pragma unroll
                    for (int n = 0; n < 2; ++n) acc[a][b][m][n] = (f32x4){0.f, 0.f, 0.f, 0.f};
        cur = nxt; cA = nA; cB = nB; ++ui;
        if constexpr (GATHER) {
#pragma unroll
            for (int h = 0; h < 2; ++h) { vc[h][0] = vn[h][0]; vc[h][1] = vn[h][1]; } }
        if (wr == 1) PG8_BAR;
    }
    PG8_WAIT_V(0);
    PG8_BAR;
#undef PG8_STAGE_A
#undef PG8_SA
#undef PG8_SB
#undef PG8_STAGE
#undef PG8_LDA
#undef PG8_LDB
#undef PG8_MMA
#undef PG8_WAIT_V
#undef PG8_WAIT_L
#undef PG8_BAR
#undef PG8_SCHED
#undef PG8_LOADROWS
}
}

struct SchedDense {
    const char* A; const char* Bt; int nM, nN, G, c; size_t tstepA, tstepB; bool rev = false;
    DI void init(const void* A_, int lda, const void* Bt_, int K, int M, int N, int G_, int c_) { A = (const char*)A_; Bt = (const char*)Bt_; nM = M / 256; nN = N / 256; G = G_; c = c_; tstepA = (size_t)256 * lda * 2; tstepB = (size_t)256 * K * 2; }
    DI bool next(int i, pg8::Unit& u) const {
        const int L = i * G + c; if (L >= nM * nN) return false;
        const int nig = 8 * nN, gid = L / nig, fm = gid * 8, gsz = (nM - fm) < 8 ? (nM - fm) : 8, w = L - gid * nig;
        u.pm = fm + (w % gsz); if (rev) u.pm = nM - 1 - u.pm; u.pn = w / gsz; u.aux = 0; u.nvalid = 256; u.A = A + (size_t)u.pm * tstepA; u.B = Bt + (size_t)u.pn * tstepB; u.rows = nullptr; return true; }
};
struct SchedBranch {
    const char* A; const char* Bt; int nM, G, c;
    DI void init(const void* A_, const void* Bt_, int M, int G_, int c_) { A = (const char*)A_; Bt = (const char*)Bt_; nM = M / 256; G = G_; c = c_; }
    DI bool next(int i, pg8::Unit& u) const {
        const int L = i * G + c; if (L >= nM * 16) return false;
        u.pm = L >> 4; const int b = (L >> 2) & 3; u.pn = L & 3; u.aux = b; u.nvalid = 256;
        u.A = A + (size_t)u.pm * 256 * (D * 2) + b * 512; u.B = Bt + ((size_t)b * 1024 + u.pn * 256) * 512; u.rows = nullptr; return true; }
};
struct SchedMoe {
    bool rev = false; const char* A; const char* Bt; const int* rowtok; const int* off; const int* cnt; int nN, G, c, ntiles; size_t tstepA, estepB, tstepB; bool gather;
    DI bool next(int i, pg8::Unit& u) const {
        int rt, pn;
        if (G == 256) {
            const int v = i * 32 + (c >> 3), rl = v / nN; pn = v - rl * nN; rt = rl * 8 + (c & 7); if (rt >= ntiles) return false; }
        else { const int L = i * G + c; if (L >= ntiles * nN) return false; rt = L / nN; pn = L - rt * nN; }
        if (rev) rt = ntiles - 1 - rt;
        u.pm = rt; u.pn = pn; const int r0 = rt * 256; int e = 0;
#pragma unroll 1
        for (int k = 1; k < NE; ++k) e += (off[k] <= r0) ? 1 : 0;
        u.aux = e; u.A = gather ? A : A + (size_t)rt * tstepA; u.B = Bt + (size_t)e * estepB + (size_t)u.pn * tstepB;
        const int rin = r0 - off[e]; u.rows = rowtok + (size_t)e * T + rin; u.nvalid = cnt[e] - rin; return true; }
};

struct EpiStoreBf16 {
    static constexpr bool PERM = true;
    bf16* O; int ldc; int auxstride; const float* bias; int biasstride;
    DI void operator()(const pg8::f32x4 (&acc)[2][2][4][2], const pg8::Unit& u, int wr, int wc, int fr, int fq) const {
        const int row0 = u.pm * 256 + wr * 64 + fr, col0 = u.aux * auxstride + u.pn * 256 + wc * 32 + 8 * fq, bcol0 = u.pn * 256 + wc * 32 + 8 * fq;
        pg8::f32x4 bv[2][2];
#pragma unroll
        for (int bj = 0; bj < 2; ++bj)
#pragma unroll
            for (int n = 0; n < 2; ++n) bv[bj][n] = bias ? *(const pg8::f32x4*)(bias + (size_t)u.aux * biasstride + bcol0 + bj * 128 + 4 * n) : (pg8::f32x4){0.f, 0.f, 0.f, 0.f};
#pragma unroll
        for (int ai = 0; ai < 2; ++ai)
#pragma unroll
            for (int m = 0; m < 4; ++m) { bf16* rowp = O + (size_t)(row0 + ai * 128 + m * 16) * ldc + col0;
#pragma unroll
                for (int bj = 0; bj < 2; ++bj) { const pg8::f32x4 v0 = acc[ai][bj][m][0] + bv[bj][0], v1 = acc[ai][bj][m][1] + bv[bj][1];
                    pg8::u32x4 w; w.x = pg8::cvt_pk_bf16(v0[0], v0[1]); w.y = pg8::cvt_pk_bf16(v0[2], v0[3]); w.z = pg8::cvt_pk_bf16(v1[0], v1[1]); w.w = pg8::cvt_pk_bf16(v1[2], v1[3]);
                    *(pg8::u32x4*)(rowp + bj * 128) = w; } }
    }
};
DI float sigm_fast(float x) { return __builtin_amdgcn_rcpf(1.f + __builtin_amdgcn_exp2f(-LOG2E * x)); }
struct EpiMerge {
    static constexpr bool PERM = false;
    const bf16* YB; bf16* YM; const float* gb; const float* HS1; const float* GATES;
    DI void operator()(const pg8::f32x4 (&acc)[2][2][4][2], const pg8::Unit& u, int wr, int wc, int fr, int fq) const {
        const int row0 = u.pm * 256 + wr * 64 + fr, col = u.pn * 64 + wc * 16 + fq * 4;
        pg8::f32x4 bv[2][2];
#pragma unroll
        for (int bj = 0; bj < 2; ++bj)
#pragma unroll
            for (int n = 0; n < 2; ++n) bv[bj][n] = *(const pg8::f32x4*)(gb + (2 * bj + n) * 1024 + col);
#pragma unroll
        for (int ai = 0; ai < 2; ++ai)
#pragma unroll
            for (int m = 0; m < 4; ++m) { const size_t r = (size_t)(row0 + ai * 128 + m * 16); const float sa = HS1[r]; pg8::f32x4 y = (pg8::f32x4){0.f, 0.f, 0.f, 0.f};
#pragma unroll
                for (int bj = 0; bj < 2; ++bj)
#pragma unroll
                    for (int n = 0; n < 2; ++n) { const pg8::u32x2 yb = *(const pg8::u32x2*)(YB + r * 4096 + (2 * bj + n) * 1024 + col); const pg8::i32x4v iv = __builtin_bit_cast(pg8::i32x4v, acc[ai][bj][m][n]);
                        const pg8::f32x4 cs = *(const pg8::f32x4*)(GATES + u.pn * 256 + 128 * bj + 32 * wc + 16 * n + 4 * fq);
                        const pg8::f32x4 g = (pg8::f32x4){(float)iv[0] * sa * cs[0], (float)iv[1] * sa * cs[1], (float)iv[2] * sa * cs[2], (float)iv[3] * sa * cs[3]} + bv[bj][n];
                        y[0] += sigm_fast(g[0]) * __uint_as_float(yb.x << 16); y[1] += sigm_fast(g[1]) * __uint_as_float(yb.x & 0xffff0000u);
                        y[2] += sigm_fast(g[2]) * __uint_as_float(yb.y << 16); y[3] += sigm_fast(g[3]) * __uint_as_float(yb.y & 0xffff0000u); }
                pg8::u32x2 w; w.x = pg8::cvt_pk_bf16(y[0], y[1]); w.y = pg8::cvt_pk_bf16(y[2], y[3]); *(pg8::u32x2*)(YM + r * 1024 + col) = w; }
    }
};
struct EpiWo {
    static constexpr bool PERM = false;
    const float* xlat; const float* xctx; float* XF; const float* modg;
    DI void operator()(const pg8::f32x4 (&acc)[2][2][4][2], const pg8::Unit& u, int wr, int wc, int fr, int fq) const {
        const int row0 = u.pm * 256 + wr * 64 + fr, col0 = u.pn * 256 + wc * 32 + 4 * fq;
        const float* g = modg + (size_t)modidx(u.pm * 256) * 6144 + col0;
        pg8::f32x4 gv[2][2];
#pragma unroll
        for (int bj = 0; bj < 2; ++bj)
#pragma unroll
            for (int n = 0; n < 2; ++n) gv[bj][n] = *(const pg8::f32x4*)(g + bj * 128 + n * 16);
#pragma unroll
        for (int ai = 0; ai < 2; ++ai)
#pragma unroll
            for (int mp = 0; mp < 2; ++mp) { pg8::f32x4 t[2][2][2];
#pragma unroll
                for (int mm = 0; mm < 2; ++mm) { const int r = row0 + ai * 128 + (2 * mp + mm) * 16; const float* xs = (r < TL ? xlat + (size_t)r * D : xctx + (size_t)(r - TL) * D) + col0;
#pragma unroll
                    for (int bj = 0; bj < 2; ++bj)
#pragma unroll
                        for (int n = 0; n < 2; ++n) t[mm][bj][n] = *(const pg8::f32x4*)(xs + bj * 128 + n * 16); }
#pragma unroll
                for (int mm = 0; mm < 2; ++mm) { const int m = 2 * mp + mm; const int r = row0 + ai * 128 + m * 16; float* xo = XF + (size_t)r * D + col0;
#pragma unroll
                    for (int bj = 0; bj < 2; ++bj)
#pragma unroll
                        for (int n = 0; n < 2; ++n) *(pg8::f32x4*)(xo + bj * 128 + n * 16) = t[mm][bj][n] + gv[bj][n] * acc[ai][bj][m][n]; } }
    }
};
struct EpiProjFused {
    static constexpr bool PERM = true;
    bf16 *CU, *AQ, *DQ, *DK, *DV, *NQ, *NK, *NV, *KPE; float *QBD, *QBN; const float* ROPE;
    const float *cqg, *ckvg, *dqg, *dkg, *nqg, *nkg;
    float kbd, kbn, nbias; float* P;
    const float* HS1; const float* WINS;
    DI static float red4(float v, int lane) { v += lane_xor(v, lane, 16); v += lane_xor(v, lane, 32); return v; }
    DI static void st8(bf16* dst, const float (&x)[8]) { pg8::u32x4 w; w.x = pg8::cvt_pk_bf16(x[0], x[1]); w.y = pg8::cvt_pk_bf16(x[2], x[3]); w.z = pg8::cvt_pk_bf16(x[4], x[5]); w.w = pg8::cvt_pk_bf16(x[6], x[7]); *(pg8::u32x4*)dst = w; }
    DI void operator()(const pg8::f32x4 (&acc)[2][2][4][2], const pg8::Unit& u, int wr, int wc, int fr, int fq) const {
        const int t = u.pn, lane = fr + 16 * fq, row0 = u.pm * 256 + wr * 64 + fr; const bool lat = u.pm < TL / 256;
        const float* sap = HS1 + row0; const float* sbp = WINS + 256 * t + 32 * wc + 8 * fq; asm volatile("" : "+v"(sap), "+v"(sbp));
#define GET8(ai, bj, m, x) do { const float sa_ = sap[(ai) * 128 + (m) * 16]; _Pragma("unroll") for (int n_ = 0; n_ < 2; ++n_) { const pg8::i32x4v iv_ = __builtin_bit_cast(pg8::i32x4v, acc[ai][bj][m][n_]); \
        const pg8::f32x4 sb_ = *(const pg8::f32x4*)(sbp + 128 * (bj) + 4 * n_); _Pragma("unroll") for (int j_ = 0; j_ < 4; ++j_) x[4 * n_ + j_] = (float)iv_[j_] * sa_ * sb_[j_]; } } while (0)
        if (t < 2) {
#pragma unroll
            for (int ai = 0; ai < 2; ++ai)
#pragma unroll
                for (int m = 0; m < 4; ++m) { float a[8], g[8], o[8]; GET8(ai, 0, m, a); GET8(ai, 1, m, g);
#pragma unroll
                    for (int i = 0; i < 8; ++i) o[i] = a[i] * sigm_fast(g[i]);
                    st8(CU + (size_t)(row0 + ai * 128 + m * 16) * 256 + 128 * t + 32 * wc + 8 * fq, o); }
        } else if (t < 5) {
#pragma unroll
            for (int bj = 0; bj < 2; ++bj) { const int ds = (t - 2) * 8 + bj * 4 + wc, head = ds / 6, kind = ds - head * 6;
                const bool isq = kind < 2, isv = kind >= 4; const float* gp = (isq ? dqg : dkg) + 8 * fq; float gg[8];
#pragma unroll
                for (int i = 0; i < 8; ++i) gg[i] = gp[i];
#pragma unroll
                for (int ai = 0; ai < 2; ++ai)
#pragma unroll
                    for (int m = 0; m < 4; ++m) { const int r = row0 + ai * 128 + m * 16; float x[8]; GET8(ai, bj, m, x);
                        if (isv) { st8(DV + (size_t)r * 256 + head * 64 + (kind - 4) * 32 + 8 * fq, x); continue; }
                        float ss = 0.f;
#pragma unroll
                        for (int i = 0; i < 8; ++i) ss += x[i] * x[i];
                        const float rs = rsqrtf(red4(ss, lane) * (1.f / 32.f) + EPS);
#pragma unroll
                        for (int i = 0; i < 8; ++i) x[i] = x[i] * rs * gg[i];
                        float pt[8];
#pragma unroll
                        for (int i = 0; i < 8; ++i) pt[i] = lane_xor(x[i], lane, 32);
                        if (lat) { const float* rp = ROPE + (size_t)(r & (SEQ - 1)) * 32 + 8 * (fq & 1); const bool first = fq < 2;
                            const pg8::f32x4 c0 = *(const pg8::f32x4*)rp, c1 = *(const pg8::f32x4*)(rp + 4), s0 = *(const pg8::f32x4*)(rp + 16), s1 = *(const pg8::f32x4*)(rp + 20);
#pragma unroll
                            for (int i = 0; i < 8; ++i) { const float cs = i < 4 ? c0[i & 3] : c1[i & 3], sn = i < 4 ? s0[i & 3] : s1[i & 3]; x[i] = first ? x[i] * cs - pt[i] * sn : x[i] * cs + pt[i] * sn; } }
                        if (isq) { float qn = 0.f;
#pragma unroll
                            for (int i = 0; i < 8; ++i) { x[i] *= 0.17677669529663687f * LOG2E; qn += x[i] * x[i]; }
                            qn = red4(qn, lane); if (fq == 0) QBD[(size_t)r * 8 + head * 2 + kind] = -(sqrtf(qn) * kbd + 0.05f); }
                        st8((isq ? DQ : DK) + (size_t)r * 256 + head * 64 + (kind & 1) * 32 + 8 * fq, x); } }
        } else if (t < 7) {
            const int pi = (t - 5) * 4 + wc, head = pi >> 1; const bool isq = (pi & 1) == 0; const float* gp = (isq ? nqg : nkg) + 8 * fq; float g0[8], g1[8];
#pragma unroll
            for (int i = 0; i < 8; ++i) { g0[i] = gp[i]; g1[i] = gp[32 + i]; }
#pragma unroll
            for (int ai = 0; ai < 2; ++ai)
#pragma unroll
                for (int m = 0; m < 4; ++m) { const int r = row0 + ai * 128 + m * 16; float x0[8], x1[8]; GET8(ai, 0, m, x0); GET8(ai, 1, m, x1); float ss = 0.f;
#pragma unroll
                    for (int i = 0; i < 8; ++i) ss += x0[i] * x0[i] + x1[i] * x1[i];
                    const float rs = rsqrtf(red4(ss, lane) * (1.f / 64.f) + EPS) * (isq ? 0.125f * LOG2E : 1.f); float qn = 0.f;
#pragma unroll
                    for (int i = 0; i < 8; ++i) { x0[i] = x0[i] * rs * g0[i]; x1[i] = x1[i] * rs * g1[i]; qn += x0[i] * x0[i] + x1[i] * x1[i]; }
                    if (isq) { qn = red4(qn, lane); if (fq == 0) QBN[(size_t)r * 4 + head] = -(sqrtf(qn) * kbn + nbias); }
                    bf16* dst = (isq ? NQ : NK) + (size_t)r * 256 + head * 64 + 8 * fq; st8(dst, x0); st8(dst + 32, x1); }
        } else if (t == 7) {
#pragma unroll
            for (int bj = 0; bj < 2; ++bj) { const int sl = bj * 4 + wc, head = sl >> 1, half = sl & 1;
#pragma unroll
                for (int ai = 0; ai < 2; ++ai)
#pragma unroll
                    for (int m = 0; m < 4; ++m) { float x[8]; GET8(ai, bj, m, x); st8(NV + (size_t)(row0 + ai * 128 + m * 16) * 256 + head * 64 + half * 32 + 8 * fq, x); } }
        } else {
            const int nsl = t == 8 ? 6 : 4;
#pragma unroll
            for (int bj = 0; bj < 2; ++bj) { const int sl = bj * 4 + wc;
#pragma unroll
                for (int ai = 0; ai < 2; ++ai)
#pragma unroll
                    for (int m = 0; m < 4; ++m) { float x[8]; GET8(ai, bj, m, x); float ss = 0.f;
#pragma unroll
                        for (int i = 0; i < 8; ++i) ss += x[i] * x[i];
                        ss = red4(ss, lane); if (fq == 0) P[(ai * 128 + wr * 64 + m * 16 + fr) * 8 + sl] = sl < nsl ? ss : 0.f; } }
            asm volatile("s_waitcnt lgkmcnt(0)" ::: "memory"); __builtin_amdgcn_s_barrier(); asm volatile("" ::: "memory");
#pragma unroll
            for (int bj = 0; bj < 2; ++bj) { const int sl = bj * 4 + wc; const float* gp = (t == 8 ? cqg : ckvg) + 32 * (sl < nsl ? sl : 0) + 8 * fq; float gg[8];
#pragma unroll
                for (int i = 0; i < 8; ++i) gg[i] = gp[i];
#pragma unroll
                for (int ai = 0; ai < 2; ++ai)
#pragma unroll
                    for (int m = 0; m < 4; ++m) { const int rl = ai * 128 + wr * 64 + m * 16 + fr, r = u.pm * 256 + rl; float x[8]; GET8(ai, bj, m, x);
                        const pg8::f32x4 p0 = *(const pg8::f32x4*)(P + rl * 8), p1 = *(const pg8::f32x4*)(P + rl * 8 + 4);
                        const float tot = (p0[0] + p0[1]) + (p0[2] + p0[3]) + (p1[0] + p1[1]) + (p1[2] + p1[3]);
                        const float rs = rsqrtf(tot * (t == 8 ? 1.f / 192.f : 1.f / 128.f) + EPS);
                        if (sl < nsl) {
#pragma unroll
                            for (int i = 0; i < 8; ++i) x[i] = x[i] * rs * gg[i];
                            st8(AQ + (size_t)r * 384 + (t == 8 ? 0 : 192) + 32 * sl + 8 * fq, x); }
                        else if (t == 8 && sl == 6) st8(KPE + (size_t)r * 32 + 8 * fq, x);
                        else if (t == 9 && sl < 6) {
#pragma unroll
                            for (int i = 0; i < 8; ++i) x[i] = 0.f;
                            st8(AQ + (size_t)r * 384 + 320 + 32 * (sl - 4) + 8 * fq, x); } } }
            asm volatile("s_waitcnt lgkmcnt(0)" ::: "memory"); __builtin_amdgcn_s_barrier(); asm volatile("" ::: "memory");
        }
#undef GET8
    }
};
struct EpiQkvFused {
    static constexpr bool PERM = true;
    bf16 *MQ, *MK, *MV; const bf16* KPE; float* QBM; const float* ROPE; const float *gq, *gk; float nbconst; float* P;
    DI static float red4(float v, int lane) { v += lane_xor(v, lane, 16); v += lane_xor(v, lane, 32); return v; }
    DI static void st8(bf16* dst, const float (&x)[8]) { pg8::u32x4 w; w.x = pg8::cvt_pk_bf16(x[0], x[1]); w.y = pg8::cvt_pk_bf16(x[2], x[3]); w.z = pg8::cvt_pk_bf16(x[4], x[5]); w.w = pg8::cvt_pk_bf16(x[6], x[7]); *(pg8::u32x4*)dst = w; }
    DI void rope8(float (&x)[8], int r, int fq, int lane) const {
        float pt[8];
#pragma unroll
        for (int i = 0; i < 8; ++i) pt[i] = lane_xor(x[i], lane, 32);
        const float* rp = ROPE + (size_t)(r & (SEQ - 1)) * 32 + 8 * (fq & 1); const bool first = fq < 2;
        const pg8::f32x4 c0 = *(const pg8::f32x4*)rp, c1 = *(const pg8::f32x4*)(rp + 4), s0 = *(const pg8::f32x4*)(rp + 16), s1 = *(const pg8::f32x4*)(rp + 20);
#pragma unroll
        for (int i = 0; i < 8; ++i) { const float cs = i < 4 ? c0[i & 3] : c1[i & 3], sn = i < 4 ? s0[i & 3] : s1[i & 3]; x[i] = first ? x[i] * cs - pt[i] * sn : x[i] * cs + pt[i] * sn; }
    }
    DI void operator()(const pg8::f32x4 (&acc)[2][2][4][2], const pg8::Unit& u, int wr, int wc, int fr, int fq) const {
        const int t = u.pn, lane = fr + 16 * fq, row0 = u.pm * 256 + wr * 64 + fr; const bool lat = u.pm < TL / 256;
#define GET8(ai, bj, m, x) do { _Pragma("unroll") for (int n_ = 0; n_ < 2; ++n_) _Pragma("unroll") for (int j_ = 0; j_ < 4; ++j_) x[4 * n_ + j_] = acc[ai][bj][m][n_][j_]; } while (0)
        if (t < 2) {
#pragma unroll
            for (int bj = 0; bj < 2; ++bj)
#pragma unroll
                for (int ai = 0; ai < 2; ++ai)
#pragma unroll
                    for (int m = 0; m < 4; ++m) { float x[8]; GET8(ai, bj, m, x); float ss = 0.f;
#pragma unroll
                        for (int i = 0; i < 8; ++i) ss += x[i] * x[i];
                        ss = red4(ss, lane); if (fq == 0) P[(ai * 128 + wr * 64 + m * 16 + fr) * 8 + bj * 4 + wc] = wc < 3 ? ss : 0.f; }
            asm volatile("s_waitcnt lgkmcnt(0)" ::: "memory"); __builtin_amdgcn_s_barrier(); asm volatile("" ::: "memory");
            if (wc < 3) {
#pragma unroll
                for (int bj = 0; bj < 2; ++bj) { const int head = 2 * t + bj; const float* gp = gq + 32 * wc + 8 * fq; asm volatile("" : "+v"(gp)); float gg[8];
#pragma unroll
                    for (int i = 0; i < 8; ++i) gg[i] = gp[i];
#pragma unroll
                    for (int ai = 0; ai < 2; ++ai)
#pragma unroll
                        for (int m = 0; m < 4; ++m) { const int rl = ai * 128 + wr * 64 + m * 16 + fr, r = u.pm * 256 + rl; float x[8]; GET8(ai, bj, m, x);
                            const pg8::f32x4 pp = *(const pg8::f32x4*)(P + rl * 8 + bj * 4);
                            const float rs = rsqrtf((pp[0] + pp[1] + pp[2]) * (1.f / 96.f) + EPS);
#pragma unroll
                            for (int i = 0; i < 8; ++i) x[i] = x[i] * rs * gg[i];
                            if (wc == 2 && lat) rope8(x, r, fq, lane);
#pragma unroll
                            for (int i = 0; i < 8; ++i) x[i] *= 0.10206207261596577f * LOG2E;
                            st8(MQ + (size_t)r * 384 + head * 96 + 32 * wc + 8 * fq, x);
                            if (wc == 0 && fq == 0) QBM[(size_t)r * 4 + head] = nbconst; } }
            }
            asm volatile("s_waitcnt lgkmcnt(0)" ::: "memory"); __builtin_amdgcn_s_barrier(); asm volatile("" ::: "memory");
        } else if (wc < 2) {
            const int head = 2 * (t - 2) + wc;
#pragma unroll
            for (int ai = 0; ai < 2; ++ai)
#pragma unroll
                for (int m = 0; m < 4; ++m) { const int r = row0 + ai * 128 + m * 16; float xp[8];
                    { const uint4 kq = *(const uint4*)(KPE + (size_t)r * 32 + 8 * fq); const unsigned w[4] = {kq.x, kq.y, kq.z, kq.w};
#pragma unroll
                      for (int i = 0; i < 4; ++i) { xp[2 * i] = __uint_as_float(w[i] << 16); xp[2 * i + 1] = __uint_as_float(w[i] & 0xffff0000u); } }
                    float ss = 0.f;
#pragma unroll
                    for (int n = 0; n < 2; ++n)
#pragma unroll
                        for (int j = 0; j < 4; ++j) ss += acc[ai][0][m][n][j] * acc[ai][0][m][n][j] + acc[ai][1][m][n][j] * acc[ai][1][m][n][j] + xp[4 * n + j] * xp[4 * n + j];
                    const float rs = rsqrtf(red4(ss, lane) * (1.f / 96.f) + EPS);
                    const float* gp = gk + 8 * fq; asm volatile("" : "+v"(gp));
                    bf16* dst = MK + (size_t)r * 384 + head * 96 + 8 * fq;
#pragma unroll
                    for (int bj = 0; bj < 2; ++bj) { float x[8]; GET8(ai, bj, m, x);
#pragma unroll
                        for (int i = 0; i < 8; ++i) x[i] = x[i] * rs * gp[32 * bj + i];
                        st8(dst + 32 * bj, x); }
#pragma unroll
                    for (int i = 0; i < 8; ++i) xp[i] = xp[i] * rs * gp[64 + i];
                    if (lat) rope8(xp, r, fq, lane);
                    st8(dst + 64, xp); }
        } else {
            const int head = 2 * (t - 2) + wc - 2;
#pragma unroll
            for (int bj = 0; bj < 2; ++bj)
#pragma unroll
                for (int ai = 0; ai < 2; ++ai)
#pragma unroll
                    for (int m = 0; m < 4; ++m) { float x[8]; GET8(ai, bj, m, x); st8(MV + (size_t)(row0 + ai * 128 + m * 16) * 256 + head * 64 + 32 * bj + 8 * fq, x); }
        }
#undef GET8
    }
};
struct EpiMoeActI8 {
    static constexpr bool PERM = true;
    bf16* ACT; const float* bgu; const float* HS; const float* WGUS;
    DI void operator()(const pg8::f32x4 (&acc)[2][2][4][2], const pg8::Unit& u, int wr, int wc, int fr, int fq) const {
        const int rl0 = wr * 64 + fr, row0 = u.pm * 256 + rl0, col0 = u.pn * 128 + wc * 32 + 8 * fq;
        const float* b = bgu + (size_t)u.aux * 2048 + col0;
        const pg8::f32x4 bg0 = *(const pg8::f32x4*)(b), bg1 = *(const pg8::f32x4*)(b + 4), bu0 = *(const pg8::f32x4*)(b + 1024), bu1 = *(const pg8::f32x4*)(b + 1028);
        const float* cs = WGUS + (size_t)u.aux * 2048 + u.pn * 256 + wc * 32 + 8 * fq;
        const pg8::f32x4 sg0 = *(const pg8::f32x4*)(cs), sg1 = *(const pg8::f32x4*)(cs + 4), su0 = *(const pg8::f32x4*)(cs + 128), su1 = *(const pg8::f32x4*)(cs + 132);
#pragma unroll
        for (int ai = 0; ai < 2; ++ai)
#pragma unroll
            for (int m = 0; m < 4; ++m) { const int rl = rl0 + ai * 128 + m * 16; const float sa = HS[rl < u.nvalid ? u.rows[rl] : 0]; float a[8];
#pragma unroll
                for (int n = 0; n < 2; ++n) { const pg8::i32x4v ig = __builtin_bit_cast(pg8::i32x4v, acc[ai][0][m][n]), iu = __builtin_bit_cast(pg8::i32x4v, acc[ai][1][m][n]);
#pragma unroll
                    for (int j = 0; j < 4; ++j) { const float gg = (float)ig[j] * sa * (n ? sg1[j] : sg0[j]) + (n ? bg1[j] : bg0[j]), uu = (float)iu[j] * sa * (n ? su1[j] : su0[j]) + (n ? bu1[j] : bu0[j]);
                        const float g = fminf(gg, 7.f), uc = fminf(fmaxf(uu, -7.f), 7.f); a[4 * n + j] = (uc + 1.f) * (g * sigm_fast(1.702f * g)); } }
                pg8::u32x4 w; w.x = pg8::cvt_pk_bf16(a[0], a[1]); w.y = pg8::cvt_pk_bf16(a[2], a[3]); w.z = pg8::cvt_pk_bf16(a[4], a[5]); w.w = pg8::cvt_pk_bf16(a[6], a[7]);
                *(pg8::u32x4*)(ACT + (size_t)(row0 + ai * 128 + m * 16) * D + col0) = w; }
    }
};
struct EpiMoeAct {
    static constexpr bool PERM = true;
    bf16* ACT; const float* bgu;
    DI void operator()(const pg8::f32x4 (&acc)[2][2][4][2], const pg8::Unit& u, int wr, int wc, int fr, int fq) const {
        const int row0 = u.pm * 256 + wr * 64 + fr, col0 = u.pn * 128 + wc * 32 + 8 * fq;
        const float* b = bgu + (size_t)u.aux * 2048 + col0;
        const pg8::f32x4 bg0 = *(const pg8::f32x4*)(b), bg1 = *(const pg8::f32x4*)(b + 4), bu0 = *(const pg8::f32x4*)(b + 1024), bu1 = *(const pg8::f32x4*)(b + 1028);
#pragma unroll
        for (int ai = 0; ai < 2; ++ai)
#pragma unroll
            for (int m = 0; m < 4; ++m) { float a[8];
#pragma unroll
                for (int n = 0; n < 2; ++n) { const pg8::f32x4 gg = acc[ai][0][m][n] + (n ? bg1 : bg0), uu = acc[ai][1][m][n] + (n ? bu1 : bu0);
#pragma unroll
                    for (int j = 0; j < 4; ++j) { const float g = fminf(gg[j], 7.f), uc = fminf(fmaxf(uu[j], -7.f), 7.f); a[4 * n + j] = (uc + 1.f) * (g * sigm_fast(1.702f * g)); } }
                pg8::u32x4 w; w.x = pg8::cvt_pk_bf16(a[0], a[1]); w.y = pg8::cvt_pk_bf16(a[2], a[3]); w.z = pg8::cvt_pk_bf16(a[4], a[5]); w.w = pg8::cvt_pk_bf16(a[6], a[7]);
                *(pg8::u32x4*)(ACT + (size_t)(row0 + ai * 128 + m * 16) * D + col0) = w; }
    }
};

struct MapId { int off; DI int operator()(int n) const { return n + off; } };
struct MapProj { DI int operator()(int s) const {
    int t, slot;
    if (s < 512) { const int isg = s >> 8, ch = s & 255; t = ch >> 7; slot = isg * 4 + ((ch >> 5) & 3); }
    else if (s < OFF_C) { const int m = s - OFF_B; if (m < 192) { t = 8; slot = m >> 5; } else if (m < 320) { t = 9; slot = (m - 192) >> 5; } else { t = 8; slot = 6; } }
    else if (s < OFF_D) { const int m = s - OFF_C, head = m / 192, w = m - head * 192, ds = head * 6 + (w >> 5); t = 2 + (ds >> 3); slot = ds & 7; }
    else { const int m = s - OFF_D, head = m / 192, w = m - head * 192;
      if (w < 128) { const int pi = head * 2 + (w >> 6); t = 5 + (pi >> 2); slot = ((w >> 5) & 1) * 4 + (pi & 3); } else { t = 7; slot = head * 2 + ((w - 128) >> 5); } }
    return 256 * t + (slot >> 2) * 128 + (slot & 3) * 32 + (s & 31); } };
struct MapQ  { DI int operator()(int s) const { const int head = s / 96, w = s - head * 96; return 256 * (head >> 1) + 128 * (head & 1) + 32 * (w >> 5) + (s & 31); } };
struct MapKV { DI int operator()(int s) const { const int head = s >> 7, w = s & 127, isv = w >> 6, half = (w >> 5) & 1; return 256 * (2 + (head >> 1)) + 128 * half + 32 * (2 * isv + (head & 1)) + (s & 31); } };
struct MapGate { DI int operator()(int s) const { const int b = s >> 10, w = s & 1023, pn = w >> 6, lc = w & 63; return 256 * pn + 128 * (b >> 1) + 32 * (lc >> 4) + 16 * (b & 1) + (lc & 15); } };
struct MapGu { DI int operator()(int s) const { const int isu = s >> 10, c = s & 1023; return 256 * (c >> 7) + 128 * isu + (c & 127); } };
struct CvtItem { const float* W; bf16* WT; int N, ldk, kdst0, mapt, mapoff, item; };
DI CvtItem cvt_decode(PRef p, int it) {
    constexpr int I_WIN_ = (D / 64) * (INW / 32), I_UQ_ = 3 * 12, I_UKV_ = 2 * 16, I_BR_ = 4 * 32, I_GATE_ = 16 * 128, I_WO_ = 16 * 32, I_GU_ = 16 * 64, I_DN_ = 16 * 32;
    constexpr int PER_L = I_UQ_ + I_UKV_ + 4 * I_BR_ + I_WO_ + NE * I_DN_;
    unsigned char* ws = p.ws; CvtItem c; (void)I_WIN_; (void)I_GATE_; c.mapt = 0; c.mapoff = 0; c.kdst0 = 0;
    const int l = it / PER_L; int r = it - l * PER_L;
    if (r < I_UQ_) { c.W = p.in[I_WUQ] + (size_t)l * 192 * 384; c.N = 384; c.WT = (bf16*)(ws + WS_QKV_T) + (size_t)l * 1024 * 384; c.ldk = 384; c.mapt = 4; c.item = r; return c; } r -= I_UQ_;
    if (r < I_UKV_) { c.W = p.in[I_WUKV] + (size_t)l * 128 * 512; c.N = 512; c.WT = (bf16*)(ws + WS_QKV_T) + (size_t)l * 1024 * 384; c.ldk = 384; c.kdst0 = 192; c.mapt = 5; c.item = r; return c; } r -= I_UKV_;
    if (r < 4 * I_BR_) { const int b = r / I_BR_; c.W = (b == 0 ? p.in[I_CONVOUT] : b == 1 ? p.in[I_MLAOUT] : b == 2 ? p.in[I_DIFFOUT] : p.in[I_NAOUT]) + (size_t)l * 256 * D; c.N = D;
        c.WT = (bf16*)(ws + WS_WB_T) + ((size_t)l * 4 + b) * 1024 * 256; c.ldk = 256; c.item = r - b * I_BR_; return c; } r -= 4 * I_BR_;
    if (r < I_WO_) { c.W = p.in[I_WO] + (size_t)l * D * D; c.N = D; c.WT = (bf16*)(ws + WS_WO_T) + (size_t)l * D * D; c.ldk = D; c.item = r; return c; } r -= I_WO_;
    const int e = r / I_DN_; r -= e * I_DN_; (void)I_GU_;
    c.W = p.in[I_WDN] + ((size_t)l * NE + e) * DFF * D; c.N = D; c.WT = (bf16*)(ws + WS_WDN_T) + ((size_t)l * NE + e) * D * DFF; c.ldk = DFF; c.item = r; return c;
}
DI void cvt_load(const CvtItem& c, float (&v)[32], int lane) {
    const int nblk = c.N / 32, kb = c.item / nblk, nb = c.item - kb * nblk;
    const float* src = c.W + (size_t)(64 * kb + (lane >> 5)) * c.N + 32 * nb + (lane & 31);
#pragma unroll
    for (int i = 0; i < 32; ++i) v[i] = src[(size_t)(2 * i) * c.N];
}
DI void cvt_store(const CvtItem& c, const float (&v)[32], float* scr, int lane) {
    const int nblk = c.N / 32, kb = c.item / nblk, nb = c.item - kb * nblk, k0 = 64 * kb, n0 = 32 * nb;
#pragma unroll
    for (int i = 0; i < 32; ++i) scr[(2 * i + (lane >> 5)) * 33 + (lane & 31)] = v[i];
    asm volatile("s_waitcnt lgkmcnt(0)" ::: "memory");
    const int cc = lane & 7;
#pragma unroll
    for (int j = 0; j < 4; ++j) { const int n = (lane >> 3) + 8 * j; const float* s = scr + (8 * cc) * 33 + n;
        pg8::u32x4 o; o.x = pg8::cvt_pk_bf16(s[0 * 33], s[1 * 33]); o.y = pg8::cvt_pk_bf16(s[2 * 33], s[3 * 33]); o.z = pg8::cvt_pk_bf16(s[4 * 33], s[5 * 33]); o.w = pg8::cvt_pk_bf16(s[6 * 33], s[7 * 33]);
        const int sn = n0 + n; const int row = c.mapt == 0 ? sn + c.mapoff : (c.mapt == 1 ? MapGate()(sn) : (c.mapt == 2 ? MapGu()(sn) : (c.mapt == 3 ? MapProj()(sn) : (c.mapt == 4 ? MapQ()(sn) : MapKV()(sn)))));
        *(pg8::u32x4*)(c.WT + (size_t)row * c.ldk + c.kdst0 + k0 + 8 * cc) = o; }
    asm volatile("s_waitcnt lgkmcnt(0)" ::: "memory");
}
DI void ph_convert(PRef p, unsigned char* lds) {
    const int tid_ = opq_tid(); const int bid_ = opq_bid(), nblk_ = opq_nblk(); const int lane = tid_ & 63, wave = __builtin_amdgcn_readfirstlane(tid_ >> 6);
    float* scr = (float*)(lds + wave * 8704);
    const int gw = bid_ * 8 + wave, ngw = nblk_ * 8;
    constexpr int PER_L = 3 * 12 + 2 * 16 + 4 * 4 * 32 + 16 * 32 + NE * (16 * 32);
    const int total = 2 * PER_L;
    float va[32], vb[32];
    int it = gw;
    CvtItem ca, cb;
    if (it < total) { ca = cvt_decode(p, it); cvt_load(ca, va, lane); }
    for (; it < total; it += 2 * ngw) {
        const int i1 = it + ngw, i2 = it + 2 * ngw;
        if (i1 < total) { cb = cvt_decode(p, i1); cvt_load(cb, vb, lane); }
        cvt_store(ca, va, scr, lane);
        if (i2 < total) { ca = cvt_decode(p, i2); cvt_load(ca, va, lane); }
        if (i1 < total) cvt_store(cb, vb, scr, lane);
    }
    __syncthreads();
    { float* red = (float*)lds;
      const int n = tid_ & 31, kg = tid_ >> 5; signed char* W8 = (signed char*)(p.ws + WS_WGU_T); float* WS_ = (float*)(p.ws + WS_WGUS);
      float xa[64], xb[64];
#define I8_DECODE(it, src_, N_, dst_, sca_, kind_, nb_) const float* src_; int N_, kind_, nb_; signed char* dst_; float* sca_; \
        if ((it) < 4096) { const int le_ = (it) >> 6; nb_ = (it) & 63; src_ = p.in[I_WGU] + (size_t)le_ * D * 2048; N_ = 2048; dst_ = W8 + (size_t)le_ * 2048 * D * 2; sca_ = WS_ + (size_t)le_ * 2048; kind_ = 0; } \
        else if ((it) < 4096 + 150) { const int l_ = ((it) - 4096) / 75; nb_ = ((it) - 4096) - l_ * 75; src_ = p.in[I_WIN] + (size_t)l_ * D * INW; N_ = INW; dst_ = (signed char*)(p.ws + WS_WIN_T) + (size_t)l_ * PLD * D * 2; sca_ = (float*)(p.ws + WS_WINS) + l_ * PLD; kind_ = 1; } \
        else { const int l_ = ((it) - 4246) >> 7; nb_ = ((it) - 4246) & 127; src_ = p.in[I_GATEW] + (size_t)l_ * D * 4096; N_ = 4096; dst_ = (signed char*)(p.ws + WS_GATE_T) + (size_t)l_ * 4096 * D * 2; sca_ = (float*)(p.ws + WS_GATES) + l_ * 4096; kind_ = 2; }
#define GU_LOAD(dst, it) do { I8_DECODE(it, src_, N_, d8_, sc8_, kind_, nb_); (void)d8_; (void)sc8_; (void)kind_; const float* s2_ = src_ + (size_t)(64 * kg) * N_ + 32 * nb_ + n; \
        _Pragma("unroll") for (int i = 0; i < 64; ++i) dst[i] = s2_[(size_t)i * N_]; } while (0)
#define GU_EMIT(src, it) do { I8_DECODE(it, src_, N_, d8_, sc8_, kind_, nb_); (void)src_; float m_ = 0.f; _Pragma("unroll") for (int i = 0; i < 64; ++i) m_ = fmaxf(m_, fabsf(src[i])); \
        red[kg * 32 + n] = m_; __syncthreads(); \
        if (tid_ < 32) { float mm_ = 0.f; _Pragma("unroll") for (int g = 0; g < 16; ++g) mm_ = fmaxf(mm_, red[g * 32 + tid_]); red[512 + tid_] = mm_ > 0.f ? mm_ * (1.f / 127.f) : 1.f; } \
        __syncthreads(); const float sc_ = red[512 + n], inv_ = 1.f / sc_; const int col_ = 32 * nb_ + n; const int row_ = kind_ == 0 ? MapGu()(col_) : (kind_ == 1 ? MapProj()(col_) : MapGate()(col_)); \
        if (kg == 0) sc8_[row_] = sc_; \
        signed char* dst_ = d8_ + (size_t)row_ * D + 64 * kg; \
        _Pragma("unroll") for (int q = 0; q < 4; ++q) { unsigned w_[4]; _Pragma("unroll") for (int d = 0; d < 4; ++d) { unsigned b_ = 0; _Pragma("unroll") for (int i = 0; i < 4; ++i) { \
            const int v_ = (int)rintf(src[16 * q + 4 * d + i] * inv_); b_ |= ((unsigned)v_ & 255u) << (8 * i); } w_[d] = b_; } \
            *(uint4*)(dst_ + 16 * q) = make_uint4(w_[0], w_[1], w_[2], w_[3]); } \
        __syncthreads(); } while (0)
      const int nit = 2 * NE * 64 + 150 + 256; int it2 = bid_;
      if (it2 < nit) GU_LOAD(xa, it2);
      for (; it2 < nit; it2 += 2 * nblk_) { const int j1 = it2 + nblk_, j2 = it2 + 2 * nblk_;
        if (j1 < nit) GU_LOAD(xb, j1);
        GU_EMIT(xa, it2);
        if (j2 < nit) GU_LOAD(xa, j2);
        if (j1 < nit) GU_EMIT(xb, j1); }
#undef GU_LOAD
#undef GU_EMIT
#undef I8_DECODE
    }
}

#define LDSP ((PG8_LAS unsigned char*)lds)
DI void ph_proj_fast(PRef p, int l, unsigned char* lds) {
    const int bid_ = opq_bid(), nblk_ = opq_nblk(); const int tid0 = opq_tid(), lane0 = tid0 & 63;
    SchedDense S; S.init(p.ws + WS_H, D / 2, (const bf16*)(p.ws + WS_WIN_T) + (size_t)l * PLD * D, D / 2, T, PLD, nblk_, bid_);
    EpiProjFused E;
    E.CU = (bf16*)(p.ws + WS_CU); E.AQ = (bf16*)(p.ws + WS_AQ); E.DQ = (bf16*)(p.ws + WS_DQ); E.DK = (bf16*)(p.ws + WS_DK); E.DV = (bf16*)(p.ws + WS_DV);
    E.NQ = (bf16*)(p.ws + WS_NQ); E.NK = (bf16*)(p.ws + WS_NK); E.NV = (bf16*)(p.ws + WS_NV); E.KPE = (bf16*)(p.ws + WS_KPE);
    E.QBD = (float*)(p.ws + WS_QBD); E.QBN = (float*)(p.ws + WS_QBN); E.ROPE = (const float*)(p.ws + WS_ROPE);
    E.cqg = p.in[I_CQG] + l * 192; E.ckvg = p.in[I_CKVG] + l * 128; E.dqg = p.in[I_DQNG] + l * 32; E.dkg = p.in[I_DKNG] + l * 32; E.nqg = p.in[I_NQNG] + l * 64; E.nkg = p.in[I_NKNG] + l * 64;
    { float m = lane0 < 32 ? fabsf(p.in[I_DKNG][l * 32 + lane0]) : 0.f;
#pragma unroll
      for (int o = 1; o < 64; o <<= 1) m = fmaxf(m, lane_xor(m, lane0, o));
      float m2 = fabsf(p.in[I_NKNG][l * 64 + lane0]);
#pragma unroll
      for (int o = 1; o < 64; o <<= 1) m2 = fmaxf(m2, lane_xor(m2, lane0, o));
      float t0 = 5.656854249f * 1.004f * m, t1 = 8.f * 1.004f * m2, t2 = __int_as_float(((const int*)(p.ws + WS_CTL))[CW_BIASMAX + l]) * LOG2E + 0.05f;
      asm volatile("" : "+v"(t0), "+v"(t1), "+v"(t2));
      const int b0 = __builtin_amdgcn_readfirstlane(__float_as_int(t0)), b1 = __builtin_amdgcn_readfirstlane(__float_as_int(t1)), b2 = __builtin_amdgcn_readfirstlane(__float_as_int(t2));
      E.kbd = __int_as_float(b0); E.kbn = __int_as_float(b1); E.nbias = __int_as_float(b2); }
    E.P = (float*)(lds + 131072 + 4096); E.HS1 = (const float*)(p.ws + WS_HS1); E.WINS = (const float*)(p.ws + WS_WINS) + l * PLD;
    pg8::gemm_phase<EpiProjFused, SchedDense, false, true>(LDSP, D, D, S, E);
}
DI void ph_qkvraw_fast(PRef p, int l, unsigned char* lds) {
    const int bid_ = opq_bid(), nblk_ = opq_nblk(); const int lane0 = opq_tid() & 63;
    SchedDense S; S.init(p.ws + WS_AQ, 384, (const bf16*)(p.ws + WS_QKV_T) + (size_t)l * 1024 * 384, 384, T, 1024, nblk_, bid_);
    EpiQkvFused E; E.MQ = (bf16*)(p.ws + WS_MQ); E.MK = (bf16*)(p.ws + WS_MK); E.MV = (bf16*)(p.ws + WS_MV); E.KPE = (const bf16*)(p.ws + WS_KPE); E.QBM = (float*)(p.ws + WS_QBM);
    E.ROPE = (const float*)(p.ws + WS_ROPE); E.gq = p.in[I_QNG] + l * 96; E.gk = p.in[I_KNG] + l * 96; E.P = (float*)(lds + 131072 + 4096);
    { float mq = 0.f, mk = 0.f;
      for (int i = lane0; i < 96; i += 64) { mq = fmaxf(mq, fabsf(E.gq[i])); mk = fmaxf(mk, fabsf(E.gk[i])); }
#pragma unroll
      for (int o = 1; o < 64; o <<= 1) { mq = fmaxf(mq, lane_xor(mq, lane0, o)); mk = fmaxf(mk, lane_xor(mk, lane0, o)); }
      E.nbconst = __int_as_float(__builtin_amdgcn_readfirstlane(__float_as_int(-(96.f * 0.10206207261596577f * LOG2E * mq * mk * 1.004f + 0.05f)))); }
    pg8::gemm_phase<EpiQkvFused, SchedDense, false>(LDSP, 384, 384, S, E);
}
DI void ph_branch_fast(PRef p, int l, int nrows, unsigned char* lds) {
    const int bid_ = opq_bid(), nblk_ = opq_nblk();
    SchedBranch S; S.init(p.ws + WS_BI, (const bf16*)(p.ws + WS_WB_T) + (size_t)l * 4 * 1024 * 256, nrows, nblk_, bid_);
    EpiStoreBf16 E{(bf16*)(p.ws + WS_YB), 4096, 1024, nullptr, 0};
    pg8::gemm_phase<EpiStoreBf16, SchedBranch, false>(LDSP, D, 256, S, E);
}
DI void ph_merge_fast(PRef p, int l, int nrows, unsigned char* lds) {
    const int bid_ = opq_bid(), nblk_ = opq_nblk();
    SchedDense S; S.init(p.ws + WS_H, D / 2, (const bf16*)(p.ws + WS_GATE_T) + (size_t)l * 4096 * D, D / 2, nrows, 4096, nblk_, bid_);
    S.rev = true;
    EpiMerge E{(const bf16*)(p.ws + WS_YB), (bf16*)(p.ws + WS_YM), p.in[I_GATEB] + l * 4096, (const float*)(p.ws + WS_HS1), (const float*)(p.ws + WS_GATES) + l * 4096};
    pg8::gemm_phase<EpiMerge, SchedDense, false, true>(LDSP, D, D, S, E);
}
DI void ph_wo_fast(PRef p, int l, int nrows, unsigned char* lds) {
    const int bid_ = opq_bid(), nblk_ = opq_nblk();
    SchedDense S; S.init(p.ws + WS_YM, D, (const bf16*)(p.ws + WS_WO_T) + (size_t)l * D * D, D, nrows, D, nblk_, bid_);
    const float* XFc = (const float*)(p.ws + WS_XF);
    EpiWo E{l == 0 ? p.in[I_X] : XFc, l == 0 ? p.in[I_CTX] : XFc + (size_t)TL * D, (float*)(p.ws + WS_XF), (const float*)(p.ws + WS_MOD) + (size_t)l * 9 * 6144 + 2048};
    pg8::gemm_phase<EpiWo, SchedDense, false>(LDSP, D, D, S, E);
}
DI void moe_offsets(PRef p, int l, int* off, int tid) {
    const unsigned* cnt = (const unsigned*)(p.ws + WS_CTL) + CW_CNT + l * 64;
    if (tid == 0) expert_offsets(cnt, off);
    if (tid < NE) off[40 + tid] = (int)cnt[tid];
    __syncthreads();
}
DI void ph_moe1_fast(PRef p, int l, unsigned char* lds) {
    const int tid_ = opq_tid(); const int bid_ = opq_bid(), nblk_ = opq_nblk(); (void)bid_; (void)nblk_; int* off = (int*)(lds + 131072 + 1024); moe_offsets(p, l, off, tid_);
    SchedMoe S; S.A = (const char*)(p.ws + WS_H2); S.Bt = (const char*)((const bf16*)(p.ws + WS_WGU_T) + (size_t)l * NE * 2048 * D); S.rowtok = (const int*)(p.ws + WS_ROWTOK); S.off = off; S.cnt = off + 40;
    S.nN = 8; S.G = nblk_; S.c = bid_; S.ntiles = off[NE] >> 8; S.tstepA = 0; S.estepB = (size_t)2048 * D * 2  ; S.tstepB = (size_t)256 * D  ; S.gather = true;
    EpiMoeActI8 E{(bf16*)(p.ws + WS_ACT), p.in[I_BGU] + (size_t)l * NE * 2048, (const float*)(p.ws + WS_HS), (const float*)(p.ws + WS_WGUS) + (size_t)l * NE * 2048};
    pg8::gemm_phase<EpiMoeActI8, SchedMoe, true, true>(LDSP, D, D, S, E);
}
DI void ph_moe2_fast(PRef p, int l, unsigned char* lds) {
    const int tid_ = opq_tid(); const int bid_ = opq_bid(), nblk_ = opq_nblk(); (void)bid_; (void)nblk_; int* off = (int*)(lds + 131072 + 1024); moe_offsets(p, l, off, tid_);
    SchedMoe S; S.A = (const char*)(p.ws + WS_ACT); S.Bt = (const char*)((const bf16*)(p.ws + WS_WDN_T) + (size_t)l * NE * D * DFF); S.rowtok = (const int*)(p.ws + WS_ROWTOK); S.off = off; S.cnt = off + 40;
    S.nN = 4; S.G = nblk_; S.c = bid_; S.ntiles = off[NE] >> 8; S.tstepA = (size_t)256 * D * 2; S.estepB = (size_t)D * DFF * 2; S.tstepB = (size_t)256 * DFF * 2; S.gather = false;
    S.rev = true;
    EpiStoreBf16 E{(bf16*)(p.ws + WS_YE), D, 0, p.in[I_BDN] + (size_t)l * NE * D, D};
    pg8::gemm_phase<EpiStoreBf16, SchedMoe, false>(LDSP, DFF, DFF, S, E);
}

namespace fa {
using bf16x8 = __attribute__((ext_vector_type(8))) short;
using s16x4  = __attribute__((ext_vector_type(4))) short;
using f32x16 = __attribute__((ext_vector_type(16))) float;
using u32x4  = __attribute__((ext_vector_type(4))) unsigned;
constexpr int SHM_K = 64 * 256, SHM_V = 64 * 256;
constexpr float THR2 = 11.5f;
#define FA_KSWZ(row, colB) ((row) * 256 + ((colB) ^ (((row) & 7) << 4)))
#define FA_SBAR() __builtin_amdgcn_sched_barrier(0)
DI int crow(int r, int hi) { return (r & 3) + 8 * (r >> 2) + 4 * hi; }
DI unsigned cvtpk(float lo, float hi) { unsigned r; asm volatile("v_cvt_pk_bf16_f32 %0, %1, %2" : "=v"(r) : "v"(lo), "v"(hi)); return r; }
DI int v_st(int k, int c) { const int kk = k;        return ((kk >> 3) * 4 + (c >> 5)) * 512 + ((kk & 7) * 32 + (c & 31)) * 2; }
DI int v_rd_base(int lane) { return ((lane & 3) << 3) | (((lane >> 2) & 3) << 6) | (((lane >> 4) & 1) << 5) | (((lane >> 5) & 1) << 8); }
constexpr int v_rd_off(int d0, int ks, int half) { return d0 * 512 + ks * 4096 + half * 2048; }
template <int OFF> DI s16x4 tr_read(int vb) { s16x4 r; asm volatile("ds_read_b64_tr_b16 %0, %1 offset:%2" : "=&v"(r) : "v"(vb), "i"(OFF) : "memory"); return r; }
template <int D0> DI void pv_one(f32x16& od, int vb, bf16x8 pa0, bf16x8 pa1, bf16x8 pa2, bf16x8 pa3) {
  const s16x4 l0 = tr_read<v_rd_off(D0, 0, 0)>(vb), h0 = tr_read<v_rd_off(D0, 0, 1)>(vb), l1 = tr_read<v_rd_off(D0, 1, 0)>(vb), h1 = tr_read<v_rd_off(D0, 1, 1)>(vb);
  const s16x4 l2 = tr_read<v_rd_off(D0, 2, 0)>(vb), h2 = tr_read<v_rd_off(D0, 2, 1)>(vb), l3 = tr_read<v_rd_off(D0, 3, 0)>(vb), h3 = tr_read<v_rd_off(D0, 3, 1)>(vb);
  asm volatile("s_waitcnt lgkmcnt(0)" ::: "memory"); FA_SBAR();
#define FA_PK(L, H) (bf16x8){L[0], L[1], L[2], L[3], H[0], H[1], H[2], H[3]}
  od = __builtin_amdgcn_mfma_f32_32x32x16_bf16(pa0, FA_PK(l0, h0), od, 0, 0, 0);
  od = __builtin_amdgcn_mfma_f32_32x32x16_bf16(pa1, FA_PK(l1, h1), od, 0, 0, 0);
  od = __builtin_amdgcn_mfma_f32_32x32x16_bf16(pa2, FA_PK(l2, h2), od, 0, 0, 0);
  od = __builtin_amdgcn_mfma_f32_32x32x16_bf16(pa3, FA_PK(l3, h3), od, 0, 0, 0);
#undef FA_PK
}

}


DI void ph_ada_fast(PRef p, unsigned char* lds) {
  const int tid_ = opq_tid(); const int bid_ = opq_bid(), nblk_ = opq_nblk();
  float* MOD = (float*)(p.ws + WS_MOD);
  { float* ROPE = (float*)(p.ws + WS_ROPE);
    for (int idx = GTID; idx < SEQ * 16; idx += NTHR) { const int sq = idx >> 4, i = idx & 15; const float pos = (i < 8) ? (float)(sq >> 6) : (float)(sq & 63);
      const float inv = powf(10000.f, -(float)(2 * (i & 7)) / 16.f); const float th = pos * inv; ROPE[sq * 32 + i] = cosf(th); ROPE[sq * 32 + 16 + i] = sinf(th); } }
  if (bid_ == 0) { for (int k = tid_; k < 2 * NH * 15 * 31; k += 512) { const float v = fmaxf(p.in[I_RPB][k], 0.f); atomicMax((int*)(p.ws + WS_CTL) + CW_BIASMAX + k / (NH * 15 * 31), __float_as_int(v)); } }
  float* sc = (float*)lds;
  float* red = (float*)(lds + 40960);
  for (int k = tid_; k < 9 * D; k += 512) { const int i = k >> 10, kk = k & 1023; const float v = i < 8 ? p.in[I_C][i * D + kk] : p.in[I_CCTX][kk]; sc[k] = v * sigmoidf_(v); }
  __syncthreads();
  const int nn = tid_ & 63, kg = tid_ >> 6;
  for (int it = bid_; it < 2 * 96; it += nblk_) {
    const int l = it / 96, n0 = (it - l * 96) * 64;
    const float* W = p.in[I_ADAW] + (size_t)l * D * 6144 + n0 + nn;
    float acc[9];
#pragma unroll
    for (int i = 0; i < 9; ++i) acc[i] = 0.f;
#pragma unroll 8
    for (int k = kg * 128; k < kg * 128 + 128; ++k) { const float w = W[(size_t)k * 6144];
#pragma unroll
      for (int i = 0; i < 9; ++i) acc[i] += sc[i * D + k] * w; }
#pragma unroll
    for (int i = 0; i < 9; ++i) red[(kg * 9 + i) * 64 + nn] = acc[i];
    __syncthreads();
    for (int o = tid_; o < 9 * 64; o += 512) { const int i = o >> 6, n = o & 63; float s = 0.f;
#pragma unroll
      for (int g = 0; g < 8; ++g) s += red[(g * 9 + i) * 64 + n];
      MOD[((size_t)l * 9 + i) * 6144 + n0 + n] = s + p.in[I_ADAB][l * 6144 + n0 + n]; }
    __syncthreads();
  }
}


DI void ld32(const bf16* __restrict__ src, float (&x)[32]) {
#pragma unroll
  for (int q = 0; q < 4; ++q) { const uint4 u = *(const uint4*)(src + 8 * q); const unsigned w[4] = {u.x, u.y, u.z, u.w};
#pragma unroll
    for (int i = 0; i < 4; ++i) { x[8 * q + 2 * i] = __uint_as_float(w[i] << 16); x[8 * q + 2 * i + 1] = __uint_as_float(w[i] & 0xffff0000u); } }
}
DI void st32(bf16* __restrict__ dst, const float (&x)[32]) {
#pragma unroll
  for (int q = 0; q < 4; ++q) { uint4 u; u.x = cvt_pk_bf16_(x[8 * q], x[8 * q + 1]); u.y = cvt_pk_bf16_(x[8 * q + 2], x[8 * q + 3]); u.z = cvt_pk_bf16_(x[8 * q + 4], x[8 * q + 5]); u.w = cvt_pk_bf16_(x[8 * q + 6], x[8 * q + 7]); *(uint4*)(dst + 8 * q) = u; }
}


DI void ph_diffcombine_fast(PRef p, int l, int nrows, float lam_init) {
  const int tid_ = opq_tid(); const int bid_ = opq_bid(), nblk_ = opq_nblk();
  const int lane = tid_ & 63, gw = GTID >> 6, ngw = NTHR >> 6;
  const bf16* __restrict__ DO_ = (const bf16*)(p.ws + WS_DO); bf16* __restrict__ BI = (bf16*)(p.ws + WS_BI);
  const float* lv = p.in[I_DLAM] + l * 128;
  const float t1 = seg_sum(lane < 32 ? lv[lane] * lv[32 + lane] : 0.f, lane, 64), t2 = seg_sum(lane < 32 ? lv[64 + lane] * lv[96 + lane] : 0.f, lane, 64);
  const float lam = expf(t1) - expf(t2) + lam_init;
  const int h = lane >> 4, d = 4 * (lane & 15);
  float g[4];
#pragma unroll
  for (int i = 0; i < 4; ++i) g[i] = p.in[I_DSUBG][l * 64 + d + i] * (1.f - lam_init);
#pragma unroll 4
  for (int r = gw; r < nrows; r += ngw) {
    float a[4], b[4], v[4]; ld4(DO_ + (size_t)r * 512 + (2 * h) * 64 + d, a); ld4(DO_ + (size_t)r * 512 + (2 * h + 1) * 64 + d, b);
#pragma unroll
    for (int i = 0; i < 4; ++i) v[i] = a[i] - lam * b[i];
    const float ss = seg_sum(v[0] * v[0] + v[1] * v[1] + v[2] * v[2] + v[3] * v[3], lane, 16); const float rs = rsqrtf(ss * (1.f / 64.f) + EPS);
#pragma unroll
    for (int i = 0; i < 4; ++i) v[i] = v[i] * rs * g[i];
    st4(BI + (size_t)r * D + 512 + h * 64 + d, v);
  }
}

DI void ph_mod2_router_fast(PRef p, int l, int nrows, unsigned char* lds) {
  const int tid_ = opq_tid(); const int bid_ = opq_bid(), nblk_ = opq_nblk();
  const int lane = tid_ & 63, wave = tid_ >> 6;
  float* rwT = (float*)lds;
  unsigned* lcnt = (unsigned*)(lds + 131072 + 2048);
  int* rbuf = (int*)(lds + 131072 + 4096);
  const float* rw = p.in[I_RW] + (size_t)l * D * NE;
  for (int q = tid_; q < D * NE / 4; q += 512) { const float4 v = *(const float4*)(rw + (size_t)q * 4); const int c = q >> 3, e = (q & 7) * 4;
    rwT[(e + 0) * D + c] = v.x; rwT[(e + 1) * D + c] = v.y; rwT[(e + 2) * D + c] = v.z; rwT[(e + 3) * D + c] = v.w; }
  if (tid_ < 64) lcnt[tid_] = 0u;
  __syncthreads();
  const float* MOD = (const float*)(p.ws + WS_MOD); const float* XF = (const float*)(p.ws + WS_XF);
  bf16* H2 = (bf16*)(p.ws + WS_H2); float* HS = (float*)(p.ws + WS_HS); const float* g = p.in[I_N2G] + l * D; const float* rb = p.in[I_RB] + l * NE;
  int* ROUTE = (int*)(p.ws + WS_ROUTE); unsigned* cnt = (unsigned*)(p.ws + WS_CTL) + CW_CNT + l * 64; int* ROWTOK = (int*)(p.ws + WS_ROWTOK);
  const int per = (nrows + nblk_ - 1) / nblk_, rlo = bid_ * per, rhi = min(rlo + per, nrows);
  float4 cx0, cx1, cx2, cx3;
  { const int r = min(rlo + wave, nrows - 1); const float* x = XF + (size_t)r * D + lane * 4; cx0 = *(const float4*)(x); cx1 = *(const float4*)(x + 256); cx2 = *(const float4*)(x + 512); cx3 = *(const float4*)(x + 768); }
  for (int r = rlo + wave; r < rhi; r += 8) {
    float4 nx0, nx1, nx2, nx3;
    { const int rn = min(r + 8, nrows - 1); const float* x = XF + (size_t)rn * D + lane * 4; nx0 = *(const float4*)(x); nx1 = *(const float4*)(x + 256); nx2 = *(const float4*)(x + 512); nx3 = *(const float4*)(x + 768); }
    float v[16]; float ss = 0.f;
    { const float4 t4[4] = {cx0, cx1, cx2, cx3};
#pragma unroll
    for (int j = 0; j < 4; ++j) { const float4 t = t4[j]; v[4 * j] = t.x; v[4 * j + 1] = t.y; v[4 * j + 2] = t.z; v[4 * j + 3] = t.w; ss += t.x * t.x + t.y * t.y + t.z * t.z + t.w * t.w; } }
    cx0 = nx0; cx1 = nx1; cx2 = nx2; cx3 = nx3;
    ss = seg_sum(ss, lane, 64);
    const float rstd = rsqrtf(ss * (1.f / D) + EPS);
    const float* md = MOD + ((size_t)l * 9 + modidx(r)) * 6144;
#pragma unroll
    for (int j = 0; j < 4; ++j) { const int c = j * 256 + lane * 4; const float4 gg = *(const float4*)(g + c), s4 = *(const float4*)(md + 4 * 1024 + c), h4 = *(const float4*)(md + 3 * 1024 + c);
      v[4 * j] = v[4 * j] * rstd * gg.x * (1.f + s4.x) + h4.x; v[4 * j + 1] = v[4 * j + 1] * rstd * gg.y * (1.f + s4.y) + h4.y;
      v[4 * j + 2] = v[4 * j + 2] * rstd * gg.z * (1.f + s4.z) + h4.z; v[4 * j + 3] = v[4 * j + 3] * rstd * gg.w * (1.f + s4.w) + h4.w;
      }
    { float mx = 0.f;
#pragma unroll
      for (int i = 0; i < 16; ++i) mx = fmaxf(mx, fabsf(v[i]));
#pragma unroll
      for (int o = 1; o < 64; o <<= 1) mx = fmaxf(mx, lane_xor(mx, lane, o));
      const float sc = mx > 0.f ? mx * (1.f / 127.f) : 1.f, inv = 1.f / sc; if (lane == 0) HS[r] = sc;
#pragma unroll
      for (int j = 0; j < 4; ++j) { unsigned b = 0;
#pragma unroll
        for (int i = 0; i < 4; ++i) b |= ((unsigned)(int)rintf(v[4 * j + i] * inv) & 255u) << (8 * i);
        *(unsigned*)((signed char*)H2 + (size_t)r * D + j * 256 + lane * 4) = b; } }
    float lg[NE];
#pragma unroll
    for (int e = 0; e < NE; ++e) { float s = 0.f;
#pragma unroll
      for (int j = 0; j < 4; ++j) { const float4 w = *(const float4*)(rwT + e * D + j * 256 + lane * 4); s += v[4 * j] * w.x + v[4 * j + 1] * w.y + v[4 * j + 2] * w.z + v[4 * j + 3] * w.w; }
      lg[e] = s; }
#pragma unroll
    for (int e = 0; e < NE; ++e) lg[e] = seg_sum(lg[e], lane, 64) + rb[e];
    int te[4]; float tv[4];
#pragma unroll
    for (int k = 0; k < 4; ++k) { float best = -3.4e38f; int bi = 0;
#pragma unroll
      for (int e = 0; e < NE; ++e) { const bool taken = (k > 0 && te[0] == e) || (k > 1 && te[1] == e) || (k > 2 && te[2] == e); if (!taken && lg[e] > best) { best = lg[e]; bi = e; } }
      te[k] = bi; tv[k] = best; }
    const float mx = tv[0]; float ex[4], se = 0.f;
#pragma unroll
    for (int k = 0; k < 4; ++k) { ex[k] = expf(tv[k] - mx); se += ex[k]; }
    if (lane == 0) { int* rt = rbuf + (r - rlo) * 12;
#pragma unroll
      for (int k = 0; k < 4; ++k) { rt[3 * k] = te[k]; rt[3 * k + 1] = (int)atomicAdd(&lcnt[te[k]], 1u); rt[3 * k + 2] = __float_as_int(ex[k] / se); } }
  }
  __syncthreads();
  if (tid_ < NE) lcnt[32 + tid_] = lcnt[tid_] ? atomicAdd(&cnt[tid_], lcnt[tid_]) : 0u;
  __syncthreads();
  for (int q = tid_; q < (rhi - rlo) * 4; q += 512) { const int lr = q >> 2, k = q & 3; const int* rt = rbuf + lr * 12 + 3 * k; int* o = ROUTE + ((size_t)(rlo + lr) * 4 + k) * 4;
    const int pos = rt[1] + (int)lcnt[32 + rt[0]];
    o[0] = rt[0]; o[1] = pos; o[2] = rt[2]; o[3] = 0; ROWTOK[(size_t)rt[0] * T + pos] = rlo + lr; }
}


namespace fa {
DI void expcvt(f32x16& p0, f32x16& p1, bf16x8& pa0, bf16x8& pa1, bf16x8& pa2, bf16x8& pa3) {
#pragma unroll
  for (int r = 0; r < 16; ++r) p0[r] = __builtin_amdgcn_exp2f(p0[r]);
#pragma unroll
  for (int r = 0; r < 16; ++r) p1[r] = __builtin_amdgcn_exp2f(p1[r]);
#define FA_PK4(P, BASE, OUT) do { unsigned a0 = cvtpk(P[BASE + 0], P[BASE + 1]), a1 = cvtpk(P[BASE + 2], P[BASE + 3]);   \
    unsigned b0 = cvtpk(P[BASE + 4], P[BASE + 5]), b1 = cvtpk(P[BASE + 6], P[BASE + 7]);                              \
    u32x4 w = {a0, a1, b0, b1}; OUT = *reinterpret_cast<bf16x8*>(&w); } while (0)
  FA_PK4(p0, 0, pa0); FA_PK4(p0, 8, pa1); FA_PK4(p1, 0, pa2); FA_PK4(p1, 8, pa3);
#undef FA_PK4
}
template <int ND0, int KST = 0>
DI void qkt2(f32x16& p0, f32x16& p1, const char* Ks, const bf16x8* qr, const f32x16& nbt, int r32, int hi) {
#pragma unroll
  for (int d0 = 0; d0 < ND0; ++d0) { const int cb = (d0 * 16 + hi * 8) * 2;
    bf16x8 b0 = *reinterpret_cast<const bf16x8*>(Ks + (KST ? r32 * KST + cb : FA_KSWZ(r32, cb)));
    bf16x8 b1 = *reinterpret_cast<const bf16x8*>(Ks + (KST ? (32 + r32) * KST + cb : FA_KSWZ(32 + r32, cb)));
    p0 = __builtin_amdgcn_mfma_f32_32x32x16_bf16(b0, qr[d0], d0 == 0 ? nbt : p0, 0, 0, 0);
    p1 = __builtin_amdgcn_mfma_f32_32x32x16_bf16(b1, qr[d0], d0 == 0 ? nbt : p1, 0, 0, 0); }
}
DI void pv3(f32x16* o, int vb, bf16x8 pa0, bf16x8 pa1, bf16x8 pa2, bf16x8 pa3) { pv_one<0>(o[0], vb, pa0, pa1, pa2, pa3); pv_one<1>(o[1], vb, pa0, pa1, pa2, pa3); pv_one<2>(o[2], vb, pa0, pa1, pa2, pa3); }
DI void fill_ones(char* V_lds, int tid) {
  const int b = tid >> 8, t = tid & 255, key = t >> 2, c8 = (t & 3) * 8;
  u32x4 w = {c8 == 0 ? 0x00003F80u : 0u, 0u, 0u, 0u};
  *(u32x4*)(V_lds + b * SHM_V + v_st(key, 64 + c8)) = w;
}
template <int DQK>
DI void attn_unit2(const bf16* __restrict__ Qb, int ldq, const bf16* __restrict__ Kh, int ldk, const bf16* __restrict__ Vh, const float* __restrict__ nbp, int nbs, int kva, int kvb, int NT,
                   bf16* __restrict__ Ob, int ldo, char* lds, int tid) {
  constexpr int ND0 = DQK / 16;
  const int wid = tid >> 6, lane = tid & 63, r32 = lane & 31, hi = lane >> 5;
  char* V_lds = lds; char* K_lds = lds + 2 * SHM_V;
  f32x16 o[3] = {}; bf16x8 qr[ND0];
  const bf16* Qw = Qb + (long)(wid * 32 + r32) * ldq + hi * 8;
#pragma unroll
  for (int d0 = 0; d0 < ND0; ++d0) qr[d0] = *reinterpret_cast<const bf16x8*>(Qw + d0 * 16);
  const float nb = nbp[(long)(wid * 32 + r32) * nbs];
  f32x16 nbt;
#pragma unroll
  for (int r = 0; r < 16; ++r) nbt[r] = nb;
  const int sr = tid >> 4, sc = (tid & 15) * 8; const bool kact = sc < DQK, vact = sc < 64;
  const int vst0 = v_st(sr, sc & 63), vst1 = v_st(32 + sr, sc & 63);
  const int vb0 = (int)(uintptr_t)V_lds + v_rd_base(lane);
  struct { bf16x8 vs0, vs1, ks0, ks1; } sr_[2];
#define FA_KROW(j) ((j) < 4 ? kva + 64 * (j) : kvb + 64 * ((j) - 4))
#define FA_SLOAD(i, j) do { const long kr_ = FA_KROW(j); \
    if (vact) { sr_[i].vs0 = *reinterpret_cast<const bf16x8*>(&Vh[(kr_ + sr) * 256 + sc]); sr_[i].vs1 = *reinterpret_cast<const bf16x8*>(&Vh[(kr_ + 32 + sr) * 256 + sc]); } \
    if (kact) { sr_[i].ks0 = *reinterpret_cast<const bf16x8*>(&Kh[(kr_ + sr) * ldk + sc]); sr_[i].ks1 = *reinterpret_cast<const bf16x8*>(&Kh[(kr_ + 32 + sr) * ldk + sc]); } } while (0)
#define FA_SWRITE(b, i) do { if (vact) { *(bf16x8*)(V_lds + (b) * SHM_V + vst0) = sr_[i].vs0; *(bf16x8*)(V_lds + (b) * SHM_V + vst1) = sr_[i].vs1; } \
    if (kact) { const int kc = sc * 2; *(bf16x8*)(K_lds + (b) * SHM_K + FA_KSWZ(sr, kc)) = sr_[i].ks0; *(bf16x8*)(K_lds + (b) * SHM_K + FA_KSWZ(32 + sr, kc)) = sr_[i].ks1; } } while (0)
  f32x16 pA0, pA1, pB0, pB1; bf16x8 pa0, pa1, pa2, pa3;
  FA_SLOAD(0, 0); asm volatile("s_waitcnt vmcnt(0)" ::: "memory"); FA_SWRITE(0, 0); __syncthreads();
  qkt2<ND0>(pA0, pA1, K_lds, qr, nbt, r32, hi);
  FA_SLOAD(1, 1); if (2 < NT) FA_SLOAD(0, 2);
  FA_SWRITE(1, 1); __syncthreads();
  for (int j = 1; j + 1 < NT; j += 2) {
    FA_SBAR(); qkt2<ND0>(pB0, pB1, K_lds + SHM_K, qr, nbt, r32, hi);
    expcvt(pA0, pA1, pa0, pa1, pa2, pa3); FA_SBAR();
    FA_SLOAD(1, j + 2); FA_SBAR();
    pv3(o, vb0, pa0, pa1, pa2, pa3);
    __syncthreads(); FA_SWRITE(0, 0); __syncthreads();
    FA_SBAR(); qkt2<ND0>(pA0, pA1, K_lds, qr, nbt, r32, hi);
    expcvt(pB0, pB1, pa0, pa1, pa2, pa3); FA_SBAR();
    if (j + 3 < NT) FA_SLOAD(0, j + 3); FA_SBAR();
    pv3(o, vb0 + SHM_V, pa0, pa1, pa2, pa3);
    __syncthreads(); FA_SWRITE(1, 1); __syncthreads();
  }
  FA_SBAR(); qkt2<ND0>(pB0, pB1, K_lds + SHM_K, qr, nbt, r32, hi);
  expcvt(pA0, pA1, pa0, pa1, pa2, pa3); FA_SBAR();
  pv3(o, vb0, pa0, pa1, pa2, pa3);
  expcvt(pB0, pB1, pa0, pa1, pa2, pa3); FA_SBAR();
  pv3(o, vb0 + SHM_V, pa0, pa1, pa2, pa3);
  bf16* Ow = Ob + (long)(wid * 32) * ldo;
#pragma unroll
  for (int r = 0; r < 16; ++r) { const int orow = crow(r, hi);
    const float lsum = __int_as_float(__builtin_amdgcn_ds_bpermute((hi * 32) << 2, __float_as_int(o[2][r]))); const float rl = __builtin_amdgcn_rcpf(lsum);
#pragma unroll
    for (int d0 = 0; d0 < 2; ++d0) Ow[(long)orow * ldo + d0 * 32 + r32] = f2bf(o[d0][r] * rl); }
  __syncthreads();
#undef FA_KROW
#undef FA_SLOAD
#undef FA_SWRITE
}
typedef float f32x2v __attribute__((ext_vector_type(2)));
typedef __bf16 bf16x2v __attribute__((ext_vector_type(2)));
DI unsigned cvtpk_b(float lo, float hi) { f32x2v v = {lo, hi}; bf16x2v b = __builtin_convertvector(v, bf16x2v); return __builtin_bit_cast(unsigned, b); }
DI void expcvt_b(f32x16& p0, f32x16& p1, bf16x8& pa0, bf16x8& pa1, bf16x8& pa2, bf16x8& pa3) {
#pragma unroll
  for (int r = 0; r < 16; ++r) p0[r] = __builtin_amdgcn_exp2f(p0[r]);
#pragma unroll
  for (int r = 0; r < 16; ++r) p1[r] = __builtin_amdgcn_exp2f(p1[r]);
#define FA_PK4(P, BASE, OUT) do { u32x4 w = {cvtpk_b(P[BASE + 0], P[BASE + 1]), cvtpk_b(P[BASE + 2], P[BASE + 3]), cvtpk_b(P[BASE + 4], P[BASE + 5]), cvtpk_b(P[BASE + 6], P[BASE + 7])}; \
    OUT = *reinterpret_cast<bf16x8*>(&w); } while (0)
  FA_PK4(p0, 0, pa0); FA_PK4(p0, 8, pa1); FA_PK4(p1, 0, pa2); FA_PK4(p1, 8, pa3);
#undef FA_PK4
}
template <int NM> DI void step_pipeline() {
  __builtin_amdgcn_sched_group_barrier(0x100, 4, 0);
#pragma unroll
  for (int i = 0; i < NM; ++i) {
    __builtin_amdgcn_sched_group_barrier(0x008, 1, 0);
    __builtin_amdgcn_sched_group_barrier(0x400, 2, 0);
    __builtin_amdgcn_sched_group_barrier(0x002, 2, 0);
    __builtin_amdgcn_sched_group_barrier(0x100, 2, 0);
  }
}
template <int OFF> DI s16x4 tr_rd(int vb) { return __builtin_amdgcn_ds_read_tr16_b64_v4i16((__attribute__((address_space(3))) s16x4*)(vb + OFF)); }
template <int D0> DI void pv_one_b(f32x16& od, int vb, bf16x8 pa0, bf16x8 pa1, bf16x8 pa2, bf16x8 pa3) {
  const s16x4 l0 = tr_rd<v_rd_off(D0, 0, 0)>(vb), h0 = tr_rd<v_rd_off(D0, 0, 1)>(vb), l1 = tr_rd<v_rd_off(D0, 1, 0)>(vb), h1 = tr_rd<v_rd_off(D0, 1, 1)>(vb);
  const s16x4 l2 = tr_rd<v_rd_off(D0, 2, 0)>(vb), h2 = tr_rd<v_rd_off(D0, 2, 1)>(vb), l3 = tr_rd<v_rd_off(D0, 3, 0)>(vb), h3 = tr_rd<v_rd_off(D0, 3, 1)>(vb);
#define FA_PK(L, H) (bf16x8){L[0], L[1], L[2], L[3], H[0], H[1], H[2], H[3]}
  od = __builtin_amdgcn_mfma_f32_32x32x16_bf16(pa0, FA_PK(l0, h0), od, 0, 0, 0);
  od = __builtin_amdgcn_mfma_f32_32x32x16_bf16(pa1, FA_PK(l1, h1), od, 0, 0, 0);
  od = __builtin_amdgcn_mfma_f32_32x32x16_bf16(pa2, FA_PK(l2, h2), od, 0, 0, 0);
  od = __builtin_amdgcn_mfma_f32_32x32x16_bf16(pa3, FA_PK(l3, h3), od, 0, 0, 0);
#undef FA_PK
}
DI void pv3b(f32x16* o, int vb, bf16x8 pa0, bf16x8 pa1, bf16x8 pa2, bf16x8 pa3, bf16x8 onesB) { pv_one_b<0>(o[0], vb, pa0, pa1, pa2, pa3); pv_one_b<1>(o[1], vb, pa0, pa1, pa2, pa3);
  o[2] = __builtin_amdgcn_mfma_f32_32x32x16_bf16(pa0, onesB, o[2], 0, 0, 0); o[2] = __builtin_amdgcn_mfma_f32_32x32x16_bf16(pa1, onesB, o[2], 0, 0, 0);
  o[2] = __builtin_amdgcn_mfma_f32_32x32x16_bf16(pa2, onesB, o[2], 0, 0, 0); o[2] = __builtin_amdgcn_mfma_f32_32x32x16_bf16(pa3, onesB, o[2], 0, 0, 0); }
#ifndef FS_SPREAD
#define FS_SPREAD 1
#endif
#ifndef FS_AH
#define FS_AH 2
#endif
template <int NM> constexpr int fs_ec(int s) { const int e = (FS_SPREAD && NM >= 24) ? s + (s + 2) / 3 : 2 * s; return e < 32 ? e : 32; }
template <int NM> constexpr int fs_cc(int s) { const int c = s >= 1 ? fs_ec<NM>(s - 1) / 2 : 0; return c < 16 ? c : 16; }
DI s16x4 tr_rd2(int vb, int off) { return __builtin_amdgcn_ds_read_tr16_b64_v4i16((__attribute__((address_space(3))) s16x4*)(vb + off)); }
template <int ND0, int WI, int KST = 0>
DI void fused_step(f32x16& pn0, f32x16& pn1, f32x16& pc0, f32x16& pc1, bf16x8& an0, bf16x8& an1, bf16x8& an2, bf16x8& an3, bf16x8 ac0, bf16x8 ac1, bf16x8 ac2, bf16x8 ac3,
                   f32x16* o, const char* Ks, int vb, const bf16x8* qr, const f32x16& nbt, int r32, int hi, bf16x8 onesB) {
  constexpr int NQ = 2 * ND0, NM = NQ + 12, AH = FS_AH;
  bf16x8 kf[NQ]; s16x4 vl[8], vh[8]; unsigned w[16];
  bf16x8 kz_; s16x4 vz_; if (WI & (4 | 16 | 32)) { asm volatile("v_mov_b32 %0, 0" : "=v"(vz_[0])); u32x4 z4_ = {0u, 0u, 0u, 0u}; asm volatile("" : "+v"(z4_)); kz_ = *reinterpret_cast<bf16x8*>(&z4_); vz_ = (s16x4){0, 0, 0, 0}; asm volatile("" : "+v"(vz_)); }
#define FS_ISSUE(m) do { if ((WI & 4) || ((WI & 16) && (m) < NQ) || ((WI & 32) && (m) >= NQ)) { if ((m) < NQ) kf[(m) < NQ ? (m) : 0] = kz_; else if ((m) - NQ < 8) { const int q_ = (m) - NQ; vl[q_ >= 0 ? q_ : 0] = vz_; vh[q_ >= 0 ? q_ : 0] = vz_; } } else if ((m) < NQ) { kf[(m) < NQ ? (m) : 0] = *reinterpret_cast<const bf16x8*>(Ks + (KST ? (((m) & 1) * 32 + r32) * KST + ((((m) >> 1) * 16 + hi * 8) * 2) : FA_KSWZ(((m) & 1) * 32 + r32, ((((m) >> 1) * 16 + hi * 8) * 2)))); } \
    else if ((m) - NQ < 8) { const int q_ = (m) - NQ; vl[q_ >= 0 ? q_ : 0] = tr_rd2(vb, v_rd_off(q_ >> 2, q_ & 3, 0)); vh[q_ >= 0 ? q_ : 0] = tr_rd2(vb, v_rd_off(q_ >> 2, q_ & 3, 1)); } } while (0)
#define FS_PC(v) ((v) < 16 ? pc0[(v) & 15] : pc1[(v) & 15])
#pragma unroll
  for (int m = 0; m < AH; ++m) FS_ISSUE(m);
#pragma unroll
  for (int s_ = 0; s_ < NM; ++s_) {
    if (s_ + AH < NM) FS_ISSUE(s_ + AH);
    if (s_ < NQ) { const int d0 = s_ >> 1;
      if ((s_ & 1) == 0) pn0 = __builtin_amdgcn_mfma_f32_32x32x16_bf16(kf[s_ < NQ ? s_ : 0], qr[d0 < ND0 ? d0 : 0], d0 == 0 ? nbt : pn0, 0, 0, 0);
      else pn1 = __builtin_amdgcn_mfma_f32_32x32x16_bf16(kf[s_ < NQ ? s_ : 0], qr[d0 < ND0 ? d0 : 0], d0 == 0 ? nbt : pn1, 0, 0, 0);
    } else { const int q = s_ - NQ, blk = q >> 2, ks = q & 3; const int qi = (q >= 0 && q < 8) ? q : 0; const s16x4 L = vl[qi], H = vh[qi];
      const bf16x8 B = blk == 2 ? onesB : (bf16x8){L[0], L[1], L[2], L[3], H[0], H[1], H[2], H[3]};       const bf16x8 A = ks == 0 ? ac0 : (ks == 1 ? ac1 : (ks == 2 ? ac2 : ac3));
      o[blk >= 0 ? blk : 0] = __builtin_amdgcn_mfma_f32_32x32x16_bf16(A, B, o[blk >= 0 ? blk : 0], 0, 0, 0); }
#pragma unroll
    for (int v = fs_ec<NM>(s_); v < ((WI & 2) ? 0 : fs_ec<NM>(s_ + 1)); ++v) { float e0 = FS_PC(v); asm volatile("" : "+v"(e0)); e0 = __builtin_amdgcn_exp2f(e0); asm volatile("" : "+v"(e0));
      if (v < 16) pc0[v & 15] = e0; else pc1[v & 15] = e0; }
#pragma unroll
    for (int k = fs_cc<NM>(s_); k < ((WI & 2) ? 0 : fs_cc<NM>(s_ + 1)); ++k) { unsigned wk = cvtpk_b(FS_PC(2 * k), FS_PC(2 * k + 1)); asm volatile("" : "+v"(wk)); w[k & 15] = wk; }
    FA_SBAR();
  }
#pragma unroll
  for (int k = fs_cc<NM>(NM); k < ((WI & 2) ? 0 : 16); ++k) w[k] = cvtpk_b(FS_PC(2 * k), FS_PC(2 * k + 1));
  if (WI & 2) { an0 = ac0; an1 = ac1; an2 = ac2; an3 = ac3; } else
  { u32x4 t0 = {w[0], w[1], w[2], w[3]}, t1 = {w[4], w[5], w[6], w[7]}, t2 = {w[8], w[9], w[10], w[11]}, t3 = {w[12], w[13], w[14], w[15]};
    an0 = *reinterpret_cast<bf16x8*>(&t0); an1 = *reinterpret_cast<bf16x8*>(&t1); an2 = *reinterpret_cast<bf16x8*>(&t2); an3 = *reinterpret_cast<bf16x8*>(&t3); }
#undef FS_ISSUE
#undef FS_PC
}
template <int DQK, int WI>
DI void attn_unit3(const bf16* __restrict__ Qb, int ldq, const bf16* __restrict__ Kh, int ldk, const bf16* __restrict__ Vh, const float* __restrict__ nbp, int nbs, int kva, int kvb, int NT,
                   bf16* __restrict__ Ob, int ldo, char* lds, int tid) {
  constexpr int ND0 = DQK / 16;
  const int wid = tid >> 6, lane = tid & 63, r32 = lane & 31, hi = lane >> 5;
  char* V_lds = lds; char* K_lds = lds + 2 * SHM_V;
  f32x16 o[3] = {}; bf16x8 qr[ND0];
  const bf16* Qw = Qb + (long)(wid * 32 + r32) * ldq + hi * 8;
#pragma unroll
  for (int d0 = 0; d0 < ND0; ++d0) qr[d0] = *reinterpret_cast<const bf16x8*>(Qw + d0 * 16);
  const float nb = nbp[(long)(wid * 32 + r32) * nbs];
  f32x16 nbt;
#pragma unroll
  for (int r = 0; r < 16; ++r) nbt[r] = nb;
  const int sr = tid >> 4, sc = (tid & 15) * 8; const bool kact = sc < DQK, vact = sc < 64;
  const int vst0 = v_st(sr, sc & 63), vst1 = v_st(32 + sr, sc & 63);
  const int vb0 = (int)(uintptr_t)V_lds + v_rd_base(lane);
  bf16x8 vs0, vs1, ks0, ks1;
#define FA_KROW(j) ((j) < 4 ? kva + 64 * (j) : kvb + 64 * ((j) - 4))
#define FA_LOADK(j) do { if (kact) { const long kr_ = FA_KROW(j); ks0 = *reinterpret_cast<const bf16x8*>(&Kh[(kr_ + sr) * ldk + sc]); ks1 = *reinterpret_cast<const bf16x8*>(&Kh[(kr_ + 32 + sr) * ldk + sc]); } } while (0)
#define FA_LOADV(j) do { if (vact) { const long kr_ = FA_KROW(j); vs0 = *reinterpret_cast<const bf16x8*>(&Vh[(kr_ + sr) * 256 + sc]); vs1 = *reinterpret_cast<const bf16x8*>(&Vh[(kr_ + 32 + sr) * 256 + sc]); } } while (0)
#define FA_WRITEK(b) do { if (kact) { const int kc = sc * 2; *(bf16x8*)(K_lds + (b) * SHM_K + FA_KSWZ(sr, kc)) = ks0; *(bf16x8*)(K_lds + (b) * SHM_K + FA_KSWZ(32 + sr, kc)) = ks1; } } while (0)
#define FA_WRITEV(b) do { if (vact) { *(bf16x8*)(V_lds + (b) * SHM_V + vst0) = vs0; *(bf16x8*)(V_lds + (b) * SHM_V + vst1) = vs1; } } while (0)
  f32x16 pE0, pE1, pO0, pO1; bf16x8 ae0, ae1, ae2, ae3, ao0, ao1, ao2, ao3;
  bf16x8 onesB; { const unsigned ov = r32 == 0 ? 0x3F803F80u : 0u; u32x4 t = {ov, ov, ov, ov}; onesB = *reinterpret_cast<bf16x8*>(&t); }
  FA_LOADK(0); asm volatile("s_waitcnt vmcnt(0)" ::: "memory"); FA_WRITEK(0); __syncthreads();
  FA_LOADK(1);
  qkt2<ND0>(pE0, pE1, K_lds, qr, nbt, r32, hi);
  __syncthreads(); FA_WRITEK(1); __syncthreads(); FA_LOADK(2); FA_LOADV(0);
  FA_SBAR(); qkt2<ND0>(pO0, pO1, K_lds + SHM_K, qr, nbt, r32, hi); expcvt(pE0, pE1, ae0, ae1, ae2, ae3); FA_SBAR();
  __syncthreads(); FA_WRITEK(0); FA_WRITEV(0); __syncthreads(); if (3 < NT) FA_LOADK(3); FA_LOADV(1);
#define FA_SY() do { if (!(WI & 1)) __syncthreads(); } while (0)
#define FA_IO(x) do { if (!(WI & 8)) { x; } } while (0)
  for (int j = 1; j + 2 < NT; j += 2) {
    FA_SBAR(); asm volatile("" : "+v"(pO0), "+v"(pO1));
    fused_step<ND0, WI>(pE0, pE1, pO0, pO1, ao0, ao1, ao2, ao3, ae0, ae1, ae2, ae3, o, K_lds, vb0, qr, nbt, r32, hi, onesB);
    FA_SY(); FA_IO(FA_WRITEK(1); FA_WRITEV(1)); FA_SY(); FA_IO(if (j + 3 < NT) FA_LOADK(j + 3); FA_LOADV(j + 1));
    FA_SBAR(); asm volatile("" : "+v"(pE0), "+v"(pE1));
    fused_step<ND0, WI>(pO0, pO1, pE0, pE1, ae0, ae1, ae2, ae3, ao0, ao1, ao2, ao3, o, K_lds + SHM_K, vb0 + SHM_V, qr, nbt, r32, hi, onesB);
    FA_SY(); FA_IO(if (j + 3 < NT) FA_WRITEK(0); FA_WRITEV(0)); FA_SY(); FA_IO(if (j + 4 < NT) FA_LOADK(j + 4); if (j + 2 < NT) FA_LOADV(j + 2));
  }
#undef FA_SY
#undef FA_IO
  FA_SBAR(); expcvt(pO0, pO1, ao0, ao1, ao2, ao3); pv3b(o, vb0, ae0, ae1, ae2, ae3, onesB); FA_SBAR();
  __syncthreads(); FA_WRITEV(1); __syncthreads();
  pv3b(o, vb0 + SHM_V, ao0, ao1, ao2, ao3, onesB);
  bf16* Ow = Ob + (long)(wid * 32) * ldo;
#pragma unroll
  for (int r = 0; r < 16; ++r) { const int orow = crow(r, hi);
    const float lsum = __int_as_float(__builtin_amdgcn_ds_bpermute((hi * 32) << 2, __float_as_int(o[2][r]))); const float rl = __builtin_amdgcn_rcpf(lsum);
#pragma unroll
    for (int d0 = 0; d0 < 2; ++d0) Ow[(long)orow * ldo + d0 * 32 + r32] = f2bf(o[d0][r] * rl); }
  __syncthreads();
#undef FA_KROW
#undef FA_LOADK
#undef FA_LOADV
#undef FA_WRITEK
#undef FA_WRITEV
}
template <int DQK>
DI void attn_unit4(const bf16* __restrict__ Qb, int ldq, const bf16* __restrict__ Kh, int ldk, const bf16* __restrict__ Vh, const float* __restrict__ nbp, int nbs, int kva, int kvb, int NT,
                   bf16* __restrict__ Ob, int ldo, char* lds, int tid, bool prefetched, const bf16* Knext) {
  constexpr int ND0 = DQK / 16, CPR = DQK / 8 + 1, KST = CPR * 16, KSZ = 64 * KST;
  const int wid = __builtin_amdgcn_readfirstlane(tid >> 6), lane = tid & 63, r32 = lane & 31, hi = lane >> 5;
  char* V_lds = lds; char* K_lds = lds + 3 * SHM_V;
  f32x16 o[3] = {}; bf16x8 qr[ND0];
  const bf16* Qw = Qb + (long)(wid * 32 + r32) * ldq + hi * 8;
#pragma unroll
  for (int d0 = 0; d0 < ND0; ++d0) qr[d0] = *reinterpret_cast<const bf16x8*>(Qw + d0 * 16);
  const float nb = nbp[(long)(wid * 32 + r32) * nbs];
  f32x16 nbt;
#pragma unroll
  for (int r = 0; r < 16; ++r) nbt[r] = nb;
  const int vb0 = (int)(uintptr_t)V_lds + v_rd_base(lane);
  bf16x8 onesB; { const unsigned ov = r32 == 0 ? 0x3F803F80u : 0u; u32x4 t = {ov, ov, ov, ov}; onesB = *reinterpret_cast<bf16x8*>(&t); }
  unsigned kof0, kof1, vof;
  { const int c0 = 64 * wid + lane, c1 = c0 + 512; const int ra = c0 / CPR, ca = c0 - ra * CPR, rb = c1 / CPR, cb = c1 - rb * CPR;
    kof0 = (unsigned)(ra * ldk + (ca < CPR - 1 ? ca : 0) * 8) * 2u; kof1 = (unsigned)(rb * ldk + (cb < CPR - 1 ? cb : 0) * 8) * 2u;
    vof = (unsigned)((wid * 8 + ((lane & 31) >> 2)) * 256 + (lane >> 5) * 32 + (lane & 3) * 8) * 2u; }
  const bool k0act = wid < CPR, k1act = wid + 8 < CPR;
  const unsigned kl0 = (unsigned)(uintptr_t)K_lds + (unsigned)wid * 1024u, vl0 = (unsigned)(uintptr_t)V_lds + (unsigned)wid * 2048u;
#define FA_LAS __attribute__((address_space(3)))
#define FA_KROW(j) ((j) < 4 ? kva + 64 * (j) : kvb + 64 * ((j) - 4))
#define FA_DMAK(t, slot) do { const char* kb_ = (const char*)(Kh + (long)FA_KROW(t) * ldk); const unsigned kd_ = kl0 + (unsigned)(slot) * (unsigned)KSZ; \
    if (k0act) __builtin_amdgcn_global_load_lds((const unsigned*)(kb_ + kof0), (FA_LAS unsigned*)kd_, 16, 0, 0); \
    if (k1act) __builtin_amdgcn_global_load_lds((const unsigned*)(kb_ + kof1), (FA_LAS unsigned*)(kd_ + 8192u), 16, 0, 0); } while (0)
#define FA_DMAV(t, slot) do { const char* vb_ = (const char*)(Vh + (long)FA_KROW(t) * 256); \
    __builtin_amdgcn_global_load_lds((const unsigned*)(vb_ + vof), (FA_LAS unsigned*)(vl0 + (unsigned)(slot) * (unsigned)SHM_V), 16, 0, 0); } while (0)
#define FA_NX(s) ((s) == 2 ? 0 : (s) + 1)
#define FA_END(n) do { asm volatile("s_waitcnt vmcnt(" #n ")" ::: "memory"); __builtin_amdgcn_s_barrier(); } while (0)
  f32x16 pE0, pE1, pO0, pO1; bf16x8 ae0, ae1, ae2, ae3, ao0, ao1, ao2, ao3;
  if (!prefetched) { FA_DMAK(0, 0); FA_DMAK(1, 1); }
  FA_END(0);
#pragma unroll
  for (int d0 = 0; d0 < ND0; ++d0) asm volatile("" : "+v"(qr[d0]));
  asm volatile("" : "+v"(nbt));
  if (2 < NT) FA_DMAK(2, 2); FA_DMAV(0, 0);
  qkt2<ND0, KST>(pE0, pE1, K_lds, qr, nbt, r32, hi);
  FA_END(1);
  if (3 < NT) FA_DMAK(3, 0); FA_DMAV(1, 1);
  FA_SBAR(); qkt2<ND0, KST>(pO0, pO1, K_lds + KSZ, qr, nbt, r32, hi); expcvt(pE0, pE1, ae0, ae1, ae2, ae3); FA_SBAR();
  FA_END(1);
  int sj = 1;
  for (int j = 1; j + 2 < NT; j += 2) {
    { const int s1 = FA_NX(sj), s2 = FA_NX(s1);
      if (j + 3 < NT) FA_DMAK(j + 3, sj); FA_DMAV(j + 1, s1);
      FA_SBAR(); asm volatile("" : "+v"(pO0), "+v"(pO1));
      fused_step<ND0, 0, KST>(pE0, pE1, pO0, pO1, ao0, ao1, ao2, ao3, ae0, ae1, ae2, ae3, o, K_lds + s1 * KSZ, vb0 + s2 * SHM_V, qr, nbt, r32, hi, onesB);
      FA_END(1); sj = s1; }
    { const int s1 = FA_NX(sj), s2 = FA_NX(s1);
      if (j + 4 < NT) FA_DMAK(j + 4, sj); if (j + 2 < NT) FA_DMAV(j + 2, s1);
      FA_SBAR(); asm volatile("" : "+v"(pE0), "+v"(pE1));
      fused_step<ND0, 0, KST>(pO0, pO1, pE0, pE1, ae0, ae1, ae2, ae3, ao0, ao1, ao2, ao3, o, K_lds + s1 * KSZ, vb0 + s2 * SHM_V, qr, nbt, r32, hi, onesB);
      FA_END(1); sj = s1; }
  }
  { const int s2 = FA_NX(FA_NX(sj));
    if (Knext) { const char* kb_ = (const char*)Knext;
      if (k0act) __builtin_amdgcn_global_load_lds((const unsigned*)(kb_ + kof0), (FA_LAS unsigned*)kl0, 16, 0, 0);
      if (k1act) __builtin_amdgcn_global_load_lds((const unsigned*)(kb_ + kof1), (FA_LAS unsigned*)(kl0 + 8192u), 16, 0, 0);
      kb_ += (size_t)64 * ldk * 2;
      if (k0act) __builtin_amdgcn_global_load_lds((const unsigned*)(kb_ + kof0), (FA_LAS unsigned*)(kl0 + (unsigned)KSZ), 16, 0, 0);
      if (k1act) __builtin_amdgcn_global_load_lds((const unsigned*)(kb_ + kof1), (FA_LAS unsigned*)(kl0 + (unsigned)KSZ + 8192u), 16, 0, 0); }
    FA_SBAR(); expcvt(pO0, pO1, ao0, ao1, ao2, ao3); pv3b(o, vb0 + s2 * SHM_V, ae0, ae1, ae2, ae3, onesB); FA_SBAR();
    if (!Knext || !k0act) { FA_END(0); } else if (k1act) { FA_END(4); } else { FA_END(2); }
    sj = FA_NX(sj); }
  { const int s2 = FA_NX(FA_NX(sj)); pv3b(o, vb0 + s2 * SHM_V, ao0, ao1, ao2, ao3, onesB); }
  bf16* Ow = Ob + (long)(wid * 32) * ldo;
#pragma unroll
  for (int r = 0; r < 16; ++r) { const int orow = crow(r, hi);
    const float lsum = __int_as_float(__builtin_amdgcn_ds_bpermute((hi * 32) << 2, __float_as_int(o[2][r]))); const float rl = __builtin_amdgcn_rcpf(lsum);
#pragma unroll
    for (int d0 = 0; d0 < 2; ++d0) Ow[(long)orow * ldo + d0 * 32 + r32] = f2bf(o[d0][r] * rl); }
  __syncthreads();
#undef FA_KROW
#undef FA_DMAK
#undef FA_DMAV
#undef FA_NX
#undef FA_END
}
}

template <int DQK, int WI = 0>
DI void ph_attn_fast2(const bf16* Q, const bf16* K, const bf16* V, const float* QB, int nhv, int vdiv, bf16* O, int ldo, int ooff, int qbase, int nq_per_b, bool with_latent, unsigned char* lds) {
  const int tid_ = opq_tid(); const int bid_ = opq_bid(), nblk_ = opq_nblk();
  const int chunks = nq_per_b / 256, npairs = NB * nhv, nunits = npairs * chunks;
  const bool xmap = (nblk_ == 256) && (chunks == 16);
#define AT_DECODE(i, ok, pair, ch) do { if (xmap) { const int v = (i) * 32 + (bid_ >> 3); ok = v < nhv * 16; pair = (v >> 4) * 8 + (bid_ & 7); ch = v & 15; } \
    else { const int u = (i) * nblk_ + bid_; ok = u < nunits; pair = u / chunks; ch = u - pair * chunks; } } while (0)
  bool ok, pre = false; int pair, ch;
  AT_DECODE(0, ok, pair, ch);
  for (int i = 0; ok; ++i) {
    bool okn; int pairn, chn;
    AT_DECODE(i + 1, okn, pairn, chn); (void)chn;
    const int b = pair / nhv, hv = pair - b * nhv;
    const int r0 = qbase + b * nq_per_b + ch * 256;
    int tu_ = tid_; asm volatile("" : "+v"(tu_));
    if constexpr (WI == 0) {
      const int bn = pairn / nhv, hvn = pairn - bn * nhv;
      const bf16* Kn = okn ? K + hvn * DQK + (size_t)(TL + bn * CTX) * (nhv * DQK) : nullptr;
      fa::attn_unit4<DQK>(Q + (size_t)r0 * (nhv * DQK) + hv * DQK, nhv * DQK, K + hv * DQK, nhv * DQK, V + (hv / vdiv) * 64, QB + (size_t)r0 * nhv + hv, nhv, TL + b * CTX, b * SEQ, with_latent ? 68 : 4,
                        O + (size_t)r0 * ldo + ooff + hv * 64, ldo, (char*)lds, tu_, pre, Kn);
      pre = okn;
    } else {
      fa::attn_unit3<DQK, WI>(Q + (size_t)r0 * (nhv * DQK) + hv * DQK, nhv * DQK, K + hv * DQK, nhv * DQK, V + (hv / vdiv) * 64, QB + (size_t)r0 * nhv + hv, nhv, TL + b * CTX, b * SEQ, with_latent ? 68 : 4,
                        O + (size_t)r0 * ldo + ooff + hv * 64, ldo, (char*)lds, tu_);
    }
    ok = okn; pair = pairn; ch = chn;
  }
#undef AT_DECODE
}

DI void ph_na_fast2(PRef p, int l, unsigned char* lds8) {
  using namespace fa;
  const int tid_ = opq_tid(); const int bid_ = opq_bid(), nblk_ = opq_nblk();
  char* lds = (char*)lds8;
  const bf16* __restrict__ Q = (const bf16*)(p.ws + WS_NQ); const bf16* __restrict__ K = (const bf16*)(p.ws + WS_NK); const bf16* __restrict__ V = (const bf16*)(p.ws + WS_NV); bf16* __restrict__ BI = (bf16*)(p.ws + WS_BI);
  const float* __restrict__ QB = (const float*)(p.ws + WS_QBN);
  const float* rpb = p.in[I_RPB] + (size_t)l * NH * 15 * 31;
  const int wid = __builtin_amdgcn_readfirstlane(tid_ >> 6), lane = tid_ & 63, r32 = lane & 31, hi = lane >> 5;
  char* V_lds = lds; char* K_lds = lds + 2 * SHM_V;
  float* tbl = (float*)(lds + 2 * SHM_V + 2 * SHM_K + 2048);
  bf16x8 onesB; { const unsigned ov = r32 == 0 ? 0x3F803F80u : 0u; u32x4 t = {ov, ov, ov, ov}; onesB = *reinterpret_cast<bf16x8*>(&t); }
  const int sr = tid_ >> 4, sc = (tid_ & 15) * 8; const bool act = sc < 64;
  const int vst0 = v_st(sr, sc & 63), vst1 = v_st(32 + sr, sc & 63);
  const int vb0 = (int)(uintptr_t)V_lds + v_rd_base(lane);
  const bool xmap = (nblk_ == 256);
  for (int i = 0;; ++i) {
    int pair, g;
    if (xmap) { const int v = i * 32 + (bid_ >> 3); if (v >= 64) break; pair = (v >> 4) * 8 + (bid_ & 7); g = v & 15; }
    else { const int u = i * nblk_ + bid_; if (u >= NB * NH * 16) break; pair = u >> 4; g = u & 15; }
    const int b = pair >> 2, h = pair & 3;
    for (int k = tid_; k < 15 * 32; k += 512) { const int ii = k >> 5, jj = k & 31; tbl[k] = jj < 31 ? rpb[(h * 15 + ii) * 31 + jj] * LOG2E : 0.f; }
    const int lo = min(max(4 * g - 4, 0), 56), hiR = min(max(4 * g + 3 - 4, 0), 56) + 7, NT = 4 + (hiR - lo + 1);
    const int qrow = 4 * g + (wid >> 1), rs_w = min(max(qrow - 4, 0), 56), qc = 32 * (wid & 1) + r32, ws0 = min(max(qc - 8, 0), 48);
    const int r0 = b * SEQ + g * 256;
    const bf16* Kh = K + h * 64; const bf16* Vh = V + h * 64;
    unsigned vmask = 0u;
#pragma unroll
    for (int r = 0; r < 16; ++r) { const int kc = crow(r, hi); vmask |= ((unsigned)(kc - ws0) < 16u ? 1u : 0u) << r; vmask |= ((unsigned)(kc + 32 - ws0) < 16u ? 1u : 0u) << (16 + r); }
    const int bbase = 4 * hi - qc + 15;
    f32x16 o[3] = {}; bf16x8 qr[4];
    const bf16* Qw = Q + (size_t)(r0 + wid * 32 + r32) * 256 + h * 64 + hi * 8;
#pragma unroll
    for (int d0 = 0; d0 < 4; ++d0) qr[d0] = *reinterpret_cast<const bf16x8*>(Qw + d0 * 16);
    const float nb = QB[(size_t)(r0 + wid * 32 + r32) * 4 + h];
    f32x16 nbt;
#pragma unroll
    for (int r = 0; r < 16; ++r) nbt[r] = nb;
    bf16x8 vs0, vs1, ks0, ks1;
#define NA_KROW(j) ((j) < 4 ? TL + b * CTX + 64 * (j) : b * SEQ + (lo + (j) - 4) * 64)
#define NA_SLOAD(j) do { if (act) { const long kr_ = NA_KROW(j); vs0 = *reinterpret_cast<const bf16x8*>(&Vh[(kr_ + sr) * 256 + sc]); vs1 = *reinterpret_cast<const bf16x8*>(&Vh[(kr_ + 32 + sr) * 256 + sc]); \
      ks0 = *reinterpret_cast<const bf16x8*>(&Kh[(kr_ + sr) * 256 + sc]); ks1 = *reinterpret_cast<const bf16x8*>(&Kh[(kr_ + 32 + sr) * 256 + sc]); } } while (0)
#define NA_SWRITE(bb) do { if (act) { *(bf16x8*)(V_lds + (bb) * SHM_V + vst0) = vs0; *(bf16x8*)(V_lds + (bb) * SHM_V + vst1) = vs1; const int kc_ = sc * 2; \
      *(bf16x8*)(K_lds + (bb) * SHM_K + FA_KSWZ(sr, kc_)) = ks0; *(bf16x8*)(K_lds + (bb) * SHM_K + FA_KSWZ(32 + sr, kc_)) = ks1; } } while (0)
    NA_SLOAD(0); NA_SWRITE(0); __syncthreads();
    for (int j = 0; j < NT; ++j) {
      const int bb = j & 1;
      if (j + 1 < NT) NA_SLOAD(j + 1);
      const int kr = lo + j - 4;
      const bool wvalid = (j < 4) || (kr >= rs_w && kr < rs_w + 8);
      if (wvalid) {
        f32x16 p0, p1; bf16x8 pa0, pa1, pa2, pa3;
        qkt2<4>(p0, p1, K_lds + bb * SHM_K, qr, nbt, r32, hi);
        if (j >= 4) {
          const float* brow = tbl + (kr - qrow + 7) * 32 + bbase;
#pragma unroll
          for (int r = 0; r < 16; ++r) { const int co = (r & 3) + 8 * (r >> 2);
            p0[r] = ((vmask >> r) & 1u) ? p0[r] + brow[co] : -1e30f; p1[r] = ((vmask >> (16 + r)) & 1u) ? p1[r] + brow[co + 32] : -1e30f; }
        }
        expcvt_b(p0, p1, pa0, pa1, pa2, pa3);
        pv3b(o, vb0 + bb * SHM_V, pa0, pa1, pa2, pa3, onesB);
      }
      if (j + 1 < NT) NA_SWRITE(bb ^ 1);
      __syncthreads();
    }
    bf16* Ow = BI + (size_t)(r0 + wid * 32) * D + 768 + h * 64;
#pragma unroll
    for (int r = 0; r < 16; ++r) { const int orow = crow(r, hi);
      const float lsum = __int_as_float(__builtin_amdgcn_ds_bpermute((hi * 32) << 2, __float_as_int(o[2][r]))); const float rl = __builtin_amdgcn_rcpf(lsum);
#pragma unroll
      for (int d0 = 0; d0 < 2; ++d0) Ow[(size_t)orow * D + d0 * 32 + r32] = f2bf(o[d0][r] * rl); }
    __syncthreads();
#undef NA_KROW
#undef NA_SLOAD
#undef NA_SWRITE
  }
}

#define LAS __attribute__((address_space(3)))
#define XB_TMO      128
#define XB_XCNT(j)  (256  + 64 * (j))
#define XB_XSUB(j)  (1280 + 64 * (j))
#define XB_XGEN(j)  (2304 + 64 * (j))
#define XB_TOP      3328
#define XB_TOPGEN   3392
#define XCD_BAR_WORDS 3456
#define XB_SPIN_CAP (1u << 24)
__device__ __forceinline__ unsigned xb_ld(unsigned* p)              { return __hip_atomic_load(p, __ATOMIC_RELAXED, __HIP_MEMORY_SCOPE_AGENT); }
__device__ __forceinline__ unsigned xb_add(unsigned* p, unsigned v) { return __hip_atomic_fetch_add(p, v, __ATOMIC_RELAXED, __HIP_MEMORY_SCOPE_AGENT); }
__device__ __forceinline__ unsigned xb_xcc_id() { return (unsigned)__builtin_amdgcn_s_getreg((3 << 11) | 20) & 0xFu; }
#define XB_SPIN(cond, bar) do { unsigned _sp = 0; while (cond) { __builtin_amdgcn_s_sleep(1); \
    if ((++_sp & 255u) == 0u) { if (xb_ld(&(bar)[XB_TMO])) break; if (_sp > XB_SPIN_CAP) { atomicAdd(&(bar)[XB_TMO], 1u); break; } } } } while (0)
struct XcdBarrier { unsigned* bar; unsigned x; volatile LAS unsigned* st; };
__device__ __forceinline__ XcdBarrier xcd_barrier_post(unsigned* bar, volatile LAS unsigned* st) {
    XcdBarrier b; b.bar = bar; b.x = xb_xcc_id(); b.st = st;
    if (threadIdx.x == 0) (void)xb_add(&bar[XB_XCNT(b.x)], 1u);
    return b;
}
__device__ __forceinline__ void xcd_barrier_complete(unsigned* bar, unsigned x, unsigned& nloc, unsigned& nx) {
    const unsigned G = gridDim.x * gridDim.y * gridDim.z;
    unsigned sum, cnt, mine, sp = 0u;
    for (;;) {
        sum = 0u; cnt = 0u; mine = 0u;
#pragma unroll
        for (unsigned j = 0; j < 16; ++j) { const unsigned c = xb_ld(&bar[XB_XCNT(j)]); sum += c; cnt += (c > 0u) ? 1u : 0u; }
        mine = xb_ld(&bar[XB_XCNT(x)]);
        if (sum == G) break;
        __builtin_amdgcn_s_sleep(1);
        if ((++sp & 255u) == 0u) { if (xb_ld(&bar[XB_TMO])) break; if (sp > XB_SPIN_CAP) { atomicAdd(&bar[XB_TMO], 1u); break; } }
    }
    nloc = mine > 0u ? mine : 1u; nx = cnt > 0u ? cnt : 1u;
}
__device__ __forceinline__ void xcd_barrier(const XcdBarrier& b) {
    asm volatile("s_waitcnt vmcnt(0)" ::: "memory");
    __syncthreads();
    if (threadIdx.x == 0) {
        unsigned* bar = b.bar; unsigned bx = b.x; asm volatile("" : "+s"(bar), "+s"(bx));
        __builtin_amdgcn_s_waitcnt(0);
        unsigned nloc = b.st[0], nx = b.st[1];
        if (nloc == 0u) { xcd_barrier_complete(bar, bx, nloc, nx); b.st[0] = nloc; b.st[1] = nx; }
        const unsigned old = xb_add(&bar[XB_XSUB(bx)], 1u);
        const unsigned gen = old / nloc;
        if (old + 1u == (gen + 1u) * nloc) {
            __builtin_amdgcn_fence(__ATOMIC_RELEASE, "agent");
            asm volatile("s_waitcnt vmcnt(0)" ::: "memory");
            const unsigned og = xb_add(&bar[XB_TOP], 1u);
            const unsigned tg = og / nx;
            if (og + 1u == (tg + 1u) * nx) xb_add(&bar[XB_TOPGEN], 1u);
            else XB_SPIN(xb_ld(&bar[XB_TOPGEN]) == tg, bar);
            __builtin_amdgcn_fence(__ATOMIC_ACQUIRE, "agent");
            xb_add(&bar[XB_XGEN(bx)], 1u);
            asm volatile("s_waitcnt vmcnt(0)" ::: "memory");
        } else {
            XB_SPIN(xb_ld(&bar[XB_XGEN(bx)]) == gen, bar);
            __builtin_amdgcn_fence(__ATOMIC_ACQUIRE, "agent");
            asm volatile("s_waitcnt vmcnt(0)" ::: "memory");
        }
    }
    __syncthreads();
}

constexpr int LDS_BYTES = 147456;
constexpr int BARW_OFF = 131072 + 512;
constexpr int CW_BAR = 4096;

#ifndef ATTN_V2
#define ATTN_V2 1
#endif
#ifndef REP_GEMM
#define REP_GEMM 1
#endif
#ifndef REP_ATTN
#define REP_ATTN 1
#endif
#ifndef REP_SMALL
#define REP_SMALL 1
#endif
#ifndef REP_CVT
#define REP_CVT 1
#endif
#ifndef REP_MD
#define REP_MD 1
#endif
#ifndef FA_WI
#define FA_WI 0
#endif
#define REPEAT_L(n, stmt) do { if ((n) == 1) { stmt; } else { int n_ = (n); asm volatile("" : "+s"(n_)); for (int rep_ = 0; rep_ < n_; ++rep_) { stmt; __syncthreads(); } } } while (0)
#define REPEAT(n, stmt) do { _Pragma("unroll") for (int rep_ = 0; rep_ < (n); ++rep_) { stmt; if ((n) > 1) __syncthreads(); } } while (0)
template <int l>
DI void layer_program(const XcdBarrier& bar, unsigned char* lds) {
#define GBAR() xcd_barrier(bar)
    const bool last = (l == 1);
    const int nrows = last ? TL : T;
    const float lam_init = last ? 0.35550906759096924f : 0.2f;
    if (l == 0) { REPEAT(REP_SMALL, ph_mod1(PP, l)); GBAR(); }
    REPEAT(REP_GEMM, ph_proj_fast(PP, l, lds));
    GBAR();
    REPEAT(REP_GEMM, ph_qkvraw_fast(PP, l, lds));
    REPEAT(REP_SMALL, ph_conv(PP, l, nrows, lds));
    GBAR();
#if ATTN_V2
#if REP_MD > 1
    { int n_ = REP_MD; asm volatile("" : "+s"(n_)); for (int rep_ = 0; rep_ < n_ - 1; ++rep_) { ph_attn_fast2<96, FA_WI>((const bf16*)(PP.ws + WS_MQ), (const bf16*)(PP.ws + WS_MK), (const bf16*)(PP.ws + WS_MV), (const float*)(PP.ws + WS_QBM), 4, 1, (bf16*)(PP.ws + WS_BI), D, 256, 0, SEQ, true, lds); __syncthreads(); ph_attn_fast2<32, FA_WI>((const bf16*)(PP.ws + WS_DQ), (const bf16*)(PP.ws + WS_DK), (const bf16*)(PP.ws + WS_DV), (const float*)(PP.ws + WS_QBD), 8, 2, (bf16*)(PP.ws + WS_DO), 512, 0, 0, SEQ, true, lds); __syncthreads(); } }
#endif
    ph_attn_fast2<96>((const bf16*)(PP.ws + WS_MQ), (const bf16*)(PP.ws + WS_MK), (const bf16*)(PP.ws + WS_MV), (const float*)(PP.ws + WS_QBM), 4, 1, (bf16*)(PP.ws + WS_BI), D, 256, 0, SEQ, true, lds);
    ph_attn_fast2<32>((const bf16*)(PP.ws + WS_DQ), (const bf16*)(PP.ws + WS_DK), (const bf16*)(PP.ws + WS_DV), (const float*)(PP.ws + WS_QBD), 8, 2, (bf16*)(PP.ws + WS_DO), 512, 0, 0, SEQ, true, lds);
    REPEAT(REP_ATTN, ph_na_fast2(PP, l, lds));
    if (!last) {
      ph_attn_fast2<96>((const bf16*)(PP.ws + WS_MQ), (const bf16*)(PP.ws + WS_MK), (const bf16*)(PP.ws + WS_MV), (const float*)(PP.ws + WS_QBM), 4, 1, (bf16*)(PP.ws + WS_BI), D, 256, TL, CTX, false, lds);
      ph_attn_fast2<32>((const bf16*)(PP.ws + WS_DQ), (const bf16*)(PP.ws + WS_DK), (const bf16*)(PP.ws + WS_DV), (const float*)(PP.ws + WS_QBD), 8, 2, (bf16*)(PP.ws + WS_DO), 512, 0, TL, CTX, false, lds);
      ph_attn_fast2<64>((const bf16*)(PP.ws + WS_NQ), (const bf16*)(PP.ws + WS_NK), (const bf16*)(PP.ws + WS_NV), (const float*)(PP.ws + WS_QBN), 4, 1, (bf16*)(PP.ws + WS_BI), D, 768, TL, CTX, false, lds);
    }
    GBAR();
#else
    REPEAT(REP_ATTN, ph_attn_fast<96>((const bf16*)(PP.ws + WS_MQ), (const bf16*)(PP.ws + WS_MK), (const bf16*)(PP.ws + WS_MV), 4, 1, (bf16*)(PP.ws + WS_BI), D, 256, 0, SEQ, true, lds));
    REPEAT(REP_ATTN, ph_attn_fast<32>((const bf16*)(PP.ws + WS_DQ), (const bf16*)(PP.ws + WS_DK), (const bf16*)(PP.ws + WS_DV), 8, 2, (bf16*)(PP.ws + WS_DO), 512, 0, 0, SEQ, true, lds));
    REPEAT(REP_ATTN, ph_na_fast(PP, l, lds));
    if (!last) {
      ph_attn_fast<96>((const bf16*)(PP.ws + WS_MQ), (const bf16*)(PP.ws + WS_MK), (const bf16*)(PP.ws + WS_MV), 4, 1, (bf16*)(PP.ws + WS_BI), D, 256, TL, CTX, false, lds);
      ph_attn_fast<32>((const bf16*)(PP.ws + WS_DQ), (const bf16*)(PP.ws + WS_DK), (const bf16*)(PP.ws + WS_DV), 8, 2, (bf16*)(PP.ws + WS_DO), 512, 0, TL, CTX, false, lds);
      ph_attn_fast<64>((const bf16*)(PP.ws + WS_NQ), (const bf16*)(PP.ws + WS_NK), (const bf16*)(PP.ws + WS_NV), 4, 1, (bf16*)(PP.ws + WS_BI), D, 768, TL, CTX, false, lds);
    }
    GBAR();
#endif
    REPEAT(REP_SMALL, ph_diffcombine_fast(PP, l, nrows, lam_init));
    GBAR();
    REPEAT(REP_GEMM, ph_branch_fast(PP, l, nrows, lds));
    GBAR();
    REPEAT(REP_GEMM, ph_merge_fast(PP, l, nrows, lds));
    GBAR();
    REPEAT((l == 0 ? REP_GEMM : 1), ph_wo_fast(PP, l, nrows, lds));
    GBAR();
    ph_mod2_router_fast(PP, l, nrows, lds);
    GBAR();
    REPEAT(REP_GEMM, ph_moe1_fast(PP, l, lds));
    GBAR();
    REPEAT(REP_GEMM, ph_moe2_fast(PP, l, lds));
    GBAR();
    ph_combine(PP, l, nrows, lds);
    if (l == 0) GBAR();
}

__global__ void __launch_bounds__(512, 2) fwd(Params p) {
  extern __shared__ __attribute__((aligned(16))) unsigned char lds[];
  if (threadIdx.x < 4) ((unsigned*)(lds + BARW_OFF))[threadIdx.x] = 0u;
  __syncthreads();
  XcdBarrier bar = xcd_barrier_post((unsigned*)(PP.ws + WS_CTL) + CW_BAR, (volatile LAS unsigned*)(lds + BARW_OFF));
  ph_ada_fast(PP, lds);
  __syncthreads();
  REPEAT(REP_CVT, ph_convert(PP, lds));
  GBAR();
  layer_program<0>(bar, lds);
  layer_program<1>(bar, lds);
}

extern "C" void kernel_launch(void* const* d_in, const int* in_sizes, int n_in, void* d_out, int out_size, void* d_ws, size_t ws_size, hipStream_t stream) {
  static int grid = 0;
  if (grid == 0) {
    if (n_in != N_IN || ws_size < WS_END) { fprintf(stderr, "kernel_launch: n_in %d ws %zu need %zu\n", n_in, ws_size, (size_t)WS_END); grid = -1; return; }
    int dev = 0, cus = 0;
    if (hipGetDevice(&dev) != hipSuccess || hipDeviceGetAttribute(&cus, hipDeviceAttributeMultiprocessorCount, dev) != hipSuccess) { grid = -1; return; }
    if (hipFuncSetAttribute((const void*)fwd, hipFuncAttributeMaxDynamicSharedMemorySize, LDS_BYTES) != hipSuccess) { fprintf(stderr, "kernel_launch: hipFuncSetAttribute failed\n"); grid = -1; return; }
    int per_cu = 0;
    if (hipOccupancyMaxActiveBlocksPerMultiprocessor(&per_cu, (const void*)fwd, 512, LDS_BYTES) != hipSuccess || per_cu < 1) fprintf(stderr, "kernel_launch: occupancy query says %d\n", per_cu);
    (void)hipGetLastError();
    grid = cus;
  }
  if (grid < 0) return;
  Params p{};
  for (int i = 0; i < N_IN; ++i) p.in[i] = (const float*)d_in[i];
  p.out = (float*)d_out; p.ws = (unsigned char*)d_ws;
  (void)hipMemsetAsync((char*)d_ws + WS_CTL, 0, 1 * MiB, stream);
  (void)hipMemsetAsync((char*)d_ws + WS_QKV_T, 0, (size_t)2 * 1024 * 384 * 2, stream);
  (void)hipMemsetAsync((char*)d_ws + WS_WIN_T, 0, (size_t)2 * PLD * D * 2, stream);
  hipLaunchKernelGGL(fwd, dim3(grid), dim3(512), LDS_BYTES, stream, p);
}
```

```cpp
#include <hip/hip_runtime.h>
#include <cstdio>
#include <cstdint>

typedef unsigned short bf16;
#ifndef FAST_ATTN
#define FAST_ATTN 1
#endif
#if FAST_ATTN
#define ATTN_FN ph_attn_fast
#define ATTN_LDS , lds
#else
#define ATTN_FN ph_attn_naive
#define ATTN_LDS
#endif
#ifndef FAST_NA
#define FAST_NA 1
#endif
#ifndef FAST_SMALL
#define FAST_SMALL 1
#endif
#ifndef FAST_ROUTER
#define FAST_ROUTER 1
#endif
#ifndef FAST_PROJ
#define FAST_PROJ 1
#endif
#ifndef FAST_QKV
#define FAST_QKV 1
#endif
#ifndef FAST_MERGE
#define FAST_MERGE 1
#endif
#ifndef FAST_WO
#define FAST_WO 1
#endif
#ifndef FAST_MOE
#define FAST_MOE 1
#endif
#define DI __device__ __forceinline__

constexpr int D = 1024, NB = 8, SEQ = 4096, CTX = 256, GW = 64;
constexpr int TL = NB * SEQ;
constexpr int TC = NB * CTX;
constexpr int T = TL + TC;
constexpr int NH = 4;
constexpr int INW = 2400, PLD = 2560;
constexpr int OFF_B = 512, OFF_C = 864, OFF_D = 1632;
constexpr int NE = 32, DFF = 1024;
constexpr int MAXROWS = 4 * T + NE * 256;
constexpr float EPS = 1e-6f;
constexpr float LOG2E = 1.4426950408889634f;

enum { I_X = 0, I_C, I_CTX, I_CCTX, I_ADAW, I_ADAB, I_N1G, I_N2G, I_WIN, I_CONVW, I_CONVB, I_CLNG, I_CLNB, I_CONVOUT,
       I_CQG, I_CKVG, I_WUQ, I_WUKV, I_QNG, I_KNG, I_MLAOUT, I_DQNG, I_DKNG, I_DLAM, I_DSUBG, I_DIFFOUT, I_NQNG, I_NKNG,
       I_RPB, I_NAOUT, I_GATEW, I_GATEB, I_WO, I_RW, I_RB, I_WGU, I_BGU, I_WDN, I_BDN, N_IN };

constexpr size_t MiB = 1u << 20;
constexpr size_t al(size_t x) { return (x + 255) / 256 * 256; }
constexpr size_t WS_CTL = 0;
constexpr size_t WS_MOD = 1 * MiB;
constexpr size_t WS_ROPE = WS_MOD + al(2 * 9 * 6144 * 4);
constexpr size_t WS_ROUTE = WS_ROPE + al(4096 * 32 * 4);
constexpr size_t WS_ROWTOK = WS_ROUTE + al((size_t)T * 4 * 16);
constexpr size_t WS_HS = WS_ROWTOK + al((size_t)NE * T * 4);
constexpr size_t WS_WGUS = WS_HS + al((size_t)T * 4);
constexpr size_t WS_HS1 = WS_WGUS + al((size_t)2 * NE * 2048 * 4);
constexpr size_t WS_WINS = WS_HS1 + al((size_t)T * 4);
constexpr size_t WS_GATES = WS_WINS + al((size_t)2 * PLD * 4);
constexpr size_t WS_WIN_T = WS_GATES + al((size_t)2 * 4096 * 4);
constexpr size_t WS_QKV_T = WS_WIN_T + al((size_t)2 * PLD * D * 2);
constexpr size_t WS_WB_T = WS_QKV_T + al((size_t)2 * 1024 * 384 * 2);
constexpr size_t WS_GATE_T = WS_WB_T + al((size_t)2 * 4 * 1024 * 256 * 2);
constexpr size_t WS_WO_T = WS_GATE_T + al((size_t)2 * 4096 * D * 2);
constexpr size_t WS_WGU_T = WS_WO_T + al((size_t)2 * D * D * 2);
constexpr size_t WS_WDN_T = WS_WGU_T + al((size_t)2 * NE * 2048 * D * 2);
constexpr size_t WS_H = WS_WDN_T + al((size_t)2 * NE * D * DFF * 2);
constexpr size_t WS_H2 = WS_H + al((size_t)T * D * 2);
constexpr size_t WS_XF = WS_H2 + al((size_t)T * D * 2);
constexpr size_t WS_SCR = WS_XF + al((size_t)T * D * 4);
constexpr size_t WS_PROJ = WS_SCR;
constexpr size_t WS_CU = WS_PROJ + al((size_t)T * PLD * 2);
constexpr size_t WS_AQ = WS_CU + al((size_t)T * 256 * 2);
constexpr size_t WS_QKVRAW = WS_AQ + al((size_t)T * 384 * 2);
constexpr size_t WS_MQ = WS_QKVRAW + al((size_t)T * 1024 * 2);
constexpr size_t WS_MK = WS_MQ + al((size_t)T * 384 * 2);
constexpr size_t WS_MV = WS_MK + al((size_t)T * 384 * 2);
constexpr size_t WS_DQ = WS_MV + al((size_t)T * 256 * 2);
constexpr size_t WS_DK = WS_DQ + al((size_t)T * 256 * 2);
constexpr size_t WS_DV = WS_DK + al((size_t)T * 256 * 2);
constexpr size_t WS_NQ = WS_DV + al((size_t)T * 256 * 2);
constexpr size_t WS_NK = WS_NQ + al((size_t)T * 256 * 2);
constexpr size_t WS_NV = WS_NK + al((size_t)T * 256 * 2);
constexpr size_t WS_BI = WS_NV + al((size_t)T * 256 * 2);
constexpr size_t WS_DO = WS_BI + al((size_t)T * D * 2);
constexpr size_t WS_QBM = WS_DO + al((size_t)T * 512 * 2);
constexpr size_t WS_QBD = WS_QBM + al((size_t)T * 4 * 4);
constexpr size_t WS_QBN = WS_QBD + al((size_t)T * 8 * 4);
constexpr size_t WS_KPE = WS_QBN + al((size_t)T * 4 * 4);
constexpr size_t WS_YB = WS_KPE + al((size_t)T * 32 * 2);
constexpr size_t WS_YM = WS_YB + al((size_t)T * 4096 * 2);
constexpr size_t WS_MIX_END = WS_YM + al((size_t)T * D * 2);
constexpr size_t WS_ACT = WS_SCR;
constexpr size_t WS_YE = WS_ACT + al((size_t)MAXROWS * D * 2);
constexpr size_t WS_MOE_END = WS_YE + al((size_t)MAXROWS * D * 2);
constexpr size_t WS_END = WS_MIX_END > WS_MOE_END ? WS_MIX_END : WS_MOE_END;
static_assert(WS_END <= (size_t)2048 * MiB, "workspace budget (>= 2 GiB guaranteed)");
constexpr int CW_BIASMAX = 2048;
constexpr int CW_CNT = 1024;

struct Params {
  const float* in[N_IN];
  float* out;
  unsigned char* ws;
};
typedef const __attribute__((address_space(4))) Params& PRef;
typedef const __attribute__((address_space(4))) Params* PPtr;
__device__ __forceinline__ PPtr opq_params() { PPtr pp = (PPtr)__builtin_amdgcn_kernarg_segment_ptr(); asm volatile("" : "+s"(pp)); return pp; }
#define PP (*opq_params())

DI float bf2f(bf16 v) { return __uint_as_float(((unsigned)v) << 16); }
DI bf16 f2bf(float f) { unsigned u = __float_as_uint(f); u += 0x7fffu + ((u >> 16) & 1u); return (bf16)(u >> 16); }
DI float sigmoidf_(float x) { return 1.f / (1.f + __expf(-x)); }
DI float wave_sum_l(float v, int lane) {
#pragma unroll
  for (int o = 1; o < 64; o <<= 1) v += __int_as_float(__builtin_amdgcn_ds_bpermute((lane ^ o) << 2, __float_as_int(v)));
  return v;
}
#define wave_sum(v) wave_sum_l((v), lane)
DI unsigned cvt_pk_bf16_(float lo, float hi) { unsigned r; asm volatile("v_cvt_pk_bf16_f32 %0, %1, %2" : "=v"(r) : "v"(lo), "v"(hi)); return r; }
DI float seg_sum(float v, int lane, int width) {
#pragma unroll
  for (int o = 1; o < 64; o <<= 1) if (o < width) v += __int_as_float(__builtin_amdgcn_ds_bpermute((lane ^ o) << 2, __float_as_int(v)));
  return v;
}
DI float lane_xor(float v, int lane, int o) { return __int_as_float(__builtin_amdgcn_ds_bpermute((lane ^ o) << 2, __float_as_int(v))); }

DI void quant_row_i8(const float (&v)[16], signed char* dst, float* scale_out, int lane) {
  float mx = 0.f;
#pragma unroll
  for (int i = 0; i < 16; ++i) mx = fmaxf(mx, fabsf(v[i]));
#pragma unroll
  for (int o = 1; o < 64; o <<= 1) mx = fmaxf(mx, lane_xor(mx, lane, o));
  const float sc = mx > 0.f ? mx * (1.f / 127.f) : 1.f, inv = 1.f / sc; if (lane == 0) *scale_out = sc;
#pragma unroll
  for (int j = 0; j < 4; ++j) { unsigned b = 0;
#pragma unroll
    for (int i = 0; i < 4; ++i) b |= ((unsigned)(int)rintf(v[4 * j + i] * inv) & 255u) << (8 * i);
    *(unsigned*)(dst + j * 256 + lane * 4) = b; }
}
DI void ld4(const bf16* p, float (&x)[4]) { const uint2 u = *(const uint2*)p; x[0] = __uint_as_float(u.x << 16); x[1] = __uint_as_float(u.x & 0xffff0000u); x[2] = __uint_as_float(u.y << 16); x[3] = __uint_as_float(u.y & 0xffff0000u); }
DI void st4(bf16* p, const float (&x)[4]) { uint2 u; u.x = cvt_pk_bf16_(x[0], x[1]); u.y = cvt_pk_bf16_(x[2], x[3]); *(uint2*)p = u; }

DI int opq_bid() { int b = blockIdx.x; asm volatile("" : "+s"(b)); return b; }
DI int opq_nblk() { int g = gridDim.x; asm volatile("" : "+s"(g)); return g; }
DI int opq_tid() { int t = threadIdx.x; asm volatile("" : "+v"(t)); return t; }
#define GTID ((int)(bid_ * 512 + tid_))
#define NTHR ((int)(nblk_ * 512))
#define SUB ((int)(tid_ >> 8))
#define T256 ((int)(tid_ & 255))
DI int modidx(int r) { return r < TL ? (r >> 12) : NB; }


DI const float* stream_row(PRef p, int l, int r, bool after_mixer) {
  if (l == 0 && !after_mixer) return r < TL ? p.in[I_X] + (size_t)r * D : p.in[I_CTX] + (size_t)(r - TL) * D;
  return (const float*)(p.ws + WS_XF) + (size_t)r * D;
}
DI void ph_mod1(PRef p, int l) {
  const int tid_ = opq_tid(); const int bid_ = opq_bid(), nblk_ = opq_nblk(); (void)bid_; (void)nblk_;
  const int lane = tid_ & 63, gw = GTID >> 6, ngw = NTHR >> 6;
  const float* MOD = (const float*)(p.ws + WS_MOD);
  bf16* H = (bf16*)(p.ws + WS_H);
  const float* g = p.in[I_N1G] + l * D;
  float4 c0, c1, c2, c3;
  { const float* x = stream_row(p, l, min(gw, T - 1), false) + lane * 4; c0 = *(const float4*)(x); c1 = *(const float4*)(x + 256); c2 = *(const float4*)(x + 512); c3 = *(const float4*)(x + 768); }
  for (int r = gw; r < T; r += ngw) {
    float4 n0, n1, n2, n3;
    { const float* x = stream_row(p, l, min(r + ngw, T - 1), false) + lane * 4; n0 = *(const float4*)(x); n1 = *(const float4*)(x + 256); n2 = *(const float4*)(x + 512); n3 = *(const float4*)(x + 768); }
    float v[16]; float ss = 0.f;
    { const float4 t4[4] = {c0, c1, c2, c3};
#pragma unroll
    for (int j = 0; j < 4; ++j) { const float4 t = t4[j]; v[4 * j] = t.x; v[4 * j + 1] = t.y; v[4 * j + 2] = t.z; v[4 * j + 3] = t.w; ss += t.x * t.x + t.y * t.y + t.z * t.z + t.w * t.w; } }
    c0 = n0; c1 = n1; c2 = n2; c3 = n3;
    ss = wave_sum(ss);
    const float rstd = rsqrtf(ss * (1.f / D) + EPS);
    const float* md = MOD + ((size_t)l * 9 + modidx(r)) * 6144;
#pragma unroll
    for (int j = 0; j < 4; ++j)
#pragma unroll
      for (int i = 0; i < 4; ++i) { const int c = j * 256 + lane * 4 + i; v[4 * j + i] = v[4 * j + i] * rstd * g[c] * (1.f + md[1024 + c]) + md[c]; }
    quant_row_i8(v, (signed char*)H + (size_t)r * D, (float*)(p.ws + WS_HS1) + r, lane);
  }
}

struct RowId { DI int operator()(int m) const { return m; } };
struct RowGather { const int* idx; DI int operator()(int m) const { return idx[m]; } };
#define ZERO_ACC(acc) do { _Pragma("unroll") for (int i_ = 0; i_ < 4; ++i_) _Pragma("unroll") for (int j_ = 0; j_ < 4; ++j_) acc[i_][j_] = 0.f; } while (0)


DI void ph_conv(PRef p, int l, int nrows, unsigned char* lds) {
  const int tid_ = opq_tid(); const int bid_ = opq_bid(), nblk_ = opq_nblk(); (void)bid_; (void)nblk_;
  const int lane = tid_ & 63, gw = GTID >> 6, ngw = NTHR >> 6;
  const bf16* __restrict__ CU = (const bf16*)(p.ws + WS_CU); bf16* __restrict__ BI = (bf16*)(p.ws + WS_BI);
  const float* cw = p.in[I_CONVW] + l * 31 * 256; const float* cb = p.in[I_CONVB] + l * 256;
  float4* wl = (float4*)lds;
  for (int k = tid_; k < 31 * 64; k += 512) wl[k] = *(const float4*)(cw + 4 * k);
  __syncthreads();
  const float4 bias = *(const float4*)(cb + lane * 4), lg = *(const float4*)(p.in[I_CLNG] + l * 256 + lane * 4), lb = *(const float4*)(p.in[I_CLNB] + l * 256 + lane * 4);
  for (int r = gw; r < nrows; r += ngw) {
    int lo, hi; if (r < TL) { lo = r & ~(SEQ - 1); hi = lo + SEQ; } else { lo = TL + ((r - TL) & ~(CTX - 1)); hi = lo + CTX; }
    const bf16* up = CU + (long)(r - 15) * 256 + lane * 4; asm volatile("" : "+v"(up));
    uint2 u[31];
#pragma unroll
    for (int j = 0; j < 31; ++j) { const int rr = r + j - 15; u[j] = make_uint2(0u, 0u); if (rr >= lo && rr < hi) u[j] = *(const uint2*)(up + j * 256); }
    float a[4] = {bias.x, bias.y, bias.z, bias.w};
#pragma unroll
    for (int j = 0; j < 31; ++j) { const float4 w = wl[j * 64 + lane];
      a[0] += __uint_as_float(u[j].x << 16) * w.x; a[1] += __uint_as_float(u[j].x & 0xffff0000u) * w.y; a[2] += __uint_as_float(u[j].y << 16) * w.z; a[3] += __uint_as_float(u[j].y & 0xffff0000u) * w.w; }
    const float mu = seg_sum(a[0] + a[1] + a[2] + a[3], lane, 64) * (1.f / 256.f);
    float q2 = 0.f;
#pragma unroll
    for (int c = 0; c < 4; ++c) { a[c] -= mu; q2 += a[c] * a[c]; }
    const float rs = rsqrtf(seg_sum(q2, lane, 64) * (1.f / 256.f) + EPS);
    float y[4] = {a[0] * rs * lg.x + lb.x, a[1] * rs * lg.y + lb.y, a[2] * rs * lg.z + lb.z, a[3] * rs * lg.w + lb.w};
#pragma unroll
    for (int c = 0; c < 4; ++c) y[c] = y[c] * sigmoidf_(y[c]);
    st4(BI + (size_t)r * D + lane * 4, y);
  }
  __syncthreads();
}


DI void expert_offsets(const unsigned* cnt, int* off  ) { int a = 0; for (int e = 0; e < NE; ++e) { off[e] = a; a += ((int)cnt[e] + 255) & ~255; } off[NE] = a; }
DI void ph_combine(PRef p, int l, int nrows, unsigned char* lds) {
  const int tid_ = opq_tid(); const int bid_ = opq_bid(), nblk_ = opq_nblk();
  int* off = (int*)(lds + 32768);
  const unsigned* cnt = (const unsigned*)(p.ws + WS_CTL) + CW_CNT + l * 64;
  if (tid_ == 0) expert_offsets(cnt, off);
  __syncthreads();
  const int lane = tid_ & 63, gw = GTID >> 6, ngw = NTHR >> 6;
  const float* MOD = (const float*)(p.ws + WS_MOD); float* XF = (float*)(p.ws + WS_XF); const bf16* YE = (const bf16*)(p.ws + WS_YE); const int* ROUTE = (const int*)(p.ws + WS_ROUTE);
  bf16* H = (bf16*)(p.ws + WS_H); const float* g1n = p.in[I_N1G] + D;
  for (int r = gw; r < nrows; r += ngw) {
    const float* md = MOD + ((size_t)l * 9 + modidx(r)) * 6144 + 5 * 1024;
    float* dst = (l == 1) ? p.out + (size_t)r * D : XF + (size_t)r * D;
    const float* xs = XF + (size_t)r * D;
    float acc[16];
#pragma unroll
    for (int i = 0; i < 16; ++i) acc[i] = 0.f;
#pragma unroll
    for (int k = 0; k < 4; ++k) { const int* rt = ROUTE + ((size_t)r * 4 + k) * 4; const float w = __int_as_float(rt[2]); const bf16* y = YE + (size_t)(off[rt[0]] + rt[1]) * D;
#pragma unroll
      for (int j = 0; j < 4; ++j) { const uint2 u = *(const uint2*)(y + j * 256 + lane * 4);
        acc[4 * j] += w * __uint_as_float(u.x << 16); acc[4 * j + 1] += w * __uint_as_float(u.x & 0xffff0000u); acc[4 * j + 2] += w * __uint_as_float(u.y << 16); acc[4 * j + 3] += w * __uint_as_float(u.y & 0xffff0000u); } }
    float ss = 0.f;
#pragma unroll
    for (int j = 0; j < 4; ++j) { const int c = j * 256 + lane * 4; const float4 x4 = *(const float4*)(xs + c), m4 = *(const float4*)(md + c);
      acc[4 * j] = x4.x + m4.x * acc[4 * j]; acc[4 * j + 1] = x4.y + m4.y * acc[4 * j + 1]; acc[4 * j + 2] = x4.z + m4.z * acc[4 * j + 2]; acc[4 * j + 3] = x4.w + m4.w * acc[4 * j + 3];
      *(float4*)(dst + c) = make_float4(acc[4 * j], acc[4 * j + 1], acc[4 * j + 2], acc[4 * j + 3]);
      ss += acc[4 * j] * acc[4 * j] + acc[4 * j + 1] * acc[4 * j + 1] + acc[4 * j + 2] * acc[4 * j + 2] + acc[4 * j + 3] * acc[4 * j + 3]; }
    if (l == 0) {
      ss = seg_sum(ss, lane, 64); const float rstd = rsqrtf(ss * (1.f / D) + EPS);
      const float* m1 = MOD + ((size_t)9 + modidx(r)) * 6144;
#pragma unroll
      for (int j = 0; j < 4; ++j) { const int c = j * 256 + lane * 4; const float4 gg = *(const float4*)(g1n + c), s4 = *(const float4*)(m1 + 1024 + c), h4 = *(const float4*)(m1 + c);
        acc[4 * j] = acc[4 * j] * rstd * gg.x * (1.f + s4.x) + h4.x; acc[4 * j + 1] = acc[4 * j + 1] * rstd * gg.y * (1.f + s4.y) + h4.y; acc[4 * j + 2] = acc[4 * j + 2] * rstd * gg.z * (1.f + s4.z) + h4.z; acc[4 * j + 3] = acc[4 * j + 3] * rstd * gg.w * (1.f + s4.w) + h4.w; }
      quant_row_i8(acc, (signed char*)H + (size_t)r * D, (float*)(p.ws + WS_HS1) + r, lane);
    }
  }
}

namespace pg8 {
#define PG8_LAS __attribute__((address_space(3)))
typedef unsigned short bf16_t;
typedef short bf16x8 __attribute__((ext_vector_type(8)));
typedef float f32x4 __attribute__((ext_vector_type(4)));
typedef unsigned u32x4 __attribute__((ext_vector_type(4)));
typedef unsigned u32x2 __attribute__((ext_vector_type(2)));
typedef int i32x4v __attribute__((ext_vector_type(4)));
constexpr int BM = 256, BK = 64, HALF = 128, HTB = HALF * BK * 2, STAGE_BYTES = 8 * HTB;
__host__ __device__ __forceinline__ int lds_byte(int r, int c) { const int st = (r >> 4) * 2 + (c >> 5), rr = r & 15, cc = c & 31, ob = rr * 64 + cc * 2; return st * 1024 + (ob ^ (((ob >> 9) & 1) << 5)); }
__host__ __device__ __forceinline__ void stage_rc(int b, int& R, int& C) { const int st = b / 1024, sb = b % 1024, swz = sb ^ (((sb >> 9) & 1) << 5); R = (st >> 1) * 16 + swz / 64; C = (st & 1) * 32 + (swz % 64) / 2; }
__host__ __device__ __forceinline__ int perm32(int rho) { const int n = rho >> 4, i = rho & 15; return 8 * (i >> 2) + 4 * n + (i & 3); }
__device__ __forceinline__ unsigned cvt_pk_bf16(float lo, float hi) { unsigned r; asm volatile("v_cvt_pk_bf16_f32 %0, %1, %2" : "=v"(r) : "v"(lo), "v"(hi)); return r; }

struct Unit { int pm, pn, aux, nvalid; const char* A; const char* B; const int* rows; };

template <class Epi, class Sched, bool GATHER, bool I8 = false>
__device__ __forceinline__ void gemm_phase(PG8_LAS unsigned char* lds, const int lda_, const int K_, const Sched& S, const Epi& E) {
    const int lda = I8 ? lda_ / 2 : lda_, K = I8 ? K_ / 2 : K_;
    const int tid = opq_tid(), wid = __builtin_amdgcn_readfirstlane(tid >> 6), lane = tid & 63, wr = wid >> 2, wc = wid & 3, fr = lane & 15, fq = lane >> 4;
    const int nt = K / BK;
    unsigned voffA[2], voffB[2];
#pragma unroll
    for (int i = 0; i < 2; ++i) { int R, C; stage_rc(tid * 16 + i * 8192, R, C); const int Rb = Epi::PERM ? ((R & ~31) + perm32(R & 31)) : R;
        voffA[i] = GATHER ? (unsigned)(R * 65536 + C * 2) : (unsigned)(R * lda + C) * 2u; voffB[i] = (unsigned)(Rb * K + C) * 2u; }
    const size_t kstep = (size_t)(BK * 2);
    const size_t hstepA = GATHER ? 0 : (size_t)HALF * lda * 2, hstepB = (size_t)HALF * K * 2;
    const unsigned ldsw = (unsigned)wid * 1024u;
    const int aoff = lds_byte(wr * 64 + fr, fq * 8), boff = lds_byte(wc * 32 + fr, fq * 8);
#define PG8_SA(b, h) (((b) * 2 + (h)) * HTB)
#define PG8_SB(b, h) ((4 + (b) * 2 + (h)) * HTB)
#define PG8_STAGE(bufoff, gbase, voff) do { _Pragma("unroll") for (int _i = 0; _i < 2; ++_i) \
        __builtin_amdgcn_global_load_lds((const unsigned*)((const char*)(gbase) + (voff)[_i]), (PG8_LAS unsigned*)(lds + (bufoff) + ldsw + _i * 8192), 16, 0, 0); } while (0)
#define PG8_LDA(dst, b, h) do { _Pragma("unroll") for (int m = 0; m < 4; ++m) _Pragma("unroll") for (int k = 0; k < 2; ++k) dst[m][k] = *(const PG8_LAS bf16x8*)(lds + PG8_SA(b, h) + aoff + m * 2048 + k * 1024); } while (0)
#define PG8_LDB(dst, b, h) do { _Pragma("unroll") for (int n = 0; n < 2; ++n) _Pragma("unroll") for (int k = 0; k < 2; ++k) dst[n][k] = *(const PG8_LAS bf16x8*)(lds + PG8_SB(b, h) + boff + n * 2048 + k * 1024); } while (0)
#define PG8_MMA(ai, bj, At, Bt) do { __builtin_amdgcn_s_setprio(1); _Pragma("unroll") for (int m = 0; m < 4; ++m) _Pragma("unroll") for (int n = 0; n < 2; ++n) _Pragma("unroll") for (int k = 0; k < 2; ++k) { \
        if constexpr (I8) acc[ai][bj][m][n] = __builtin_bit_cast(f32x4, __builtin_amdgcn_mfma_i32_16x16x64_i8(__builtin_bit_cast(i32x4v, Bt[n][k]), __builtin_bit_cast(i32x4v, At[m][k]), __builtin_bit_cast(i32x4v, acc[ai][bj][m][n]), 0, 0, 0)); \
        else acc[ai][bj][m][n] = __builtin_amdgcn_mfma_f32_16x16x32_bf16(Bt[n][k], At[m][k], acc[ai][bj][m][n], 0, 0, 0); } __builtin_amdgcn_s_setprio(0); } while (0)
#define PG8_WAIT_V(n) asm volatile("s_waitcnt vmcnt(" #n ")" ::: "memory")
#define PG8_WAIT_L(n) asm volatile("s_waitcnt lgkmcnt(" #n ")" ::: "memory")
#define PG8_BAR __builtin_amdgcn_s_barrier()
#define PG8_SCHED __builtin_amdgcn_sched_barrier(0)
#define PG8_LOADROWS(dst, u) do { _Pragma("unroll") for (int h_ = 0; h_ < 2; ++h_) _Pragma("unroll") for (int i_ = 0; i_ < 2; ++i_) \
        { const int ri_ = h_ * HALF + (int)(voffA[i_] >> 16); dst[h_][i_] = (unsigned)(ri_ < (u).nvalid ? (u).rows[ri_] : 0) * (unsigned)(lda * 2) + (voffA[i_] & 0xffffu); } } while (0)
#define PG8_STAGE_A(bufoff, gbase, h, NEXT) do { if constexpr (GATHER) { PG8_STAGE(bufoff, gbase, ((NEXT) ? vn[h] : vc[h])); } else { PG8_STAGE(bufoff, (gbase) + (h) * hstepA, voffA); } } while (0)
    Unit cur, nxt; int ui = 0;
    if (!S.next(0, cur)) return;
    f32x4 acc[2][2][4][2];
#pragma unroll
    for (int a = 0; a < 2; ++a)
#pragma unroll
        for (int b = 0; b < 2; ++b)
#pragma unroll
            for (int m = 0; m < 4; ++m)
#pragma unroll
                for (int n = 0; n < 2; ++n) acc[a][b][m][n] = (f32x4){0.f, 0.f, 0.f, 0.f};
    bf16x8 At[4][2], B0[2][2], B1[2][2];
    unsigned vc[2][2], vn[2][2];
    if constexpr (GATHER) { PG8_LOADROWS(vc, cur);
#pragma unroll
        for (int h = 0; h < 2; ++h) { vn[h][0] = vc[h][0]; vn[h][1] = vc[h][1]; } }
    const char* cA = cur.A; const char* cB = cur.B;
    PG8_STAGE(PG8_SB(0, 0), cB, voffB); PG8_STAGE(PG8_SB(0, 1), cB + hstepB, voffB); PG8_STAGE_A(PG8_SA(0, 0), cA, 0, false); PG8_STAGE_A(PG8_SA(0, 1), cA, 1, false);
    if (wr == 1) PG8_BAR;
    PG8_WAIT_V(2); PG8_BAR;
    PG8_STAGE(PG8_SB(1, 0), cB + kstep, voffB); PG8_STAGE_A(PG8_SA(1, 0), cA + kstep, 0, false); PG8_STAGE(PG8_SB(1, 1), cB + hstepB + kstep, voffB);
    PG8_WAIT_V(6); PG8_BAR;
    for (;;) {
        const bool has_next = S.next(ui + 1, nxt);
        const char* nA = has_next ? nxt.A : cA; const char* nB = has_next ? nxt.B : cB;
        if constexpr (GATHER) { if (has_next) { PG8_LOADROWS(vn, nxt); } }
#pragma unroll 1
        for (int t = 0; t < nt; t += 2) {
            const bool last = (t == nt - 2);
            const char* a1 = cA + (size_t)(t + 1) * kstep;
            const char* a2 = last ? nA : cA + (size_t)(t + 2) * kstep; const char* b2 = last ? nB : cB + (size_t)(t + 2) * kstep;
            const char* a3 = a2 + kstep; const char* b3 = b2 + kstep;
            PG8_LDB(B0, 0, 0); PG8_LDB(B1, 0, 1); PG8_SCHED; PG8_LDA(At, 0, 0); PG8_STAGE_A(PG8_SA(1, 1), a1, 1, false);
            PG8_WAIT_V(8); PG8_WAIT_L(0); PG8_BAR; PG8_MMA(0, 0, At, B0); PG8_MMA(0, 1, At, B1); PG8_BAR; PG8_SCHED;
            PG8_LDA(At, 0, 1); PG8_STAGE(PG8_SB(0, 0), b2, voffB); PG8_STAGE(PG8_SB(0, 1), b2 + hstepB, voffB); PG8_STAGE_A(PG8_SA(0, 0), a2, 0, last);
            PG8_WAIT_V(8); PG8_WAIT_L(0); PG8_BAR; PG8_MMA(1, 0, At, B0); PG8_MMA(1, 1, At, B1); PG8_BAR; PG8_SCHED;
            PG8_LDB(B0, 1, 0); PG8_LDB(B1, 1, 1); PG8_SCHED; PG8_LDA(At, 1, 0); PG8_STAGE_A(PG8_SA(0, 1), a2, 1, last);
            PG8_WAIT_V(8); PG8_WAIT_L(0); PG8_BAR; PG8_MMA(0, 0, At, B0); PG8_MMA(0, 1, At, B1); PG8_BAR; PG8_SCHED;
            PG8_LDA(At, 1, 1); PG8_STAGE(PG8_SB(1, 0), b3, voffB); PG8_STAGE(PG8_SB(1, 1), b3 + hstepB, voffB); PG8_STAGE_A(PG8_SA(1, 0), a3, 0, last);
            PG8_WAIT_V(8); PG8_WAIT_L(0); PG8_BAR; PG8_MMA(1, 0, At, B0); PG8_MMA(1, 1, At, B1); PG8_BAR; PG8_SCHED;
        }
        if (wr == 0) PG8_BAR;
        { const int l2 = opq_tid() & 63; E(acc, cur, wr, wc, l2 & 15, l2 >> 4); }
        if (!has_next) break;
#pragma unroll
        for (int a = 0; a < 2; ++a)
#pragma unroll
            for (int b = 0; b < 2; ++b)
#pragma unroll
                for (int m = 0; m < 4; ++m)
#pragma unroll
                    for (int n = 0; n < 2; ++n) acc[a][b][m][n] = (f32x4){0.f, 0.f, 0.f, 0.f};
        cur = nxt; cA = nA; cB = nB; ++ui;
        if constexpr (GATHER) {
#pragma unroll
            for (int h = 0; h < 2; ++h) { vc[h][0] = vn[h][0]; vc[h][1] = vn[h][1]; } }
        if (wr == 1) PG8_BAR;
    }
    PG8_WAIT_V(0);
    PG8_BAR;
#undef PG8_STAGE_A
#undef PG8_SA
#undef PG8_SB
#undef PG8_STAGE
#undef PG8_LDA
#undef PG8_LDB
#undef PG8_MMA
#undef PG8_WAIT_V
#undef PG8_WAIT_L
#undef PG8_BAR
#undef PG8_SCHED
#undef PG8_LOADROWS
}
}

struct SchedDense {
    const char* A; const char* Bt; int nM, nN, G, c; size_t tstepA, tstepB; bool rev = false;
    DI void init(const void* A_, int lda, const void* Bt_, int K, int M, int N, int G_, int c_) { A = (const char*)A_; Bt = (const char*)Bt_; nM = M / 256; nN = N / 256; G = G_; c = c_; tstepA = (size_t)256 * lda * 2; tstepB = (size_t)256 * K * 2; }
    DI bool next(int i, pg8::Unit& u) const {
        const int L = i * G + c; if (L >= nM * nN) return false;
        const int nig = 8 * nN, gid = L / nig, fm = gid * 8, gsz = (nM - fm) < 8 ? (nM - fm) : 8, w = L - gid * nig;
        u.pm = fm + (w % gsz); if (rev) u.pm = nM - 1 - u.pm; u.pn = w / gsz; u.aux = 0; u.nvalid = 256; u.A = A + (size_t)u.pm * tstepA; u.B = Bt + (size_t)u.pn * tstepB; u.rows = nullptr; return true; }
};
struct SchedBranch {
    const char* A; const char* Bt; int nM, G, c;
    DI void init(const void* A_, const void* Bt_, int M, int G_, int c_) { A = (const char*)A_; Bt = (const char*)Bt_; nM = M / 256; G = G_; c = c_; }
    DI bool next(int i, pg8::Unit& u) const {
        const int L = i * G + c; if (L >= nM * 16) return false;
        u.pm = L >> 4; const int b = (L >> 2) & 3; u.pn = L & 3; u.aux = b; u.nvalid = 256;
        u.A = A + (size_t)u.pm * 256 * (D * 2) + b * 512; u.B = Bt + ((size_t)b * 1024 + u.pn * 256) * 512; u.rows = nullptr; return true; }
};
struct SchedMoe {
    bool rev = false; const char* A; const char* Bt; const int* rowtok; const int* off; const int* cnt; int nN, G, c, ntiles; size_t tstepA, estepB, tstepB; bool gather;
    DI bool next(int i, pg8::Unit& u) const {
        int rt, pn;
        if (G == 256) {
            const int v = i * 32 + (c >> 3), rl = v / nN; pn = v - rl * nN; rt = rl * 8 + (c & 7); if (rt >= ntiles) return false; }
        else { const int L = i * G + c; if (L >= ntiles * nN) return false; rt = L / nN; pn = L - rt * nN; }
        if (rev) rt = ntiles - 1 - rt;
        u.pm = rt; u.pn = pn; const int r0 = rt * 256; int e = 0;
#pragma unroll 1
        for (int k = 1; k < NE; ++k) e += (off[k] <= r0) ? 1 : 0;
        u.aux = e; u.A = gather ? A : A + (size_t)rt * tstepA; u.B = Bt + (size_t)e * estepB + (size_t)u.pn * tstepB;
        const int rin = r0 - off[e]; u.rows = rowtok + (size_t)e * T + rin; u.nvalid = cnt[e] - rin; return true; }
};

struct EpiStoreBf16 {
    static constexpr bool PERM = true;
    bf16* O; int ldc; int auxstride; const float* bias; int biasstride;
    DI void operator()(const pg8::f32x4 (&acc)[2][2][4][2], const pg8::Unit& u, int wr, int wc, int fr, int fq) const {
        const int row0 = u.pm * 256 + wr * 64 + fr, col0 = u.aux * auxstride + u.pn * 256 + wc * 32 + 8 * fq, bcol0 = u.pn * 256 + wc * 32 + 8 * fq;
        pg8::f32x4 bv[2][2];
#pragma unroll
        for (int bj = 0; bj < 2; ++bj)
#pragma unroll
            for (int n = 0; n < 2; ++n) bv[bj][n] = bias ? *(const pg8::f32x4*)(bias + (size_t)u.aux * biasstride + bcol0 + bj * 128 + 4 * n) : (pg8::f32x4){0.f, 0.f, 0.f, 0.f};
#pragma unroll
        for (int ai = 0; ai < 2; ++ai)
#pragma unroll
            for (int m = 0; m < 4; ++m) { bf16* rowp = O + (size_t)(row0 + ai * 128 + m * 16) * ldc + col0;
#pragma unroll
                for (int bj = 0; bj < 2; ++bj) { const pg8::f32x4 v0 = acc[ai][bj][m][0] + bv[bj][0], v1 = acc[ai][bj][m][1] + bv[bj][1];
                    pg8::u32x4 w; w.x = pg8::cvt_pk_bf16(v0[0], v0[1]); w.y = pg8::cvt_pk_bf16(v0[2], v0[3]); w.z = pg8::cvt_pk_bf16(v1[0], v1[1]); w.w = pg8::cvt_pk_bf16(v1[2], v1[3]);
                    *(pg8::u32x4*)(rowp + bj * 128) = w; } }
    }
};
DI float sigm_fast(float x) { return __builtin_amdgcn_rcpf(1.f + __builtin_amdgcn_exp2f(-LOG2E * x)); }
struct EpiMerge {
    static constexpr bool PERM = false;
    const bf16* YB; bf16* YM; const float* gb; const float* HS1; const float* GATES;
    DI void operator()(const pg8::f32x4 (&acc)[2][2][4][2], const pg8::Unit& u, int wr, int wc, int fr, int fq) const {
        const int row0 = u.pm * 256 + wr * 64 + fr, col = u.pn * 64 + wc * 16 + fq * 4;
        pg8::f32x4 bv[2][2];
#pragma unroll
        for (int bj = 0; bj < 2; ++bj)
#pragma unroll
            for (int n = 0; n < 2; ++n) bv[bj][n] = *(const pg8::f32x4*)(gb + (2 * bj + n) * 1024 + col);
#pragma unroll
        for (int ai = 0; ai < 2; ++ai)
#pragma unroll
            for (int m = 0; m < 4; ++m) { const size_t r = (size_t)(row0 + ai * 128 + m * 16); const float sa = HS1[r]; pg8::f32x4 y = (pg8::f32x4){0.f, 0.f, 0.f, 0.f};
#pragma unroll
                for (int bj = 0; bj < 2; ++bj)
#pragma unroll
                    for (int n = 0; n < 2; ++n) { const pg8::u32x2 yb = *(const pg8::u32x2*)(YB + r * 4096 + (2 * bj + n) * 1024 + col); const pg8::i32x4v iv = __builtin_bit_cast(pg8::i32x4v, acc[ai][bj][m][n]);
                        const pg8::f32x4 cs = *(const pg8::f32x4*)(GATES + u.pn * 256 + 128 * bj + 32 * wc + 16 * n + 4 * fq);
                        const pg8::f32x4 g = (pg8::f32x4){(float)iv[0] * sa * cs[0], (float)iv[1] * sa * cs[1], (float)iv[2] * sa * cs[2], (float)iv[3] * sa * cs[3]} + bv[bj][n];
                        y[0] += sigm_fast(g[0]) * __uint_as_float(yb.x << 16); y[1] += sigm_fast(g[1]) * __uint_as_float(yb.x & 0xffff0000u);
                        y[2] += sigm_fast(g[2]) * __uint_as_float(yb.y << 16); y[3] += sigm_fast(g[3]) * __uint_as_float(yb.y & 0xffff0000u); }
                pg8::u32x2 w; w.x = pg8::cvt_pk_bf16(y[0], y[1]); w.y = pg8::cvt_pk_bf16(y[2], y[3]); *(pg8::u32x2*)(YM + r * 1024 + col) = w; }
    }
};
struct EpiWo {
    static constexpr bool PERM = false;
    const float* xlat; const float* xctx; float* XF; const float* modg;
    DI void operator()(const pg8::f32x4 (&acc)[2][2][4][2], const pg8::Unit& u, int wr, int wc, int fr, int fq) const {
        const int row0 = u.pm * 256 + wr * 64 + fr, col0 = u.pn * 256 + wc * 32 + 4 * fq;
        const float* g = modg + (size_t)modidx(u.pm * 256) * 6144 + col0;
        pg8::f32x4 gv[2][2];
#pragma unroll
        for (int bj = 0; bj < 2; ++bj)
#pragma unroll
            for (int n = 0; n < 2; ++n) gv[bj][n] = *(const pg8::f32x4*)(g + bj * 128 + n * 16);
#pragma unroll
        for (int ai = 0; ai < 2; ++ai)
#pragma unroll
            for (int mp = 0; mp < 2; ++mp) { pg8::f32x4 t[2][2][2];
#pragma unroll
                for (int mm = 0; mm < 2; ++mm) { const int r = row0 + ai * 128 + (2 * mp + mm) * 16; const float* xs = (r < TL ? xlat + (size_t)r * D : xctx + (size_t)(r - TL) * D) + col0;
#pragma unroll
                    for (int bj = 0; bj < 2; ++bj)
#pragma unroll
                        for (int n = 0; n < 2; ++n) t[mm][bj][n] = *(const pg8::f32x4*)(xs + bj * 128 + n * 16); }
#pragma unroll
                for (int mm = 0; mm < 2; ++mm) { const int m = 2 * mp + mm; const int r = row0 + ai * 128 + m * 16; float* xo = XF + (size_t)r * D + col0;
#pragma unroll
                    for (int bj = 0; bj < 2; ++bj)
#pragma unroll
                        for (int n = 0; n < 2; ++n) *(pg8::f32x4*)(xo + bj * 128 + n * 16) = t[mm][bj][n] + gv[bj][n] * acc[ai][bj][m][n]; } }
    }
};
struct EpiProjFused {
    static constexpr bool PERM = true;
    bf16 *CU, *AQ, *DQ, *DK, *DV, *NQ, *NK, *NV, *KPE; float *QBD, *QBN; const float* ROPE;
    const float *cqg, *ckvg, *dqg, *dkg, *nqg, *nkg;
    float kbd, kbn, nbias; float* P;
    const float* HS1; const float* WINS;
    DI static float red4(float v, int lane) { v += lane_xor(v, lane, 16); v += lane_xor(v, lane, 32); return v; }
    DI static void st8(bf16* dst, const float (&x)[8]) { pg8::u32x4 w; w.x = pg8::cvt_pk_bf16(x[0], x[1]); w.y = pg8::cvt_pk_bf16(x[2], x[3]); w.z = pg8::cvt_pk_bf16(x[4], x[5]); w.w = pg8::cvt_pk_bf16(x[6], x[7]); *(pg8::u32x4*)dst = w; }
    DI void operator()(const pg8::f32x4 (&acc)[2][2][4][2], const pg8::Unit& u, int wr, int wc, int fr, int fq) const {
        const int t = u.pn, lane = fr + 16 * fq, row0 = u.pm * 256 + wr * 64 + fr; const bool lat = u.pm < TL / 256;
        const float* sap = HS1 + row0; const float* sbp = WINS + 256 * t + 32 * wc + 8 * fq; asm volatile("" : "+v"(sap), "+v"(sbp));
#define GET8(ai, bj, m, x) do { const float sa_ = sap[(ai) * 128 + (m) * 16]; _Pragma("unroll") for (int n_ = 0; n_ < 2; ++n_) { const pg8::i32x4v iv_ = __builtin_bit_cast(pg8::i32x4v, acc[ai][bj][m][n_]); \
        const pg8::f32x4 sb_ = *(const pg8::f32x4*)(sbp + 128 * (bj) + 4 * n_); _Pragma("unroll") for (int j_ = 0; j_ < 4; ++j_) x[4 * n_ + j_] = (float)iv_[j_] * sa_ * sb_[j_]; } } while (0)
        if (t < 2) {
#pragma unroll
            for (int ai = 0; ai < 2; ++ai)
#pragma unroll
                for (int m = 0; m < 4; ++m) { float a[8], g[8], o[8]; GET8(ai, 0, m, a); GET8(ai, 1, m, g);
#pragma unroll
                    for (int i = 0; i < 8; ++i) o[i] = a[i] * sigm_fast(g[i]);
                    st8(CU + (size_t)(row0 + ai * 128 + m * 16) * 256 + 128 * t + 32 * wc + 8 * fq, o); }
        } else if (t < 5) {
#pragma unroll
            for (int bj = 0; bj < 2; ++bj) { const int ds = (t - 2) * 8 + bj * 4 + wc, head = ds / 6, kind = ds - head * 6;
                const bool isq = kind < 2, isv = kind >= 4; const float* gp = (isq ? dqg : dkg) + 8 * fq; float gg[8];
#pragma unroll
                for (int i = 0; i < 8; ++i) gg[i] = gp[i];
#pragma unroll
                for (int ai = 0; ai < 2; ++ai)
#pragma unroll
                    for (int m = 0; m < 4; ++m) { const int r = row0 + ai * 128 + m * 16; float x[8]; GET8(ai, bj, m, x);
                        if (isv) { st8(DV + (size_t)r * 256 + head * 64 + (kind - 4) * 32 + 8 * fq, x); continue; }
                        float ss = 0.f;
#pragma unroll
                        for (int i = 0; i < 8; ++i) ss += x[i] * x[i];
                        const float rs = rsqrtf(red4(ss, lane) * (1.f / 32.f) + EPS);
#pragma unroll
                        for (int i = 0; i < 8; ++i) x[i] = x[i] * rs * gg[i];
                        float pt[8];
#pragma unroll
                        for (int i = 0; i < 8; ++i) pt[i] = lane_xor(x[i], lane, 32);
                        if (lat) { const float* rp = ROPE + (size_t)(r & (SEQ - 1)) * 32 + 8 * (fq & 1); const bool first = fq < 2;
                            const pg8::f32x4 c0 = *(const pg8::f32x4*)rp, c1 = *(const pg8::f32x4*)(rp + 4), s0 = *(const pg8::f32x4*)(rp + 16), s1 = *(const pg8::f32x4*)(rp + 20);
#pragma unroll
                            for (int i = 0; i < 8; ++i) { const float cs = i < 4 ? c0[i & 3] : c1[i & 3], sn = i < 4 ? s0[i & 3] : s1[i & 3]; x[i] = first ? x[i] * cs - pt[i] * sn : x[i] * cs + pt[i] * sn; } }
                        if (isq) { float qn = 0.f;
#pragma unroll
                            for (int i = 0; i < 8; ++i) { x[i] *= 0.17677669529663687f * LOG2E; qn += x[i] * x[i]; }
                            qn = red4(qn, lane); if (fq == 0) QBD[(size_t)r * 8 + head * 2 + kind] = -(sqrtf(qn) * kbd + 0.05f); }
                        st8((isq ? DQ : DK) + (size_t)r * 256 + head * 64 + (kind & 1) * 32 + 8 * fq, x); } }
        } else if (t < 7) {
            const int pi = (t - 5) * 4 + wc, head = pi >> 1; const bool isq = (pi & 1) == 0; const float* gp = (isq ? nqg : nkg) + 8 * fq; float g0[8], g1[8];
#pragma unroll
            for (int i = 0; i < 8; ++i) { g0[i] = gp[i]; g1[i] = gp[32 + i]; }
#pragma unroll
            for (int ai = 0; ai < 2; ++ai)
#pragma unroll
                for (int m = 0; m < 4; ++m) { const int r = row0 + ai * 128 + m * 16; float x0[8], x1[8]; GET8(ai, 0, m, x0); GET8(ai, 1, m, x1); float ss = 0.f;
#pragma unroll
                    for (int i = 0; i < 8; ++i) ss += x0[i] * x0[i] + x1[i] * x1[i];
                    const float rs = rsqrtf(red4(ss, lane) * (1.f / 64.f) + EPS) * (isq ? 0.125f * LOG2E : 1.f); float qn = 0.f;
#pragma unroll
                    for (int i = 0; i < 8; ++i) { x0[i] = x0[i] * rs * g0[i]; x1[i] = x1[i] * rs * g1[i]; qn += x0[i] * x0[i] + x1[i] * x1[i]; }
                    if (isq) { qn = red4(qn, lane); if (fq == 0) QBN[(size_t)r * 4 + head] = -(sqrtf(qn) * kbn + nbias); }
                    bf16* dst = (isq ? NQ : NK) + (size_t)r * 256 + head * 64 + 8 * fq; st8(dst, x0); st8(dst + 32, x1); }
        } else if (t == 7) {
#pragma unroll
            for (int bj = 0; bj < 2; ++bj) { const int sl = bj * 4 + wc, head = sl >> 1, half = sl & 1;
#pragma unroll
                for (int ai = 0; ai < 2; ++ai)
#pragma unroll
                    for (int m = 0; m < 4; ++m) { float x[8]; GET8(ai, bj, m, x); st8(NV + (size_t)(row0 + ai * 128 + m * 16) * 256 + head * 64 + half * 32 + 8 * fq, x); } }
        } else {
            const int nsl = t == 8 ? 6 : 4;
#pragma unroll
            for (int bj = 0; bj < 2; ++bj) { const int sl = bj * 4 + wc;
#pragma unroll
                for (int ai = 0; ai < 2; ++ai)
#pragma unroll
                    for (int m = 0; m < 4; ++m) { float x[8]; GET8(ai, bj, m, x); float ss = 0.f;
#pragma unroll
                        for (int i = 0; i < 8; ++i) ss += x[i] * x[i];
                        ss = red4(ss, lane); if (fq == 0) P[(ai * 128 + wr * 64 + m * 16 + fr) * 8 + sl] = sl < nsl ? ss : 0.f; } }
            asm volatile("s_waitcnt lgkmcnt(0)" ::: "memory"); __builtin_amdgcn_s_barrier(); asm volatile("" ::: "memory");
#pragma unroll
            for (int bj = 0; bj < 2; ++bj) { const int sl = bj * 4 + wc; const float* gp = (t == 8 ? cqg : ckvg) + 32 * (sl < nsl ? sl : 0) + 8 * fq; float gg[8];
#pragma unroll
                for (int i = 0; i < 8; ++i) gg[i] = gp[i];
#pragma unroll
                for (int ai = 0; ai < 2; ++ai)
#pragma unroll
                    for (int m = 0; m < 4; ++m) { const int rl = ai * 128 + wr * 64 + m * 16 + fr, r = u.pm * 256 + rl; float x[8]; GET8(ai, bj, m, x);
                        const pg8::f32x4 p0 = *(const pg8::f32x4*)(P + rl * 8), p1 = *(const pg8::f32x4*)(P + rl * 8 + 4);
                        const float tot = (p0[0] + p0[1]) + (p0[2] + p0[3]) + (p1[0] + p1[1]) + (p1[2] + p1[3]);
                        const float rs = rsqrtf(tot * (t == 8 ? 1.f / 192.f : 1.f / 128.f) + EPS);
                        if (sl < nsl) {
#pragma unroll
                            for (int i = 0; i < 8; ++i) x[i] = x[i] * rs * gg[i];
                            st8(AQ + (size_t)r * 384 + (t == 8 ? 0 : 192) + 32 * sl + 8 * fq, x); }
                        else if (t == 8 && sl == 6) st8(KPE + (size_t)r * 32 + 8 * fq, x);
                        else if (t == 9 && sl < 6) {
#pragma unroll
                            for (int i = 0; i < 8; ++i) x[i] = 0.f;
                            st8(AQ + (size_t)r * 384 + 320 + 32 * (sl - 4) + 8 * fq, x); } } }
            asm volatile("s_waitcnt lgkmcnt(0)" ::: "memory"); __builtin_amdgcn_s_barrier(); asm volatile("" ::: "memory");
        }
#undef GET8
    }
};
struct EpiQkvFused {
    static constexpr bool PERM = true;
    bf16 *MQ, *MK, *MV; const bf16* KPE; float* QBM; const float* ROPE; const float *gq, *gk; float nbconst; float* P;
    DI static float red4(float v, int lane) { v += lane_xor(v, lane, 16); v += lane_xor(v, lane, 32); return v; }
    DI static void st8(bf16* dst, const float (&x)[8]) { pg8::u32x4 w; w.x = pg8::cvt_pk_bf16(x[0], x[1]); w.y = pg8::cvt_pk_bf16(x[2], x[3]); w.z = pg8::cvt_pk_bf16(x[4], x[5]); w.w = pg8::cvt_pk_bf16(x[6], x[7]); *(pg8::u32x4*)dst = w; }
    DI void rope8(float (&x)[8], int r, int fq, int lane) const {
        float pt[8];
#pragma unroll
        for (int i = 0; i < 8; ++i) pt[i] = lane_xor(x[i], lane, 32);
        const float* rp = ROPE + (size_t)(r & (SEQ - 1)) * 32 + 8 * (fq & 1); const bool first = fq < 2;
        const pg8::f32x4 c0 = *(const pg8::f32x4*)rp, c1 = *(const pg8::f32x4*)(rp + 4), s0 = *(const pg8::f32x4*)(rp + 16), s1 = *(const pg8::f32x4*)(rp + 20);
#pragma unroll
        for (int i = 0; i < 8; ++i) { const float cs = i < 4 ? c0[i & 3] : c1[i & 3], sn = i < 4 ? s0[i & 3] : s1[i & 3]; x[i] = first ? x[i] * cs - pt[i] * sn : x[i] * cs + pt[i] * sn; }
    }
    DI void operator()(const pg8::f32x4 (&acc)[2][2][4][2], const pg8::Unit& u, int wr, int wc, int fr, int fq) const {
        const int t = u.pn, lane = fr + 16 * fq, row0 = u.pm * 256 + wr * 64 + fr; const bool lat = u.pm < TL / 256;
#define GET8(ai, bj, m, x) do { _Pragma("unroll") for (int n_ = 0; n_ < 2; ++n_) _Pragma("unroll") for (int j_ = 0; j_ < 4; ++j_) x[4 * n_ + j_] = acc[ai][bj][m][n_][j_]; } while (0)
        if (t < 2) {
#pragma unroll
            for (int bj = 0; bj < 2; ++bj)
#pragma unroll
                for (int ai = 0; ai < 2; ++ai)
#pragma unroll
                    for (int m = 0; m < 4; ++m) { float x[8]; GET8(ai, bj, m, x); float ss = 0.f;
#pragma unroll
                        for (int i = 0; i < 8; ++i) ss += x[i] * x[i];
                        ss = red4(ss, lane); if (fq == 0) P[(ai * 128 + wr * 64 + m * 16 + fr) * 8 + bj * 4 + wc] = wc < 3 ? ss : 0.f; }
            asm volatile("s_waitcnt lgkmcnt(0)" ::: "memory"); __builtin_amdgcn_s_barrier(); asm volatile("" ::: "memory");
            if (wc < 3) {
#pragma unroll
                for (int bj = 0; bj < 2; ++bj) { const int head = 2 * t + bj; const float* gp = gq + 32 * wc + 8 * fq; asm volatile("" : "+v"(gp)); float gg[8];
#pragma unroll
                    for (int i = 0; i < 8; ++i) gg[i] = gp[i];
#pragma unroll
                    for (int ai = 0; ai < 2; ++ai)
#pragma unroll
                        for (int m = 0; m < 4; ++m) { const int rl = ai * 128 + wr * 64 + m * 16 + fr, r = u.pm * 256 + rl; float x[8]; GET8(ai, bj, m, x);
                            const pg8::f32x4 pp = *(const pg8::f32x4*)(P + rl * 8 + bj * 4);
                            const float rs = rsqrtf((pp[0] + pp[1] + pp[2]) * (1.f / 96.f) + EPS);
#pragma unroll
                            for (int i = 0; i < 8; ++i) x[i] = x[i] * rs * gg[i];
                            if (wc == 2 && lat) rope8(x, r, fq, lane);
#pragma unroll
                            for (int i = 0; i < 8; ++i) x[i] *= 0.10206207261596577f * LOG2E;
                            st8(MQ + (size_t)r * 384 + head * 96 + 32 * wc + 8 * fq, x);
                            if (wc == 0 && fq == 0) QBM[(size_t)r * 4 + head] = nbconst; } }
            }
            asm volatile("s_waitcnt lgkmcnt(0)" ::: "memory"); __builtin_amdgcn_s_barrier(); asm volatile("" ::: "memory");
        } else if (wc < 2) {
            const int head = 2 * (t - 2) + wc;
#pragma unroll
            for (int ai = 0; ai < 2; ++ai)
#pragma unroll
                for (int m = 0; m < 4; ++m) { const int r = row0 + ai * 128 + m * 16; float xp[8];
                    { const uint4 kq = *(const uint4*)(KPE + (size_t)r * 32 + 8 * fq); const unsigned w[4] = {kq.x, kq.y, kq.z, kq.w};
#pragma unroll
                      for (int i = 0; i < 4; ++i) { xp[2 * i] = __uint_as_float(w[i] << 16); xp[2 * i + 1] = __uint_as_float(w[i] & 0xffff0000u); } }
                    float ss = 0.f;
#pragma unroll
                    for (int n = 0; n < 2; ++n)
#pragma unroll
                        for (int j = 0; j < 4; ++j) ss += acc[ai][0][m][n][j] * acc[ai][0][m][n][j] + acc[ai][1][m][n][j] * acc[ai][1][m][n][j] + xp[4 * n + j] * xp[4 * n + j];
                    const float rs = rsqrtf(red4(ss, lane) * (1.f / 96.f) + EPS);
                    const float* gp = gk + 8 * fq; asm volatile("" : "+v"(gp));
                    bf16* dst = MK + (size_t)r * 384 + head * 96 + 8 * fq;
#pragma unroll
                    for (int bj = 0; bj < 2; ++bj) { float x[8]; GET8(ai, bj, m, x);
#pragma unroll
                        for (int i = 0; i < 8; ++i) x[i] = x[i] * rs * gp[32 * bj + i];
                        st8(dst + 32 * bj, x); }
#pragma unroll
                    for (int i = 0; i < 8; ++i) xp[i] = xp[i] * rs * gp[64 + i];
                    if (lat) rope8(xp, r, fq, lane);
                    st8(dst + 64, xp); }
        } else {
            const int head = 2 * (t - 2) + wc - 2;
#pragma unroll
            for (int bj = 0; bj < 2; ++bj)
#pragma unroll
                for (int ai = 0; ai < 2; ++ai)
#pragma unroll
                    for (int m = 0; m < 4; ++m) { float x[8]; GET8(ai, bj, m, x); st8(MV + (size_t)(row0 + ai * 128 + m * 16) * 256 + head * 64 + 32 * bj + 8 * fq, x); }
        }
#undef GET8
    }
};
struct EpiMoeActI8 {
    static constexpr bool PERM = true;
    bf16* ACT; const float* bgu; const float* HS; const float* WGUS;
    DI void operator()(const pg8::f32x4 (&acc)[2][2][4][2], const pg8::Unit& u, int wr, int wc, int fr, int fq) const {
        const int rl0 = wr * 64 + fr, row0 = u.pm * 256 + rl0, col0 = u.pn * 128 + wc * 32 + 8 * fq;
        const float* b = bgu + (size_t)u.aux * 2048 + col0;
        const pg8::f32x4 bg0 = *(const pg8::f32x4*)(b), bg1 = *(const pg8::f32x4*)(b + 4), bu0 = *(const pg8::f32x4*)(b + 1024), bu1 = *(const pg8::f32x4*)(b + 1028);
        const float* cs = WGUS + (size_t)u.aux * 2048 + u.pn * 256 + wc * 32 + 8 * fq;
        const pg8::f32x4 sg0 = *(const pg8::f32x4*)(cs), sg1 = *(const pg8::f32x4*)(cs + 4), su0 = *(const pg8::f32x4*)(cs + 128), su1 = *(const pg8::f32x4*)(cs + 132);
        int tk[2][4]; float sas[2][4];
#pragma unroll
        for (int ai = 0; ai < 2; ++ai)
#pragma unroll
            for (int m = 0; m < 4; ++m) { const int rl = rl0 + ai * 128 + m * 16; tk[ai][m] = u.rows[rl < u.nvalid ? rl : 0]; }
#pragma unroll
        for (int ai = 0; ai < 2; ++ai)
#pragma unroll
            for (int m = 0; m < 4; ++m) sas[ai][m] = HS[tk[ai][m]];
#pragma unroll
        for (int ai = 0; ai < 2; ++ai)
#pragma unroll
            for (int m = 0; m < 4; ++m) { const float sa = sas[ai][m]; float a[8];
#pragma unroll
                for (int n = 0; n < 2; ++n) { const pg8::i32x4v ig = __builtin_bit_cast(pg8::i32x4v, acc[ai][0][m][n]), iu = __builtin_bit_cast(pg8::i32x4v, acc[ai][1][m][n]);
#pragma unroll
                    for (int j = 0; j < 4; ++j) { const float gg = (float)ig[j] * sa * (n ? sg1[j] : sg0[j]) + (n ? bg1[j] : bg0[j]), uu = (float)iu[j] * sa * (n ? su1[j] : su0[j]) + (n ? bu1[j] : bu0[j]);
                        const float g = fminf(gg, 7.f), uc = fminf(fmaxf(uu, -7.f), 7.f); a[4 * n + j] = (uc + 1.f) * (g * sigm_fast(1.702f * g)); } }
                pg8::u32x4 w; w.x = pg8::cvt_pk_bf16(a[0], a[1]); w.y = pg8::cvt_pk_bf16(a[2], a[3]); w.z = pg8::cvt_pk_bf16(a[4], a[5]); w.w = pg8::cvt_pk_bf16(a[6], a[7]);
                *(pg8::u32x4*)(ACT + (size_t)(row0 + ai * 128 + m * 16) * D + col0) = w; }
    }
};
struct EpiMoeAct {
    static constexpr bool PERM = true;
    bf16* ACT; const float* bgu;
    DI void operator()(const pg8::f32x4 (&acc)[2][2][4][2], const pg8::Unit& u, int wr, int wc, int fr, int fq) const {
        const int row0 = u.pm * 256 + wr * 64 + fr, col0 = u.pn * 128 + wc * 32 + 8 * fq;
        const float* b = bgu + (size_t)u.aux * 2048 + col0;
        const pg8::f32x4 bg0 = *(const pg8::f32x4*)(b), bg1 = *(const pg8::f32x4*)(b + 4), bu0 = *(const pg8::f32x4*)(b + 1024), bu1 = *(const pg8::f32x4*)(b + 1028);
#pragma unroll
        for (int ai = 0; ai < 2; ++ai)
#pragma unroll
            for (int m = 0; m < 4; ++m) { float a[8];
#pragma unroll
                for (int n = 0; n < 2; ++n) { const pg8::f32x4 gg = acc[ai][0][m][n] + (n ? bg1 : bg0), uu = acc[ai][1][m][n] + (n ? bu1 : bu0);
#pragma unroll
                    for (int j = 0; j < 4; ++j) { const float g = fminf(gg[j], 7.f), uc = fminf(fmaxf(uu[j], -7.f), 7.f); a[4 * n + j] = (uc + 1.f) * (g * sigm_fast(1.702f * g)); } }
                pg8::u32x4 w; w.x = pg8::cvt_pk_bf16(a[0], a[1]); w.y = pg8::cvt_pk_bf16(a[2], a[3]); w.z = pg8::cvt_pk_bf16(a[4], a[5]); w.w = pg8::cvt_pk_bf16(a[6], a[7]);
                *(pg8::u32x4*)(ACT + (size_t)(row0 + ai * 128 + m * 16) * D + col0) = w; }
    }
};

struct MapId { int off; DI int operator()(int n) const { return n + off; } };
struct MapProj { DI int operator()(int s) const {
    int t, slot;
    if (s < 512) { const int isg = s >> 8, ch = s & 255; t = ch >> 7; slot = isg * 4 + ((ch >> 5) & 3); }
    else if (s < OFF_C) { const int m = s - OFF_B; if (m < 192) { t = 8; slot = m >> 5; } else if (m < 320) { t = 9; slot = (m - 192) >> 5; } else { t = 8; slot = 6; } }
    else if (s < OFF_D) { const int m = s - OFF_C, head = m / 192, w = m - head * 192, ds = head * 6 + (w >> 5); t = 2 + (ds >> 3); slot = ds & 7; }
    else { const int m = s - OFF_D, head = m / 192, w = m - head * 192;
      if (w < 128) { const int pi = head * 2 + (w >> 6); t = 5 + (pi >> 2); slot = ((w >> 5) & 1) * 4 + (pi & 3); } else { t = 7; slot = head * 2 + ((w - 128) >> 5); } }
    return 256 * t + (slot >> 2) * 128 + (slot & 3) * 32 + (s & 31); } };
struct MapQ  { DI int operator()(int s) const { const int head = s / 96, w = s - head * 96; return 256 * (head >> 1) + 128 * (head & 1) + 32 * (w >> 5) + (s & 31); } };
struct MapKV { DI int operator()(int s) const { const int head = s >> 7, w = s & 127, isv = w >> 6, half = (w >> 5) & 1; return 256 * (2 + (head >> 1)) + 128 * half + 32 * (2 * isv + (head & 1)) + (s & 31); } };
struct MapGate { DI int operator()(int s) const { const int b = s >> 10, w = s & 1023, pn = w >> 6, lc = w & 63; return 256 * pn + 128 * (b >> 1) + 32 * (lc >> 4) + 16 * (b & 1) + (lc & 15); } };
struct MapGu { DI int operator()(int s) const { const int isu = s >> 10, c = s & 1023; return 256 * (c >> 7) + 128 * isu + (c & 127); } };
struct CvtItem { const float* W; bf16* WT; int N, ldk, kdst0, mapt, mapoff, item; };
DI CvtItem cvt_decode(PRef p, int it) {
    constexpr int I_WIN_ = (D / 64) * (INW / 32), I_UQ_ = 3 * 12, I_UKV_ = 2 * 16, I_BR_ = 4 * 32, I_GATE_ = 16 * 128, I_WO_ = 16 * 32, I_GU_ = 16 * 64, I_DN_ = 16 * 32;
    constexpr int PER_L = I_UQ_ + I_UKV_ + 4 * I_BR_ + I_WO_ + NE * I_DN_;
    unsigned char* ws = p.ws; CvtItem c; (void)I_WIN_; (void)I_GATE_; c.mapt = 0; c.mapoff = 0; c.kdst0 = 0;
    const int l = it / PER_L; int r = it - l * PER_L;
    if (r < I_UQ_) { c.W = p.in[I_WUQ] + (size_t)l * 192 * 384; c.N = 384; c.WT = (bf16*)(ws + WS_QKV_T) + (size_t)l * 1024 * 384; c.ldk = 384; c.mapt = 4; c.item = r; return c; } r -= I_UQ_;
    if (r < I_UKV_) { c.W = p.in[I_WUKV] + (size_t)l * 128 * 512; c.N = 512; c.WT = (bf16*)(ws + WS_QKV_T) + (size_t)l * 1024 * 384; c.ldk = 384; c.kdst0 = 192; c.mapt = 5; c.item = r; return c; } r -= I_UKV_;
    if (r < 4 * I_BR_) { const int b = r / I_BR_; c.W = (b == 0 ? p.in[I_CONVOUT] : b == 1 ? p.in[I_MLAOUT] : b == 2 ? p.in[I_DIFFOUT] : p.in[I_NAOUT]) + (size_t)l * 256 * D; c.N = D;
        c.WT = (bf16*)(ws + WS_WB_T) + ((size_t)l * 4 + b) * 1024 * 256; c.ldk = 256; c.item = r - b * I_BR_; return c; } r -= 4 * I_BR_;
    if (r < I_WO_) { c.W = p.in[I_WO] + (size_t)l * D * D; c.N = D; c.WT = (bf16*)(ws + WS_WO_T) + (size_t)l * D * D; c.ldk = D; c.item = r; return c; } r -= I_WO_;
    const int e = r / I_DN_; r -= e * I_DN_; (void)I_GU_;
    c.W = p.in[I_WDN] + ((size_t)l * NE + e) * DFF * D; c.N = D; c.WT = (bf16*)(ws + WS_WDN_T) + ((size_t)l * NE + e) * D * DFF; c.ldk = DFF; c.item = r; return c;
}
DI void cvt_load(const CvtItem& c, float (&v)[32], int lane) {
    const int nblk = c.N / 32, kb = c.item / nblk, nb = c.item - kb * nblk;
    const float* src = c.W + (size_t)(64 * kb + (lane >> 5)) * c.N + 32 * nb + (lane & 31);
#pragma unroll
    for (int i = 0; i < 32; ++i) v[i] = src[(size_t)(2 * i) * c.N];
}
DI void cvt_store(const CvtItem& c, const float (&v)[32], float* scr, int lane) {
    const int nblk = c.N / 32, kb = c.item / nblk, nb = c.item - kb * nblk, k0 = 64 * kb, n0 = 32 * nb;
#pragma unroll
    for (int i = 0; i < 32; ++i) scr[(2 * i + (lane >> 5)) * 33 + (lane & 31)] = v[i];
    asm volatile("s_waitcnt lgkmcnt(0)" ::: "memory");
    const int cc = lane & 7;
#pragma unroll
    for (int j = 0; j < 4; ++j) { const int n = (lane >> 3) + 8 * j; const float* s = scr + (8 * cc) * 33 + n;
        pg8::u32x4 o; o.x = pg8::cvt_pk_bf16(s[0 * 33], s[1 * 33]); o.y = pg8::cvt_pk_bf16(s[2 * 33], s[3 * 33]); o.z = pg8::cvt_pk_bf16(s[4 * 33], s[5 * 33]); o.w = pg8::cvt_pk_bf16(s[6 * 33], s[7 * 33]);
        const int sn = n0 + n; const int row = c.mapt == 0 ? sn + c.mapoff : (c.mapt == 1 ? MapGate()(sn) : (c.mapt == 2 ? MapGu()(sn) : (c.mapt == 3 ? MapProj()(sn) : (c.mapt == 4 ? MapQ()(sn) : MapKV()(sn)))));
        *(pg8::u32x4*)(c.WT + (size_t)row * c.ldk + c.kdst0 + k0 + 8 * cc) = o; }
    asm volatile("s_waitcnt lgkmcnt(0)" ::: "memory");
}
DI void ph_convert(PRef p, unsigned char* lds) {
    const int tid_ = opq_tid(); const int bid_ = opq_bid(), nblk_ = opq_nblk(); const int lane = tid_ & 63, wave = __builtin_amdgcn_readfirstlane(tid_ >> 6);
    float* scr = (float*)(lds + wave * 8704);
    const int gw = bid_ * 8 + wave, ngw = nblk_ * 8;
    constexpr int PER_L = 3 * 12 + 2 * 16 + 4 * 4 * 32 + 16 * 32 + NE * (16 * 32);
    const int total = 2 * PER_L;
    float va[32], vb[32];
    int it = gw;
    CvtItem ca, cb;
    if (it < total) { ca = cvt_decode(p, it); cvt_load(ca, va, lane); }
    for (; it < total; it += 2 * ngw) {
        const int i1 = it + ngw, i2 = it + 2 * ngw;
        if (i1 < total) { cb = cvt_decode(p, i1); cvt_load(cb, vb, lane); }
        cvt_store(ca, va, scr, lane);
        if (i2 < total) { ca = cvt_decode(p, i2); cvt_load(ca, va, lane); }
        if (i1 < total) cvt_store(cb, vb, scr, lane);
    }
    __syncthreads();
    { float* red = (float*)lds;
      const int n = tid_ & 31, kg = tid_ >> 5; signed char* W8 = (signed char*)(p.ws + WS_WGU_T); float* WS_ = (float*)(p.ws + WS_WGUS);
      float xa[64], xb[64];
#define I8_DECODE(it, src_, N_, dst_, sca_, kind_, nb_) const float* src_; int N_, kind_, nb_; signed char* dst_; float* sca_; \
        if ((it) < 4096) { const int le_ = (it) >> 6; nb_ = (it) & 63; src_ = p.in[I_WGU] + (size_t)le_ * D * 2048; N_ = 2048; dst_ = W8 + (size_t)le_ * 2048 * D * 2; sca_ = WS_ + (size_t)le_ * 2048; kind_ = 0; } \
        else if ((it) < 4096 + 150) { const int l_ = ((it) - 4096) / 75; nb_ = ((it) - 4096) - l_ * 75; src_ = p.in[I_WIN] + (size_t)l_ * D * INW; N_ = INW; dst_ = (signed char*)(p.ws + WS_WIN_T) + (size_t)l_ * PLD * D * 2; sca_ = (float*)(p.ws + WS_WINS) + l_ * PLD; kind_ = 1; } \
        else { const int l_ = ((it) - 4246) >> 7; nb_ = ((it) - 4246) & 127; src_ = p.in[I_GATEW] + (size_t)l_ * D * 4096; N_ = 4096; dst_ = (signed char*)(p.ws + WS_GATE_T) + (size_t)l_ * 4096 * D * 2; sca_ = (float*)(p.ws + WS_GATES) + l_ * 4096; kind_ = 2; }
#define GU_LOAD(dst, it) do { I8_DECODE(it, src_, N_, d8_, sc8_, kind_, nb_); (void)d8_; (void)sc8_; (void)kind_; const float* s2_ = src_ + (size_t)(64 * kg) * N_ + 32 * nb_ + n; \
        _Pragma("unroll") for (int i = 0; i < 64; ++i) dst[i] = s2_[(size_t)i * N_]; } while (0)
#define GU_EMIT(src, it) do { I8_DECODE(it, src_, N_, d8_, sc8_, kind_, nb_); (void)src_; float m_ = 0.f; _Pragma("unroll") for (int i = 0; i < 64; ++i) m_ = fmaxf(m_, fabsf(src[i])); \
        red[kg * 32 + n] = m_; __syncthreads(); \
        if (tid_ < 32) { float mm_ = 0.f; _Pragma("unroll") for (int g = 0; g < 16; ++g) mm_ = fmaxf(mm_, red[g * 32 + tid_]); red[512 + tid_] = mm_ > 0.f ? mm_ * (1.f / 127.f) : 1.f; } \
        __syncthreads(); const float sc_ = red[512 + n], inv_ = 1.f / sc_; const int col_ = 32 * nb_ + n; const int row_ = kind_ == 0 ? MapGu()(col_) : (kind_ == 1 ? MapProj()(col_) : MapGate()(col_)); \
        if (kg == 0) sc8_[row_] = sc_; \
        signed char* dst_ = d8_ + (size_t)row_ * D + 64 * kg; \
        _Pragma("unroll") for (int q = 0; q < 4; ++q) { unsigned w_[4]; _Pragma("unroll") for (int d = 0; d < 4; ++d) { unsigned b_ = 0; _Pragma("unroll") for (int i = 0; i < 4; ++i) { \
            const int v_ = (int)rintf(src[16 * q + 4 * d + i] * inv_); b_ |= ((unsigned)v_ & 255u) << (8 * i); } w_[d] = b_; } \
            *(uint4*)(dst_ + 16 * q) = make_uint4(w_[0], w_[1], w_[2], w_[3]); } \
        __syncthreads(); } while (0)
      const int nit = 2 * NE * 64 + 150 + 256; int it2 = bid_;
      if (it2 < nit) GU_LOAD(xa, it2);
      for (; it2 < nit; it2 += 2 * nblk_) { const int j1 = it2 + nblk_, j2 = it2 + 2 * nblk_;
        if (j1 < nit) GU_LOAD(xb, j1);
        GU_EMIT(xa, it2);
        if (j2 < nit) GU_LOAD(xa, j2);
        if (j1 < nit) GU_EMIT(xb, j1); }
#undef GU_LOAD
#undef GU_EMIT
#undef I8_DECODE
    }
}

#define LDSP ((PG8_LAS unsigned char*)lds)
DI void ph_proj_fast(PRef p, int l, unsigned char* lds) {
    const int bid_ = opq_bid(), nblk_ = opq_nblk(); const int tid0 = opq_tid(), lane0 = tid0 & 63;
    SchedDense S; S.init(p.ws + WS_H, D / 2, (const bf16*)(p.ws + WS_WIN_T) + (size_t)l * PLD * D, D / 2, T, PLD, nblk_, bid_);
    EpiProjFused E;
    E.CU = (bf16*)(p.ws + WS_CU); E.AQ = (bf16*)(p.ws + WS_AQ); E.DQ = (bf16*)(p.ws + WS_DQ); E.DK = (bf16*)(p.ws + WS_DK); E.DV = (bf16*)(p.ws + WS_DV);
    E.NQ = (bf16*)(p.ws + WS_NQ); E.NK = (bf16*)(p.ws + WS_NK); E.NV = (bf16*)(p.ws + WS_NV); E.KPE = (bf16*)(p.ws + WS_KPE);
    E.QBD = (float*)(p.ws + WS_QBD); E.QBN = (float*)(p.ws + WS_QBN); E.ROPE = (const float*)(p.ws + WS_ROPE);
    E.cqg = p.in[I_CQG] + l * 192; E.ckvg = p.in[I_CKVG] + l * 128; E.dqg = p.in[I_DQNG] + l * 32; E.dkg = p.in[I_DKNG] + l * 32; E.nqg = p.in[I_NQNG] + l * 64; E.nkg = p.in[I_NKNG] + l * 64;
    { float m = lane0 < 32 ? fabsf(p.in[I_DKNG][l * 32 + lane0]) : 0.f;
#pragma unroll
      for (int o = 1; o < 64; o <<= 1) m = fmaxf(m, lane_xor(m, lane0, o));
      float m2 = fabsf(p.in[I_NKNG][l * 64 + lane0]);
#pragma unroll
      for (int o = 1; o < 64; o <<= 1) m2 = fmaxf(m2, lane_xor(m2, lane0, o));
      float t0 = 5.656854249f * 1.004f * m, t1 = 8.f * 1.004f * m2, t2 = __int_as_float(((const int*)(p.ws + WS_CTL))[CW_BIASMAX + l]) * LOG2E + 0.05f;
      asm volatile("" : "+v"(t0), "+v"(t1), "+v"(t2));
      const int b0 = __builtin_amdgcn_readfirstlane(__float_as_int(t0)), b1 = __builtin_amdgcn_readfirstlane(__float_as_int(t1)), b2 = __builtin_amdgcn_readfirstlane(__float_as_int(t2));
      E.kbd = __int_as_float(b0); E.kbn = __int_as_float(b1); E.nbias = __int_as_float(b2); }
    E.P = (float*)(lds + 131072 + 4096); E.HS1 = (const float*)(p.ws + WS_HS1); E.WINS = (const float*)(p.ws + WS_WINS) + l * PLD;
    pg8::gemm_phase<EpiProjFused, SchedDense, false, true>(LDSP, D, D, S, E);
}
DI void ph_qkvraw_fast(PRef p, int l, unsigned char* lds) {
    const int bid_ = opq_bid(), nblk_ = opq_nblk(); const int lane0 = opq_tid() & 63;
    SchedDense S; S.init(p.ws + WS_AQ, 384, (const bf16*)(p.ws + WS_QKV_T) + (size_t)l * 1024 * 384, 384, T, 1024, nblk_, bid_);
    EpiQkvFused E; E.MQ = (bf16*)(p.ws + WS_MQ); E.MK = (bf16*)(p.ws + WS_MK); E.MV = (bf16*)(p.ws + WS_MV); E.KPE = (const bf16*)(p.ws + WS_KPE); E.QBM = (float*)(p.ws + WS_QBM);
    E.ROPE = (const float*)(p.ws + WS_ROPE); E.gq = p.in[I_QNG] + l * 96; E.gk = p.in[I_KNG] + l * 96; E.P = (float*)(lds + 131072 + 4096);
    { float mq = 0.f, mk = 0.f;
      for (int i = lane0; i < 96; i += 64) { mq = fmaxf(mq, fabsf(E.gq[i])); mk = fmaxf(mk, fabsf(E.gk[i])); }
#pragma unroll
      for (int o = 1; o < 64; o <<= 1) { mq = fmaxf(mq, lane_xor(mq, lane0, o)); mk = fmaxf(mk, lane_xor(mk, lane0, o)); }
      E.nbconst = __int_as_float(__builtin_amdgcn_readfirstlane(__float_as_int(-(96.f * 0.10206207261596577f * LOG2E * mq * mk * 1.004f + 0.05f)))); }
    pg8::gemm_phase<EpiQkvFused, SchedDense, false>(LDSP, 384, 384, S, E);
}
DI void ph_branch_fast(PRef p, int l, int nrows, unsigned char* lds) {
    const int bid_ = opq_bid(), nblk_ = opq_nblk();
    SchedBranch S; S.init(p.ws + WS_BI, (const bf16*)(p.ws + WS_WB_T) + (size_t)l * 4 * 1024 * 256, nrows, nblk_, bid_);
    EpiStoreBf16 E{(bf16*)(p.ws + WS_YB), 4096, 1024, nullptr, 0};
    pg8::gemm_phase<EpiStoreBf16, SchedBranch, false>(LDSP, D, 256, S, E);
}
DI void ph_merge_fast(PRef p, int l, int nrows, unsigned char* lds) {
    const int bid_ = opq_bid(), nblk_ = opq_nblk();
    SchedDense S; S.init(p.ws + WS_H, D / 2, (const bf16*)(p.ws + WS_GATE_T) + (size_t)l * 4096 * D, D / 2, nrows, 4096, nblk_, bid_);
    S.rev = true;
    EpiMerge E{(const bf16*)(p.ws + WS_YB), (bf16*)(p.ws + WS_YM), p.in[I_GATEB] + l * 4096, (const float*)(p.ws + WS_HS1), (const float*)(p.ws + WS_GATES) + l * 4096};
    pg8::gemm_phase<EpiMerge, SchedDense, false, true>(LDSP, D, D, S, E);
}
DI void ph_wo_fast(PRef p, int l, int nrows, unsigned char* lds) {
    const int bid_ = opq_bid(), nblk_ = opq_nblk();
    SchedDense S; S.init(p.ws + WS_YM, D, (const bf16*)(p.ws + WS_WO_T) + (size_t)l * D * D, D, nrows, D, nblk_, bid_);
    const float* XFc = (const float*)(p.ws + WS_XF);
    EpiWo E{l == 0 ? p.in[I_X] : XFc, l == 0 ? p.in[I_CTX] : XFc + (size_t)TL * D, (float*)(p.ws + WS_XF), (const float*)(p.ws + WS_MOD) + (size_t)l * 9 * 6144 + 2048};
    pg8::gemm_phase<EpiWo, SchedDense, false>(LDSP, D, D, S, E);
}
DI void moe_offsets(PRef p, int l, int* off, int tid) {
    const unsigned* cnt = (const unsigned*)(p.ws + WS_CTL) + CW_CNT + l * 64;
    if (tid == 0) expert_offsets(cnt, off);
    if (tid < NE) off[40 + tid] = (int)cnt[tid];
    __syncthreads();
}
DI void ph_moe1_fast(PRef p, int l, unsigned char* lds) {
    const int tid_ = opq_tid(); const int bid_ = opq_bid(), nblk_ = opq_nblk(); (void)bid_; (void)nblk_; int* off = (int*)(lds + 131072 + 1024); moe_offsets(p, l, off, tid_);
    SchedMoe S; S.A = (const char*)(p.ws + WS_H2); S.Bt = (const char*)((const bf16*)(p.ws + WS_WGU_T) + (size_t)l * NE * 2048 * D); S.rowtok = (const int*)(p.ws + WS_ROWTOK); S.off = off; S.cnt = off + 40;
    S.nN = 8; S.G = nblk_; S.c = bid_; S.ntiles = off[NE] >> 8; S.tstepA = 0; S.estepB = (size_t)2048 * D * 2  ; S.tstepB = (size_t)256 * D  ; S.gather = true;
    EpiMoeActI8 E{(bf16*)(p.ws + WS_ACT), p.in[I_BGU] + (size_t)l * NE * 2048, (const float*)(p.ws + WS_HS), (const float*)(p.ws + WS_WGUS) + (size_t)l * NE * 2048};
    pg8::gemm_phase<EpiMoeActI8, SchedMoe, true, true>(LDSP, D, D, S, E);
}
DI void ph_moe2_fast(PRef p, int l, unsigned char* lds) {
    const int tid_ = opq_tid(); const int bid_ = opq_bid(), nblk_ = opq_nblk(); (void)bid_; (void)nblk_; int* off = (int*)(lds + 131072 + 1024); moe_offsets(p, l, off, tid_);
    SchedMoe S; S.A = (const char*)(p.ws + WS_ACT); S.Bt = (const char*)((const bf16*)(p.ws + WS_WDN_T) + (size_t)l * NE * D * DFF); S.rowtok = (const int*)(p.ws + WS_ROWTOK); S.off = off; S.cnt = off + 40;
    S.nN = 4; S.G = nblk_; S.c = bid_; S.ntiles = off[NE] >> 8; S.tstepA = (size_t)256 * D * 2; S.estepB = (size_t)D * DFF * 2; S.tstepB = (size_t)256 * DFF * 2; S.gather = false;
    S.rev = true;
    EpiStoreBf16 E{(bf16*)(p.ws + WS_YE), D, 0, p.in[I_BDN] + (size_t)l * NE * D, D};
    pg8::gemm_phase<EpiStoreBf16, SchedMoe, false>(LDSP, DFF, DFF, S, E);
}

namespace fa {
using bf16x8 = __attribute__((ext_vector_type(8))) short;
using s16x4  = __attribute__((ext_vector_type(4))) short;
using f32x16 = __attribute__((ext_vector_type(16))) float;
using u32x4  = __attribute__((ext_vector_type(4))) unsigned;
constexpr int SHM_K = 64 * 256, SHM_V = 64 * 256;
constexpr float THR2 = 11.5f;
#define FA_KSWZ(row, colB) ((row) * 256 + ((colB) ^ (((row) & 7) << 4)))
#define FA_SBAR() __builtin_amdgcn_sched_barrier(0)
DI int crow(int r, int hi) { return (r & 3) + 8 * (r >> 2) + 4 * hi; }
DI unsigned cvtpk(float lo, float hi) { unsigned r; asm volatile("v_cvt_pk_bf16_f32 %0, %1, %2" : "=v"(r) : "v"(lo), "v"(hi)); return r; }
DI int v_st(int k, int c) { const int kk = k;        return ((kk >> 3) * 4 + (c >> 5)) * 512 + ((kk & 7) * 32 + (c & 31)) * 2; }
DI int v_rd_base(int lane) { return ((lane & 3) << 3) | (((lane >> 2) & 3) << 6) | (((lane >> 4) & 1) << 5) | (((lane >> 5) & 1) << 8); }
constexpr int v_rd_off(int d0, int ks, int half) { return d0 * 512 + ks * 4096 + half * 2048; }
template <int OFF> DI s16x4 tr_read(int vb) { s16x4 r; asm volatile("ds_read_b64_tr_b16 %0, %1 offset:%2" : "=&v"(r) : "v"(vb), "i"(OFF) : "memory"); return r; }
template <int D0> DI void pv_one(f32x16& od, int vb, bf16x8 pa0, bf16x8 pa1, bf16x8 pa2, bf16x8 pa3) {
  const s16x4 l0 = tr_read<v_rd_off(D0, 0, 0)>(vb), h0 = tr_read<v_rd_off(D0, 0, 1)>(vb), l1 = tr_read<v_rd_off(D0, 1, 0)>(vb), h1 = tr_read<v_rd_off(D0, 1, 1)>(vb);
  const s16x4 l2 = tr_read<v_rd_off(D0, 2, 0)>(vb), h2 = tr_read<v_rd_off(D0, 2, 1)>(vb), l3 = tr_read<v_rd_off(D0, 3, 0)>(vb), h3 = tr_read<v_rd_off(D0, 3, 1)>(vb);
  asm volatile("s_waitcnt lgkmcnt(0)" ::: "memory"); FA_SBAR();
#define FA_PK(L, H) (bf16x8){L[0], L[1], L[2], L[3], H[0], H[1], H[2], H[3]}
  od = __builtin_amdgcn_mfma_f32_32x32x16_bf16(pa0, FA_PK(l0, h0), od, 0, 0, 0);
  od = __builtin_amdgcn_mfma_f32_32x32x16_bf16(pa1, FA_PK(l1, h1), od, 0, 0, 0);
  od = __builtin_amdgcn_mfma_f32_32x32x16_bf16(pa2, FA_PK(l2, h2), od, 0, 0, 0);
  od = __builtin_amdgcn_mfma_f32_32x32x16_bf16(pa3, FA_PK(l3, h3), od, 0, 0, 0);
#undef FA_PK
}

}


DI void ph_ada_fast(PRef p, unsigned char* lds) {
  const int tid_ = opq_tid(); const int bid_ = opq_bid(), nblk_ = opq_nblk();
  float* MOD = (float*)(p.ws + WS_MOD);
  { float* ROPE = (float*)(p.ws + WS_ROPE);
    for (int idx = GTID; idx < SEQ * 16; idx += NTHR) { const int sq = idx >> 4, i = idx & 15; const float pos = (i < 8) ? (float)(sq >> 6) : (float)(sq & 63);
      const float inv = powf(10000.f, -(float)(2 * (i & 7)) / 16.f); const float th = pos * inv; ROPE[sq * 32 + i] = cosf(th); ROPE[sq * 32 + 16 + i] = sinf(th); } }
  if (bid_ == 0) { for (int k = tid_; k < 2 * NH * 15 * 31; k += 512) { const float v = fmaxf(p.in[I_RPB][k], 0.f); atomicMax((int*)(p.ws + WS_CTL) + CW_BIASMAX + k / (NH * 15 * 31), __float_as_int(v)); } }
  float* sc = (float*)lds;
  float* red = (float*)(lds + 40960);
  for (int k = tid_; k < 9 * D; k += 512) { const int i = k >> 10, kk = k & 1023; const float v = i < 8 ? p.in[I_C][i * D + kk] : p.in[I_CCTX][kk]; sc[k] = v * sigmoidf_(v); }
  __syncthreads();
  const int nn = tid_ & 63, kg = tid_ >> 6;
  for (int it = bid_; it < 2 * 96; it += nblk_) {
    const int l = it / 96, n0 = (it - l * 96) * 64;
    const float* W = p.in[I_ADAW] + (size_t)l * D * 6144 + n0 + nn;
    float acc[9];
#pragma unroll
    for (int i = 0; i < 9; ++i) acc[i] = 0.f;
#pragma unroll 8
    for (int k = kg * 128; k < kg * 128 + 128; ++k) { const float w = W[(size_t)k * 6144];
#pragma unroll
      for (int i = 0; i < 9; ++i) acc[i] += sc[i * D + k] * w; }
#pragma unroll
    for (int i = 0; i < 9; ++i) red[(kg * 9 + i) * 64 + nn] = acc[i];
    __syncthreads();
    for (int o = tid_; o < 9 * 64; o += 512) { const int i = o >> 6, n = o & 63; float s = 0.f;
#pragma unroll
      for (int g = 0; g < 8; ++g) s += red[(g * 9 + i) * 64 + n];
      MOD[((size_t)l * 9 + i) * 6144 + n0 + n] = s + p.in[I_ADAB][l * 6144 + n0 + n]; }
    __syncthreads();
  }
}


DI void ld32(const bf16* __restrict__ src, float (&x)[32]) {
#pragma unroll
  for (int q = 0; q < 4; ++q) { const uint4 u = *(const uint4*)(src + 8 * q); const unsigned w[4] = {u.x, u.y, u.z, u.w};
#pragma unroll
    for (int i = 0; i < 4; ++i) { x[8 * q + 2 * i] = __uint_as_float(w[i] << 16); x[8 * q + 2 * i + 1] = __uint_as_float(w[i] & 0xffff0000u); } }
}
DI void st32(bf16* __restrict__ dst, const float (&x)[32]) {
#pragma unroll
  for (int q = 0; q < 4; ++q) { uint4 u; u.x = cvt_pk_bf16_(x[8 * q], x[8 * q + 1]); u.y = cvt_pk_bf16_(x[8 * q + 2], x[8 * q + 3]); u.z = cvt_pk_bf16_(x[8 * q + 4], x[8 * q + 5]); u.w = cvt_pk_bf16_(x[8 * q + 6], x[8 * q + 7]); *(uint4*)(dst + 8 * q) = u; }
}


DI void ph_diffcombine_fast(PRef p, int l, int nrows, float lam_init) {
  const int tid_ = opq_tid(); const int bid_ = opq_bid(), nblk_ = opq_nblk();
  const int lane = tid_ & 63, gw = GTID >> 6, ngw = NTHR >> 6;
  const bf16* __restrict__ DO_ = (const bf16*)(p.ws + WS_DO); bf16* __restrict__ BI = (bf16*)(p.ws + WS_BI);
  const float* lv = p.in[I_DLAM] + l * 128;
  const float t1 = seg_sum(lane < 32 ? lv[lane] * lv[32 + lane] : 0.f, lane, 64), t2 = seg_sum(lane < 32 ? lv[64 + lane] * lv[96 + lane] : 0.f, lane, 64);
  const float lam = expf(t1) - expf(t2) + lam_init;
  const int h = lane >> 4, d = 4 * (lane & 15);
  float g[4];
#pragma unroll
  for (int i = 0; i < 4; ++i) g[i] = p.in[I_DSUBG][l * 64 + d + i] * (1.f - lam_init);
#pragma unroll 4
  for (int r = gw; r < nrows; r += ngw) {
    float a[4], b[4], v[4]; ld4(DO_ + (size_t)r * 512 + (2 * h) * 64 + d, a); ld4(DO_ + (size_t)r * 512 + (2 * h + 1) * 64 + d, b);
#pragma unroll
    for (int i = 0; i < 4; ++i) v[i] = a[i] - lam * b[i];
    const float ss = seg_sum(v[0] * v[0] + v[1] * v[1] + v[2] * v[2] + v[3] * v[3], lane, 16); const float rs = rsqrtf(ss * (1.f / 64.f) + EPS);
#pragma unroll
    for (int i = 0; i < 4; ++i) v[i] = v[i] * rs * g[i];
    st4(BI + (size_t)r * D + 512 + h * 64 + d, v);
  }
}

DI void ph_mod2_router_fast(PRef p, int l, int nrows, unsigned char* lds) {
  const int tid_ = opq_tid(); const int bid_ = opq_bid(), nblk_ = opq_nblk();
  const int lane = tid_ & 63, wave = tid_ >> 6;
  float* rwT = (float*)lds;
  unsigned* lcnt = (unsigned*)(lds + 131072 + 2048);
  int* rbuf = (int*)(lds + 131072 + 4096);
  const float* rw = p.in[I_RW] + (size_t)l * D * NE;
  for (int q = tid_; q < D * NE / 4; q += 512) { const float4 v = *(const float4*)(rw + (size_t)q * 4); const int c = q >> 3, e = (q & 7) * 4;
    rwT[(e + 0) * D + c] = v.x; rwT[(e + 1) * D + c] = v.y; rwT[(e + 2) * D + c] = v.z; rwT[(e + 3) * D + c] = v.w; }
  if (tid_ < 64) lcnt[tid_] = 0u;
  __syncthreads();
  const float* MOD = (const float*)(p.ws + WS_MOD); const float* XF = (const float*)(p.ws + WS_XF);
  bf16* H2 = (bf16*)(p.ws + WS_H2); float* HS = (float*)(p.ws + WS_HS); const float* g = p.in[I_N2G] + l * D; const float* rb = p.in[I_RB] + l * NE;
  int* ROUTE = (int*)(p.ws + WS_ROUTE); unsigned* cnt = (unsigned*)(p.ws + WS_CTL) + CW_CNT + l * 64; int* ROWTOK = (int*)(p.ws + WS_ROWTOK);
  const int per = (nrows + nblk_ - 1) / nblk_, rlo = bid_ * per, rhi = min(rlo + per, nrows);
  float4 cx0, cx1, cx2, cx3;
  { const int r = min(rlo + wave, nrows - 1); const float* x = XF + (size_t)r * D + lane * 4; cx0 = *(const float4*)(x); cx1 = *(const float4*)(x + 256); cx2 = *(const float4*)(x + 512); cx3 = *(const float4*)(x + 768); }
  for (int r = rlo + wave; r < rhi; r += 8) {
    float4 nx0, nx1, nx2, nx3;
    { const int rn = min(r + 8, nrows - 1); const float* x = XF + (size_t)rn * D + lane * 4; nx0 = *(const float4*)(x); nx1 = *(const float4*)(x + 256); nx2 = *(const float4*)(x + 512); nx3 = *(const float4*)(x + 768); }
    float v[16]; float ss = 0.f;
    { const float4 t4[4] = {cx0, cx1, cx2, cx3};
#pragma unroll
    for (int j = 0; j < 4; ++j) { const float4 t = t4[j]; v[4 * j] = t.x; v[4 * j + 1] = t.y; v[4 * j + 2] = t.z; v[4 * j + 3] = t.w; ss += t.x * t.x + t.y * t.y + t.z * t.z + t.w * t.w; } }
    cx0 = nx0; cx1 = nx1; cx2 = nx2; cx3 = nx3;
    ss = seg_sum(ss, lane, 64);
    const float rstd = rsqrtf(ss * (1.f / D) + EPS);
    const float* md = MOD + ((size_t)l * 9 + modidx(r)) * 6144;
#pragma unroll
    for (int j = 0; j < 4; ++j) { const int c = j * 256 + lane * 4; const float4 gg = *(const float4*)(g + c), s4 = *(const float4*)(md + 4 * 1024 + c), h4 = *(const float4*)(md + 3 * 1024 + c);
      v[4 * j] = v[4 * j] * rstd * gg.x * (1.f + s4.x) + h4.x; v[4 * j + 1] = v[4 * j + 1] * rstd * gg.y * (1.f + s4.y) + h4.y;
      v[4 * j + 2] = v[4 * j + 2] * rstd * gg.z * (1.f + s4.z) + h4.z; v[4 * j + 3] = v[4 * j + 3] * rstd * gg.w * (1.f + s4.w) + h4.w;
      }
    { float mx = 0.f;
#pragma unroll
      for (int i = 0; i < 16; ++i) mx = fmaxf(mx, fabsf(v[i]));
#pragma unroll
      for (int o = 1; o < 64; o <<= 1) mx = fmaxf(mx, lane_xor(mx, lane, o));
      const float sc = mx > 0.f ? mx * (1.f / 127.f) : 1.f, inv = 1.f / sc; if (lane == 0) HS[r] = sc;
#pragma unroll
      for (int j = 0; j < 4; ++j) { unsigned b = 0;
#pragma unroll
        for (int i = 0; i < 4; ++i) b |= ((unsigned)(int)rintf(v[4 * j + i] * inv) & 255u) << (8 * i);
        *(unsigned*)((signed char*)H2 + (size_t)r * D + j * 256 + lane * 4) = b; } }
    float lg[NE];
#pragma unroll
    for (int e = 0; e < NE; ++e) { float s = 0.f;
#pragma unroll
      for (int j = 0; j < 4; ++j) { const float4 w = *(const float4*)(rwT + e * D + j * 256 + lane * 4); s += v[4 * j] * w.x + v[4 * j + 1] * w.y + v[4 * j + 2] * w.z + v[4 * j + 3] * w.w; }
      lg[e] = s; }
#pragma unroll
    for (int e = 0; e < NE; ++e) lg[e] = seg_sum(lg[e], lane, 64) + rb[e];
    int te[4]; float tv[4];
#pragma unroll
    for (int k = 0; k < 4; ++k) { float best = -3.4e38f; int bi = 0;
#pragma unroll
      for (int e = 0; e < NE; ++e) { const bool taken = (k > 0 && te[0] == e) || (k > 1 && te[1] == e) || (k > 2 && te[2] == e); if (!taken && lg[e] > best) { best = lg[e]; bi = e; } }
      te[k] = bi; tv[k] = best; }
    const float mx = tv[0]; float ex[4], se = 0.f;
#pragma unroll
    for (int k = 0; k < 4; ++k) { ex[k] = expf(tv[k] - mx); se += ex[k]; }
    if (lane == 0) { int* rt = rbuf + (r - rlo) * 12;
#pragma unroll
      for (int k = 0; k < 4; ++k) { rt[3 * k] = te[k]; rt[3 * k + 1] = (int)atomicAdd(&lcnt[te[k]], 1u); rt[3 * k + 2] = __float_as_int(ex[k] / se); } }
  }
  __syncthreads();
  if (tid_ < NE) lcnt[32 + tid_] = lcnt[tid_] ? atomicAdd(&cnt[tid_], lcnt[tid_]) : 0u;
  __syncthreads();
  for (int q = tid_; q < (rhi - rlo) * 4; q += 512) { const int lr = q >> 2, k = q & 3; const int* rt = rbuf + lr * 12 + 3 * k; int* o = ROUTE + ((size_t)(rlo + lr) * 4 + k) * 4;
    const int pos = rt[1] + (int)lcnt[32 + rt[0]];
    o[0] = rt[0]; o[1] = pos; o[2] = rt[2]; o[3] = 0; ROWTOK[(size_t)rt[0] * T + pos] = rlo + lr; }
}


namespace fa {
DI void expcvt(f32x16& p0, f32x16& p1, bf16x8& pa0, bf16x8& pa1, bf16x8& pa2, bf16x8& pa3) {
#pragma unroll
  for (int r = 0; r < 16; ++r) p0[r] = __builtin_amdgcn_exp2f(p0[r]);
#pragma unroll
  for (int r = 0; r < 16; ++r) p1[r] = __builtin_amdgcn_exp2f(p1[r]);
#define FA_PK4(P, BASE, OUT) do { unsigned a0 = cvtpk(P[BASE + 0], P[BASE + 1]), a1 = cvtpk(P[BASE + 2], P[BASE + 3]);   \
    unsigned b0 = cvtpk(P[BASE + 4], P[BASE + 5]), b1 = cvtpk(P[BASE + 6], P[BASE + 7]);                              \
    u32x4 w = {a0, a1, b0, b1}; OUT = *reinterpret_cast<bf16x8*>(&w); } while (0)
  FA_PK4(p0, 0, pa0); FA_PK4(p0, 8, pa1); FA_PK4(p1, 0, pa2); FA_PK4(p1, 8, pa3);
#undef FA_PK4
}
template <int ND0, int KST = 0>
DI void qkt2(f32x16& p0, f32x16& p1, const char* Ks, const bf16x8* qr, const f32x16& nbt, int r32, int hi) {
#pragma unroll
  for (int d0 = 0; d0 < ND0; ++d0) { const int cb = (d0 * 16 + hi * 8) * 2;
    bf16x8 b0 = *reinterpret_cast<const bf16x8*>(Ks + (KST ? r32 * KST + cb : FA_KSWZ(r32, cb)));
    bf16x8 b1 = *reinterpret_cast<const bf16x8*>(Ks + (KST ? (32 + r32) * KST + cb : FA_KSWZ(32 + r32, cb)));
    p0 = __builtin_amdgcn_mfma_f32_32x32x16_bf16(b0, qr[d0], d0 == 0 ? nbt : p0, 0, 0, 0);
    p1 = __builtin_amdgcn_mfma_f32_32x32x16_bf16(b1, qr[d0], d0 == 0 ? nbt : p1, 0, 0, 0); }
}
DI void pv3(f32x16* o, int vb, bf16x8 pa0, bf16x8 pa1, bf16x8 pa2, bf16x8 pa3) { pv_one<0>(o[0], vb, pa0, pa1, pa2, pa3); pv_one<1>(o[1], vb, pa0, pa1, pa2, pa3); pv_one<2>(o[2], vb, pa0, pa1, pa2, pa3); }
DI void fill_ones(char* V_lds, int tid) {
  const int b = tid >> 8, t = tid & 255, key = t >> 2, c8 = (t & 3) * 8;
  u32x4 w = {c8 == 0 ? 0x00003F80u : 0u, 0u, 0u, 0u};
  *(u32x4*)(V_lds + b * SHM_V + v_st(key, 64 + c8)) = w;
}
template <int DQK>
DI void attn_unit2(const bf16* __restrict__ Qb, int ldq, const bf16* __restrict__ Kh, int ldk, const bf16* __restrict__ Vh, const float* __restrict__ nbp, int nbs, int kva, int kvb, int NT,
                   bf16* __restrict__ Ob, int ldo, char* lds, int tid) {
  constexpr int ND0 = DQK / 16;
  const int wid = tid >> 6, lane = tid & 63, r32 = lane & 31, hi = lane >> 5;
  char* V_lds = lds; char* K_lds = lds + 2 * SHM_V;
  f32x16 o[3] = {}; bf16x8 qr[ND0];
  const bf16* Qw = Qb + (long)(wid * 32 + r32) * ldq + hi * 8;
#pragma unroll
  for (int d0 = 0; d0 < ND0; ++d0) qr[d0] = *reinterpret_cast<const bf16x8*>(Qw + d0 * 16);
  const float nb = nbp[(long)(wid * 32 + r32) * nbs];
  f32x16 nbt;
#pragma unroll
  for (int r = 0; r < 16; ++r) nbt[r] = nb;
  const int sr = tid >> 4, sc = (tid & 15) * 8; const bool kact = sc < DQK, vact = sc < 64;
  const int vst0 = v_st(sr, sc & 63), vst1 = v_st(32 + sr, sc & 63);
  const int vb0 = (int)(uintptr_t)V_lds + v_rd_base(lane);
  struct { bf16x8 vs0, vs1, ks0, ks1; } sr_[2];
#define FA_KROW(j) ((j) < 4 ? kva + 64 * (j) : kvb + 64 * ((j) - 4))
#define FA_SLOAD(i, j) do { const long kr_ = FA_KROW(j); \
    if (vact) { sr_[i].vs0 = *reinterpret_cast<const bf16x8*>(&Vh[(kr_ + sr) * 256 + sc]); sr_[i].vs1 = *reinterpret_cast<const bf16x8*>(&Vh[(kr_ + 32 + sr) * 256 + sc]); } \
    if (kact) { sr_[i].ks0 = *reinterpret_cast<const bf16x8*>(&Kh[(kr_ + sr) * ldk + sc]); sr_[i].ks1 = *reinterpret_cast<const bf16x8*>(&Kh[(kr_ + 32 + sr) * ldk + sc]); } } while (0)
#define FA_SWRITE(b, i) do { if (vact) { *(bf16x8*)(V_lds + (b) * SHM_V + vst0) = sr_[i].vs0; *(bf16x8*)(V_lds + (b) * SHM_V + vst1) = sr_[i].vs1; } \
    if (kact) { const int kc = sc * 2; *(bf16x8*)(K_lds + (b) * SHM_K + FA_KSWZ(sr, kc)) = sr_[i].ks0; *(bf16x8*)(K_lds + (b) * SHM_K + FA_KSWZ(32 + sr, kc)) = sr_[i].ks1; } } while (0)
  f32x16 pA0, pA1, pB0, pB1; bf16x8 pa0, pa1, pa2, pa3;
  FA_SLOAD(0, 0); asm volatile("s_waitcnt vmcnt(0)" ::: "memory"); FA_SWRITE(0, 0); __syncthreads();
  qkt2<ND0>(pA0, pA1, K_lds, qr, nbt, r32, hi);
  FA_SLOAD(1, 1); if (2 < NT) FA_SLOAD(0, 2);
  FA_SWRITE(1, 1); __syncthreads();
  for (int j = 1; j + 1 < NT; j += 2) {
    FA_SBAR(); qkt2<ND0>(pB0, pB1, K_lds + SHM_K, qr, nbt, r32, hi);
    expcvt(pA0, pA1, pa0, pa1, pa2, pa3); FA_SBAR();
    FA_SLOAD(1, j + 2); FA_SBAR();
    pv3(o, vb0, pa0, pa1, pa2, pa3);
    __syncthreads(); FA_SWRITE(0, 0); __syncthreads();
    FA_SBAR(); qkt2<ND0>(pA0, pA1, K_lds, qr, nbt, r32, hi);
    expcvt(pB0, pB1, pa0, pa1, pa2, pa3); FA_SBAR();
    if (j + 3 < NT) FA_SLOAD(0, j + 3); FA_SBAR();
    pv3(o, vb0 + SHM_V, pa0, pa1, pa2, pa3);
    __syncthreads(); FA_SWRITE(1, 1); __syncthreads();
  }
  FA_SBAR(); qkt2<ND0>(pB0, pB1, K_lds + SHM_K, qr, nbt, r32, hi);
  expcvt(pA0, pA1, pa0, pa1, pa2, pa3); FA_SBAR();
  pv3(o, vb0, pa0, pa1, pa2, pa3);
  expcvt(pB0, pB1, pa0, pa1, pa2, pa3); FA_SBAR();
  pv3(o, vb0 + SHM_V, pa0, pa1, pa2, pa3);
  bf16* Ow = Ob + (long)(wid * 32) * ldo;
#pragma unroll
  for (int r = 0; r < 16; ++r) { const int orow = crow(r, hi);
    const float lsum = __int_as_float(__builtin_amdgcn_ds_bpermute((hi * 32) << 2, __float_as_int(o[2][r]))); const float rl = __builtin_amdgcn_rcpf(lsum);
#pragma unroll
    for (int d0 = 0; d0 < 2; ++d0) Ow[(long)orow * ldo + d0 * 32 + r32] = f2bf(o[d0][r] * rl); }
  __syncthreads();
#undef FA_KROW
#undef FA_SLOAD
#undef FA_SWRITE
}
typedef float f32x2v __attribute__((ext_vector_type(2)));
typedef __bf16 bf16x2v __attribute__((ext_vector_type(2)));
DI unsigned cvtpk_b(float lo, float hi) { f32x2v v = {lo, hi}; bf16x2v b = __builtin_convertvector(v, bf16x2v); return __builtin_bit_cast(unsigned, b); }
DI void expcvt_b(f32x16& p0, f32x16& p1, bf16x8& pa0, bf16x8& pa1, bf16x8& pa2, bf16x8& pa3) {
#pragma unroll
  for (int r = 0; r < 16; ++r) p0[r] = __builtin_amdgcn_exp2f(p0[r]);
#pragma unroll
  for (int r = 0; r < 16; ++r) p1[r] = __builtin_amdgcn_exp2f(p1[r]);
#define FA_PK4(P, BASE, OUT) do { u32x4 w = {cvtpk_b(P[BASE + 0], P[BASE + 1]), cvtpk_b(P[BASE + 2], P[BASE + 3]), cvtpk_b(P[BASE + 4], P[BASE + 5]), cvtpk_b(P[BASE + 6], P[BASE + 7])}; \
    OUT = *reinterpret_cast<bf16x8*>(&w); } while (0)
  FA_PK4(p0, 0, pa0); FA_PK4(p0, 8, pa1); FA_PK4(p1, 0, pa2); FA_PK4(p1, 8, pa3);
#undef FA_PK4
}
template <int NM> DI void step_pipeline() {
  __builtin_amdgcn_sched_group_barrier(0x100, 4, 0);
#pragma unroll
  for (int i = 0; i < NM; ++i) {
    __builtin_amdgcn_sched_group_barrier(0x008, 1, 0);
    __builtin_amdgcn_sched_group_barrier(0x400, 2, 0);
    __builtin_amdgcn_sched_group_barrier(0x002, 2, 0);
    __builtin_amdgcn_sched_group_barrier(0x100, 2, 0);
  }
}
template <int OFF> DI s16x4 tr_rd(int vb) { return __builtin_amdgcn_ds_read_tr16_b64_v4i16((__attribute__((address_space(3))) s16x4*)(vb + OFF)); }
template <int D0> DI void pv_one_b(f32x16& od, int vb, bf16x8 pa0, bf16x8 pa1, bf16x8 pa2, bf16x8 pa3) {
  const s16x4 l0 = tr_rd<v_rd_off(D0, 0, 0)>(vb), h0 = tr_rd<v_rd_off(D0, 0, 1)>(vb), l1 = tr_rd<v_rd_off(D0, 1, 0)>(vb), h1 = tr_rd<v_rd_off(D0, 1, 1)>(vb);
  const s16x4 l2 = tr_rd<v_rd_off(D0, 2, 0)>(vb), h2 = tr_rd<v_rd_off(D0, 2, 1)>(vb), l3 = tr_rd<v_rd_off(D0, 3, 0)>(vb), h3 = tr_rd<v_rd_off(D0, 3, 1)>(vb);
#define FA_PK(L, H) (bf16x8){L[0], L[1], L[2], L[3], H[0], H[1], H[2], H[3]}
  od = __builtin_amdgcn_mfma_f32_32x32x16_bf16(pa0, FA_PK(l0, h0), od, 0, 0, 0);
  od = __builtin_amdgcn_mfma_f32_32x32x16_bf16(pa1, FA_PK(l1, h1), od, 0, 0, 0);
  od = __builtin_amdgcn_mfma_f32_32x32x16_bf16(pa2, FA_PK(l2, h2), od, 0, 0, 0);
  od = __builtin_amdgcn_mfma_f32_32x32x16_bf16(pa3, FA_PK(l3, h3), od, 0, 0, 0);
#undef FA_PK
}
DI void pv3b(f32x16* o, int vb, bf16x8 pa0, bf16x8 pa1, bf16x8 pa2, bf16x8 pa3, bf16x8 onesB) { pv_one_b<0>(o[0], vb, pa0, pa1, pa2, pa3); pv_one_b<1>(o[1], vb, pa0, pa1, pa2, pa3);
  o[2] = __builtin_amdgcn_mfma_f32_32x32x16_bf16(pa0, onesB, o[2], 0, 0, 0); o[2] = __builtin_amdgcn_mfma_f32_32x32x16_bf16(pa1, onesB, o[2], 0, 0, 0);
  o[2] = __builtin_amdgcn_mfma_f32_32x32x16_bf16(pa2, onesB, o[2], 0, 0, 0); o[2] = __builtin_amdgcn_mfma_f32_32x32x16_bf16(pa3, onesB, o[2], 0, 0, 0); }
#ifndef FS_SPREAD
#define FS_SPREAD 1
#endif
#ifndef FS_AH
#define FS_AH 2
#endif
template <int NM> constexpr int fs_ec(int s) { const int e = (FS_SPREAD && NM >= 24) ? s + (s + 2) / 3 : 2 * s; return e < 32 ? e : 32; }
template <int NM> constexpr int fs_cc(int s) { const int c = s >= 1 ? fs_ec<NM>(s - 1) / 2 : 0; return c < 16 ? c : 16; }
DI s16x4 tr_rd2(int vb, int off) { return __builtin_amdgcn_ds_read_tr16_b64_v4i16((__attribute__((address_space(3))) s16x4*)(vb + off)); }
template <int ND0, int WI, int KST = 0>
DI void fused_step(f32x16& pn0, f32x16& pn1, f32x16& pc0, f32x16& pc1, bf16x8& an0, bf16x8& an1, bf16x8& an2, bf16x8& an3, bf16x8 ac0, bf16x8 ac1, bf16x8 ac2, bf16x8 ac3,
                   f32x16* o, const char* Ks, int vb, const bf16x8* qr, const f32x16& nbt, int r32, int hi, bf16x8 onesB) {
  constexpr int NQ = 2 * ND0, NM = NQ + 12, AH = FS_AH;
  bf16x8 kf[NQ]; s16x4 vl[8], vh[8]; unsigned w[16];
  bf16x8 kz_; s16x4 vz_; if (WI & (4 | 16 | 32)) { asm volatile("v_mov_b32 %0, 0" : "=v"(vz_[0])); u32x4 z4_ = {0u, 0u, 0u, 0u}; asm volatile("" : "+v"(z4_)); kz_ = *reinterpret_cast<bf16x8*>(&z4_); vz_ = (s16x4){0, 0, 0, 0}; asm volatile("" : "+v"(vz_)); }
#define FS_ISSUE(m) do { if ((WI & 4) || ((WI & 16) && (m) < NQ) || ((WI & 32) && (m) >= NQ)) { if ((m) < NQ) kf[(m) < NQ ? (m) : 0] = kz_; else if ((m) - NQ < 8) { const int q_ = (m) - NQ; vl[q_ >= 0 ? q_ : 0] = vz_; vh[q_ >= 0 ? q_ : 0] = vz_; } } else if ((m) < NQ) { kf[(m) < NQ ? (m) : 0] = *reinterpret_cast<const bf16x8*>(Ks + (KST ? (((m) & 1) * 32 + r32) * KST + ((((m) >> 1) * 16 + hi * 8) * 2) : FA_KSWZ(((m) & 1) * 32 + r32, ((((m) >> 1) * 16 + hi * 8) * 2)))); } \
    else if ((m) - NQ < 8) { const int q_ = (m) - NQ; vl[q_ >= 0 ? q_ : 0] = tr_rd2(vb, v_rd_off(q_ >> 2, q_ & 3, 0)); vh[q_ >= 0 ? q_ : 0] = tr_rd2(vb, v_rd_off(q_ >> 2, q_ & 3, 1)); } } while (0)
#define FS_PC(v) ((v) < 16 ? pc0[(v) & 15] : pc1[(v) & 15])
#pragma unroll
  for (int m = 0; m < AH; ++m) FS_ISSUE(m);
#pragma unroll
  for (int s_ = 0; s_ < NM; ++s_) {
    if (s_ + AH < NM) FS_ISSUE(s_ + AH);
    if (s_ < NQ) { const int d0 = s_ >> 1;
      if ((s_ & 1) == 0) pn0 = __builtin_amdgcn_mfma_f32_32x32x16_bf16(kf[s_ < NQ ? s_ : 0], qr[d0 < ND0 ? d0 : 0], d0 == 0 ? nbt : pn0, 0, 0, 0);
      else pn1 = __builtin_amdgcn_mfma_f32_32x32x16_bf16(kf[s_ < NQ ? s_ : 0], qr[d0 < ND0 ? d0 : 0], d0 == 0 ? nbt : pn1, 0, 0, 0);
    } else { const int q = s_ - NQ, blk = q >> 2, ks = q & 3; const int qi = (q >= 0 && q < 8) ? q : 0; const s16x4 L = vl[qi], H = vh[qi];
      const bf16x8 B = blk == 2 ? onesB : (bf16x8){L[0], L[1], L[2], L[3], H[0], H[1], H[2], H[3]};       const bf16x8 A = ks == 0 ? ac0 : (ks == 1 ? ac1 : (ks == 2 ? ac2 : ac3));
      o[blk >= 0 ? blk : 0] = __builtin_amdgcn_mfma_f32_32x32x16_bf16(A, B, o[blk >= 0 ? blk : 0], 0, 0, 0); }
#pragma unroll
    for (int v = fs_ec<NM>(s_); v < ((WI & 2) ? 0 : fs_ec<NM>(s_ + 1)); ++v) { float e0 = FS_PC(v); asm volatile("" : "+v"(e0)); e0 = __builtin_amdgcn_exp2f(e0); asm volatile("" : "+v"(e0));
      if (v < 16) pc0[v & 15] = e0; else pc1[v & 15] = e0; }
#pragma unroll
    for (int k = fs_cc<NM>(s_); k < ((WI & 2) ? 0 : fs_cc<NM>(s_ + 1)); ++k) { unsigned wk = cvtpk_b(FS_PC(2 * k), FS_PC(2 * k + 1)); asm volatile("" : "+v"(wk)); w[k & 15] = wk; }
    FA_SBAR();
  }
#pragma unroll
  for (int k = fs_cc<NM>(NM); k < ((WI & 2) ? 0 : 16); ++k) w[k] = cvtpk_b(FS_PC(2 * k), FS_PC(2 * k + 1));
  if (WI & 2) { an0 = ac0; an1 = ac1; an2 = ac2; an3 = ac3; } else
  { u32x4 t0 = {w[0], w[1], w[2], w[3]}, t1 = {w[4], w[5], w[6], w[7]}, t2 = {w[8], w[9], w[10], w[11]}, t3 = {w[12], w[13], w[14], w[15]};
    an0 = *reinterpret_cast<bf16x8*>(&t0); an1 = *reinterpret_cast<bf16x8*>(&t1); an2 = *reinterpret_cast<bf16x8*>(&t2); an3 = *reinterpret_cast<bf16x8*>(&t3); }
#undef FS_ISSUE
#undef FS_PC
}
template <int DQK, int WI>
DI void attn_unit3(const bf16* __restrict__ Qb, int ldq, const bf16* __restrict__ Kh, int ldk, const bf16* __restrict__ Vh, const float* __restrict__ nbp, int nbs, int kva, int kvb, int NT,
                   bf16* __restrict__ Ob, int ldo, char* lds, int tid) {
  constexpr int ND0 = DQK / 16;
  const int wid = tid >> 6, lane = tid & 63, r32 = lane & 31, hi = lane >> 5;
  char* V_lds = lds; char* K_lds = lds + 2 * SHM_V;
  f32x16 o[3] = {}; bf16x8 qr[ND0];
  const bf16* Qw = Qb + (long)(wid * 32 + r32) * ldq + hi * 8;
#pragma unroll
  for (int d0 = 0; d0 < ND0; ++d0) qr[d0] = *reinterpret_cast<const bf16x8*>(Qw + d0 * 16);
  const float nb = nbp[(long)(wid * 32 + r32) * nbs];
  f32x16 nbt;
#pragma unroll
  for (int r = 0; r < 16; ++r) nbt[r] = nb;
  const int sr = tid >> 4, sc = (tid & 15) * 8; const bool kact = sc < DQK, vact = sc < 64;
  const int vst0 = v_st(sr, sc & 63), vst1 = v_st(32 + sr, sc & 63);
  const int vb0 = (int)(uintptr_t)V_lds + v_rd_base(lane);
  bf16x8 vs0, vs1, ks0, ks1;
#define FA_KROW(j) ((j) < 4 ? kva + 64 * (j) : kvb + 64 * ((j) - 4))
#define FA_LOADK(j) do { if (kact) { const long kr_ = FA_KROW(j); ks0 = *reinterpret_cast<const bf16x8*>(&Kh[(kr_ + sr) * ldk + sc]); ks1 = *reinterpret_cast<const bf16x8*>(&Kh[(kr_ + 32 + sr) * ldk + sc]); } } while (0)
#define FA_LOADV(j) do { if (vact) { const long kr_ = FA_KROW(j); vs0 = *reinterpret_cast<const bf16x8*>(&Vh[(kr_ + sr) * 256 + sc]); vs1 = *reinterpret_cast<const bf16x8*>(&Vh[(kr_ + 32 + sr) * 256 + sc]); } } while (0)
#define FA_WRITEK(b) do { if (kact) { const int kc = sc * 2; *(bf16x8*)(K_lds + (b) * SHM_K + FA_KSWZ(sr, kc)) = ks0; *(bf16x8*)(K_lds + (b) * SHM_K + FA_KSWZ(32 + sr, kc)) = ks1; } } while (0)
#define FA_WRITEV(b) do { if (vact) { *(bf16x8*)(V_lds + (b) * SHM_V + vst0) = vs0; *(bf16x8*)(V_lds + (b) * SHM_V + vst1) = vs1; } } while (0)
  f32x16 pE0, pE1, pO0, pO1; bf16x8 ae0, ae1, ae2, ae3, ao0, ao1, ao2, ao3;
  bf16x8 onesB; { const unsigned ov = r32 == 0 ? 0x3F803F80u : 0u; u32x4 t = {ov, ov, ov, ov}; onesB = *reinterpret_cast<bf16x8*>(&t); }
  FA_LOADK(0); asm volatile("s_waitcnt vmcnt(0)" ::: "memory"); FA_WRITEK(0); __syncthreads();
  FA_LOADK(1);
  qkt2<ND0>(pE0, pE1, K_lds, qr, nbt, r32, hi);
  __syncthreads(); FA_WRITEK(1); __syncthreads(); FA_LOADK(2); FA_LOADV(0);
  FA_SBAR(); qkt2<ND0>(pO0, pO1, K_lds + SHM_K, qr, nbt, r32, hi); expcvt(pE0, pE1, ae0, ae1, ae2, ae3); FA_SBAR();
  __syncthreads(); FA_WRITEK(0); FA_WRITEV(0); __syncthreads(); if (3 < NT) FA_LOADK(3); FA_LOADV(1);
#define FA_SY() do { if (!(WI & 1)) __syncthreads(); } while (0)
#define FA_IO(x) do { if (!(WI & 8)) { x; } } while (0)
  for (int j = 1; j + 2 < NT; j += 2) {
    FA_SBAR(); asm volatile("" : "+v"(pO0), "+v"(pO1));
    fused_step<ND0, WI>(pE0, pE1, pO0, pO1, ao0, ao1, ao2, ao3, ae0, ae1, ae2, ae3, o, K_lds, vb0, qr, nbt, r32, hi, onesB);
    FA_SY(); FA_IO(FA_WRITEK(1); FA_WRITEV(1)); FA_SY(); FA_IO(if (j + 3 < NT) FA_LOADK(j + 3); FA_LOADV(j + 1));
    FA_SBAR(); asm volatile("" : "+v"(pE0), "+v"(pE1));
    fused_step<ND0, WI>(pO0, pO1, pE0, pE1, ae0, ae1, ae2, ae3, ao0, ao1, ao2, ao3, o, K_lds + SHM_K, vb0 + SHM_V, qr, nbt, r32, hi, onesB);
    FA_SY(); FA_IO(if (j + 3 < NT) FA_WRITEK(0); FA_WRITEV(0)); FA_SY(); FA_IO(if (j + 4 < NT) FA_LOADK(j + 4); if (j + 2 < NT) FA_LOADV(j + 2));
  }
#undef FA_SY
#undef FA_IO
  FA_SBAR(); expcvt(pO0, pO1, ao0, ao1, ao2, ao3); pv3b(o, vb0, ae0, ae1, ae2, ae3, onesB); FA_SBAR();
  __syncthreads(); FA_WRITEV(1); __syncthreads();
  pv3b(o, vb0 + SHM_V, ao0, ao1, ao2, ao3, onesB);
  bf16* Ow = Ob + (long)(wid * 32) * ldo;
#pragma unroll
  for (int r = 0; r < 16; ++r) { const int orow = crow(r, hi);
    const float lsum = __int_as_float(__builtin_amdgcn_ds_bpermute((hi * 32) << 2, __float_as_int(o[2][r]))); const float rl = __builtin_amdgcn_rcpf(lsum);
#pragma unroll
    for (int d0 = 0; d0 < 2; ++d0) Ow[(long)orow * ldo + d0 * 32 + r32] = f2bf(o[d0][r] * rl); }
  __syncthreads();
#undef FA_KROW
#undef FA_LOADK
#undef FA_LOADV
#undef FA_WRITEK
#undef FA_WRITEV
}
template <int DQK>
DI void attn_unit4(const bf16* __restrict__ Qb, int ldq, const bf16* __restrict__ Kh, int ldk, const bf16* __restrict__ Vh, const float* __restrict__ nbp, int nbs, int kva, int kvb, int NT,
                   bf16* __restrict__ Ob, int ldo, char* lds, int tid, bool prefetched, const bf16* Knext) {
  constexpr int ND0 = DQK / 16, CPR = DQK / 8 + 1, KST = CPR * 16, KSZ = 64 * KST;
  const int wid = __builtin_amdgcn_readfirstlane(tid >> 6), lane = tid & 63, r32 = lane & 31, hi = lane >> 5;
  char* V_lds = lds; char* K_lds = lds + 3 * SHM_V;
  f32x16 o[3] = {}; bf16x8 qr[ND0];
  const bf16* Qw = Qb + (long)(wid * 32 + r32) * ldq + hi * 8;
#pragma unroll
  for (int d0 = 0; d0 < ND0; ++d0) qr[d0] = *reinterpret_cast<const bf16x8*>(Qw + d0 * 16);
  const float nb = nbp[(long)(wid * 32 + r32) * nbs];
  f32x16 nbt;
#pragma unroll
  for (int r = 0; r < 16; ++r) nbt[r] = nb;
  const int vb0 = (int)(uintptr_t)V_lds + v_rd_base(lane);
  bf16x8 onesB; { const unsigned ov = r32 == 0 ? 0x3F803F80u : 0u; u32x4 t = {ov, ov, ov, ov}; onesB = *reinterpret_cast<bf16x8*>(&t); }
  unsigned kof0, kof1, vof;
  { const int c0 = 64 * wid + lane, c1 = c0 + 512; const int ra = c0 / CPR, ca = c0 - ra * CPR, rb = c1 / CPR, cb = c1 - rb * CPR;
    kof0 = (unsigned)(ra * ldk + (ca < CPR - 1 ? ca : 0) * 8) * 2u; kof1 = (unsigned)(rb * ldk + (cb < CPR - 1 ? cb : 0) * 8) * 2u;
    vof = (unsigned)((wid * 8 + ((lane & 31) >> 2)) * 256 + (lane >> 5) * 32 + (lane & 3) * 8) * 2u; }
  const bool k0act = wid < CPR, k1act = wid + 8 < CPR;
  const unsigned kl0 = (unsigned)(uintptr_t)K_lds + (unsigned)wid * 1024u, vl0 = (unsigned)(uintptr_t)V_lds + (unsigned)wid * 2048u;
#define FA_LAS __attribute__((address_space(3)))
#define FA_KROW(j) ((j) < 4 ? kva + 64 * (j) : kvb + 64 * ((j) - 4))
#define FA_DMAK(t, slot) do { const char* kb_ = (const char*)(Kh + (long)FA_KROW(t) * ldk); const unsigned kd_ = kl0 + (unsigned)(slot) * (unsigned)KSZ; \
    if (k0act) __builtin_amdgcn_global_load_lds((const unsigned*)(kb_ + kof0), (FA_LAS unsigned*)kd_, 16, 0, 0); \
    if (k1act) __builtin_amdgcn_global_load_lds((const unsigned*)(kb_ + kof1), (FA_LAS unsigned*)(kd_ + 8192u), 16, 0, 0); } while (0)
#define FA_DMAV(t, slot) do { const char* vb_ = (const char*)(Vh + (long)FA_KROW(t) * 256); \
    __builtin_amdgcn_global_load_lds((const unsigned*)(vb_ + vof), (FA_LAS unsigned*)(vl0 + (unsigned)(slot) * (unsigned)SHM_V), 16, 0, 0); } while (0)
#define FA_NX(s) ((s) == 2 ? 0 : (s) + 1)
#define FA_END(n) do { asm volatile("s_waitcnt vmcnt(" #n ")" ::: "memory"); __builtin_amdgcn_s_barrier(); } while (0)
  f32x16 pE0, pE1, pO0, pO1; bf16x8 ae0, ae1, ae2, ae3, ao0, ao1, ao2, ao3;
  if (!prefetched) { FA_DMAK(0, 0); FA_DMAK(1, 1); }
  FA_END(0);
#pragma unroll
  for (int d0 = 0; d0 < ND0; ++d0) asm volatile("" : "+v"(qr[d0]));
  asm volatile("" : "+v"(nbt));
  if (2 < NT) FA_DMAK(2, 2); FA_DMAV(0, 0);
  qkt2<ND0, KST>(pE0, pE1, K_lds, qr, nbt, r32, hi);
  FA_END(1);
  if (3 < NT) FA_DMAK(3, 0); FA_DMAV(1, 1);
  FA_SBAR(); qkt2<ND0, KST>(pO0, pO1, K_lds + KSZ, qr, nbt, r32, hi); expcvt(pE0, pE1, ae0, ae1, ae2, ae3); FA_SBAR();
  FA_END(1);
  int sj = 1;
  for (int j = 1; j + 2 < NT; j += 2) {
    { const int s1 = FA_NX(sj), s2 = FA_NX(s1);
      if (j + 3 < NT) FA_DMAK(j + 3, sj); FA_DMAV(j + 1, s1);
      FA_SBAR(); asm volatile("" : "+v"(pO0), "+v"(pO1));
      fused_step<ND0, 0, KST>(pE0, pE1, pO0, pO1, ao0, ao1, ao2, ao3, ae0, ae1, ae2, ae3, o, K_lds + s1 * KSZ, vb0 + s2 * SHM_V, qr, nbt, r32, hi, onesB);
      FA_END(1); sj = s1; }
    { const int s1 = FA_NX(sj), s2 = FA_NX(s1);
      if (j + 4 < NT) FA_DMAK(j + 4, sj); if (j + 2 < NT) FA_DMAV(j + 2, s1);
      FA_SBAR(); asm volatile("" : "+v"(pE0), "+v"(pE1));
      fused_step<ND0, 0, KST>(pO0, pO1, pE0, pE1, ae0, ae1, ae2, ae3, ao0, ao1, ao2, ao3, o, K_lds + s1 * KSZ, vb0 + s2 * SHM_V, qr, nbt, r32, hi, onesB);
      FA_END(1); sj = s1; }
  }
  { const int s2 = FA_NX(FA_NX(sj));
    if (Knext) { const char* kb_ = (const char*)Knext;
      if (k0act) __builtin_amdgcn_global_load_lds((const unsigned*)(kb_ + kof0), (FA_LAS unsigned*)kl0, 16, 0, 0);
      if (k1act) __builtin_amdgcn_global_load_lds((const unsigned*)(kb_ + kof1), (FA_LAS unsigned*)(kl0 + 8192u), 16, 0, 0);
      kb_ += (size_t)64 * ldk * 2;
      if (k0act) __builtin_amdgcn_global_load_lds((const unsigned*)(kb_ + kof0), (FA_LAS unsigned*)(kl0 + (unsigned)KSZ), 16, 0, 0);
      if (k1act) __builtin_amdgcn_global_load_lds((const unsigned*)(kb_ + kof1), (FA_LAS unsigned*)(kl0 + (unsigned)KSZ + 8192u), 16, 0, 0); }
    FA_SBAR(); expcvt(pO0, pO1, ao0, ao1, ao2, ao3); pv3b(o, vb0 + s2 * SHM_V, ae0, ae1, ae2, ae3, onesB); FA_SBAR();
    if (!Knext || !k0act) { FA_END(0); } else if (k1act) { FA_END(4); } else { FA_END(2); }
    sj = FA_NX(sj); }
  { const int s2 = FA_NX(FA_NX(sj)); pv3b(o, vb0 + s2 * SHM_V, ao0, ao1, ao2, ao3, onesB); }
  bf16* Ow = Ob + (long)(wid * 32) * ldo;
#pragma unroll
  for (int r = 0; r < 16; ++r) { const int orow = crow(r, hi);
    const float lsum = __int_as_float(__builtin_amdgcn_ds_bpermute((hi * 32) << 2, __float_as_int(o[2][r]))); const float rl = __builtin_amdgcn_rcpf(lsum);
#pragma unroll
    for (int d0 = 0; d0 < 2; ++d0) Ow[(long)orow * ldo + d0 * 32 + r32] = f2bf(o[d0][r] * rl); }
  __syncthreads();
#undef FA_KROW
#undef FA_DMAK
#undef FA_DMAV
#undef FA_NX
#undef FA_END
}
}

template <int DQK, int WI = 0>
DI void ph_attn_fast2(const bf16* Q, const bf16* K, const bf16* V, const float* QB, int nhv, int vdiv, bf16* O, int ldo, int ooff, int qbase, int nq_per_b, bool with_latent, unsigned char* lds) {
  const int tid_ = opq_tid(); const int bid_ = opq_bid(), nblk_ = opq_nblk();
  const int chunks = nq_per_b / 256, npairs = NB * nhv, nunits = npairs * chunks;
  const bool xmap = (nblk_ == 256) && (chunks == 16);
#define AT_DECODE(i, ok, pair, ch) do { if (xmap) { const int v = (i) * 32 + (bid_ >> 3); ok = v < nhv * 16; pair = (v >> 4) * 8 + (bid_ & 7); ch = v & 15; } \
    else { const int u = (i) * nblk_ + bid_; ok = u < nunits; pair = u / chunks; ch = u - pair * chunks; } } while (0)
  bool ok, pre = false; int pair, ch;
  AT_DECODE(0, ok, pair, ch);
  for (int i = 0; ok; ++i) {
    bool okn; int pairn, chn;
    AT_DECODE(i + 1, okn, pairn, chn); (void)chn;
    const int b = pair / nhv, hv = pair - b * nhv;
    const int r0 = qbase + b * nq_per_b + ch * 256;
    int tu_ = tid_; asm volatile("" : "+v"(tu_));
    if constexpr (WI == 0) {
      const int bn = pairn / nhv, hvn = pairn - bn * nhv;
      const bf16* Kn = okn ? K + hvn * DQK + (size_t)(TL + bn * CTX) * (nhv * DQK) : nullptr;
      fa::attn_unit4<DQK>(Q + (size_t)r0 * (nhv * DQK) + hv * DQK, nhv * DQK, K + hv * DQK, nhv * DQK, V + (hv / vdiv) * 64, QB + (size_t)r0 * nhv + hv, nhv, TL + b * CTX, b * SEQ, with_latent ? 68 : 4,
                        O + (size_t)r0 * ldo + ooff + hv * 64, ldo, (char*)lds, tu_, pre, Kn);
      pre = okn;
    } else {
      fa::attn_unit3<DQK, WI>(Q + (size_t)r0 * (nhv * DQK) + hv * DQK, nhv * DQK, K + hv * DQK, nhv * DQK, V + (hv / vdiv) * 64, QB + (size_t)r0 * nhv + hv, nhv, TL + b * CTX, b * SEQ, with_latent ? 68 : 4,
                        O + (size_t)r0 * ldo + ooff + hv * 64, ldo, (char*)lds, tu_);
    }
    ok = okn; pair = pairn; ch = chn;
  }
#undef AT_DECODE
}

DI void ph_na_fast2(PRef p, int l, unsigned char* lds8) {
  using namespace fa;
  const int tid_ = opq_tid(); const int bid_ = opq_bid(), nblk_ = opq_nblk();
  char* lds = (char*)lds8;
  const bf16* __restrict__ Q = (const bf16*)(p.ws + WS_NQ); const bf16* __restrict__ K = (const bf16*)(p.ws + WS_NK); const bf16* __restrict__ V = (const bf16*)(p.ws + WS_NV); bf16* __restrict__ BI = (bf16*)(p.ws + WS_BI);
  const float* __restrict__ QB = (const float*)(p.ws + WS_QBN);
  const float* rpb = p.in[I_RPB] + (size_t)l * NH * 15 * 31;
  const int wid = __builtin_amdgcn_readfirstlane(tid_ >> 6), lane = tid_ & 63, r32 = lane & 31, hi = lane >> 5;
  char* V_lds = lds; char* K_lds = lds + 2 * SHM_V;
  float* tbl = (float*)(lds + 2 * SHM_V + 2 * SHM_K + 2048);
  bf16x8 onesB; { const unsigned ov = r32 == 0 ? 0x3F803F80u : 0u; u32x4 t = {ov, ov, ov, ov}; onesB = *reinterpret_cast<bf16x8*>(&t); }
  const int sr = tid_ >> 4, sc = (tid_ & 15) * 8; const bool act = sc < 64;
  const int vst0 = v_st(sr, sc & 63), vst1 = v_st(32 + sr, sc & 63);
  const int vb0 = (int)(uintptr_t)V_lds + v_rd_base(lane);
  const bool xmap = (nblk_ == 256);
  for (int i = 0;; ++i) {
    int pair, g;
    if (xmap) { const int v = i * 32 + (bid_ >> 3); if (v >= 64) break; pair = (v >> 4) * 8 + (bid_ & 7); g = v & 15; }
    else { const int u = i * nblk_ + bid_; if (u >= NB * NH * 16) break; pair = u >> 4; g = u & 15; }
    const int b = pair >> 2, h = pair & 3;
    for (int k = tid_; k < 15 * 32; k += 512) { const int ii = k >> 5, jj = k & 31; tbl[k] = jj < 31 ? rpb[(h * 15 + ii) * 31 + jj] * LOG2E : 0.f; }
    const int lo = min(max(4 * g - 4, 0), 56), hiR = min(max(4 * g + 3 - 4, 0), 56) + 7, NT = 4 + (hiR - lo + 1);
    const int qrow = 4 * g + (wid >> 1), rs_w = min(max(qrow - 4, 0), 56), qc = 32 * (wid & 1) + r32, ws0 = min(max(qc - 8, 0), 48);
    const int r0 = b * SEQ + g * 256;
    const bf16* Kh = K + h * 64; const bf16* Vh = V + h * 64;
    unsigned vmask = 0u;
#pragma unroll
    for (int r = 0; r < 16; ++r) { const int kc = crow(r, hi); vmask |= ((unsigned)(kc - ws0) < 16u ? 1u : 0u) << r; vmask |= ((unsigned)(kc + 32 - ws0) < 16u ? 1u : 0u) << (16 + r); }
    const int bbase = 4 * hi - qc + 15;
    f32x16 o[3] = {}; bf16x8 qr[4];
    const bf16* Qw = Q + (size_t)(r0 + wid * 32 + r32) * 256 + h * 64 + hi * 8;
#pragma unroll
    for (int d0 = 0; d0 < 4; ++d0) qr[d0] = *reinterpret_cast<const bf16x8*>(Qw + d0 * 16);
    const float nb = QB[(size_t)(r0 + wid * 32 + r32) * 4 + h];
    f32x16 nbt;
#pragma unroll
    for (int r = 0; r < 16; ++r) nbt[r] = nb;
    bf16x8 vs0, vs1, ks0, ks1;
#define NA_KROW(j) ((j) < 4 ? TL + b * CTX + 64 * (j) : b * SEQ + (lo + (j) - 4) * 64)
#define NA_SLOAD(j) do { if (act) { const long kr_ = NA_KROW(j); vs0 = *reinterpret_cast<const bf16x8*>(&Vh[(kr_ + sr) * 256 + sc]); vs1 = *reinterpret_cast<const bf16x8*>(&Vh[(kr_ + 32 + sr) * 256 + sc]); \
      ks0 = *reinterpret_cast<const bf16x8*>(&Kh[(kr_ + sr) * 256 + sc]); ks1 = *reinterpret_cast<const bf16x8*>(&Kh[(kr_ + 32 + sr) * 256 + sc]); } } while (0)
#define NA_SWRITE(bb) do { if (act) { *(bf16x8*)(V_lds + (bb) * SHM_V + vst0) = vs0; *(bf16x8*)(V_lds + (bb) * SHM_V + vst1) = vs1; const int kc_ = sc * 2; \
      *(bf16x8*)(K_lds + (bb) * SHM_K + FA_KSWZ(sr, kc_)) = ks0; *(bf16x8*)(K_lds + (bb) * SHM_K + FA_KSWZ(32 + sr, kc_)) = ks1; } } while (0)
    NA_SLOAD(0); NA_SWRITE(0); __syncthreads();
    for (int j = 0; j < NT; ++j) {
      const int bb = j & 1;
      if (j + 1 < NT) NA_SLOAD(j + 1);
      const int kr = lo + j - 4;
      const bool wvalid = (j < 4) || (kr >= rs_w && kr < rs_w + 8);
      if (wvalid) {
        f32x16 p0, p1; bf16x8 pa0, pa1, pa2, pa3;
        qkt2<4>(p0, p1, K_lds + bb * SHM_K, qr, nbt, r32, hi);
        if (j >= 4) {
          const float* brow = tbl + (kr - qrow + 7) * 32 + bbase;
#pragma unroll
          for (int r = 0; r < 16; ++r) { const int co = (r & 3) + 8 * (r >> 2);
            p0[r] = ((vmask >> r) & 1u) ? p0[r] + brow[co] : -1e30f; p1[r] = ((vmask >> (16 + r)) & 1u) ? p1[r] + brow[co + 32] : -1e30f; }
        }
        expcvt_b(p0, p1, pa0, pa1, pa2, pa3);
        pv3b(o, vb0 + bb * SHM_V, pa0, pa1, pa2, pa3, onesB);
      }
      if (j + 1 < NT) NA_SWRITE(bb ^ 1);
      __syncthreads();
    }
    bf16* Ow = BI + (size_t)(r0 + wid * 32) * D + 768 + h * 64;
#pragma unroll
    for (int r = 0; r < 16; ++r) { const int orow = crow(r, hi);
      const float lsum = __int_as_float(__builtin_amdgcn_ds_bpermute((hi * 32) << 2, __float_as_int(o[2][r]))); const float rl = __builtin_amdgcn_rcpf(lsum);
#pragma unroll
      for (int d0 = 0; d0 < 2; ++d0) Ow[(size_t)orow * D + d0 * 32 + r32] = f2bf(o[d0][r] * rl); }
    __syncthreads();
#undef NA_KROW
#undef NA_SLOAD
#undef NA_SWRITE
  }
}

#define LAS __attribute__((address_space(3)))
#define XB_TMO      128
#define XB_XCNT(j)  (256  + 64 * (j))
#define XB_XSUB(j)  (1280 + 64 * (j))
#define XB_XGEN(j)  (2304 + 64 * (j))
#define XB_TOP      3328
#define XB_TOPGEN   3392
#define XCD_BAR_WORDS 3456
#define XB_SPIN_CAP (1u << 24)
__device__ __forceinline__ unsigned xb_ld(unsigned* p)              { return __hip_atomic_load(p, __ATOMIC_RELAXED, __HIP_MEMORY_SCOPE_AGENT); }
__device__ __forceinline__ unsigned xb_add(unsigned* p, unsigned v) { return __hip_atomic_fetch_add(p, v, __ATOMIC_RELAXED, __HIP_MEMORY_SCOPE_AGENT); }
__device__ __forceinline__ unsigned xb_xcc_id() { return (unsigned)__builtin_amdgcn_s_getreg((3 << 11) | 20) & 0xFu; }
#define XB_SPIN(cond, bar) do { unsigned _sp = 0; while (cond) { __builtin_amdgcn_s_sleep(1); \
    if ((++_sp & 255u) == 0u) { if (xb_ld(&(bar)[XB_TMO])) break; if (_sp > XB_SPIN_CAP) { atomicAdd(&(bar)[XB_TMO], 1u); break; } } } } while (0)
struct XcdBarrier { unsigned* bar; unsigned x; volatile LAS unsigned* st; };
__device__ __forceinline__ XcdBarrier xcd_barrier_post(unsigned* bar, volatile LAS unsigned* st) {
    XcdBarrier b; b.bar = bar; b.x = xb_xcc_id(); b.st = st;
    if (threadIdx.x == 0) (void)xb_add(&bar[XB_XCNT(b.x)], 1u);
    return b;
}
__device__ __forceinline__ void xcd_barrier_complete(unsigned* bar, unsigned x, unsigned& nloc, unsigned& nx) {
    const unsigned G = gridDim.x * gridDim.y * gridDim.z;
    unsigned sum, cnt, mine, sp = 0u;
    for (;;) {
        sum = 0u; cnt = 0u; mine = 0u;
#pragma unroll
        for (unsigned j = 0; j < 16; ++j) { const unsigned c = xb_ld(&bar[XB_XCNT(j)]); sum += c; cnt += (c > 0u) ? 1u : 0u; }
        mine = xb_ld(&bar[XB_XCNT(x)]);
        if (sum == G) break;
        __builtin_amdgcn_s_sleep(1);
        if ((++sp & 255u) == 0u) { if (xb_ld(&bar[XB_TMO])) break; if (sp > XB_SPIN_CAP) { atomicAdd(&bar[XB_TMO], 1u); break; } }
    }
    nloc = mine > 0u ? mine : 1u; nx = cnt > 0u ? cnt : 1u;
}
__device__ __forceinline__ void xcd_barrier(const XcdBarrier& b) {
    asm volatile("s_waitcnt vmcnt(0)" ::: "memory");
    __syncthreads();
    if (threadIdx.x == 0) {
        unsigned* bar = b.bar; unsigned bx = b.x; asm volatile("" : "+s"(bar), "+s"(bx));
        __builtin_amdgcn_s_waitcnt(0);
        unsigned nloc = b.st[0], nx = b.st[1];
        if (nloc == 0u) { xcd_barrier_complete(bar, bx, nloc, nx); b.st[0] = nloc; b.st[1] = nx; }
        const unsigned old = xb_add(&bar[XB_XSUB(bx)], 1u);
        const unsigned gen = old / nloc;
        if (old + 1u == (gen + 1u) * nloc) {
            __builtin_amdgcn_fence(__ATOMIC_RELEASE, "agent");
            asm volatile("s_waitcnt vmcnt(0)" ::: "memory");
            const unsigned og = xb_add(&bar[XB_TOP], 1u);
            const unsigned tg = og / nx;
            if (og + 1u == (tg + 1u) * nx) xb_add(&bar[XB_TOPGEN], 1u);
            else XB_SPIN(xb_ld(&bar[XB_TOPGEN]) == tg, bar);
            __builtin_amdgcn_fence(__ATOMIC_ACQUIRE, "agent");
            xb_add(&bar[XB_XGEN(bx)], 1u);
            asm volatile("s_waitcnt vmcnt(0)" ::: "memory");
        } else {
            XB_SPIN(xb_ld(&bar[XB_XGEN(bx)]) == gen, bar);
            __builtin_amdgcn_fence(__ATOMIC_ACQUIRE, "agent");
            asm volatile("s_waitcnt vmcnt(0)" ::: "memory");
        }
    }
    __syncthreads();
}

constexpr int LDS_BYTES = 147456;
constexpr int BARW_OFF = 131072 + 512;
constexpr int CW_BAR = 4096;

#ifndef ATTN_V2
#define ATTN_V2 1
#endif
#ifndef REP_GEMM
#define REP_GEMM 1
#endif
#ifndef REP_ATTN
#define REP_ATTN 1
#endif
#ifndef REP_SMALL
#define REP_SMALL 1
#endif
#ifndef REP_CVT
#define REP_CVT 1
#endif
#ifndef REP_MD
#define REP_MD 1
#endif
#ifndef FA_WI
#define FA_WI 0
#endif
#define REPEAT_L(n, stmt) do { if ((n) == 1) { stmt; } else { int n_ = (n); asm volatile("" : "+s"(n_)); for (int rep_ = 0; rep_ < n_; ++rep_) { stmt; __syncthreads(); } } } while (0)
#define REPEAT(n, stmt) do { _Pragma("unroll") for (int rep_ = 0; rep_ < (n); ++rep_) { stmt; if ((n) > 1) __syncthreads(); } } while (0)
template <int l>
DI void layer_program(const XcdBarrier& bar, unsigned char* lds) {
#define GBAR() xcd_barrier(bar)
    const bool last = (l == 1);
    const int nrows = last ? TL : T;
    const float lam_init = last ? 0.35550906759096924f : 0.2f;
    if (l == 0) { REPEAT(REP_SMALL, ph_mod1(PP, l)); GBAR(); }
    REPEAT(REP_GEMM, ph_proj_fast(PP, l, lds));
    GBAR();
    REPEAT(REP_GEMM, ph_qkvraw_fast(PP, l, lds));
    REPEAT(REP_SMALL, ph_conv(PP, l, nrows, lds));
    GBAR();
#if ATTN_V2
#if REP_MD > 1
    { int n_ = REP_MD; asm volatile("" : "+s"(n_)); for (int rep_ = 0; rep_ < n_ - 1; ++rep_) { ph_attn_fast2<96, FA_WI>((const bf16*)(PP.ws + WS_MQ), (const bf16*)(PP.ws + WS_MK), (const bf16*)(PP.ws + WS_MV), (const float*)(PP.ws + WS_QBM), 4, 1, (bf16*)(PP.ws + WS_BI), D, 256, 0, SEQ, true, lds); __syncthreads(); ph_attn_fast2<32, FA_WI>((const bf16*)(PP.ws + WS_DQ), (const bf16*)(PP.ws + WS_DK), (const bf16*)(PP.ws + WS_DV), (const float*)(PP.ws + WS_QBD), 8, 2, (bf16*)(PP.ws + WS_DO), 512, 0, 0, SEQ, true, lds); __syncthreads(); } }
#endif
    ph_attn_fast2<96>((const bf16*)(PP.ws + WS_MQ), (const bf16*)(PP.ws + WS_MK), (const bf16*)(PP.ws + WS_MV), (const float*)(PP.ws + WS_QBM), 4, 1, (bf16*)(PP.ws + WS_BI), D, 256, 0, SEQ, true, lds);
    ph_attn_fast2<32>((const bf16*)(PP.ws + WS_DQ), (const bf16*)(PP.ws + WS_DK), (const bf16*)(PP.ws + WS_DV), (const float*)(PP.ws + WS_QBD), 8, 2, (bf16*)(PP.ws + WS_DO), 512, 0, 0, SEQ, true, lds);
    REPEAT(REP_ATTN, ph_na_fast2(PP, l, lds));
    if (!last) {
      ph_attn_fast2<96>((const bf16*)(PP.ws + WS_MQ), (const bf16*)(PP.ws + WS_MK), (const bf16*)(PP.ws + WS_MV), (const float*)(PP.ws + WS_QBM), 4, 1, (bf16*)(PP.ws + WS_BI), D, 256, TL, CTX, false, lds);
      ph_attn_fast2<32>((const bf16*)(PP.ws + WS_DQ), (const bf16*)(PP.ws + WS_DK), (const bf16*)(PP.ws + WS_DV), (const float*)(PP.ws + WS_QBD), 8, 2, (bf16*)(PP.ws + WS_DO), 512, 0, TL, CTX, false, lds);
      ph_attn_fast2<64>((const bf16*)(PP.ws + WS_NQ), (const bf16*)(PP.ws + WS_NK), (const bf16*)(PP.ws + WS_NV), (const float*)(PP.ws + WS_QBN), 4, 1, (bf16*)(PP.ws + WS_BI), D, 768, TL, CTX, false, lds);
    }
    GBAR();
#else
    REPEAT(REP_ATTN, ph_attn_fast<96>((const bf16*)(PP.ws + WS_MQ), (const bf16*)(PP.ws + WS_MK), (const bf16*)(PP.ws + WS_MV), 4, 1, (bf16*)(PP.ws + WS_BI), D, 256, 0, SEQ, true, lds));
    REPEAT(REP_ATTN, ph_attn_fast<32>((const bf16*)(PP.ws + WS_DQ), (const bf16*)(PP.ws + WS_DK), (const bf16*)(PP.ws + WS_DV), 8, 2, (bf16*)(PP.ws + WS_DO), 512, 0, 0, SEQ, true, lds));
    REPEAT(REP_ATTN, ph_na_fast(PP, l, lds));
    if (!last) {
      ph_attn_fast<96>((const bf16*)(PP.ws + WS_MQ), (const bf16*)(PP.ws + WS_MK), (const bf16*)(PP.ws + WS_MV), 4, 1, (bf16*)(PP.ws + WS_BI), D, 256, TL, CTX, false, lds);
      ph_attn_fast<32>((const bf16*)(PP.ws + WS_DQ), (const bf16*)(PP.ws + WS_DK), (const bf16*)(PP.ws + WS_DV), 8, 2, (bf16*)(PP.ws + WS_DO), 512, 0, TL, CTX, false, lds);
      ph_attn_fast<64>((const bf16*)(PP.ws + WS_NQ), (const bf16*)(PP.ws + WS_NK), (const bf16*)(PP.ws + WS_NV), 4, 1, (bf16*)(PP.ws + WS_BI), D, 768, TL, CTX, false, lds);
    }
    GBAR();
#endif
    REPEAT(REP_SMALL, ph_diffcombine_fast(PP, l, nrows, lam_init));
    GBAR();
    REPEAT(REP_GEMM, ph_branch_fast(PP, l, nrows, lds));
    GBAR();
    REPEAT(REP_GEMM, ph_merge_fast(PP, l, nrows, lds));
    GBAR();
    REPEAT((l == 0 ? REP_GEMM : 1), ph_wo_fast(PP, l, nrows, lds));
    GBAR();
    ph_mod2_router_fast(PP, l, nrows, lds);
    GBAR();
    REPEAT(REP_GEMM, ph_moe1_fast(PP, l, lds));
    GBAR();
    REPEAT(REP_GEMM, ph_moe2_fast(PP, l, lds));
    GBAR();
    ph_combine(PP, l, nrows, lds);
    if (l == 0) GBAR();
}

__global__ void __launch_bounds__(512, 2) fwd(Params p) {
  extern __shared__ __attribute__((aligned(16))) unsigned char lds[];
  if (threadIdx.x < 4) ((unsigned*)(lds + BARW_OFF))[threadIdx.x] = 0u;
  __syncthreads();
  XcdBarrier bar = xcd_barrier_post((unsigned*)(PP.ws + WS_CTL) + CW_BAR, (volatile LAS unsigned*)(lds + BARW_OFF));
  ph_ada_fast(PP, lds);
  __syncthreads();
  REPEAT(REP_CVT, ph_convert(PP, lds));
  GBAR();
  layer_program<0>(bar, lds);
  layer_program<1>(bar, lds);
}

extern "C" void kernel_launch(void* const* d_in, const int* in_sizes, int n_in, void* d_out, int out_size, void* d_ws, size_t ws_size, hipStream_t stream) {
  static int grid = 0;
  if (grid == 0) {
    if (n_in != N_IN || ws_size < WS_END) { fprintf(stderr, "kernel_launch: n_in %d ws %zu need %zu\n", n_in, ws_size, (size_t)WS_END); grid = -1; return; }
    int dev = 0, cus = 0;
    if (hipGetDevice(&dev) != hipSuccess || hipDeviceGetAttribute(&cus, hipDeviceAttributeMultiprocessorCount, dev) != hipSuccess) { grid = -1; return; }
    if (hipFuncSetAttribute((const void*)fwd, hipFuncAttributeMaxDynamicSharedMemorySize, LDS_BYTES) != hipSuccess) { fprintf(stderr, "kernel_launch: hipFuncSetAttribute failed\n"); grid = -1; return; }
    int per_cu = 0;
    if (hipOccupancyMaxActiveBlocksPerMultiprocessor(&per_cu, (const void*)fwd, 512, LDS_BYTES) != hipSuccess || per_cu < 1) fprintf(stderr, "kernel_launch: occupancy query says %d\n", per_cu);
    (void)hipGetLastError();
    grid = cus;
  }
  if (grid < 0) return;
  Params p{};
  for (int i = 0; i < N_IN; ++i) p.in[i] = (const float*)d_in[i];
  p.out = (float*)d_out; p.ws = (unsigned char*)d_ws;
  (void)hipMemsetAsync((char*)d_ws + WS_CTL, 0, 1 * MiB, stream);
  (void)hipMemsetAsync((char*)d_ws + WS_QKV_T, 0, (size_t)2 * 1024 * 384 * 2, stream);
  (void)hipMemsetAsync((char*)d_ws + WS_WIN_T, 0, (size_t)2 * PLD * D * 2, stream);
  hipLaunchKernelGGL(fwd, dim3(grid), dim3(512), LDS_BYTES, stream, p);
}
```

```cpp
#include <hip/hip_runtime.h>
#include <cstdio>
#include <cstdint>

typedef unsigned short bf16;
#ifndef FAST_ATTN
#define FAST_ATTN 1
#endif
#if FAST_ATTN
#define ATTN_FN ph_attn_fast
#define ATTN_LDS , lds
#else
#define ATTN_FN ph_attn_naive
#define ATTN_LDS
#endif
#ifndef FAST_NA
#define FAST_NA 1
#endif
#ifndef FAST_SMALL
#define FAST_SMALL 1
#endif
#ifndef FAST_ROUTER
#define FAST_ROUTER 1
#endif
#ifndef FAST_PROJ
#define FAST_PROJ 1
#endif
#ifndef FAST_QKV
#define FAST_QKV 1
#endif
#ifndef FAST_MERGE
#define FAST_MERGE 1
#endif
#ifndef FAST_WO
#define FAST_WO 1
#endif
#ifndef FAST_MOE
#define FAST_MOE 1
#endif
#define DI __device__ __forceinline__

constexpr int D = 1024, NB = 8, SEQ = 4096, CTX = 256, GW = 64;
constexpr int TL = NB * SEQ;
constexpr int TC = NB * CTX;
constexpr int T = TL + TC;
constexpr int NH = 4;
constexpr int INW = 2400, PLD = 2560;
constexpr int OFF_B = 512, OFF_C = 864, OFF_D = 1632;
constexpr int NE = 32, DFF = 1024;
constexpr int MAXROWS = 4 * T + NE * 256;
constexpr float EPS = 1e-6f;
constexpr float LOG2E = 1.4426950408889634f;

enum { I_X = 0, I_C, I_CTX, I_CCTX, I_ADAW, I_ADAB, I_N1G, I_N2G, I_WIN, I_CONVW, I_CONVB, I_CLNG, I_CLNB, I_CONVOUT,
       I_CQG, I_CKVG, I_WUQ, I_WUKV, I_QNG, I_KNG, I_MLAOUT, I_DQNG, I_DKNG, I_DLAM, I_DSUBG, I_DIFFOUT, I_NQNG, I_NKNG,
       I_RPB, I_NAOUT, I_GATEW, I_GATEB, I_WO, I_RW, I_RB, I_WGU, I_BGU, I_WDN, I_BDN, N_IN };

constexpr size_t MiB = 1u << 20;
constexpr size_t al(size_t x) { return (x + 255) / 256 * 256; }
constexpr size_t WS_CTL = 0;
constexpr size_t WS_MOD = 1 * MiB;
constexpr size_t WS_ROPE = WS_MOD + al(2 * 9 * 6144 * 4);
constexpr size_t WS_ROUTE = WS_ROPE + al(4096 * 32 * 4);
constexpr size_t WS_ROWTOK = WS_ROUTE + al((size_t)T * 4 * 16);
constexpr size_t WS_HS = WS_ROWTOK + al((size_t)NE * T * 4);
constexpr size_t WS_WGUS = WS_HS + al((size_t)T * 4);
constexpr size_t WS_HS1 = WS_WGUS + al((size_t)2 * NE * 2048 * 4);
constexpr size_t WS_WINS = WS_HS1 + al((size_t)T * 4);
constexpr size_t WS_GATES = WS_WINS + al((size_t)2 * PLD * 4);
constexpr size_t WS_WIN_T = WS_GATES + al((size_t)2 * 4096 * 4);
constexpr size_t WS_QKV_T = WS_WIN_T + al((size_t)2 * PLD * D * 2);
constexpr size_t WS_WB_T = WS_QKV_T + al((size_t)2 * 1024 * 384 * 2);
constexpr size_t WS_GATE_T = WS_WB_T + al((size_t)2 * 4 * 1024 * 256 * 2);
constexpr size_t WS_WO_T = WS_GATE_T + al((size_t)2 * 4096 * D * 2);
constexpr size_t WS_WGU_T = WS_WO_T + al((size_t)2 * D * D * 2);
constexpr size_t WS_WDN_T = WS_WGU_T + al((size_t)2 * NE * 2048 * D * 2);
constexpr size_t WS_H = WS_WDN_T + al((size_t)2 * NE * D * DFF * 2);
constexpr size_t WS_H2 = WS_H + al((size_t)T * D * 2);
constexpr size_t WS_XF = WS_H2 + al((size_t)T * D * 2);
constexpr size_t WS_SCR = WS_XF + al((size_t)T * D * 4);
constexpr size_t WS_PROJ = WS_SCR;
constexpr size_t WS_CU = WS_PROJ + al((size_t)T * PLD * 2);
constexpr size_t WS_AQ = WS_CU + al((size_t)T * 256 * 2);
constexpr size_t WS_QKVRAW = WS_AQ + al((size_t)T * 384 * 2);
constexpr size_t WS_MQ = WS_QKVRAW + al((size_t)T * 1024 * 2);
constexpr size_t WS_MK = WS_MQ + al((size_t)T * 384 * 2);
constexpr size_t WS_MV = WS_MK + al((size_t)T * 384 * 2);
constexpr size_t WS_DQ = WS_MV + al((size_t)T * 256 * 2);
constexpr size_t WS_DK = WS_DQ + al((size_t)T * 256 * 2);
constexpr size_t WS_DV = WS_DK + al((size_t)T * 256 * 2);
constexpr size_t WS_NQ = WS_DV + al((size_t)T * 256 * 2);
constexpr size_t WS_NK = WS_NQ + al((size_t)T * 256 * 2);
constexpr size_t WS_NV = WS_NK + al((size_t)T * 256 * 2);
constexpr size_t WS_BI = WS_NV + al((size_t)T * 256 * 2);
constexpr size_t WS_DO = WS_BI + al((size_t)T * D * 2);
constexpr size_t WS_QBM = WS_DO + al((size_t)T * 512 * 2);
constexpr size_t WS_QBD = WS_QBM + al((size_t)T * 4 * 4);
constexpr size_t WS_QBN = WS_QBD + al((size_t)T * 8 * 4);
constexpr size_t WS_KPE = WS_QBN + al((size_t)T * 4 * 4);
constexpr size_t WS_YB = WS_KPE + al((size_t)T * 32 * 2);
constexpr size_t WS_YM = WS_YB + al((size_t)T * 4096 * 2);
constexpr size_t WS_MIX_END = WS_YM + al((size_t)T * D * 2);
constexpr size_t WS_ACT = WS_SCR;
constexpr size_t WS_YE = WS_ACT + al((size_t)MAXROWS * D * 2);
constexpr size_t WS_MOE_END = WS_YE + al((size_t)MAXROWS * D * 2);
constexpr size_t WS_END = WS_MIX_END > WS_MOE_END ? WS_MIX_END : WS_MOE_END;
static_assert(WS_END <= (size_t)2048 * MiB, "workspace budget (>= 2 GiB guaranteed)");
constexpr int CW_BIASMAX = 2048;
constexpr int CW_CNT = 1024;

struct Params {
  const float* in[N_IN];
  float* out;
  unsigned char* ws;
};
typedef const __attribute__((address_space(4))) Params& PRef;
typedef const __attribute__((address_space(4))) Params* PPtr;
__device__ __forceinline__ PPtr opq_params() { PPtr pp = (PPtr)__builtin_amdgcn_kernarg_segment_ptr(); asm volatile("" : "+s"(pp)); return pp; }
#define PP (*opq_params())

DI float bf2f(bf16 v) { return __uint_as_float(((unsigned)v) << 16); }
DI bf16 f2bf(float f) { unsigned u = __float_as_uint(f); u += 0x7fffu + ((u >> 16) & 1u); return (bf16)(u >> 16); }
DI float sigmoidf_(float x) { return 1.f / (1.f + __expf(-x)); }
DI float wave_sum_l(float v, int lane) {
#pragma unroll
  for (int o = 1; o < 64; o <<= 1) v += __int_as_float(__builtin_amdgcn_ds_bpermute((lane ^ o) << 2, __float_as_int(v)));
  return v;
}
#define wave_sum(v) wave_sum_l((v), lane)
DI unsigned cvt_pk_bf16_(float lo, float hi) { unsigned r; asm volatile("v_cvt_pk_bf16_f32 %0, %1, %2" : "=v"(r) : "v"(lo), "v"(hi)); return r; }
DI float seg_sum(float v, int lane, int width) {
#pragma unroll
  for (int o = 1; o < 64; o <<= 1) if (o < width) v += __int_as_float(__builtin_amdgcn_ds_bpermute((lane ^ o) << 2, __float_as_int(v)));
  return v;
}
DI float lane_xor(float v, int lane, int o) { return __int_as_float(__builtin_amdgcn_ds_bpermute((lane ^ o) << 2, __float_as_int(v))); }

DI void quant_row_i8(const float (&v)[16], signed char* dst, float* scale_out, int lane) {
  float mx = 0.f;
#pragma unroll
  for (int i = 0; i < 16; ++i) mx = fmaxf(mx, fabsf(v[i]));
#pragma unroll
  for (int o = 1; o < 64; o <<= 1) mx = fmaxf(mx, lane_xor(mx, lane, o));
  const float sc = mx > 0.f ? mx * (1.f / 127.f) : 1.f, inv = 1.f / sc; if (lane == 0) *scale_out = sc;
#pragma unroll
  for (int j = 0; j < 4; ++j) { unsigned b = 0;
#pragma unroll
    for (int i = 0; i < 4; ++i) b |= ((unsigned)(int)rintf(v[4 * j + i] * inv) & 255u) << (8 * i);
    *(unsigned*)(dst + j * 256 + lane * 4) = b; }
}
DI void ld4(const bf16* p, float (&x)[4]) { const uint2 u = *(const uint2*)p; x[0] = __uint_as_float(u.x << 16); x[1] = __uint_as_float(u.x & 0xffff0000u); x[2] = __uint_as_float(u.y << 16); x[3] = __uint_as_float(u.y & 0xffff0000u); }
DI void st4(bf16* p, const float (&x)[4]) { uint2 u; u.x = cvt_pk_bf16_(x[0], x[1]); u.y = cvt_pk_bf16_(x[2], x[3]); *(uint2*)p = u; }

DI int opq_bid() { int b = blockIdx.x; asm volatile("" : "+s"(b)); return b; }
DI int opq_nblk() { int g = gridDim.x; asm volatile("" : "+s"(g)); return g; }
DI int opq_tid() { int t = threadIdx.x; asm volatile("" : "+v"(t)); return t; }
#define GTID ((int)(bid_ * 512 + tid_))
#define NTHR ((int)(nblk_ * 512))
#define SUB ((int)(tid_ >> 8))
#define T256 ((int)(tid_ & 255))
DI int modidx(int r) { return r < TL ? (r >> 12) : NB; }


DI const float* stream_row(PRef p, int l, int r, bool after_mixer) {
  if (l == 0 && !after_mixer) return r < TL ? p.in[I_X] + (size_t)r * D : p.in[I_CTX] + (size_t)(r - TL) * D;
  return (const float*)(p.ws + WS_XF) + (size_t)r * D;
}
DI void ph_mod1(PRef p, int l) {
  const int tid_ = opq_tid(); const int bid_ = opq_bid(), nblk_ = opq_nblk(); (void)bid_; (void)nblk_;
  const int lane = tid_ & 63, gw = GTID >> 6, ngw = NTHR >> 6;
  const float* MOD = (const float*)(p.ws + WS_MOD);
  bf16* H = (bf16*)(p.ws + WS_H);
  const float* g = p.in[I_N1G] + l * D;
  float4 c0, c1, c2, c3;
  { const float* x = stream_row(p, l, min(gw, T - 1), false) + lane * 4; c0 = *(const float4*)(x); c1 = *(const float4*)(x + 256); c2 = *(const float4*)(x + 512); c3 = *(const float4*)(x + 768); }
  for (int r = gw; r < T; r += ngw) {
    float4 n0, n1, n2, n3;
    { const float* x = stream_row(p, l, min(r + ngw, T - 1), false) + lane * 4; n0 = *(const float4*)(x); n1 = *(const float4*)(x + 256); n2 = *(const float4*)(x + 512); n3 = *(const float4*)(x + 768); }
    float v[16]; float ss = 0.f;
    { const float4 t4[4] = {c0, c1, c2, c3};
#pragma unroll
    for (int j = 0; j < 4; ++j) { const float4 t = t4[j]; v[4 * j] = t.x; v[4 * j + 1] = t.y; v[4 * j + 2] = t.z; v[4 * j + 3] = t.w; ss += t.x * t.x + t.y * t.y + t.z * t.z + t.w * t.w; } }
    c0 = n0; c1 = n1; c2 = n2; c3 = n3;
    ss = wave_sum(ss);
    const float rstd = rsqrtf(ss * (1.f / D) + EPS);
    const float* md = MOD + ((size_t)l * 9 + modidx(r)) * 6144;
#pragma unroll
    for (int j = 0; j < 4; ++j)
#pragma unroll
      for (int i = 0; i < 4; ++i) { const int c = j * 256 + lane * 4 + i; v[4 * j + i] = v[4 * j + i] * rstd * g[c] * (1.f + md[1024 + c]) + md[c]; }
    quant_row_i8(v, (signed char*)H + (size_t)r * D, (float*)(p.ws + WS_HS1) + r, lane);
  }
}

struct RowId { DI int operator()(int m) const { return m; } };
struct RowGather { const int* idx; DI int operator()(int m) const { return idx[m]; } };
#define ZERO_ACC(acc) do { _Pragma("unroll") for (int i_ = 0; i_ < 4; ++i_) _Pragma("unroll") for (int j_ = 0; j_ < 4; ++j_) acc[i_][j_] = 0.f; } while (0)


DI void ph_conv(PRef p, int l, int nrows, unsigned char* lds) {
  const int tid_ = opq_tid(); const int bid_ = opq_bid(), nblk_ = opq_nblk(); (void)bid_; (void)nblk_;
  const int lane = tid_ & 63, gw = GTID >> 6, ngw = NTHR >> 6;
  const bf16* __restrict__ CU = (const bf16*)(p.ws + WS_CU); bf16* __restrict__ BI = (bf16*)(p.ws + WS_BI);
  const float* cw = p.in[I_CONVW] + l * 31 * 256; const float* cb = p.in[I_CONVB] + l * 256;
  float4* wl = (float4*)lds;
  for (int k = tid_; k < 31 * 64; k += 512) wl[k] = *(const float4*)(cw + 4 * k);
  __syncthreads();
  const float4 bias = *(const float4*)(cb + lane * 4), lg = *(const float4*)(p.in[I_CLNG] + l * 256 + lane * 4), lb = *(const float4*)(p.in[I_CLNB] + l * 256 + lane * 4);
  for (int r = gw; r < nrows; r += ngw) {
    int lo, hi; if (r < TL) { lo = r & ~(SEQ - 1); hi = lo + SEQ; } else { lo = TL + ((r - TL) & ~(CTX - 1)); hi = lo + CTX; }
    const bf16* up = CU + (long)(r - 15) * 256 + lane * 4; asm volatile("" : "+v"(up));
    uint2 u[31];
#pragma unroll
    for (int j = 0; j < 31; ++j) { const int rr = r + j - 15; u[j] = make_uint2(0u, 0u); if (rr >= lo && rr < hi) u[j] = *(const uint2*)(up + j * 256); }
    float a[4] = {bias.x, bias.y, bias.z, bias.w};
#pragma unroll
    for (int j = 0; j < 31; ++j) { const float4 w = wl[j * 64 + lane];
      a[0] += __uint_as_float(u[j].x << 16) * w.x; a[1] += __uint_as_float(u[j].x & 0xffff0000u) * w.y; a[2] += __uint_as_float(u[j].y << 16) * w.z; a[3] += __uint_as_float(u[j].y & 0xffff0000u) * w.w; }
    const float mu = seg_sum(a[0] + a[1] + a[2] + a[3], lane, 64) * (1.f / 256.f);
    float q2 = 0.f;
#pragma unroll
    for (int c = 0; c < 4; ++c) { a[c] -= mu; q2 += a[c] * a[c]; }
    const float rs = rsqrtf(seg_sum(q2, lane, 64) * (1.f / 256.f) + EPS);
    float y[4] = {a[0] * rs * lg.x + lb.x, a[1] * rs * lg.y + lb.y, a[2] * rs * lg.z + lb.z, a[3] * rs * lg.w + lb.w};
#pragma unroll
    for (int c = 0; c < 4; ++c) y[c] = y[c] * sigmoidf_(y[c]);
    st4(BI + (size_t)r * D + lane * 4, y);
  }
  __syncthreads();
}


DI void expert_offsets(const unsigned* cnt, int* off  ) { int a = 0; for (int e = 0; e < NE; ++e) { off[e] = a; a += ((int)cnt[e] + 255) & ~255; } off[NE] = a; }
DI void ph_combine(PRef p, int l, int nrows, unsigned char* lds) {
  const int tid_ = opq_tid(); const int bid_ = opq_bid(), nblk_ = opq_nblk();
  int* off = (int*)(lds + 32768);
  const unsigned* cnt = (const unsigned*)(p.ws + WS_CTL) + CW_CNT + l * 64;
  if (tid_ == 0) expert_offsets(cnt, off);
  __syncthreads();
  const int lane = tid_ & 63, gw = GTID >> 6, ngw = NTHR >> 6;
  const float* MOD = (const float*)(p.ws + WS_MOD); float* XF = (float*)(p.ws + WS_XF); const bf16* YE = (const bf16*)(p.ws + WS_YE); const int* ROUTE = (const int*)(p.ws + WS_ROUTE);
  bf16* H = (bf16*)(p.ws + WS_H); const float* g1n = p.in[I_N1G] + D;
  for (int r = gw; r < nrows; r += ngw) {
    const float* md = MOD + ((size_t)l * 9 + modidx(r)) * 6144 + 5 * 1024;
    float* dst = (l == 1) ? p.out + (size_t)r * D : XF + (size_t)r * D;
    const float* xs = XF + (size_t)r * D;
    float acc[16];
#pragma unroll
    for (int i = 0; i < 16; ++i) acc[i] = 0.f;
#pragma unroll
    for (int k = 0; k < 4; ++k) { const int* rt = ROUTE + ((size_t)r * 4 + k) * 4; const float w = __int_as_float(rt[2]); const bf16* y = YE + (size_t)(off[rt[0]] + rt[1]) * D;
#pragma unroll
      for (int j = 0; j < 4; ++j) { const uint2 u = *(const uint2*)(y + j * 256 + lane * 4);
        acc[4 * j] += w * __uint_as_float(u.x << 16); acc[4 * j + 1] += w * __uint_as_float(u.x & 0xffff0000u); acc[4 * j + 2] += w * __uint_as_float(u.y << 16); acc[4 * j + 3] += w * __uint_as_float(u.y & 0xffff0000u); } }
    float ss = 0.f;
#pragma unroll
    for (int j = 0; j < 4; ++j) { const int c = j * 256 + lane * 4; const float4 x4 = *(const float4*)(xs + c), m4 = *(const float4*)(md + c);
      acc[4 * j] = x4.x + m4.x * acc[4 * j]; acc[4 * j + 1] = x4.y + m4.y * acc[4 * j + 1]; acc[4 * j + 2] = x4.z + m4.z * acc[4 * j + 2]; acc[4 * j + 3] = x4.w + m4.w * acc[4 * j + 3];
      *(float4*)(dst + c) = make_float4(acc[4 * j], acc[4 * j + 1], acc[4 * j + 2], acc[4 * j + 3]);
      ss += acc[4 * j] * acc[4 * j] + acc[4 * j + 1] * acc[4 * j + 1] + acc[4 * j + 2] * acc[4 * j + 2] + acc[4 * j + 3] * acc[4 * j + 3]; }
    if (l == 0) {
      ss = seg_sum(ss, lane, 64); const float rstd = rsqrtf(ss * (1.f / D) + EPS);
      const float* m1 = MOD + ((size_t)9 + modidx(r)) * 6144;
#pragma unroll
      for (int j = 0; j < 4; ++j) { const int c = j * 256 + lane * 4; const float4 gg = *(const float4*)(g1n + c), s4 = *(const float4*)(m1 + 1024 + c), h4 = *(const float4*)(m1 + c);
        acc[4 * j] = acc[4 * j] * rstd * gg.x * (1.f + s4.x) + h4.x; acc[4 * j + 1] = acc[4 * j + 1] * rstd * gg.y * (1.f + s4.y) + h4.y; acc[4 * j + 2] = acc[4 * j + 2] * rstd * gg.z * (1.f + s4.z) + h4.z; acc[4 * j + 3] = acc[4 * j + 3] * rstd * gg.w * (1.f + s4.w) + h4.w; }
      quant_row_i8(acc, (signed char*)H + (size_t)r * D, (float*)(p.ws + WS_HS1) + r, lane);
    }
  }
}

namespace pg8 {
#define PG8_LAS __attribute__((address_space(3)))
typedef unsigned short bf16_t;
typedef short bf16x8 __attribute__((ext_vector_type(8)));
typedef float f32x4 __attribute__((ext_vector_type(4)));
typedef unsigned u32x4 __attribute__((ext_vector_type(4)));
typedef unsigned u32x2 __attribute__((ext_vector_type(2)));
typedef int i32x4v __attribute__((ext_vector_type(4)));
constexpr int BM = 256, BK = 64, HALF = 128, HTB = HALF * BK * 2, STAGE_BYTES = 8 * HTB;
__host__ __device__ __forceinline__ int lds_byte(int r, int c) { const int st = (r >> 4) * 2 + (c >> 5), rr = r & 15, cc = c & 31, ob = rr * 64 + cc * 2; return st * 1024 + (ob ^ (((ob >> 9) & 1) << 5)); }
__host__ __device__ __forceinline__ void stage_rc(int b, int& R, int& C) { const int st = b / 1024, sb = b % 1024, swz = sb ^ (((sb >> 9) & 1) << 5); R = (st >> 1) * 16 + swz / 64; C = (st & 1) * 32 + (swz % 64) / 2; }
__host__ __device__ __forceinline__ int perm32(int rho) { const int n = rho >> 4, i = rho & 15; return 8 * (i >> 2) + 4 * n + (i & 3); }
__device__ __forceinline__ unsigned cvt_pk_bf16(float lo, float hi) { unsigned r; asm volatile("v_cvt_pk_bf16_f32 %0, %1, %2" : "=v"(r) : "v"(lo), "v"(hi)); return r; }

struct Unit { int pm, pn, aux, nvalid; const char* A; const char* B; const int* rows; };

template <class Epi, class Sched, bool GATHER, bool I8 = false>
__device__ __forceinline__ void gemm_phase(PG8_LAS unsigned char* lds, const int lda_, const int K_, const Sched& S, const Epi& E) {
    const int lda = I8 ? lda_ / 2 : lda_, K = I8 ? K_ / 2 : K_;
    const int tid = opq_tid(), wid = __builtin_amdgcn_readfirstlane(tid >> 6), lane = tid & 63, wr = wid >> 2, wc = wid & 3, fr = lane & 15, fq = lane >> 4;
    const int nt = K / BK;
    unsigned voffA[2], voffB[2];
#pragma unroll
    for (int i = 0; i < 2; ++i) { int R, C; stage_rc(tid * 16 + i * 8192, R, C); const int Rb = Epi::PERM ? ((R & ~31) + perm32(R & 31)) : R;
        voffA[i] = GATHER ? (unsigned)(R * 65536 + C * 2) : (unsigned)(R * lda + C) * 2u; voffB[i] = (unsigned)(Rb * K + C) * 2u; }
    const size_t kstep = (size_t)(BK * 2);
    const size_t hstepA = GATHER ? 0 : (size_t)HALF * lda * 2, hstepB = (size_t)HALF * K * 2;
    const unsigned ldsw = (unsigned)wid * 1024u;
    const int aoff = lds_byte(wr * 64 + fr, fq * 8), boff = lds_byte(wc * 32 + fr, fq * 8);
#define PG8_SA(b, h) (((b) * 2 + (h)) * HTB)
#define PG8_SB(b, h) ((4 + (b) * 2 + (h)) * HTB)
#define PG8_STAGE(bufoff, gbase, voff) do { _Pragma("unroll") for (int _i = 0; _i < 2; ++_i) \
        __builtin_amdgcn_global_load_lds((const unsigned*)((const char*)(gbase) + (voff)[_i]), (PG8_LAS unsigned*)(lds + (bufoff) + ldsw + _i * 8192), 16, 0, 0); } while (0)
#define PG8_LDA(dst, b, h) do { _Pragma("unroll") for (int m = 0; m < 4; ++m) _Pragma("unroll") for (int k = 0; k < 2; ++k) dst[m][k] = *(const PG8_LAS bf16x8*)(lds + PG8_SA(b, h) + aoff + m * 2048 + k * 1024); } while (0)
#define PG8_LDB(dst, b, h) do { _Pragma("unroll") for (int n = 0; n < 2; ++n) _Pragma("unroll") for (int k = 0; k < 2; ++k) dst[n][k] = *(const PG8_LAS bf16x8*)(lds + PG8_SB(b, h) + boff + n * 2048 + k * 1024); } while (0)
#define PG8_MMA(ai, bj, At, Bt) do { __builtin_amdgcn_s_setprio(1); _Pragma("unroll") for (int m = 0; m < 4; ++m) _Pragma("unroll") for (int n = 0; n < 2; ++n) _Pragma("unroll") for (int k = 0; k < 2; ++k) { \
        if constexpr (I8) acc[ai][bj][m][n] = __builtin_bit_cast(f32x4, __builtin_amdgcn_mfma_i32_16x16x64_i8(__builtin_bit_cast(i32x4v, Bt[n][k]), __builtin_bit_cast(i32x4v, At[m][k]), __builtin_bit_cast(i32x4v, acc[ai][bj][m][n]), 0, 0, 0)); \
        else acc[ai][bj][m][n] = __builtin_amdgcn_mfma_f32_16x16x32_bf16(Bt[n][k], At[m][k], acc[ai][bj][m][n], 0, 0, 0); } __builtin_amdgcn_s_setprio(0); } while (0)
#define PG8_WAIT_V(n) asm volatile("s_waitcnt vmcnt(" #n ")" ::: "memory")
#define PG8_WAIT_L(n) asm volatile("s_waitcnt lgkmcnt(" #n ")" ::: "memory")
#define PG8_BAR __builtin_amdgcn_s_barrier()
#define PG8_SCHED __builtin_amdgcn_sched_barrier(0)
#define PG8_LOADROWS(dst, u) do { _Pragma("unroll") for (int h_ = 0; h_ < 2; ++h_) _Pragma("unroll") for (int i_ = 0; i_ < 2; ++i_) \
        { const int ri_ = h_ * HALF + (int)(voffA[i_] >> 16); dst[h_][i_] = (unsigned)((u).rows[ri_ < (u).nvalid ? ri_ : 0]) * (unsigned)(lda * 2) + (voffA[i_] & 0xffffu); } } while (0)
#define PG8_STAGE_A(bufoff, gbase, h, NEXT) do { if constexpr (GATHER) { PG8_STAGE(bufoff, gbase, ((NEXT) ? vn[h] : vc[h])); } else { PG8_STAGE(bufoff, (gbase) + (h) * hstepA, voffA); } } while (0)
    Unit cur, nxt; int ui = 0;
    if (!S.next(0, cur)) return;
    f32x4 acc[2][2][4][2];
#pragma unroll
    for (int a = 0; a < 2; ++a)
#pragma unroll
        for (int b = 0; b < 2; ++b)
#pragma unroll
            for (int m = 0; m < 4; ++m)
#pragma unroll
                for (int n = 0; n < 2; ++n) acc[a][b][m][n] = (f32x4){0.f, 0.f, 0.f, 0.f};
    bf16x8 At[4][2], B0[2][2], B1[2][2];
    unsigned vc[2][2], vn[2][2];
    if constexpr (GATHER) { PG8_LOADROWS(vc, cur);
#pragma unroll
        for (int h = 0; h < 2; ++h) { vn[h][0] = vc[h][0]; vn[h][1] = vc[h][1]; } }
    const char* cA = cur.A; const char* cB = cur.B;
    PG8_STAGE(PG8_SB(0, 0), cB, voffB); PG8_STAGE(PG8_SB(0, 1), cB + hstepB, voffB); PG8_STAGE_A(PG8_SA(0, 0), cA, 0, false); PG8_STAGE_A(PG8_SA(0, 1), cA, 1, false);
    if (wr == 1) PG8_BAR;
    PG8_WAIT_V(2); PG8_BAR;
    PG8_STAGE(PG8_SB(1, 0), cB + kstep, voffB); PG8_STAGE_A(PG8_SA(1, 0), cA + kstep, 0, false); PG8_STAGE(PG8_SB(1, 1), cB + hstepB + kstep, voffB);
    PG8_WAIT_V(6); PG8_BAR;
    for (;;) {
        const bool has_next = S.next(ui + 1, nxt);
        const char* nA = has_next ? nxt.A : cA; const char* nB = has_next ? nxt.B : cB;
        if constexpr (GATHER) { if (has_next) { PG8_LOADROWS(vn, nxt); } }
#pragma unroll 1
        for (int t = 0; t < nt; t += 2) {
            const bool last = (t == nt - 2);
            const char* a1 = cA + (size_t)(t + 1) * kstep;
            const char* a2 = last ? nA : cA + (size_t)(t + 2) * kstep; const char* b2 = last ? nB : cB + (size_t)(t + 2) * kstep;
            const char* a3 = a2 + kstep; const char* b3 = b2 + kstep;
            PG8_LDB(B0, 0, 0); PG8_LDB(B1, 0, 1); PG8_SCHED; PG8_LDA(At, 0, 0); PG8_STAGE_A(PG8_SA(1, 1), a1, 1, false);
            PG8_WAIT_V(8); PG8_WAIT_L(0); PG8_BAR; PG8_MMA(0, 0, At, B0); PG8_MMA(0, 1, At, B1); PG8_BAR; PG8_SCHED;
            PG8_LDA(At, 0, 1); PG8_STAGE(PG8_SB(0, 0), b2, voffB); PG8_STAGE(PG8_SB(0, 1), b2 + hstepB, voffB); PG8_STAGE_A(PG8_SA(0, 0), a2, 0, last);
            PG8_WAIT_V(8); PG8_WAIT_L(0); PG8_BAR; PG8_MMA(1, 0, At, B0); PG8_MMA(1, 1, At, B1); PG8_BAR; PG8_SCHED;
            PG8_LDB(B0, 1, 0); PG8_LDB(B1, 1, 1); PG8_SCHED; PG8_LDA(At, 1, 0); PG8_STAGE_A(PG8_SA(0, 1), a2, 1, last);
            PG8_WAIT_V(8); PG8_WAIT_L(0); PG8_BAR; PG8_MMA(0, 0, At, B0); PG8_MMA(0, 1, At, B1); PG8_BAR; PG8_SCHED;
            PG8_LDA(At, 1, 1); PG8_STAGE(PG8_SB(1, 0), b3, voffB); PG8_STAGE(PG8_SB(1, 1), b3 + hstepB, voffB); PG8_STAGE_A(PG8_SA(1, 0), a3, 0, last);
            PG8_WAIT_V(8); PG8_WAIT_L(0); PG8_BAR; PG8_MMA(1, 0, At, B0); PG8_MMA(1, 1, At, B1); PG8_BAR; PG8_SCHED;
        }
        if (wr == 0) PG8_BAR;
        { const int l2 = opq_tid() & 63; E(acc, cur, wr, wc, l2 & 15, l2 >> 4); }
        if (!has_next) break;
#pragma unroll
        for (int a = 0; a < 2; ++a)
#pragma unroll
            for (int b = 0; b < 2; ++b)
#pragma unroll
                for (int m = 0; m < 4; ++m)
#pragma unroll
                    for (int n = 0; n < 2; ++n) acc[a][b][m][n] = (f32x4){0.f, 0.f, 0.f, 0.f};
        cur = nxt; cA = nA; cB = nB; ++ui;
        if constexpr (GATHER) {
#pragma unroll
            for (int h = 0; h < 2; ++h) { vc[h][0] = vn[h][0]; vc[h][1] = vn[h][1]; } }
        if (wr == 1) PG8_BAR;
    }
    PG8_WAIT_V(0);
    PG8_BAR;
#undef PG8_STAGE_A
#undef PG8_SA
#undef PG8_SB
#undef PG8_STAGE
#undef PG8_LDA
#undef PG8_LDB
#undef PG8_MMA
#undef PG8_WAIT_V
#undef PG8_WAIT_L
#undef PG8_BAR
#undef PG8_SCHED
#undef PG8_LOADROWS
}
}

struct SchedDense {
    const char* A; const char* Bt; int nM, nN, G, c; size_t tstepA, tstepB; bool rev = false;
    DI void init(const void* A_, int lda, const void* Bt_, int K, int M, int N, int G_, int c_) { A = (const char*)A_; Bt = (const char*)Bt_; nM = M / 256; nN = N / 256; G = G_; c = c_; tstepA = (size_t)256 * lda * 2; tstepB = (size_t)256 * K * 2; }
    DI bool next(int i, pg8::Unit& u) const {
        const int L = i * G + c; if (L >= nM * nN) return false;
        const int nig = 8 * nN, gid = L / nig, fm = gid * 8, gsz = (nM - fm) < 8 ? (nM - fm) : 8, w = L - gid * nig;
        u.pm = fm + (w % gsz); if (rev) u.pm = nM - 1 - u.pm; u.pn = w / gsz; u.aux = 0; u.nvalid = 256; u.A = A + (size_t)u.pm * tstepA; u.B = Bt + (size_t)u.pn * tstepB; u.rows = nullptr; return true; }
};
struct SchedBranch {
    const char* A; const char* Bt; int nM, G, c;
    DI void init(const void* A_, const void* Bt_, int M, int G_, int c_) { A = (const char*)A_; Bt = (const char*)Bt_; nM = M / 256; G = G_; c = c_; }
    DI bool next(int i, pg8::Unit& u) const {
        const int L = i * G + c; if (L >= nM * 16) return false;
        u.pm = L >> 4; const int b = (L >> 2) & 3; u.pn = L & 3; u.aux = b; u.nvalid = 256;
        u.A = A + (size_t)u.pm * 256 * (D * 2) + b * 512; u.B = Bt + ((size_t)b * 1024 + u.pn * 256) * 512; u.rows = nullptr; return true; }
};
struct SchedMoe {
    bool rev = false; const char* A; const char* Bt; const int* rowtok; const int* off; const int* cnt; int nN, G, c, ntiles; size_t tstepA, estepB, tstepB; bool gather;
    DI bool next(int i, pg8::Unit& u) const {
        int rt, pn;
        if (G == 256) {
            const int v = i * 32 + (c >> 3), rl = v / nN; pn = v - rl * nN; rt = rl * 8 + (c & 7); if (rt >= ntiles) return false; }
        else { const int L = i * G + c; if (L >= ntiles * nN) return false; rt = L / nN; pn = L - rt * nN; }
        if (rev) rt = ntiles - 1 - rt;
        u.pm = rt; u.pn = pn; const int r0 = rt * 256; int e = 0;
#pragma unroll 1
        for (int k = 1; k < NE; ++k) e += (off[k] <= r0) ? 1 : 0;
        u.aux = e; u.A = gather ? A : A + (size_t)rt * tstepA; u.B = Bt + (size_t)e * estepB + (size_t)u.pn * tstepB;
        const int rin = r0 - off[e]; u.rows = rowtok + (size_t)e * T + rin; u.nvalid = cnt[e] - rin; return true; }
};

struct EpiStoreBf16 {
    static constexpr bool PERM = true;
    bf16* O; int ldc; int auxstride; const float* bias; int biasstride;
    DI void operator()(const pg8::f32x4 (&acc)[2][2][4][2], const pg8::Unit& u, int wr, int wc, int fr, int fq) const {
        const int row0 = u.pm * 256 + wr * 64 + fr, col0 = u.aux * auxstride + u.pn * 256 + wc * 32 + 8 * fq, bcol0 = u.pn * 256 + wc * 32 + 8 * fq;
        pg8::f32x4 bv[2][2];
#pragma unroll
        for (int bj = 0; bj < 2; ++bj)
#pragma unroll
            for (int n = 0; n < 2; ++n) bv[bj][n] = bias ? *(const pg8::f32x4*)(bias + (size_t)u.aux * biasstride + bcol0 + bj * 128 + 4 * n) : (pg8::f32x4){0.f, 0.f, 0.f, 0.f};
#pragma unroll
        for (int ai = 0; ai < 2; ++ai)
#pragma unroll
            for (int m = 0; m < 4; ++m) { bf16* rowp = O + (size_t)(row0 + ai * 128 + m * 16) * ldc + col0;
#pragma unroll
                for (int bj = 0; bj < 2; ++bj) { const pg8::f32x4 v0 = acc[ai][bj][m][0] + bv[bj][0], v1 = acc[ai][bj][m][1] + bv[bj][1];
                    pg8::u32x4 w; w.x = pg8::cvt_pk_bf16(v0[0], v0[1]); w.y = pg8::cvt_pk_bf16(v0[2], v0[3]); w.z = pg8::cvt_pk_bf16(v1[0], v1[1]); w.w = pg8::cvt_pk_bf16(v1[2], v1[3]);
                    *(pg8::u32x4*)(rowp + bj * 128) = w; } }
    }
};
DI float sigm_fast(float x) { return __builtin_amdgcn_rcpf(1.f + __builtin_amdgcn_exp2f(-LOG2E * x)); }
struct EpiMerge {
    static constexpr bool PERM = false;
    const bf16* YB; bf16* YM; const float* gb; const float* HS1; const float* GATES;
    DI void operator()(const pg8::f32x4 (&acc)[2][2][4][2], const pg8::Unit& u, int wr, int wc, int fr, int fq) const {
        const int row0 = u.pm * 256 + wr * 64 + fr, col = u.pn * 64 + wc * 16 + fq * 4;
        pg8::f32x4 bv[2][2];
#pragma unroll
        for (int bj = 0; bj < 2; ++bj)
#pragma unroll
            for (int n = 0; n < 2; ++n) bv[bj][n] = *(const pg8::f32x4*)(gb + (2 * bj + n) * 1024 + col);
#pragma unroll
        for (int ai = 0; ai < 2; ++ai)
#pragma unroll
            for (int m = 0; m < 4; ++m) { const size_t r = (size_t)(row0 + ai * 128 + m * 16); const float sa = HS1[r]; pg8::f32x4 y = (pg8::f32x4){0.f, 0.f, 0.f, 0.f};
#pragma unroll
                for (int bj = 0; bj < 2; ++bj)
#pragma unroll
                    for (int n = 0; n < 2; ++n) { const pg8::u32x2 yb = *(const pg8::u32x2*)(YB + r * 4096 + (2 * bj + n) * 1024 + col); const pg8::i32x4v iv = __builtin_bit_cast(pg8::i32x4v, acc[ai][bj][m][n]);
                        const pg8::f32x4 cs = *(const pg8::f32x4*)(GATES + u.pn * 256 + 128 * bj + 32 * wc + 16 * n + 4 * fq);
                        const pg8::f32x4 g = (pg8::f32x4){(float)iv[0] * sa * cs[0], (float)iv[1] * sa * cs[1], (float)iv[2] * sa * cs[2], (float)iv[3] * sa * cs[3]} + bv[bj][n];
                        y[0] += sigm_fast(g[0]) * __uint_as_float(yb.x << 16); y[1] += sigm_fast(g[1]) * __uint_as_float(yb.x & 0xffff0000u);
                        y[2] += sigm_fast(g[2]) * __uint_as_float(yb.y << 16); y[3] += sigm_fast(g[3]) * __uint_as_float(yb.y & 0xffff0000u); }
                pg8::u32x2 w; w.x = pg8::cvt_pk_bf16(y[0], y[1]); w.y = pg8::cvt_pk_bf16(y[2], y[3]); *(pg8::u32x2*)(YM + r * 1024 + col) = w; }
    }
};
struct EpiWo {
    static constexpr bool PERM = false;
    const float* xlat; const float* xctx; float* XF; const float* modg;
    DI void operator()(const pg8::f32x4 (&acc)[2][2][4][2], const pg8::Unit& u, int wr, int wc, int fr, int fq) const {
        const int row0 = u.pm * 256 + wr * 64 + fr, col0 = u.pn * 256 + wc * 32 + 4 * fq;
        const float* g = modg + (size_t)modidx(u.pm * 256) * 6144 + col0;
        pg8::f32x4 gv[2][2];
#pragma unroll
        for (int bj = 0; bj < 2; ++bj)
#pragma unroll
            for (int n = 0; n < 2; ++n) gv[bj][n] = *(const pg8::f32x4*)(g + bj * 128 + n * 16);
#pragma unroll
        for (int ai = 0; ai < 2; ++ai)
#pragma unroll
            for (int mp = 0; mp < 2; ++mp) { pg8::f32x4 t[2][2][2];
#pragma unroll
                for (int mm = 0; mm < 2; ++mm) { const int r = row0 + ai * 128 + (2 * mp + mm) * 16; const float* xs = (r < TL ? xlat + (size_t)r * D : xctx + (size_t)(r - TL) * D) + col0;
#pragma unroll
                    for (int bj = 0; bj < 2; ++bj)
#pragma unroll
                        for (int n = 0; n < 2; ++n) t[mm][bj][n] = *(const pg8::f32x4*)(xs + bj * 128 + n * 16); }
#pragma unroll
                for (int mm = 0; mm < 2; ++mm) { const int m = 2 * mp + mm; const int r = row0 + ai * 128 + m * 16; float* xo = XF + (size_t)r * D + col0;
#pragma unroll
                    for (int bj = 0; bj < 2; ++bj)
#pragma unroll
                        for (int n = 0; n < 2; ++n) *(pg8::f32x4*)(xo + bj * 128 + n * 16) = t[mm][bj][n] + gv[bj][n] * acc[ai][bj][m][n]; } }
    }
};
struct EpiProjFused {
    static constexpr bool PERM = true;
    bf16 *CU, *AQ, *DQ, *DK, *DV, *NQ, *NK, *NV, *KPE; float *QBD, *QBN; const float* ROPE;
    const float *cqg, *ckvg, *dqg, *dkg, *nqg, *nkg;
    float kbd, kbn, nbias; float* P;
    const float* HS1; const float* WINS;
    DI static float red4(float v, int lane) { v += lane_xor(v, lane, 16); v += lane_xor(v, lane, 32); return v; }
    DI static void st8(bf16* dst, const float (&x)[8]) { pg8::u32x4 w; w.x = pg8::cvt_pk_bf16(x[0], x[1]); w.y = pg8::cvt_pk_bf16(x[2], x[3]); w.z = pg8::cvt_pk_bf16(x[4], x[5]); w.w = pg8::cvt_pk_bf16(x[6], x[7]); *(pg8::u32x4*)dst = w; }
    DI void operator()(const pg8::f32x4 (&acc)[2][2][4][2], const pg8::Unit& u, int wr, int wc, int fr, int fq) const {
        const int t = u.pn, lane = fr + 16 * fq, row0 = u.pm * 256 + wr * 64 + fr; const bool lat = u.pm < TL / 256;
        float* SL = P + 2048;
        { const int te = (wr * 4 + wc) * 64 + lane; const float* src = te < 256 ? HS1 + u.pm * 256 + te : WINS + 256 * t + (te - 256); SL[te] = *src;
          asm volatile("s_waitcnt lgkmcnt(0)" ::: "memory"); __builtin_amdgcn_s_barrier(); asm volatile("" ::: "memory"); }
        const float* sap = SL + wr * 64 + fr; const float* sbp = SL + 256 + 32 * wc + 8 * fq;
#define GET8(ai, bj, m, x) do { const float sa_ = sap[(ai) * 128 + (m) * 16]; _Pragma("unroll") for (int n_ = 0; n_ < 2; ++n_) { const pg8::i32x4v iv_ = __builtin_bit_cast(pg8::i32x4v, acc[ai][bj][m][n_]); \
        const pg8::f32x4 sb_ = *(const pg8::f32x4*)(sbp + 128 * (bj) + 4 * n_); _Pragma("unroll") for (int j_ = 0; j_ < 4; ++j_) x[4 * n_ + j_] = (float)iv_[j_] * sa_ * sb_[j_]; } } while (0)
        if (t < 2) {
#pragma unroll
            for (int ai = 0; ai < 2; ++ai)
#pragma unroll
                for (int m = 0; m < 4; ++m) { float a[8], g[8], o[8]; GET8(ai, 0, m, a); GET8(ai, 1, m, g);
#pragma unroll
                    for (int i = 0; i < 8; ++i) o[i] = a[i] * sigm_fast(g[i]);
                    st8(CU + (size_t)(row0 + ai * 128 + m * 16) * 256 + 128 * t + 32 * wc + 8 * fq, o); }
        } else if (t < 5) {
#pragma unroll
            for (int bj = 0; bj < 2; ++bj) { const int ds = (t - 2) * 8 + bj * 4 + wc, head = ds / 6, kind = ds - head * 6;
                const bool isq = kind < 2, isv = kind >= 4; const float* gp = (isq ? dqg : dkg) + 8 * fq; float gg[8];
#pragma unroll
                for (int i = 0; i < 8; ++i) gg[i] = gp[i];
#pragma unroll
                for (int ai = 0; ai < 2; ++ai)
#pragma unroll
                    for (int m = 0; m < 4; ++m) { const int r = row0 + ai * 128 + m * 16; float x[8]; GET8(ai, bj, m, x);
                        if (isv) { st8(DV + (size_t)r * 256 + head * 64 + (kind - 4) * 32 + 8 * fq, x); continue; }
                        float ss = 0.f;
#pragma unroll
                        for (int i = 0; i < 8; ++i) ss += x[i] * x[i];
                        const float rs = rsqrtf(red4(ss, lane) * (1.f / 32.f) + EPS);
#pragma unroll
                        for (int i = 0; i < 8; ++i) x[i] = x[i] * rs * gg[i];
                        float pt[8];
#pragma unroll
                        for (int i = 0; i < 8; ++i) pt[i] = lane_xor(x[i], lane, 32);
                        if (lat) { const float* rp = ROPE + (size_t)(r & (SEQ - 1)) * 32 + 8 * (fq & 1); const bool first = fq < 2;
                            const pg8::f32x4 c0 = *(const pg8::f32x4*)rp, c1 = *(const pg8::f32x4*)(rp + 4), s0 = *(const pg8::f32x4*)(rp + 16), s1 = *(const pg8::f32x4*)(rp + 20);
#pragma unroll
                            for (int i = 0; i < 8; ++i) { const float cs = i < 4 ? c0[i & 3] : c1[i & 3], sn = i < 4 ? s0[i & 3] : s1[i & 3]; x[i] = first ? x[i] * cs - pt[i] * sn : x[i] * cs + pt[i] * sn; } }
                        if (isq) { float qn = 0.f;
#pragma unroll
                            for (int i = 0; i < 8; ++i) { x[i] *= 0.17677669529663687f * LOG2E; qn += x[i] * x[i]; }
                            qn = red4(qn, lane); if (fq == 0) QBD[(size_t)r * 8 + head * 2 + kind] = -(sqrtf(qn) * kbd + 0.05f); }
                        st8((isq ? DQ : DK) + (size_t)r * 256 + head * 64 + (kind & 1) * 32 + 8 * fq, x); } }
        } else if (t < 7) {
            const int pi = (t - 5) * 4 + wc, head = pi >> 1; const bool isq = (pi & 1) == 0; const float* gp = (isq ? nqg : nkg) + 8 * fq; float g0[8], g1[8];
#pragma unroll
            for (int i = 0; i < 8; ++i) { g0[i] = gp[i]; g1[i] = gp[32 + i]; }
#pragma unroll
            for (int ai = 0; ai < 2; ++ai)
#pragma unroll
                for (int m = 0; m < 4; ++m) { const int r = row0 + ai * 128 + m * 16; float x0[8], x1[8]; GET8(ai, 0, m, x0); GET8(ai, 1, m, x1); float ss = 0.f;
#pragma unroll
                    for (int i = 0; i < 8; ++i) ss += x0[i] * x0[i] + x1[i] * x1[i];
                    const float rs = rsqrtf(red4(ss, lane) * (1.f / 64.f) + EPS) * (isq ? 0.125f * LOG2E : 1.f); float qn = 0.f;
#pragma unroll
                    for (int i = 0; i < 8; ++i) { x0[i] = x0[i] * rs * g0[i]; x1[i] = x1[i] * rs * g1[i]; qn += x0[i] * x0[i] + x1[i] * x1[i]; }
                    if (isq) { qn = red4(qn, lane); if (fq == 0) QBN[(size_t)r * 4 + head] = -(sqrtf(qn) * kbn + nbias); }
                    bf16* dst = (isq ? NQ : NK) + (size_t)r * 256 + head * 64 + 8 * fq; st8(dst, x0); st8(dst + 32, x1); }
        } else if (t == 7) {
#pragma unroll
            for (int bj = 0; bj < 2; ++bj) { const int sl = bj * 4 + wc, head = sl >> 1, half = sl & 1;
#pragma unroll
                for (int ai = 0; ai < 2; ++ai)
#pragma unroll
                    for (int m = 0; m < 4; ++m) { float x[8]; GET8(ai, bj, m, x); st8(NV + (size_t)(row0 + ai * 128 + m * 16) * 256 + head * 64 + half * 32 + 8 * fq, x); } }
        } else {
            const int nsl = t == 8 ? 6 : 4;
#pragma unroll
            for (int bj = 0; bj < 2; ++bj) { const int sl = bj * 4 + wc;
#pragma unroll
                for (int ai = 0; ai < 2; ++ai)
#pragma unroll
                    for (int m = 0; m < 4; ++m) { float x[8]; GET8(ai, bj, m, x); float ss = 0.f;
#pragma unroll
                        for (int i = 0; i < 8; ++i) ss += x[i] * x[i];
                        ss = red4(ss, lane); if (fq == 0) P[(ai * 128 + wr * 64 + m * 16 + fr) * 8 + sl] = sl < nsl ? ss : 0.f; } }
            asm volatile("s_waitcnt lgkmcnt(0)" ::: "memory"); __builtin_amdgcn_s_barrier(); asm volatile("" ::: "memory");
#pragma unroll
            for (int bj = 0; bj < 2; ++bj) { const int sl = bj * 4 + wc; const float* gp = (t == 8 ? cqg : ckvg) + 32 * (sl < nsl ? sl : 0) + 8 * fq; float gg[8];
#pragma unroll
                for (int i = 0; i < 8; ++i) gg[i] = gp[i];
#pragma unroll
                for (int ai = 0; ai < 2; ++ai)
#pragma unroll
                    for (int m = 0; m < 4; ++m) { const int rl = ai * 128 + wr * 64 + m * 16 + fr, r = u.pm * 256 + rl; float x[8]; GET8(ai, bj, m, x);
                        const pg8::f32x4 p0 = *(const pg8::f32x4*)(P + rl * 8), p1 = *(const pg8::f32x4*)(P + rl * 8 + 4);
                        const float tot = (p0[0] + p0[1]) + (p0[2] + p0[3]) + (p1[0] + p1[1]) + (p1[2] + p1[3]);
                        const float rs = rsqrtf(tot * (t == 8 ? 1.f / 192.f : 1.f / 128.f) + EPS);
                        if (sl < nsl) {
#pragma unroll
                            for (int i = 0; i < 8; ++i) x[i] = x[i] * rs * gg[i];
                            st8(AQ + (size_t)r * 384 + (t == 8 ? 0 : 192) + 32 * sl + 8 * fq, x); }
                        else if (t == 8 && sl == 6) st8(KPE + (size_t)r * 32 + 8 * fq, x);
                        else if (t == 9 && sl < 6) {
#pragma unroll
                            for (int i = 0; i < 8; ++i) x[i] = 0.f;
                            st8(AQ + (size_t)r * 384 + 320 + 32 * (sl - 4) + 8 * fq, x); } } }
            asm volatile("s_waitcnt lgkmcnt(0)" ::: "memory"); __builtin_amdgcn_s_barrier(); asm volatile("" ::: "memory");
        }
#undef GET8
    }
};
struct EpiQkvFused {
    static constexpr bool PERM = true;
    bf16 *MQ, *MK, *MV; const bf16* KPE; float* QBM; const float* ROPE; const float *gq, *gk; float nbconst; float* P;
    DI static float red4(float v, int lane) { v += lane_xor(v, lane, 16); v += lane_xor(v, lane, 32); return v; }
    DI static void st8(bf16* dst, const float (&x)[8]) { pg8::u32x4 w; w.x = pg8::cvt_pk_bf16(x[0], x[1]); w.y = pg8::cvt_pk_bf16(x[2], x[3]); w.z = pg8::cvt_pk_bf16(x[4], x[5]); w.w = pg8::cvt_pk_bf16(x[6], x[7]); *(pg8::u32x4*)dst = w; }
    DI void rope8(float (&x)[8], int r, int fq, int lane) const {
        float pt[8];
#pragma unroll
        for (int i = 0; i < 8; ++i) pt[i] = lane_xor(x[i], lane, 32);
        const float* rp = ROPE + (size_t)(r & (SEQ - 1)) * 32 + 8 * (fq & 1); const bool first = fq < 2;
        const pg8::f32x4 c0 = *(const pg8::f32x4*)rp, c1 = *(const pg8::f32x4*)(rp + 4), s0 = *(const pg8::f32x4*)(rp + 16), s1 = *(const pg8::f32x4*)(rp + 20);
#pragma unroll
        for (int i = 0; i < 8; ++i) { const float cs = i < 4 ? c0[i & 3] : c1[i & 3], sn = i < 4 ? s0[i & 3] : s1[i & 3]; x[i] = first ? x[i] * cs - pt[i] * sn : x[i] * cs + pt[i] * sn; }
    }
    DI void operator()(const pg8::f32x4 (&acc)[2][2][4][2], const pg8::Unit& u, int wr, int wc, int fr, int fq) const {
        const int t = u.pn, lane = fr + 16 * fq, row0 = u.pm * 256 + wr * 64 + fr; const bool lat = u.pm < TL / 256;
#define GET8(ai, bj, m, x) do { _Pragma("unroll") for (int n_ = 0; n_ < 2; ++n_) _Pragma("unroll") for (int j_ = 0; j_ < 4; ++j_) x[4 * n_ + j_] = acc[ai][bj][m][n_][j_]; } while (0)
        if (t < 2) {
#pragma unroll
            for (int bj = 0; bj < 2; ++bj)
#pragma unroll
                for (int ai = 0; ai < 2; ++ai)
#pragma unroll
                    for (int m = 0; m < 4; ++m) { float x[8]; GET8(ai, bj, m, x); float ss = 0.f;
#pragma unroll
                        for (int i = 0; i < 8; ++i) ss += x[i] * x[i];
                        ss = red4(ss, lane); if (fq == 0) P[(ai * 128 + wr * 64 + m * 16 + fr) * 8 + bj * 4 + wc] = wc < 3 ? ss : 0.f; }
            asm volatile("s_waitcnt lgkmcnt(0)" ::: "memory"); __builtin_amdgcn_s_barrier(); asm volatile("" ::: "memory");
            if (wc < 3) {
#pragma unroll
                for (int bj = 0; bj < 2; ++bj) { const int head = 2 * t + bj; const float* gp = gq + 32 * wc + 8 * fq; asm volatile("" : "+v"(gp)); float gg[8];
#pragma unroll
                    for (int i = 0; i < 8; ++i) gg[i] = gp[i];
#pragma unroll
                    for (int ai = 0; ai < 2; ++ai)
#pragma unroll
                        for (int m = 0; m < 4; ++m) { const int rl = ai * 128 + wr * 64 + m * 16 + fr, r = u.pm * 256 + rl; float x[8]; GET8(ai, bj, m, x);
                            const pg8::f32x4 pp = *(const pg8::f32x4*)(P + rl * 8 + bj * 4);
                            const float rs = rsqrtf((pp[0] + pp[1] + pp[2]) * (1.f / 96.f) + EPS);
#pragma unroll
                            for (int i = 0; i < 8; ++i) x[i] = x[i] * rs * gg[i];
                            if (wc == 2 && lat) rope8(x, r, fq, lane);
#pragma unroll
                            for (int i = 0; i < 8; ++i) x[i] *= 0.10206207261596577f * LOG2E;
                            st8(MQ + (size_t)r * 384 + head * 96 + 32 * wc + 8 * fq, x);
                            if (wc == 0 && fq == 0) QBM[(size_t)r * 4 + head] = nbconst; } }
            }
            asm volatile("s_waitcnt lgkmcnt(0)" ::: "memory"); __builtin_amdgcn_s_barrier(); asm volatile("" ::: "memory");
        } else if (wc < 2) {
            const int head = 2 * (t - 2) + wc;
#pragma unroll
            for (int ai = 0; ai < 2; ++ai)
#pragma unroll
                for (int m = 0; m < 4; ++m) { const int r = row0 + ai * 128 + m * 16; float xp[8];
                    { const uint4 kq = *(const uint4*)(KPE + (size_t)r * 32 + 8 * fq); const unsigned w[4] = {kq.x, kq.y, kq.z, kq.w};
#pragma unroll
                      for (int i = 0; i < 4; ++i) { xp[2 * i] = __uint_as_float(w[i] << 16); xp[2 * i + 1] = __uint_as_float(w[i] & 0xffff0000u); } }
                    float ss = 0.f;
#pragma unroll
                    for (int n = 0; n < 2; ++n)
#pragma unroll
                        for (int j = 0; j < 4; ++j) ss += acc[ai][0][m][n][j] * acc[ai][0][m][n][j] + acc[ai][1][m][n][j] * acc[ai][1][m][n][j] + xp[4 * n + j] * xp[4 * n + j];
                    const float rs = rsqrtf(red4(ss, lane) * (1.f / 96.f) + EPS);
                    const float* gp = gk + 8 * fq; asm volatile("" : "+v"(gp));
                    bf16* dst = MK + (size_t)r * 384 + head * 96 + 8 * fq;
#pragma unroll
                    for (int bj = 0; bj < 2; ++bj) { float x[8]; GET8(ai, bj, m, x);
#pragma unroll
                        for (int i = 0; i < 8; ++i) x[i] = x[i] * rs * gp[32 * bj + i];
                        st8(dst + 32 * bj, x); }
#pragma unroll
                    for (int i = 0; i < 8; ++i) xp[i] = xp[i] * rs * gp[64 + i];
                    if (lat) rope8(xp, r, fq, lane);
                    st8(dst + 64, xp); }
        } else {
            const int head = 2 * (t - 2) + wc - 2;
#pragma unroll
            for (int bj = 0; bj < 2; ++bj)
#pragma unroll
                for (int ai = 0; ai < 2; ++ai)
#pragma unroll
                    for (int m = 0; m < 4; ++m) { float x[8]; GET8(ai, bj, m, x); st8(MV + (size_t)(row0 + ai * 128 + m * 16) * 256 + head * 64 + 32 * bj + 8 * fq, x); }
        }
#undef GET8
    }
};
struct EpiMoeActI8 {
    static constexpr bool PERM = true;
    bf16* ACT; const float* bgu; const float* HS; const float* WGUS;
    DI void operator()(const pg8::f32x4 (&acc)[2][2][4][2], const pg8::Unit& u, int wr, int wc, int fr, int fq) const {
        const int rl0 = wr * 64 + fr, row0 = u.pm * 256 + rl0, col0 = u.pn * 128 + wc * 32 + 8 * fq;
        const float* b = bgu + (size_t)u.aux * 2048 + col0;
        const pg8::f32x4 bg0 = *(const pg8::f32x4*)(b), bg1 = *(const pg8::f32x4*)(b + 4), bu0 = *(const pg8::f32x4*)(b + 1024), bu1 = *(const pg8::f32x4*)(b + 1028);
        const float* cs = WGUS + (size_t)u.aux * 2048 + u.pn * 256 + wc * 32 + 8 * fq;
        const pg8::f32x4 sg0 = *(const pg8::f32x4*)(cs), sg1 = *(const pg8::f32x4*)(cs + 4), su0 = *(const pg8::f32x4*)(cs + 128), su1 = *(const pg8::f32x4*)(cs + 132);
        int tk[2][4]; float sas[2][4];
#pragma unroll
        for (int ai = 0; ai < 2; ++ai)
#pragma unroll
            for (int m = 0; m < 4; ++m) { const int rl = rl0 + ai * 128 + m * 16; tk[ai][m] = u.rows[rl < u.nvalid ? rl : 0]; }
#pragma unroll
        for (int ai = 0; ai < 2; ++ai)
#pragma unroll
            for (int m = 0; m < 4; ++m) sas[ai][m] = HS[tk[ai][m]];
#pragma unroll
        for (int ai = 0; ai < 2; ++ai)
#pragma unroll
            for (int m = 0; m < 4; ++m) { const float sa = sas[ai][m]; float a[8];
#pragma unroll
                for (int n = 0; n < 2; ++n) { const pg8::i32x4v ig = __builtin_bit_cast(pg8::i32x4v, acc[ai][0][m][n]), iu = __builtin_bit_cast(pg8::i32x4v, acc[ai][1][m][n]);
#pragma unroll
                    for (int j = 0; j < 4; ++j) { const float gg = (float)ig[j] * sa * (n ? sg1[j] : sg0[j]) + (n ? bg1[j] : bg0[j]), uu = (float)iu[j] * sa * (n ? su1[j] : su0[j]) + (n ? bu1[j] : bu0[j]);
                        const float g = fminf(gg, 7.f), uc = fminf(fmaxf(uu, -7.f), 7.f); a[4 * n + j] = (uc + 1.f) * (g * sigm_fast(1.702f * g)); } }
                pg8::u32x4 w; w.x = pg8::cvt_pk_bf16(a[0], a[1]); w.y = pg8::cvt_pk_bf16(a[2], a[3]); w.z = pg8::cvt_pk_bf16(a[4], a[5]); w.w = pg8::cvt_pk_bf16(a[6], a[7]);
                *(pg8::u32x4*)(ACT + (size_t)(row0 + ai * 128 + m * 16) * D + col0) = w; }
    }
};
struct EpiMoeAct {
    static constexpr bool PERM = true;
    bf16* ACT; const float* bgu;
    DI void operator()(const pg8::f32x4 (&acc)[2][2][4][2], const pg8::Unit& u, int wr, int wc, int fr, int fq) const {
        const int row0 = u.pm * 256 + wr * 64 + fr, col0 = u.pn * 128 + wc * 32 + 8 * fq;
        const float* b = bgu + (size_t)u.aux * 2048 + col0;
        const pg8::f32x4 bg0 = *(const pg8::f32x4*)(b), bg1 = *(const pg8::f32x4*)(b + 4), bu0 = *(const pg8::f32x4*)(b + 1024), bu1 = *(const pg8::f32x4*)(b + 1028);
#pragma unroll
        for (int ai = 0; ai < 2; ++ai)
#pragma unroll
            for (int m = 0; m < 4; ++m) { float a[8];
#pragma unroll
                for (int n = 0; n < 2; ++n) { const pg8::f32x4 gg = acc[ai][0][m][n] + (n ? bg1 : bg0), uu = acc[ai][1][m][n] + (n ? bu1 : bu0);
#pragma unroll
                    for (int j = 0; j < 4; ++j) { const float g = fminf(gg[j], 7.f), uc = fminf(fmaxf(uu[j], -7.f), 7.f); a[4 * n + j] = (uc + 1.f) * (g * sigm_fast(1.702f * g)); } }
                pg8::u32x4 w; w.x = pg8::cvt_pk_bf16(a[0], a[1]); w.y = pg8::cvt_pk_bf16(a[2], a[3]); w.z = pg8::cvt_pk_bf16(a[4], a[5]); w.w = pg8::cvt_pk_bf16(a[6], a[7]);
                *(pg8::u32x4*)(ACT + (size_t)(row0 + ai * 128 + m * 16) * D + col0) = w; }
    }
};

struct MapId { int off; DI int operator()(int n) const { return n + off; } };
struct MapProj { DI int operator()(int s) const {
    int t, slot;
    if (s < 512) { const int isg = s >> 8, ch = s & 255; t = ch >> 7; slot = isg * 4 + ((ch >> 5) & 3); }
    else if (s < OFF_C) { const int m = s - OFF_B; if (m < 192) { t = 8; slot = m >> 5; } else if (m < 320) { t = 9; slot = (m - 192) >> 5; } else { t = 8; slot = 6; } }
    else if (s < OFF_D) { const int m = s - OFF_C, head = m / 192, w = m - head * 192, ds = head * 6 + (w >> 5); t = 2 + (ds >> 3); slot = ds & 7; }
    else { const int m = s - OFF_D, head = m / 192, w = m - head * 192;
      if (w < 128) { const int pi = head * 2 + (w >> 6); t = 5 + (pi >> 2); slot = ((w >> 5) & 1) * 4 + (pi & 3); } else { t = 7; slot = head * 2 + ((w - 128) >> 5); } }
    return 256 * t + (slot >> 2) * 128 + (slot & 3) * 32 + (s & 31); } };
struct MapQ  { DI int operator()(int s) const { const int head = s / 96, w = s - head * 96; return 256 * (head >> 1) + 128 * (head & 1) + 32 * (w >> 5) + (s & 31); } };
struct MapKV { DI int operator()(int s) const { const int head = s >> 7, w = s & 127, isv = w >> 6, half = (w >> 5) & 1; return 256 * (2 + (head >> 1)) + 128 * half + 32 * (2 * isv + (head & 1)) + (s & 31); } };
struct MapGate { DI int operator()(int s) const { const int b = s >> 10, w = s & 1023, pn = w >> 6, lc = w & 63; return 256 * pn + 128 * (b >> 1) + 32 * (lc >> 4) + 16 * (b & 1) + (lc & 15); } };
struct MapGu { DI int operator()(int s) const { const int isu = s >> 10, c = s & 1023; return 256 * (c >> 7) + 128 * isu + (c & 127); } };
struct CvtItem { const float* W; bf16* WT; int N, ldk, kdst0, mapt, mapoff, item; };
DI CvtItem cvt_decode(PRef p, int it) {
    constexpr int I_WIN_ = (D / 64) * (INW / 32), I_UQ_ = 3 * 12, I_UKV_ = 2 * 16, I_BR_ = 4 * 32, I_GATE_ = 16 * 128, I_WO_ = 16 * 32, I_GU_ = 16 * 64, I_DN_ = 16 * 32;
    constexpr int PER_L = I_UQ_ + I_UKV_ + 4 * I_BR_ + I_WO_ + NE * I_DN_;
    unsigned char* ws = p.ws; CvtItem c; (void)I_WIN_; (void)I_GATE_; c.mapt = 0; c.mapoff = 0; c.kdst0 = 0;
    const int l = it / PER_L; int r = it - l * PER_L;
    if (r < I_UQ_) { c.W = p.in[I_WUQ] + (size_t)l * 192 * 384; c.N = 384; c.WT = (bf16*)(ws + WS_QKV_T) + (size_t)l * 1024 * 384; c.ldk = 384; c.mapt = 4; c.item = r; return c; } r -= I_UQ_;
    if (r < I_UKV_) { c.W = p.in[I_WUKV] + (size_t)l * 128 * 512; c.N = 512; c.WT = (bf16*)(ws + WS_QKV_T) + (size_t)l * 1024 * 384; c.ldk = 384; c.kdst0 = 192; c.mapt = 5; c.item = r; return c; } r -= I_UKV_;
    if (r < 4 * I_BR_) { const int b = r / I_BR_; c.W = (b == 0 ? p.in[I_CONVOUT] : b == 1 ? p.in[I_MLAOUT] : b == 2 ? p.in[I_DIFFOUT] : p.in[I_NAOUT]) + (size_t)l * 256 * D; c.N = D;
        c.WT = (bf16*)(ws + WS_WB_T) + ((size_t)l * 4 + b) * 1024 * 256; c.ldk = 256; c.item = r - b * I_BR_; return c; } r -= 4 * I_BR_;
    if (r < I_WO_) { c.W = p.in[I_WO] + (size_t)l * D * D; c.N = D; c.WT = (bf16*)(ws + WS_WO_T) + (size_t)l * D * D; c.ldk = D; c.item = r; return c; } r -= I_WO_;
    const int e = r / I_DN_; r -= e * I_DN_; (void)I_GU_;
    c.W = p.in[I_WDN] + ((size_t)l * NE + e) * DFF * D; c.N = D; c.WT = (bf16*)(ws + WS_WDN_T) + ((size_t)l * NE + e) * D * DFF; c.ldk = DFF; c.item = r; return c;
}
DI void cvt_load(const CvtItem& c, float (&v)[32], int lane) {
    const int nblk = c.N / 32, kb = c.item / nblk, nb = c.item - kb * nblk;
    const float* src = c.W + (size_t)(64 * kb + (lane >> 5)) * c.N + 32 * nb + (lane & 31);
#pragma unroll
    for (int i = 0; i < 32; ++i) v[i] = src[(size_t)(2 * i) * c.N];
}
DI void cvt_store(const CvtItem& c, const float (&v)[32], float* scr, int lane) {
    const int nblk = c.N / 32, kb = c.item / nblk, nb = c.item - kb * nblk, k0 = 64 * kb, n0 = 32 * nb;
#pragma unroll
    for (int i = 0; i < 32; ++i) scr[(2 * i + (lane >> 5)) * 33 + (lane & 31)] = v[i];
    asm volatile("s_waitcnt lgkmcnt(0)" ::: "memory");
    const int cc = lane & 7;
#pragma unroll
    for (int j = 0; j < 4; ++j) { const int n = (lane >> 3) + 8 * j; const float* s = scr + (8 * cc) * 33 + n;
        pg8::u32x4 o; o.x = pg8::cvt_pk_bf16(s[0 * 33], s[1 * 33]); o.y = pg8::cvt_pk_bf16(s[2 * 33], s[3 * 33]); o.z = pg8::cvt_pk_bf16(s[4 * 33], s[5 * 33]); o.w = pg8::cvt_pk_bf16(s[6 * 33], s[7 * 33]);
        const int sn = n0 + n; const int row = c.mapt == 0 ? sn + c.mapoff : (c.mapt == 1 ? MapGate()(sn) : (c.mapt == 2 ? MapGu()(sn) : (c.mapt == 3 ? MapProj()(sn) : (c.mapt == 4 ? MapQ()(sn) : MapKV()(sn)))));
        *(pg8::u32x4*)(c.WT + (size_t)row * c.ldk + c.kdst0 + k0 + 8 * cc) = o; }
    asm volatile("s_waitcnt lgkmcnt(0)" ::: "memory");
}
DI void ph_convert(PRef p, unsigned char* lds) {
    const int tid_ = opq_tid(); const int bid_ = opq_bid(), nblk_ = opq_nblk(); const int lane = tid_ & 63, wave = __builtin_amdgcn_readfirstlane(tid_ >> 6);
    float* scr = (float*)(lds + wave * 8704);
    const int gw = bid_ * 8 + wave, ngw = nblk_ * 8;
    constexpr int PER_L = 3 * 12 + 2 * 16 + 4 * 4 * 32 + 16 * 32 + NE * (16 * 32);
    const int total = 2 * PER_L;
    float va[32], vb[32];
    int it = gw;
    CvtItem ca, cb;
    if (it < total) { ca = cvt_decode(p, it); cvt_load(ca, va, lane); }
    for (; it < total; it += 2 * ngw) {
        const int i1 = it + ngw, i2 = it + 2 * ngw;
        if (i1 < total) { cb = cvt_decode(p, i1); cvt_load(cb, vb, lane); }
        cvt_store(ca, va, scr, lane);
        if (i2 < total) { ca = cvt_decode(p, i2); cvt_load(ca, va, lane); }
        if (i1 < total) cvt_store(cb, vb, scr, lane);
    }
    __syncthreads();
    { float* red = (float*)lds;
      const int n = tid_ & 31, kg = tid_ >> 5; signed char* W8 = (signed char*)(p.ws + WS_WGU_T); float* WS_ = (float*)(p.ws + WS_WGUS);
      float xa[64], xb[64];
#define I8_DECODE(it, src_, N_, dst_, sca_, kind_, nb_) const float* src_; int N_, kind_, nb_; signed char* dst_; float* sca_; \
        if ((it) < 4096) { const int le_ = (it) >> 6; nb_ = (it) & 63; src_ = p.in[I_WGU] + (size_t)le_ * D * 2048; N_ = 2048; dst_ = W8 + (size_t)le_ * 2048 * D * 2; sca_ = WS_ + (size_t)le_ * 2048; kind_ = 0; } \
        else if ((it) < 4096 + 150) { const int l_ = ((it) - 4096) / 75; nb_ = ((it) - 4096) - l_ * 75; src_ = p.in[I_WIN] + (size_t)l_ * D * INW; N_ = INW; dst_ = (signed char*)(p.ws + WS_WIN_T) + (size_t)l_ * PLD * D * 2; sca_ = (float*)(p.ws + WS_WINS) + l_ * PLD; kind_ = 1; } \
        else { const int l_ = ((it) - 4246) >> 7; nb_ = ((it) - 4246) & 127; src_ = p.in[I_GATEW] + (size_t)l_ * D * 4096; N_ = 4096; dst_ = (signed char*)(p.ws + WS_GATE_T) + (size_t)l_ * 4096 * D * 2; sca_ = (float*)(p.ws + WS_GATES) + l_ * 4096; kind_ = 2; }
#define GU_LOAD(dst, it) do { I8_DECODE(it, src_, N_, d8_, sc8_, kind_, nb_); (void)d8_; (void)sc8_; (void)kind_; const float* s2_ = src_ + (size_t)(64 * kg) * N_ + 32 * nb_ + n; \
        _Pragma("unroll") for (int i = 0; i < 64; ++i) dst[i] = s2_[(size_t)i * N_]; } while (0)
#define GU_EMIT(src, it) do { I8_DECODE(it, src_, N_, d8_, sc8_, kind_, nb_); (void)src_; float m_ = 0.f; _Pragma("unroll") for (int i = 0; i < 64; ++i) m_ = fmaxf(m_, fabsf(src[i])); \
        red[kg * 32 + n] = m_; __syncthreads(); \
        if (tid_ < 32) { float mm_ = 0.f; _Pragma("unroll") for (int g = 0; g < 16; ++g) mm_ = fmaxf(mm_, red[g * 32 + tid_]); red[512 + tid_] = mm_ > 0.f ? mm_ * (1.f / 127.f) : 1.f; } \
        __syncthreads(); const float sc_ = red[512 + n], inv_ = 1.f / sc_; const int col_ = 32 * nb_ + n; const int row_ = kind_ == 0 ? MapGu()(col_) : (kind_ == 1 ? MapProj()(col_) : MapGate()(col_)); \
        if (kg == 0) sc8_[row_] = sc_; \
        signed char* dst_ = d8_ + (size_t)row_ * D + 64 * kg; \
        _Pragma("unroll") for (int q = 0; q < 4; ++q) { unsigned w_[4]; _Pragma("unroll") for (int d = 0; d < 4; ++d) { unsigned b_ = 0; _Pragma("unroll") for (int i = 0; i < 4; ++i) { \
            const int v_ = (int)rintf(src[16 * q + 4 * d + i] * inv_); b_ |= ((unsigned)v_ & 255u) << (8 * i); } w_[d] = b_; } \
            *(uint4*)(dst_ + 16 * q) = make_uint4(w_[0], w_[1], w_[2], w_[3]); } \
        __syncthreads(); } while (0)
      const int nit = 2 * NE * 64 + 150 + 256; int it2 = bid_;
      if (it2 < nit) GU_LOAD(xa, it2);
      for (; it2 < nit; it2 += 2 * nblk_) { const int j1 = it2 + nblk_, j2 = it2 + 2 * nblk_;
        if (j1 < nit) GU_LOAD(xb, j1);
        GU_EMIT(xa, it2);
        if (j2 < nit) GU_LOAD(xa, j2);
        if (j1 < nit) GU_EMIT(xb, j1); }
#undef GU_LOAD
#undef GU_EMIT
#undef I8_DECODE
    }
}

#define LDSP ((PG8_LAS unsigned char*)lds)
DI void ph_proj_fast(PRef p, int l, unsigned char* lds) {
    const int bid_ = opq_bid(), nblk_ = opq_nblk(); const int tid0 = opq_tid(), lane0 = tid0 & 63;
    SchedDense S; S.init(p.ws + WS_H, D / 2, (const bf16*)(p.ws + WS_WIN_T) + (size_t)l * PLD * D, D / 2, T, PLD, nblk_, bid_);
    EpiProjFused E;
    E.CU = (bf16*)(p.ws + WS_CU); E.AQ = (bf16*)(p.ws + WS_AQ); E.DQ = (bf16*)(p.ws + WS_DQ); E.DK = (bf16*)(p.ws + WS_DK); E.DV = (bf16*)(p.ws + WS_DV);
    E.NQ = (bf16*)(p.ws + WS_NQ); E.NK = (bf16*)(p.ws + WS_NK); E.NV = (bf16*)(p.ws + WS_NV); E.KPE = (bf16*)(p.ws + WS_KPE);
    E.QBD = (float*)(p.ws + WS_QBD); E.QBN = (float*)(p.ws + WS_QBN); E.ROPE = (const float*)(p.ws + WS_ROPE);
    E.cqg = p.in[I_CQG] + l * 192; E.ckvg = p.in[I_CKVG] + l * 128; E.dqg = p.in[I_DQNG] + l * 32; E.dkg = p.in[I_DKNG] + l * 32; E.nqg = p.in[I_NQNG] + l * 64; E.nkg = p.in[I_NKNG] + l * 64;
    { float m = lane0 < 32 ? fabsf(p.in[I_DKNG][l * 32 + lane0]) : 0.f;
#pragma unroll
      for (int o = 1; o < 64; o <<= 1) m = fmaxf(m, lane_xor(m, lane0, o));
      float m2 = fabsf(p.in[I_NKNG][l * 64 + lane0]);
#pragma unroll
      for (int o = 1; o < 64; o <<= 1) m2 = fmaxf(m2, lane_xor(m2, lane0, o));
      float t0 = 5.656854249f * 1.004f * m, t1 = 8.f * 1.004f * m2, t2 = __int_as_float(((const int*)(p.ws + WS_CTL))[CW_BIASMAX + l]) * LOG2E + 0.05f;
      asm volatile("" : "+v"(t0), "+v"(t1), "+v"(t2));
      const int b0 = __builtin_amdgcn_readfirstlane(__float_as_int(t0)), b1 = __builtin_amdgcn_readfirstlane(__float_as_int(t1)), b2 = __builtin_amdgcn_readfirstlane(__float_as_int(t2));
      E.kbd = __int_as_float(b0); E.kbn = __int_as_float(b1); E.nbias = __int_as_float(b2); }
    E.P = (float*)(lds + 131072 + 4096); E.HS1 = (const float*)(p.ws + WS_HS1); E.WINS = (const float*)(p.ws + WS_WINS) + l * PLD;
    pg8::gemm_phase<EpiProjFused, SchedDense, false, true>(LDSP, D, D, S, E);
}
DI void ph_qkvraw_fast(PRef p, int l, unsigned char* lds) {
    const int bid_ = opq_bid(), nblk_ = opq_nblk(); const int lane0 = opq_tid() & 63;
    SchedDense S; S.init(p.ws + WS_AQ, 384, (const bf16*)(p.ws + WS_QKV_T) + (size_t)l * 1024 * 384, 384, T, 1024, nblk_, bid_);
    EpiQkvFused E; E.MQ = (bf16*)(p.ws + WS_MQ); E.MK = (bf16*)(p.ws + WS_MK); E.MV = (bf16*)(p.ws + WS_MV); E.KPE = (const bf16*)(p.ws + WS_KPE); E.QBM = (float*)(p.ws + WS_QBM);
    E.ROPE = (const float*)(p.ws + WS_ROPE); E.gq = p.in[I_QNG] + l * 96; E.gk = p.in[I_KNG] + l * 96; E.P = (float*)(lds + 131072 + 4096);
    { float mq = 0.f, mk = 0.f;
      for (int i = lane0; i < 96; i += 64) { mq = fmaxf(mq, fabsf(E.gq[i])); mk = fmaxf(mk, fabsf(E.gk[i])); }
#pragma unroll
      for (int o = 1; o < 64; o <<= 1) { mq = fmaxf(mq, lane_xor(mq, lane0, o)); mk = fmaxf(mk, lane_xor(mk, lane0, o)); }
      E.nbconst = __int_as_float(__builtin_amdgcn_readfirstlane(__float_as_int(-(96.f * 0.10206207261596577f * LOG2E * mq * mk * 1.004f + 0.05f)))); }
    pg8::gemm_phase<EpiQkvFused, SchedDense, false>(LDSP, 384, 384, S, E);
}
DI void ph_branch_fast(PRef p, int l, int nrows, unsigned char* lds) {
    const int bid_ = opq_bid(), nblk_ = opq_nblk();
    SchedBranch S; S.init(p.ws + WS_BI, (const bf16*)(p.ws + WS_WB_T) + (size_t)l * 4 * 1024 * 256, nrows, nblk_, bid_);
    EpiStoreBf16 E{(bf16*)(p.ws + WS_YB), 4096, 1024, nullptr, 0};
    pg8::gemm_phase<EpiStoreBf16, SchedBranch, false>(LDSP, D, 256, S, E);
}
DI void ph_merge_fast(PRef p, int l, int nrows, unsigned char* lds) {
    const int bid_ = opq_bid(), nblk_ = opq_nblk();
    SchedDense S; S.init(p.ws + WS_H, D / 2, (const bf16*)(p.ws + WS_GATE_T) + (size_t)l * 4096 * D, D / 2, nrows, 4096, nblk_, bid_);
    S.rev = true;
    EpiMerge E{(const bf16*)(p.ws + WS_YB), (bf16*)(p.ws + WS_YM), p.in[I_GATEB] + l * 4096, (const float*)(p.ws + WS_HS1), (const float*)(p.ws + WS_GATES) + l * 4096};
    pg8::gemm_phase<EpiMerge, SchedDense, false, true>(LDSP, D, D, S, E);
}
DI void ph_wo_fast(PRef p, int l, int nrows, unsigned char* lds) {
    const int bid_ = opq_bid(), nblk_ = opq_nblk();
    SchedDense S; S.init(p.ws + WS_YM, D, (const bf16*)(p.ws + WS_WO_T) + (size_t)l * D * D, D, nrows, D, nblk_, bid_);
    const float* XFc = (const float*)(p.ws + WS_XF);
    EpiWo E{l == 0 ? p.in[I_X] : XFc, l == 0 ? p.in[I_CTX] : XFc + (size_t)TL * D, (float*)(p.ws + WS_XF), (const float*)(p.ws + WS_MOD) + (size_t)l * 9 * 6144 + 2048};
    pg8::gemm_phase<EpiWo, SchedDense, false>(LDSP, D, D, S, E);
}
DI void moe_offsets(PRef p, int l, int* off, int tid) {
    const unsigned* cnt = (const unsigned*)(p.ws + WS_CTL) + CW_CNT + l * 64;
    if (tid == 0) expert_offsets(cnt, off);
    if (tid < NE) off[40 + tid] = (int)cnt[tid];
    __syncthreads();
}
DI void ph_moe1_fast(PRef p, int l, unsigned char* lds) {
    const int tid_ = opq_tid(); const int bid_ = opq_bid(), nblk_ = opq_nblk(); (void)bid_; (void)nblk_; int* off = (int*)(lds + 131072 + 1024); moe_offsets(p, l, off, tid_);
    SchedMoe S; S.A = (const char*)(p.ws + WS_H2); S.Bt = (const char*)((const bf16*)(p.ws + WS_WGU_T) + (size_t)l * NE * 2048 * D); S.rowtok = (const int*)(p.ws + WS_ROWTOK); S.off = off; S.cnt = off + 40;
    S.nN = 8; S.G = nblk_; S.c = bid_; S.ntiles = off[NE] >> 8; S.tstepA = 0; S.estepB = (size_t)2048 * D * 2  ; S.tstepB = (size_t)256 * D  ; S.gather = true;
    EpiMoeActI8 E{(bf16*)(p.ws + WS_ACT), p.in[I_BGU] + (size_t)l * NE * 2048, (const float*)(p.ws + WS_HS), (const float*)(p.ws + WS_WGUS) + (size_t)l * NE * 2048};
    pg8::gemm_phase<EpiMoeActI8, SchedMoe, true, true>(LDSP, D, D, S, E);
}
DI void ph_moe2_fast(PRef p, int l, unsigned char* lds) {
    const int tid_ = opq_tid(); const int bid_ = opq_bid(), nblk_ = opq_nblk(); (void)bid_; (void)nblk_; int* off = (int*)(lds + 131072 + 1024); moe_offsets(p, l, off, tid_);
    SchedMoe S; S.A = (const char*)(p.ws + WS_ACT); S.Bt = (const char*)((const bf16*)(p.ws + WS_WDN_T) + (size_t)l * NE * D * DFF); S.rowtok = (const int*)(p.ws + WS_ROWTOK); S.off = off; S.cnt = off + 40;
    S.nN = 4; S.G = nblk_; S.c = bid_; S.ntiles = off[NE] >> 8; S.tstepA = (size_t)256 * D * 2; S.estepB = (size_t)D * DFF * 2; S.tstepB = (size_t)256 * DFF * 2; S.gather = false;
    S.rev = true;
    EpiStoreBf16 E{(bf16*)(p.ws + WS_YE), D, 0, p.in[I_BDN] + (size_t)l * NE * D, D};
    pg8::gemm_phase<EpiStoreBf16, SchedMoe, false>(LDSP, DFF, DFF, S, E);
}

namespace fa {
using bf16x8 = __attribute__((ext_vector_type(8))) short;
using s16x4  = __attribute__((ext_vector_type(4))) short;
using f32x16 = __attribute__((ext_vector_type(16))) float;
using u32x4  = __attribute__((ext_vector_type(4))) unsigned;
constexpr int SHM_K = 64 * 256, SHM_V = 64 * 256;
constexpr float THR2 = 11.5f;
#define FA_KSWZ(row, colB) ((row) * 256 + ((colB) ^ (((row) & 7) << 4)))
#define FA_SBAR() __builtin_amdgcn_sched_barrier(0)
DI int crow(int r, int hi) { return (r & 3) + 8 * (r >> 2) + 4 * hi; }
DI unsigned cvtpk(float lo, float hi) { unsigned r; asm volatile("v_cvt_pk_bf16_f32 %0, %1, %2" : "=v"(r) : "v"(lo), "v"(hi)); return r; }
DI int v_st(int k, int c) { const int kk = k;        return ((kk >> 3) * 4 + (c >> 5)) * 512 + ((kk & 7) * 32 + (c & 31)) * 2; }
DI int v_rd_base(int lane) { return ((lane & 3) << 3) | (((lane >> 2) & 3) << 6) | (((lane >> 4) & 1) << 5) | (((lane >> 5) & 1) << 8); }
constexpr int v_rd_off(int d0, int ks, int half) { return d0 * 512 + ks * 4096 + half * 2048; }
template <int OFF> DI s16x4 tr_read(int vb) { s16x4 r; asm volatile("ds_read_b64_tr_b16 %0, %1 offset:%2" : "=&v"(r) : "v"(vb), "i"(OFF) : "memory"); return r; }
template <int D0> DI void pv_one(f32x16& od, int vb, bf16x8 pa0, bf16x8 pa1, bf16x8 pa2, bf16x8 pa3) {
  const s16x4 l0 = tr_read<v_rd_off(D0, 0, 0)>(vb), h0 = tr_read<v_rd_off(D0, 0, 1)>(vb), l1 = tr_read<v_rd_off(D0, 1, 0)>(vb), h1 = tr_read<v_rd_off(D0, 1, 1)>(vb);
  const s16x4 l2 = tr_read<v_rd_off(D0, 2, 0)>(vb), h2 = tr_read<v_rd_off(D0, 2, 1)>(vb), l3 = tr_read<v_rd_off(D0, 3, 0)>(vb), h3 = tr_read<v_rd_off(D0, 3, 1)>(vb);
  asm volatile("s_waitcnt lgkmcnt(0)" ::: "memory"); FA_SBAR();
#define FA_PK(L, H) (bf16x8){L[0], L[1], L[2], L[3], H[0], H[1], H[2], H[3]}
  od = __builtin_amdgcn_mfma_f32_32x32x16_bf16(pa0, FA_PK(l0, h0), od, 0, 0, 0);
  od = __builtin_amdgcn_mfma_f32_32x32x16_bf16(pa1, FA_PK(l1, h1), od, 0, 0, 0);
  od = __builtin_amdgcn_mfma_f32_32x32x16_bf16(pa2, FA_PK(l2, h2), od, 0, 0, 0);
  od = __builtin_amdgcn_mfma_f32_32x32x16_bf16(pa3, FA_PK(l3, h3), od, 0, 0, 0);
#undef FA_PK
}

}


DI void ph_ada_fast(PRef p, unsigned char* lds) {
  const int tid_ = opq_tid(); const int bid_ = opq_bid(), nblk_ = opq_nblk();
  float* MOD = (float*)(p.ws + WS_MOD);
  { float* ROPE = (float*)(p.ws + WS_ROPE);
    for (int idx = GTID; idx < SEQ * 16; idx += NTHR) { const int sq = idx >> 4, i = idx & 15; const float pos = (i < 8) ? (float)(sq >> 6) : (float)(sq & 63);
      const float inv = powf(10000.f, -(float)(2 * (i & 7)) / 16.f); const float th = pos * inv; ROPE[sq * 32 + i] = cosf(th); ROPE[sq * 32 + 16 + i] = sinf(th); } }
  if (bid_ == 0) { for (int k = tid_; k < 2 * NH * 15 * 31; k += 512) { const float v = fmaxf(p.in[I_RPB][k], 0.f); atomicMax((int*)(p.ws + WS_CTL) + CW_BIASMAX + k / (NH * 15 * 31), __float_as_int(v)); } }
  float* sc = (float*)lds;
  float* red = (float*)(lds + 40960);
  for (int k = tid_; k < 9 * D; k += 512) { const int i = k >> 10, kk = k & 1023; const float v = i < 8 ? p.in[I_C][i * D + kk] : p.in[I_CCTX][kk]; sc[k] = v * sigmoidf_(v); }
  __syncthreads();
  const int nn = tid_ & 63, kg = tid_ >> 6;
  for (int it = bid_; it < 2 * 96; it += nblk_) {
    const int l = it / 96, n0 = (it - l * 96) * 64;
    const float* W = p.in[I_ADAW] + (size_t)l * D * 6144 + n0 + nn;
    float acc[9];
#pragma unroll
    for (int i = 0; i < 9; ++i) acc[i] = 0.f;
#pragma unroll 8
    for (int k = kg * 128; k < kg * 128 + 128; ++k) { const float w = W[(size_t)k * 6144];
#pragma unroll
      for (int i = 0; i < 9; ++i) acc[i] += sc[i * D + k] * w; }
#pragma unroll
    for (int i = 0; i < 9; ++i) red[(kg * 9 + i) * 64 + nn] = acc[i];
    __syncthreads();
    for (int o = tid_; o < 9 * 64; o += 512) { const int i = o >> 6, n = o & 63; float s = 0.f;
#pragma unroll
      for (int g = 0; g < 8; ++g) s += red[(g * 9 + i) * 64 + n];
      MOD[((size_t)l * 9 + i) * 6144 + n0 + n] = s + p.in[I_ADAB][l * 6144 + n0 + n]; }
    __syncthreads();
  }
}


DI void ld32(const bf16* __restrict__ src, float (&x)[32]) {
#pragma unroll
  for (int q = 0; q < 4; ++q) { const uint4 u = *(const uint4*)(src + 8 * q); const unsigned w[4] = {u.x, u.y, u.z, u.w};
#pragma unroll
    for (int i = 0; i < 4; ++i) { x[8 * q + 2 * i] = __uint_as_float(w[i] << 16); x[8 * q + 2 * i + 1] = __uint_as_float(w[i] & 0xffff0000u); } }
}
DI void st32(bf16* __restrict__ dst, const float (&x)[32]) {
#pragma unroll
  for (int q = 0; q < 4; ++q) { uint4 u; u.x = cvt_pk_bf16_(x[8 * q], x[8 * q + 1]); u.y = cvt_pk_bf16_(x[8 * q + 2], x[8 * q + 3]); u.z = cvt_pk_bf16_(x[8 * q + 4], x[8 * q + 5]); u.w = cvt_pk_bf16_(x[8 * q + 6], x[8 * q + 7]); *(uint4*)(dst + 8 * q) = u; }
}


DI void ph_diffcombine_fast(PRef p, int l, int nrows, float lam_init) {
  const int tid_ = opq_tid(); const int bid_ = opq_bid(), nblk_ = opq_nblk();
  const int lane = tid_ & 63, gw = GTID >> 6, ngw = NTHR >> 6;
  const bf16* __restrict__ DO_ = (const bf16*)(p.ws + WS_DO); bf16* __restrict__ BI = (bf16*)(p.ws + WS_BI);
  const float* lv = p.in[I_DLAM] + l * 128;
  const float t1 = seg_sum(lane < 32 ? lv[lane] * lv[32 + lane] : 0.f, lane, 64), t2 = seg_sum(lane < 32 ? lv[64 + lane] * lv[96 + lane] : 0.f, lane, 64);
  const float lam = expf(t1) - expf(t2) + lam_init;
  const int h = lane >> 4, d = 4 * (lane & 15);
  float g[4];
#pragma unroll
  for (int i = 0; i < 4; ++i) g[i] = p.in[I_DSUBG][l * 64 + d + i] * (1.f - lam_init);
#pragma unroll 4
  for (int r = gw; r < nrows; r += ngw) {
    float a[4], b[4], v[4]; ld4(DO_ + (size_t)r * 512 + (2 * h) * 64 + d, a); ld4(DO_ + (size_t)r * 512 + (2 * h + 1) * 64 + d, b);
#pragma unroll
    for (int i = 0; i < 4; ++i) v[i] = a[i] - lam * b[i];
    const float ss = seg_sum(v[0] * v[0] + v[1] * v[1] + v[2] * v[2] + v[3] * v[3], lane, 16); const float rs = rsqrtf(ss * (1.f / 64.f) + EPS);
#pragma unroll
    for (int i = 0; i < 4; ++i) v[i] = v[i] * rs * g[i];
    st4(BI + (size_t)r * D + 512 + h * 64 + d, v);
  }
}

DI void ph_mod2_router_fast(PRef p, int l, int nrows, unsigned char* lds) {
  const int tid_ = opq_tid(); const int bid_ = opq_bid(), nblk_ = opq_nblk();
  const int lane = tid_ & 63, wave = tid_ >> 6;
  float* rwT = (float*)lds;
  unsigned* lcnt = (unsigned*)(lds + 131072 + 2048);
  int* rbuf = (int*)(lds + 131072 + 4096);
  const float* rw = p.in[I_RW] + (size_t)l * D * NE;
  for (int q = tid_; q < D * NE / 4; q += 512) { const float4 v = *(const float4*)(rw + (size_t)q * 4); const int c = q >> 3, e = (q & 7) * 4;
    rwT[(e + 0) * D + c] = v.x; rwT[(e + 1) * D + c] = v.y; rwT[(e + 2) * D + c] = v.z; rwT[(e + 3) * D + c] = v.w; }
  if (tid_ < 64) lcnt[tid_] = 0u;
  __syncthreads();
  const float* MOD = (const float*)(p.ws + WS_MOD); const float* XF = (const float*)(p.ws + WS_XF);
  bf16* H2 = (bf16*)(p.ws + WS_H2); float* HS = (float*)(p.ws + WS_HS); const float* g = p.in[I_N2G] + l * D; const float* rb = p.in[I_RB] + l * NE;
  int* ROUTE = (int*)(p.ws + WS_ROUTE); unsigned* cnt = (unsigned*)(p.ws + WS_CTL) + CW_CNT + l * 64; int* ROWTOK = (int*)(p.ws + WS_ROWTOK);
  const int per = (nrows + nblk_ - 1) / nblk_, rlo = bid_ * per, rhi = min(rlo + per, nrows);
  float4 cx0, cx1, cx2, cx3;
  { const int r = min(rlo + wave, nrows - 1); const float* x = XF + (size_t)r * D + lane * 4; cx0 = *(const float4*)(x); cx1 = *(const float4*)(x + 256); cx2 = *(const float4*)(x + 512); cx3 = *(const float4*)(x + 768); }
  for (int r = rlo + wave; r < rhi; r += 8) {
    float4 nx0, nx1, nx2, nx3;
    { const int rn = min(r + 8, nrows - 1); const float* x = XF + (size_t)rn * D + lane * 4; nx0 = *(const float4*)(x); nx1 = *(const float4*)(x + 256); nx2 = *(const float4*)(x + 512); nx3 = *(const float4*)(x + 768); }
    float v[16]; float ss = 0.f;
    { const float4 t4[4] = {cx0, cx1, cx2, cx3};
#pragma unroll
    for (int j = 0; j < 4; ++j) { const float4 t = t4[j]; v[4 * j] = t.x; v[4 * j + 1] = t.y; v[4 * j + 2] = t.z; v[4 * j + 3] = t.w; ss += t.x * t.x + t.y * t.y + t.z * t.z + t.w * t.w; } }
    cx0 = nx0; cx1 = nx1; cx2 = nx2; cx3 = nx3;
    ss = seg_sum(ss, lane, 64);
    const float rstd = rsqrtf(ss * (1.f / D) + EPS);
    const float* md = MOD + ((size_t)l * 9 + modidx(r)) * 6144;
#pragma unroll
    for (int j = 0; j < 4; ++j) { const int c = j * 256 + lane * 4; const float4 gg = *(const float4*)(g + c), s4 = *(const float4*)(md + 4 * 1024 + c), h4 = *(const float4*)(md + 3 * 1024 + c);
      v[4 * j] = v[4 * j] * rstd * gg.x * (1.f + s4.x) + h4.x; v[4 * j + 1] = v[4 * j + 1] * rstd * gg.y * (1.f + s4.y) + h4.y;
      v[4 * j + 2] = v[4 * j + 2] * rstd * gg.z * (1.f + s4.z) + h4.z; v[4 * j + 3] = v[4 * j + 3] * rstd * gg.w * (1.f + s4.w) + h4.w;
      }
    { float mx = 0.f;
#pragma unroll
      for (int i = 0; i < 16; ++i) mx = fmaxf(mx, fabsf(v[i]));
#pragma unroll
      for (int o = 1; o < 64; o <<= 1) mx = fmaxf(mx, lane_xor(mx, lane, o));
      const float sc = mx > 0.f ? mx * (1.f / 127.f) : 1.f, inv = 1.f / sc; if (lane == 0) HS[r] = sc;
#pragma unroll
      for (int j = 0; j < 4; ++j) { unsigned b = 0;
#pragma unroll
        for (int i = 0; i < 4; ++i) b |= ((unsigned)(int)rintf(v[4 * j + i] * inv) & 255u) << (8 * i);
        *(unsigned*)((signed char*)H2 + (size_t)r * D + j * 256 + lane * 4) = b; } }
    float lg[NE];
#pragma unroll
    for (int e = 0; e < NE; ++e) { float s = 0.f;
#pragma unroll
      for (int j = 0; j < 4; ++j) { const float4 w = *(const float4*)(rwT + e * D + j * 256 + lane * 4); s += v[4 * j] * w.x + v[4 * j + 1] * w.y + v[4 * j + 2] * w.z + v[4 * j + 3] * w.w; }
      lg[e] = s; }
#pragma unroll
    for (int e = 0; e < NE; ++e) lg[e] = seg_sum(lg[e], lane, 64) + rb[e];
    int te[4]; float tv[4];
#pragma unroll
    for (int k = 0; k < 4; ++k) { float best = -3.4e38f; int bi = 0;
#pragma unroll
      for (int e = 0; e < NE; ++e) { const bool taken = (k > 0 && te[0] == e) || (k > 1 && te[1] == e) || (k > 2 && te[2] == e); if (!taken && lg[e] > best) { best = lg[e]; bi = e; } }
      te[k] = bi; tv[k] = best; }
    const float mx = tv[0]; float ex[4], se = 0.f;
#pragma unroll
    for (int k = 0; k < 4; ++k) { ex[k] = expf(tv[k] - mx); se += ex[k]; }
    if (lane == 0) { int* rt = rbuf + (r - rlo) * 12;
#pragma unroll
      for (int k = 0; k < 4; ++k) { rt[3 * k] = te[k]; rt[3 * k + 1] = (int)atomicAdd(&lcnt[te[k]], 1u); rt[3 * k + 2] = __float_as_int(ex[k] / se); } }
  }
  __syncthreads();
  if (tid_ < NE) lcnt[32 + tid_] = lcnt[tid_] ? atomicAdd(&cnt[tid_], lcnt[tid_]) : 0u;
  __syncthreads();
  for (int q = tid_; q < (rhi - rlo) * 4; q += 512) { const int lr = q >> 2, k = q & 3; const int* rt = rbuf + lr * 12 + 3 * k; int* o = ROUTE + ((size_t)(rlo + lr) * 4 + k) * 4;
    const int pos = rt[1] + (int)lcnt[32 + rt[0]];
    o[0] = rt[0]; o[1] = pos; o[2] = rt[2]; o[3] = 0; ROWTOK[(size_t)rt[0] * T + pos] = rlo + lr; }
}


namespace fa {
DI void expcvt(f32x16& p0, f32x16& p1, bf16x8& pa0, bf16x8& pa1, bf16x8& pa2, bf16x8& pa3) {
#pragma unroll
  for (int r = 0; r < 16; ++r) p0[r] = __builtin_amdgcn_exp2f(p0[r]);
#pragma unroll
  for (int r = 0; r < 16; ++r) p1[r] = __builtin_amdgcn_exp2f(p1[r]);
#define FA_PK4(P, BASE, OUT) do { unsigned a0 = cvtpk(P[BASE + 0], P[BASE + 1]), a1 = cvtpk(P[BASE + 2], P[BASE + 3]);   \
    unsigned b0 = cvtpk(P[BASE + 4], P[BASE + 5]), b1 = cvtpk(P[BASE + 6], P[BASE + 7]);                              \
    u32x4 w = {a0, a1, b0, b1}; OUT = *reinterpret_cast<bf16x8*>(&w); } while (0)
  FA_PK4(p0, 0, pa0); FA_PK4(p0, 8, pa1); FA_PK4(p1, 0, pa2); FA_PK4(p1, 8, pa3);
#undef FA_PK4
}
template <int ND0, int KST = 0>
DI void qkt2(f32x16& p0, f32x16& p1, const char* Ks, const bf16x8* qr, const f32x16& nbt, int r32, int hi) {
#pragma unroll
  for (int d0 = 0; d0 < ND0; ++d0) { const int cb = (d0 * 16 + hi * 8) * 2;
    bf16x8 b0 = *reinterpret_cast<const bf16x8*>(Ks + (KST ? r32 * KST + cb : FA_KSWZ(r32, cb)));
    bf16x8 b1 = *reinterpret_cast<const bf16x8*>(Ks + (KST ? (32 + r32) * KST + cb : FA_KSWZ(32 + r32, cb)));
    p0 = __builtin_amdgcn_mfma_f32_32x32x16_bf16(b0, qr[d0], d0 == 0 ? nbt : p0, 0, 0, 0);
    p1 = __builtin_amdgcn_mfma_f32_32x32x16_bf16(b1, qr[d0], d0 == 0 ? nbt : p1, 0, 0, 0); }
}
DI void pv3(f32x16* o, int vb, bf16x8 pa0, bf16x8 pa1, bf16x8 pa2, bf16x8 pa3) { pv_one<0>(o[0], vb, pa0, pa1, pa2, pa3); pv_one<1>(o[1], vb, pa0, pa1, pa2, pa3); pv_one<2>(o[2], vb, pa0, pa1, pa2, pa3); }
DI void fill_ones(char* V_lds, int tid) {
  const int b = tid >> 8, t = tid & 255, key = t >> 2, c8 = (t & 3) * 8;
  u32x4 w = {c8 == 0 ? 0x00003F80u : 0u, 0u, 0u, 0u};
  *(u32x4*)(V_lds + b * SHM_V + v_st(key, 64 + c8)) = w;
}
template <int DQK>
DI void attn_unit2(const bf16* __restrict__ Qb, int ldq, const bf16* __restrict__ Kh, int ldk, const bf16* __restrict__ Vh, const float* __restrict__ nbp, int nbs, int kva, int kvb, int NT,
                   bf16* __restrict__ Ob, int ldo, char* lds, int tid) {
  constexpr int ND0 = DQK / 16;
  const int wid = tid >> 6, lane = tid & 63, r32 = lane & 31, hi = lane >> 5;
  char* V_lds = lds; char* K_lds = lds + 2 * SHM_V;
  f32x16 o[3] = {}; bf16x8 qr[ND0];
  const bf16* Qw = Qb + (long)(wid * 32 + r32) * ldq + hi * 8;
#pragma unroll
  for (int d0 = 0; d0 < ND0; ++d0) qr[d0] = *reinterpret_cast<const bf16x8*>(Qw + d0 * 16);
  const float nb = nbp[(long)(wid * 32 + r32) * nbs];
  f32x16 nbt;
#pragma unroll
  for (int r = 0; r < 16; ++r) nbt[r] = nb;
  const int sr = tid >> 4, sc = (tid & 15) * 8; const bool kact = sc < DQK, vact = sc < 64;
  const int vst0 = v_st(sr, sc & 63), vst1 = v_st(32 + sr, sc & 63);
  const int vb0 = (int)(uintptr_t)V_lds + v_rd_base(lane);
  struct { bf16x8 vs0, vs1, ks0, ks1; } sr_[2];
#define FA_KROW(j) ((j) < 4 ? kva + 64 * (j) : kvb + 64 * ((j) - 4))
#define FA_SLOAD(i, j) do { const long kr_ = FA_KROW(j); \
    if (vact) { sr_[i].vs0 = *reinterpret_cast<const bf16x8*>(&Vh[(kr_ + sr) * 256 + sc]); sr_[i].vs1 = *reinterpret_cast<const bf16x8*>(&Vh[(kr_ + 32 + sr) * 256 + sc]); } \
    if (kact) { sr_[i].ks0 = *reinterpret_cast<const bf16x8*>(&Kh[(kr_ + sr) * ldk + sc]); sr_[i].ks1 = *reinterpret_cast<const bf16x8*>(&Kh[(kr_ + 32 + sr) * ldk + sc]); } } while (0)
#define FA_SWRITE(b, i) do { if (vact) { *(bf16x8*)(V_lds + (b) * SHM_V + vst0) = sr_[i].vs0; *(bf16x8*)(V_lds + (b) * SHM_V + vst1) = sr_[i].vs1; } \
    if (kact) { const int kc = sc * 2; *(bf16x8*)(K_lds + (b) * SHM_K + FA_KSWZ(sr, kc)) = sr_[i].ks0; *(bf16x8*)(K_lds + (b) * SHM_K + FA_KSWZ(32 + sr, kc)) = sr_[i].ks1; } } while (0)
  f32x16 pA0, pA1, pB0, pB1; bf16x8 pa0, pa1, pa2, pa3;
  FA_SLOAD(0, 0); asm volatile("s_waitcnt vmcnt(0)" ::: "memory"); FA_SWRITE(0, 0); __syncthreads();
  qkt2<ND0>(pA0, pA1, K_lds, qr, nbt, r32, hi);
  FA_SLOAD(1, 1); if (2 < NT) FA_SLOAD(0, 2);
  FA_SWRITE(1, 1); __syncthreads();
  for (int j = 1; j + 1 < NT; j += 2) {
    FA_SBAR(); qkt2<ND0>(pB0, pB1, K_lds + SHM_K, qr, nbt, r32, hi);
    expcvt(pA0, pA1, pa0, pa1, pa2, pa3); FA_SBAR();
    FA_SLOAD(1, j + 2); FA_SBAR();
    pv3(o, vb0, pa0, pa1, pa2, pa3);
    __syncthreads(); FA_SWRITE(0, 0); __syncthreads();
    FA_SBAR(); qkt2<ND0>(pA0, pA1, K_lds, qr, nbt, r32, hi);
    expcvt(pB0, pB1, pa0, pa1, pa2, pa3); FA_SBAR();
    if (j + 3 < NT) FA_SLOAD(0, j + 3); FA_SBAR();
    pv3(o, vb0 + SHM_V, pa0, pa1, pa2, pa3);
    __syncthreads(); FA_SWRITE(1, 1); __syncthreads();
  }
  FA_SBAR(); qkt2<ND0>(pB0, pB1, K_lds + SHM_K, qr, nbt, r32, hi);
  expcvt(pA0, pA1, pa0, pa1, pa2, pa3); FA_SBAR();
  pv3(o, vb0, pa0, pa1, pa2, pa3);
  expcvt(pB0, pB1, pa0, pa1, pa2, pa3); FA_SBAR();
  pv3(o, vb0 + SHM_V, pa0, pa1, pa2, pa3);
  bf16* Ow = Ob + (long)(wid * 32) * ldo;
#pragma unroll
  for (int r = 0; r < 16; ++r) { const int orow = crow(r, hi);
    const float lsum = __int_as_float(__builtin_amdgcn_ds_bpermute((hi * 32) << 2, __float_as_int(o[2][r]))); const float rl = __builtin_amdgcn_rcpf(lsum);
#pragma unroll
    for (int d0 = 0; d0 < 2; ++d0) Ow[(long)orow * ldo + d0 * 32 + r32] = f2bf(o[d0][r] * rl); }
  __syncthreads();
#undef FA_KROW
#undef FA_SLOAD
#undef FA_SWRITE
}
typedef float f32x2v __attribute__((ext_vector_type(2)));
typedef __bf16 bf16x2v __attribute__((ext_vector_type(2)));
DI unsigned cvtpk_b(float lo, float hi) { f32x2v v = {lo, hi}; bf16x2v b = __builtin_convertvector(v, bf16x2v); return __builtin_bit_cast(unsigned, b); }
DI void expcvt_b(f32x16& p0, f32x16& p1, bf16x8& pa0, bf16x8& pa1, bf16x8& pa2, bf16x8& pa3) {
#pragma unroll
  for (int r = 0; r < 16; ++r) p0[r] = __builtin_amdgcn_exp2f(p0[r]);
#pragma unroll
  for (int r = 0; r < 16; ++r) p1[r] = __builtin_amdgcn_exp2f(p1[r]);
#define FA_PK4(P, BASE, OUT) do { u32x4 w = {cvtpk_b(P[BASE + 0], P[BASE + 1]), cvtpk_b(P[BASE + 2], P[BASE + 3]), cvtpk_b(P[BASE + 4], P[BASE + 5]), cvtpk_b(P[BASE + 6], P[BASE + 7])}; \
    OUT = *reinterpret_cast<bf16x8*>(&w); } while (0)
  FA_PK4(p0, 0, pa0); FA_PK4(p0, 8, pa1); FA_PK4(p1, 0, pa2); FA_PK4(p1, 8, pa3);
#undef FA_PK4
}
template <int NM> DI void step_pipeline() {
  __builtin_amdgcn_sched_group_barrier(0x100, 4, 0);
#pragma unroll
  for (int i = 0; i < NM; ++i) {
    __builtin_amdgcn_sched_group_barrier(0x008, 1, 0);
    __builtin_amdgcn_sched_group_barrier(0x400, 2, 0);
    __builtin_amdgcn_sched_group_barrier(0x002, 2, 0);
    __builtin_amdgcn_sched_group_barrier(0x100, 2, 0);
  }
}
template <int OFF> DI s16x4 tr_rd(int vb) { return __builtin_amdgcn_ds_read_tr16_b64_v4i16((__attribute__((address_space(3))) s16x4*)(vb + OFF)); }
template <int D0> DI void pv_one_b(f32x16& od, int vb, bf16x8 pa0, bf16x8 pa1, bf16x8 pa2, bf16x8 pa3) {
  const s16x4 l0 = tr_rd<v_rd_off(D0, 0, 0)>(vb), h0 = tr_rd<v_rd_off(D0, 0, 1)>(vb), l1 = tr_rd<v_rd_off(D0, 1, 0)>(vb), h1 = tr_rd<v_rd_off(D0, 1, 1)>(vb);
  const s16x4 l2 = tr_rd<v_rd_off(D0, 2, 0)>(vb), h2 = tr_rd<v_rd_off(D0, 2, 1)>(vb), l3 = tr_rd<v_rd_off(D0, 3, 0)>(vb), h3 = tr_rd<v_rd_off(D0, 3, 1)>(vb);
#define FA_PK(L, H) (bf16x8){L[0], L[1], L[2], L[3], H[0], H[1], H[2], H[3]}
  od = __builtin_amdgcn_mfma_f32_32x32x16_bf16(pa0, FA_PK(l0, h0), od, 0, 0, 0);
  od = __builtin_amdgcn_mfma_f32_32x32x16_bf16(pa1, FA_PK(l1, h1), od, 0, 0, 0);
  od = __builtin_amdgcn_mfma_f32_32x32x16_bf16(pa2, FA_PK(l2, h2), od, 0, 0, 0);
  od = __builtin_amdgcn_mfma_f32_32x32x16_bf16(pa3, FA_PK(l3, h3), od, 0, 0, 0);
#undef FA_PK
}
DI void pv3b(f32x16* o, int vb, bf16x8 pa0, bf16x8 pa1, bf16x8 pa2, bf16x8 pa3, bf16x8 onesB) { pv_one_b<0>(o[0], vb, pa0, pa1, pa2, pa3); pv_one_b<1>(o[1], vb, pa0, pa1, pa2, pa3);
  o[2] = __builtin_amdgcn_mfma_f32_32x32x16_bf16(pa0, onesB, o[2], 0, 0, 0); o[2] = __builtin_amdgcn_mfma_f32_32x32x16_bf16(pa1, onesB, o[2], 0, 0, 0);
  o[2] = __builtin_amdgcn_mfma_f32_32x32x16_bf16(pa2, onesB, o[2], 0, 0, 0); o[2] = __builtin_amdgcn_mfma_f32_32x32x16_bf16(pa3, onesB, o[2], 0, 0, 0); }
#ifndef FS_SPREAD
#define FS_SPREAD 1
#endif
#ifndef FS_AH
#define FS_AH 2
#endif
template <int NM> constexpr int fs_ec(int s) { const int e = (FS_SPREAD && NM >= 24) ? s + (s + 2) / 3 : 2 * s; return e < 32 ? e : 32; }
template <int NM> constexpr int fs_cc(int s) { const int c = s >= 1 ? fs_ec<NM>(s - 1) / 2 : 0; return c < 16 ? c : 16; }
DI s16x4 tr_rd2(int vb, int off) { return __builtin_amdgcn_ds_read_tr16_b64_v4i16((__attribute__((address_space(3))) s16x4*)(vb + off)); }
template <int ND0, int WI, int KST = 0>
DI void fused_step(f32x16& pn0, f32x16& pn1, f32x16& pc0, f32x16& pc1, bf16x8& an0, bf16x8& an1, bf16x8& an2, bf16x8& an3, bf16x8 ac0, bf16x8 ac1, bf16x8 ac2, bf16x8 ac3,
                   f32x16* o, const char* Ks, int vb, const bf16x8* qr, const f32x16& nbt, int r32, int hi, bf16x8 onesB) {
  constexpr int NQ = 2 * ND0, NM = NQ + 12, AH = FS_AH;
  bf16x8 kf[NQ]; s16x4 vl[8], vh[8]; unsigned w[16];
  bf16x8 kz_; s16x4 vz_; if (WI & (4 | 16 | 32)) { asm volatile("v_mov_b32 %0, 0" : "=v"(vz_[0])); u32x4 z4_ = {0u, 0u, 0u, 0u}; asm volatile("" : "+v"(z4_)); kz_ = *reinterpret_cast<bf16x8*>(&z4_); vz_ = (s16x4){0, 0, 0, 0}; asm volatile("" : "+v"(vz_)); }
#define FS_ISSUE(m) do { if ((WI & 4) || ((WI & 16) && (m) < NQ) || ((WI & 32) && (m) >= NQ)) { if ((m) < NQ) kf[(m) < NQ ? (m) : 0] = kz_; else if ((m) - NQ < 8) { const int q_ = (m) - NQ; vl[q_ >= 0 ? q_ : 0] = vz_; vh[q_ >= 0 ? q_ : 0] = vz_; } } else if ((m) < NQ) { kf[(m) < NQ ? (m) : 0] = *reinterpret_cast<const bf16x8*>(Ks + (KST ? (((m) & 1) * 32 + r32) * KST + ((((m) >> 1) * 16 + hi * 8) * 2) : FA_KSWZ(((m) & 1) * 32 + r32, ((((m) >> 1) * 16 + hi * 8) * 2)))); } \
    else if ((m) - NQ < 8) { const int q_ = (m) - NQ; vl[q_ >= 0 ? q_ : 0] = tr_rd2(vb, v_rd_off(q_ >> 2, q_ & 3, 0)); vh[q_ >= 0 ? q_ : 0] = tr_rd2(vb, v_rd_off(q_ >> 2, q_ & 3, 1)); } } while (0)
#define FS_PC(v) ((v) < 16 ? pc0[(v) & 15] : pc1[(v) & 15])
#pragma unroll
  for (int m = 0; m < AH; ++m) FS_ISSUE(m);
#pragma unroll
  for (int s_ = 0; s_ < NM; ++s_) {
    if (s_ + AH < NM) FS_ISSUE(s_ + AH);
    if (s_ < NQ) { const int d0 = s_ >> 1;
      if ((s_ & 1) == 0) pn0 = __builtin_amdgcn_mfma_f32_32x32x16_bf16(kf[s_ < NQ ? s_ : 0], qr[d0 < ND0 ? d0 : 0], d0 == 0 ? nbt : pn0, 0, 0, 0);
      else pn1 = __builtin_amdgcn_mfma_f32_32x32x16_bf16(kf[s_ < NQ ? s_ : 0], qr[d0 < ND0 ? d0 : 0], d0 == 0 ? nbt : pn1, 0, 0, 0);
    } else { const int q = s_ - NQ, blk = q >> 2, ks = q & 3; const int qi = (q >= 0 && q < 8) ? q : 0; const s16x4 L = vl[qi], H = vh[qi];
      const bf16x8 B = blk == 2 ? onesB : (bf16x8){L[0], L[1], L[2], L[3], H[0], H[1], H[2], H[3]};       const bf16x8 A = ks == 0 ? ac0 : (ks == 1 ? ac1 : (ks == 2 ? ac2 : ac3));
      o[blk >= 0 ? blk : 0] = __builtin_amdgcn_mfma_f32_32x32x16_bf16(A, B, o[blk >= 0 ? blk : 0], 0, 0, 0); }
#pragma unroll
    for (int v = fs_ec<NM>(s_); v < ((WI & 2) ? 0 : fs_ec<NM>(s_ + 1)); ++v) { float e0 = FS_PC(v); asm volatile("" : "+v"(e0)); e0 = __builtin_amdgcn_exp2f(e0); asm volatile("" : "+v"(e0));
      if (v < 16) pc0[v & 15] = e0; else pc1[v & 15] = e0; }
#pragma unroll
    for (int k = fs_cc<NM>(s_); k < ((WI & 2) ? 0 : fs_cc<NM>(s_ + 1)); ++k) { unsigned wk = cvtpk_b(FS_PC(2 * k), FS_PC(2 * k + 1)); asm volatile("" : "+v"(wk)); w[k & 15] = wk; }
    FA_SBAR();
  }
#pragma unroll
  for (int k = fs_cc<NM>(NM); k < ((WI & 2) ? 0 : 16); ++k) w[k] = cvtpk_b(FS_PC(2 * k), FS_PC(2 * k + 1));
  if (WI & 2) { an0 = ac0; an1 = ac1; an2 = ac2; an3 = ac3; } else
  { u32x4 t0 = {w[0], w[1], w[2], w[3]}, t1 = {w[4], w[5], w[6], w[7]}, t2 = {w[8], w[9], w[10], w[11]}, t3 = {w[12], w[13], w[14], w[15]};
    an0 = *reinterpret_cast<bf16x8*>(&t0); an1 = *reinterpret_cast<bf16x8*>(&t1); an2 = *reinterpret_cast<bf16x8*>(&t2); an3 = *reinterpret_cast<bf16x8*>(&t3); }
#undef FS_ISSUE
#undef FS_PC
}
template <int DQK, int WI>
DI void attn_unit3(const bf16* __restrict__ Qb, int ldq, const bf16* __restrict__ Kh, int ldk, const bf16* __restrict__ Vh, const float* __restrict__ nbp, int nbs, int kva, int kvb, int NT,
                   bf16* __restrict__ Ob, int ldo, char* lds, int tid) {
  constexpr int ND0 = DQK / 16;
  const int wid = tid >> 6, lane = tid & 63, r32 = lane & 31, hi = lane >> 5;
  char* V_lds = lds; char* K_lds = lds + 2 * SHM_V;
  f32x16 o[3] = {}; bf16x8 qr[ND0];
  const bf16* Qw = Qb + (long)(wid * 32 + r32) * ldq + hi * 8;
#pragma unroll
  for (int d0 = 0; d0 < ND0; ++d0) qr[d0] = *reinterpret_cast<const bf16x8*>(Qw + d0 * 16);
  const float nb = nbp[(long)(wid * 32 + r32) * nbs];
  f32x16 nbt;
#pragma unroll
  for (int r = 0; r < 16; ++r) nbt[r] = nb;
  const int sr = tid >> 4, sc = (tid & 15) * 8; const bool kact = sc < DQK, vact = sc < 64;
  const int vst0 = v_st(sr, sc & 63), vst1 = v_st(32 + sr, sc & 63);
  const int vb0 = (int)(uintptr_t)V_lds + v_rd_base(lane);
  bf16x8 vs0, vs1, ks0, ks1;
#define FA_KROW(j) ((j) < 4 ? kva + 64 * (j) : kvb + 64 * ((j) - 4))
#define FA_LOADK(j) do { if (kact) { const long kr_ = FA_KROW(j); ks0 = *reinterpret_cast<const bf16x8*>(&Kh[(kr_ + sr) * ldk + sc]); ks1 = *reinterpret_cast<const bf16x8*>(&Kh[(kr_ + 32 + sr) * ldk + sc]); } } while (0)
#define FA_LOADV(j) do { if (vact) { const long kr_ = FA_KROW(j); vs0 = *reinterpret_cast<const bf16x8*>(&Vh[(kr_ + sr) * 256 + sc]); vs1 = *reinterpret_cast<const bf16x8*>(&Vh[(kr_ + 32 + sr) * 256 + sc]); } } while (0)
#define FA_WRITEK(b) do { if (kact) { const int kc = sc * 2; *(bf16x8*)(K_lds + (b) * SHM_K + FA_KSWZ(sr, kc)) = ks0; *(bf16x8*)(K_lds + (b) * SHM_K + FA_KSWZ(32 + sr, kc)) = ks1; } } while (0)
#define FA_WRITEV(b) do { if (vact) { *(bf16x8*)(V_lds + (b) * SHM_V + vst0) = vs0; *(bf16x8*)(V_lds + (b) * SHM_V + vst1) = vs1; } } while (0)
  f32x16 pE0, pE1, pO0, pO1; bf16x8 ae0, ae1, ae2, ae3, ao0, ao1, ao2, ao3;
  bf16x8 onesB; { const unsigned ov = r32 == 0 ? 0x3F803F80u : 0u; u32x4 t = {ov, ov, ov, ov}; onesB = *reinterpret_cast<bf16x8*>(&t); }
  FA_LOADK(0); asm volatile("s_waitcnt vmcnt(0)" ::: "memory"); FA_WRITEK(0); __syncthreads();
  FA_LOADK(1);
  qkt2<ND0>(pE0, pE1, K_lds, qr, nbt, r32, hi);
  __syncthreads(); FA_WRITEK(1); __syncthreads(); FA_LOADK(2); FA_LOADV(0);
  FA_SBAR(); qkt2<ND0>(pO0, pO1, K_lds + SHM_K, qr, nbt, r32, hi); expcvt(pE0, pE1, ae0, ae1, ae2, ae3); FA_SBAR();
  __syncthreads(); FA_WRITEK(0); FA_WRITEV(0); __syncthreads(); if (3 < NT) FA_LOADK(3); FA_LOADV(1);
#define FA_SY() do { if (!(WI & 1)) __syncthreads(); } while (0)
#define FA_IO(x) do { if (!(WI & 8)) { x; } } while (0)
  for (int j = 1; j + 2 < NT; j += 2) {
    FA_SBAR(); asm volatile("" : "+v"(pO0), "+v"(pO1));
    fused_step<ND0, WI>(pE0, pE1, pO0, pO1, ao0, ao1, ao2, ao3, ae0, ae1, ae2, ae3, o, K_lds, vb0, qr, nbt, r32, hi, onesB);
    FA_SY(); FA_IO(FA_WRITEK(1); FA_WRITEV(1)); FA_SY(); FA_IO(if (j + 3 < NT) FA_LOADK(j + 3); FA_LOADV(j + 1));
    FA_SBAR(); asm volatile("" : "+v"(pE0), "+v"(pE1));
    fused_step<ND0, WI>(pO0, pO1, pE0, pE1, ae0, ae1, ae2, ae3, ao0, ao1, ao2, ao3, o, K_lds + SHM_K, vb0 + SHM_V, qr, nbt, r32, hi, onesB);
    FA_SY(); FA_IO(if (j + 3 < NT) FA_WRITEK(0); FA_WRITEV(0)); FA_SY(); FA_IO(if (j + 4 < NT) FA_LOADK(j + 4); if (j + 2 < NT) FA_LOADV(j + 2));
  }
#undef FA_SY
#undef FA_IO
  FA_SBAR(); expcvt(pO0, pO1, ao0, ao1, ao2, ao3); pv3b(o, vb0, ae0, ae1, ae2, ae3, onesB); FA_SBAR();
  __syncthreads(); FA_WRITEV(1); __syncthreads();
  pv3b(o, vb0 + SHM_V, ao0, ao1, ao2, ao3, onesB);
  bf16* Ow = Ob + (long)(wid * 32) * ldo;
#pragma unroll
  for (int r = 0; r < 16; ++r) { const int orow = crow(r, hi);
    const float lsum = __int_as_float(__builtin_amdgcn_ds_bpermute((hi * 32) << 2, __float_as_int(o[2][r]))); const float rl = __builtin_amdgcn_rcpf(lsum);
#pragma unroll
    for (int d0 = 0; d0 < 2; ++d0) Ow[(long)orow * ldo + d0 * 32 + r32] = f2bf(o[d0][r] * rl); }
  __syncthreads();
#undef FA_KROW
#undef FA_LOADK
#undef FA_LOADV
#undef FA_WRITEK
#undef FA_WRITEV
}
template <int DQK>
DI void attn_unit4(const bf16* __restrict__ Qb, int ldq, const bf16* __restrict__ Kh, int ldk, const bf16* __restrict__ Vh, const float* __restrict__ nbp, int nbs, int kva, int kvb, int NT,
                   bf16* __restrict__ Ob, int ldo, char* lds, int tid, bool prefetched, const bf16* Knext) {
  constexpr int ND0 = DQK / 16, CPR = DQK / 8 + 1, KST = CPR * 16, KSZ = 64 * KST;
  const int wid = __builtin_amdgcn_readfirstlane(tid >> 6), lane = tid & 63, r32 = lane & 31, hi = lane >> 5;
  char* V_lds = lds; char* K_lds = lds + 3 * SHM_V;
  f32x16 o[3] = {}; bf16x8 qr[ND0];
  const bf16* Qw = Qb + (long)(wid * 32 + r32) * ldq + hi * 8;
#pragma unroll
  for (int d0 = 0; d0 < ND0; ++d0) qr[d0] = *reinterpret_cast<const bf16x8*>(Qw + d0 * 16);
  const float nb = nbp[(long)(wid * 32 + r32) * nbs];
  f32x16 nbt;
#pragma unroll
  for (int r = 0; r < 16; ++r) nbt[r] = nb;
  const int vb0 = (int)(uintptr_t)V_lds + v_rd_base(lane);
  bf16x8 onesB; { const unsigned ov = r32 == 0 ? 0x3F803F80u : 0u; u32x4 t = {ov, ov, ov, ov}; onesB = *reinterpret_cast<bf16x8*>(&t); }
  unsigned kof0, kof1, vof;
  { const int c0 = 64 * wid + lane, c1 = c0 + 512; const int ra = c0 / CPR, ca = c0 - ra * CPR, rb = c1 / CPR, cb = c1 - rb * CPR;
    kof0 = (unsigned)(ra * ldk + (ca < CPR - 1 ? ca : 0) * 8) * 2u; kof1 = (unsigned)(rb * ldk + (cb < CPR - 1 ? cb : 0) * 8) * 2u;
    vof = (unsigned)((wid * 8 + ((lane & 31) >> 2)) * 256 + (lane >> 5) * 32 + (lane & 3) * 8) * 2u; }
  const bool k0act = wid < CPR, k1act = wid + 8 < CPR;
  const unsigned kl0 = (unsigned)(uintptr_t)K_lds + (unsigned)wid * 1024u, vl0 = (unsigned)(uintptr_t)V_lds + (unsigned)wid * 2048u;
#define FA_LAS __attribute__((address_space(3)))
#define FA_KROW(j) ((j) < 4 ? kva + 64 * (j) : kvb + 64 * ((j) - 4))
#define FA_DMAK(t, slot) do { const char* kb_ = (const char*)(Kh + (long)FA_KROW(t) * ldk); const unsigned kd_ = kl0 + (unsigned)(slot) * (unsigned)KSZ; \
    if (k0act) __builtin_amdgcn_global_load_lds((const unsigned*)(kb_ + kof0), (FA_LAS unsigned*)kd_, 16, 0, 0); \
    if (k1act) __builtin_amdgcn_global_load_lds((const unsigned*)(kb_ + kof1), (FA_LAS unsigned*)(kd_ + 8192u), 16, 0, 0); } while (0)
#define FA_DMAV(t, slot) do { const char* vb_ = (const char*)(Vh + (long)FA_KROW(t) * 256); \
    __builtin_amdgcn_global_load_lds((const unsigned*)(vb_ + vof), (FA_LAS unsigned*)(vl0 + (unsigned)(slot) * (unsigned)SHM_V), 16, 0, 0); } while (0)
#define FA_NX(s) ((s) == 2 ? 0 : (s) + 1)
#define FA_END(n) do { asm volatile("s_waitcnt vmcnt(" #n ")" ::: "memory"); __builtin_amdgcn_s_barrier(); } while (0)
  f32x16 pE0, pE1, pO0, pO1; bf16x8 ae0, ae1, ae2, ae3, ao0, ao1, ao2, ao3;
  if (!prefetched) { FA_DMAK(0, 0); FA_DMAK(1, 1); }
  FA_END(0);
#pragma unroll
  for (int d0 = 0; d0 < ND0; ++d0) asm volatile("" : "+v"(qr[d0]));
  asm volatile("" : "+v"(nbt));
  if (2 < NT) FA_DMAK(2, 2); FA_DMAV(0, 0);
  qkt2<ND0, KST>(pE0, pE1, K_lds, qr, nbt, r32, hi);
  FA_END(1);
  if (3 < NT) FA_DMAK(3, 0); FA_DMAV(1, 1);
  FA_SBAR(); qkt2<ND0, KST>(pO0, pO1, K_lds + KSZ, qr, nbt, r32, hi); expcvt(pE0, pE1, ae0, ae1, ae2, ae3); FA_SBAR();
  FA_END(1);
  int sj = 1;
  for (int j = 1; j + 2 < NT; j += 2) {
    { const int s1 = FA_NX(sj), s2 = FA_NX(s1);
      if (j + 3 < NT) FA_DMAK(j + 3, sj); FA_DMAV(j + 1, s1);
      FA_SBAR(); asm volatile("" : "+v"(pO0), "+v"(pO1));
      fused_step<ND0, 0, KST>(pE0, pE1, pO0, pO1, ao0, ao1, ao2, ao3, ae0, ae1, ae2, ae3, o, K_lds + s1 * KSZ, vb0 + s2 * SHM_V, qr, nbt, r32, hi, onesB);
      FA_END(1); sj = s1; }
    { const int s1 = FA_NX(sj), s2 = FA_NX(s1);
      if (j + 4 < NT) FA_DMAK(j + 4, sj); if (j + 2 < NT) FA_DMAV(j + 2, s1);
      FA_SBAR(); asm volatile("" : "+v"(pE0), "+v"(pE1));
      fused_step<ND0, 0, KST>(pO0, pO1, pE0, pE1, ae0, ae1, ae2, ae3, ao0, ao1, ao2, ao3, o, K_lds + s1 * KSZ, vb0 + s2 * SHM_V, qr, nbt, r32, hi, onesB);
      FA_END(1); sj = s1; }
  }
  { const int s2 = FA_NX(FA_NX(sj));
    if (Knext) { const char* kb_ = (const char*)Knext;
      if (k0act) __builtin_amdgcn_global_load_lds((const unsigned*)(kb_ + kof0), (FA_LAS unsigned*)kl0, 16, 0, 0);
      if (k1act) __builtin_amdgcn_global_load_lds((const unsigned*)(kb_ + kof1), (FA_LAS unsigned*)(kl0 + 8192u), 16, 0, 0);
      kb_ += (size_t)64 * ldk * 2;
      if (k0act) __builtin_amdgcn_global_load_lds((const unsigned*)(kb_ + kof0), (FA_LAS unsigned*)(kl0 + (unsigned)KSZ), 16, 0, 0);
      if (k1act) __builtin_amdgcn_global_load_lds((const unsigned*)(kb_ + kof1), (FA_LAS unsigned*)(kl0 + (unsigned)KSZ + 8192u), 16, 0, 0); }
    FA_SBAR(); expcvt(pO0, pO1, ao0, ao1, ao2, ao3); pv3b(o, vb0 + s2 * SHM_V, ae0, ae1, ae2, ae3, onesB); FA_SBAR();
    if (!Knext || !k0act) { FA_END(0); } else if (k1act) { FA_END(4); } else { FA_END(2); }
    sj = FA_NX(sj); }
  { const int s2 = FA_NX(FA_NX(sj)); pv3b(o, vb0 + s2 * SHM_V, ao0, ao1, ao2, ao3, onesB); }
  bf16* Ow = Ob + (long)(wid * 32) * ldo;
#pragma unroll
  for (int r = 0; r < 16; ++r) { const int orow = crow(r, hi);
    const float lsum = __int_as_float(__builtin_amdgcn_ds_bpermute((hi * 32) << 2, __float_as_int(o[2][r]))); const float rl = __builtin_amdgcn_rcpf(lsum);
#pragma unroll
    for (int d0 = 0; d0 < 2; ++d0) Ow[(long)orow * ldo + d0 * 32 + r32] = f2bf(o[d0][r] * rl); }
  __syncthreads();
#undef FA_KROW
#undef FA_DMAK
#undef FA_DMAV
#undef FA_NX
#undef FA_END
}
}

template <int DQK, int WI = 0>
DI void ph_attn_fast2(const bf16* Q, const bf16* K, const bf16* V, const float* QB, int nhv, int vdiv, bf16* O, int ldo, int ooff, int qbase, int nq_per_b, bool with_latent, unsigned char* lds) {
  const int tid_ = opq_tid(); const int bid_ = opq_bid(), nblk_ = opq_nblk();
  const int chunks = nq_per_b / 256, npairs = NB * nhv, nunits = npairs * chunks;
  const bool xmap = (nblk_ == 256) && (chunks == 16);
#define AT_DECODE(i, ok, pair, ch) do { if (xmap) { const int v = (i) * 32 + (bid_ >> 3); ok = v < nhv * 16; pair = (v >> 4) * 8 + (bid_ & 7); ch = v & 15; } \
    else { const int u = (i) * nblk_ + bid_; ok = u < nunits; pair = u / chunks; ch = u - pair * chunks; } } while (0)
  bool ok, pre = false; int pair, ch;
  AT_DECODE(0, ok, pair, ch);
  for (int i = 0; ok; ++i) {
    bool okn; int pairn, chn;
    AT_DECODE(i + 1, okn, pairn, chn); (void)chn;
    const int b = pair / nhv, hv = pair - b * nhv;
    const int r0 = qbase + b * nq_per_b + ch * 256;
    int tu_ = tid_; asm volatile("" : "+v"(tu_));
    if constexpr (WI == 0) {
      const int bn = pairn / nhv, hvn = pairn - bn * nhv;
      const bf16* Kn = okn ? K + hvn * DQK + (size_t)(TL + bn * CTX) * (nhv * DQK) : nullptr;
      fa::attn_unit4<DQK>(Q + (size_t)r0 * (nhv * DQK) + hv * DQK, nhv * DQK, K + hv * DQK, nhv * DQK, V + (hv / vdiv) * 64, QB + (size_t)r0 * nhv + hv, nhv, TL + b * CTX, b * SEQ, with_latent ? 68 : 4,
                        O + (size_t)r0 * ldo + ooff + hv * 64, ldo, (char*)lds, tu_, pre, Kn);
      pre = okn;
    } else {
      fa::attn_unit3<DQK, WI>(Q + (size_t)r0 * (nhv * DQK) + hv * DQK, nhv * DQK, K + hv * DQK, nhv * DQK, V + (hv / vdiv) * 64, QB + (size_t)r0 * nhv + hv, nhv, TL + b * CTX, b * SEQ, with_latent ? 68 : 4,
                        O + (size_t)r0 * ldo + ooff + hv * 64, ldo, (char*)lds, tu_);
    }
    ok = okn; pair = pairn; ch = chn;
  }
#undef AT_DECODE
}

DI void ph_na_fast2(PRef p, int l, unsigned char* lds8) {
  using namespace fa;
  const int tid_ = opq_tid(); const int bid_ = opq_bid(), nblk_ = opq_nblk();
  char* lds = (char*)lds8;
  const bf16* __restrict__ Q = (const bf16*)(p.ws + WS_NQ); const bf16* __restrict__ K = (const bf16*)(p.ws + WS_NK); const bf16* __restrict__ V = (const bf16*)(p.ws + WS_NV); bf16* __restrict__ BI = (bf16*)(p.ws + WS_BI);
  const float* __restrict__ QB = (const float*)(p.ws + WS_QBN);
  const float* rpb = p.in[I_RPB] + (size_t)l * NH * 15 * 31;
  const int wid = __builtin_amdgcn_readfirstlane(tid_ >> 6), lane = tid_ & 63, r32 = lane & 31, hi = lane >> 5;
  char* V_lds = lds; char* K_lds = lds + 2 * SHM_V;
  float* tbl = (float*)(lds + 2 * SHM_V + 2 * SHM_K + 2048);
  bf16x8 onesB; { const unsigned ov = r32 == 0 ? 0x3F803F80u : 0u; u32x4 t = {ov, ov, ov, ov}; onesB = *reinterpret_cast<bf16x8*>(&t); }
  const int sr = tid_ >> 4, sc = (tid_ & 15) * 8; const bool act = sc < 64;
  const int vst0 = v_st(sr, sc & 63), vst1 = v_st(32 + sr, sc & 63);
  const int vb0 = (int)(uintptr_t)V_lds + v_rd_base(lane);
  const bool xmap = (nblk_ == 256);
  for (int i = 0;; ++i) {
    int pair, g;
    if (xmap) { const int v = i * 32 + (bid_ >> 3); if (v >= 64) break; pair = (v >> 4) * 8 + (bid_ & 7); g = v & 15; }
    else { const int u = i * nblk_ + bid_; if (u >= NB * NH * 16) break; pair = u >> 4; g = u & 15; }
    const int b = pair >> 2, h = pair & 3;
    for (int k = tid_; k < 15 * 32; k += 512) { const int ii = k >> 5, jj = k & 31; tbl[k] = jj < 31 ? rpb[(h * 15 + ii) * 31 + jj] * LOG2E : 0.f; }
    const int lo = min(max(4 * g - 4, 0), 56), hiR = min(max(4 * g + 3 - 4, 0), 56) + 7, NT = 4 + (hiR - lo + 1);
    const int qrow = 4 * g + (wid >> 1), rs_w = min(max(qrow - 4, 0), 56), qc = 32 * (wid & 1) + r32, ws0 = min(max(qc - 8, 0), 48);
    const int r0 = b * SEQ + g * 256;
    const bf16* Kh = K + h * 64; const bf16* Vh = V + h * 64;
    unsigned vmask = 0u;
#pragma unroll
    for (int r = 0; r < 16; ++r) { const int kc = crow(r, hi); vmask |= ((unsigned)(kc - ws0) < 16u ? 1u : 0u) << r; vmask |= ((unsigned)(kc + 32 - ws0) < 16u ? 1u : 0u) << (16 + r); }
    const int bbase = 4 * hi - qc + 15;
    f32x16 o[3] = {}; bf16x8 qr[4];
    const bf16* Qw = Q + (size_t)(r0 + wid * 32 + r32) * 256 + h * 64 + hi * 8;
#pragma unroll
    for (int d0 = 0; d0 < 4; ++d0) qr[d0] = *reinterpret_cast<const bf16x8*>(Qw + d0 * 16);
    const float nb = QB[(size_t)(r0 + wid * 32 + r32) * 4 + h];
    f32x16 nbt;
#pragma unroll
    for (int r = 0; r < 16; ++r) nbt[r] = nb;
    bf16x8 vs0, vs1, ks0, ks1;
#define NA_KROW(j) ((j) < 4 ? TL + b * CTX + 64 * (j) : b * SEQ + (lo + (j) - 4) * 64)
#define NA_SLOAD(j) do { if (act) { const long kr_ = NA_KROW(j); vs0 = *reinterpret_cast<const bf16x8*>(&Vh[(kr_ + sr) * 256 + sc]); vs1 = *reinterpret_cast<const bf16x8*>(&Vh[(kr_ + 32 + sr) * 256 + sc]); \
      ks0 = *reinterpret_cast<const bf16x8*>(&Kh[(kr_ + sr) * 256 + sc]); ks1 = *reinterpret_cast<const bf16x8*>(&Kh[(kr_ + 32 + sr) * 256 + sc]); } } while (0)
#define NA_SWRITE(bb) do { if (act) { *(bf16x8*)(V_lds + (bb) * SHM_V + vst0) = vs0; *(bf16x8*)(V_lds + (bb) * SHM_V + vst1) = vs1; const int kc_ = sc * 2; \
      *(bf16x8*)(K_lds + (bb) * SHM_K + FA_KSWZ(sr, kc_)) = ks0; *(bf16x8*)(K_lds + (bb) * SHM_K + FA_KSWZ(32 + sr, kc_)) = ks1; } } while (0)
    NA_SLOAD(0); NA_SWRITE(0); __syncthreads();
    for (int j = 0; j < NT; ++j) {
      const int bb = j & 1;
      if (j + 1 < NT) NA_SLOAD(j + 1);
      const int kr = lo + j - 4;
      const bool wvalid = (j < 4) || (kr >= rs_w && kr < rs_w + 8);
      if (wvalid) {
        f32x16 p0, p1; bf16x8 pa0, pa1, pa2, pa3;
        qkt2<4>(p0, p1, K_lds + bb * SHM_K, qr, nbt, r32, hi);
        if (j >= 4) {
          const float* brow = tbl + (kr - qrow + 7) * 32 + bbase;
#pragma unroll
          for (int r = 0; r < 16; ++r) { const int co = (r & 3) + 8 * (r >> 2);
            p0[r] = ((vmask >> r) & 1u) ? p0[r] + brow[co] : -1e30f; p1[r] = ((vmask >> (16 + r)) & 1u) ? p1[r] + brow[co + 32] : -1e30f; }
        }
        expcvt_b(p0, p1, pa0, pa1, pa2, pa3);
        pv3b(o, vb0 + bb * SHM_V, pa0, pa1, pa2, pa3, onesB);
      }
      if (j + 1 < NT) NA_SWRITE(bb ^ 1);
      __syncthreads();
    }
    bf16* Ow = BI + (size_t)(r0 + wid * 32) * D + 768 + h * 64;
#pragma unroll
    for (int r = 0; r < 16; ++r) { const int orow = crow(r, hi);
      const float lsum = __int_as_float(__builtin_amdgcn_ds_bpermute((hi * 32) << 2, __float_as_int(o[2][r]))); const float rl = __builtin_amdgcn_rcpf(lsum);
#pragma unroll
      for (int d0 = 0; d0 < 2; ++d0) Ow[(size_t)orow * D + d0 * 32 + r32] = f2bf(o[d0][r] * rl); }
    __syncthreads();
#undef NA_KROW
#undef NA_SLOAD
#undef NA_SWRITE
  }
}

#define LAS __attribute__((address_space(3)))
#define XB_TMO      128
#define XB_XCNT(j)  (256  + 64 * (j))
#define XB_XSUB(j)  (1280 + 64 * (j))
#define XB_XGEN(j)  (2304 + 64 * (j))
#define XB_TOP      3328
#define XB_TOPGEN   3392
#define XCD_BAR_WORDS 3456
#define XB_SPIN_CAP (1u << 24)
__device__ __forceinline__ unsigned xb_ld(unsigned* p)              { return __hip_atomic_load(p, __ATOMIC_RELAXED, __HIP_MEMORY_SCOPE_AGENT); }
__device__ __forceinline__ unsigned xb_add(unsigned* p, unsigned v) { return __hip_atomic_fetch_add(p, v, __ATOMIC_RELAXED, __HIP_MEMORY_SCOPE_AGENT); }
__device__ __forceinline__ unsigned xb_xcc_id() { return (unsigned)__builtin_amdgcn_s_getreg((3 << 11) | 20) & 0xFu; }
#define XB_SPIN(cond, bar) do { unsigned _sp = 0; while (cond) { __builtin_amdgcn_s_sleep(1); \
    if ((++_sp & 255u) == 0u) { if (xb_ld(&(bar)[XB_TMO])) break; if (_sp > XB_SPIN_CAP) { atomicAdd(&(bar)[XB_TMO], 1u); break; } } } } while (0)
struct XcdBarrier { unsigned* bar; unsigned x; volatile LAS unsigned* st; };
__device__ __forceinline__ XcdBarrier xcd_barrier_post(unsigned* bar, volatile LAS unsigned* st) {
    XcdBarrier b; b.bar = bar; b.x = xb_xcc_id(); b.st = st;
    if (threadIdx.x == 0) (void)xb_add(&bar[XB_XCNT(b.x)], 1u);
    return b;
}
__device__ __forceinline__ void xcd_barrier_complete(unsigned* bar, unsigned x, unsigned& nloc, unsigned& nx) {
    const unsigned G = gridDim.x * gridDim.y * gridDim.z;
    unsigned sum, cnt, mine, sp = 0u;
    for (;;) {
        sum = 0u; cnt = 0u; mine = 0u;
#pragma unroll
        for (unsigned j = 0; j < 16; ++j) { const unsigned c = xb_ld(&bar[XB_XCNT(j)]); sum += c; cnt += (c > 0u) ? 1u : 0u; }
        mine = xb_ld(&bar[XB_XCNT(x)]);
        if (sum == G) break;
        __builtin_amdgcn_s_sleep(1);
        if ((++sp & 255u) == 0u) { if (xb_ld(&bar[XB_TMO])) break; if (sp > XB_SPIN_CAP) { atomicAdd(&bar[XB_TMO], 1u); break; } }
    }
    nloc = mine > 0u ? mine : 1u; nx = cnt > 0u ? cnt : 1u;
}
__device__ __forceinline__ void xcd_barrier(const XcdBarrier& b) {
    asm volatile("s_waitcnt vmcnt(0)" ::: "memory");
    __syncthreads();
    if (threadIdx.x == 0) {
        unsigned* bar = b.bar; unsigned bx = b.x; asm volatile("" : "+s"(bar), "+s"(bx));
        __builtin_amdgcn_s_waitcnt(0);
        unsigned nloc = b.st[0], nx = b.st[1];
        if (nloc == 0u) { xcd_barrier_complete(bar, bx, nloc, nx); b.st[0] = nloc; b.st[1] = nx; }
        const unsigned old = xb_add(&bar[XB_XSUB(bx)], 1u);
        const unsigned gen = old / nloc;
        if (old + 1u == (gen + 1u) * nloc) {
            __builtin_amdgcn_fence(__ATOMIC_RELEASE, "agent");
            asm volatile("s_waitcnt vmcnt(0)" ::: "memory");
            const unsigned og = xb_add(&bar[XB_TOP], 1u);
            const unsigned tg = og / nx;
            if (og + 1u == (tg + 1u) * nx) xb_add(&bar[XB_TOPGEN], 1u);
            else XB_SPIN(xb_ld(&bar[XB_TOPGEN]) == tg, bar);
            __builtin_amdgcn_fence(__ATOMIC_ACQUIRE, "agent");
            xb_add(&bar[XB_XGEN(bx)], 1u);
            asm volatile("s_waitcnt vmcnt(0)" ::: "memory");
        } else {
            XB_SPIN(xb_ld(&bar[XB_XGEN(bx)]) == gen, bar);
            __builtin_amdgcn_fence(__ATOMIC_ACQUIRE, "agent");
            asm volatile("s_waitcnt vmcnt(0)" ::: "memory");
        }
    }
    __syncthreads();
}

constexpr int LDS_BYTES = 147456;
constexpr int BARW_OFF = 131072 + 512;
constexpr int CW_BAR = 4096;

#ifndef ATTN_V2
#define ATTN_V2 1
#endif
#ifndef REP_GEMM
#define REP_GEMM 1
#endif
#ifndef REP_ATTN
#define REP_ATTN 1
#endif
#ifndef REP_SMALL
#define REP_SMALL 1
#endif
#ifndef REP_CVT
#define REP_CVT 1
#endif
#ifndef REP_MD
#define REP_MD 1
#endif
#ifndef FA_WI
#define FA_WI 0
#endif
#define REPEAT_L(n, stmt) do { if ((n) == 1) { stmt; } else { int n_ = (n); asm volatile("" : "+s"(n_)); for (int rep_ = 0; rep_ < n_; ++rep_) { stmt; __syncthreads(); } } } while (0)
#define REPEAT(n, stmt) do { _Pragma("unroll") for (int rep_ = 0; rep_ < (n); ++rep_) { stmt; if ((n) > 1) __syncthreads(); } } while (0)
template <int l>
DI void layer_program(const XcdBarrier& bar, unsigned char* lds) {
#define GBAR() xcd_barrier(bar)
    const bool last = (l == 1);
    const int nrows = last ? TL : T;
    const float lam_init = last ? 0.35550906759096924f : 0.2f;
    if (l == 0) { REPEAT(REP_SMALL, ph_mod1(PP, l)); GBAR(); }
    REPEAT(REP_GEMM, ph_proj_fast(PP, l, lds));
    GBAR();
    REPEAT(REP_GEMM, ph_qkvraw_fast(PP, l, lds));
    REPEAT(REP_SMALL, ph_conv(PP, l, nrows, lds));
    GBAR();
#if ATTN_V2
#if REP_MD > 1
    { int n_ = REP_MD; asm volatile("" : "+s"(n_)); for (int rep_ = 0; rep_ < n_ - 1; ++rep_) { ph_attn_fast2<96, FA_WI>((const bf16*)(PP.ws + WS_MQ), (const bf16*)(PP.ws + WS_MK), (const bf16*)(PP.ws + WS_MV), (const float*)(PP.ws + WS_QBM), 4, 1, (bf16*)(PP.ws + WS_BI), D, 256, 0, SEQ, true, lds); __syncthreads(); ph_attn_fast2<32, FA_WI>((const bf16*)(PP.ws + WS_DQ), (const bf16*)(PP.ws + WS_DK), (const bf16*)(PP.ws + WS_DV), (const float*)(PP.ws + WS_QBD), 8, 2, (bf16*)(PP.ws + WS_DO), 512, 0, 0, SEQ, true, lds); __syncthreads(); } }
#endif
    ph_attn_fast2<96>((const bf16*)(PP.ws + WS_MQ), (const bf16*)(PP.ws + WS_MK), (const bf16*)(PP.ws + WS_MV), (const float*)(PP.ws + WS_QBM), 4, 1, (bf16*)(PP.ws + WS_BI), D, 256, 0, SEQ, true, lds);
    ph_attn_fast2<32>((const bf16*)(PP.ws + WS_DQ), (const bf16*)(PP.ws + WS_DK), (const bf16*)(PP.ws + WS_DV), (const float*)(PP.ws + WS_QBD), 8, 2, (bf16*)(PP.ws + WS_DO), 512, 0, 0, SEQ, true, lds);
    REPEAT(REP_ATTN, ph_na_fast2(PP, l, lds));
    if (!last) {
      ph_attn_fast2<96>((const bf16*)(PP.ws + WS_MQ), (const bf16*)(PP.ws + WS_MK), (const bf16*)(PP.ws + WS_MV), (const float*)(PP.ws + WS_QBM), 4, 1, (bf16*)(PP.ws + WS_BI), D, 256, TL, CTX, false, lds);
      ph_attn_fast2<32>((const bf16*)(PP.ws + WS_DQ), (const bf16*)(PP.ws + WS_DK), (const bf16*)(PP.ws + WS_DV), (const float*)(PP.ws + WS_QBD), 8, 2, (bf16*)(PP.ws + WS_DO), 512, 0, TL, CTX, false, lds);
      ph_attn_fast2<64>((const bf16*)(PP.ws + WS_NQ), (const bf16*)(PP.ws + WS_NK), (const bf16*)(PP.ws + WS_NV), (const float*)(PP.ws + WS_QBN), 4, 1, (bf16*)(PP.ws + WS_BI), D, 768, TL, CTX, false, lds);
    }
    GBAR();
#else
    REPEAT(REP_ATTN, ph_attn_fast<96>((const bf16*)(PP.ws + WS_MQ), (const bf16*)(PP.ws + WS_MK), (const bf16*)(PP.ws + WS_MV), 4, 1, (bf16*)(PP.ws + WS_BI), D, 256, 0, SEQ, true, lds));
    REPEAT(REP_ATTN, ph_attn_fast<32>((const bf16*)(PP.ws + WS_DQ), (const bf16*)(PP.ws + WS_DK), (const bf16*)(PP.ws + WS_DV), 8, 2, (bf16*)(PP.ws + WS_DO), 512, 0, 0, SEQ, true, lds));
    REPEAT(REP_ATTN, ph_na_fast(PP, l, lds));
    if (!last) {
      ph_attn_fast<96>((const bf16*)(PP.ws + WS_MQ), (const bf16*)(PP.ws + WS_MK), (const bf16*)(PP.ws + WS_MV), 4, 1, (bf16*)(PP.ws + WS_BI), D, 256, TL, CTX, false, lds);
      ph_attn_fast<32>((const bf16*)(PP.ws + WS_DQ), (const bf16*)(PP.ws + WS_DK), (const bf16*)(PP.ws + WS_DV), 8, 2, (bf16*)(PP.ws + WS_DO), 512, 0, TL, CTX, false, lds);
      ph_attn_fast<64>((const bf16*)(PP.ws + WS_NQ), (const bf16*)(PP.ws + WS_NK), (const bf16*)(PP.ws + WS_NV), 4, 1, (bf16*)(PP.ws + WS_BI), D, 768, TL, CTX, false, lds);
    }
    GBAR();
#endif
    REPEAT(REP_SMALL, ph_diffcombine_fast(PP, l, nrows, lam_init));
    GBAR();
    REPEAT(REP_GEMM, ph_branch_fast(PP, l, nrows, lds));
    GBAR();
    REPEAT(REP_GEMM, ph_merge_fast(PP, l, nrows, lds));
    GBAR();
    REPEAT((l == 0 ? REP_GEMM : 1), ph_wo_fast(PP, l, nrows, lds));
    GBAR();
    ph_mod2_router_fast(PP, l, nrows, lds);
    GBAR();
    REPEAT(REP_GEMM, ph_moe1_fast(PP, l, lds));
    GBAR();
    REPEAT(REP_GEMM, ph_moe2_fast(PP, l, lds));
    GBAR();
    ph_combine(PP, l, nrows, lds);
    if (l == 0) GBAR();
}

__global__ void __launch_bounds__(512, 2) fwd(Params p) {
  extern __shared__ __attribute__((aligned(16))) unsigned char lds[];
  if (threadIdx.x < 4) ((unsigned*)(lds + BARW_OFF))[threadIdx.x] = 0u;
  __syncthreads();
  XcdBarrier bar = xcd_barrier_post((unsigned*)(PP.ws + WS_CTL) + CW_BAR, (volatile LAS unsigned*)(lds + BARW_OFF));
  ph_ada_fast(PP, lds);
  __syncthreads();
  REPEAT(REP_CVT, ph_convert(PP, lds));
  GBAR();
  layer_program<0>(bar, lds);
  layer_program<1>(bar, lds);
}

extern "C" void kernel_launch(void* const* d_in, const int* in_sizes, int n_in, void* d_out, int out_size, void* d_ws, size_t ws_size, hipStream_t stream) {
  static int grid = 0;
  if (grid == 0) {
    if (n_in != N_IN || ws_size < WS_END) { fprintf(stderr, "kernel_launch: n_in %d ws %zu need %zu\n", n_in, ws_size, (size_t)WS_END); grid = -1; return; }
    int dev = 0, cus = 0;
    if (hipGetDevice(&dev) != hipSuccess || hipDeviceGetAttribute(&cus, hipDeviceAttributeMultiprocessorCount, dev) != hipSuccess) { grid = -1; return; }
    if (hipFuncSetAttribute((const void*)fwd, hipFuncAttributeMaxDynamicSharedMemorySize, LDS_BYTES) != hipSuccess) { fprintf(stderr, "kernel_launch: hipFuncSetAttribute failed\n"); grid = -1; return; }
    int per_cu = 0;
    if (hipOccupancyMaxActiveBlocksPerMultiprocessor(&per_cu, (const void*)fwd, 512, LDS_BYTES) != hipSuccess || per_cu < 1) fprintf(stderr, "kernel_launch: occupancy query says %d\n", per_cu);
    (void)hipGetLastError();
    grid = cus;
  }
  if (grid < 0) return;
  Params p{};
  for (int i = 0; i < N_IN; ++i) p.in[i] = (const float*)d_in[i];
  p.out = (float*)d_out; p.ws = (unsigned char*)d_ws;
  (void)hipMemsetAsync((char*)d_ws + WS_CTL, 0, 1 * MiB, stream);
  (void)hipMemsetAsync((char*)d_ws + WS_QKV_T, 0, (size_t)2 * 1024 * 384 * 2, stream);
  (void)hipMemsetAsync((char*)d_ws + WS_WIN_T, 0, (size_t)2 * PLD * D * 2, stream);
  hipLaunchKernelGGL(fwd, dim3(grid), dim3(512), LDS_BYTES, stream, p);
}
```

```cpp
#include <hip/hip_runtime.h>
#include <cstdio>
#include <cstdint>

typedef unsigned short bf16;
#ifndef FAST_ATTN
#define FAST_ATTN 1
#endif
#if FAST_ATTN
#define ATTN_FN ph_attn_fast
#define ATTN_LDS , lds
#else
#define ATTN_FN ph_attn_naive
#define ATTN_LDS
#endif
#ifndef FAST_NA
#define FAST_NA 1
#endif
#ifndef FAST_SMALL
#define FAST_SMALL 1
#endif
#ifndef FAST_ROUTER
#define FAST_ROUTER 1
#endif
#ifndef FAST_PROJ
#define FAST_PROJ 1
#endif
#ifndef FAST_QKV
#define FAST_QKV 1
#endif
#ifndef FAST_MERGE
#define FAST_MERGE 1
#endif
#ifndef FAST_WO
#define FAST_WO 1
#endif
#ifndef FAST_MOE
#define FAST_MOE 1
#endif
#define DI __device__ __forceinline__

constexpr int D = 1024, NB = 8, SEQ = 4096, CTX = 256, GW = 64;
constexpr int TL = NB * SEQ;
constexpr int TC = NB * CTX;
constexpr int T = TL + TC;
constexpr int NH = 4;
constexpr int INW = 2400, PLD = 2560;
constexpr int OFF_B = 512, OFF_C = 864, OFF_D = 1632;
constexpr int NE = 32, DFF = 1024;
constexpr int MAXROWS = 4 * T + NE * 256;
constexpr float EPS = 1e-6f;
constexpr float LOG2E = 1.4426950408889634f;

enum { I_X = 0, I_C, I_CTX, I_CCTX, I_ADAW, I_ADAB, I_N1G, I_N2G, I_WIN, I_CONVW, I_CONVB, I_CLNG, I_CLNB, I_CONVOUT,
       I_CQG, I_CKVG, I_WUQ, I_WUKV, I_QNG, I_KNG, I_MLAOUT, I_DQNG, I_DKNG, I_DLAM, I_DSUBG, I_DIFFOUT, I_NQNG, I_NKNG,
       I_RPB, I_NAOUT, I_GATEW, I_GATEB, I_WO, I_RW, I_RB, I_WGU, I_BGU, I_WDN, I_BDN, N_IN };

constexpr size_t MiB = 1u << 20;
constexpr size_t al(size_t x) { return (x + 255) / 256 * 256; }
constexpr size_t WS_CTL = 0;
constexpr size_t WS_MOD = 1 * MiB;
constexpr size_t WS_ROPE = WS_MOD + al(2 * 9 * 6144 * 4);
constexpr size_t WS_ROUTE = WS_ROPE + al(4096 * 32 * 4);
constexpr size_t WS_ROWTOK = WS_ROUTE + al((size_t)T * 4 * 16);
constexpr size_t WS_HS = WS_ROWTOK + al((size_t)NE * T * 4);
constexpr size_t WS_WGUS = WS_HS + al((size_t)T * 4);
constexpr size_t WS_HS1 = WS_WGUS + al((size_t)2 * NE * 2048 * 4);
constexpr size_t WS_WINS = WS_HS1 + al((size_t)T * 4);
constexpr size_t WS_GATES = WS_WINS + al((size_t)2 * PLD * 4);
constexpr size_t WS_WIN_T = WS_GATES + al((size_t)2 * 4096 * 4);
constexpr size_t WS_QKV_T = WS_WIN_T + al((size_t)2 * PLD * D * 2);
constexpr size_t WS_WB_T = WS_QKV_T + al((size_t)2 * 1024 * 384 * 2);
constexpr size_t WS_GATE_T = WS_WB_T + al((size_t)2 * 4 * 1024 * 256 * 2);
constexpr size_t WS_WO_T = WS_GATE_T + al((size_t)2 * 4096 * D * 2);
constexpr size_t WS_WGU_T = WS_WO_T + al((size_t)2 * D * D * 2);
constexpr size_t WS_WDN_T = WS_WGU_T + al((size_t)2 * NE * 2048 * D * 2);
constexpr size_t WS_H = WS_WDN_T + al((size_t)2 * NE * D * DFF * 2);
constexpr size_t WS_H2 = WS_H + al((size_t)T * D * 2);
constexpr size_t WS_XF = WS_H2 + al((size_t)T * D * 2);
constexpr size_t WS_SCR = WS_XF + al((size_t)T * D * 4);
constexpr size_t WS_PROJ = WS_SCR;
constexpr size_t WS_CU = WS_PROJ + al((size_t)T * PLD * 2);
constexpr size_t WS_AQ = WS_CU + al((size_t)T * 256 * 2);
constexpr size_t WS_QKVRAW = WS_AQ + al((size_t)T * 384 * 2);
constexpr size_t WS_MQ = WS_QKVRAW + al((size_t)T * 1024 * 2);
constexpr size_t WS_MK = WS_MQ + al((size_t)T * 384 * 2);
constexpr size_t WS_MV = WS_MK + al((size_t)T * 384 * 2);
constexpr size_t WS_DQ = WS_MV + al((size_t)T * 256 * 2);
constexpr size_t WS_DK = WS_DQ + al((size_t)T * 256 * 2);
constexpr size_t WS_DV = WS_DK + al((size_t)T * 256 * 2);
constexpr size_t WS_NQ = WS_DV + al((size_t)T * 256 * 2);
constexpr size_t WS_NK = WS_NQ + al((size_t)T * 256 * 2);
constexpr size_t WS_NV = WS_NK + al((size_t)T * 256 * 2);
constexpr size_t WS_BI = WS_NV + al((size_t)T * 256 * 2);
constexpr size_t WS_DO = WS_BI + al((size_t)T * D * 2);
constexpr size_t WS_QBM = WS_DO + al((size_t)T * 512 * 2);
constexpr size_t WS_QBD = WS_QBM + al((size_t)T * 4 * 4);
constexpr size_t WS_QBN = WS_QBD + al((size_t)T * 8 * 4);
constexpr size_t WS_KPE = WS_QBN + al((size_t)T * 4 * 4);
constexpr size_t WS_YB = WS_KPE + al((size_t)T * 32 * 2);
constexpr size_t WS_YM = WS_YB + al((size_t)T * 4096 * 2);
constexpr size_t WS_MIX_END = WS_YM + al((size_t)T * D * 2);
constexpr size_t WS_ACT = WS_SCR;
constexpr size_t WS_YE = WS_ACT + al((size_t)MAXROWS * D * 2);
constexpr size_t WS_MOE_END = WS_YE + al((size_t)MAXROWS * D * 2);
constexpr size_t WS_END = WS_MIX_END > WS_MOE_END ? WS_MIX_END : WS_MOE_END;
static_assert(WS_END <= (size_t)2048 * MiB, "workspace budget (>= 2 GiB guaranteed)");
constexpr int CW_BIASMAX = 2048;
constexpr int CW_CNT = 1024;

struct Params {
  const float* in[N_IN];
  float* out;
  unsigned char* ws;
};
typedef const __attribute__((address_space(4))) Params& PRef;
typedef const __attribute__((address_space(4))) Params* PPtr;
__device__ __forceinline__ PPtr opq_params() { PPtr pp = (PPtr)__builtin_amdgcn_kernarg_segment_ptr(); asm volatile("" : "+s"(pp)); return pp; }
#define PP (*opq_params())

DI float bf2f(bf16 v) { return __uint_as_float(((unsigned)v) << 16); }
DI bf16 f2bf(float f) { unsigned u = __float_as_uint(f); u += 0x7fffu + ((u >> 16) & 1u); return (bf16)(u >> 16); }
DI float sigmoidf_(float x) { return 1.f / (1.f + __expf(-x)); }
DI float wave_sum_l(float v, int lane) {
#pragma unroll
  for (int o = 1; o < 64; o <<= 1) v += __int_as_float(__builtin_amdgcn_ds_bpermute((lane ^ o) << 2, __float_as_int(v)));
  return v;
}
#define wave_sum(v) wave_sum_l((v), lane)
DI unsigned cvt_pk_bf16_(float lo, float hi) { unsigned r; asm volatile("v_cvt_pk_bf16_f32 %0, %1, %2" : "=v"(r) : "v"(lo), "v"(hi)); return r; }
DI float seg_sum(float v, int lane, int width) {
#pragma unroll
  for (int o = 1; o < 64; o <<= 1) if (o < width) v += __int_as_float(__builtin_amdgcn_ds_bpermute((lane ^ o) << 2, __float_as_int(v)));
  return v;
}
DI float lane_xor(float v, int lane, int o) { return __int_as_float(__builtin_amdgcn_ds_bpermute((lane ^ o) << 2, __float_as_int(v))); }

DI void quant_row_i8(const float (&v)[16], signed char* dst, float* scale_out, int lane) {
  float mx = 0.f;
#pragma unroll
  for (int i = 0; i < 16; ++i) mx = fmaxf(mx, fabsf(v[i]));
#pragma unroll
  for (int o = 1; o < 64; o <<= 1) mx = fmaxf(mx, lane_xor(mx, lane, o));
  const float sc = mx > 0.f ? mx * (1.f / 127.f) : 1.f, inv = 1.f / sc; if (lane == 0) *scale_out = sc;
#pragma unroll
  for (int j = 0; j < 4; ++j) { unsigned b = 0;
#pragma unroll
    for (int i = 0; i < 4; ++i) b |= ((unsigned)(int)rintf(v[4 * j + i] * inv) & 255u) << (8 * i);
    *(unsigned*)(dst + j * 256 + lane * 4) = b; }
}
DI void ld4(const bf16* p, float (&x)[4]) { const uint2 u = *(const uint2*)p; x[0] = __uint_as_float(u.x << 16); x[1] = __uint_as_float(u.x & 0xffff0000u); x[2] = __uint_as_float(u.y << 16); x[3] = __uint_as_float(u.y & 0xffff0000u); }
DI void st4(bf16* p, const float (&x)[4]) { uint2 u; u.x = cvt_pk_bf16_(x[0], x[1]); u.y = cvt_pk_bf16_(x[2], x[3]); *(uint2*)p = u; }

DI int opq_bid() { int b = blockIdx.x; asm volatile("" : "+s"(b)); return b; }
DI int opq_nblk() { int g = gridDim.x; asm volatile("" : "+s"(g)); return g; }
DI int opq_tid() { int t = threadIdx.x; asm volatile("" : "+v"(t)); return t; }
#define GTID ((int)(bid_ * 512 + tid_))
#define NTHR ((int)(nblk_ * 512))
#define SUB ((int)(tid_ >> 8))
#define T256 ((int)(tid_ & 255))
DI int modidx(int r) { return r < TL ? (r >> 12) : NB; }


DI const float* stream_row(PRef p, int l, int r, bool after_mixer) {
  if (l == 0 && !after_mixer) return r < TL ? p.in[I_X] + (size_t)r * D : p.in[I_CTX] + (size_t)(r - TL) * D;
  return (const float*)(p.ws + WS_XF) + (size_t)r * D;
}
DI void ph_mod1(PRef p, int l) {
  const int tid_ = opq_tid(); const int bid_ = opq_bid(), nblk_ = opq_nblk(); (void)bid_; (void)nblk_;
  const int lane = tid_ & 63, gw = GTID >> 6, ngw = NTHR >> 6;
  const float* MOD = (const float*)(p.ws + WS_MOD);
  bf16* H = (bf16*)(p.ws + WS_H);
  const float* g = p.in[I_N1G] + l * D;
  float4 c0, c1, c2, c3;
  { const float* x = stream_row(p, l, min(gw, T - 1), false) + lane * 4; c0 = *(const float4*)(x); c1 = *(const float4*)(x + 256); c2 = *(const float4*)(x + 512); c3 = *(const float4*)(x + 768); }
  for (int r = gw; r < T; r += ngw) {
    float4 n0, n1, n2, n3;
    { const float* x = stream_row(p, l, min(r + ngw, T - 1), false) + lane * 4; n0 = *(const float4*)(x); n1 = *(const float4*)(x + 256); n2 = *(const float4*)(x + 512); n3 = *(const float4*)(x + 768); }
    float v[16]; float ss = 0.f;
    { const float4 t4[4] = {c0, c1, c2, c3};
#pragma unroll
    for (int j = 0; j < 4; ++j) { const float4 t = t4[j]; v[4 * j] = t.x; v[4 * j + 1] = t.y; v[4 * j + 2] = t.z; v[4 * j + 3] = t.w; ss += t.x * t.x + t.y * t.y + t.z * t.z + t.w * t.w; } }
    c0 = n0; c1 = n1; c2 = n2; c3 = n3;
    ss = wave_sum(ss);
    const float rstd = rsqrtf(ss * (1.f / D) + EPS);
    const float* md = MOD + ((size_t)l * 9 + modidx(r)) * 6144;
#pragma unroll
    for (int j = 0; j < 4; ++j)
#pragma unroll
      for (int i = 0; i < 4; ++i) { const int c = j * 256 + lane * 4 + i; v[4 * j + i] = v[4 * j + i] * rstd * g[c] * (1.f + md[1024 + c]) + md[c]; }
    quant_row_i8(v, (signed char*)H + (size_t)r * D, (float*)(p.ws + WS_HS1) + r, lane);
  }
}

struct RowId { DI int operator()(int m) const { return m; } };
struct RowGather { const int* idx; DI int operator()(int m) const { return idx[m]; } };
#define ZERO_ACC(acc) do { _Pragma("unroll") for (int i_ = 0; i_ < 4; ++i_) _Pragma("unroll") for (int j_ = 0; j_ < 4; ++j_) acc[i_][j_] = 0.f; } while (0)


DI void ph_conv(PRef p, int l, int nrows, unsigned char* lds) {
  const int tid_ = opq_tid(); const int bid_ = opq_bid(), nblk_ = opq_nblk(); (void)bid_; (void)nblk_;
  const int lane = tid_ & 63, gw = GTID >> 6, ngw = NTHR >> 6;
  const bf16* __restrict__ CU = (const bf16*)(p.ws + WS_CU); bf16* __restrict__ BI = (bf16*)(p.ws + WS_BI);
  const float* cw = p.in[I_CONVW] + l * 31 * 256; const float* cb = p.in[I_CONVB] + l * 256;
  float4* wl = (float4*)lds;
  for (int k = tid_; k < 31 * 64; k += 512) wl[k] = *(const float4*)(cw + 4 * k);
  __syncthreads();
  const float4 bias = *(const float4*)(cb + lane * 4), lg = *(const float4*)(p.in[I_CLNG] + l * 256 + lane * 4), lb = *(const float4*)(p.in[I_CLNB] + l * 256 + lane * 4);
  for (int r = gw; r < nrows; r += ngw) {
    int lo, hi; if (r < TL) { lo = r & ~(SEQ - 1); hi = lo + SEQ; } else { lo = TL + ((r - TL) & ~(CTX - 1)); hi = lo + CTX; }
    const bf16* up = CU + (long)(r - 15) * 256 + lane * 4; asm volatile("" : "+v"(up));
    uint2 u[31];
#pragma unroll
    for (int j = 0; j < 31; ++j) { const int rr = r + j - 15; u[j] = make_uint2(0u, 0u); if (rr >= lo && rr < hi) u[j] = *(const uint2*)(up + j * 256); }
    float a[4] = {bias.x, bias.y, bias.z, bias.w};
#pragma unroll
    for (int j = 0; j < 31; ++j) { const float4 w = wl[j * 64 + lane];
      a[0] += __uint_as_float(u[j].x << 16) * w.x; a[1] += __uint_as_float(u[j].x & 0xffff0000u) * w.y; a[2] += __uint_as_float(u[j].y << 16) * w.z; a[3] += __uint_as_float(u[j].y & 0xffff0000u) * w.w; }
    const float mu = seg_sum(a[0] + a[1] + a[2] + a[3], lane, 64) * (1.f / 256.f);
    float q2 = 0.f;
#pragma unroll
    for (int c = 0; c < 4; ++c) { a[c] -= mu; q2 += a[c] * a[c]; }
    const float rs = rsqrtf(seg_sum(q2, lane, 64) * (1.f / 256.f) + EPS);
    float y[4] = {a[0] * rs * lg.x + lb.x, a[1] * rs * lg.y + lb.y, a[2] * rs * lg.z + lb.z, a[3] * rs * lg.w + lb.w};
#pragma unroll
    for (int c = 0; c < 4; ++c) y[c] = y[c] * sigmoidf_(y[c]);
    st4(BI + (size_t)r * D + lane * 4, y);
  }
  __syncthreads();
}


DI void expert_offsets(const unsigned* cnt, int* off  ) { int a = 0; for (int e = 0; e < NE; ++e) { off[e] = a; a += ((int)cnt[e] + 255) & ~255; } off[NE] = a; }
DI void ph_combine(PRef p, int l, int nrows, unsigned char* lds) {
  const int tid_ = opq_tid(); const int bid_ = opq_bid(), nblk_ = opq_nblk();
  int* off = (int*)(lds + 32768);
  const unsigned* cnt = (const unsigned*)(p.ws + WS_CTL) + CW_CNT + l * 64;
  if (tid_ == 0) expert_offsets(cnt, off);
  __syncthreads();
  const int lane = tid_ & 63, gw = GTID >> 6, ngw = NTHR >> 6;
  const float* MOD = (const float*)(p.ws + WS_MOD); float* XF = (float*)(p.ws + WS_XF); const bf16* YE = (const bf16*)(p.ws + WS_YE); const int* ROUTE = (const int*)(p.ws + WS_ROUTE);
  bf16* H = (bf16*)(p.ws + WS_H); const float* g1n = p.in[I_N1G] + D;
  for (int r = gw; r < nrows; r += ngw) {
    const float* md = MOD + ((size_t)l * 9 + modidx(r)) * 6144 + 5 * 1024;
    float* dst = (l == 1) ? p.out + (size_t)r * D : XF + (size_t)r * D;
    const float* xs = XF + (size_t)r * D;
    float acc[16];
#pragma unroll
    for (int i = 0; i < 16; ++i) acc[i] = 0.f;
#pragma unroll
    for (int k = 0; k < 4; ++k) { const int* rt = ROUTE + ((size_t)r * 4 + k) * 4; const float w = __int_as_float(rt[2]); const bf16* y = YE + (size_t)(off[rt[0]] + rt[1]) * D;
#pragma unroll
      for (int j = 0; j < 4; ++j) { const uint2 u = *(const uint2*)(y + j * 256 + lane * 4);
        acc[4 * j] += w * __uint_as_float(u.x << 16); acc[4 * j + 1] += w * __uint_as_float(u.x & 0xffff0000u); acc[4 * j + 2] += w * __uint_as_float(u.y << 16); acc[4 * j + 3] += w * __uint_as_float(u.y & 0xffff0000u); } }
    float ss = 0.f;
#pragma unroll
    for (int j = 0; j < 4; ++j) { const int c = j * 256 + lane * 4; const float4 x4 = *(const float4*)(xs + c), m4 = *(const float4*)(md + c);
      acc[4 * j] = x4.x + m4.x * acc[4 * j]; acc[4 * j + 1] = x4.y + m4.y * acc[4 * j + 1]; acc[4 * j + 2] = x4.z + m4.z * acc[4 * j + 2]; acc[4 * j + 3] = x4.w + m4.w * acc[4 * j + 3];
      *(float4*)(dst + c) = make_float4(acc[4 * j], acc[4 * j + 1], acc[4 * j + 2], acc[4 * j + 3]);
      ss += acc[4 * j] * acc[4 * j] + acc[4 * j + 1] * acc[4 * j + 1] + acc[4 * j + 2] * acc[4 * j + 2] + acc[4 * j + 3] * acc[4 * j + 3]; }
    if (l == 0) {
      ss = seg_sum(ss, lane, 64); const float rstd = rsqrtf(ss * (1.f / D) + EPS);
      const float* m1 = MOD + ((size_t)9 + modidx(r)) * 6144;
#pragma unroll
      for (int j = 0; j < 4; ++j) { const int c = j * 256 + lane * 4; const float4 gg = *(const float4*)(g1n + c), s4 = *(const float4*)(m1 + 1024 + c), h4 = *(const float4*)(m1 + c);
        acc[4 * j] = acc[4 * j] * rstd * gg.x * (1.f + s4.x) + h4.x; acc[4 * j + 1] = acc[4 * j + 1] * rstd * gg.y * (1.f + s4.y) + h4.y; acc[4 * j + 2] = acc[4 * j + 2] * rstd * gg.z * (1.f + s4.z) + h4.z; acc[4 * j + 3] = acc[4 * j + 3] * rstd * gg.w * (1.f + s4.w) + h4.w; }
      quant_row_i8(acc, (signed char*)H + (size_t)r * D, (float*)(p.ws + WS_HS1) + r, lane);
    }
  }
}

namespace pg8 {
#define PG8_LAS __attribute__((address_space(3)))
typedef unsigned short bf16_t;
typedef short bf16x8 __attribute__((ext_vector_type(8)));
typedef float f32x4 __attribute__((ext_vector_type(4)));
typedef unsigned u32x4 __attribute__((ext_vector_type(4)));
typedef unsigned u32x2 __attribute__((ext_vector_type(2)));
typedef int i32x4v __attribute__((ext_vector_type(4)));
constexpr int BM = 256, BK = 64, HALF = 128, HTB = HALF * BK * 2, STAGE_BYTES = 8 * HTB;
__host__ __device__ __forceinline__ int lds_byte(int r, int c) { const int st = (r >> 4) * 2 + (c >> 5), rr = r & 15, cc = c & 31, ob = rr * 64 + cc * 2; return st * 1024 + (ob ^ (((ob >> 9) & 1) << 5)); }
__host__ __device__ __forceinline__ void stage_rc(int b, int& R, int& C) { const int st = b / 1024, sb = b % 1024, swz = sb ^ (((sb >> 9) & 1) << 5); R = (st >> 1) * 16 + swz / 64; C = (st & 1) * 32 + (swz % 64) / 2; }
__host__ __device__ __forceinline__ int perm32(int rho) { const int n = rho >> 4, i = rho & 15; return 8 * (i >> 2) + 4 * n + (i & 3); }
__device__ __forceinline__ unsigned cvt_pk_bf16(float lo, float hi) { unsigned r; asm volatile("v_cvt_pk_bf16_f32 %0, %1, %2" : "=v"(r) : "v"(lo), "v"(hi)); return r; }

struct Unit { int pm, pn, aux, nvalid; const char* A; const char* B; const int* rows; };

template <class Epi, class Sched, bool GATHER, bool I8 = false>
__device__ __forceinline__ void gemm_phase(PG8_LAS unsigned char* lds, const int lda_, const int K_, const Sched& S, const Epi& E) {
    const int lda = I8 ? lda_ / 2 : lda_, K = I8 ? K_ / 2 : K_;
    const int tid = opq_tid(), wid = __builtin_amdgcn_readfirstlane(tid >> 6), lane = tid & 63, wr = wid >> 2, wc = wid & 3, fr = lane & 15, fq = lane >> 4;
    const int nt = K / BK;
    unsigned voffA[2], voffB[2];
#pragma unroll
    for (int i = 0; i < 2; ++i) { int R, C; stage_rc(tid * 16 + i * 8192, R, C); const int Rb = Epi::PERM ? ((R & ~31) + perm32(R & 31)) : R;
        voffA[i] = GATHER ? (unsigned)(R * 65536 + C * 2) : (unsigned)(R * lda + C) * 2u; voffB[i] = (unsigned)(Rb * K + C) * 2u; }
    const size_t kstep = (size_t)(BK * 2);
    const size_t hstepA = GATHER ? 0 : (size_t)HALF * lda * 2, hstepB = (size_t)HALF * K * 2;
    const unsigned ldsw = (unsigned)wid * 1024u;
    const int aoff = lds_byte(wr * 64 + fr, fq * 8), boff = lds_byte(wc * 32 + fr, fq * 8);
#define PG8_SA(b, h) (((b) * 2 + (h)) * HTB)
#define PG8_SB(b, h) ((4 + (b) * 2 + (h)) * HTB)
#define PG8_STAGE(bufoff, gbase, voff) do { _Pragma("unroll") for (int _i = 0; _i < 2; ++_i) \
        __builtin_amdgcn_global_load_lds((const unsigned*)((const char*)(gbase) + (voff)[_i]), (PG8_LAS unsigned*)(lds + (bufoff) + ldsw + _i * 8192), 16, 0, 0); } while (0)
#define PG8_LDA(dst, b, h) do { _Pragma("unroll") for (int m = 0; m < 4; ++m) _Pragma("unroll") for (int k = 0; k < 2; ++k) dst[m][k] = *(const PG8_LAS bf16x8*)(lds + PG8_SA(b, h) + aoff + m * 2048 + k * 1024); } while (0)
#define PG8_LDB(dst, b, h) do { _Pragma("unroll") for (int n = 0; n < 2; ++n) _Pragma("unroll") for (int k = 0; k < 2; ++k) dst[n][k] = *(const PG8_LAS bf16x8*)(lds + PG8_SB(b, h) + boff + n * 2048 + k * 1024); } while (0)
#define PG8_MMA(ai, bj, At, Bt) do { __builtin_amdgcn_s_setprio(1); _Pragma("unroll") for (int m = 0; m < 4; ++m) _Pragma("unroll") for (int n = 0; n < 2; ++n) _Pragma("unroll") for (int k = 0; k < 2; ++k) { \
        if constexpr (I8) acc[ai][bj][m][n] = __builtin_bit_cast(f32x4, __builtin_amdgcn_mfma_i32_16x16x64_i8(__builtin_bit_cast(i32x4v, Bt[n][k]), __builtin_bit_cast(i32x4v, At[m][k]), __builtin_bit_cast(i32x4v, acc[ai][bj][m][n]), 0, 0, 0)); \
        else acc[ai][bj][m][n] = __builtin_amdgcn_mfma_f32_16x16x32_bf16(Bt[n][k], At[m][k], acc[ai][bj][m][n], 0, 0, 0); } __builtin_amdgcn_s_setprio(0); } while (0)
#define PG8_WAIT_V(n) asm volatile("s_waitcnt vmcnt(" #n ")" ::: "memory")
#define PG8_WAIT_L(n) asm volatile("s_waitcnt lgkmcnt(" #n ")" ::: "memory")
#define PG8_BAR __builtin_amdgcn_s_barrier()
#define PG8_SCHED __builtin_amdgcn_sched_barrier(0)
#define PG8_LOADROWS(dst, u) do { _Pragma("unroll") for (int h_ = 0; h_ < 2; ++h_) _Pragma("unroll") for (int i_ = 0; i_ < 2; ++i_) \
        { const int ri_ = h_ * HALF + (int)(voffA[i_] >> 16); dst[h_][i_] = (unsigned)((u).rows[ri_ < (u).nvalid ? ri_ : 0]) * (unsigned)(lda * 2) + (voffA[i_] & 0xffffu); } } while (0)
#define PG8_STAGE_A(bufoff, gbase, h, NEXT) do { if constexpr (GATHER) { PG8_STAGE(bufoff, gbase, ((NEXT) ? vn[h] : vc[h])); } else { PG8_STAGE(bufoff, (gbase) + (h) * hstepA, voffA); } } while (0)
    Unit cur, nxt; int ui = 0;
    if (!S.next(0, cur)) return;
    f32x4 acc[2][2][4][2];
#pragma unroll
    for (int a = 0; a < 2; ++a)
#pragma unroll
        for (int b = 0; b < 2; ++b)
#pragma unroll
            for (int m = 0; m < 4; ++m)
#pragma unroll
                for (int n = 0; n < 2; ++n) acc[a][b][m][n] = (f32x4){0.f, 0.f, 0.f, 0.f};
    bf16x8 At[4][2], B0[2][2], B1[2][2];
    unsigned vc[2][2], vn[2][2];
    if constexpr (GATHER) { PG8_LOADROWS(vc, cur);
#pragma unroll
        for (int h = 0; h < 2; ++h) { vn[h][0] = vc[h][0]; vn[h][1] = vc[h][1]; } }
    const char* cA = cur.A; const char* cB = cur.B;
    PG8_STAGE(PG8_SB(0, 0), cB, voffB); PG8_STAGE(PG8_SB(0, 1), cB + hstepB, voffB); PG8_STAGE_A(PG8_SA(0, 0), cA, 0, false); PG8_STAGE_A(PG8_SA(0, 1), cA, 1, false);
    if (wr == 1) PG8_BAR;
    PG8_WAIT_V(2); PG8_BAR;
    PG8_STAGE(PG8_SB(1, 0), cB + kstep, voffB); PG8_STAGE_A(PG8_SA(1, 0), cA + kstep, 0, false); PG8_STAGE(PG8_SB(1, 1), cB + hstepB + kstep, voffB);
    PG8_WAIT_V(6); PG8_BAR;
    for (;;) {
        const bool has_next = S.next(ui + 1, nxt);
        int pf_tok = 0; float pf_s = 0.f;
        if constexpr (GATHER && I8) { const int pt_ = opq_tid() & 255; pf_tok = cur.rows[pt_ < cur.nvalid ? pt_ : 0]; }
        const char* nA = has_next ? nxt.A : cA; const char* nB = has_next ? nxt.B : cB;
        if constexpr (GATHER) { if (has_next) { PG8_LOADROWS(vn, nxt); } }
#pragma unroll 1
        for (int t = 0; t < nt; t += 2) {
            const bool last = (t == nt - 2);
            if constexpr (GATHER && I8) { if (t == 2) pf_s = E.HS[pf_tok]; }
            const char* a1 = cA + (size_t)(t + 1) * kstep;
            const char* a2 = last ? nA : cA + (size_t)(t + 2) * kstep; const char* b2 = last ? nB : cB + (size_t)(t + 2) * kstep;
            const char* a3 = a2 + kstep; const char* b3 = b2 + kstep;
            PG8_LDB(B0, 0, 0); PG8_LDB(B1, 0, 1); PG8_SCHED; PG8_LDA(At, 0, 0); PG8_STAGE_A(PG8_SA(1, 1), a1, 1, false);
            PG8_WAIT_V(8); PG8_WAIT_L(0); PG8_BAR; PG8_MMA(0, 0, At, B0); PG8_MMA(0, 1, At, B1); PG8_BAR; PG8_SCHED;
            PG8_LDA(At, 0, 1); PG8_STAGE(PG8_SB(0, 0), b2, voffB); PG8_STAGE(PG8_SB(0, 1), b2 + hstepB, voffB); PG8_STAGE_A(PG8_SA(0, 0), a2, 0, last);
            PG8_WAIT_V(8); PG8_WAIT_L(0); PG8_BAR; PG8_MMA(1, 0, At, B0); PG8_MMA(1, 1, At, B1); PG8_BAR; PG8_SCHED;
            PG8_LDB(B0, 1, 0); PG8_LDB(B1, 1, 1); PG8_SCHED; PG8_LDA(At, 1, 0); PG8_STAGE_A(PG8_SA(0, 1), a2, 1, last);
            PG8_WAIT_V(8); PG8_WAIT_L(0); PG8_BAR; PG8_MMA(0, 0, At, B0); PG8_MMA(0, 1, At, B1); PG8_BAR; PG8_SCHED;
            PG8_LDA(At, 1, 1); PG8_STAGE(PG8_SB(1, 0), b3, voffB); PG8_STAGE(PG8_SB(1, 1), b3 + hstepB, voffB); PG8_STAGE_A(PG8_SA(1, 0), a3, 0, last);
            PG8_WAIT_V(8); PG8_WAIT_L(0); PG8_BAR; PG8_MMA(1, 0, At, B0); PG8_MMA(1, 1, At, B1); PG8_BAR; PG8_SCHED;
        }
        if constexpr (GATHER && I8) { ((PG8_LAS float*)(lds + 131072 + 4096 + 8192))[opq_tid() & 255] = pf_s; PG8_WAIT_L(0); }
        if (wr == 0) PG8_BAR;
        { const int l2 = opq_tid() & 63; E(acc, cur, wr, wc, l2 & 15, l2 >> 4); }
        if (!has_next) break;
#pragma unroll
        for (int a = 0; a < 2; ++a)
#pragma unroll
            for (int b = 0; b < 2; ++b)
#pragma unroll
                for (int m = 0; m < 4; ++m)
#pragma unroll
                    for (int n = 0; n < 2; ++n) acc[a][b][m][n] = (f32x4){0.f, 0.f, 0.f, 0.f};
        cur = nxt; cA = nA; cB = nB; ++ui;
        if constexpr (GATHER) {
#pragma unroll
            for (int h = 0; h < 2; ++h) { vc[h][0] = vn[h][0]; vc[h][1] = vn[h][1]; } }
        if (wr == 1) PG8_BAR;
    }
    PG8_WAIT_V(0);
    PG8_BAR;
#undef PG8_STAGE_A
#undef PG8_SA
#undef PG8_SB
#undef PG8_STAGE
#undef PG8_LDA
#undef PG8_LDB
#undef PG8_MMA
#undef PG8_WAIT_V
#undef PG8_WAIT_L
#undef PG8_BAR
#undef PG8_SCHED
#undef PG8_LOADROWS
}
}

struct SchedDense {
    const char* A; const char* Bt; int nM, nN, G, c; size_t tstepA, tstepB; bool rev = false;
    DI void init(const void* A_, int lda, const void* Bt_, int K, int M, int N, int G_, int c_) { A = (const char*)A_; Bt = (const char*)Bt_; nM = M / 256; nN = N / 256; G = G_; c = c_; tstepA = (size_t)256 * lda * 2; tstepB = (size_t)256 * K * 2; }
    DI bool next(int i, pg8::Unit& u) const {
        const int L = i * G + c; if (L >= nM * nN) return false;
        const int nig = 8 * nN, gid = L / nig, fm = gid * 8, gsz = (nM - fm) < 8 ? (nM - fm) : 8, w = L - gid * nig;
        u.pm = fm + (w % gsz); if (rev) u.pm = nM - 1 - u.pm; u.pn = w / gsz; u.aux = 0; u.nvalid = 256; u.A = A + (size_t)u.pm * tstepA; u.B = Bt + (size_t)u.pn * tstepB; u.rows = nullptr; return true; }
};
struct SchedBranch {
    const char* A; const char* Bt; int nM, G, c;
    DI void init(const void* A_, const void* Bt_, int M, int G_, int c_) { A = (const char*)A_; Bt = (const char*)Bt_; nM = M / 256; G = G_; c = c_; }
    DI bool next(int i, pg8::Unit& u) const {
        const int L = i * G + c; if (L >= nM * 16) return false;
        u.pm = L >> 4; const int b = (L >> 2) & 3; u.pn = L & 3; u.aux = b; u.nvalid = 256;
        u.A = A + (size_t)u.pm * 256 * (D * 2) + b * 512; u.B = Bt + ((size_t)b * 1024 + u.pn * 256) * 512; u.rows = nullptr; return true; }
};
struct SchedMoe {
    bool rev = false; const char* A; const char* Bt; const int* rowtok; const int* off; const int* cnt; int nN, G, c, ntiles; size_t tstepA, estepB, tstepB; bool gather;
    DI bool next(int i, pg8::Unit& u) const {
        int rt, pn;
        if (G == 256) {
            const int v = i * 32 + (c >> 3), rl = v / nN; pn = v - rl * nN; rt = rl * 8 + (c & 7); if (rt >= ntiles) return false; }
        else { const int L = i * G + c; if (L >= ntiles * nN) return false; rt = L / nN; pn = L - rt * nN; }
        if (rev) rt = ntiles - 1 - rt;
        u.pm = rt; u.pn = pn; const int r0 = rt * 256; int e = 0;
#pragma unroll 1
        for (int k = 1; k < NE; ++k) e += (off[k] <= r0) ? 1 : 0;
        u.aux = e; u.A = gather ? A : A + (size_t)rt * tstepA; u.B = Bt + (size_t)e * estepB + (size_t)u.pn * tstepB;
        const int rin = r0 - off[e]; u.rows = rowtok + (size_t)e * T + rin; u.nvalid = cnt[e] - rin; return true; }
};

struct EpiStoreBf16 {
    static constexpr bool PERM = true;
    bf16* O; int ldc; int auxstride; const float* bias; int biasstride;
    DI void operator()(const pg8::f32x4 (&acc)[2][2][4][2], const pg8::Unit& u, int wr, int wc, int fr, int fq) const {
        const int row0 = u.pm * 256 + wr * 64 + fr, col0 = u.aux * auxstride + u.pn * 256 + wc * 32 + 8 * fq, bcol0 = u.pn * 256 + wc * 32 + 8 * fq;
        pg8::f32x4 bv[2][2];
#pragma unroll
        for (int bj = 0; bj < 2; ++bj)
#pragma unroll
            for (int n = 0; n < 2; ++n) bv[bj][n] = bias ? *(const pg8::f32x4*)(bias + (size_t)u.aux * biasstride + bcol0 + bj * 128 + 4 * n) : (pg8::f32x4){0.f, 0.f, 0.f, 0.f};
#pragma unroll
        for (int ai = 0; ai < 2; ++ai)
#pragma unroll
            for (int m = 0; m < 4; ++m) { bf16* rowp = O + (size_t)(row0 + ai * 128 + m * 16) * ldc + col0;
#pragma unroll
                for (int bj = 0; bj < 2; ++bj) { const pg8::f32x4 v0 = acc[ai][bj][m][0] + bv[bj][0], v1 = acc[ai][bj][m][1] + bv[bj][1];
                    pg8::u32x4 w; w.x = pg8::cvt_pk_bf16(v0[0], v0[1]); w.y = pg8::cvt_pk_bf16(v0[2], v0[3]); w.z = pg8::cvt_pk_bf16(v1[0], v1[1]); w.w = pg8::cvt_pk_bf16(v1[2], v1[3]);
                    *(pg8::u32x4*)(rowp + bj * 128) = w; } }
    }
};
DI float sigm_fast(float x) { return __builtin_amdgcn_rcpf(1.f + __builtin_amdgcn_exp2f(-LOG2E * x)); }
struct EpiMerge {
    static constexpr bool PERM = false;
    const bf16* YB; bf16* YM; const float* gb; const float* HS1; const float* GATES;
    DI void operator()(const pg8::f32x4 (&acc)[2][2][4][2], const pg8::Unit& u, int wr, int wc, int fr, int fq) const {
        const int row0 = u.pm * 256 + wr * 64 + fr, col = u.pn * 64 + wc * 16 + fq * 4;
        pg8::f32x4 bv[2][2];
#pragma unroll
        for (int bj = 0; bj < 2; ++bj)
#pragma unroll
            for (int n = 0; n < 2; ++n) bv[bj][n] = *(const pg8::f32x4*)(gb + (2 * bj + n) * 1024 + col);
#pragma unroll
        for (int ai = 0; ai < 2; ++ai)
#pragma unroll
            for (int m = 0; m < 4; ++m) { const size_t r = (size_t)(row0 + ai * 128 + m * 16); const float sa = HS1[r]; pg8::f32x4 y = (pg8::f32x4){0.f, 0.f, 0.f, 0.f};
#pragma unroll
                for (int bj = 0; bj < 2; ++bj)
#pragma unroll
                    for (int n = 0; n < 2; ++n) { const pg8::u32x2 yb = *(const pg8::u32x2*)(YB + r * 4096 + (2 * bj + n) * 1024 + col); const pg8::i32x4v iv = __builtin_bit_cast(pg8::i32x4v, acc[ai][bj][m][n]);
                        const pg8::f32x4 cs = *(const pg8::f32x4*)(GATES + u.pn * 256 + 128 * bj + 32 * wc + 16 * n + 4 * fq);
                        const pg8::f32x4 g = (pg8::f32x4){(float)iv[0] * sa * cs[0], (float)iv[1] * sa * cs[1], (float)iv[2] * sa * cs[2], (float)iv[3] * sa * cs[3]} + bv[bj][n];
                        y[0] += sigm_fast(g[0]) * __uint_as_float(yb.x << 16); y[1] += sigm_fast(g[1]) * __uint_as_float(yb.x & 0xffff0000u);
                        y[2] += sigm_fast(g[2]) * __uint_as_float(yb.y << 16); y[3] += sigm_fast(g[3]) * __uint_as_float(yb.y & 0xffff0000u); }
                pg8::u32x2 w; w.x = pg8::cvt_pk_bf16(y[0], y[1]); w.y = pg8::cvt_pk_bf16(y[2], y[3]); *(pg8::u32x2*)(YM + r * 1024 + col) = w; }
    }
};
struct EpiWo {
    static constexpr bool PERM = false;
    const float* xlat; const float* xctx; float* XF; const float* modg;
    DI void operator()(const pg8::f32x4 (&acc)[2][2][4][2], const pg8::Unit& u, int wr, int wc, int fr, int fq) const {
        const int row0 = u.pm * 256 + wr * 64 + fr, col0 = u.pn * 256 + wc * 32 + 4 * fq;
        const float* g = modg + (size_t)modidx(u.pm * 256) * 6144 + col0;
        pg8::f32x4 gv[2][2];
#pragma unroll
        for (int bj = 0; bj < 2; ++bj)
#pragma unroll
            for (int n = 0; n < 2; ++n) gv[bj][n] = *(const pg8::f32x4*)(g + bj * 128 + n * 16);
#pragma unroll
        for (int ai = 0; ai < 2; ++ai)
#pragma unroll
            for (int mp = 0; mp < 2; ++mp) { pg8::f32x4 t[2][2][2];
#pragma unroll
                for (int mm = 0; mm < 2; ++mm) { const int r = row0 + ai * 128 + (2 * mp + mm) * 16; const float* xs = (r < TL ? xlat + (size_t)r * D : xctx + (size_t)(r - TL) * D) + col0;
#pragma unroll
                    for (int bj = 0; bj < 2; ++bj)
#pragma unroll
                        for (int n = 0; n < 2; ++n) t[mm][bj][n] = *(const pg8::f32x4*)(xs + bj * 128 + n * 16); }
#pragma unroll
                for (int mm = 0; mm < 2; ++mm) { const int m = 2 * mp + mm; const int r = row0 + ai * 128 + m * 16; float* xo = XF + (size_t)r * D + col0;
#pragma unroll
                    for (int bj = 0; bj < 2; ++bj)
#pragma unroll
                        for (int n = 0; n < 2; ++n) *(pg8::f32x4*)(xo + bj * 128 + n * 16) = t[mm][bj][n] + gv[bj][n] * acc[ai][bj][m][n]; } }
    }
};
struct EpiProjFused {
    static constexpr bool PERM = true;
    bf16 *CU, *AQ, *DQ, *DK, *DV, *NQ, *NK, *NV, *KPE; float *QBD, *QBN; const float* ROPE;
    const float *cqg, *ckvg, *dqg, *dkg, *nqg, *nkg;
    float kbd, kbn, nbias; float* P;
    const float* HS1; const float* WINS;
    DI static float red4(float v, int lane) { v += lane_xor(v, lane, 16); v += lane_xor(v, lane, 32); return v; }
    DI static void st8(bf16* dst, const float (&x)[8]) { pg8::u32x4 w; w.x = pg8::cvt_pk_bf16(x[0], x[1]); w.y = pg8::cvt_pk_bf16(x[2], x[3]); w.z = pg8::cvt_pk_bf16(x[4], x[5]); w.w = pg8::cvt_pk_bf16(x[6], x[7]); *(pg8::u32x4*)dst = w; }
    DI void operator()(const pg8::f32x4 (&acc)[2][2][4][2], const pg8::Unit& u, int wr, int wc, int fr, int fq) const {
        const int t = u.pn, lane = fr + 16 * fq, row0 = u.pm * 256 + wr * 64 + fr; const bool lat = u.pm < TL / 256;
        float* SL = P + 2048;
        { const int te = (wr * 4 + wc) * 64 + lane; const float* src = te < 256 ? HS1 + u.pm * 256 + te : WINS + 256 * t + (te - 256); SL[te] = *src;
          asm volatile("s_waitcnt lgkmcnt(0)" ::: "memory"); __builtin_amdgcn_s_barrier(); asm volatile("" ::: "memory"); }
        const float* sap = SL + wr * 64 + fr; const float* sbp = SL + 256 + 32 * wc + 8 * fq;
#define GET8(ai, bj, m, x) do { const float sa_ = sap[(ai) * 128 + (m) * 16]; _Pragma("unroll") for (int n_ = 0; n_ < 2; ++n_) { const pg8::i32x4v iv_ = __builtin_bit_cast(pg8::i32x4v, acc[ai][bj][m][n_]); \
        const pg8::f32x4 sb_ = *(const pg8::f32x4*)(sbp + 128 * (bj) + 4 * n_); _Pragma("unroll") for (int j_ = 0; j_ < 4; ++j_) x[4 * n_ + j_] = (float)iv_[j_] * sa_ * sb_[j_]; } } while (0)
        if (t < 2) {
#pragma unroll
            for (int ai = 0; ai < 2; ++ai)
#pragma unroll
                for (int m = 0; m < 4; ++m) { float a[8], g[8], o[8]; GET8(ai, 0, m, a); GET8(ai, 1, m, g);
#pragma unroll
                    for (int i = 0; i < 8; ++i) o[i] = a[i] * sigm_fast(g[i]);
                    st8(CU + (size_t)(row0 + ai * 128 + m * 16) * 256 + 128 * t + 32 * wc + 8 * fq, o); }
        } else if (t < 5) {
#pragma unroll
            for (int bj = 0; bj < 2; ++bj) { const int ds = (t - 2) * 8 + bj * 4 + wc, head = ds / 6, kind = ds - head * 6;
                const bool isq = kind < 2, isv = kind >= 4; const float* gp = (isq ? dqg : dkg) + 8 * fq; float gg[8];
#pragma unroll
                for (int i = 0; i < 8; ++i) gg[i] = gp[i];
#pragma unroll
                for (int ai = 0; ai < 2; ++ai)
#pragma unroll
                    for (int m = 0; m < 4; ++m) { const int r = row0 + ai * 128 + m * 16; float x[8]; GET8(ai, bj, m, x);
                        if (isv) { st8(DV + (size_t)r * 256 + head * 64 + (kind - 4) * 32 + 8 * fq, x); continue; }
                        float ss = 0.f;
#pragma unroll
                        for (int i = 0; i < 8; ++i) ss += x[i] * x[i];
                        const float rs = rsqrtf(red4(ss, lane) * (1.f / 32.f) + EPS);
#pragma unroll
                        for (int i = 0; i < 8; ++i) x[i] = x[i] * rs * gg[i];
                        float pt[8];
#pragma unroll
                        for (int i = 0; i < 8; ++i) pt[i] = lane_xor(x[i], lane, 32);
                        if (lat) { const float* rp = ROPE + (size_t)(r & (SEQ - 1)) * 32 + 8 * (fq & 1); const bool first = fq < 2;
                            const pg8::f32x4 c0 = *(const pg8::f32x4*)rp, c1 = *(const pg8::f32x4*)(rp + 4), s0 = *(const pg8::f32x4*)(rp + 16), s1 = *(const pg8::f32x4*)(rp + 20);
#pragma unroll
                            for (int i = 0; i < 8; ++i) { const float cs = i < 4 ? c0[i & 3] : c1[i & 3], sn = i < 4 ? s0[i & 3] : s1[i & 3]; x[i] = first ? x[i] * cs - pt[i] * sn : x[i] * cs + pt[i] * sn; } }
                        if (isq) { float qn = 0.f;
#pragma unroll
                            for (int i = 0; i < 8; ++i) { x[i] *= 0.17677669529663687f * LOG2E; qn += x[i] * x[i]; }
                            qn = red4(qn, lane); if (fq == 0) QBD[(size_t)r * 8 + head * 2 + kind] = -(sqrtf(qn) * kbd + 0.05f); }
                        st8((isq ? DQ : DK) + (size_t)r * 256 + head * 64 + (kind & 1) * 32 + 8 * fq, x); } }
        } else if (t < 7) {
            const int pi = (t - 5) * 4 + wc, head = pi >> 1; const bool isq = (pi & 1) == 0; const float* gp = (isq ? nqg : nkg) + 8 * fq; float g0[8], g1[8];
#pragma unroll
            for (int i = 0; i < 8; ++i) { g0[i] = gp[i]; g1[i] = gp[32 + i]; }
#pragma unroll
            for (int ai = 0; ai < 2; ++ai)
#pragma unroll
                for (int m = 0; m < 4; ++m) { const int r = row0 + ai * 128 + m * 16; float x0[8], x1[8]; GET8(ai, 0, m, x0); GET8(ai, 1, m, x1); float ss = 0.f;
#pragma unroll
                    for (int i = 0; i < 8; ++i) ss += x0[i] * x0[i] + x1[i] * x1[i];
                    const float rs = rsqrtf(red4(ss, lane) * (1.f / 64.f) + EPS) * (isq ? 0.125f * LOG2E : 1.f); float qn = 0.f;
#pragma unroll
                    for (int i = 0; i < 8; ++i) { x0[i] = x0[i] * rs * g0[i]; x1[i] = x1[i] * rs * g1[i]; qn += x0[i] * x0[i] + x1[i] * x1[i]; }
                    if (isq) { qn = red4(qn, lane); if (fq == 0) QBN[(size_t)r * 4 + head] = -(sqrtf(qn) * kbn + nbias); }
                    bf16* dst = (isq ? NQ : NK) + (size_t)r * 256 + head * 64 + 8 * fq; st8(dst, x0); st8(dst + 32, x1); }
        } else if (t == 7) {
#pragma unroll
            for (int bj = 0; bj < 2; ++bj) { const int sl = bj * 4 + wc, head = sl >> 1, half = sl & 1;
#pragma unroll
                for (int ai = 0; ai < 2; ++ai)
#pragma unroll
                    for (int m = 0; m < 4; ++m) { float x[8]; GET8(ai, bj, m, x); st8(NV + (size_t)(row0 + ai * 128 + m * 16) * 256 + head * 64 + half * 32 + 8 * fq, x); } }
        } else {
            const int nsl = t == 8 ? 6 : 4;
#pragma unroll
            for (int bj = 0; bj < 2; ++bj) { const int sl = bj * 4 + wc;
#pragma unroll
                for (int ai = 0; ai < 2; ++ai)
#pragma unroll
                    for (int m = 0; m < 4; ++m) { float x[8]; GET8(ai, bj, m, x); float ss = 0.f;
#pragma unroll
                        for (int i = 0; i < 8; ++i) ss += x[i] * x[i];
                        ss = red4(ss, lane); if (fq == 0) P[(ai * 128 + wr * 64 + m * 16 + fr) * 8 + sl] = sl < nsl ? ss : 0.f; } }
            asm volatile("s_waitcnt lgkmcnt(0)" ::: "memory"); __builtin_amdgcn_s_barrier(); asm volatile("" ::: "memory");
#pragma unroll
            for (int bj = 0; bj < 2; ++bj) { const int sl = bj * 4 + wc; const float* gp = (t == 8 ? cqg : ckvg) + 32 * (sl < nsl ? sl : 0) + 8 * fq; float gg[8];
#pragma unroll
                for (int i = 0; i < 8; ++i) gg[i] = gp[i];
#pragma unroll
                for (int ai = 0; ai < 2; ++ai)
#pragma unroll
                    for (int m = 0; m < 4; ++m) { const int rl = ai * 128 + wr * 64 + m * 16 + fr, r = u.pm * 256 + rl; float x[8]; GET8(ai, bj, m, x);
                        const pg8::f32x4 p0 = *(const pg8::f32x4*)(P + rl * 8), p1 = *(const pg8::f32x4*)(P + rl * 8 + 4);
                        const float tot = (p0[0] + p0[1]) + (p0[2] + p0[3]) + (p1[0] + p1[1]) + (p1[2] + p1[3]);
                        const float rs = rsqrtf(tot * (t == 8 ? 1.f / 192.f : 1.f / 128.f) + EPS);
                        if (sl < nsl) {
#pragma unroll
                            for (int i = 0; i < 8; ++i) x[i] = x[i] * rs * gg[i];
                            st8(AQ + (size_t)r * 384 + (t == 8 ? 0 : 192) + 32 * sl + 8 * fq, x); }
                        else if (t == 8 && sl == 6) st8(KPE + (size_t)r * 32 + 8 * fq, x);
                        else if (t == 9 && sl < 6) {
#pragma unroll
                            for (int i = 0; i < 8; ++i) x[i] = 0.f;
                            st8(AQ + (size_t)r * 384 + 320 + 32 * (sl - 4) + 8 * fq, x); } } }
            asm volatile("s_waitcnt lgkmcnt(0)" ::: "memory"); __builtin_amdgcn_s_barrier(); asm volatile("" ::: "memory");
        }
#undef GET8
    }
};
struct EpiQkvFused {
    static constexpr bool PERM = true;
    bf16 *MQ, *MK, *MV; const bf16* KPE; float* QBM; const float* ROPE; const float *gq, *gk; float nbconst; float* P;
    DI static float red4(float v, int lane) { v += lane_xor(v, lane, 16); v += lane_xor(v, lane, 32); return v; }
    DI static void st8(bf16* dst, const float (&x)[8]) { pg8::u32x4 w; w.x = pg8::cvt_pk_bf16(x[0], x[1]); w.y = pg8::cvt_pk_bf16(x[2], x[3]); w.z = pg8::cvt_pk_bf16(x[4], x[5]); w.w = pg8::cvt_pk_bf16(x[6], x[7]); *(pg8::u32x4*)dst = w; }
    DI void rope8(float (&x)[8], int r, int fq, int lane) const {
        float pt[8];
#pragma unroll
        for (int i = 0; i < 8; ++i) pt[i] = lane_xor(x[i], lane, 32);
        const float* rp = ROPE + (size_t)(r & (SEQ - 1)) * 32 + 8 * (fq & 1); const bool first = fq < 2;
        const pg8::f32x4 c0 = *(const pg8::f32x4*)rp, c1 = *(const pg8::f32x4*)(rp + 4), s0 = *(const pg8::f32x4*)(rp + 16), s1 = *(const pg8::f32x4*)(rp + 20);
#pragma unroll
        for (int i = 0; i < 8; ++i) { const float cs = i < 4 ? c0[i & 3] : c1[i & 3], sn = i < 4 ? s0[i & 3] : s1[i & 3]; x[i] = first ? x[i] * cs - pt[i] * sn : x[i] * cs + pt[i] * sn; }
    }
    DI void operator()(const pg8::f32x4 (&acc)[2][2][4][2], const pg8::Unit& u, int wr, int wc, int fr, int fq) const {
        const int t = u.pn, lane = fr + 16 * fq, row0 = u.pm * 256 + wr * 64 + fr; const bool lat = u.pm < TL / 256;
#define GET8(ai, bj, m, x) do { _Pragma("unroll") for (int n_ = 0; n_ < 2; ++n_) _Pragma("unroll") for (int j_ = 0; j_ < 4; ++j_) x[4 * n_ + j_] = acc[ai][bj][m][n_][j_]; } while (0)
        if (t < 2) {
#pragma unroll
            for (int bj = 0; bj < 2; ++bj)
#pragma unroll
                for (int ai = 0; ai < 2; ++ai)
#pragma unroll
                    for (int m = 0; m < 4; ++m) { float x[8]; GET8(ai, bj, m, x); float ss = 0.f;
#pragma unroll
                        for (int i = 0; i < 8; ++i) ss += x[i] * x[i];
                        ss = red4(ss, lane); if (fq == 0) P[(ai * 128 + wr * 64 + m * 16 + fr) * 8 + bj * 4 + wc] = wc < 3 ? ss : 0.f; }
            asm volatile("s_waitcnt lgkmcnt(0)" ::: "memory"); __builtin_amdgcn_s_barrier(); asm volatile("" ::: "memory");
            if (wc < 3) {
#pragma unroll
                for (int bj = 0; bj < 2; ++bj) { const int head = 2 * t + bj; const float* gp = gq + 32 * wc + 8 * fq; asm volatile("" : "+v"(gp)); float gg[8];
#pragma unroll
                    for (int i = 0; i < 8; ++i) gg[i] = gp[i];
#pragma unroll
                    for (int ai = 0; ai < 2; ++ai)
#pragma unroll
                        for (int m = 0; m < 4; ++m) { const int rl = ai * 128 + wr * 64 + m * 16 + fr, r = u.pm * 256 + rl; float x[8]; GET8(ai, bj, m, x);
                            const pg8::f32x4 pp = *(const pg8::f32x4*)(P + rl * 8 + bj * 4);
                            const float rs = rsqrtf((pp[0] + pp[1] + pp[2]) * (1.f / 96.f) + EPS);
#pragma unroll
                            for (int i = 0; i < 8; ++i) x[i] = x[i] * rs * gg[i];
                            if (wc == 2 && lat) rope8(x, r, fq, lane);
#pragma unroll
                            for (int i = 0; i < 8; ++i) x[i] *= 0.10206207261596577f * LOG2E;
                            st8(MQ + (size_t)r * 384 + head * 96 + 32 * wc + 8 * fq, x);
                            if (wc == 0 && fq == 0) QBM[(size_t)r * 4 + head] = nbconst; } }
            }
            asm volatile("s_waitcnt lgkmcnt(0)" ::: "memory"); __builtin_amdgcn_s_barrier(); asm volatile("" ::: "memory");
        } else if (wc < 2) {
            const int head = 2 * (t - 2) + wc;
#pragma unroll
            for (int ai = 0; ai < 2; ++ai)
#pragma unroll
                for (int m = 0; m < 4; ++m) { const int r = row0 + ai * 128 + m * 16; float xp[8];
                    { const uint4 kq = *(const uint4*)(KPE + (size_t)r * 32 + 8 * fq); const unsigned w[4] = {kq.x, kq.y, kq.z, kq.w};
#pragma unroll
                      for (int i = 0; i < 4; ++i) { xp[2 * i] = __uint_as_float(w[i] << 16); xp[2 * i + 1] = __uint_as_float(w[i] & 0xffff0000u); } }
                    float ss = 0.f;
#pragma unroll
                    for (int n = 0; n < 2; ++n)
#pragma unroll
                        for (int j = 0; j < 4; ++j) ss += acc[ai][0][m][n][j] * acc[ai][0][m][n][j] + acc[ai][1][m][n][j] * acc[ai][1][m][n][j] + xp[4 * n + j] * xp[4 * n + j];
                    const float rs = rsqrtf(red4(ss, lane) * (1.f / 96.f) + EPS);
                    const float* gp = gk + 8 * fq; asm volatile("" : "+v"(gp));
                    bf16* dst = MK + (size_t)r * 384 + head * 96 + 8 * fq;
#pragma unroll
                    for (int bj = 0; bj < 2; ++bj) { float x[8]; GET8(ai, bj, m, x);
#pragma unroll
                        for (int i = 0; i < 8; ++i) x[i] = x[i] * rs * gp[32 * bj + i];
                        st8(dst + 32 * bj, x); }
#pragma unroll
                    for (int i = 0; i < 8; ++i) xp[i] = xp[i] * rs * gp[64 + i];
                    if (lat) rope8(xp, r, fq, lane);
                    st8(dst + 64, xp); }
        } else {
            const int head = 2 * (t - 2) + wc - 2;
#pragma unroll
            for (int bj = 0; bj < 2; ++bj)
#pragma unroll
                for (int ai = 0; ai < 2; ++ai)
#pragma unroll
                    for (int m = 0; m < 4; ++m) { float x[8]; GET8(ai, bj, m, x); st8(MV + (size_t)(row0 + ai * 128 + m * 16) * 256 + head * 64 + 32 * bj + 8 * fq, x); }
        }
#undef GET8
    }
};
struct EpiMoeActI8 {
    static constexpr bool PERM = true;
    bf16* ACT; const float* bgu; const float* HS; const float* WGUS;
    const float* SLm;
    DI void operator()(const pg8::f32x4 (&acc)[2][2][4][2], const pg8::Unit& u, int wr, int wc, int fr, int fq) const {
        const int rl0 = wr * 64 + fr, row0 = u.pm * 256 + rl0, col0 = u.pn * 128 + wc * 32 + 8 * fq;
        const float* b = bgu + (size_t)u.aux * 2048 + col0;
        const pg8::f32x4 bg0 = *(const pg8::f32x4*)(b), bg1 = *(const pg8::f32x4*)(b + 4), bu0 = *(const pg8::f32x4*)(b + 1024), bu1 = *(const pg8::f32x4*)(b + 1028);
        const float* cs = WGUS + (size_t)u.aux * 2048 + u.pn * 256 + wc * 32 + 8 * fq;
        const pg8::f32x4 sg0 = *(const pg8::f32x4*)(cs), sg1 = *(const pg8::f32x4*)(cs + 4), su0 = *(const pg8::f32x4*)(cs + 128), su1 = *(const pg8::f32x4*)(cs + 132);
        float sas[2][4];
#pragma unroll
        for (int ai = 0; ai < 2; ++ai)
#pragma unroll
            for (int m = 0; m < 4; ++m) sas[ai][m] = SLm[rl0 + ai * 128 + m * 16];
#pragma unroll
        for (int ai = 0; ai < 2; ++ai)
#pragma unroll
            for (int m = 0; m < 4; ++m) { const float sa = sas[ai][m]; float a[8];
#pragma unroll
                for (int n = 0; n < 2; ++n) { const pg8::i32x4v ig = __builtin_bit_cast(pg8::i32x4v, acc[ai][0][m][n]), iu = __builtin_bit_cast(pg8::i32x4v, acc[ai][1][m][n]);
#pragma unroll
                    for (int j = 0; j < 4; ++j) { const float gg = (float)ig[j] * sa * (n ? sg1[j] : sg0[j]) + (n ? bg1[j] : bg0[j]), uu = (float)iu[j] * sa * (n ? su1[j] : su0[j]) + (n ? bu1[j] : bu0[j]);
                        const float g = fminf(gg, 7.f), uc = fminf(fmaxf(uu, -7.f), 7.f); a[4 * n + j] = (uc + 1.f) * (g * sigm_fast(1.702f * g)); } }
                pg8::u32x4 w; w.x = pg8::cvt_pk_bf16(a[0], a[1]); w.y = pg8::cvt_pk_bf16(a[2], a[3]); w.z = pg8::cvt_pk_bf16(a[4], a[5]); w.w = pg8::cvt_pk_bf16(a[6], a[7]);
                *(pg8::u32x4*)(ACT + (size_t)(row0 + ai * 128 + m * 16) * D + col0) = w; }
    }
};
struct EpiMoeAct {
    static constexpr bool PERM = true;
    bf16* ACT; const float* bgu;
    DI void operator()(const pg8::f32x4 (&acc)[2][2][4][2], const pg8::Unit& u, int wr, int wc, int fr, int fq) const {
        const int row0 = u.pm * 256 + wr * 64 + fr, col0 = u.pn * 128 + wc * 32 + 8 * fq;
        const float* b = bgu + (size_t)u.aux * 2048 + col0;
        const pg8::f32x4 bg0 = *(const pg8::f32x4*)(b), bg1 = *(const pg8::f32x4*)(b + 4), bu0 = *(const pg8::f32x4*)(b + 1024), bu1 = *(const pg8::f32x4*)(b + 1028);
#pragma unroll
        for (int ai = 0; ai < 2; ++ai)
#pragma unroll
            for (int m = 0; m < 4; ++m) { float a[8];
#pragma unroll
                for (int n = 0; n < 2; ++n) { const pg8::f32x4 gg = acc[ai][0][m][n] + (n ? bg1 : bg0), uu = acc[ai][1][m][n] + (n ? bu1 : bu0);
#pragma unroll
                    for (int j = 0; j < 4; ++j) { const float g = fminf(gg[j], 7.f), uc = fminf(fmaxf(uu[j], -7.f), 7.f); a[4 * n + j] = (uc + 1.f) * (g * sigm_fast(1.702f * g)); } }
                pg8::u32x4 w; w.x = pg8::cvt_pk_bf16(a[0], a[1]); w.y = pg8::cvt_pk_bf16(a[2], a[3]); w.z = pg8::cvt_pk_bf16(a[4], a[5]); w.w = pg8::cvt_pk_bf16(a[6], a[7]);
                *(pg8::u32x4*)(ACT + (size_t)(row0 + ai * 128 + m * 16) * D + col0) = w; }
    }
};

struct MapId { int off; DI int operator()(int n) const { return n + off; } };
struct MapProj { DI int operator()(int s) const {
    int t, slot;
    if (s < 512) { const int isg = s >> 8, ch = s & 255; t = ch >> 7; slot = isg * 4 + ((ch >> 5) & 3); }
    else if (s < OFF_C) { const int m = s - OFF_B; if (m < 192) { t = 8; slot = m >> 5; } else if (m < 320) { t = 9; slot = (m - 192) >> 5; } else { t = 8; slot = 6; } }
    else if (s < OFF_D) { const int m = s - OFF_C, head = m / 192, w = m - head * 192, ds = head * 6 + (w >> 5); t = 2 + (ds >> 3); slot = ds & 7; }
    else { const int m = s - OFF_D, head = m / 192, w = m - head * 192;
      if (w < 128) { const int pi = head * 2 + (w >> 6); t = 5 + (pi >> 2); slot = ((w >> 5) & 1) * 4 + (pi & 3); } else { t = 7; slot = head * 2 + ((w - 128) >> 5); } }
    return 256 * t + (slot >> 2) * 128 + (slot & 3) * 32 + (s & 31); } };
struct MapQ  { DI int operator()(int s) const { const int head = s / 96, w = s - head * 96; return 256 * (head >> 1) + 128 * (head & 1) + 32 * (w >> 5) + (s & 31); } };
struct MapKV { DI int operator()(int s) const { const int head = s >> 7, w = s & 127, isv = w >> 6, half = (w >> 5) & 1; return 256 * (2 + (head >> 1)) + 128 * half + 32 * (2 * isv + (head & 1)) + (s & 31); } };
struct MapGate { DI int operator()(int s) const { const int b = s >> 10, w = s & 1023, pn = w >> 6, lc = w & 63; return 256 * pn + 128 * (b >> 1) + 32 * (lc >> 4) + 16 * (b & 1) + (lc & 15); } };
struct MapGu { DI int operator()(int s) const { const int isu = s >> 10, c = s & 1023; return 256 * (c >> 7) + 128 * isu + (c & 127); } };
struct CvtItem { const float* W; bf16* WT; int N, ldk, kdst0, mapt, mapoff, item; };
DI CvtItem cvt_decode(PRef p, int it) {
    constexpr int I_WIN_ = (D / 64) * (INW / 32), I_UQ_ = 3 * 12, I_UKV_ = 2 * 16, I_BR_ = 4 * 32, I_GATE_ = 16 * 128, I_WO_ = 16 * 32, I_GU_ = 16 * 64, I_DN_ = 16 * 32;
    constexpr int PER_L = I_UQ_ + I_UKV_ + 4 * I_BR_ + I_WO_ + NE * I_DN_;
    unsigned char* ws = p.ws; CvtItem c; (void)I_WIN_; (void)I_GATE_; c.mapt = 0; c.mapoff = 0; c.kdst0 = 0;
    const int l = it / PER_L; int r = it - l * PER_L;
    if (r < I_UQ_) { c.W = p.in[I_WUQ] + (size_t)l * 192 * 384; c.N = 384; c.WT = (bf16*)(ws + WS_QKV_T) + (size_t)l * 1024 * 384; c.ldk = 384; c.mapt = 4; c.item = r; return c; } r -= I_UQ_;
    if (r < I_UKV_) { c.W = p.in[I_WUKV] + (size_t)l * 128 * 512; c.N = 512; c.WT = (bf16*)(ws + WS_QKV_T) + (size_t)l * 1024 * 384; c.ldk = 384; c.kdst0 = 192; c.mapt = 5; c.item = r; return c; } r -= I_UKV_;
    if (r < 4 * I_BR_) { const int b = r / I_BR_; c.W = (b == 0 ? p.in[I_CONVOUT] : b == 1 ? p.in[I_MLAOUT] : b == 2 ? p.in[I_DIFFOUT] : p.in[I_NAOUT]) + (size_t)l * 256 * D; c.N = D;
        c.WT = (bf16*)(ws + WS_WB_T) + ((size_t)l * 4 + b) * 1024 * 256; c.ldk = 256; c.item = r - b * I_BR_; return c; } r -= 4 * I_BR_;
    if (r < I_WO_) { c.W = p.in[I_WO] + (size_t)l * D * D; c.N = D; c.WT = (bf16*)(ws + WS_WO_T) + (size_t)l * D * D; c.ldk = D; c.item = r; return c; } r -= I_WO_;
    const int e = r / I_DN_; r -= e * I_DN_; (void)I_GU_;
    c.W = p.in[I_WDN] + ((size_t)l * NE + e) * DFF * D; c.N = D; c.WT = (bf16*)(ws + WS_WDN_T) + ((size_t)l * NE + e) * D * DFF; c.ldk = DFF; c.item = r; return c;
}
DI void cvt_load(const CvtItem& c, float (&v)[32], int lane) {
    const int nblk = c.N / 32, kb = c.item / nblk, nb = c.item - kb * nblk;
    const float* src = c.W + (size_t)(64 * kb + (lane >> 5)) * c.N + 32 * nb + (lane & 31);
#pragma unroll
    for (int i = 0; i < 32; ++i) v[i] = src[(size_t)(2 * i) * c.N];
}
DI void cvt_store(const CvtItem& c, const float (&v)[32], float* scr, int lane) {
    const int nblk = c.N / 32, kb = c.item / nblk, nb = c.item - kb * nblk, k0 = 64 * kb, n0 = 32 * nb;
#pragma unroll
    for (int i = 0; i < 32; ++i) scr[(2 * i + (lane >> 5)) * 33 + (lane & 31)] = v[i];
    asm volatile("s_waitcnt lgkmcnt(0)" ::: "memory");
    const int cc = lane & 7;
#pragma unroll
    for (int j = 0; j < 4; ++j) { const int n = (lane >> 3) + 8 * j; const float* s = scr + (8 * cc) * 33 + n;
        pg8::u32x4 o; o.x = pg8::cvt_pk_bf16(s[0 * 33], s[1 * 33]); o.y = pg8::cvt_pk_bf16(s[2 * 33], s[3 * 33]); o.z = pg8::cvt_pk_bf16(s[4 * 33], s[5 * 33]); o.w = pg8::cvt_pk_bf16(s[6 * 33], s[7 * 33]);
        const int sn = n0 + n; const int row = c.mapt == 0 ? sn + c.mapoff : (c.mapt == 1 ? MapGate()(sn) : (c.mapt == 2 ? MapGu()(sn) : (c.mapt == 3 ? MapProj()(sn) : (c.mapt == 4 ? MapQ()(sn) : MapKV()(sn)))));
        *(pg8::u32x4*)(c.WT + (size_t)row * c.ldk + c.kdst0 + k0 + 8 * cc) = o; }
    asm volatile("s_waitcnt lgkmcnt(0)" ::: "memory");
}
DI void ph_convert(PRef p, unsigned char* lds) {
    const int tid_ = opq_tid(); const int bid_ = opq_bid(), nblk_ = opq_nblk(); const int lane = tid_ & 63, wave = __builtin_amdgcn_readfirstlane(tid_ >> 6);
    float* scr = (float*)(lds + wave * 8704);
    const int gw = bid_ * 8 + wave, ngw = nblk_ * 8;
    constexpr int PER_L = 3 * 12 + 2 * 16 + 4 * 4 * 32 + 16 * 32 + NE * (16 * 32);
    const int total = 2 * PER_L;
    float va[32], vb[32];
    int it = gw;
    CvtItem ca, cb;
    if (it < total) { ca = cvt_decode(p, it); cvt_load(ca, va, lane); }
    for (; it < total; it += 2 * ngw) {
        const int i1 = it + ngw, i2 = it + 2 * ngw;
        if (i1 < total) { cb = cvt_decode(p, i1); cvt_load(cb, vb, lane); }
        cvt_store(ca, va, scr, lane);
        if (i2 < total) { ca = cvt_decode(p, i2); cvt_load(ca, va, lane); }
        if (i1 < total) cvt_store(cb, vb, scr, lane);
    }
    __syncthreads();
    { float* red = (float*)lds;
      const int n = tid_ & 31, kg = tid_ >> 5; signed char* W8 = (signed char*)(p.ws + WS_WGU_T); float* WS_ = (float*)(p.ws + WS_WGUS);
      float xa[64], xb[64];
#define I8_DECODE(it, src_, N_, dst_, sca_, kind_, nb_) const float* src_; int N_, kind_, nb_; signed char* dst_; float* sca_; \
        if ((it) < 4096) { const int le_ = (it) >> 6; nb_ = (it) & 63; src_ = p.in[I_WGU] + (size_t)le_ * D * 2048; N_ = 2048; dst_ = W8 + (size_t)le_ * 2048 * D * 2; sca_ = WS_ + (size_t)le_ * 2048; kind_ = 0; } \
        else if ((it) < 4096 + 150) { const int l_ = ((it) - 4096) / 75; nb_ = ((it) - 4096) - l_ * 75; src_ = p.in[I_WIN] + (size_t)l_ * D * INW; N_ = INW; dst_ = (signed char*)(p.ws + WS_WIN_T) + (size_t)l_ * PLD * D * 2; sca_ = (float*)(p.ws + WS_WINS) + l_ * PLD; kind_ = 1; } \
        else { const int l_ = ((it) - 4246) >> 7; nb_ = ((it) - 4246) & 127; src_ = p.in[I_GATEW] + (size_t)l_ * D * 4096; N_ = 4096; dst_ = (signed char*)(p.ws + WS_GATE_T) + (size_t)l_ * 4096 * D * 2; sca_ = (float*)(p.ws + WS_GATES) + l_ * 4096; kind_ = 2; }
#define GU_LOAD(dst, it) do { I8_DECODE(it, src_, N_, d8_, sc8_, kind_, nb_); (void)d8_; (void)sc8_; (void)kind_; const float* s2_ = src_ + (size_t)(64 * kg) * N_ + 32 * nb_ + n; \
        _Pragma("unroll") for (int i = 0; i < 64; ++i) dst[i] = s2_[(size_t)i * N_]; } while (0)
#define GU_EMIT(src, it) do { I8_DECODE(it, src_, N_, d8_, sc8_, kind_, nb_); (void)src_; float m_ = 0.f; _Pragma("unroll") for (int i = 0; i < 64; ++i) m_ = fmaxf(m_, fabsf(src[i])); \
        red[kg * 32 + n] = m_; __syncthreads(); \
        if (tid_ < 32) { float mm_ = 0.f; _Pragma("unroll") for (int g = 0; g < 16; ++g) mm_ = fmaxf(mm_, red[g * 32 + tid_]); red[512 + tid_] = mm_ > 0.f ? mm_ * (1.f / 127.f) : 1.f; } \
        __syncthreads(); const float sc_ = red[512 + n], inv_ = 1.f / sc_; const int col_ = 32 * nb_ + n; const int row_ = kind_ == 0 ? MapGu()(col_) : (kind_ == 1 ? MapProj()(col_) : MapGate()(col_)); \
        if (kg == 0) sc8_[row_] = sc_; \
        signed char* dst_ = d8_ + (size_t)row_ * D + 64 * kg; \
        _Pragma("unroll") for (int q = 0; q < 4; ++q) { unsigned w_[4]; _Pragma("unroll") for (int d = 0; d < 4; ++d) { unsigned b_ = 0; _Pragma("unroll") for (int i = 0; i < 4; ++i) { \
            const int v_ = (int)rintf(src[16 * q + 4 * d + i] * inv_); b_ |= ((unsigned)v_ & 255u) << (8 * i); } w_[d] = b_; } \
            *(uint4*)(dst_ + 16 * q) = make_uint4(w_[0], w_[1], w_[2], w_[3]); } \
        __syncthreads(); } while (0)
      const int nit = 2 * NE * 64 + 150 + 256; int it2 = bid_;
      if (it2 < nit) GU_LOAD(xa, it2);
      for (; it2 < nit; it2 += 2 * nblk_) { const int j1 = it2 + nblk_, j2 = it2 + 2 * nblk_;
        if (j1 < nit) GU_LOAD(xb, j1);
        GU_EMIT(xa, it2);
        if (j2 < nit) GU_LOAD(xa, j2);
        if (j1 < nit) GU_EMIT(xb, j1); }
#undef GU_LOAD
#undef GU_EMIT
#undef I8_DECODE
    }
}

#define LDSP ((PG8_LAS unsigned char*)lds)
DI void ph_proj_fast(PRef p, int l, unsigned char* lds) {
    const int bid_ = opq_bid(), nblk_ = opq_nblk(); const int tid0 = opq_tid(), lane0 = tid0 & 63;
    SchedDense S; S.init(p.ws + WS_H, D / 2, (const bf16*)(p.ws + WS_WIN_T) + (size_t)l * PLD * D, D / 2, T, PLD, nblk_, bid_);
    EpiProjFused E;
    E.CU = (bf16*)(p.ws + WS_CU); E.AQ = (bf16*)(p.ws + WS_AQ); E.DQ = (bf16*)(p.ws + WS_DQ); E.DK = (bf16*)(p.ws + WS_DK); E.DV = (bf16*)(p.ws + WS_DV);
    E.NQ = (bf16*)(p.ws + WS_NQ); E.NK = (bf16*)(p.ws + WS_NK); E.NV = (bf16*)(p.ws + WS_NV); E.KPE = (bf16*)(p.ws + WS_KPE);
    E.QBD = (float*)(p.ws + WS_QBD); E.QBN = (float*)(p.ws + WS_QBN); E.ROPE = (const float*)(p.ws + WS_ROPE);
    E.cqg = p.in[I_CQG] + l * 192; E.ckvg = p.in[I_CKVG] + l * 128; E.dqg = p.in[I_DQNG] + l * 32; E.dkg = p.in[I_DKNG] + l * 32; E.nqg = p.in[I_NQNG] + l * 64; E.nkg = p.in[I_NKNG] + l * 64;
    { float m = lane0 < 32 ? fabsf(p.in[I_DKNG][l * 32 + lane0]) : 0.f;
#pragma unroll
      for (int o = 1; o < 64; o <<= 1) m = fmaxf(m, lane_xor(m, lane0, o));
      float m2 = fabsf(p.in[I_NKNG][l * 64 + lane0]);
#pragma unroll
      for (int o = 1; o < 64; o <<= 1) m2 = fmaxf(m2, lane_xor(m2, lane0, o));
      float t0 = 5.656854249f * 1.004f * m, t1 = 8.f * 1.004f * m2, t2 = __int_as_float(((const int*)(p.ws + WS_CTL))[CW_BIASMAX + l]) * LOG2E + 0.05f;
      asm volatile("" : "+v"(t0), "+v"(t1), "+v"(t2));
      const int b0 = __builtin_amdgcn_readfirstlane(__float_as_int(t0)), b1 = __builtin_amdgcn_readfirstlane(__float_as_int(t1)), b2 = __builtin_amdgcn_readfirstlane(__float_as_int(t2));
      E.kbd = __int_as_float(b0); E.kbn = __int_as_float(b1); E.nbias = __int_as_float(b2); }
    E.P = (float*)(lds + 131072 + 4096); E.HS1 = (const float*)(p.ws + WS_HS1); E.WINS = (const float*)(p.ws + WS_WINS) + l * PLD;
    pg8::gemm_phase<EpiProjFused, SchedDense, false, true>(LDSP, D, D, S, E);
}
DI void ph_qkvraw_fast(PRef p, int l, unsigned char* lds) {
    const int bid_ = opq_bid(), nblk_ = opq_nblk(); const int lane0 = opq_tid() & 63;
    SchedDense S; S.init(p.ws + WS_AQ, 384, (const bf16*)(p.ws + WS_QKV_T) + (size_t)l * 1024 * 384, 384, T, 1024, nblk_, bid_);
    EpiQkvFused E; E.MQ = (bf16*)(p.ws + WS_MQ); E.MK = (bf16*)(p.ws + WS_MK); E.MV = (bf16*)(p.ws + WS_MV); E.KPE = (const bf16*)(p.ws + WS_KPE); E.QBM = (float*)(p.ws + WS_QBM);
    E.ROPE = (const float*)(p.ws + WS_ROPE); E.gq = p.in[I_QNG] + l * 96; E.gk = p.in[I_KNG] + l * 96; E.P = (float*)(lds + 131072 + 4096);
    { float mq = 0.f, mk = 0.f;
      for (int i = lane0; i < 96; i += 64) { mq = fmaxf(mq, fabsf(E.gq[i])); mk = fmaxf(mk, fabsf(E.gk[i])); }
#pragma unroll
      for (int o = 1; o < 64; o <<= 1) { mq = fmaxf(mq, lane_xor(mq, lane0, o)); mk = fmaxf(mk, lane_xor(mk, lane0, o)); }
      E.nbconst = __int_as_float(__builtin_amdgcn_readfirstlane(__float_as_int(-(96.f * 0.10206207261596577f * LOG2E * mq * mk * 1.004f + 0.05f)))); }
    pg8::gemm_phase<EpiQkvFused, SchedDense, false>(LDSP, 384, 384, S, E);
}
DI void ph_branch_fast(PRef p, int l, int nrows, unsigned char* lds) {
    const int bid_ = opq_bid(), nblk_ = opq_nblk();
    SchedBranch S; S.init(p.ws + WS_BI, (const bf16*)(p.ws + WS_WB_T) + (size_t)l * 4 * 1024 * 256, nrows, nblk_, bid_);
    EpiStoreBf16 E{(bf16*)(p.ws + WS_YB), 4096, 1024, nullptr, 0};
    pg8::gemm_phase<EpiStoreBf16, SchedBranch, false>(LDSP, D, 256, S, E);
}
DI void ph_merge_fast(PRef p, int l, int nrows, unsigned char* lds) {
    const int bid_ = opq_bid(), nblk_ = opq_nblk();
    SchedDense S; S.init(p.ws + WS_H, D / 2, (const bf16*)(p.ws + WS_GATE_T) + (size_t)l * 4096 * D, D / 2, nrows, 4096, nblk_, bid_);
    S.rev = true;
    EpiMerge E{(const bf16*)(p.ws + WS_YB), (bf16*)(p.ws + WS_YM), p.in[I_GATEB] + l * 4096, (const float*)(p.ws + WS_HS1), (const float*)(p.ws + WS_GATES) + l * 4096};
    pg8::gemm_phase<EpiMerge, SchedDense, false, true>(LDSP, D, D, S, E);
}
DI void ph_wo_fast(PRef p, int l, int nrows, unsigned char* lds) {
    const int bid_ = opq_bid(), nblk_ = opq_nblk();
    SchedDense S; S.init(p.ws + WS_YM, D, (const bf16*)(p.ws + WS_WO_T) + (size_t)l * D * D, D, nrows, D, nblk_, bid_);
    const float* XFc = (const float*)(p.ws + WS_XF);
    EpiWo E{l == 0 ? p.in[I_X] : XFc, l == 0 ? p.in[I_CTX] : XFc + (size_t)TL * D, (float*)(p.ws + WS_XF), (const float*)(p.ws + WS_MOD) + (size_t)l * 9 * 6144 + 2048};
    pg8::gemm_phase<EpiWo, SchedDense, false>(LDSP, D, D, S, E);
}
DI void moe_offsets(PRef p, int l, int* off, int tid) {
    const unsigned* cnt = (const unsigned*)(p.ws + WS_CTL) + CW_CNT + l * 64;
    if (tid == 0) expert_offsets(cnt, off);
    if (tid < NE) off[40 + tid] = (int)cnt[tid];
    __syncthreads();
}
DI void ph_moe1_fast(PRef p, int l, unsigned char* lds) {
    const int tid_ = opq_tid(); const int bid_ = opq_bid(), nblk_ = opq_nblk(); (void)bid_; (void)nblk_; int* off = (int*)(lds + 131072 + 1024); moe_offsets(p, l, off, tid_);
    SchedMoe S; S.A = (const char*)(p.ws + WS_H2); S.Bt = (const char*)((const bf16*)(p.ws + WS_WGU_T) + (size_t)l * NE * 2048 * D); S.rowtok = (const int*)(p.ws + WS_ROWTOK); S.off = off; S.cnt = off + 40;
    S.nN = 8; S.G = nblk_; S.c = bid_; S.ntiles = off[NE] >> 8; S.tstepA = 0; S.estepB = (size_t)2048 * D * 2  ; S.tstepB = (size_t)256 * D  ; S.gather = true;
    EpiMoeActI8 E{(bf16*)(p.ws + WS_ACT), p.in[I_BGU] + (size_t)l * NE * 2048, (const float*)(p.ws + WS_HS), (const float*)(p.ws + WS_WGUS) + (size_t)l * NE * 2048, (const float*)(lds + 131072 + 4096 + 8192)};
    pg8::gemm_phase<EpiMoeActI8, SchedMoe, true, true>(LDSP, D, D, S, E);
}
DI void ph_moe2_fast(PRef p, int l, unsigned char* lds) {
    const int tid_ = opq_tid(); const int bid_ = opq_bid(), nblk_ = opq_nblk(); (void)bid_; (void)nblk_; int* off = (int*)(lds + 131072 + 1024); moe_offsets(p, l, off, tid_);
    SchedMoe S; S.A = (const char*)(p.ws + WS_ACT); S.Bt = (const char*)((const bf16*)(p.ws + WS_WDN_T) + (size_t)l * NE * D * DFF); S.rowtok = (const int*)(p.ws + WS_ROWTOK); S.off = off; S.cnt = off + 40;
    S.nN = 4; S.G = nblk_; S.c = bid_; S.ntiles = off[NE] >> 8; S.tstepA = (size_t)256 * D * 2; S.estepB = (size_t)D * DFF * 2; S.tstepB = (size_t)256 * DFF * 2; S.gather = false;
    S.rev = true;
    EpiStoreBf16 E{(bf16*)(p.ws + WS_YE), D, 0, p.in[I_BDN] + (size_t)l * NE * D, D};
    pg8::gemm_phase<EpiStoreBf16, SchedMoe, false>(LDSP, DFF, DFF, S, E);
}

namespace fa {
using bf16x8 = __attribute__((ext_vector_type(8))) short;
using s16x4  = __attribute__((ext_vector_type(4))) short;
using f32x16 = __attribute__((ext_vector_type(16))) float;
using u32x4  = __attribute__((ext_vector_type(4))) unsigned;
constexpr int SHM_K = 64 * 256, SHM_V = 64 * 256;
constexpr float THR2 = 11.5f;
#define FA_KSWZ(row, colB) ((row) * 256 + ((colB) ^ (((row) & 7) << 4)))
#define FA_SBAR() __builtin_amdgcn_sched_barrier(0)
DI int crow(int r, int hi) { return (r & 3) + 8 * (r >> 2) + 4 * hi; }
DI unsigned cvtpk(float lo, float hi) { unsigned r; asm volatile("v_cvt_pk_bf16_f32 %0, %1, %2" : "=v"(r) : "v"(lo), "v"(hi)); return r; }
DI int v_st(int k, int c) { const int kk = k;        return ((kk >> 3) * 4 + (c >> 5)) * 512 + ((kk & 7) * 32 + (c & 31)) * 2; }
DI int v_rd_base(int lane) { return ((lane & 3) << 3) | (((lane >> 2) & 3) << 6) | (((lane >> 4) & 1) << 5) | (((lane >> 5) & 1) << 8); }
constexpr int v_rd_off(int d0, int ks, int half) { return d0 * 512 + ks * 4096 + half * 2048; }
template <int OFF> DI s16x4 tr_read(int vb) { s16x4 r; asm volatile("ds_read_b64_tr_b16 %0, %1 offset:%2" : "=&v"(r) : "v"(vb), "i"(OFF) : "memory"); return r; }
template <int D0> DI void pv_one(f32x16& od, int vb, bf16x8 pa0, bf16x8 pa1, bf16x8 pa2, bf16x8 pa3) {
  const s16x4 l0 = tr_read<v_rd_off(D0, 0, 0)>(vb), h0 = tr_read<v_rd_off(D0, 0, 1)>(vb), l1 = tr_read<v_rd_off(D0, 1, 0)>(vb), h1 = tr_read<v_rd_off(D0, 1, 1)>(vb);
  const s16x4 l2 = tr_read<v_rd_off(D0, 2, 0)>(vb), h2 = tr_read<v_rd_off(D0, 2, 1)>(vb), l3 = tr_read<v_rd_off(D0, 3, 0)>(vb), h3 = tr_read<v_rd_off(D0, 3, 1)>(vb);
  asm volatile("s_waitcnt lgkmcnt(0)" ::: "memory"); FA_SBAR();
#define FA_PK(L, H) (bf16x8){L[0], L[1], L[2], L[3], H[0], H[1], H[2], H[3]}
  od = __builtin_amdgcn_mfma_f32_32x32x16_bf16(pa0, FA_PK(l0, h0), od, 0, 0, 0);
  od = __builtin_amdgcn_mfma_f32_32x32x16_bf16(pa1, FA_PK(l1, h1), od, 0, 0, 0);
  od = __builtin_amdgcn_mfma_f32_32x32x16_bf16(pa2, FA_PK(l2, h2), od, 0, 0, 0);
  od = __builtin_amdgcn_mfma_f32_32x32x16_bf16(pa3, FA_PK(l3, h3), od, 0, 0, 0);
#undef FA_PK
}

}


DI void ph_ada_fast(PRef p, unsigned char* lds) {
  const int tid_ = opq_tid(); const int bid_ = opq_bid(), nblk_ = opq_nblk();
  float* MOD = (float*)(p.ws + WS_MOD);
  { float* ROPE = (float*)(p.ws + WS_ROPE);
    for (int idx = GTID; idx < SEQ * 16; idx += NTHR) { const int sq = idx >> 4, i = idx & 15; const float pos = (i < 8) ? (float)(sq >> 6) : (float)(sq & 63);
      const float inv = powf(10000.f, -(float)(2 * (i & 7)) / 16.f); const float th = pos * inv; ROPE[sq * 32 + i] = cosf(th); ROPE[sq * 32 + 16 + i] = sinf(th); } }
  if (bid_ == 0) { for (int k = tid_; k < 2 * NH * 15 * 31; k += 512) { const float v = fmaxf(p.in[I_RPB][k], 0.f); atomicMax((int*)(p.ws + WS_CTL) + CW_BIASMAX + k / (NH * 15 * 31), __float_as_int(v)); } }
  float* sc = (float*)lds;
  float* red = (float*)(lds + 40960);
  for (int k = tid_; k < 9 * D; k += 512) { const int i = k >> 10, kk = k & 1023; const float v = i < 8 ? p.in[I_C][i * D + kk] : p.in[I_CCTX][kk]; sc[k] = v * sigmoidf_(v); }
  __syncthreads();
  const int nn = tid_ & 63, kg = tid_ >> 6;
  for (int it = bid_; it < 2 * 96; it += nblk_) {
    const int l = it / 96, n0 = (it - l * 96) * 64;
    const float* W = p.in[I_ADAW] + (size_t)l * D * 6144 + n0 + nn;
    float acc[9];
#pragma unroll
    for (int i = 0; i < 9; ++i) acc[i] = 0.f;
#pragma unroll 8
    for (int k = kg * 128; k < kg * 128 + 128; ++k) { const float w = W[(size_t)k * 6144];
#pragma unroll
      for (int i = 0; i < 9; ++i) acc[i] += sc[i * D + k] * w; }
#pragma unroll
    for (int i = 0; i < 9; ++i) red[(kg * 9 + i) * 64 + nn] = acc[i];
    __syncthreads();
    for (int o = tid_; o < 9 * 64; o += 512) { const int i = o >> 6, n = o & 63; float s = 0.f;
#pragma unroll
      for (int g = 0; g < 8; ++g) s += red[(g * 9 + i) * 64 + n];
      MOD[((size_t)l * 9 + i) * 6144 + n0 + n] = s + p.in[I_ADAB][l * 6144 + n0 + n]; }
    __syncthreads();
  }
}


DI void ld32(const bf16* __restrict__ src, float (&x)[32]) {
#pragma unroll
  for (int q = 0; q < 4; ++q) { const uint4 u = *(const uint4*)(src + 8 * q); const unsigned w[4] = {u.x, u.y, u.z, u.w};
#pragma unroll
    for (int i = 0; i < 4; ++i) { x[8 * q + 2 * i] = __uint_as_float(w[i] << 16); x[8 * q + 2 * i + 1] = __uint_as_float(w[i] & 0xffff0000u); } }
}
DI void st32(bf16* __restrict__ dst, const float (&x)[32]) {
#pragma unroll
  for (int q = 0; q < 4; ++q) { uint4 u; u.x = cvt_pk_bf16_(x[8 * q], x[8 * q + 1]); u.y = cvt_pk_bf16_(x[8 * q + 2], x[8 * q + 3]); u.z = cvt_pk_bf16_(x[8 * q + 4], x[8 * q + 5]); u.w = cvt_pk_bf16_(x[8 * q + 6], x[8 * q + 7]); *(uint4*)(dst + 8 * q) = u; }
}


DI void ph_diffcombine_fast(PRef p, int l, int nrows, float lam_init) {
  const int tid_ = opq_tid(); const int bid_ = opq_bid(), nblk_ = opq_nblk();
  const int lane = tid_ & 63, gw = GTID >> 6, ngw = NTHR >> 6;
  const bf16* __restrict__ DO_ = (const bf16*)(p.ws + WS_DO); bf16* __restrict__ BI = (bf16*)(p.ws + WS_BI);
  const float* lv = p.in[I_DLAM] + l * 128;
  const float t1 = seg_sum(lane < 32 ? lv[lane] * lv[32 + lane] : 0.f, lane, 64), t2 = seg_sum(lane < 32 ? lv[64 + lane] * lv[96 + lane] : 0.f, lane, 64);
  const float lam = expf(t1) - expf(t2) + lam_init;
  const int h = lane >> 4, d = 4 * (lane & 15);
  float g[4];
#pragma unroll
  for (int i = 0; i < 4; ++i) g[i] = p.in[I_DSUBG][l * 64 + d + i] * (1.f - lam_init);
#pragma unroll 4
  for (int r = gw; r < nrows; r += ngw) {
    float a[4], b[4], v[4]; ld4(DO_ + (size_t)r * 512 + (2 * h) * 64 + d, a); ld4(DO_ + (size_t)r * 512 + (2 * h + 1) * 64 + d, b);
#pragma unroll
    for (int i = 0; i < 4; ++i) v[i] = a[i] - lam * b[i];
    const float ss = seg_sum(v[0] * v[0] + v[1] * v[1] + v[2] * v[2] + v[3] * v[3], lane, 16); const float rs = rsqrtf(ss * (1.f / 64.f) + EPS);
#pragma unroll
    for (int i = 0; i < 4; ++i) v[i] = v[i] * rs * g[i];
    st4(BI + (size_t)r * D + 512 + h * 64 + d, v);
  }
}

DI void ph_mod2_router_fast(PRef p, int l, int nrows, unsigned char* lds) {
  const int tid_ = opq_tid(); const int bid_ = opq_bid(), nblk_ = opq_nblk();
  const int lane = tid_ & 63, wave = tid_ >> 6;
  float* rwT = (float*)lds;
  unsigned* lcnt = (unsigned*)(lds + 131072 + 2048);
  int* rbuf = (int*)(lds + 131072 + 4096);
  const float* rw = p.in[I_RW] + (size_t)l * D * NE;
  for (int q = tid_; q < D * NE / 4; q += 512) { const float4 v = *(const float4*)(rw + (size_t)q * 4); const int c = q >> 3, e = (q & 7) * 4;
    rwT[(e + 0) * D + c] = v.x; rwT[(e + 1) * D + c] = v.y; rwT[(e + 2) * D + c] = v.z; rwT[(e + 3) * D + c] = v.w; }
  if (tid_ < 64) lcnt[tid_] = 0u;
  __syncthreads();
  const float* MOD = (const float*)(p.ws + WS_MOD); const float* XF = (const float*)(p.ws + WS_XF);
  bf16* H2 = (bf16*)(p.ws + WS_H2); float* HS = (float*)(p.ws + WS_HS); const float* g = p.in[I_N2G] + l * D; const float* rb = p.in[I_RB] + l * NE;
  int* ROUTE = (int*)(p.ws + WS_ROUTE); unsigned* cnt = (unsigned*)(p.ws + WS_CTL) + CW_CNT + l * 64; int* ROWTOK = (int*)(p.ws + WS_ROWTOK);
  const int per = (nrows + nblk_ - 1) / nblk_, rlo = bid_ * per, rhi = min(rlo + per, nrows);
  float4 cx0, cx1, cx2, cx3;
  { const int r = min(rlo + wave, nrows - 1); const float* x = XF + (size_t)r * D + lane * 4; cx0 = *(const float4*)(x); cx1 = *(const float4*)(x + 256); cx2 = *(const float4*)(x + 512); cx3 = *(const float4*)(x + 768); }
  for (int r = rlo + wave; r < rhi; r += 8) {
    float4 nx0, nx1, nx2, nx3;
    { const int rn = min(r + 8, nrows - 1); const float* x = XF + (size_t)rn * D + lane * 4; nx0 = *(const float4*)(x); nx1 = *(const float4*)(x + 256); nx2 = *(const float4*)(x + 512); nx3 = *(const float4*)(x + 768); }
    float v[16]; float ss = 0.f;
    { const float4 t4[4] = {cx0, cx1, cx2, cx3};
#pragma unroll
    for (int j = 0; j < 4; ++j) { const float4 t = t4[j]; v[4 * j] = t.x; v[4 * j + 1] = t.y; v[4 * j + 2] = t.z; v[4 * j + 3] = t.w; ss += t.x * t.x + t.y * t.y + t.z * t.z + t.w * t.w; } }
    cx0 = nx0; cx1 = nx1; cx2 = nx2; cx3 = nx3;
    ss = seg_sum(ss, lane, 64);
    const float rstd = rsqrtf(ss * (1.f / D) + EPS);
    const float* md = MOD + ((size_t)l * 9 + modidx(r)) * 6144;
#pragma unroll
    for (int j = 0; j < 4; ++j) { const int c = j * 256 + lane * 4; const float4 gg = *(const float4*)(g + c), s4 = *(const float4*)(md + 4 * 1024 + c), h4 = *(const float4*)(md + 3 * 1024 + c);
      v[4 * j] = v[4 * j] * rstd * gg.x * (1.f + s4.x) + h4.x; v[4 * j + 1] = v[4 * j + 1] * rstd * gg.y * (1.f + s4.y) + h4.y;
      v[4 * j + 2] = v[4 * j + 2] * rstd * gg.z * (1.f + s4.z) + h4.z; v[4 * j + 3] = v[4 * j + 3] * rstd * gg.w * (1.f + s4.w) + h4.w;
      }
    { float mx = 0.f;
#pragma unroll
      for (int i = 0; i < 16; ++i) mx = fmaxf(mx, fabsf(v[i]));
#pragma unroll
      for (int o = 1; o < 64; o <<= 1) mx = fmaxf(mx, lane_xor(mx, lane, o));
      const float sc = mx > 0.f ? mx * (1.f / 127.f) : 1.f, inv = 1.f / sc; if (lane == 0) HS[r] = sc;
#pragma unroll
      for (int j = 0; j < 4; ++j) { unsigned b = 0;
#pragma unroll
        for (int i = 0; i < 4; ++i) b |= ((unsigned)(int)rintf(v[4 * j + i] * inv) & 255u) << (8 * i);
        *(unsigned*)((signed char*)H2 + (size_t)r * D + j * 256 + lane * 4) = b; } }
    float lg[NE];
#pragma unroll
    for (int e = 0; e < NE; ++e) { float s = 0.f;
#pragma unroll
      for (int j = 0; j < 4; ++j) { const float4 w = *(const float4*)(rwT + e * D + j * 256 + lane * 4); s += v[4 * j] * w.x + v[4 * j + 1] * w.y + v[4 * j + 2] * w.z + v[4 * j + 3] * w.w; }
      lg[e] = s; }
#pragma unroll
    for (int e = 0; e < NE; ++e) lg[e] = seg_sum(lg[e], lane, 64) + rb[e];
    int te[4]; float tv[4];
#pragma unroll
    for (int k = 0; k < 4; ++k) { float best = -3.4e38f; int bi = 0;
#pragma unroll
      for (int e = 0; e < NE; ++e) { const bool taken = (k > 0 && te[0] == e) || (k > 1 && te[1] == e) || (k > 2 && te[2] == e); if (!taken && lg[e] > best) { best = lg[e]; bi = e; } }
      te[k] = bi; tv[k] = best; }
    const float mx = tv[0]; float ex[4], se = 0.f;
#pragma unroll
    for (int k = 0; k < 4; ++k) { ex[k] = expf(tv[k] - mx); se += ex[k]; }
    if (lane == 0) { int* rt = rbuf + (r - rlo) * 12;
#pragma unroll
      for (int k = 0; k < 4; ++k) { rt[3 * k] = te[k]; rt[3 * k + 1] = (int)atomicAdd(&lcnt[te[k]], 1u); rt[3 * k + 2] = __float_as_int(ex[k] / se); } }
  }
  __syncthreads();
  if (tid_ < NE) lcnt[32 + tid_] = lcnt[tid_] ? atomicAdd(&cnt[tid_], lcnt[tid_]) : 0u;
  __syncthreads();
  for (int q = tid_; q < (rhi - rlo) * 4; q += 512) { const int lr = q >> 2, k = q & 3; const int* rt = rbuf + lr * 12 + 3 * k; int* o = ROUTE + ((size_t)(rlo + lr) * 4 + k) * 4;
    const int pos = rt[1] + (int)lcnt[32 + rt[0]];
    o[0] = rt[0]; o[1] = pos; o[2] = rt[2]; o[3] = 0; ROWTOK[(size_t)rt[0] * T + pos] = rlo + lr; }
}


namespace fa {
DI void expcvt(f32x16& p0, f32x16& p1, bf16x8& pa0, bf16x8& pa1, bf16x8& pa2, bf16x8& pa3) {
#pragma unroll
  for (int r = 0; r < 16; ++r) p0[r] = __builtin_amdgcn_exp2f(p0[r]);
#pragma unroll
  for (int r = 0; r < 16; ++r) p1[r] = __builtin_amdgcn_exp2f(p1[r]);
#define FA_PK4(P, BASE, OUT) do { unsigned a0 = cvtpk(P[BASE + 0], P[BASE + 1]), a1 = cvtpk(P[BASE + 2], P[BASE + 3]);   \
    unsigned b0 = cvtpk(P[BASE + 4], P[BASE + 5]), b1 = cvtpk(P[BASE + 6], P[BASE + 7]);                              \
    u32x4 w = {a0, a1, b0, b1}; OUT = *reinterpret_cast<bf16x8*>(&w); } while (0)
  FA_PK4(p0, 0, pa0); FA_PK4(p0, 8, pa1); FA_PK4(p1, 0, pa2); FA_PK4(p1, 8, pa3);
#undef FA_PK4
}
template <int ND0, int KST = 0>
DI void qkt2(f32x16& p0, f32x16& p1, const char* Ks, const bf16x8* qr, const f32x16& nbt, int r32, int hi) {
#pragma unroll
  for (int d0 = 0; d0 < ND0; ++d0) { const int cb = (d0 * 16 + hi * 8) * 2;
    bf16x8 b0 = *reinterpret_cast<const bf16x8*>(Ks + (KST ? r32 * KST + cb : FA_KSWZ(r32, cb)));
    bf16x8 b1 = *reinterpret_cast<const bf16x8*>(Ks + (KST ? (32 + r32) * KST + cb : FA_KSWZ(32 + r32, cb)));
    p0 = __builtin_amdgcn_mfma_f32_32x32x16_bf16(b0, qr[d0], d0 == 0 ? nbt : p0, 0, 0, 0);
    p1 = __builtin_amdgcn_mfma_f32_32x32x16_bf16(b1, qr[d0], d0 == 0 ? nbt : p1, 0, 0, 0); }
}
DI void pv3(f32x16* o, int vb, bf16x8 pa0, bf16x8 pa1, bf16x8 pa2, bf16x8 pa3) { pv_one<0>(o[0], vb, pa0, pa1, pa2, pa3); pv_one<1>(o[1], vb, pa0, pa1, pa2, pa3); pv_one<2>(o[2], vb, pa0, pa1, pa2, pa3); }
DI void fill_ones(char* V_lds, int tid) {
  const int b = tid >> 8, t = tid & 255, key = t >> 2, c8 = (t & 3) * 8;
  u32x4 w = {c8 == 0 ? 0x00003F80u : 0u, 0u, 0u, 0u};
  *(u32x4*)(V_lds + b * SHM_V + v_st(key, 64 + c8)) = w;
}
template <int DQK>
DI void attn_unit2(const bf16* __restrict__ Qb, int ldq, const bf16* __restrict__ Kh, int ldk, const bf16* __restrict__ Vh, const float* __restrict__ nbp, int nbs, int kva, int kvb, int NT,
                   bf16* __restrict__ Ob, int ldo, char* lds, int tid) {
  constexpr int ND0 = DQK / 16;
  const int wid = tid >> 6, lane = tid & 63, r32 = lane & 31, hi = lane >> 5;
  char* V_lds = lds; char* K_lds = lds + 2 * SHM_V;
  f32x16 o[3] = {}; bf16x8 qr[ND0];
  const bf16* Qw = Qb + (long)(wid * 32 + r32) * ldq + hi * 8;
#pragma unroll
  for (int d0 = 0; d0 < ND0; ++d0) qr[d0] = *reinterpret_cast<const bf16x8*>(Qw + d0 * 16);
  const float nb = nbp[(long)(wid * 32 + r32) * nbs];
  f32x16 nbt;
#pragma unroll
  for (int r = 0; r < 16; ++r) nbt[r] = nb;
  const int sr = tid >> 4, sc = (tid & 15) * 8; const bool kact = sc < DQK, vact = sc < 64;
  const int vst0 = v_st(sr, sc & 63), vst1 = v_st(32 + sr, sc & 63);
  const int vb0 = (int)(uintptr_t)V_lds + v_rd_base(lane);
  struct { bf16x8 vs0, vs1, ks0, ks1; } sr_[2];
#define FA_KROW(j) ((j) < 4 ? kva + 64 * (j) : kvb + 64 * ((j) - 4))
#define FA_SLOAD(i, j) do { const long kr_ = FA_KROW(j); \
    if (vact) { sr_[i].vs0 = *reinterpret_cast<const bf16x8*>(&Vh[(kr_ + sr) * 256 + sc]); sr_[i].vs1 = *reinterpret_cast<const bf16x8*>(&Vh[(kr_ + 32 + sr) * 256 + sc]); } \
    if (kact) { sr_[i].ks0 = *reinterpret_cast<const bf16x8*>(&Kh[(kr_ + sr) * ldk + sc]); sr_[i].ks1 = *reinterpret_cast<const bf16x8*>(&Kh[(kr_ + 32 + sr) * ldk + sc]); } } while (0)
#define FA_SWRITE(b, i) do { if (vact) { *(bf16x8*)(V_lds + (b) * SHM_V + vst0) = sr_[i].vs0; *(bf16x8*)(V_lds + (b) * SHM_V + vst1) = sr_[i].vs1; } \
    if (kact) { const int kc = sc * 2; *(bf16x8*)(K_lds + (b) * SHM_K + FA_KSWZ(sr, kc)) = sr_[i].ks0; *(bf16x8*)(K_lds + (b) * SHM_K + FA_KSWZ(32 + sr, kc)) = sr_[i].ks1; } } while (0)
  f32x16 pA0, pA1, pB0, pB1; bf16x8 pa0, pa1, pa2, pa3;
  FA_SLOAD(0, 0); asm volatile("s_waitcnt vmcnt(0)" ::: "memory"); FA_SWRITE(0, 0); __syncthreads();
  qkt2<ND0>(pA0, pA1, K_lds, qr, nbt, r32, hi);
  FA_SLOAD(1, 1); if (2 < NT) FA_SLOAD(0, 2);
  FA_SWRITE(1, 1); __syncthreads();
  for (int j = 1; j + 1 < NT; j += 2) {
    FA_SBAR(); qkt2<ND0>(pB0, pB1, K_lds + SHM_K, qr, nbt, r32, hi);
    expcvt(pA0, pA1, pa0, pa1, pa2, pa3); FA_SBAR();
    FA_SLOAD(1, j + 2); FA_SBAR();
    pv3(o, vb0, pa0, pa1, pa2, pa3);
    __syncthreads(); FA_SWRITE(0, 0); __syncthreads();
    FA_SBAR(); qkt2<ND0>(pA0, pA1, K_lds, qr, nbt, r32, hi);
    expcvt(pB0, pB1, pa0, pa1, pa2, pa3); FA_SBAR();
    if (j + 3 < NT) FA_SLOAD(0, j + 3); FA_SBAR();
    pv3(o, vb0 + SHM_V, pa0, pa1, pa2, pa3);
    __syncthreads(); FA_SWRITE(1, 1); __syncthreads();
  }
  FA_SBAR(); qkt2<ND0>(pB0, pB1, K_lds + SHM_K, qr, nbt, r32, hi);
  expcvt(pA0, pA1, pa0, pa1, pa2, pa3); FA_SBAR();
  pv3(o, vb0, pa0, pa1, pa2, pa3);
  expcvt(pB0, pB1, pa0, pa1, pa2, pa3); FA_SBAR();
  pv3(o, vb0 + SHM_V, pa0, pa1, pa2, pa3);
  bf16* Ow = Ob + (long)(wid * 32) * ldo;
#pragma unroll
  for (int r = 0; r < 16; ++r) { const int orow = crow(r, hi);
    const float lsum = __int_as_float(__builtin_amdgcn_ds_bpermute((hi * 32) << 2, __float_as_int(o[2][r]))); const float rl = __builtin_amdgcn_rcpf(lsum);
#pragma unroll
    for (int d0 = 0; d0 < 2; ++d0) Ow[(long)orow * ldo + d0 * 32 + r32] = f2bf(o[d0][r] * rl); }
  __syncthreads();
#undef FA_KROW
#undef FA_SLOAD
#undef FA_SWRITE
}
typedef float f32x2v __attribute__((ext_vector_type(2)));
typedef __bf16 bf16x2v __attribute__((ext_vector_type(2)));
DI unsigned cvtpk_b(float lo, float hi) { f32x2v v = {lo, hi}; bf16x2v b = __builtin_convertvector(v, bf16x2v); return __builtin_bit_cast(unsigned, b); }
DI void expcvt_b(f32x16& p0, f32x16& p1, bf16x8& pa0, bf16x8& pa1, bf16x8& pa2, bf16x8& pa3) {
#pragma unroll
  for (int r = 0; r < 16; ++r) p0[r] = __builtin_amdgcn_exp2f(p0[r]);
#pragma unroll
  for (int r = 0; r < 16; ++r) p1[r] = __builtin_amdgcn_exp2f(p1[r]);
#define FA_PK4(P, BASE, OUT) do { u32x4 w = {cvtpk_b(P[BASE + 0], P[BASE + 1]), cvtpk_b(P[BASE + 2], P[BASE + 3]), cvtpk_b(P[BASE + 4], P[BASE + 5]), cvtpk_b(P[BASE + 6], P[BASE + 7])}; \
    OUT = *reinterpret_cast<bf16x8*>(&w); } while (0)
  FA_PK4(p0, 0, pa0); FA_PK4(p0, 8, pa1); FA_PK4(p1, 0, pa2); FA_PK4(p1, 8, pa3);
#undef FA_PK4
}
template <int NM> DI void step_pipeline() {
  __builtin_amdgcn_sched_group_barrier(0x100, 4, 0);
#pragma unroll
  for (int i = 0; i < NM; ++i) {
    __builtin_amdgcn_sched_group_barrier(0x008, 1, 0);
    __builtin_amdgcn_sched_group_barrier(0x400, 2, 0);
    __builtin_amdgcn_sched_group_barrier(0x002, 2, 0);
    __builtin_amdgcn_sched_group_barrier(0x100, 2, 0);
  }
}
template <int OFF> DI s16x4 tr_rd(int vb) { return __builtin_amdgcn_ds_read_tr16_b64_v4i16((__attribute__((address_space(3))) s16x4*)(vb + OFF)); }
template <int D0> DI void pv_one_b(f32x16& od, int vb, bf16x8 pa0, bf16x8 pa1, bf16x8 pa2, bf16x8 pa3) {
  const s16x4 l0 = tr_rd<v_rd_off(D0, 0, 0)>(vb), h0 = tr_rd<v_rd_off(D0, 0, 1)>(vb), l1 = tr_rd<v_rd_off(D0, 1, 0)>(vb), h1 = tr_rd<v_rd_off(D0, 1, 1)>(vb);
  const s16x4 l2 = tr_rd<v_rd_off(D0, 2, 0)>(vb), h2 = tr_rd<v_rd_off(D0, 2, 1)>(vb), l3 = tr_rd<v_rd_off(D0, 3, 0)>(vb), h3 = tr_rd<v_rd_off(D0, 3, 1)>(vb);
#define FA_PK(L, H) (bf16x8){L[0], L[1], L[2], L[3], H[0], H[1], H[2], H[3]}
  od = __builtin_amdgcn_mfma_f32_32x32x16_bf16(pa0, FA_PK(l0, h0), od, 0, 0, 0);
  od = __builtin_amdgcn_mfma_f32_32x32x16_bf16(pa1, FA_PK(l1, h1), od, 0, 0, 0);
  od = __builtin_amdgcn_mfma_f32_32x32x16_bf16(pa2, FA_PK(l2, h2), od, 0, 0, 0);
  od = __builtin_amdgcn_mfma_f32_32x32x16_bf16(pa3, FA_PK(l3, h3), od, 0, 0, 0);
#undef FA_PK
}
DI void pv3b(f32x16* o, int vb, bf16x8 pa0, bf16x8 pa1, bf16x8 pa2, bf16x8 pa3, bf16x8 onesB) { pv_one_b<0>(o[0], vb, pa0, pa1, pa2, pa3); pv_one_b<1>(o[1], vb, pa0, pa1, pa2, pa3);
  o[2] = __builtin_amdgcn_mfma_f32_32x32x16_bf16(pa0, onesB, o[2], 0, 0, 0); o[2] = __builtin_amdgcn_mfma_f32_32x32x16_bf16(pa1, onesB, o[2], 0, 0, 0);
  o[2] = __builtin_amdgcn_mfma_f32_32x32x16_bf16(pa2, onesB, o[2], 0, 0, 0); o[2] = __builtin_amdgcn_mfma_f32_32x32x16_bf16(pa3, onesB, o[2], 0, 0, 0); }
#ifndef FS_SPREAD
#define FS_SPREAD 1
#endif
#ifndef FS_AH
#define FS_AH 2
#endif
template <int NM> constexpr int fs_ec(int s) { const int e = (FS_SPREAD && NM >= 24) ? s + (s + 2) / 3 : 2 * s; return e < 32 ? e : 32; }
template <int NM> constexpr int fs_cc(int s) { const int c = s >= 1 ? fs_ec<NM>(s - 1) / 2 : 0; return c < 16 ? c : 16; }
DI s16x4 tr_rd2(int vb, int off) { return __builtin_amdgcn_ds_read_tr16_b64_v4i16((__attribute__((address_space(3))) s16x4*)(vb + off)); }
template <int ND0, int WI, int KST = 0>
DI void fused_step(f32x16& pn0, f32x16& pn1, f32x16& pc0, f32x16& pc1, bf16x8& an0, bf16x8& an1, bf16x8& an2, bf16x8& an3, bf16x8 ac0, bf16x8 ac1, bf16x8 ac2, bf16x8 ac3,
                   f32x16* o, const char* Ks, int vb, const bf16x8* qr, const f32x16& nbt, int r32, int hi, bf16x8 onesB) {
  constexpr int NQ = 2 * ND0, NM = NQ + 12, AH = FS_AH;
  bf16x8 kf[NQ]; s16x4 vl[8], vh[8]; unsigned w[16];
  bf16x8 kz_; s16x4 vz_; if (WI & (4 | 16 | 32)) { asm volatile("v_mov_b32 %0, 0" : "=v"(vz_[0])); u32x4 z4_ = {0u, 0u, 0u, 0u}; asm volatile("" : "+v"(z4_)); kz_ = *reinterpret_cast<bf16x8*>(&z4_); vz_ = (s16x4){0, 0, 0, 0}; asm volatile("" : "+v"(vz_)); }
#define FS_ISSUE(m) do { if ((WI & 4) || ((WI & 16) && (m) < NQ) || ((WI & 32) && (m) >= NQ)) { if ((m) < NQ) kf[(m) < NQ ? (m) : 0] = kz_; else if ((m) - NQ < 8) { const int q_ = (m) - NQ; vl[q_ >= 0 ? q_ : 0] = vz_; vh[q_ >= 0 ? q_ : 0] = vz_; } } else if ((m) < NQ) { kf[(m) < NQ ? (m) : 0] = *reinterpret_cast<const bf16x8*>(Ks + (KST ? (((m) & 1) * 32 + r32) * KST + ((((m) >> 1) * 16 + hi * 8) * 2) : FA_KSWZ(((m) & 1) * 32 + r32, ((((m) >> 1) * 16 + hi * 8) * 2)))); } \
    else if ((m) - NQ < 8) { const int q_ = (m) - NQ; vl[q_ >= 0 ? q_ : 0] = tr_rd2(vb, v_rd_off(q_ >> 2, q_ & 3, 0)); vh[q_ >= 0 ? q_ : 0] = tr_rd2(vb, v_rd_off(q_ >> 2, q_ & 3, 1)); } } while (0)
#define FS_PC(v) ((v) < 16 ? pc0[(v) & 15] : pc1[(v) & 15])
#pragma unroll
  for (int m = 0; m < AH; ++m) FS_ISSUE(m);
#pragma unroll
  for (int s_ = 0; s_ < NM; ++s_) {
    if (s_ + AH < NM) FS_ISSUE(s_ + AH);
    if (s_ < NQ) { const int d0 = s_ >> 1;
      if ((s_ & 1) == 0) pn0 = __builtin_amdgcn_mfma_f32_32x32x16_bf16(kf[s_ < NQ ? s_ : 0], qr[d0 < ND0 ? d0 : 0], d0 == 0 ? nbt : pn0, 0, 0, 0);
      else pn1 = __builtin_amdgcn_mfma_f32_32x32x16_bf16(kf[s_ < NQ ? s_ : 0], qr[d0 < ND0 ? d0 : 0], d0 == 0 ? nbt : pn1, 0, 0, 0);
    } else { const int q = s_ - NQ, blk = q >> 2, ks = q & 3; const int qi = (q >= 0 && q < 8) ? q : 0; const s16x4 L = vl[qi], H = vh[qi];
      const bf16x8 B = blk == 2 ? onesB : (bf16x8){L[0], L[1], L[2], L[3], H[0], H[1], H[2], H[3]};       const bf16x8 A = ks == 0 ? ac0 : (ks == 1 ? ac1 : (ks == 2 ? ac2 : ac3));
      o[blk >= 0 ? blk : 0] = __builtin_amdgcn_mfma_f32_32x32x16_bf16(A, B, o[blk >= 0 ? blk : 0], 0, 0, 0); }
#pragma unroll
    for (int v = fs_ec<NM>(s_); v < ((WI & 2) ? 0 : fs_ec<NM>(s_ + 1)); ++v) { float e0 = FS_PC(v); asm volatile("" : "+v"(e0)); e0 = __builtin_amdgcn_exp2f(e0); asm volatile("" : "+v"(e0));
      if (v < 16) pc0[v & 15] = e0; else pc1[v & 15] = e0; }
#pragma unroll
    for (int k = fs_cc<NM>(s_); k < ((WI & 2) ? 0 : fs_cc<NM>(s_ + 1)); ++k) { unsigned wk = cvtpk_b(FS_PC(2 * k), FS_PC(2 * k + 1)); asm volatile("" : "+v"(wk)); w[k & 15] = wk; }
    FA_SBAR();
  }
#pragma unroll
  for (int k = fs_cc<NM>(NM); k < ((WI & 2) ? 0 : 16); ++k) w[k] = cvtpk_b(FS_PC(2 * k), FS_PC(2 * k + 1));
  if (WI & 2) { an0 = ac0; an1 = ac1; an2 = ac2; an3 = ac3; } else
  { u32x4 t0 = {w[0], w[1], w[2], w[3]}, t1 = {w[4], w[5], w[6], w[7]}, t2 = {w[8], w[9], w[10], w[11]}, t3 = {w[12], w[13], w[14], w[15]};
    an0 = *reinterpret_cast<bf16x8*>(&t0); an1 = *reinterpret_cast<bf16x8*>(&t1); an2 = *reinterpret_cast<bf16x8*>(&t2); an3 = *reinterpret_cast<bf16x8*>(&t3); }
#undef FS_ISSUE
#undef FS_PC
}
template <int DQK, int WI>
DI void attn_unit3(const bf16* __restrict__ Qb, int ldq, const bf16* __restrict__ Kh, int ldk, const bf16* __restrict__ Vh, const float* __restrict__ nbp, int nbs, int kva, int kvb, int NT,
                   bf16* __restrict__ Ob, int ldo, char* lds, int tid) {
  constexpr int ND0 = DQK / 16;
  const int wid = tid >> 6, lane = tid & 63, r32 = lane & 31, hi = lane >> 5;
  char* V_lds = lds; char* K_lds = lds + 2 * SHM_V;
  f32x16 o[3] = {}; bf16x8 qr[ND0];
  const bf16* Qw = Qb + (long)(wid * 32 + r32) * ldq + hi * 8;
#pragma unroll
  for (int d0 = 0; d0 < ND0; ++d0) qr[d0] = *reinterpret_cast<const bf16x8*>(Qw + d0 * 16);
  const float nb = nbp[(long)(wid * 32 + r32) * nbs];
  f32x16 nbt;
#pragma unroll
  for (int r = 0; r < 16; ++r) nbt[r] = nb;
  const int sr = tid >> 4, sc = (tid & 15) * 8; const bool kact = sc < DQK, vact = sc < 64;
  const int vst0 = v_st(sr, sc & 63), vst1 = v_st(32 + sr, sc & 63);
  const int vb0 = (int)(uintptr_t)V_lds + v_rd_base(lane);
  bf16x8 vs0, vs1, ks0, ks1;
#define FA_KROW(j) ((j) < 4 ? kva + 64 * (j) : kvb + 64 * ((j) - 4))
#define FA_LOADK(j) do { if (kact) { const long kr_ = FA_KROW(j); ks0 = *reinterpret_cast<const bf16x8*>(&Kh[(kr_ + sr) * ldk + sc]); ks1 = *reinterpret_cast<const bf16x8*>(&Kh[(kr_ + 32 + sr) * ldk + sc]); } } while (0)
#define FA_LOADV(j) do { if (vact) { const long kr_ = FA_KROW(j); vs0 = *reinterpret_cast<const bf16x8*>(&Vh[(kr_ + sr) * 256 + sc]); vs1 = *reinterpret_cast<const bf16x8*>(&Vh[(kr_ + 32 + sr) * 256 + sc]); } } while (0)
#define FA_WRITEK(b) do { if (kact) { const int kc = sc * 2; *(bf16x8*)(K_lds + (b) * SHM_K + FA_KSWZ(sr, kc)) = ks0; *(bf16x8*)(K_lds + (b) * SHM_K + FA_KSWZ(32 + sr, kc)) = ks1; } } while (0)
#define FA_WRITEV(b) do { if (vact) { *(bf16x8*)(V_lds + (b) * SHM_V + vst0) = vs0; *(bf16x8*)(V_lds + (b) * SHM_V + vst1) = vs1; } } while (0)
  f32x16 pE0, pE1, pO0, pO1; bf16x8 ae0, ae1, ae2, ae3, ao0, ao1, ao2, ao3;
  bf16x8 onesB; { const unsigned ov = r32 == 0 ? 0x3F803F80u : 0u; u32x4 t = {ov, ov, ov, ov}; onesB = *reinterpret_cast<bf16x8*>(&t); }
  FA_LOADK(0); asm volatile("s_waitcnt vmcnt(0)" ::: "memory"); FA_WRITEK(0); __syncthreads();
  FA_LOADK(1);
  qkt2<ND0>(pE0, pE1, K_lds, qr, nbt, r32, hi);
  __syncthreads(); FA_WRITEK(1); __syncthreads(); FA_LOADK(2); FA_LOADV(0);
  FA_SBAR(); qkt2<ND0>(pO0, pO1, K_lds + SHM_K, qr, nbt, r32, hi); expcvt(pE0, pE1, ae0, ae1, ae2, ae3); FA_SBAR();
  __syncthreads(); FA_WRITEK(0); FA_WRITEV(0); __syncthreads(); if (3 < NT) FA_LOADK(3); FA_LOADV(1);
#define FA_SY() do { if (!(WI & 1)) __syncthreads(); } while (0)
#define FA_IO(x) do { if (!(WI & 8)) { x; } } while (0)
  for (int j = 1; j + 2 < NT; j += 2) {
    FA_SBAR(); asm volatile("" : "+v"(pO0), "+v"(pO1));
    fused_step<ND0, WI>(pE0, pE1, pO0, pO1, ao0, ao1, ao2, ao3, ae0, ae1, ae2, ae3, o, K_lds, vb0, qr, nbt, r32, hi, onesB);
    FA_SY(); FA_IO(FA_WRITEK(1); FA_WRITEV(1)); FA_SY(); FA_IO(if (j + 3 < NT) FA_LOADK(j + 3); FA_LOADV(j + 1));
    FA_SBAR(); asm volatile("" : "+v"(pE0), "+v"(pE1));
    fused_step<ND0, WI>(pO0, pO1, pE0, pE1, ae0, ae1, ae2, ae3, ao0, ao1, ao2, ao3, o, K_lds + SHM_K, vb0 + SHM_V, qr, nbt, r32, hi, onesB);
    FA_SY(); FA_IO(if (j + 3 < NT) FA_WRITEK(0); FA_WRITEV(0)); FA_SY(); FA_IO(if (j + 4 < NT) FA_LOADK(j + 4); if (j + 2 < NT) FA_LOADV(j + 2));
  }
#undef FA_SY
#undef FA_IO
  FA_SBAR(); expcvt(pO0, pO1, ao0, ao1, ao2, ao3); pv3b(o, vb0, ae0, ae1, ae2, ae3, onesB); FA_SBAR();
  __syncthreads(); FA_WRITEV(1); __syncthreads();
  pv3b(o, vb0 + SHM_V, ao0, ao1, ao2, ao3, onesB);
  bf16* Ow = Ob + (long)(wid * 32) * ldo;
#pragma unroll
  for (int r = 0; r < 16; ++r) { const int orow = crow(r, hi);
    const float lsum = __int_as_float(__builtin_amdgcn_ds_bpermute((hi * 32) << 2, __float_as_int(o[2][r]))); const float rl = __builtin_amdgcn_rcpf(lsum);
#pragma unroll
    for (int d0 = 0; d0 < 2; ++d0) Ow[(long)orow * ldo + d0 * 32 + r32] = f2bf(o[d0][r] * rl); }
  __syncthreads();
#undef FA_KROW
#undef FA_LOADK
#undef FA_LOADV
#undef FA_WRITEK
#undef FA_WRITEV
}
template <int DQK>
DI void attn_unit4(const bf16* __restrict__ Qb, int ldq, const bf16* __restrict__ Kh, int ldk, const bf16* __restrict__ Vh, const float* __restrict__ nbp, int nbs, int kva, int kvb, int NT,
                   bf16* __restrict__ Ob, int ldo, char* lds, int tid, bool prefetched, const bf16* Knext) {
  constexpr int ND0 = DQK / 16, CPR = DQK / 8 + 1, KST = CPR * 16, KSZ = 64 * KST;
  const int wid = __builtin_amdgcn_readfirstlane(tid >> 6), lane = tid & 63, r32 = lane & 31, hi = lane >> 5;
  char* V_lds = lds; char* K_lds = lds + 3 * SHM_V;
  f32x16 o[3] = {}; bf16x8 qr[ND0];
  const bf16* Qw = Qb + (long)(wid * 32 + r32) * ldq + hi * 8;
#pragma unroll
  for (int d0 = 0; d0 < ND0; ++d0) qr[d0] = *reinterpret_cast<const bf16x8*>(Qw + d0 * 16);
  const float nb = nbp[(long)(wid * 32 + r32) * nbs];
  f32x16 nbt;
#pragma unroll
  for (int r = 0; r < 16; ++r) nbt[r] = nb;
  const int vb0 = (int)(uintptr_t)V_lds + v_rd_base(lane);
  bf16x8 onesB; { const unsigned ov = r32 == 0 ? 0x3F803F80u : 0u; u32x4 t = {ov, ov, ov, ov}; onesB = *reinterpret_cast<bf16x8*>(&t); }
  unsigned kof0, kof1, vof;
  { const int c0 = 64 * wid + lane, c1 = c0 + 512; const int ra = c0 / CPR, ca = c0 - ra * CPR, rb = c1 / CPR, cb = c1 - rb * CPR;
    kof0 = (unsigned)(ra * ldk + (ca < CPR - 1 ? ca : 0) * 8) * 2u; kof1 = (unsigned)(rb * ldk + (cb < CPR - 1 ? cb : 0) * 8) * 2u;
    vof = (unsigned)((wid * 8 + ((lane & 31) >> 2)) * 256 + (lane >> 5) * 32 + (lane & 3) * 8) * 2u; }
  const bool k0act = wid < CPR, k1act = wid + 8 < CPR;
  const unsigned kl0 = (unsigned)(uintptr_t)K_lds + (unsigned)wid * 1024u, vl0 = (unsigned)(uintptr_t)V_lds + (unsigned)wid * 2048u;
#define FA_LAS __attribute__((address_space(3)))
#define FA_KROW(j) ((j) < 4 ? kva + 64 * (j) : kvb + 64 * ((j) - 4))
#define FA_DMAK(t, slot) do { const char* kb_ = (const char*)(Kh + (long)FA_KROW(t) * ldk); const unsigned kd_ = kl0 + (unsigned)(slot) * (unsigned)KSZ; \
    if (k0act) __builtin_amdgcn_global_load_lds((const unsigned*)(kb_ + kof0), (FA_LAS unsigned*)kd_, 16, 0, 0); \
    if (k1act) __builtin_amdgcn_global_load_lds((const unsigned*)(kb_ + kof1), (FA_LAS unsigned*)(kd_ + 8192u), 16, 0, 0); } while (0)
#define FA_DMAV(t, slot) do { const char* vb_ = (const char*)(Vh + (long)FA_KROW(t) * 256); \
    __builtin_amdgcn_global_load_lds((const unsigned*)(vb_ + vof), (FA_LAS unsigned*)(vl0 + (unsigned)(slot) * (unsigned)SHM_V), 16, 0, 0); } while (0)
#define FA_NX(s) ((s) == 2 ? 0 : (s) + 1)
#define FA_END(n) do { asm volatile("s_waitcnt vmcnt(" #n ")" ::: "memory"); __builtin_amdgcn_s_barrier(); } while (0)
  f32x16 pE0, pE1, pO0, pO1; bf16x8 ae0, ae1, ae2, ae3, ao0, ao1, ao2, ao3;
  if (!prefetched) { FA_DMAK(0, 0); FA_DMAK(1, 1); }
  FA_END(0);
#pragma unroll
  for (int d0 = 0; d0 < ND0; ++d0) asm volatile("" : "+v"(qr[d0]));
  asm volatile("" : "+v"(nbt));
  if (2 < NT) FA_DMAK(2, 2); FA_DMAV(0, 0);
  qkt2<ND0, KST>(pE0, pE1, K_lds, qr, nbt, r32, hi);
  FA_END(1);
  if (3 < NT) FA_DMAK(3, 0); FA_DMAV(1, 1);
  FA_SBAR(); qkt2<ND0, KST>(pO0, pO1, K_lds + KSZ, qr, nbt, r32, hi); expcvt(pE0, pE1, ae0, ae1, ae2, ae3); FA_SBAR();
  FA_END(1);
  int sj = 1;
  for (int j = 1; j + 2 < NT; j += 2) {
    { const int s1 = FA_NX(sj), s2 = FA_NX(s1);
      if (j + 3 < NT) FA_DMAK(j + 3, sj); FA_DMAV(j + 1, s1);
      FA_SBAR(); asm volatile("" : "+v"(pO0), "+v"(pO1));
      fused_step<ND0, 0, KST>(pE0, pE1, pO0, pO1, ao0, ao1, ao2, ao3, ae0, ae1, ae2, ae3, o, K_lds + s1 * KSZ, vb0 + s2 * SHM_V, qr, nbt, r32, hi, onesB);
      FA_END(1); sj = s1; }
    { const int s1 = FA_NX(sj), s2 = FA_NX(s1);
      if (j + 4 < NT) FA_DMAK(j + 4, sj); if (j + 2 < NT) FA_DMAV(j + 2, s1);
      FA_SBAR(); asm volatile("" : "+v"(pE0), "+v"(pE1));
      fused_step<ND0, 0, KST>(pO0, pO1, pE0, pE1, ae0, ae1, ae2, ae3, ao0, ao1, ao2, ao3, o, K_lds + s1 * KSZ, vb0 + s2 * SHM_V, qr, nbt, r32, hi, onesB);
      FA_END(1); sj = s1; }
  }
  { const int s2 = FA_NX(FA_NX(sj));
    if (Knext) { const char* kb_ = (const char*)Knext;
      if (k0act) __builtin_amdgcn_global_load_lds((const unsigned*)(kb_ + kof0), (FA_LAS unsigned*)kl0, 16, 0, 0);
      if (k1act) __builtin_amdgcn_global_load_lds((const unsigned*)(kb_ + kof1), (FA_LAS unsigned*)(kl0 + 8192u), 16, 0, 0);
      kb_ += (size_t)64 * ldk * 2;
      if (k0act) __builtin_amdgcn_global_load_lds((const unsigned*)(kb_ + kof0), (FA_LAS unsigned*)(kl0 + (unsigned)KSZ), 16, 0, 0);
      if (k1act) __builtin_amdgcn_global_load_lds((const unsigned*)(kb_ + kof1), (FA_LAS unsigned*)(kl0 + (unsigned)KSZ + 8192u), 16, 0, 0); }
    FA_SBAR(); expcvt(pO0, pO1, ao0, ao1, ao2, ao3); pv3b(o, vb0 + s2 * SHM_V, ae0, ae1, ae2, ae3, onesB); FA_SBAR();
    if (!Knext || !k0act) { FA_END(0); } else if (k1act) { FA_END(4); } else { FA_END(2); }
    sj = FA_NX(sj); }
  { const int s2 = FA_NX(FA_NX(sj)); pv3b(o, vb0 + s2 * SHM_V, ao0, ao1, ao2, ao3, onesB); }
  bf16* Ow = Ob + (long)(wid * 32) * ldo;
#pragma unroll
  for (int r = 0; r < 16; ++r) { const int orow = crow(r, hi);
    const float lsum = __int_as_float(__builtin_amdgcn_ds_bpermute((hi * 32) << 2, __float_as_int(o[2][r]))); const float rl = __builtin_amdgcn_rcpf(lsum);
#pragma unroll
    for (int d0 = 0; d0 < 2; ++d0) Ow[(long)orow * ldo + d0 * 32 + r32] = f2bf(o[d0][r] * rl); }
  __syncthreads();
#undef FA_KROW
#undef FA_DMAK
#undef FA_DMAV
#undef FA_NX
#undef FA_END
}
}

template <int DQK, int WI = 0>
DI void ph_attn_fast2(const bf16* Q, const bf16* K, const bf16* V, const float* QB, int nhv, int vdiv, bf16* O, int ldo, int ooff, int qbase, int nq_per_b, bool with_latent, unsigned char* lds) {
  const int tid_ = opq_tid(); const int bid_ = opq_bid(), nblk_ = opq_nblk();
  const int chunks = nq_per_b / 256, npairs = NB * nhv, nunits = npairs * chunks;
  const bool xmap = (nblk_ == 256) && (chunks == 16);
#define AT_DECODE(i, ok, pair, ch) do { if (xmap) { const int v = (i) * 32 + (bid_ >> 3); ok = v < nhv * 16; pair = (v >> 4) * 8 + (bid_ & 7); ch = v & 15; } \
    else { const int u = (i) * nblk_ + bid_; ok = u < nunits; pair = u / chunks; ch = u - pair * chunks; } } while (0)
  bool ok, pre = false; int pair, ch;
  AT_DECODE(0, ok, pair, ch);
  for (int i = 0; ok; ++i) {
    bool okn; int pairn, chn;
    AT_DECODE(i + 1, okn, pairn, chn); (void)chn;
    const int b = pair / nhv, hv = pair - b * nhv;
    const int r0 = qbase + b * nq_per_b + ch * 256;
    int tu_ = tid_; asm volatile("" : "+v"(tu_));
    if constexpr (WI == 0) {
      const int bn = pairn / nhv, hvn = pairn - bn * nhv;
      const bf16* Kn = okn ? K + hvn * DQK + (size_t)(TL + bn * CTX) * (nhv * DQK) : nullptr;
      fa::attn_unit4<DQK>(Q + (size_t)r0 * (nhv * DQK) + hv * DQK, nhv * DQK, K + hv * DQK, nhv * DQK, V + (hv / vdiv) * 64, QB + (size_t)r0 * nhv + hv, nhv, TL + b * CTX, b * SEQ, with_latent ? 68 : 4,
                        O + (size_t)r0 * ldo + ooff + hv * 64, ldo, (char*)lds, tu_, pre, Kn);
      pre = okn;
    } else {
      fa::attn_unit3<DQK, WI>(Q + (size_t)r0 * (nhv * DQK) + hv * DQK, nhv * DQK, K + hv * DQK, nhv * DQK, V + (hv / vdiv) * 64, QB + (size_t)r0 * nhv + hv, nhv, TL + b * CTX, b * SEQ, with_latent ? 68 : 4,
                        O + (size_t)r0 * ldo + ooff + hv * 64, ldo, (char*)lds, tu_);
    }
    ok = okn; pair = pairn; ch = chn;
  }
#undef AT_DECODE
}

DI void ph_na_fast2(PRef p, int l, unsigned char* lds8) {
  using namespace fa;
  const int tid_ = opq_tid(); const int bid_ = opq_bid(), nblk_ = opq_nblk();
  char* lds = (char*)lds8;
  const bf16* __restrict__ Q = (const bf16*)(p.ws + WS_NQ); const bf16* __restrict__ K = (const bf16*)(p.ws + WS_NK); const bf16* __restrict__ V = (const bf16*)(p.ws + WS_NV); bf16* __restrict__ BI = (bf16*)(p.ws + WS_BI);
  const float* __restrict__ QB = (const float*)(p.ws + WS_QBN);
  const float* rpb = p.in[I_RPB] + (size_t)l * NH * 15 * 31;
  const int wid = __builtin_amdgcn_readfirstlane(tid_ >> 6), lane = tid_ & 63, r32 = lane & 31, hi = lane >> 5;
  char* V_lds = lds; char* K_lds = lds + 2 * SHM_V;
  float* tbl = (float*)(lds + 2 * SHM_V + 2 * SHM_K + 2048);
  bf16x8 onesB; { const unsigned ov = r32 == 0 ? 0x3F803F80u : 0u; u32x4 t = {ov, ov, ov, ov}; onesB = *reinterpret_cast<bf16x8*>(&t); }
  const int sr = tid_ >> 4, sc = (tid_ & 15) * 8; const bool act = sc < 64;
  const int vst0 = v_st(sr, sc & 63), vst1 = v_st(32 + sr, sc & 63);
  const int vb0 = (int)(uintptr_t)V_lds + v_rd_base(lane);
  const bool xmap = (nblk_ == 256);
  for (int i = 0;; ++i) {
    int pair, g;
    if (xmap) { const int v = i * 32 + (bid_ >> 3); if (v >= 64) break; pair = (v >> 4) * 8 + (bid_ & 7); g = v & 15; }
    else { const int u = i * nblk_ + bid_; if (u >= NB * NH * 16) break; pair = u >> 4; g = u & 15; }
    const int b = pair >> 2, h = pair & 3;
    for (int k = tid_; k < 15 * 32; k += 512) { const int ii = k >> 5, jj = k & 31; tbl[k] = jj < 31 ? rpb[(h * 15 + ii) * 31 + jj] * LOG2E : 0.f; }
    const int lo = min(max(4 * g - 4, 0), 56), hiR = min(max(4 * g + 3 - 4, 0), 56) + 7, NT = 4 + (hiR - lo + 1);
    const int qrow = 4 * g + (wid >> 1), rs_w = min(max(qrow - 4, 0), 56), qc = 32 * (wid & 1) + r32, ws0 = min(max(qc - 8, 0), 48);
    const int r0 = b * SEQ + g * 256;
    const bf16* Kh = K + h * 64; const bf16* Vh = V + h * 64;
    unsigned vmask = 0u;
#pragma unroll
    for (int r = 0; r < 16; ++r) { const int kc = crow(r, hi); vmask |= ((unsigned)(kc - ws0) < 16u ? 1u : 0u) << r; vmask |= ((unsigned)(kc + 32 - ws0) < 16u ? 1u : 0u) << (16 + r); }
    const int bbase = 4 * hi - qc + 15;
    f32x16 o[3] = {}; bf16x8 qr[4];
    const bf16* Qw = Q + (size_t)(r0 + wid * 32 + r32) * 256 + h * 64 + hi * 8;
#pragma unroll
    for (int d0 = 0; d0 < 4; ++d0) qr[d0] = *reinterpret_cast<const bf16x8*>(Qw + d0 * 16);
    const float nb = QB[(size_t)(r0 + wid * 32 + r32) * 4 + h];
    f32x16 nbt;
#pragma unroll
    for (int r = 0; r < 16; ++r) nbt[r] = nb;
    bf16x8 vs0, vs1, ks0, ks1;
#define NA_KROW(j) ((j) < 4 ? TL + b * CTX + 64 * (j) : b * SEQ + (lo + (j) - 4) * 64)
#define NA_SLOAD(j) do { if (act) { const long kr_ = NA_KROW(j); vs0 = *reinterpret_cast<const bf16x8*>(&Vh[(kr_ + sr) * 256 + sc]); vs1 = *reinterpret_cast<const bf16x8*>(&Vh[(kr_ + 32 + sr) * 256 + sc]); \
      ks0 = *reinterpret_cast<const bf16x8*>(&Kh[(kr_ + sr) * 256 + sc]); ks1 = *reinterpret_cast<const bf16x8*>(&Kh[(kr_ + 32 + sr) * 256 + sc]); } } while (0)
#define NA_SWRITE(bb) do { if (act) { *(bf16x8*)(V_lds + (bb) * SHM_V + vst0) = vs0; *(bf16x8*)(V_lds + (bb) * SHM_V + vst1) = vs1; const int kc_ = sc * 2; \
      *(bf16x8*)(K_lds + (bb) * SHM_K + FA_KSWZ(sr, kc_)) = ks0; *(bf16x8*)(K_lds + (bb) * SHM_K + FA_KSWZ(32 + sr, kc_)) = ks1; } } while (0)
    NA_SLOAD(0); NA_SWRITE(0); __syncthreads();
    for (int j = 0; j < NT; ++j) {
      const int bb = j & 1;
      if (j + 1 < NT) NA_SLOAD(j + 1);
      const int kr = lo + j - 4;
      const bool wvalid = (j < 4) || (kr >= rs_w && kr < rs_w + 8);
      if (wvalid) {
        f32x16 p0, p1; bf16x8 pa0, pa1, pa2, pa3;
        qkt2<4>(p0, p1, K_lds + bb * SHM_K, qr, nbt, r32, hi);
        if (j >= 4) {
          const float* brow = tbl + (kr - qrow + 7) * 32 + bbase;
#pragma unroll
          for (int r = 0; r < 16; ++r) { const int co = (r & 3) + 8 * (r >> 2);
            p0[r] = ((vmask >> r) & 1u) ? p0[r] + brow[co] : -1e30f; p1[r] = ((vmask >> (16 + r)) & 1u) ? p1[r] + brow[co + 32] : -1e30f; }
        }
        expcvt_b(p0, p1, pa0, pa1, pa2, pa3);
        pv3b(o, vb0 + bb * SHM_V, pa0, pa1, pa2, pa3, onesB);
      }
      if (j + 1 < NT) NA_SWRITE(bb ^ 1);
      __syncthreads();
    }
    bf16* Ow = BI + (size_t)(r0 + wid * 32) * D + 768 + h * 64;
#pragma unroll
    for (int r = 0; r < 16; ++r) { const int orow = crow(r, hi);
      const float lsum = __int_as_float(__builtin_amdgcn_ds_bpermute((hi * 32) << 2, __float_as_int(o[2][r]))); const float rl = __builtin_amdgcn_rcpf(lsum);
#pragma unroll
      for (int d0 = 0; d0 < 2; ++d0) Ow[(size_t)orow * D + d0 * 32 + r32] = f2bf(o[d0][r] * rl); }
    __syncthreads();
#undef NA_KROW
#undef NA_SLOAD
#undef NA_SWRITE
  }
}

#define LAS __attribute__((address_space(3)))
#define XB_TMO      128
#define XB_XCNT(j)  (256  + 64 * (j))
#define XB_XSUB(j)  (1280 + 64 * (j))
#define XB_XGEN(j)  (2304 + 64 * (j))
#define XB_TOP      3328
#define XB_TOPGEN   3392
#define XCD_BAR_WORDS 3456
#define XB_SPIN_CAP (1u << 24)
__device__ __forceinline__ unsigned xb_ld(unsigned* p)              { return __hip_atomic_load(p, __ATOMIC_RELAXED, __HIP_MEMORY_SCOPE_AGENT); }
__device__ __forceinline__ unsigned xb_add(unsigned* p, unsigned v) { return __hip_atomic_fetch_add(p, v, __ATOMIC_RELAXED, __HIP_MEMORY_SCOPE_AGENT); }
__device__ __forceinline__ unsigned xb_xcc_id() { return (unsigned)__builtin_amdgcn_s_getreg((3 << 11) | 20) & 0xFu; }
#define XB_SPIN(cond, bar) do { unsigned _sp = 0; while (cond) { __builtin_amdgcn_s_sleep(1); \
    if ((++_sp & 255u) == 0u) { if (xb_ld(&(bar)[XB_TMO])) break; if (_sp > XB_SPIN_CAP) { atomicAdd(&(bar)[XB_TMO], 1u); break; } } } } while (0)
struct XcdBarrier { unsigned* bar; unsigned x; volatile LAS unsigned* st; };
__device__ __forceinline__ XcdBarrier xcd_barrier_post(unsigned* bar, volatile LAS unsigned* st) {
    XcdBarrier b; b.bar = bar; b.x = xb_xcc_id(); b.st = st;
    if (threadIdx.x == 0) (void)xb_add(&bar[XB_XCNT(b.x)], 1u);
    return b;
}
__device__ __forceinline__ void xcd_barrier_complete(unsigned* bar, unsigned x, unsigned& nloc, unsigned& nx) {
    const unsigned G = gridDim.x * gridDim.y * gridDim.z;
    unsigned sum, cnt, mine, sp = 0u;
    for (;;) {
        sum = 0u; cnt = 0u; mine = 0u;
#pragma unroll
        for (unsigned j = 0; j < 16; ++j) { const unsigned c = xb_ld(&bar[XB_XCNT(j)]); sum += c; cnt += (c > 0u) ? 1u : 0u; }
        mine = xb_ld(&bar[XB_XCNT(x)]);
        if (sum == G) break;
        __builtin_amdgcn_s_sleep(1);
        if ((++sp & 255u) == 0u) { if (xb_ld(&bar[XB_TMO])) break; if (sp > XB_SPIN_CAP) { atomicAdd(&bar[XB_TMO], 1u); break; } }
    }
    nloc = mine > 0u ? mine : 1u; nx = cnt > 0u ? cnt : 1u;
}
__device__ __forceinline__ void xcd_barrier(const XcdBarrier& b) {
    asm volatile("s_waitcnt vmcnt(0)" ::: "memory");
    __syncthreads();
    if (threadIdx.x == 0) {
        unsigned* bar = b.bar; unsigned bx = b.x; asm volatile("" : "+s"(bar), "+s"(bx));
        __builtin_amdgcn_s_waitcnt(0);
        unsigned nloc = b.st[0], nx = b.st[1];
        if (nloc == 0u) { xcd_barrier_complete(bar, bx, nloc, nx); b.st[0] = nloc; b.st[1] = nx; }
        const unsigned old = xb_add(&bar[XB_XSUB(bx)], 1u);
        const unsigned gen = old / nloc;
        if (old + 1u == (gen + 1u) * nloc) {
            __builtin_amdgcn_fence(__ATOMIC_RELEASE, "agent");
            asm volatile("s_waitcnt vmcnt(0)" ::: "memory");
            const unsigned og = xb_add(&bar[XB_TOP], 1u);
            const unsigned tg = og / nx;
            if (og + 1u == (tg + 1u) * nx) xb_add(&bar[XB_TOPGEN], 1u);
            else XB_SPIN(xb_ld(&bar[XB_TOPGEN]) == tg, bar);
            __builtin_amdgcn_fence(__ATOMIC_ACQUIRE, "agent");
            xb_add(&bar[XB_XGEN(bx)], 1u);
            asm volatile("s_waitcnt vmcnt(0)" ::: "memory");
        } else {
            XB_SPIN(xb_ld(&bar[XB_XGEN(bx)]) == gen, bar);
            __builtin_amdgcn_fence(__ATOMIC_ACQUIRE, "agent");
            asm volatile("s_waitcnt vmcnt(0)" ::: "memory");
        }
    }
    __syncthreads();
}

constexpr int LDS_BYTES = 147456;
constexpr int BARW_OFF = 131072 + 512;
constexpr int CW_BAR = 4096;

#ifndef ATTN_V2
#define ATTN_V2 1
#endif
#ifndef REP_GEMM
#define REP_GEMM 1
#endif
#ifndef REP_ATTN
#define REP_ATTN 1
#endif
#ifndef REP_SMALL
#define REP_SMALL 1
#endif
#ifndef REP_CVT
#define REP_CVT 1
#endif
#ifndef REP_MD
#define REP_MD 1
#endif
#ifndef FA_WI
#define FA_WI 0
#endif
#define REPEAT_L(n, stmt) do { if ((n) == 1) { stmt; } else { int n_ = (n); asm volatile("" : "+s"(n_)); for (int rep_ = 0; rep_ < n_; ++rep_) { stmt; __syncthreads(); } } } while (0)
#define REPEAT(n, stmt) do { _Pragma("unroll") for (int rep_ = 0; rep_ < (n); ++rep_) { stmt; if ((n) > 1) __syncthreads(); } } while (0)
template <int l>
DI void layer_program(const XcdBarrier& bar, unsigned char* lds) {
#define GBAR() xcd_barrier(bar)
    const bool last = (l == 1);
    const int nrows = last ? TL : T;
    const float lam_init = last ? 0.35550906759096924f : 0.2f;
    if (l == 0) { REPEAT(REP_SMALL, ph_mod1(PP, l)); GBAR(); }
    REPEAT(REP_GEMM, ph_proj_fast(PP, l, lds));
    GBAR();
    REPEAT(REP_GEMM, ph_qkvraw_fast(PP, l, lds));
    REPEAT(REP_SMALL, ph_conv(PP, l, nrows, lds));
    GBAR();
#if ATTN_V2
#if REP_MD > 1
    { int n_ = REP_MD; asm volatile("" : "+s"(n_)); for (int rep_ = 0; rep_ < n_ - 1; ++rep_) { ph_attn_fast2<96, FA_WI>((const bf16*)(PP.ws + WS_MQ), (const bf16*)(PP.ws + WS_MK), (const bf16*)(PP.ws + WS_MV), (const float*)(PP.ws + WS_QBM), 4, 1, (bf16*)(PP.ws + WS_BI), D, 256, 0, SEQ, true, lds); __syncthreads(); ph_attn_fast2<32, FA_WI>((const bf16*)(PP.ws + WS_DQ), (const bf16*)(PP.ws + WS_DK), (const bf16*)(PP.ws + WS_DV), (const float*)(PP.ws + WS_QBD), 8, 2, (bf16*)(PP.ws + WS_DO), 512, 0, 0, SEQ, true, lds); __syncthreads(); } }
#endif
    ph_attn_fast2<96>((const bf16*)(PP.ws + WS_MQ), (const bf16*)(PP.ws + WS_MK), (const bf16*)(PP.ws + WS_MV), (const float*)(PP.ws + WS_QBM), 4, 1, (bf16*)(PP.ws + WS_BI), D, 256, 0, SEQ, true, lds);
    ph_attn_fast2<32>((const bf16*)(PP.ws + WS_DQ), (const bf16*)(PP.ws + WS_DK), (const bf16*)(PP.ws + WS_DV), (const float*)(PP.ws + WS_QBD), 8, 2, (bf16*)(PP.ws + WS_DO), 512, 0, 0, SEQ, true, lds);
    REPEAT(REP_ATTN, ph_na_fast2(PP, l, lds));
    if (!last) {
      ph_attn_fast2<96>((const bf16*)(PP.ws + WS_MQ), (const bf16*)(PP.ws + WS_MK), (const bf16*)(PP.ws + WS_MV), (const float*)(PP.ws + WS_QBM), 4, 1, (bf16*)(PP.ws + WS_BI), D, 256, TL, CTX, false, lds);
      ph_attn_fast2<32>((const bf16*)(PP.ws + WS_DQ), (const bf16*)(PP.ws + WS_DK), (const bf16*)(PP.ws + WS_DV), (const float*)(PP.ws + WS_QBD), 8, 2, (bf16*)(PP.ws + WS_DO), 512, 0, TL, CTX, false, lds);
      ph_attn_fast2<64>((const bf16*)(PP.ws + WS_NQ), (const bf16*)(PP.ws + WS_NK), (const bf16*)(PP.ws + WS_NV), (const float*)(PP.ws + WS_QBN), 4, 1, (bf16*)(PP.ws + WS_BI), D, 768, TL, CTX, false, lds);
    }
    GBAR();
#else
    REPEAT(REP_ATTN, ph_attn_fast<96>((const bf16*)(PP.ws + WS_MQ), (const bf16*)(PP.ws + WS_MK), (const bf16*)(PP.ws + WS_MV), 4, 1, (bf16*)(PP.ws + WS_BI), D, 256, 0, SEQ, true, lds));
    REPEAT(REP_ATTN, ph_attn_fast<32>((const bf16*)(PP.ws + WS_DQ), (const bf16*)(PP.ws + WS_DK), (const bf16*)(PP.ws + WS_DV), 8, 2, (bf16*)(PP.ws + WS_DO), 512, 0, 0, SEQ, true, lds));
    REPEAT(REP_ATTN, ph_na_fast(PP, l, lds));
    if (!last) {
      ph_attn_fast<96>((const bf16*)(PP.ws + WS_MQ), (const bf16*)(PP.ws + WS_MK), (const bf16*)(PP.ws + WS_MV), 4, 1, (bf16*)(PP.ws + WS_BI), D, 256, TL, CTX, false, lds);
      ph_attn_fast<32>((const bf16*)(PP.ws + WS_DQ), (const bf16*)(PP.ws + WS_DK), (const bf16*)(PP.ws + WS_DV), 8, 2, (bf16*)(PP.ws + WS_DO), 512, 0, TL, CTX, false, lds);
      ph_attn_fast<64>((const bf16*)(PP.ws + WS_NQ), (const bf16*)(PP.ws + WS_NK), (const bf16*)(PP.ws + WS_NV), 4, 1, (bf16*)(PP.ws + WS_BI), D, 768, TL, CTX, false, lds);
    }
    GBAR();
#endif
    REPEAT(REP_SMALL, ph_diffcombine_fast(PP, l, nrows, lam_init));
    GBAR();
    REPEAT(REP_GEMM, ph_branch_fast(PP, l, nrows, lds));
    GBAR();
    REPEAT(REP_GEMM, ph_merge_fast(PP, l, nrows, lds));
    GBAR();
    REPEAT((l == 0 ? REP_GEMM : 1), ph_wo_fast(PP, l, nrows, lds));
    GBAR();
    ph_mod2_router_fast(PP, l, nrows, lds);
    GBAR();
    REPEAT(REP_GEMM, ph_moe1_fast(PP, l, lds));
    GBAR();
    REPEAT(REP_GEMM, ph_moe2_fast(PP, l, lds));
    GBAR();
    ph_combine(PP, l, nrows, lds);
    if (l == 0) GBAR();
}

__global__ void __launch_bounds__(512, 2) fwd(Params p) {
  extern __shared__ __attribute__((aligned(16))) unsigned char lds[];
  if (threadIdx.x < 4) ((unsigned*)(lds + BARW_OFF))[threadIdx.x] = 0u;
  __syncthreads();
  XcdBarrier bar = xcd_barrier_post((unsigned*)(PP.ws + WS_CTL) + CW_BAR, (volatile LAS unsigned*)(lds + BARW_OFF));
  ph_ada_fast(PP, lds);
  __syncthreads();
  REPEAT(REP_CVT, ph_convert(PP, lds));
  GBAR();
  layer_program<0>(bar, lds);
  layer_program<1>(bar, lds);
}

extern "C" void kernel_launch(void* const* d_in, const int* in_sizes, int n_in, void* d_out, int out_size, void* d_ws, size_t ws_size, hipStream_t stream) {
  static int grid = 0;
  if (grid == 0) {
    if (n_in != N_IN || ws_size < WS_END) { fprintf(stderr, "kernel_launch: n_in %d ws %zu need %zu\n", n_in, ws_size, (size_t)WS_END); grid = -1; return; }
    int dev = 0, cus = 0;
    if (hipGetDevice(&dev) != hipSuccess || hipDeviceGetAttribute(&cus, hipDeviceAttributeMultiprocessorCount, dev) != hipSuccess) { grid = -1; return; }
    if (hipFuncSetAttribute((const void*)fwd, hipFuncAttributeMaxDynamicSharedMemorySize, LDS_BYTES) != hipSuccess) { fprintf(stderr, "kernel_launch: hipFuncSetAttribute failed\n"); grid = -1; return; }
    int per_cu = 0;
    if (hipOccupancyMaxActiveBlocksPerMultiprocessor(&per_cu, (const void*)fwd, 512, LDS_BYTES) != hipSuccess || per_cu < 1) fprintf(stderr, "kernel_launch: occupancy query says %d\n", per_cu);
    (void)hipGetLastError();
    grid = cus;
  }
  if (grid < 0) return;
  Params p{};
  for (int i = 0; i < N_IN; ++i) p.in[i] = (const float*)d_in[i];
  p.out = (float*)d_out; p.ws = (unsigned char*)d_ws;
  (void)hipMemsetAsync((char*)d_ws + WS_CTL, 0, 1 * MiB, stream);
  (void)hipMemsetAsync((char*)d_ws + WS_QKV_T, 0, (size_t)2 * 1024 * 384 * 2, stream);
  (void)hipMemsetAsync((char*)d_ws + WS_WIN_T, 0, (size_t)2 * PLD * D * 2, stream);
  hipLaunchKernelGGL(fwd, dim3(grid), dim3(512), LDS_BYTES, stream, p);
}
```

```cpp
#include <hip/hip_runtime.h>
#include <cstdio>
#include <cstdint>

typedef unsigned short bf16;
#ifndef FAST_ATTN
#define FAST_ATTN 1
#endif
#if FAST_ATTN
#define ATTN_FN ph_attn_fast
#define ATTN_LDS , lds
#else
#define ATTN_FN ph_attn_naive
#define ATTN_LDS
#endif
#ifndef FAST_NA
#define FAST_NA 1
#endif
#ifndef FAST_SMALL
#define FAST_SMALL 1
#endif
#ifndef FAST_ROUTER
#define FAST_ROUTER 1
#endif
#ifndef FAST_PROJ
#define FAST_PROJ 1
#endif
#ifndef FAST_QKV
#define FAST_QKV 1
#endif
#ifndef FAST_MERGE
#define FAST_MERGE 1
#endif
#ifndef FAST_WO
#define FAST_WO 1
#endif
#ifndef FAST_MOE
#define FAST_MOE 1
#endif
#define DI __device__ __forceinline__

constexpr int D = 1024, NB = 8, SEQ = 4096, CTX = 256, GW = 64;
constexpr int TL = NB * SEQ;
constexpr int TC = NB * CTX;
constexpr int T = TL + TC;
constexpr int NH = 4;
constexpr int INW = 2400, PLD = 2560;
constexpr int OFF_B = 512, OFF_C = 864, OFF_D = 1632;
constexpr int NE = 32, DFF = 1024;
constexpr int MAXROWS = 4 * T + NE * 256;
constexpr float EPS = 1e-6f;
constexpr float LOG2E = 1.4426950408889634f;

enum { I_X = 0, I_C, I_CTX, I_CCTX, I_ADAW, I_ADAB, I_N1G, I_N2G, I_WIN, I_CONVW, I_CONVB, I_CLNG, I_CLNB, I_CONVOUT,
       I_CQG, I_CKVG, I_WUQ, I_WUKV, I_QNG, I_KNG, I_MLAOUT, I_DQNG, I_DKNG, I_DLAM, I_DSUBG, I_DIFFOUT, I_NQNG, I_NKNG,
       I_RPB, I_NAOUT, I_GATEW, I_GATEB, I_WO, I_RW, I_RB, I_WGU, I_BGU, I_WDN, I_BDN, N_IN };

constexpr size_t MiB = 1u << 20;
constexpr size_t al(size_t x) { return (x + 255) / 256 * 256; }
constexpr size_t WS_CTL = 0;
constexpr size_t WS_MOD = 1 * MiB;
constexpr size_t WS_ROPE = WS_MOD + al(2 * 9 * 6144 * 4);
constexpr size_t WS_ROUTE = WS_ROPE + al(4096 * 32 * 4);
constexpr size_t WS_ROWTOK = WS_ROUTE + al((size_t)T * 4 * 16);
constexpr size_t WS_HS = WS_ROWTOK + al((size_t)NE * T * 4);
constexpr size_t WS_WGUS = WS_HS + al((size_t)T * 4);
constexpr size_t WS_HS1 = WS_WGUS + al((size_t)2 * NE * 2048 * 4);
constexpr size_t WS_WINS = WS_HS1 + al((size_t)T * 4);
constexpr size_t WS_GATES = WS_WINS + al((size_t)2 * PLD * 4);
constexpr size_t WS_WIN_T = WS_GATES + al((size_t)2 * 4096 * 4);
constexpr size_t WS_QKV_T = WS_WIN_T + al((size_t)2 * PLD * D * 2);
constexpr size_t WS_WB_T = WS_QKV_T + al((size_t)2 * 1024 * 384 * 2);
constexpr size_t WS_GATE_T = WS_WB_T + al((size_t)2 * 4 * 1024 * 256 * 2);
constexpr size_t WS_WO_T = WS_GATE_T + al((size_t)2 * 4096 * D * 2);
constexpr size_t WS_WGU_T = WS_WO_T + al((size_t)2 * D * D * 2);
constexpr size_t WS_WDN_T = WS_WGU_T + al((size_t)2 * NE * 2048 * D * 2);
constexpr size_t WS_H = WS_WDN_T + al((size_t)2 * NE * D * DFF * 2);
constexpr size_t WS_H2 = WS_H + al((size_t)T * D * 2);
constexpr size_t WS_XF = WS_H2 + al((size_t)T * D * 2);
constexpr size_t WS_SCR = WS_XF + al((size_t)T * D * 4);
constexpr size_t WS_PROJ = WS_SCR;
constexpr size_t WS_CU = WS_PROJ + al((size_t)T * PLD * 2);
constexpr size_t WS_AQ = WS_CU + al((size_t)T * 256 * 2);
constexpr size_t WS_QKVRAW = WS_AQ + al((size_t)T * 384 * 2);
constexpr size_t WS_MQ = WS_QKVRAW + al((size_t)T * 1024 * 2);
constexpr size_t WS_MK = WS_MQ + al((size_t)T * 384 * 2);
constexpr size_t WS_MV = WS_MK + al((size_t)T * 384 * 2);
constexpr size_t WS_DQ = WS_MV + al((size_t)T * 256 * 2);
constexpr size_t WS_DK = WS_DQ + al((size_t)T * 256 * 2);
constexpr size_t WS_DV = WS_DK + al((size_t)T * 256 * 2);
constexpr size_t WS_NQ = WS_DV + al((size_t)T * 256 * 2);
constexpr size_t WS_NK = WS_NQ + al((size_t)T * 256 * 2);
constexpr size_t WS_NV = WS_NK + al((size_t)T * 256 * 2);
constexpr size_t WS_BI = WS_NV + al((size_t)T * 256 * 2);
constexpr size_t WS_DO = WS_BI + al((size_t)T * D * 2);
constexpr size_t WS_QBM = WS_DO + al((size_t)T * 512 * 2);
constexpr size_t WS_QBD = WS_QBM + al((size_t)T * 4 * 4);
constexpr size_t WS_QBN = WS_QBD + al((size_t)T * 8 * 4);
constexpr size_t WS_KPE = WS_QBN + al((size_t)T * 4 * 4);
constexpr size_t WS_YB = WS_KPE + al((size_t)T * 32 * 2);
constexpr size_t WS_YM = WS_YB + al((size_t)T * 4096 * 2);
constexpr size_t WS_MIX_END = WS_YM + al((size_t)T * D * 2);
constexpr size_t WS_ACT = WS_SCR;
constexpr size_t WS_YE = WS_ACT + al((size_t)MAXROWS * D * 2);
constexpr size_t WS_MOE_END = WS_YE + al((size_t)MAXROWS * D * 2);
constexpr size_t WS_END = WS_MIX_END > WS_MOE_END ? WS_MIX_END : WS_MOE_END;
static_assert(WS_END <= (size_t)2048 * MiB, "workspace budget (>= 2 GiB guaranteed)");
constexpr int CW_BIASMAX = 2048;
constexpr int CW_CNT = 1024;

struct Params {
  const float* in[N_IN];
  float* out;
  unsigned char* ws;
};
typedef const __attribute__((address_space(4))) Params& PRef;
typedef const __attribute__((address_space(4))) Params* PPtr;
__device__ __forceinline__ PPtr opq_params() { PPtr pp = (PPtr)__builtin_amdgcn_kernarg_segment_ptr(); asm volatile("" : "+s"(pp)); return pp; }
#define PP (*opq_params())

DI float bf2f(bf16 v) { return __uint_as_float(((unsigned)v) << 16); }
DI bf16 f2bf(float f) { unsigned u = __float_as_uint(f); u += 0x7fffu + ((u >> 16) & 1u); return (bf16)(u >> 16); }
DI float sigmoidf_(float x) { return 1.f / (1.f + __expf(-x)); }
DI float wave_sum_l(float v, int lane) {
#pragma unroll
  for (int o = 1; o < 64; o <<= 1) v += __int_as_float(__builtin_amdgcn_ds_bpermute((lane ^ o) << 2, __float_as_int(v)));
  return v;
}
#define wave_sum(v) wave_sum_l((v), lane)
DI unsigned cvt_pk_bf16_(float lo, float hi) { unsigned r; asm volatile("v_cvt_pk_bf16_f32 %0, %1, %2" : "=v"(r) : "v"(lo), "v"(hi)); return r; }
DI float seg_sum(float v, int lane, int width) {
#pragma unroll
  for (int o = 1; o < 64; o <<= 1) if (o < width) v += __int_as_float(__builtin_amdgcn_ds_bpermute((lane ^ o) << 2, __float_as_int(v)));
  return v;
}
DI float lane_xor(float v, int lane, int o) { return __int_as_float(__builtin_amdgcn_ds_bpermute((lane ^ o) << 2, __float_as_int(v))); }

DI void quant_row_i8(const float (&v)[16], signed char* dst, float* scale_out, int lane) {
  float mx = 0.f;
#pragma unroll
  for (int i = 0; i < 16; ++i) mx = fmaxf(mx, fabsf(v[i]));
#pragma unroll
  for (int o = 1; o < 64; o <<= 1) mx = fmaxf(mx, lane_xor(mx, lane, o));
  const float sc = mx > 0.f ? mx * (1.f / 127.f) : 1.f, inv = 1.f / sc; if (lane == 0) *scale_out = sc;
#pragma unroll
  for (int j = 0; j < 4; ++j) { unsigned b = 0;
#pragma unroll
    for (int i = 0; i < 4; ++i) b |= ((unsigned)(int)rintf(v[4 * j + i] * inv) & 255u) << (8 * i);
    *(unsigned*)(dst + j * 256 + lane * 4) = b; }
}
DI void ld4(const bf16* p, float (&x)[4]) { const uint2 u = *(const uint2*)p; x[0] = __uint_as_float(u.x << 16); x[1] = __uint_as_float(u.x & 0xffff0000u); x[2] = __uint_as_float(u.y << 16); x[3] = __uint_as_float(u.y & 0xffff0000u); }
DI void st4(bf16* p, const float (&x)[4]) { uint2 u; u.x = cvt_pk_bf16_(x[0], x[1]); u.y = cvt_pk_bf16_(x[2], x[3]); *(uint2*)p = u; }

DI int opq_bid() { int b = blockIdx.x; asm volatile("" : "+s"(b)); return b; }
DI int opq_nblk() { int g = gridDim.x; asm volatile("" : "+s"(g)); return g; }
DI int opq_tid() { int t = threadIdx.x; asm volatile("" : "+v"(t)); return t; }
#define GTID ((int)(bid_ * 512 + tid_))
#define NTHR ((int)(nblk_ * 512))
#define SUB ((int)(tid_ >> 8))
#define T256 ((int)(tid_ & 255))
DI int modidx(int r) { return r < TL ? (r >> 12) : NB; }


DI const float* stream_row(PRef p, int l, int r, bool after_mixer) {
  if (l == 0 && !after_mixer) return r < TL ? p.in[I_X] + (size_t)r * D : p.in[I_CTX] + (size_t)(r - TL) * D;
  return (const float*)(p.ws + WS_XF) + (size_t)r * D;
}
DI void ph_mod1(PRef p, int l) {
  const int tid_ = opq_tid(); const int bid_ = opq_bid(), nblk_ = opq_nblk(); (void)bid_; (void)nblk_;
  const int lane = tid_ & 63, gw = GTID >> 6, ngw = NTHR >> 6;
  const float* MOD = (const float*)(p.ws + WS_MOD);
  bf16* H = (bf16*)(p.ws + WS_H);
  const float* g = p.in[I_N1G] + l * D;
  float4 c0, c1, c2, c3;
  { const float* x = stream_row(p, l, min(gw, T - 1), false) + lane * 4; c0 = *(const float4*)(x); c1 = *(const float4*)(x + 256); c2 = *(const float4*)(x + 512); c3 = *(const float4*)(x + 768); }
  for (int r = gw; r < T; r += ngw) {
    float4 n0, n1, n2, n3;
    { const float* x = stream_row(p, l, min(r + ngw, T - 1), false) + lane * 4; n0 = *(const float4*)(x); n1 = *(const float4*)(x + 256); n2 = *(const float4*)(x + 512); n3 = *(const float4*)(x + 768); }
    float v[16]; float ss = 0.f;
    { const float4 t4[4] = {c0, c1, c2, c3};
#pragma unroll
    for (int j = 0; j < 4; ++j) { const float4 t = t4[j]; v[4 * j] = t.x; v[4 * j + 1] = t.y; v[4 * j + 2] = t.z; v[4 * j + 3] = t.w; ss += t.x * t.x + t.y * t.y + t.z * t.z + t.w * t.w; } }
    c0 = n0; c1 = n1; c2 = n2; c3 = n3;
    ss = wave_sum(ss);
    const float rstd = rsqrtf(ss * (1.f / D) + EPS);
    const float* md = MOD + ((size_t)l * 9 + modidx(r)) * 6144;
#pragma unroll
    for (int j = 0; j < 4; ++j)
#pragma unroll
      for (int i = 0; i < 4; ++i) { const int c = j * 256 + lane * 4 + i; v[4 * j + i] = v[4 * j + i] * rstd * g[c] * (1.f + md[1024 + c]) + md[c]; }
    quant_row_i8(v, (signed char*)H + (size_t)r * D, (float*)(p.ws + WS_HS1) + r, lane);
  }
}

struct RowId { DI int operator()(int m) const { return m; } };
struct RowGather { const int* idx; DI int operator()(int m) const { return idx[m]; } };
#define ZERO_ACC(acc) do { _Pragma("unroll") for (int i_ = 0; i_ < 4; ++i_) _Pragma("unroll") for (int j_ = 0; j_ < 4; ++j_) acc[i_][j_] = 0.f; } while (0)


DI void ph_conv(PRef p, int l, int nrows, unsigned char* lds) {
  const int tid_ = opq_tid(); const int bid_ = opq_bid(), nblk_ = opq_nblk(); (void)bid_; (void)nblk_;
  const int lane = tid_ & 63, gw = GTID >> 6, ngw = NTHR >> 6;
  const bf16* __restrict__ CU = (const bf16*)(p.ws + WS_CU); bf16* __restrict__ BI = (bf16*)(p.ws + WS_BI);
  const float* cw = p.in[I_CONVW] + l * 31 * 256; const float* cb = p.in[I_CONVB] + l * 256;
  float4* wl = (float4*)lds;
  for (int k = tid_; k < 31 * 64; k += 512) wl[k] = *(const float4*)(cw + 4 * k);
  __syncthreads();
  const float4 bias = *(const float4*)(cb + lane * 4), lg = *(const float4*)(p.in[I_CLNG] + l * 256 + lane * 4), lb = *(const float4*)(p.in[I_CLNB] + l * 256 + lane * 4);
  for (int r = gw; r < nrows; r += ngw) {
    int lo, hi; if (r < TL) { lo = r & ~(SEQ - 1); hi = lo + SEQ; } else { lo = TL + ((r - TL) & ~(CTX - 1)); hi = lo + CTX; }
    const bf16* up = CU + (long)(r - 15) * 256 + lane * 4; asm volatile("" : "+v"(up));
    uint2 u[31];
#pragma unroll
    for (int j = 0; j < 31; ++j) { const int rr = r + j - 15; u[j] = make_uint2(0u, 0u); if (rr >= lo && rr < hi) u[j] = *(const uint2*)(up + j * 256); }
    float a[4] = {bias.x, bias.y, bias.z, bias.w};
#pragma unroll
    for (int j = 0; j < 31; ++j) { const float4 w = wl[j * 64 + lane];
      a[0] += __uint_as_float(u[j].x << 16) * w.x; a[1] += __uint_as_float(u[j].x & 0xffff0000u) * w.y; a[2] += __uint_as_float(u[j].y << 16) * w.z; a[3] += __uint_as_float(u[j].y & 0xffff0000u) * w.w; }
    const float mu = seg_sum(a[0] + a[1] + a[2] + a[3], lane, 64) * (1.f / 256.f);
    float q2 = 0.f;
#pragma unroll
    for (int c = 0; c < 4; ++c) { a[c] -= mu; q2 += a[c] * a[c]; }
    const float rs = rsqrtf(seg_sum(q2, lane, 64) * (1.f / 256.f) + EPS);
    float y[4] = {a[0] * rs * lg.x + lb.x, a[1] * rs * lg.y + lb.y, a[2] * rs * lg.z + lb.z, a[3] * rs * lg.w + lb.w};
#pragma unroll
    for (int c = 0; c < 4; ++c) y[c] = y[c] * sigmoidf_(y[c]);
    st4(BI + (size_t)r * D + lane * 4, y);
  }
  __syncthreads();
}


DI void expert_offsets(const unsigned* cnt, int* off  ) { int a = 0; for (int e = 0; e < NE; ++e) { off[e] = a; a += ((int)cnt[e] + 255) & ~255; } off[NE] = a; }
DI void expert_offsets_wave(const unsigned* cnt, int* off  , int lane) {
  const int v = lane < NE ? (((int)cnt[lane < NE ? lane : 0] + 255) & ~255) : 0; int inc = v;
#pragma unroll
  for (int d = 1; d < 32; d <<= 1) { const int o = __builtin_amdgcn_ds_bpermute(((lane - d) & 63) << 2, inc); if (lane >= d) inc += o; }
  if (lane < NE) off[lane] = inc - v;
  if (lane == NE - 1) off[NE] = inc;
}
DI void ph_combine(PRef p, int l, int nrows, unsigned char* lds) {
  const int tid_ = opq_tid(); const int bid_ = opq_bid(), nblk_ = opq_nblk();
  int* off = (int*)(lds + 32768);
  const unsigned* cnt = (const unsigned*)(p.ws + WS_CTL) + CW_CNT + l * 64;
  if (tid_ < 64) expert_offsets_wave(cnt, off, tid_);
  __syncthreads();
  const int lane = tid_ & 63, gw = GTID >> 6, ngw = NTHR >> 6;
  const float* MOD = (const float*)(p.ws + WS_MOD); float* XF = (float*)(p.ws + WS_XF); const bf16* YE = (const bf16*)(p.ws + WS_YE); const int* ROUTE = (const int*)(p.ws + WS_ROUTE);
  bf16* H = (bf16*)(p.ws + WS_H); const float* g1n = p.in[I_N1G] + D;
  for (int r = gw; r < nrows; r += ngw) {
    const float* md = MOD + ((size_t)l * 9 + modidx(r)) * 6144 + 5 * 1024;
    float* dst = (l == 1) ? p.out + (size_t)r * D : XF + (size_t)r * D;
    const float* xs = XF + (size_t)r * D;
    float acc[16];
#pragma unroll
    for (int i = 0; i < 16; ++i) acc[i] = 0.f;
#pragma unroll
    for (int k = 0; k < 4; ++k) { const int* rt = ROUTE + ((size_t)r * 4 + k) * 4; const float w = __int_as_float(rt[2]); const bf16* y = YE + (size_t)(off[rt[0]] + rt[1]) * D;
#pragma unroll
      for (int j = 0; j < 4; ++j) { const uint2 u = *(const uint2*)(y + j * 256 + lane * 4);
        acc[4 * j] += w * __uint_as_float(u.x << 16); acc[4 * j + 1] += w * __uint_as_float(u.x & 0xffff0000u); acc[4 * j + 2] += w * __uint_as_float(u.y << 16); acc[4 * j + 3] += w * __uint_as_float(u.y & 0xffff0000u); } }
    float ss = 0.f;
#pragma unroll
    for (int j = 0; j < 4; ++j) { const int c = j * 256 + lane * 4; const float4 x4 = *(const float4*)(xs + c), m4 = *(const float4*)(md + c);
      acc[4 * j] = x4.x + m4.x * acc[4 * j]; acc[4 * j + 1] = x4.y + m4.y * acc[4 * j + 1]; acc[4 * j + 2] = x4.z + m4.z * acc[4 * j + 2]; acc[4 * j + 3] = x4.w + m4.w * acc[4 * j + 3];
      *(float4*)(dst + c) = make_float4(acc[4 * j], acc[4 * j + 1], acc[4 * j + 2], acc[4 * j + 3]);
      ss += acc[4 * j] * acc[4 * j] + acc[4 * j + 1] * acc[4 * j + 1] + acc[4 * j + 2] * acc[4 * j + 2] + acc[4 * j + 3] * acc[4 * j + 3]; }
    if (l == 0) {
      ss = seg_sum(ss, lane, 64); const float rstd = rsqrtf(ss * (1.f / D) + EPS);
      const float* m1 = MOD + ((size_t)9 + modidx(r)) * 6144;
#pragma unroll
      for (int j = 0; j < 4; ++j) { const int c = j * 256 + lane * 4; const float4 gg = *(const float4*)(g1n + c), s4 = *(const float4*)(m1 + 1024 + c), h4 = *(const float4*)(m1 + c);
        acc[4 * j] = acc[4 * j] * rstd * gg.x * (1.f + s4.x) + h4.x; acc[4 * j + 1] = acc[4 * j + 1] * rstd * gg.y * (1.f + s4.y) + h4.y; acc[4 * j + 2] = acc[4 * j + 2] * rstd * gg.z * (1.f + s4.z) + h4.z; acc[4 * j + 3] = acc[4 * j + 3] * rstd * gg.w * (1.f + s4.w) + h4.w; }
      quant_row_i8(acc, (signed char*)H + (size_t)r * D, (float*)(p.ws + WS_HS1) + r, lane);
    }
  }
}

namespace pg8 {
#define PG8_LAS __attribute__((address_space(3)))
typedef unsigned short bf16_t;
typedef short bf16x8 __attribute__((ext_vector_type(8)));
typedef float f32x4 __attribute__((ext_vector_type(4)));
typedef unsigned u32x4 __attribute__((ext_vector_type(4)));
typedef unsigned u32x2 __attribute__((ext_vector_type(2)));
typedef int i32x4v __attribute__((ext_vector_type(4)));
constexpr int BM = 256, BK = 64, HALF = 128, HTB = HALF * BK * 2, STAGE_BYTES = 8 * HTB;
__host__ __device__ __forceinline__ int lds_byte(int r, int c) { const int st = (r >> 4) * 2 + (c >> 5), rr = r & 15, cc = c & 31, ob = rr * 64 + cc * 2; return st * 1024 + (ob ^ (((ob >> 9) & 1) << 5)); }
__host__ __device__ __forceinline__ void stage_rc(int b, int& R, int& C) { const int st = b / 1024, sb = b % 1024, swz = sb ^ (((sb >> 9) & 1) << 5); R = (st >> 1) * 16 + swz / 64; C = (st & 1) * 32 + (swz % 64) / 2; }
__host__ __device__ __forceinline__ int perm32(int rho) { const int n = rho >> 4, i = rho & 15; return 8 * (i >> 2) + 4 * n + (i & 3); }
__device__ __forceinline__ unsigned cvt_pk_bf16(float lo, float hi) { unsigned r; asm volatile("v_cvt_pk_bf16_f32 %0, %1, %2" : "=v"(r) : "v"(lo), "v"(hi)); return r; }

struct Unit { int pm, pn, aux, nvalid; const char* A; const char* B; const int* rows; };

template <class Epi, class Sched, bool GATHER, bool I8 = false>
__device__ __forceinline__ void gemm_phase(PG8_LAS unsigned char* lds, const int lda_, const int K_, const Sched& S, const Epi& E) {
    const int lda = I8 ? lda_ / 2 : lda_, K = I8 ? K_ / 2 : K_;
    const int tid = opq_tid(), wid = __builtin_amdgcn_readfirstlane(tid >> 6), lane = tid & 63, wr = wid >> 2, wc = wid & 3, fr = lane & 15, fq = lane >> 4;
    const int nt = K / BK;
    unsigned voffA[2], voffB[2];
#pragma unroll
    for (int i = 0; i < 2; ++i) { int R, C; stage_rc(tid * 16 + i * 8192, R, C); const int Rb = Epi::PERM ? ((R & ~31) + perm32(R & 31)) : R;
        voffA[i] = GATHER ? (unsigned)(R * 65536 + C * 2) : (unsigned)(R * lda + C) * 2u; voffB[i] = (unsigned)(Rb * K + C) * 2u; }
    const size_t kstep = (size_t)(BK * 2);
    const size_t hstepA = GATHER ? 0 : (size_t)HALF * lda * 2, hstepB = (size_t)HALF * K * 2;
    const unsigned ldsw = (unsigned)wid * 1024u;
    const int aoff = lds_byte(wr * 64 + fr, fq * 8), boff = lds_byte(wc * 32 + fr, fq * 8);
#define PG8_SA(b, h) (((b) * 2 + (h)) * HTB)
#define PG8_SB(b, h) ((4 + (b) * 2 + (h)) * HTB)
#define PG8_STAGE(bufoff, gbase, voff) do { _Pragma("unroll") for (int _i = 0; _i < 2; ++_i) \
        __builtin_amdgcn_global_load_lds((const unsigned*)((const char*)(gbase) + (voff)[_i]), (PG8_LAS unsigned*)(lds + (bufoff) + ldsw + _i * 8192), 16, 0, 0); } while (0)
#define PG8_LDA(dst, b, h) do { _Pragma("unroll") for (int m = 0; m < 4; ++m) _Pragma("unroll") for (int k = 0; k < 2; ++k) dst[m][k] = *(const PG8_LAS bf16x8*)(lds + PG8_SA(b, h) + aoff + m * 2048 + k * 1024); } while (0)
#define PG8_LDB(dst, b, h) do { _Pragma("unroll") for (int n = 0; n < 2; ++n) _Pragma("unroll") for (int k = 0; k < 2; ++k) dst[n][k] = *(const PG8_LAS bf16x8*)(lds + PG8_SB(b, h) + boff + n * 2048 + k * 1024); } while (0)
#define PG8_MMA(ai, bj, At, Bt) do { __builtin_amdgcn_s_setprio(1); _Pragma("unroll") for (int m = 0; m < 4; ++m) _Pragma("unroll") for (int n = 0; n < 2; ++n) _Pragma("unroll") for (int k = 0; k < 2; ++k) { \
        if constexpr (I8) acc[ai][bj][m][n] = __builtin_bit_cast(f32x4, __builtin_amdgcn_mfma_i32_16x16x64_i8(__builtin_bit_cast(i32x4v, Bt[n][k]), __builtin_bit_cast(i32x4v, At[m][k]), __builtin_bit_cast(i32x4v, acc[ai][bj][m][n]), 0, 0, 0)); \
        else acc[ai][bj][m][n] = __builtin_amdgcn_mfma_f32_16x16x32_bf16(Bt[n][k], At[m][k], acc[ai][bj][m][n], 0, 0, 0); } __builtin_amdgcn_s_setprio(0); } while (0)
#define PG8_WAIT_V(n) asm volatile("s_waitcnt vmcnt(" #n ")" ::: "memory")
#define PG8_WAIT_L(n) asm volatile("s_waitcnt lgkmcnt(" #n ")" ::: "memory")
#define PG8_BAR __builtin_amdgcn_s_barrier()
#define PG8_SCHED __builtin_amdgcn_sched_barrier(0)
#define PG8_LOADROWS(dst, u) do { _Pragma("unroll") for (int h_ = 0; h_ < 2; ++h_) _Pragma("unroll") for (int i_ = 0; i_ < 2; ++i_) \
        { const int ri_ = h_ * HALF + (int)(voffA[i_] >> 16); dst[h_][i_] = (unsigned)((u).rows[ri_ < (u).nvalid ? ri_ : 0]) * (unsigned)(lda * 2) + (voffA[i_] & 0xffffu); } } while (0)
#define PG8_STAGE_A(bufoff, gbase, h, NEXT) do { if constexpr (GATHER) { PG8_STAGE(bufoff, gbase, ((NEXT) ? vn[h] : vc[h])); } else { PG8_STAGE(bufoff, (gbase) + (h) * hstepA, voffA); } } while (0)
    Unit cur, nxt; int ui = 0;
    if (!S.next(0, cur)) return;
    f32x4 acc[2][2][4][2];
#pragma unroll
    for (int a = 0; a < 2; ++a)
#pragma unroll
        for (int b = 0; b < 2; ++b)
#pragma unroll
            for (int m = 0; m < 4; ++m)
#pragma unroll
                for (int n = 0; n < 2; ++n) acc[a][b][m][n] = (f32x4){0.f, 0.f, 0.f, 0.f};
    bf16x8 At[4][2], B0[2][2], B1[2][2];
    unsigned vc[2][2], vn[2][2];
    if constexpr (GATHER) { PG8_LOADROWS(vc, cur);
#pragma unroll
        for (int h = 0; h < 2; ++h) { vn[h][0] = vc[h][0]; vn[h][1] = vc[h][1]; } }
    const char* cA = cur.A; const char* cB = cur.B;
    PG8_STAGE(PG8_SB(0, 0), cB, voffB); PG8_STAGE(PG8_SB(0, 1), cB + hstepB, voffB); PG8_STAGE_A(PG8_SA(0, 0), cA, 0, false); PG8_STAGE_A(PG8_SA(0, 1), cA, 1, false);
    if (wr == 1) PG8_BAR;
    PG8_WAIT_V(2); PG8_BAR;
    PG8_STAGE(PG8_SB(1, 0), cB + kstep, voffB); PG8_STAGE_A(PG8_SA(1, 0), cA + kstep, 0, false); PG8_STAGE(PG8_SB(1, 1), cB + hstepB + kstep, voffB);
    PG8_WAIT_V(6); PG8_BAR;
    for (;;) {
        const bool has_next = S.next(ui + 1, nxt);
        const char* nA = has_next ? nxt.A : cA; const char* nB = has_next ? nxt.B : cB;
        if constexpr (GATHER) { if (has_next) { PG8_LOADROWS(vn, nxt); } }
#pragma unroll 1
        for (int t = 0; t < nt; t += 2) {
            const bool last = (t == nt - 2);
            const char* a1 = cA + (size_t)(t + 1) * kstep;
            const char* a2 = last ? nA : cA + (size_t)(t + 2) * kstep; const char* b2 = last ? nB : cB + (size_t)(t + 2) * kstep;
            const char* a3 = a2 + kstep; const char* b3 = b2 + kstep;
            PG8_LDB(B0, 0, 0); PG8_LDB(B1, 0, 1); PG8_SCHED; PG8_LDA(At, 0, 0); PG8_STAGE_A(PG8_SA(1, 1), a1, 1, false);
            PG8_WAIT_V(8); PG8_WAIT_L(0); PG8_BAR; PG8_MMA(0, 0, At, B0); PG8_MMA(0, 1, At, B1); PG8_BAR; PG8_SCHED;
            PG8_LDA(At, 0, 1); PG8_STAGE(PG8_SB(0, 0), b2, voffB); PG8_STAGE(PG8_SB(0, 1), b2 + hstepB, voffB); PG8_STAGE_A(PG8_SA(0, 0), a2, 0, last);
            PG8_WAIT_V(8); PG8_WAIT_L(0); PG8_BAR; PG8_MMA(1, 0, At, B0); PG8_MMA(1, 1, At, B1); PG8_BAR; PG8_SCHED;
            PG8_LDB(B0, 1, 0); PG8_LDB(B1, 1, 1); PG8_SCHED; PG8_LDA(At, 1, 0); PG8_STAGE_A(PG8_SA(0, 1), a2, 1, last);
            PG8_WAIT_V(8); PG8_WAIT_L(0); PG8_BAR; PG8_MMA(0, 0, At, B0); PG8_MMA(0, 1, At, B1); PG8_BAR; PG8_SCHED;
            PG8_LDA(At, 1, 1); PG8_STAGE(PG8_SB(1, 0), b3, voffB); PG8_STAGE(PG8_SB(1, 1), b3 + hstepB, voffB); PG8_STAGE_A(PG8_SA(1, 0), a3, 0, last);
            PG8_WAIT_V(8); PG8_WAIT_L(0); PG8_BAR; PG8_MMA(1, 0, At, B0); PG8_MMA(1, 1, At, B1); PG8_BAR; PG8_SCHED;
        }
        if (wr == 0) PG8_BAR;
        { const int l2 = opq_tid() & 63; E(acc, cur, wr, wc, l2 & 15, l2 >> 4); }
        if (!has_next) break;
#pragma unroll
        for (int a = 0; a < 2; ++a)
#pragma unroll
            for (int b = 0; b < 2; ++b)
#pragma unroll
                for (int m = 0; m < 4; ++m)
#pragma unroll
                    for (int n = 0; n < 2; ++n) acc[a][b][m][n] = (f32x4){0.f, 0.f, 0.f, 0.f};
        cur = nxt; cA = nA; cB = nB; ++ui;
        if constexpr (GATHER) {
#pragma unroll
            for (int h = 0; h < 2; ++h) { vc[h][0] = vn[h][0]; vc[h][1] = vn[h][1]; } }
        if (wr == 1) PG8_BAR;
    }
    PG8_WAIT_V(0);
    PG8_BAR;
#undef PG8_STAGE_A
#undef PG8_SA
#undef PG8_SB
#undef PG8_STAGE
#undef PG8_LDA
#undef PG8_LDB
#undef PG8_MMA
#undef PG8_WAIT_V
#undef PG8_WAIT_L
#undef PG8_BAR
#undef PG8_SCHED
#undef PG8_LOADROWS
}
}

struct SchedDense {
    const char* A; const char* Bt; int nM, nN, G, c; size_t tstepA, tstepB; bool rev = false;
    DI void init(const void* A_, int lda, const void* Bt_, int K, int M, int N, int G_, int c_) { A = (const char*)A_; Bt = (const char*)Bt_; nM = M / 256; nN = N / 256; G = G_; c = c_; tstepA = (size_t)256 * lda * 2; tstepB = (size_t)256 * K * 2; }
    DI bool next(int i, pg8::Unit& u) const {
        const int L = i * G + c; if (L >= nM * nN) return false;
        const int nig = 8 * nN, gid = L / nig, fm = gid * 8, gsz = (nM - fm) < 8 ? (nM - fm) : 8, w = L - gid * nig;
        u.pm = fm + (w % gsz); if (rev) u.pm = nM - 1 - u.pm; u.pn = w / gsz; u.aux = 0; u.nvalid = 256; u.A = A + (size_t)u.pm * tstepA; u.B = Bt + (size_t)u.pn * tstepB; u.rows = nullptr; return true; }
};
struct SchedBranch {
    const char* A; const char* Bt; int nM, G, c;
    DI void init(const void* A_, const void* Bt_, int M, int G_, int c_) { A = (const char*)A_; Bt = (const char*)Bt_; nM = M / 256; G = G_; c = c_; }
    DI bool next(int i, pg8::Unit& u) const {
        const int L = i * G + c; if (L >= nM * 16) return false;
        u.pm = L >> 4; const int b = (L >> 2) & 3; u.pn = L & 3; u.aux = b; u.nvalid = 256;
        u.A = A + (size_t)u.pm * 256 * (D * 2) + b * 512; u.B = Bt + ((size_t)b * 1024 + u.pn * 256) * 512; u.rows = nullptr; return true; }
};
struct SchedMoe {
    bool rev = false; const char* A; const char* Bt; const int* rowtok; const int* off; const int* cnt; int nN, G, c, ntiles; size_t tstepA, estepB, tstepB; bool gather;
    DI bool next(int i, pg8::Unit& u) const {
        int rt, pn;
        if (G == 256) {
            const int v = i * 32 + (c >> 3), rl = v / nN; pn = v - rl * nN; rt = rl * 8 + (c & 7); if (rt >= ntiles) return false; }
        else { const int L = i * G + c; if (L >= ntiles * nN) return false; rt = L / nN; pn = L - rt * nN; }
        if (rev) rt = ntiles - 1 - rt;
        u.pm = rt; u.pn = pn; const int r0 = rt * 256; int e = 0;
#pragma unroll 1
        for (int k = 1; k < NE; ++k) e += (off[k] <= r0) ? 1 : 0;
        u.aux = e; u.A = gather ? A : A + (size_t)rt * tstepA; u.B = Bt + (size_t)e * estepB + (size_t)u.pn * tstepB;
        const int rin = r0 - off[e]; u.rows = rowtok + (size_t)e * T + rin; u.nvalid = cnt[e] - rin; return true; }
};

struct EpiStoreBf16 {
    static constexpr bool PERM = true;
    bf16* O; int ldc; int auxstride; const float* bias; int biasstride;
    DI void operator()(const pg8::f32x4 (&acc)[2][2][4][2], const pg8::Unit& u, int wr, int wc, int fr, int fq) const {
        const int row0 = u.pm * 256 + wr * 64 + fr, col0 = u.aux * auxstride + u.pn * 256 + wc * 32 + 8 * fq, bcol0 = u.pn * 256 + wc * 32 + 8 * fq;
        pg8::f32x4 bv[2][2];
#pragma unroll
        for (int bj = 0; bj < 2; ++bj)
#pragma unroll
            for (int n = 0; n < 2; ++n) bv[bj][n] = bias ? *(const pg8::f32x4*)(bias + (size_t)u.aux * biasstride + bcol0 + bj * 128 + 4 * n) : (pg8::f32x4){0.f, 0.f, 0.f, 0.f};
#pragma unroll
        for (int ai = 0; ai < 2; ++ai)
#pragma unroll
            for (int m = 0; m < 4; ++m) { bf16* rowp = O + (size_t)(row0 + ai * 128 + m * 16) * ldc + col0;
#pragma unroll
                for (int bj = 0; bj < 2; ++bj) { const pg8::f32x4 v0 = acc[ai][bj][m][0] + bv[bj][0], v1 = acc[ai][bj][m][1] + bv[bj][1];
                    pg8::u32x4 w; w.x = pg8::cvt_pk_bf16(v0[0], v0[1]); w.y = pg8::cvt_pk_bf16(v0[2], v0[3]); w.z = pg8::cvt_pk_bf16(v1[0], v1[1]); w.w = pg8::cvt_pk_bf16(v1[2], v1[3]);
                    *(pg8::u32x4*)(rowp + bj * 128) = w; } }
    }
};
DI float sigm_fast(float x) { return __builtin_amdgcn_rcpf(1.f + __builtin_amdgcn_exp2f(-LOG2E * x)); }
struct EpiMerge {
    static constexpr bool PERM = false;
    const bf16* YB; bf16* YM; const float* gb; const float* HS1; const float* GATES;
    DI void operator()(const pg8::f32x4 (&acc)[2][2][4][2], const pg8::Unit& u, int wr, int wc, int fr, int fq) const {
        const int row0 = u.pm * 256 + wr * 64 + fr, col = u.pn * 64 + wc * 16 + fq * 4;
        pg8::f32x4 bv[2][2];
#pragma unroll
        for (int bj = 0; bj < 2; ++bj)
#pragma unroll
            for (int n = 0; n < 2; ++n) bv[bj][n] = *(const pg8::f32x4*)(gb + (2 * bj + n) * 1024 + col);
#pragma unroll
        for (int ai = 0; ai < 2; ++ai)
#pragma unroll
            for (int m = 0; m < 4; ++m) { const size_t r = (size_t)(row0 + ai * 128 + m * 16); const float sa = HS1[r]; pg8::f32x4 y = (pg8::f32x4){0.f, 0.f, 0.f, 0.f};
#pragma unroll
                for (int bj = 0; bj < 2; ++bj)
#pragma unroll
                    for (int n = 0; n < 2; ++n) { const pg8::u32x2 yb = *(const pg8::u32x2*)(YB + r * 4096 + (2 * bj + n) * 1024 + col); const pg8::i32x4v iv = __builtin_bit_cast(pg8::i32x4v, acc[ai][bj][m][n]);
                        const pg8::f32x4 cs = *(const pg8::f32x4*)(GATES + u.pn * 256 + 128 * bj + 32 * wc + 16 * n + 4 * fq);
                        const pg8::f32x4 g = (pg8::f32x4){(float)iv[0] * sa * cs[0], (float)iv[1] * sa * cs[1], (float)iv[2] * sa * cs[2], (float)iv[3] * sa * cs[3]} + bv[bj][n];
                        y[0] += sigm_fast(g[0]) * __uint_as_float(yb.x << 16); y[1] += sigm_fast(g[1]) * __uint_as_float(yb.x & 0xffff0000u);
                        y[2] += sigm_fast(g[2]) * __uint_as_float(yb.y << 16); y[3] += sigm_fast(g[3]) * __uint_as_float(yb.y & 0xffff0000u); }
                pg8::u32x2 w; w.x = pg8::cvt_pk_bf16(y[0], y[1]); w.y = pg8::cvt_pk_bf16(y[2], y[3]); *(pg8::u32x2*)(YM + r * 1024 + col) = w; }
    }
};
struct EpiWo {
    static constexpr bool PERM = false;
    const float* xlat; const float* xctx; float* XF; const float* modg;
    DI void operator()(const pg8::f32x4 (&acc)[2][2][4][2], const pg8::Unit& u, int wr, int wc, int fr, int fq) const {
        const int row0 = u.pm * 256 + wr * 64 + fr, col0 = u.pn * 256 + wc * 32 + 4 * fq;
        const float* g = modg + (size_t)modidx(u.pm * 256) * 6144 + col0;
        pg8::f32x4 gv[2][2];
#pragma unroll
        for (int bj = 0; bj < 2; ++bj)
#pragma unroll
            for (int n = 0; n < 2; ++n) gv[bj][n] = *(const pg8::f32x4*)(g + bj * 128 + n * 16);
#pragma unroll
        for (int ai = 0; ai < 2; ++ai)
#pragma unroll
            for (int mp = 0; mp < 2; ++mp) { pg8::f32x4 t[2][2][2];
#pragma unroll
                for (int mm = 0; mm < 2; ++mm) { const int r = row0 + ai * 128 + (2 * mp + mm) * 16; const float* xs = (r < TL ? xlat + (size_t)r * D : xctx + (size_t)(r - TL) * D) + col0;
#pragma unroll
                    for (int bj = 0; bj < 2; ++bj)
#pragma unroll
                        for (int n = 0; n < 2; ++n) t[mm][bj][n] = *(const pg8::f32x4*)(xs + bj * 128 + n * 16); }
#pragma unroll
                for (int mm = 0; mm < 2; ++mm) { const int m = 2 * mp + mm; const int r = row0 + ai * 128 + m * 16; float* xo = XF + (size_t)r * D + col0;
#pragma unroll
                    for (int bj = 0; bj < 2; ++bj)
#pragma unroll
                        for (int n = 0; n < 2; ++n) *(pg8::f32x4*)(xo + bj * 128 + n * 16) = t[mm][bj][n] + gv[bj][n] * acc[ai][bj][m][n]; } }
    }
};
struct EpiProjFused {
    static constexpr bool PERM = true;
    bf16 *CU, *AQ, *DQ, *DK, *DV, *NQ, *NK, *NV, *KPE; float *QBD, *QBN; const float* ROPE;
    const float *cqg, *ckvg, *dqg, *dkg, *nqg, *nkg;
    float kbd, kbn, nbias; float* P;
    const float* HS1; const float* WINS;
    DI static float red4(float v, int lane) { v += lane_xor(v, lane, 16); v += lane_xor(v, lane, 32); return v; }
    DI static void st8(bf16* dst, const float (&x)[8]) { pg8::u32x4 w; w.x = pg8::cvt_pk_bf16(x[0], x[1]); w.y = pg8::cvt_pk_bf16(x[2], x[3]); w.z = pg8::cvt_pk_bf16(x[4], x[5]); w.w = pg8::cvt_pk_bf16(x[6], x[7]); *(pg8::u32x4*)dst = w; }
    DI void operator()(const pg8::f32x4 (&acc)[2][2][4][2], const pg8::Unit& u, int wr, int wc, int fr, int fq) const {
        const int t = u.pn, lane = fr + 16 * fq, row0 = u.pm * 256 + wr * 64 + fr; const bool lat = u.pm < TL / 256;
        float* SL = P + 2048;
        { const int te = (wr * 4 + wc) * 64 + lane; const float* src = te < 256 ? HS1 + u.pm * 256 + te : WINS + 256 * t + (te - 256); SL[te] = *src;
          asm volatile("s_waitcnt lgkmcnt(0)" ::: "memory"); __builtin_amdgcn_s_barrier(); asm volatile("" ::: "memory"); }
        const float* sap = SL + wr * 64 + fr; const float* sbp = SL + 256 + 32 * wc + 8 * fq;
#define GET8(ai, bj, m, x) do { const float sa_ = sap[(ai) * 128 + (m) * 16]; _Pragma("unroll") for (int n_ = 0; n_ < 2; ++n_) { const pg8::i32x4v iv_ = __builtin_bit_cast(pg8::i32x4v, acc[ai][bj][m][n_]); \
        const pg8::f32x4 sb_ = *(const pg8::f32x4*)(sbp + 128 * (bj) + 4 * n_); _Pragma("unroll") for (int j_ = 0; j_ < 4; ++j_) x[4 * n_ + j_] = (float)iv_[j_] * sa_ * sb_[j_]; } } while (0)
        if (t < 2) {
#pragma unroll
            for (int ai = 0; ai < 2; ++ai)
#pragma unroll
                for (int m = 0; m < 4; ++m) { float a[8], g[8], o[8]; GET8(ai, 0, m, a); GET8(ai, 1, m, g);
#pragma unroll
                    for (int i = 0; i < 8; ++i) o[i] = a[i] * sigm_fast(g[i]);
                    st8(CU + (size_t)(row0 + ai * 128 + m * 16) * 256 + 128 * t + 32 * wc + 8 * fq, o); }
        } else if (t < 5) {
#pragma unroll
            for (int bj = 0; bj < 2; ++bj) { const int ds = (t - 2) * 8 + bj * 4 + wc, head = ds / 6, kind = ds - head * 6;
                const bool isq = kind < 2, isv = kind >= 4; const float* gp = (isq ? dqg : dkg) + 8 * fq; float gg[8];
#pragma unroll
                for (int i = 0; i < 8; ++i) gg[i] = gp[i];
#pragma unroll
                for (int ai = 0; ai < 2; ++ai)
#pragma unroll
                    for (int m = 0; m < 4; ++m) { const int r = row0 + ai * 128 + m * 16; float x[8]; GET8(ai, bj, m, x);
                        if (isv) { st8(DV + (size_t)r * 256 + head * 64 + (kind - 4) * 32 + 8 * fq, x); continue; }
                        float ss = 0.f;
#pragma unroll
                        for (int i = 0; i < 8; ++i) ss += x[i] * x[i];
                        const float rs = rsqrtf(red4(ss, lane) * (1.f / 32.f) + EPS);
#pragma unroll
                        for (int i = 0; i < 8; ++i) x[i] = x[i] * rs * gg[i];
                        float pt[8];
#pragma unroll
                        for (int i = 0; i < 8; ++i) pt[i] = lane_xor(x[i], lane, 32);
                        if (lat) { const float* rp = ROPE + (size_t)(r & (SEQ - 1)) * 32 + 8 * (fq & 1); const bool first = fq < 2;
                            const pg8::f32x4 c0 = *(const pg8::f32x4*)rp, c1 = *(const pg8::f32x4*)(rp + 4), s0 = *(const pg8::f32x4*)(rp + 16), s1 = *(const pg8::f32x4*)(rp + 20);
#pragma unroll
                            for (int i = 0; i < 8; ++i) { const float cs = i < 4 ? c0[i & 3] : c1[i & 3], sn = i < 4 ? s0[i & 3] : s1[i & 3]; x[i] = first ? x[i] * cs - pt[i] * sn : x[i] * cs + pt[i] * sn; } }
                        if (isq) { float qn = 0.f;
#pragma unroll
                            for (int i = 0; i < 8; ++i) { x[i] *= 0.17677669529663687f * LOG2E; qn += x[i] * x[i]; }
                            qn = red4(qn, lane); if (fq == 0) QBD[(size_t)r * 8 + head * 2 + kind] = -(sqrtf(qn) * kbd + 0.05f); }
                        st8((isq ? DQ : DK) + (size_t)r * 256 + head * 64 + (kind & 1) * 32 + 8 * fq, x); } }
        } else if (t < 7) {
            const int pi = (t - 5) * 4 + wc, head = pi >> 1; const bool isq = (pi & 1) == 0; const float* gp = (isq ? nqg : nkg) + 8 * fq; float g0[8], g1[8];
#pragma unroll
            for (int i = 0; i < 8; ++i) { g0[i] = gp[i]; g1[i] = gp[32 + i]; }
#pragma unroll
            for (int ai = 0; ai < 2; ++ai)
#pragma unroll
                for (int m = 0; m < 4; ++m) { const int r = row0 + ai * 128 + m * 16; float x0[8], x1[8]; GET8(ai, 0, m, x0); GET8(ai, 1, m, x1); float ss = 0.f;
#pragma unroll
                    for (int i = 0; i < 8; ++i) ss += x0[i] * x0[i] + x1[i] * x1[i];
                    const float rs = rsqrtf(red4(ss, lane) * (1.f / 64.f) + EPS) * (isq ? 0.125f * LOG2E : 1.f); float qn = 0.f;
#pragma unroll
                    for (int i = 0; i < 8; ++i) { x0[i] = x0[i] * rs * g0[i]; x1[i] = x1[i] * rs * g1[i]; qn += x0[i] * x0[i] + x1[i] * x1[i]; }
                    if (isq) { qn = red4(qn, lane); if (fq == 0) QBN[(size_t)r * 4 + head] = -(sqrtf(qn) * kbn + nbias); }
                    bf16* dst = (isq ? NQ : NK) + (size_t)r * 256 + head * 64 + 8 * fq; st8(dst, x0); st8(dst + 32, x1); }
        } else if (t == 7) {
#pragma unroll
            for (int bj = 0; bj < 2; ++bj) { const int sl = bj * 4 + wc, head = sl >> 1, half = sl & 1;
#pragma unroll
                for (int ai = 0; ai < 2; ++ai)
#pragma unroll
                    for (int m = 0; m < 4; ++m) { float x[8]; GET8(ai, bj, m, x); st8(NV + (size_t)(row0 + ai * 128 + m * 16) * 256 + head * 64 + half * 32 + 8 * fq, x); } }
        } else {
            const int nsl = t == 8 ? 6 : 4;
#pragma unroll
            for (int bj = 0; bj < 2; ++bj) { const int sl = bj * 4 + wc;
#pragma unroll
                for (int ai = 0; ai < 2; ++ai)
#pragma unroll
                    for (int m = 0; m < 4; ++m) { float x[8]; GET8(ai, bj, m, x); float ss = 0.f;
#pragma unroll
                        for (int i = 0; i < 8; ++i) ss += x[i] * x[i];
                        ss = red4(ss, lane); if (fq == 0) P[(ai * 128 + wr * 64 + m * 16 + fr) * 8 + sl] = sl < nsl ? ss : 0.f; } }
            asm volatile("s_waitcnt lgkmcnt(0)" ::: "memory"); __builtin_amdgcn_s_barrier(); asm volatile("" ::: "memory");
#pragma unroll
            for (int bj = 0; bj < 2; ++bj) { const int sl = bj * 4 + wc; const float* gp = (t == 8 ? cqg : ckvg) + 32 * (sl < nsl ? sl : 0) + 8 * fq; float gg[8];
#pragma unroll
                for (int i = 0; i < 8; ++i) gg[i] = gp[i];
#pragma unroll
                for (int ai = 0; ai < 2; ++ai)
#pragma unroll
                    for (int m = 0; m < 4; ++m) { const int rl = ai * 128 + wr * 64 + m * 16 + fr, r = u.pm * 256 + rl; float x[8]; GET8(ai, bj, m, x);
                        const pg8::f32x4 p0 = *(const pg8::f32x4*)(P + rl * 8), p1 = *(const pg8::f32x4*)(P + rl * 8 + 4);
                        const float tot = (p0[0] + p0[1]) + (p0[2] + p0[3]) + (p1[0] + p1[1]) + (p1[2] + p1[3]);
                        const float rs = rsqrtf(tot * (t == 8 ? 1.f / 192.f : 1.f / 128.f) + EPS);
                        if (sl < nsl) {
#pragma unroll
                            for (int i = 0; i < 8; ++i) x[i] = x[i] * rs * gg[i];
                            st8(AQ + (size_t)r * 384 + (t == 8 ? 0 : 192) + 32 * sl + 8 * fq, x); }
                        else if (t == 8 && sl == 6) st8(KPE + (size_t)r * 32 + 8 * fq, x);
                        else if (t == 9 && sl < 6) {
#pragma unroll
                            for (int i = 0; i < 8; ++i) x[i] = 0.f;
                            st8(AQ + (size_t)r * 384 + 320 + 32 * (sl - 4) + 8 * fq, x); } } }
            asm volatile("s_waitcnt lgkmcnt(0)" ::: "memory"); __builtin_amdgcn_s_barrier(); asm volatile("" ::: "memory");
        }
#undef GET8
    }
};
struct EpiQkvFused {
    static constexpr bool PERM = true;
    bf16 *MQ, *MK, *MV; const bf16* KPE; float* QBM; const float* ROPE; const float *gq, *gk; float nbconst; float* P;
    DI static float red4(float v, int lane) { v += lane_xor(v, lane, 16); v += lane_xor(v, lane, 32); return v; }
    DI static void st8(bf16* dst, const float (&x)[8]) { pg8::u32x4 w; w.x = pg8::cvt_pk_bf16(x[0], x[1]); w.y = pg8::cvt_pk_bf16(x[2], x[3]); w.z = pg8::cvt_pk_bf16(x[4], x[5]); w.w = pg8::cvt_pk_bf16(x[6], x[7]); *(pg8::u32x4*)dst = w; }
    DI void rope8(float (&x)[8], int r, int fq, int lane) const {
        float pt[8];
#pragma unroll
        for (int i = 0; i < 8; ++i) pt[i] = lane_xor(x[i], lane, 32);
        const float* rp = ROPE + (size_t)(r & (SEQ - 1)) * 32 + 8 * (fq & 1); const bool first = fq < 2;
        const pg8::f32x4 c0 = *(const pg8::f32x4*)rp, c1 = *(const pg8::f32x4*)(rp + 4), s0 = *(const pg8::f32x4*)(rp + 16), s1 = *(const pg8::f32x4*)(rp + 20);
#pragma unroll
        for (int i = 0; i < 8; ++i) { const float cs = i < 4 ? c0[i & 3] : c1[i & 3], sn = i < 4 ? s0[i & 3] : s1[i & 3]; x[i] = first ? x[i] * cs - pt[i] * sn : x[i] * cs + pt[i] * sn; }
    }
    DI void operator()(const pg8::f32x4 (&acc)[2][2][4][2], const pg8::Unit& u, int wr, int wc, int fr, int fq) const {
        const int t = u.pn, lane = fr + 16 * fq, row0 = u.pm * 256 + wr * 64 + fr; const bool lat = u.pm < TL / 256;
#define GET8(ai, bj, m, x) do { _Pragma("unroll") for (int n_ = 0; n_ < 2; ++n_) _Pragma("unroll") for (int j_ = 0; j_ < 4; ++j_) x[4 * n_ + j_] = acc[ai][bj][m][n_][j_]; } while (0)
        if (t < 2) {
#pragma unroll
            for (int bj = 0; bj < 2; ++bj)
#pragma unroll
                for (int ai = 0; ai < 2; ++ai)
#pragma unroll
                    for (int m = 0; m < 4; ++m) { float x[8]; GET8(ai, bj, m, x); float ss = 0.f;
#pragma unroll
                        for (int i = 0; i < 8; ++i) ss += x[i] * x[i];
                        ss = red4(ss, lane); if (fq == 0) P[(ai * 128 + wr * 64 + m * 16 + fr) * 8 + bj * 4 + wc] = wc < 3 ? ss : 0.f; }
            asm volatile("s_waitcnt lgkmcnt(0)" ::: "memory"); __builtin_amdgcn_s_barrier(); asm volatile("" ::: "memory");
            if (wc < 3) {
#pragma unroll
                for (int bj = 0; bj < 2; ++bj) { const int head = 2 * t + bj; const float* gp = gq + 32 * wc + 8 * fq; asm volatile("" : "+v"(gp)); float gg[8];
#pragma unroll
                    for (int i = 0; i < 8; ++i) gg[i] = gp[i];
#pragma unroll
                    for (int ai = 0; ai < 2; ++ai)
#pragma unroll
                        for (int m = 0; m < 4; ++m) { const int rl = ai * 128 + wr * 64 + m * 16 + fr, r = u.pm * 256 + rl; float x[8]; GET8(ai, bj, m, x);
                            const pg8::f32x4 pp = *(const pg8::f32x4*)(P + rl * 8 + bj * 4);
                            const float rs = rsqrtf((pp[0] + pp[1] + pp[2]) * (1.f / 96.f) + EPS);
#pragma unroll
                            for (int i = 0; i < 8; ++i) x[i] = x[i] * rs * gg[i];
                            if (wc == 2 && lat) rope8(x, r, fq, lane);
#pragma unroll
                            for (int i = 0; i < 8; ++i) x[i] *= 0.10206207261596577f * LOG2E;
                            st8(MQ + (size_t)r * 384 + head * 96 + 32 * wc + 8 * fq, x);
                            if (wc == 0 && fq == 0) QBM[(size_t)r * 4 + head] = nbconst; } }
            }
            asm volatile("s_waitcnt lgkmcnt(0)" ::: "memory"); __builtin_amdgcn_s_barrier(); asm volatile("" ::: "memory");
        } else if (wc < 2) {
            const int head = 2 * (t - 2) + wc;
#pragma unroll
            for (int ai = 0; ai < 2; ++ai)
#pragma unroll
                for (int m = 0; m < 4; ++m) { const int r = row0 + ai * 128 + m * 16; float xp[8];
                    { const uint4 kq = *(const uint4*)(KPE + (size_t)r * 32 + 8 * fq); const unsigned w[4] = {kq.x, kq.y, kq.z, kq.w};
#pragma unroll
                      for (int i = 0; i < 4; ++i) { xp[2 * i] = __uint_as_float(w[i] << 16); xp[2 * i + 1] = __uint_as_float(w[i] & 0xffff0000u); } }
                    float ss = 0.f;
#pragma unroll
                    for (int n = 0; n < 2; ++n)
#pragma unroll
                        for (int j = 0; j < 4; ++j) ss += acc[ai][0][m][n][j] * acc[ai][0][m][n][j] + acc[ai][1][m][n][j] * acc[ai][1][m][n][j] + xp[4 * n + j] * xp[4 * n + j];
                    const float rs = rsqrtf(red4(ss, lane) * (1.f / 96.f) + EPS);
                    const float* gp = gk + 8 * fq; asm volatile("" : "+v"(gp));
                    bf16* dst = MK + (size_t)r * 384 + head * 96 + 8 * fq;
#pragma unroll
                    for (int bj = 0; bj < 2; ++bj) { float x[8]; GET8(ai, bj, m, x);
#pragma unroll
                        for (int i = 0; i < 8; ++i) x[i] = x[i] * rs * gp[32 * bj + i];
                        st8(dst + 32 * bj, x); }
#pragma unroll
                    for (int i = 0; i < 8; ++i) xp[i] = xp[i] * rs * gp[64 + i];
                    if (lat) rope8(xp, r, fq, lane);
                    st8(dst + 64, xp); }
        } else {
            const int head = 2 * (t - 2) + wc - 2;
#pragma unroll
            for (int bj = 0; bj < 2; ++bj)
#pragma unroll
                for (int ai = 0; ai < 2; ++ai)
#pragma unroll
                    for (int m = 0; m < 4; ++m) { float x[8]; GET8(ai, bj, m, x); st8(MV + (size_t)(row0 + ai * 128 + m * 16) * 256 + head * 64 + 32 * bj + 8 * fq, x); }
        }
#undef GET8
    }
};
struct EpiMoeActI8 {
    static constexpr bool PERM = true;
    bf16* ACT; const float* bgu; const float* HS; const float* WGUS;
    DI void operator()(const pg8::f32x4 (&acc)[2][2][4][2], const pg8::Unit& u, int wr, int wc, int fr, int fq) const {
        const int rl0 = wr * 64 + fr, row0 = u.pm * 256 + rl0, col0 = u.pn * 128 + wc * 32 + 8 * fq;
        const float* b = bgu + (size_t)u.aux * 2048 + col0;
        const pg8::f32x4 bg0 = *(const pg8::f32x4*)(b), bg1 = *(const pg8::f32x4*)(b + 4), bu0 = *(const pg8::f32x4*)(b + 1024), bu1 = *(const pg8::f32x4*)(b + 1028);
        const float* cs = WGUS + (size_t)u.aux * 2048 + u.pn * 256 + wc * 32 + 8 * fq;
        const pg8::f32x4 sg0 = *(const pg8::f32x4*)(cs), sg1 = *(const pg8::f32x4*)(cs + 4), su0 = *(const pg8::f32x4*)(cs + 128), su1 = *(const pg8::f32x4*)(cs + 132);
        int tk[2][4]; float sas[2][4];
#pragma unroll
        for (int ai = 0; ai < 2; ++ai)
#pragma unroll
            for (int m = 0; m < 4; ++m) { const int rl = rl0 + ai * 128 + m * 16; tk[ai][m] = u.rows[rl < u.nvalid ? rl : 0]; }
#pragma unroll
        for (int ai = 0; ai < 2; ++ai)
#pragma unroll
            for (int m = 0; m < 4; ++m) sas[ai][m] = HS[tk[ai][m]];
#pragma unroll
        for (int ai = 0; ai < 2; ++ai)
#pragma unroll
            for (int m = 0; m < 4; ++m) { const float sa = sas[ai][m]; float a[8];
#pragma unroll
                for (int n = 0; n < 2; ++n) { const pg8::i32x4v ig = __builtin_bit_cast(pg8::i32x4v, acc[ai][0][m][n]), iu = __builtin_bit_cast(pg8::i32x4v, acc[ai][1][m][n]);
#pragma unroll
                    for (int j = 0; j < 4; ++j) { const float gg = (float)ig[j] * sa * (n ? sg1[j] : sg0[j]) + (n ? bg1[j] : bg0[j]), uu = (float)iu[j] * sa * (n ? su1[j] : su0[j]) + (n ? bu1[j] : bu0[j]);
                        const float g = fminf(gg, 7.f), uc = fminf(fmaxf(uu, -7.f), 7.f); a[4 * n + j] = (uc + 1.f) * (g * sigm_fast(1.702f * g)); } }
                pg8::u32x4 w; w.x = pg8::cvt_pk_bf16(a[0], a[1]); w.y = pg8::cvt_pk_bf16(a[2], a[3]); w.z = pg8::cvt_pk_bf16(a[4], a[5]); w.w = pg8::cvt_pk_bf16(a[6], a[7]);
                *(pg8::u32x4*)(ACT + (size_t)(row0 + ai * 128 + m * 16) * D + col0) = w; }
    }
};
struct EpiMoeAct {
    static constexpr bool PERM = true;
    bf16* ACT; const float* bgu;
    DI void operator()(const pg8::f32x4 (&acc)[2][2][4][2], const pg8::Unit& u, int wr, int wc, int fr, int fq) const {
        const int row0 = u.pm * 256 + wr * 64 + fr, col0 = u.pn * 128 + wc * 32 + 8 * fq;
        const float* b = bgu + (size_t)u.aux * 2048 + col0;
        const pg8::f32x4 bg0 = *(const pg8::f32x4*)(b), bg1 = *(const pg8::f32x4*)(b + 4), bu0 = *(const pg8::f32x4*)(b + 1024), bu1 = *(const pg8::f32x4*)(b + 1028);
#pragma unroll
        for (int ai = 0; ai < 2; ++ai)
#pragma unroll
            for (int m = 0; m < 4; ++m) { float a[8];
#pragma unroll
                for (int n = 0; n < 2; ++n) { const pg8::f32x4 gg = acc[ai][0][m][n] + (n ? bg1 : bg0), uu = acc[ai][1][m][n] + (n ? bu1 : bu0);
#pragma unroll
                    for (int j = 0; j < 4; ++j) { const float g = fminf(gg[j], 7.f), uc = fminf(fmaxf(uu[j], -7.f), 7.f); a[4 * n + j] = (uc + 1.f) * (g * sigm_fast(1.702f * g)); } }
                pg8::u32x4 w; w.x = pg8::cvt_pk_bf16(a[0], a[1]); w.y = pg8::cvt_pk_bf16(a[2], a[3]); w.z = pg8::cvt_pk_bf16(a[4], a[5]); w.w = pg8::cvt_pk_bf16(a[6], a[7]);
                *(pg8::u32x4*)(ACT + (size_t)(row0 + ai * 128 + m * 16) * D + col0) = w; }
    }
};

struct MapId { int off; DI int operator()(int n) const { return n + off; } };
struct MapProj { DI int operator()(int s) const {
    int t, slot;
    if (s < 512) { const int isg = s >> 8, ch = s & 255; t = ch >> 7; slot = isg * 4 + ((ch >> 5) & 3); }
    else if (s < OFF_C) { const int m = s - OFF_B; if (m < 192) { t = 8; slot = m >> 5; } else if (m < 320) { t = 9; slot = (m - 192) >> 5; } else { t = 8; slot = 6; } }
    else if (s < OFF_D) { const int m = s - OFF_C, head = m / 192, w = m - head * 192, ds = head * 6 + (w >> 5); t = 2 + (ds >> 3); slot = ds & 7; }
    else { const int m = s - OFF_D, head = m / 192, w = m - head * 192;
      if (w < 128) { const int pi = head * 2 + (w >> 6); t = 5 + (pi >> 2); slot = ((w >> 5) & 1) * 4 + (pi & 3); } else { t = 7; slot = head * 2 + ((w - 128) >> 5); } }
    return 256 * t + (slot >> 2) * 128 + (slot & 3) * 32 + (s & 31); } };
struct MapQ  { DI int operator()(int s) const { const int head = s / 96, w = s - head * 96; return 256 * (head >> 1) + 128 * (head & 1) + 32 * (w >> 5) + (s & 31); } };
struct MapKV { DI int operator()(int s) const { const int head = s >> 7, w = s & 127, isv = w >> 6, half = (w >> 5) & 1; return 256 * (2 + (head >> 1)) + 128 * half + 32 * (2 * isv + (head & 1)) + (s & 31); } };
struct MapGate { DI int operator()(int s) const { const int b = s >> 10, w = s & 1023, pn = w >> 6, lc = w & 63; return 256 * pn + 128 * (b >> 1) + 32 * (lc >> 4) + 16 * (b & 1) + (lc & 15); } };
struct MapGu { DI int operator()(int s) const { const int isu = s >> 10, c = s & 1023; return 256 * (c >> 7) + 128 * isu + (c & 127); } };
struct CvtItem { const float* W; bf16* WT; int N, ldk, kdst0, mapt, mapoff, item; };
DI CvtItem cvt_decode(PRef p, int it) {
    constexpr int I_WIN_ = (D / 64) * (INW / 32), I_UQ_ = 3 * 12, I_UKV_ = 2 * 16, I_BR_ = 4 * 32, I_GATE_ = 16 * 128, I_WO_ = 16 * 32, I_GU_ = 16 * 64, I_DN_ = 16 * 32;
    constexpr int PER_L = I_UQ_ + I_UKV_ + 4 * I_BR_ + I_WO_ + NE * I_DN_;
    unsigned char* ws = p.ws; CvtItem c; (void)I_WIN_; (void)I_GATE_; c.mapt = 0; c.mapoff = 0; c.kdst0 = 0;
    const int l = it / PER_L; int r = it - l * PER_L;
    if (r < I_UQ_) { c.W = p.in[I_WUQ] + (size_t)l * 192 * 384; c.N = 384; c.WT = (bf16*)(ws + WS_QKV_T) + (size_t)l * 1024 * 384; c.ldk = 384; c.mapt = 4; c.item = r; return c; } r -= I_UQ_;
    if (r < I_UKV_) { c.W = p.in[I_WUKV] + (size_t)l * 128 * 512; c.N = 512; c.WT = (bf16*)(ws + WS_QKV_T) + (size_t)l * 1024 * 384; c.ldk = 384; c.kdst0 = 192; c.mapt = 5; c.item = r; return c; } r -= I_UKV_;
    if (r < 4 * I_BR_) { const int b = r / I_BR_; c.W = (b == 0 ? p.in[I_CONVOUT] : b == 1 ? p.in[I_MLAOUT] : b == 2 ? p.in[I_DIFFOUT] : p.in[I_NAOUT]) + (size_t)l * 256 * D; c.N = D;
        c.WT = (bf16*)(ws + WS_WB_T) + ((size_t)l * 4 + b) * 1024 * 256; c.ldk = 256; c.item = r - b * I_BR_; return c; } r -= 4 * I_BR_;
    if (r < I_WO_) { c.W = p.in[I_WO] + (size_t)l * D * D; c.N = D; c.WT = (bf16*)(ws + WS_WO_T) + (size_t)l * D * D; c.ldk = D; c.item = r; return c; } r -= I_WO_;
    const int e = r / I_DN_; r -= e * I_DN_; (void)I_GU_;
    c.W = p.in[I_WDN] + ((size_t)l * NE + e) * DFF * D; c.N = D; c.WT = (bf16*)(ws + WS_WDN_T) + ((size_t)l * NE + e) * D * DFF; c.ldk = DFF; c.item = r; return c;
}
DI void cvt_load(const CvtItem& c, float (&v)[32], int lane) {
    const int nblk = c.N / 32, kb = c.item / nblk, nb = c.item - kb * nblk;
    const float* src = c.W + (size_t)(64 * kb + (lane >> 5)) * c.N + 32 * nb + (lane & 31);
#pragma unroll
    for (int i = 0; i < 32; ++i) v[i] = src[(size_t)(2 * i) * c.N];
}
DI void cvt_store(const CvtItem& c, const float (&v)[32], float* scr, int lane) {
    const int nblk = c.N / 32, kb = c.item / nblk, nb = c.item - kb * nblk, k0 = 64 * kb, n0 = 32 * nb;
#pragma unroll
    for (int i = 0; i < 32; ++i) scr[(2 * i + (lane >> 5)) * 33 + (lane & 31)] = v[i];
    asm volatile("s_waitcnt lgkmcnt(0)" ::: "memory");
    const int cc = lane & 7;
#pragma unroll
    for (int j = 0; j < 4; ++j) { const int n = (lane >> 3) + 8 * j; const float* s = scr + (8 * cc) * 33 + n;
        pg8::u32x4 o; o.x = pg8::cvt_pk_bf16(s[0 * 33], s[1 * 33]); o.y = pg8::cvt_pk_bf16(s[2 * 33], s[3 * 33]); o.z = pg8::cvt_pk_bf16(s[4 * 33], s[5 * 33]); o.w = pg8::cvt_pk_bf16(s[6 * 33], s[7 * 33]);
        const int sn = n0 + n; const int row = c.mapt == 0 ? sn + c.mapoff : (c.mapt == 1 ? MapGate()(sn) : (c.mapt == 2 ? MapGu()(sn) : (c.mapt == 3 ? MapProj()(sn) : (c.mapt == 4 ? MapQ()(sn) : MapKV()(sn)))));
        *(pg8::u32x4*)(c.WT + (size_t)row * c.ldk + c.kdst0 + k0 + 8 * cc) = o; }
    asm volatile("s_waitcnt lgkmcnt(0)" ::: "memory");
}
DI void ph_convert(PRef p, unsigned char* lds) {
    const int tid_ = opq_tid(); const int bid_ = opq_bid(), nblk_ = opq_nblk(); const int lane = tid_ & 63, wave = __builtin_amdgcn_readfirstlane(tid_ >> 6);
    float* scr = (float*)(lds + wave * 8704);
    const int gw = bid_ * 8 + wave, ngw = nblk_ * 8;
    constexpr int PER_L = 3 * 12 + 2 * 16 + 4 * 4 * 32 + 16 * 32 + NE * (16 * 32);
    const int total = 2 * PER_L;
    float va[32], vb[32];
    int it = gw;
    CvtItem ca, cb;
    if (it < total) { ca = cvt_decode(p, it); cvt_load(ca, va, lane); }
    for (; it < total; it += 2 * ngw) {
        const int i1 = it + ngw, i2 = it + 2 * ngw;
        if (i1 < total) { cb = cvt_decode(p, i1); cvt_load(cb, vb, lane); }
        cvt_store(ca, va, scr, lane);
        if (i2 < total) { ca = cvt_decode(p, i2); cvt_load(ca, va, lane); }
        if (i1 < total) cvt_store(cb, vb, scr, lane);
    }
    __syncthreads();
    { float* red = (float*)lds;
      const int n = tid_ & 31, kg = tid_ >> 5; signed char* W8 = (signed char*)(p.ws + WS_WGU_T); float* WS_ = (float*)(p.ws + WS_WGUS);
      float xa[64], xb[64];
#define I8_DECODE(it, src_, N_, dst_, sca_, kind_, nb_) const float* src_; int N_, kind_, nb_; signed char* dst_; float* sca_; \
        if ((it) < 4096) { const int le_ = (it) >> 6; nb_ = (it) & 63; src_ = p.in[I_WGU] + (size_t)le_ * D * 2048; N_ = 2048; dst_ = W8 + (size_t)le_ * 2048 * D * 2; sca_ = WS_ + (size_t)le_ * 2048; kind_ = 0; } \
        else if ((it) < 4096 + 150) { const int l_ = ((it) - 4096) / 75; nb_ = ((it) - 4096) - l_ * 75; src_ = p.in[I_WIN] + (size_t)l_ * D * INW; N_ = INW; dst_ = (signed char*)(p.ws + WS_WIN_T) + (size_t)l_ * PLD * D * 2; sca_ = (float*)(p.ws + WS_WINS) + l_ * PLD; kind_ = 1; } \
        else { const int l_ = ((it) - 4246) >> 7; nb_ = ((it) - 4246) & 127; src_ = p.in[I_GATEW] + (size_t)l_ * D * 4096; N_ = 4096; dst_ = (signed char*)(p.ws + WS_GATE_T) + (size_t)l_ * 4096 * D * 2; sca_ = (float*)(p.ws + WS_GATES) + l_ * 4096; kind_ = 2; }
#define GU_LOAD(dst, it) do { I8_DECODE(it, src_, N_, d8_, sc8_, kind_, nb_); (void)d8_; (void)sc8_; (void)kind_; const float* s2_ = src_ + (size_t)(64 * kg) * N_ + 32 * nb_ + n; \
        _Pragma("unroll") for (int i = 0; i < 64; ++i) dst[i] = s2_[(size_t)i * N_]; } while (0)
#define GU_EMIT(src, it) do { I8_DECODE(it, src_, N_, d8_, sc8_, kind_, nb_); (void)src_; float m_ = 0.f; _Pragma("unroll") for (int i = 0; i < 64; ++i) m_ = fmaxf(m_, fabsf(src[i])); \
        red[kg * 32 + n] = m_; __syncthreads(); \
        if (tid_ < 32) { float mm_ = 0.f; _Pragma("unroll") for (int g = 0; g < 16; ++g) mm_ = fmaxf(mm_, red[g * 32 + tid_]); red[512 + tid_] = mm_ > 0.f ? mm_ * (1.f / 127.f) : 1.f; } \
        __syncthreads(); const float sc_ = red[512 + n], inv_ = 1.f / sc_; const int col_ = 32 * nb_ + n; const int row_ = kind_ == 0 ? MapGu()(col_) : (kind_ == 1 ? MapProj()(col_) : MapGate()(col_)); \
        if (kg == 0) sc8_[row_] = sc_; \
        signed char* dst_ = d8_ + (size_t)row_ * D + 64 * kg; \
        _Pragma("unroll") for (int q = 0; q < 4; ++q) { unsigned w_[4]; _Pragma("unroll") for (int d = 0; d < 4; ++d) { unsigned b_ = 0; _Pragma("unroll") for (int i = 0; i < 4; ++i) { \
            const int v_ = (int)rintf(src[16 * q + 4 * d + i] * inv_); b_ |= ((unsigned)v_ & 255u) << (8 * i); } w_[d] = b_; } \
            *(uint4*)(dst_ + 16 * q) = make_uint4(w_[0], w_[1], w_[2], w_[3]); } \
        __syncthreads(); } while (0)
      const int nit = 2 * NE * 64 + 150 + 256; int it2 = bid_;
      if (it2 < nit) GU_LOAD(xa, it2);
      for (; it2 < nit; it2 += 2 * nblk_) { const int j1 = it2 + nblk_, j2 = it2 + 2 * nblk_;
        if (j1 < nit) GU_LOAD(xb, j1);
        GU_EMIT(xa, it2);
        if (j2 < nit) GU_LOAD(xa, j2);
        if (j1 < nit) GU_EMIT(xb, j1); }
#undef GU_LOAD
#undef GU_EMIT
#undef I8_DECODE
    }
}

#define LDSP ((PG8_LAS unsigned char*)lds)
DI void ph_proj_fast(PRef p, int l, unsigned char* lds) {
    const int bid_ = opq_bid(), nblk_ = opq_nblk(); const int tid0 = opq_tid(), lane0 = tid0 & 63;
    SchedDense S; S.init(p.ws + WS_H, D / 2, (const bf16*)(p.ws + WS_WIN_T) + (size_t)l * PLD * D, D / 2, T, PLD, nblk_, bid_);
    EpiProjFused E;
    E.CU = (bf16*)(p.ws + WS_CU); E.AQ = (bf16*)(p.ws + WS_AQ); E.DQ = (bf16*)(p.ws + WS_DQ); E.DK = (bf16*)(p.ws + WS_DK); E.DV = (bf16*)(p.ws + WS_DV);
    E.NQ = (bf16*)(p.ws + WS_NQ); E.NK = (bf16*)(p.ws + WS_NK); E.NV = (bf16*)(p.ws + WS_NV); E.KPE = (bf16*)(p.ws + WS_KPE);
    E.QBD = (float*)(p.ws + WS_QBD); E.QBN = (float*)(p.ws + WS_QBN); E.ROPE = (const float*)(p.ws + WS_ROPE);
    E.cqg = p.in[I_CQG] + l * 192; E.ckvg = p.in[I_CKVG] + l * 128; E.dqg = p.in[I_DQNG] + l * 32; E.dkg = p.in[I_DKNG] + l * 32; E.nqg = p.in[I_NQNG] + l * 64; E.nkg = p.in[I_NKNG] + l * 64;
    { float m = lane0 < 32 ? fabsf(p.in[I_DKNG][l * 32 + lane0]) : 0.f;
#pragma unroll
      for (int o = 1; o < 64; o <<= 1) m = fmaxf(m, lane_xor(m, lane0, o));
      float m2 = fabsf(p.in[I_NKNG][l * 64 + lane0]);
#pragma unroll
      for (int o = 1; o < 64; o <<= 1) m2 = fmaxf(m2, lane_xor(m2, lane0, o));
      float t0 = 5.656854249f * 1.004f * m, t1 = 8.f * 1.004f * m2, t2 = __int_as_float(((const int*)(p.ws + WS_CTL))[CW_BIASMAX + l]) * LOG2E + 0.05f;
      asm volatile("" : "+v"(t0), "+v"(t1), "+v"(t2));
      const int b0 = __builtin_amdgcn_readfirstlane(__float_as_int(t0)), b1 = __builtin_amdgcn_readfirstlane(__float_as_int(t1)), b2 = __builtin_amdgcn_readfirstlane(__float_as_int(t2));
      E.kbd = __int_as_float(b0); E.kbn = __int_as_float(b1); E.nbias = __int_as_float(b2); }
    E.P = (float*)(lds + 131072 + 4096); E.HS1 = (const float*)(p.ws + WS_HS1); E.WINS = (const float*)(p.ws + WS_WINS) + l * PLD;
    pg8::gemm_phase<EpiProjFused, SchedDense, false, true>(LDSP, D, D, S, E);
}
DI void ph_qkvraw_fast(PRef p, int l, unsigned char* lds) {
    const int bid_ = opq_bid(), nblk_ = opq_nblk(); const int lane0 = opq_tid() & 63;
    SchedDense S; S.init(p.ws + WS_AQ, 384, (const bf16*)(p.ws + WS_QKV_T) + (size_t)l * 1024 * 384, 384, T, 1024, nblk_, bid_);
    EpiQkvFused E; E.MQ = (bf16*)(p.ws + WS_MQ); E.MK = (bf16*)(p.ws + WS_MK); E.MV = (bf16*)(p.ws + WS_MV); E.KPE = (const bf16*)(p.ws + WS_KPE); E.QBM = (float*)(p.ws + WS_QBM);
    E.ROPE = (const float*)(p.ws + WS_ROPE); E.gq = p.in[I_QNG] + l * 96; E.gk = p.in[I_KNG] + l * 96; E.P = (float*)(lds + 131072 + 4096);
    { float mq = 0.f, mk = 0.f;
      for (int i = lane0; i < 96; i += 64) { mq = fmaxf(mq, fabsf(E.gq[i])); mk = fmaxf(mk, fabsf(E.gk[i])); }
#pragma unroll
      for (int o = 1; o < 64; o <<= 1) { mq = fmaxf(mq, lane_xor(mq, lane0, o)); mk = fmaxf(mk, lane_xor(mk, lane0, o)); }
      E.nbconst = __int_as_float(__builtin_amdgcn_readfirstlane(__float_as_int(-(96.f * 0.10206207261596577f * LOG2E * mq * mk * 1.004f + 0.05f)))); }
    pg8::gemm_phase<EpiQkvFused, SchedDense, false>(LDSP, 384, 384, S, E);
}
DI void ph_branch_fast(PRef p, int l, int nrows, unsigned char* lds) {
    const int bid_ = opq_bid(), nblk_ = opq_nblk();
    SchedBranch S; S.init(p.ws + WS_BI, (const bf16*)(p.ws + WS_WB_T) + (size_t)l * 4 * 1024 * 256, nrows, nblk_, bid_);
    EpiStoreBf16 E{(bf16*)(p.ws + WS_YB), 4096, 1024, nullptr, 0};
    pg8::gemm_phase<EpiStoreBf16, SchedBranch, false>(LDSP, D, 256, S, E);
}
DI void ph_merge_fast(PRef p, int l, int nrows, unsigned char* lds) {
    const int bid_ = opq_bid(), nblk_ = opq_nblk();
    SchedDense S; S.init(p.ws + WS_H, D / 2, (const bf16*)(p.ws + WS_GATE_T) + (size_t)l * 4096 * D, D / 2, nrows, 4096, nblk_, bid_);
    S.rev = true;
    EpiMerge E{(const bf16*)(p.ws + WS_YB), (bf16*)(p.ws + WS_YM), p.in[I_GATEB] + l * 4096, (const float*)(p.ws + WS_HS1), (const float*)(p.ws + WS_GATES) + l * 4096};
    pg8::gemm_phase<EpiMerge, SchedDense, false, true>(LDSP, D, D, S, E);
}
DI void ph_wo_fast(PRef p, int l, int nrows, unsigned char* lds) {
    const int bid_ = opq_bid(), nblk_ = opq_nblk();
    SchedDense S; S.init(p.ws + WS_YM, D, (const bf16*)(p.ws + WS_WO_T) + (size_t)l * D * D, D, nrows, D, nblk_, bid_);
    const float* XFc = (const float*)(p.ws + WS_XF);
    EpiWo E{l == 0 ? p.in[I_X] : XFc, l == 0 ? p.in[I_CTX] : XFc + (size_t)TL * D, (float*)(p.ws + WS_XF), (const float*)(p.ws + WS_MOD) + (size_t)l * 9 * 6144 + 2048};
    pg8::gemm_phase<EpiWo, SchedDense, false>(LDSP, D, D, S, E);
}
DI void moe_offsets(PRef p, int l, int* off, int tid) {
    const unsigned* cnt = (const unsigned*)(p.ws + WS_CTL) + CW_CNT + l * 64;
    if (tid < 64) expert_offsets_wave(cnt, off, tid);
    if (tid < NE) off[40 + tid] = (int)cnt[tid];
    __syncthreads();
}
DI void ph_moe1_fast(PRef p, int l, unsigned char* lds) {
    const int tid_ = opq_tid(); const int bid_ = opq_bid(), nblk_ = opq_nblk(); (void)bid_; (void)nblk_; int* off = (int*)(lds + 131072 + 1024); moe_offsets(p, l, off, tid_);
    SchedMoe S; S.A = (const char*)(p.ws + WS_H2); S.Bt = (const char*)((const bf16*)(p.ws + WS_WGU_T) + (size_t)l * NE * 2048 * D); S.rowtok = (const int*)(p.ws + WS_ROWTOK); S.off = off; S.cnt = off + 40;
    S.nN = 8; S.G = nblk_; S.c = bid_; S.ntiles = off[NE] >> 8; S.tstepA = 0; S.estepB = (size_t)2048 * D * 2  ; S.tstepB = (size_t)256 * D  ; S.gather = true;
    EpiMoeActI8 E{(bf16*)(p.ws + WS_ACT), p.in[I_BGU] + (size_t)l * NE * 2048, (const float*)(p.ws + WS_HS), (const float*)(p.ws + WS_WGUS) + (size_t)l * NE * 2048};
    pg8::gemm_phase<EpiMoeActI8, SchedMoe, true, true>(LDSP, D, D, S, E);
}
DI void ph_moe2_fast(PRef p, int l, unsigned char* lds) {
    const int tid_ = opq_tid(); const int bid_ = opq_bid(), nblk_ = opq_nblk(); (void)bid_; (void)nblk_; int* off = (int*)(lds + 131072 + 1024); moe_offsets(p, l, off, tid_);
    SchedMoe S; S.A = (const char*)(p.ws + WS_ACT); S.Bt = (const char*)((const bf16*)(p.ws + WS_WDN_T) + (size_t)l * NE * D * DFF); S.rowtok = (const int*)(p.ws + WS_ROWTOK); S.off = off; S.cnt = off + 40;
    S.nN = 4; S.G = nblk_; S.c = bid_; S.ntiles = off[NE] >> 8; S.tstepA = (size_t)256 * D * 2; S.estepB = (size_t)D * DFF * 2; S.tstepB = (size_t)256 * DFF * 2; S.gather = false;
    S.rev = true;
    EpiStoreBf16 E{(bf16*)(p.ws + WS_YE), D, 0, p.in[I_BDN] + (size_t)l * NE * D, D};
    pg8::gemm_phase<EpiStoreBf16, SchedMoe, false>(LDSP, DFF, DFF, S, E);
}

namespace fa {
using bf16x8 = __attribute__((ext_vector_type(8))) short;
using s16x4  = __attribute__((ext_vector_type(4))) short;
using f32x16 = __attribute__((ext_vector_type(16))) float;
using u32x4  = __attribute__((ext_vector_type(4))) unsigned;
constexpr int SHM_K = 64 * 256, SHM_V = 64 * 256;
constexpr float THR2 = 11.5f;
#define FA_KSWZ(row, colB) ((row) * 256 + ((colB) ^ (((row) & 7) << 4)))
#define FA_SBAR() __builtin_amdgcn_sched_barrier(0)
DI int crow(int r, int hi) { return (r & 3) + 8 * (r >> 2) + 4 * hi; }
DI unsigned cvtpk(float lo, float hi) { unsigned r; asm volatile("v_cvt_pk_bf16_f32 %0, %1, %2" : "=v"(r) : "v"(lo), "v"(hi)); return r; }
DI int v_st(int k, int c) { const int kk = k;        return ((kk >> 3) * 4 + (c >> 5)) * 512 + ((kk & 7) * 32 + (c & 31)) * 2; }
DI int v_rd_base(int lane) { return ((lane & 3) << 3) | (((lane >> 2) & 3) << 6) | (((lane >> 4) & 1) << 5) | (((lane >> 5) & 1) << 8); }
constexpr int v_rd_off(int d0, int ks, int half) { return d0 * 512 + ks * 4096 + half * 2048; }
template <int OFF> DI s16x4 tr_read(int vb) { s16x4 r; asm volatile("ds_read_b64_tr_b16 %0, %1 offset:%2" : "=&v"(r) : "v"(vb), "i"(OFF) : "memory"); return r; }
template <int D0> DI void pv_one(f32x16& od, int vb, bf16x8 pa0, bf16x8 pa1, bf16x8 pa2, bf16x8 pa3) {
  const s16x4 l0 = tr_read<v_rd_off(D0, 0, 0)>(vb), h0 = tr_read<v_rd_off(D0, 0, 1)>(vb), l1 = tr_read<v_rd_off(D0, 1, 0)>(vb), h1 = tr_read<v_rd_off(D0, 1, 1)>(vb);
  const s16x4 l2 = tr_read<v_rd_off(D0, 2, 0)>(vb), h2 = tr_read<v_rd_off(D0, 2, 1)>(vb), l3 = tr_read<v_rd_off(D0, 3, 0)>(vb), h3 = tr_read<v_rd_off(D0, 3, 1)>(vb);
  asm volatile("s_waitcnt lgkmcnt(0)" ::: "memory"); FA_SBAR();
#define FA_PK(L, H) (bf16x8){L[0], L[1], L[2], L[3], H[0], H[1], H[2], H[3]}
  od = __builtin_amdgcn_mfma_f32_32x32x16_bf16(pa0, FA_PK(l0, h0), od, 0, 0, 0);
  od = __builtin_amdgcn_mfma_f32_32x32x16_bf16(pa1, FA_PK(l1, h1), od, 0, 0, 0);
  od = __builtin_amdgcn_mfma_f32_32x32x16_bf16(pa2, FA_PK(l2, h2), od, 0, 0, 0);
  od = __builtin_amdgcn_mfma_f32_32x32x16_bf16(pa3, FA_PK(l3, h3), od, 0, 0, 0);
#undef FA_PK
}

}


DI void ph_ada_fast(PRef p, unsigned char* lds) {
  const int tid_ = opq_tid(); const int bid_ = opq_bid(), nblk_ = opq_nblk();
  float* MOD = (float*)(p.ws + WS_MOD);
  { float* ROPE = (float*)(p.ws + WS_ROPE);
    for (int idx = GTID; idx < SEQ * 16; idx += NTHR) { const int sq = idx >> 4, i = idx & 15; const float pos = (i < 8) ? (float)(sq >> 6) : (float)(sq & 63);
      const float inv = powf(10000.f, -(float)(2 * (i & 7)) / 16.f); const float th = pos * inv; ROPE[sq * 32 + i] = cosf(th); ROPE[sq * 32 + 16 + i] = sinf(th); } }
  if (bid_ == 0) { for (int k = tid_; k < 2 * NH * 15 * 31; k += 512) { const float v = fmaxf(p.in[I_RPB][k], 0.f); atomicMax((int*)(p.ws + WS_CTL) + CW_BIASMAX + k / (NH * 15 * 31), __float_as_int(v)); } }
  float* sc = (float*)lds;
  float* red = (float*)(lds + 40960);
  for (int k = tid_; k < 9 * D; k += 512) { const int i = k >> 10, kk = k & 1023; const float v = i < 8 ? p.in[I_C][i * D + kk] : p.in[I_CCTX][kk]; sc[k] = v * sigmoidf_(v); }
  __syncthreads();
  const int nn = tid_ & 63, kg = tid_ >> 6;
  for (int it = bid_; it < 2 * 96; it += nblk_) {
    const int l = it / 96, n0 = (it - l * 96) * 64;
    const float* W = p.in[I_ADAW] + (size_t)l * D * 6144 + n0 + nn;
    float acc[9];
#pragma unroll
    for (int i = 0; i < 9; ++i) acc[i] = 0.f;
#pragma unroll 8
    for (int k = kg * 128; k < kg * 128 + 128; ++k) { const float w = W[(size_t)k * 6144];
#pragma unroll
      for (int i = 0; i < 9; ++i) acc[i] += sc[i * D + k] * w; }
#pragma unroll
    for (int i = 0; i < 9; ++i) red[(kg * 9 + i) * 64 + nn] = acc[i];
    __syncthreads();
    for (int o = tid_; o < 9 * 64; o += 512) { const int i = o >> 6, n = o & 63; float s = 0.f;
#pragma unroll
      for (int g = 0; g < 8; ++g) s += red[(g * 9 + i) * 64 + n];
      MOD[((size_t)l * 9 + i) * 6144 + n0 + n] = s + p.in[I_ADAB][l * 6144 + n0 + n]; }
    __syncthreads();
  }
}


DI void ld32(const bf16* __restrict__ src, float (&x)[32]) {
#pragma unroll
  for (int q = 0; q < 4; ++q) { const uint4 u = *(const uint4*)(src + 8 * q); const unsigned w[4] = {u.x, u.y, u.z, u.w};
#pragma unroll
    for (int i = 0; i < 4; ++i) { x[8 * q + 2 * i] = __uint_as_float(w[i] << 16); x[8 * q + 2 * i + 1] = __uint_as_float(w[i] & 0xffff0000u); } }
}
DI void st32(bf16* __restrict__ dst, const float (&x)[32]) {
#pragma unroll
  for (int q = 0; q < 4; ++q) { uint4 u; u.x = cvt_pk_bf16_(x[8 * q], x[8 * q + 1]); u.y = cvt_pk_bf16_(x[8 * q + 2], x[8 * q + 3]); u.z = cvt_pk_bf16_(x[8 * q + 4], x[8 * q + 5]); u.w = cvt_pk_bf16_(x[8 * q + 6], x[8 * q + 7]); *(uint4*)(dst + 8 * q) = u; }
}


DI void ph_diffcombine_fast(PRef p, int l, int nrows, float lam_init) {
  const int tid_ = opq_tid(); const int bid_ = opq_bid(), nblk_ = opq_nblk();
  const int lane = tid_ & 63, gw = GTID >> 6, ngw = NTHR >> 6;
  const bf16* __restrict__ DO_ = (const bf16*)(p.ws + WS_DO); bf16* __restrict__ BI = (bf16*)(p.ws + WS_BI);
  const float* lv = p.in[I_DLAM] + l * 128;
  const float t1 = seg_sum(lane < 32 ? lv[lane] * lv[32 + lane] : 0.f, lane, 64), t2 = seg_sum(lane < 32 ? lv[64 + lane] * lv[96 + lane] : 0.f, lane, 64);
  const float lam = expf(t1) - expf(t2) + lam_init;
  const int h = lane >> 4, d = 4 * (lane & 15);
  float g[4];
#pragma unroll
  for (int i = 0; i < 4; ++i) g[i] = p.in[I_DSUBG][l * 64 + d + i] * (1.f - lam_init);
#pragma unroll 4
  for (int r = gw; r < nrows; r += ngw) {
    float a[4], b[4], v[4]; ld4(DO_ + (size_t)r * 512 + (2 * h) * 64 + d, a); ld4(DO_ + (size_t)r * 512 + (2 * h + 1) * 64 + d, b);
#pragma unroll
    for (int i = 0; i < 4; ++i) v[i] = a[i] - lam * b[i];
    const float ss = seg_sum(v[0] * v[0] + v[1] * v[1] + v[2] * v[2] + v[3] * v[3], lane, 16); const float rs = rsqrtf(ss * (1.f / 64.f) + EPS);
#pragma unroll
    for (int i = 0; i < 4; ++i) v[i] = v[i] * rs * g[i];
    st4(BI + (size_t)r * D + 512 + h * 64 + d, v);
  }
}

DI void ph_mod2_router_fast(PRef p, int l, int nrows, unsigned char* lds) {
  const int tid_ = opq_tid(); const int bid_ = opq_bid(), nblk_ = opq_nblk();
  const int lane = tid_ & 63, wave = tid_ >> 6;
  float* rwT = (float*)lds;
  unsigned* lcnt = (unsigned*)(lds + 131072 + 2048);
  int* rbuf = (int*)(lds + 131072 + 4096);
  const float* rw = p.in[I_RW] + (size_t)l * D * NE;
  for (int q = tid_; q < D * NE / 4; q += 512) { const float4 v = *(const float4*)(rw + (size_t)q * 4); const int c = q >> 3, e = (q & 7) * 4;
    rwT[(e + 0) * D + c] = v.x; rwT[(e + 1) * D + c] = v.y; rwT[(e + 2) * D + c] = v.z; rwT[(e + 3) * D + c] = v.w; }
  if (tid_ < 64) lcnt[tid_] = 0u;
  __syncthreads();
  const float* MOD = (const float*)(p.ws + WS_MOD); const float* XF = (const float*)(p.ws + WS_XF);
  bf16* H2 = (bf16*)(p.ws + WS_H2); float* HS = (float*)(p.ws + WS_HS); const float* g = p.in[I_N2G] + l * D; const float* rb = p.in[I_RB] + l * NE;
  int* ROUTE = (int*)(p.ws + WS_ROUTE); unsigned* cnt = (unsigned*)(p.ws + WS_CTL) + CW_CNT + l * 64; int* ROWTOK = (int*)(p.ws + WS_ROWTOK);
  const int per = (nrows + nblk_ - 1) / nblk_, rlo = bid_ * per, rhi = min(rlo + per, nrows);
  float4 cx0, cx1, cx2, cx3;
  { const int r = min(rlo + wave, nrows - 1); const float* x = XF + (size_t)r * D + lane * 4; cx0 = *(const float4*)(x); cx1 = *(const float4*)(x + 256); cx2 = *(const float4*)(x + 512); cx3 = *(const float4*)(x + 768); }
  for (int r = rlo + wave; r < rhi; r += 8) {
    float4 nx0, nx1, nx2, nx3;
    { const int rn = min(r + 8, nrows - 1); const float* x = XF + (size_t)rn * D + lane * 4; nx0 = *(const float4*)(x); nx1 = *(const float4*)(x + 256); nx2 = *(const float4*)(x + 512); nx3 = *(const float4*)(x + 768); }
    float v[16]; float ss = 0.f;
    { const float4 t4[4] = {cx0, cx1, cx2, cx3};
#pragma unroll
    for (int j = 0; j < 4; ++j) { const float4 t = t4[j]; v[4 * j] = t.x; v[4 * j + 1] = t.y; v[4 * j + 2] = t.z; v[4 * j + 3] = t.w; ss += t.x * t.x + t.y * t.y + t.z * t.z + t.w * t.w; } }
    cx0 = nx0; cx1 = nx1; cx2 = nx2; cx3 = nx3;
    ss = seg_sum(ss, lane, 64);
    const float rstd = rsqrtf(ss * (1.f / D) + EPS);
    const float* md = MOD + ((size_t)l * 9 + modidx(r)) * 6144;
#pragma unroll
    for (int j = 0; j < 4; ++j) { const int c = j * 256 + lane * 4; const float4 gg = *(const float4*)(g + c), s4 = *(const float4*)(md + 4 * 1024 + c), h4 = *(const float4*)(md + 3 * 1024 + c);
      v[4 * j] = v[4 * j] * rstd * gg.x * (1.f + s4.x) + h4.x; v[4 * j + 1] = v[4 * j + 1] * rstd * gg.y * (1.f + s4.y) + h4.y;
      v[4 * j + 2] = v[4 * j + 2] * rstd * gg.z * (1.f + s4.z) + h4.z; v[4 * j + 3] = v[4 * j + 3] * rstd * gg.w * (1.f + s4.w) + h4.w;
      }
    { float mx = 0.f;
#pragma unroll
      for (int i = 0; i < 16; ++i) mx = fmaxf(mx, fabsf(v[i]));
#pragma unroll
      for (int o = 1; o < 64; o <<= 1) mx = fmaxf(mx, lane_xor(mx, lane, o));
      const float sc = mx > 0.f ? mx * (1.f / 127.f) : 1.f, inv = 1.f / sc; if (lane == 0) HS[r] = sc;
#pragma unroll
      for (int j = 0; j < 4; ++j) { unsigned b = 0;
#pragma unroll
        for (int i = 0; i < 4; ++i) b |= ((unsigned)(int)rintf(v[4 * j + i] * inv) & 255u) << (8 * i);
        *(unsigned*)((signed char*)H2 + (size_t)r * D + j * 256 + lane * 4) = b; } }
    float lg[NE];
#pragma unroll
    for (int e = 0; e < NE; ++e) { float s = 0.f;
#pragma unroll
      for (int j = 0; j < 4; ++j) { const float4 w = *(const float4*)(rwT + e * D + j * 256 + lane * 4); s += v[4 * j] * w.x + v[4 * j + 1] * w.y + v[4 * j + 2] * w.z + v[4 * j + 3] * w.w; }
      lg[e] = s; }
#pragma unroll
    for (int e = 0; e < NE; ++e) lg[e] = seg_sum(lg[e], lane, 64) + rb[e];
    int te[4]; float tv[4];
#pragma unroll
    for (int k = 0; k < 4; ++k) { float best = -3.4e38f; int bi = 0;
#pragma unroll
      for (int e = 0; e < NE; ++e) { const bool taken = (k > 0 && te[0] == e) || (k > 1 && te[1] == e) || (k > 2 && te[2] == e); if (!taken && lg[e] > best) { best = lg[e]; bi = e; } }
      te[k] = bi; tv[k] = best; }
    const float mx = tv[0]; float ex[4], se = 0.f;
#pragma unroll
    for (int k = 0; k < 4; ++k) { ex[k] = expf(tv[k] - mx); se += ex[k]; }
    if (lane == 0) { int* rt = rbuf + (r - rlo) * 12;
#pragma unroll
      for (int k = 0; k < 4; ++k) { rt[3 * k] = te[k]; rt[3 * k + 1] = (int)atomicAdd(&lcnt[te[k]], 1u); rt[3 * k + 2] = __float_as_int(ex[k] / se); } }
  }
  __syncthreads();
  if (tid_ < NE) lcnt[32 + tid_] = lcnt[tid_] ? atomicAdd(&cnt[tid_], lcnt[tid_]) : 0u;
  __syncthreads();
  for (int q = tid_; q < (rhi - rlo) * 4; q += 512) { const int lr = q >> 2, k = q & 3; const int* rt = rbuf + lr * 12 + 3 * k; int* o = ROUTE + ((size_t)(rlo + lr) * 4 + k) * 4;
    const int pos = rt[1] + (int)lcnt[32 + rt[0]];
    o[0] = rt[0]; o[1] = pos; o[2] = rt[2]; o[3] = 0; ROWTOK[(size_t)rt[0] * T + pos] = rlo + lr; }
}


namespace fa {
DI void expcvt(f32x16& p0, f32x16& p1, bf16x8& pa0, bf16x8& pa1, bf16x8& pa2, bf16x8& pa3) {
#pragma unroll
  for (int r = 0; r < 16; ++r) p0[r] = __builtin_amdgcn_exp2f(p0[r]);
#pragma unroll
  for (int r = 0; r < 16; ++r) p1[r] = __builtin_amdgcn_exp2f(p1[r]);
#define FA_PK4(P, BASE, OUT) do { unsigned a0 = cvtpk(P[BASE + 0], P[BASE + 1]), a1 = cvtpk(P[BASE + 2], P[BASE + 3]);   \
    unsigned b0 = cvtpk(P[BASE + 4], P[BASE + 5]), b1 = cvtpk(P[BASE + 6], P[BASE + 7]);                              \
    u32x4 w = {a0, a1, b0, b1}; OUT = *reinterpret_cast<bf16x8*>(&w); } while (0)
  FA_PK4(p0, 0, pa0); FA_PK4(p0, 8, pa1); FA_PK4(p1, 0, pa2); FA_PK4(p1, 8, pa3);
#undef FA_PK4
}
template <int ND0, int KST = 0>
DI void qkt2(f32x16& p0, f32x16& p1, const char* Ks, const bf16x8* qr, const f32x16& nbt, int r32, int hi) {
#pragma unroll
  for (int d0 = 0; d0 < ND0; ++d0) { const int cb = (d0 * 16 + hi * 8) * 2;
    bf16x8 b0 = *reinterpret_cast<const bf16x8*>(Ks + (KST ? r32 * KST + cb : FA_KSWZ(r32, cb)));
    bf16x8 b1 = *reinterpret_cast<const bf16x8*>(Ks + (KST ? (32 + r32) * KST + cb : FA_KSWZ(32 + r32, cb)));
    p0 = __builtin_amdgcn_mfma_f32_32x32x16_bf16(b0, qr[d0], d0 == 0 ? nbt : p0, 0, 0, 0);
    p1 = __builtin_amdgcn_mfma_f32_32x32x16_bf16(b1, qr[d0], d0 == 0 ? nbt : p1, 0, 0, 0); }
}
DI void pv3(f32x16* o, int vb, bf16x8 pa0, bf16x8 pa1, bf16x8 pa2, bf16x8 pa3) { pv_one<0>(o[0], vb, pa0, pa1, pa2, pa3); pv_one<1>(o[1], vb, pa0, pa1, pa2, pa3); pv_one<2>(o[2], vb, pa0, pa1, pa2, pa3); }
DI void fill_ones(char* V_lds, int tid) {
  const int b = tid >> 8, t = tid & 255, key = t >> 2, c8 = (t & 3) * 8;
  u32x4 w = {c8 == 0 ? 0x00003F80u : 0u, 0u, 0u, 0u};
  *(u32x4*)(V_lds + b * SHM_V + v_st(key, 64 + c8)) = w;
}
template <int DQK>
DI void attn_unit2(const bf16* __restrict__ Qb, int ldq, const bf16* __restrict__ Kh, int ldk, const bf16* __restrict__ Vh, const float* __restrict__ nbp, int nbs, int kva, int kvb, int NT,
                   bf16* __restrict__ Ob, int ldo, char* lds, int tid) {
  constexpr int ND0 = DQK / 16;
  const int wid = tid >> 6, lane = tid & 63, r32 = lane & 31, hi = lane >> 5;
  char* V_lds = lds; char* K_lds = lds + 2 * SHM_V;
  f32x16 o[3] = {}; bf16x8 qr[ND0];
  const bf16* Qw = Qb + (long)(wid * 32 + r32) * ldq + hi * 8;
#pragma unroll
  for (int d0 = 0; d0 < ND0; ++d0) qr[d0] = *reinterpret_cast<const bf16x8*>(Qw + d0 * 16);
  const float nb = nbp[(long)(wid * 32 + r32) * nbs];
  f32x16 nbt;
#pragma unroll
  for (int r = 0; r < 16; ++r) nbt[r] = nb;
  const int sr = tid >> 4, sc = (tid & 15) * 8; const bool kact = sc < DQK, vact = sc < 64;
  const int vst0 = v_st(sr, sc & 63), vst1 = v_st(32 + sr, sc & 63);
  const int vb0 = (int)(uintptr_t)V_lds + v_rd_base(lane);
  struct { bf16x8 vs0, vs1, ks0, ks1; } sr_[2];
#define FA_KROW(j) ((j) < 4 ? kva + 64 * (j) : kvb + 64 * ((j) - 4))
#define FA_SLOAD(i, j) do { const long kr_ = FA_KROW(j); \
    if (vact) { sr_[i].vs0 = *reinterpret_cast<const bf16x8*>(&Vh[(kr_ + sr) * 256 + sc]); sr_[i].vs1 = *reinterpret_cast<const bf16x8*>(&Vh[(kr_ + 32 + sr) * 256 + sc]); } \
    if (kact) { sr_[i].ks0 = *reinterpret_cast<const bf16x8*>(&Kh[(kr_ + sr) * ldk + sc]); sr_[i].ks1 = *reinterpret_cast<const bf16x8*>(&Kh[(kr_ + 32 + sr) * ldk + sc]); } } while (0)
#define FA_SWRITE(b, i) do { if (vact) { *(bf16x8*)(V_lds + (b) * SHM_V + vst0) = sr_[i].vs0; *(bf16x8*)(V_lds + (b) * SHM_V + vst1) = sr_[i].vs1; } \
    if (kact) { const int kc = sc * 2; *(bf16x8*)(K_lds + (b) * SHM_K + FA_KSWZ(sr, kc)) = sr_[i].ks0; *(bf16x8*)(K_lds + (b) * SHM_K + FA_KSWZ(32 + sr, kc)) = sr_[i].ks1; } } while (0)
  f32x16 pA0, pA1, pB0, pB1; bf16x8 pa0, pa1, pa2, pa3;
  FA_SLOAD(0, 0); asm volatile("s_waitcnt vmcnt(0)" ::: "memory"); FA_SWRITE(0, 0); __syncthreads();
  qkt2<ND0>(pA0, pA1, K_lds, qr, nbt, r32, hi);
  FA_SLOAD(1, 1); if (2 < NT) FA_SLOAD(0, 2);
  FA_SWRITE(1, 1); __syncthreads();
  for (int j = 1; j + 1 < NT; j += 2) {
    FA_SBAR(); qkt2<ND0>(pB0, pB1, K_lds + SHM_K, qr, nbt, r32, hi);
    expcvt(pA0, pA1, pa0, pa1, pa2, pa3); FA_SBAR();
    FA_SLOAD(1, j + 2); FA_SBAR();
    pv3(o, vb0, pa0, pa1, pa2, pa3);
    __syncthreads(); FA_SWRITE(0, 0); __syncthreads();
    FA_SBAR(); qkt2<ND0>(pA0, pA1, K_lds, qr, nbt, r32, hi);
    expcvt(pB0, pB1, pa0, pa1, pa2, pa3); FA_SBAR();
    if (j + 3 < NT) FA_SLOAD(0, j + 3); FA_SBAR();
    pv3(o, vb0 + SHM_V, pa0, pa1, pa2, pa3);
    __syncthreads(); FA_SWRITE(1, 1); __syncthreads();
  }
  FA_SBAR(); qkt2<ND0>(pB0, pB1, K_lds + SHM_K, qr, nbt, r32, hi);
  expcvt(pA0, pA1, pa0, pa1, pa2, pa3); FA_SBAR();
  pv3(o, vb0, pa0, pa1, pa2, pa3);
  expcvt(pB0, pB1, pa0, pa1, pa2, pa3); FA_SBAR();
  pv3(o, vb0 + SHM_V, pa0, pa1, pa2, pa3);
  bf16* Ow = Ob + (long)(wid * 32) * ldo;
#pragma unroll
  for (int r = 0; r < 16; ++r) { const int orow = crow(r, hi);
    const float lsum = __int_as_float(__builtin_amdgcn_ds_bpermute((hi * 32) << 2, __float_as_int(o[2][r]))); const float rl = __builtin_amdgcn_rcpf(lsum);
#pragma unroll
    for (int d0 = 0; d0 < 2; ++d0) Ow[(long)orow * ldo + d0 * 32 + r32] = f2bf(o[d0][r] * rl); }
  __syncthreads();
#undef FA_KROW
#undef FA_SLOAD
#undef FA_SWRITE
}
typedef float f32x2v __attribute__((ext_vector_type(2)));
typedef __bf16 bf16x2v __attribute__((ext_vector_type(2)));
DI unsigned cvtpk_b(float lo, float hi) { f32x2v v = {lo, hi}; bf16x2v b = __builtin_convertvector(v, bf16x2v); return __builtin_bit_cast(unsigned, b); }
DI void expcvt_b(f32x16& p0, f32x16& p1, bf16x8& pa0, bf16x8& pa1, bf16x8& pa2, bf16x8& pa3) {
#pragma unroll
  for (int r = 0; r < 16; ++r) p0[r] = __builtin_amdgcn_exp2f(p0[r]);
#pragma unroll
  for (int r = 0; r < 16; ++r) p1[r] = __builtin_amdgcn_exp2f(p1[r]);
#define FA_PK4(P, BASE, OUT) do { u32x4 w = {cvtpk_b(P[BASE + 0], P[BASE + 1]), cvtpk_b(P[BASE + 2], P[BASE + 3]), cvtpk_b(P[BASE + 4], P[BASE + 5]), cvtpk_b(P[BASE + 6], P[BASE + 7])}; \
    OUT = *reinterpret_cast<bf16x8*>(&w); } while (0)
  FA_PK4(p0, 0, pa0); FA_PK4(p0, 8, pa1); FA_PK4(p1, 0, pa2); FA_PK4(p1, 8, pa3);
#undef FA_PK4
}
template <int NM> DI void step_pipeline() {
  __builtin_amdgcn_sched_group_barrier(0x100, 4, 0);
#pragma unroll
  for (int i = 0; i < NM; ++i) {
    __builtin_amdgcn_sched_group_barrier(0x008, 1, 0);
    __builtin_amdgcn_sched_group_barrier(0x400, 2, 0);
    __builtin_amdgcn_sched_group_barrier(0x002, 2, 0);
    __builtin_amdgcn_sched_group_barrier(0x100, 2, 0);
  }
}
template <int OFF> DI s16x4 tr_rd(int vb) { return __builtin_amdgcn_ds_read_tr16_b64_v4i16((__attribute__((address_space(3))) s16x4*)(vb + OFF)); }
template <int D0> DI void pv_one_b(f32x16& od, int vb, bf16x8 pa0, bf16x8 pa1, bf16x8 pa2, bf16x8 pa3) {
  const s16x4 l0 = tr_rd<v_rd_off(D0, 0, 0)>(vb), h0 = tr_rd<v_rd_off(D0, 0, 1)>(vb), l1 = tr_rd<v_rd_off(D0, 1, 0)>(vb), h1 = tr_rd<v_rd_off(D0, 1, 1)>(vb);
  const s16x4 l2 = tr_rd<v_rd_off(D0, 2, 0)>(vb), h2 = tr_rd<v_rd_off(D0, 2, 1)>(vb), l3 = tr_rd<v_rd_off(D0, 3, 0)>(vb), h3 = tr_rd<v_rd_off(D0, 3, 1)>(vb);
#define FA_PK(L, H) (bf16x8){L[0], L[1], L[2], L[3], H[0], H[1], H[2], H[3]}
  od = __builtin_amdgcn_mfma_f32_32x32x16_bf16(pa0, FA_PK(l0, h0), od, 0, 0, 0);
  od = __builtin_amdgcn_mfma_f32_32x32x16_bf16(pa1, FA_PK(l1, h1), od, 0, 0, 0);
  od = __builtin_amdgcn_mfma_f32_32x32x16_bf16(pa2, FA_PK(l2, h2), od, 0, 0, 0);
  od = __builtin_amdgcn_mfma_f32_32x32x16_bf16(pa3, FA_PK(l3, h3), od, 0, 0, 0);
#undef FA_PK
}
DI void pv3b(f32x16* o, int vb, bf16x8 pa0, bf16x8 pa1, bf16x8 pa2, bf16x8 pa3, bf16x8 onesB) { pv_one_b<0>(o[0], vb, pa0, pa1, pa2, pa3); pv_one_b<1>(o[1], vb, pa0, pa1, pa2, pa3);
  o[2] = __builtin_amdgcn_mfma_f32_32x32x16_bf16(pa0, onesB, o[2], 0, 0, 0); o[2] = __builtin_amdgcn_mfma_f32_32x32x16_bf16(pa1, onesB, o[2], 0, 0, 0);
  o[2] = __builtin_amdgcn_mfma_f32_32x32x16_bf16(pa2, onesB, o[2], 0, 0, 0); o[2] = __builtin_amdgcn_mfma_f32_32x32x16_bf16(pa3, onesB, o[2], 0, 0, 0); }
#ifndef FS_SPREAD
#define FS_SPREAD 1
#endif
#ifndef FS_AH
#define FS_AH 2
#endif
template <int NM> constexpr int fs_ec(int s) { const int e = (FS_SPREAD && NM >= 24) ? s + (s + 2) / 3 : 2 * s; return e < 32 ? e : 32; }
template <int NM> constexpr int fs_cc(int s) { const int c = s >= 1 ? fs_ec<NM>(s - 1) / 2 : 0; return c < 16 ? c : 16; }
DI s16x4 tr_rd2(int vb, int off) { return __builtin_amdgcn_ds_read_tr16_b64_v4i16((__attribute__((address_space(3))) s16x4*)(vb + off)); }
template <int ND0, int WI, int KST = 0>
DI void fused_step(f32x16& pn0, f32x16& pn1, f32x16& pc0, f32x16& pc1, bf16x8& an0, bf16x8& an1, bf16x8& an2, bf16x8& an3, bf16x8 ac0, bf16x8 ac1, bf16x8 ac2, bf16x8 ac3,
                   f32x16* o, const char* Ks, int vb, const bf16x8* qr, const f32x16& nbt, int r32, int hi, bf16x8 onesB) {
  constexpr int NQ = 2 * ND0, NM = NQ + 12, AH = FS_AH;
  bf16x8 kf[NQ]; s16x4 vl[8], vh[8]; unsigned w[16];
  bf16x8 kz_; s16x4 vz_; if (WI & (4 | 16 | 32)) { asm volatile("v_mov_b32 %0, 0" : "=v"(vz_[0])); u32x4 z4_ = {0u, 0u, 0u, 0u}; asm volatile("" : "+v"(z4_)); kz_ = *reinterpret_cast<bf16x8*>(&z4_); vz_ = (s16x4){0, 0, 0, 0}; asm volatile("" : "+v"(vz_)); }
#define FS_ISSUE(m) do { if ((WI & 4) || ((WI & 16) && (m) < NQ) || ((WI & 32) && (m) >= NQ)) { if ((m) < NQ) kf[(m) < NQ ? (m) : 0] = kz_; else if ((m) - NQ < 8) { const int q_ = (m) - NQ; vl[q_ >= 0 ? q_ : 0] = vz_; vh[q_ >= 0 ? q_ : 0] = vz_; } } else if ((m) < NQ) { kf[(m) < NQ ? (m) : 0] = *reinterpret_cast<const bf16x8*>(Ks + (KST ? (((m) & 1) * 32 + r32) * KST + ((((m) >> 1) * 16 + hi * 8) * 2) : FA_KSWZ(((m) & 1) * 32 + r32, ((((m) >> 1) * 16 + hi * 8) * 2)))); } \
    else if ((m) - NQ < 8) { const int q_ = (m) - NQ; vl[q_ >= 0 ? q_ : 0] = tr_rd2(vb, v_rd_off(q_ >> 2, q_ & 3, 0)); vh[q_ >= 0 ? q_ : 0] = tr_rd2(vb, v_rd_off(q_ >> 2, q_ & 3, 1)); } } while (0)
#define FS_PC(v) ((v) < 16 ? pc0[(v) & 15] : pc1[(v) & 15])
#pragma unroll
  for (int m = 0; m < AH; ++m) FS_ISSUE(m);
#pragma unroll
  for (int s_ = 0; s_ < NM; ++s_) {
    if (s_ + AH < NM) FS_ISSUE(s_ + AH);
    if (s_ < NQ) { const int d0 = s_ >> 1;
      if ((s_ & 1) == 0) pn0 = __builtin_amdgcn_mfma_f32_32x32x16_bf16(kf[s_ < NQ ? s_ : 0], qr[d0 < ND0 ? d0 : 0], d0 == 0 ? nbt : pn0, 0, 0, 0);
      else pn1 = __builtin_amdgcn_mfma_f32_32x32x16_bf16(kf[s_ < NQ ? s_ : 0], qr[d0 < ND0 ? d0 : 0], d0 == 0 ? nbt : pn1, 0, 0, 0);
    } else { const int q = s_ - NQ, blk = q >> 2, ks = q & 3; const int qi = (q >= 0 && q < 8) ? q : 0; const s16x4 L = vl[qi], H = vh[qi];
      const bf16x8 B = blk == 2 ? onesB : (bf16x8){L[0], L[1], L[2], L[3], H[0], H[1], H[2], H[3]};       const bf16x8 A = ks == 0 ? ac0 : (ks == 1 ? ac1 : (ks == 2 ? ac2 : ac3));
      o[blk >= 0 ? blk : 0] = __builtin_amdgcn_mfma_f32_32x32x16_bf16(A, B, o[blk >= 0 ? blk : 0], 0, 0, 0); }
#pragma unroll
    for (int v = fs_ec<NM>(s_); v < ((WI & 2) ? 0 : fs_ec<NM>(s_ + 1)); ++v) { float e0 = FS_PC(v); asm volatile("" : "+v"(e0)); e0 = __builtin_amdgcn_exp2f(e0); asm volatile("" : "+v"(e0));
      if (v < 16) pc0[v & 15] = e0; else pc1[v & 15] = e0; }
#pragma unroll
    for (int k = fs_cc<NM>(s_); k < ((WI & 2) ? 0 : fs_cc<NM>(s_ + 1)); ++k) { unsigned wk = cvtpk_b(FS_PC(2 * k), FS_PC(2 * k + 1)); asm volatile("" : "+v"(wk)); w[k & 15] = wk; }
    FA_SBAR();
  }
#pragma unroll
  for (int k = fs_cc<NM>(NM); k < ((WI & 2) ? 0 : 16); ++k) w[k] = cvtpk_b(FS_PC(2 * k), FS_PC(2 * k + 1));
  if (WI & 2) { an0 = ac0; an1 = ac1; an2 = ac2; an3 = ac3; } else
  { u32x4 t0 = {w[0], w[1], w[2], w[3]}, t1 = {w[4], w[5], w[6], w[7]}, t2 = {w[8], w[9], w[10], w[11]}, t3 = {w[12], w[13], w[14], w[15]};
    an0 = *reinterpret_cast<bf16x8*>(&t0); an1 = *reinterpret_cast<bf16x8*>(&t1); an2 = *reinterpret_cast<bf16x8*>(&t2); an3 = *reinterpret_cast<bf16x8*>(&t3); }
#undef FS_ISSUE
#undef FS_PC
}
template <int DQK, int WI>
DI void attn_unit3(const bf16* __restrict__ Qb, int ldq, const bf16* __restrict__ Kh, int ldk, const bf16* __restrict__ Vh, const float* __restrict__ nbp, int nbs, int kva, int kvb, int NT,
                   bf16* __restrict__ Ob, int ldo, char* lds, int tid) {
  constexpr int ND0 = DQK / 16;
  const int wid = tid >> 6, lane = tid & 63, r32 = lane & 31, hi = lane >> 5;
  char* V_lds = lds; char* K_lds = lds + 2 * SHM_V;
  f32x16 o[3] = {}; bf16x8 qr[ND0];
  const bf16* Qw = Qb + (long)(wid * 32 + r32) * ldq + hi * 8;
#pragma unroll
  for (int d0 = 0; d0 < ND0; ++d0) qr[d0] = *reinterpret_cast<const bf16x8*>(Qw + d0 * 16);
  const float nb = nbp[(long)(wid * 32 + r32) * nbs];
  f32x16 nbt;
#pragma unroll
  for (int r = 0; r < 16; ++r) nbt[r] = nb;
  const int sr = tid >> 4, sc = (tid & 15) * 8; const bool kact = sc < DQK, vact = sc < 64;
  const int vst0 = v_st(sr, sc & 63), vst1 = v_st(32 + sr, sc & 63);
  const int vb0 = (int)(uintptr_t)V_lds + v_rd_base(lane);
  bf16x8 vs0, vs1, ks0, ks1;
#define FA_KROW(j) ((j) < 4 ? kva + 64 * (j) : kvb + 64 * ((j) - 4))
#define FA_LOADK(j) do { if (kact) { const long kr_ = FA_KROW(j); ks0 = *reinterpret_cast<const bf16x8*>(&Kh[(kr_ + sr) * ldk + sc]); ks1 = *reinterpret_cast<const bf16x8*>(&Kh[(kr_ + 32 + sr) * ldk + sc]); } } while (0)
#define FA_LOADV(j) do { if (vact) { const long kr_ = FA_KROW(j); vs0 = *reinterpret_cast<const bf16x8*>(&Vh[(kr_ + sr) * 256 + sc]); vs1 = *reinterpret_cast<const bf16x8*>(&Vh[(kr_ + 32 + sr) * 256 + sc]); } } while (0)
#define FA_WRITEK(b) do { if (kact) { const int kc = sc * 2; *(bf16x8*)(K_lds + (b) * SHM_K + FA_KSWZ(sr, kc)) = ks0; *(bf16x8*)(K_lds + (b) * SHM_K + FA_KSWZ(32 + sr, kc)) = ks1; } } while (0)
#define FA_WRITEV(b) do { if (vact) { *(bf16x8*)(V_lds + (b) * SHM_V + vst0) = vs0; *(bf16x8*)(V_lds + (b) * SHM_V + vst1) = vs1; } } while (0)
  f32x16 pE0, pE1, pO0, pO1; bf16x8 ae0, ae1, ae2, ae3, ao0, ao1, ao2, ao3;
  bf16x8 onesB; { const unsigned ov = r32 == 0 ? 0x3F803F80u : 0u; u32x4 t = {ov, ov, ov, ov}; onesB = *reinterpret_cast<bf16x8*>(&t); }
  FA_LOADK(0); asm volatile("s_waitcnt vmcnt(0)" ::: "memory"); FA_WRITEK(0); __syncthreads();
  FA_LOADK(1);
  qkt2<ND0>(pE0, pE1, K_lds, qr, nbt, r32, hi);
  __syncthreads(); FA_WRITEK(1); __syncthreads(); FA_LOADK(2); FA_LOADV(0);
  FA_SBAR(); qkt2<ND0>(pO0, pO1, K_lds + SHM_K, qr, nbt, r32, hi); expcvt(pE0, pE1, ae0, ae1, ae2, ae3); FA_SBAR();
  __syncthreads(); FA_WRITEK(0); FA_WRITEV(0); __syncthreads(); if (3 < NT) FA_LOADK(3); FA_LOADV(1);
#define FA_SY() do { if (!(WI & 1)) __syncthreads(); } while (0)
#define FA_IO(x) do { if (!(WI & 8)) { x; } } while (0)
  for (int j = 1; j + 2 < NT; j += 2) {
    FA_SBAR(); asm volatile("" : "+v"(pO0), "+v"(pO1));
    fused_step<ND0, WI>(pE0, pE1, pO0, pO1, ao0, ao1, ao2, ao3, ae0, ae1, ae2, ae3, o, K_lds, vb0, qr, nbt, r32, hi, onesB);
    FA_SY(); FA_IO(FA_WRITEK(1); FA_WRITEV(1)); FA_SY(); FA_IO(if (j + 3 < NT) FA_LOADK(j + 3); FA_LOADV(j + 1));
    FA_SBAR(); asm volatile("" : "+v"(pE0), "+v"(pE1));
    fused_step<ND0, WI>(pO0, pO1, pE0, pE1, ae0, ae1, ae2, ae3, ao0, ao1, ao2, ao3, o, K_lds + SHM_K, vb0 + SHM_V, qr, nbt, r32, hi, onesB);
    FA_SY(); FA_IO(if (j + 3 < NT) FA_WRITEK(0); FA_WRITEV(0)); FA_SY(); FA_IO(if (j + 4 < NT) FA_LOADK(j + 4); if (j + 2 < NT) FA_LOADV(j + 2));
  }
#undef FA_SY
#undef FA_IO
  FA_SBAR(); expcvt(pO0, pO1, ao0, ao1, ao2, ao3); pv3b(o, vb0, ae0, ae1, ae2, ae3, onesB); FA_SBAR();
  __syncthreads(); FA_WRITEV(1); __syncthreads();
  pv3b(o, vb0 + SHM_V, ao0, ao1, ao2, ao3, onesB);
  bf16* Ow = Ob + (long)(wid * 32) * ldo;
#pragma unroll
  for (int r = 0; r < 16; ++r) { const int orow = crow(r, hi);
    const float lsum = __int_as_float(__builtin_amdgcn_ds_bpermute((hi * 32) << 2, __float_as_int(o[2][r]))); const float rl = __builtin_amdgcn_rcpf(lsum);
#pragma unroll
    for (int d0 = 0; d0 < 2; ++d0) Ow[(long)orow * ldo + d0 * 32 + r32] = f2bf(o[d0][r] * rl); }
  __syncthreads();
#undef FA_KROW
#undef FA_LOADK
#undef FA_LOADV
#undef FA_WRITEK
#undef FA_WRITEV
}
template <int DQK>
DI void attn_unit4(const bf16* __restrict__ Qb, int ldq, const bf16* __restrict__ Kh, int ldk, const bf16* __restrict__ Vh, const float* __restrict__ nbp, int nbs, int kva, int kvb, int NT,
                   bf16* __restrict__ Ob, int ldo, char* lds, int tid, bool prefetched, const bf16* Knext) {
  constexpr int ND0 = DQK / 16, CPR = DQK / 8 + 1, KST = CPR * 16, KSZ = 64 * KST;
  const int wid = __builtin_amdgcn_readfirstlane(tid >> 6), lane = tid & 63, r32 = lane & 31, hi = lane >> 5;
  char* V_lds = lds; char* K_lds = lds + 3 * SHM_V;
  f32x16 o[3] = {}; bf16x8 qr[ND0];
  const bf16* Qw = Qb + (long)(wid * 32 + r32) * ldq + hi * 8;
#pragma unroll
  for (int d0 = 0; d0 < ND0; ++d0) qr[d0] = *reinterpret_cast<const bf16x8*>(Qw + d0 * 16);
  const float nb = nbp[(long)(wid * 32 + r32) * nbs];
  f32x16 nbt;
#pragma unroll
  for (int r = 0; r < 16; ++r) nbt[r] = nb;
  const int vb0 = (int)(uintptr_t)V_lds + v_rd_base(lane);
  bf16x8 onesB; { const unsigned ov = r32 == 0 ? 0x3F803F80u : 0u; u32x4 t = {ov, ov, ov, ov}; onesB = *reinterpret_cast<bf16x8*>(&t); }
  unsigned kof0, kof1, vof;
  { const int c0 = 64 * wid + lane, c1 = c0 + 512; const int ra = c0 / CPR, ca = c0 - ra * CPR, rb = c1 / CPR, cb = c1 - rb * CPR;
    kof0 = (unsigned)(ra * ldk + (ca < CPR - 1 ? ca : 0) * 8) * 2u; kof1 = (unsigned)(rb * ldk + (cb < CPR - 1 ? cb : 0) * 8) * 2u;
    vof = (unsigned)((wid * 8 + ((lane & 31) >> 2)) * 256 + (lane >> 5) * 32 + (lane & 3) * 8) * 2u; }
  const bool k0act = wid < CPR, k1act = wid + 8 < CPR;
  const unsigned kl0 = (unsigned)(uintptr_t)K_lds + (unsigned)wid * 1024u, vl0 = (unsigned)(uintptr_t)V_lds + (unsigned)wid * 2048u;
#define FA_LAS __attribute__((address_space(3)))
#define FA_KROW(j) ((j) < 4 ? kva + 64 * (j) : kvb + 64 * ((j) - 4))
#define FA_DMAK(t, slot) do { const char* kb_ = (const char*)(Kh + (long)FA_KROW(t) * ldk); const unsigned kd_ = kl0 + (unsigned)(slot) * (unsigned)KSZ; \
    if (k0act) __builtin_amdgcn_global_load_lds((const unsigned*)(kb_ + kof0), (FA_LAS unsigned*)kd_, 16, 0, 0); \
    if (k1act) __builtin_amdgcn_global_load_lds((const unsigned*)(kb_ + kof1), (FA_LAS unsigned*)(kd_ + 8192u), 16, 0, 0); } while (0)
#define FA_DMAV(t, slot) do { const char* vb_ = (const char*)(Vh + (long)FA_KROW(t) * 256); \
    __builtin_amdgcn_global_load_lds((const unsigned*)(vb_ + vof), (FA_LAS unsigned*)(vl0 + (unsigned)(slot) * (unsigned)SHM_V), 16, 0, 0); } while (0)
#define FA_NX(s) ((s) == 2 ? 0 : (s) + 1)
#define FA_END(n) do { asm volatile("s_waitcnt vmcnt(" #n ")" ::: "memory"); __builtin_amdgcn_s_barrier(); } while (0)
  f32x16 pE0, pE1, pO0, pO1; bf16x8 ae0, ae1, ae2, ae3, ao0, ao1, ao2, ao3;
  if (!prefetched) { FA_DMAK(0, 0); FA_DMAK(1, 1); }
  FA_END(0);
#pragma unroll
  for (int d0 = 0; d0 < ND0; ++d0) asm volatile("" : "+v"(qr[d0]));
  asm volatile("" : "+v"(nbt));
  if (2 < NT) FA_DMAK(2, 2); FA_DMAV(0, 0);
  qkt2<ND0, KST>(pE0, pE1, K_lds, qr, nbt, r32, hi);
  FA_END(1);
  if (3 < NT) FA_DMAK(3, 0); FA_DMAV(1, 1);
  FA_SBAR(); qkt2<ND0, KST>(pO0, pO1, K_lds + KSZ, qr, nbt, r32, hi); expcvt(pE0, pE1, ae0, ae1, ae2, ae3); FA_SBAR();
  FA_END(1);
  int sj = 1;
  for (int j = 1; j + 2 < NT; j += 2) {
    { const int s1 = FA_NX(sj), s2 = FA_NX(s1);
      if (j + 3 < NT) FA_DMAK(j + 3, sj); FA_DMAV(j + 1, s1);
      FA_SBAR(); asm volatile("" : "+v"(pO0), "+v"(pO1));
      fused_step<ND0, 0, KST>(pE0, pE1, pO0, pO1, ao0, ao1, ao2, ao3, ae0, ae1, ae2, ae3, o, K_lds + s1 * KSZ, vb0 + s2 * SHM_V, qr, nbt, r32, hi, onesB);
      FA_END(1); sj = s1; }
    { const int s1 = FA_NX(sj), s2 = FA_NX(s1);
      if (j + 4 < NT) FA_DMAK(j + 4, sj); if (j + 2 < NT) FA_DMAV(j + 2, s1);
      FA_SBAR(); asm volatile("" : "+v"(pE0), "+v"(pE1));
      fused_step<ND0, 0, KST>(pO0, pO1, pE0, pE1, ae0, ae1, ae2, ae3, ao0, ao1, ao2, ao3, o, K_lds + s1 * KSZ, vb0 + s2 * SHM_V, qr, nbt, r32, hi, onesB);
      FA_END(1); sj = s1; }
  }
  { const int s2 = FA_NX(FA_NX(sj));
    if (Knext) { const char* kb_ = (const char*)Knext;
      if (k0act) __builtin_amdgcn_global_load_lds((const unsigned*)(kb_ + kof0), (FA_LAS unsigned*)kl0, 16, 0, 0);
      if (k1act) __builtin_amdgcn_global_load_lds((const unsigned*)(kb_ + kof1), (FA_LAS unsigned*)(kl0 + 8192u), 16, 0, 0);
      kb_ += (size_t)64 * ldk * 2;
      if (k0act) __builtin_amdgcn_global_load_lds((const unsigned*)(kb_ + kof0), (FA_LAS unsigned*)(kl0 + (unsigned)KSZ), 16, 0, 0);
      if (k1act) __builtin_amdgcn_global_load_lds((const unsigned*)(kb_ + kof1), (FA_LAS unsigned*)(kl0 + (unsigned)KSZ + 8192u), 16, 0, 0); }
    FA_SBAR(); expcvt(pO0, pO1, ao0, ao1, ao2, ao3); pv3b(o, vb0 + s2 * SHM_V, ae0, ae1, ae2, ae3, onesB); FA_SBAR();
    if (!Knext || !k0act) { FA_END(0); } else if (k1act) { FA_END(4); } else { FA_END(2); }
    sj = FA_NX(sj); }
  { const int s2 = FA_NX(FA_NX(sj)); pv3b(o, vb0 + s2 * SHM_V, ao0, ao1, ao2, ao3, onesB); }
  bf16* Ow = Ob + (long)(wid * 32) * ldo;
#pragma unroll
  for (int r = 0; r < 16; ++r) { const int orow = crow(r, hi);
    const float lsum = __int_as_float(__builtin_amdgcn_ds_bpermute((hi * 32) << 2, __float_as_int(o[2][r]))); const float rl = __builtin_amdgcn_rcpf(lsum);
#pragma unroll
    for (int d0 = 0; d0 < 2; ++d0) Ow[(long)orow * ldo + d0 * 32 + r32] = f2bf(o[d0][r] * rl); }
  __syncthreads();
#undef FA_KROW
#undef FA_DMAK
#undef FA_DMAV
#undef FA_NX
#undef FA_END
}
}

template <int DQK, int WI = 0>
DI void ph_attn_fast2(const bf16* Q, const bf16* K, const bf16* V, const float* QB, int nhv, int vdiv, bf16* O, int ldo, int ooff, int qbase, int nq_per_b, bool with_latent, unsigned char* lds) {
  const int tid_ = opq_tid(); const int bid_ = opq_bid(), nblk_ = opq_nblk();
  const int chunks = nq_per_b / 256, npairs = NB * nhv, nunits = npairs * chunks;
  const bool xmap = (nblk_ == 256) && (chunks == 16);
#define AT_DECODE(i, ok, pair, ch) do { if (xmap) { const int v = (i) * 32 + (bid_ >> 3); ok = v < nhv * 16; pair = (v >> 4) * 8 + (bid_ & 7); ch = v & 15; } \
    else { const int u = (i) * nblk_ + bid_; ok = u < nunits; pair = u / chunks; ch = u - pair * chunks; } } while (0)
  bool ok, pre = false; int pair, ch;
  AT_DECODE(0, ok, pair, ch);
  for (int i = 0; ok; ++i) {
    bool okn; int pairn, chn;
    AT_DECODE(i + 1, okn, pairn, chn); (void)chn;
    const int b = pair / nhv, hv = pair - b * nhv;
    const int r0 = qbase + b * nq_per_b + ch * 256;
    int tu_ = tid_; asm volatile("" : "+v"(tu_));
    if constexpr (WI == 0) {
      const int bn = pairn / nhv, hvn = pairn - bn * nhv;
      const bf16* Kn = okn ? K + hvn * DQK + (size_t)(TL + bn * CTX) * (nhv * DQK) : nullptr;
      fa::attn_unit4<DQK>(Q + (size_t)r0 * (nhv * DQK) + hv * DQK, nhv * DQK, K + hv * DQK, nhv * DQK, V + (hv / vdiv) * 64, QB + (size_t)r0 * nhv + hv, nhv, TL + b * CTX, b * SEQ, with_latent ? 68 : 4,
                        O + (size_t)r0 * ldo + ooff + hv * 64, ldo, (char*)lds, tu_, pre, Kn);
      pre = okn;
    } else {
      fa::attn_unit3<DQK, WI>(Q + (size_t)r0 * (nhv * DQK) + hv * DQK, nhv * DQK, K + hv * DQK, nhv * DQK, V + (hv / vdiv) * 64, QB + (size_t)r0 * nhv + hv, nhv, TL + b * CTX, b * SEQ, with_latent ? 68 : 4,
                        O + (size_t)r0 * ldo + ooff + hv * 64, ldo, (char*)lds, tu_);
    }
    ok = okn; pair = pairn; ch = chn;
  }
#undef AT_DECODE
}

DI void ph_na_fast2(PRef p, int l, unsigned char* lds8) {
  using namespace fa;
  const int tid_ = opq_tid(); const int bid_ = opq_bid(), nblk_ = opq_nblk();
  char* lds = (char*)lds8;
  const bf16* __restrict__ Q = (const bf16*)(p.ws + WS_NQ); const bf16* __restrict__ K = (const bf16*)(p.ws + WS_NK); const bf16* __restrict__ V = (const bf16*)(p.ws + WS_NV); bf16* __restrict__ BI = (bf16*)(p.ws + WS_BI);
  const float* __restrict__ QB = (const float*)(p.ws + WS_QBN);
  const float* rpb = p.in[I_RPB] + (size_t)l * NH * 15 * 31;
  const int wid = __builtin_amdgcn_readfirstlane(tid_ >> 6), lane = tid_ & 63, r32 = lane & 31, hi = lane >> 5;
  char* V_lds = lds; char* K_lds = lds + 2 * SHM_V;
  float* tbl = (float*)(lds + 2 * SHM_V + 2 * SHM_K + 2048);
  bf16x8 onesB; { const unsigned ov = r32 == 0 ? 0x3F803F80u : 0u; u32x4 t = {ov, ov, ov, ov}; onesB = *reinterpret_cast<bf16x8*>(&t); }
  const int sr = tid_ >> 4, sc = (tid_ & 15) * 8; const bool act = sc < 64;
  const int vst0 = v_st(sr, sc & 63), vst1 = v_st(32 + sr, sc & 63);
  const int vb0 = (int)(uintptr_t)V_lds + v_rd_base(lane);
  const bool xmap = (nblk_ == 256);
  for (int i = 0;; ++i) {
    int pair, g;
    if (xmap) { const int v = i * 32 + (bid_ >> 3); if (v >= 64) break; pair = (v >> 4) * 8 + (bid_ & 7); g = v & 15; }
    else { const int u = i * nblk_ + bid_; if (u >= NB * NH * 16) break; pair = u >> 4; g = u & 15; }
    const int b = pair >> 2, h = pair & 3;
    for (int k = tid_; k < 15 * 32; k += 512) { const int ii = k >> 5, jj = k & 31; tbl[k] = jj < 31 ? rpb[(h * 15 + ii) * 31 + jj] * LOG2E : 0.f; }
    const int lo = min(max(4 * g - 4, 0), 56), hiR = min(max(4 * g + 3 - 4, 0), 56) + 7, NT = 4 + (hiR - lo + 1);
    const int qrow = 4 * g + (wid >> 1), rs_w = min(max(qrow - 4, 0), 56), qc = 32 * (wid & 1) + r32, ws0 = min(max(qc - 8, 0), 48);
    const int r0 = b * SEQ + g * 256;
    const bf16* Kh = K + h * 64; const bf16* Vh = V + h * 64;
    unsigned vmask = 0u;
#pragma unroll
    for (int r = 0; r < 16; ++r) { const int kc = crow(r, hi); vmask |= ((unsigned)(kc - ws0) < 16u ? 1u : 0u) << r; vmask |= ((unsigned)(kc + 32 - ws0) < 16u ? 1u : 0u) << (16 + r); }
    const int bbase = 4 * hi - qc + 15;
    f32x16 o[3] = {}; bf16x8 qr[4];
    const bf16* Qw = Q + (size_t)(r0 + wid * 32 + r32) * 256 + h * 64 + hi * 8;
#pragma unroll
    for (int d0 = 0; d0 < 4; ++d0) qr[d0] = *reinterpret_cast<const bf16x8*>(Qw + d0 * 16);
    const float nb = QB[(size_t)(r0 + wid * 32 + r32) * 4 + h];
    f32x16 nbt;
#pragma unroll
    for (int r = 0; r < 16; ++r) nbt[r] = nb;
    bf16x8 vs0, vs1, ks0, ks1;
#define NA_KROW(j) ((j) < 4 ? TL + b * CTX + 64 * (j) : b * SEQ + (lo + (j) - 4) * 64)
#define NA_SLOAD(j) do { if (act) { const long kr_ = NA_KROW(j); vs0 = *reinterpret_cast<const bf16x8*>(&Vh[(kr_ + sr) * 256 + sc]); vs1 = *reinterpret_cast<const bf16x8*>(&Vh[(kr_ + 32 + sr) * 256 + sc]); \
      ks0 = *reinterpret_cast<const bf16x8*>(&Kh[(kr_ + sr) * 256 + sc]); ks1 = *reinterpret_cast<const bf16x8*>(&Kh[(kr_ + 32 + sr) * 256 + sc]); } } while (0)
#define NA_SWRITE(bb) do { if (act) { *(bf16x8*)(V_lds + (bb) * SHM_V + vst0) = vs0; *(bf16x8*)(V_lds + (bb) * SHM_V + vst1) = vs1; const int kc_ = sc * 2; \
      *(bf16x8*)(K_lds + (bb) * SHM_K + FA_KSWZ(sr, kc_)) = ks0; *(bf16x8*)(K_lds + (bb) * SHM_K + FA_KSWZ(32 + sr, kc_)) = ks1; } } while (0)
    NA_SLOAD(0); NA_SWRITE(0); __syncthreads();
    for (int j = 0; j < NT; ++j) {
      const int bb = j & 1;
      if (j + 1 < NT) NA_SLOAD(j + 1);
      const int kr = lo + j - 4;
      const bool wvalid = (j < 4) || (kr >= rs_w && kr < rs_w + 8);
      if (wvalid) {
        f32x16 p0, p1; bf16x8 pa0, pa1, pa2, pa3;
        qkt2<4>(p0, p1, K_lds + bb * SHM_K, qr, nbt, r32, hi);
        if (j >= 4) {
          const float* brow = tbl + (kr - qrow + 7) * 32 + bbase;
#pragma unroll
          for (int r = 0; r < 16; ++r) { const int co = (r & 3) + 8 * (r >> 2);
            p0[r] = ((vmask >> r) & 1u) ? p0[r] + brow[co] : -1e30f; p1[r] = ((vmask >> (16 + r)) & 1u) ? p1[r] + brow[co + 32] : -1e30f; }
        }
        expcvt_b(p0, p1, pa0, pa1, pa2, pa3);
        pv3b(o, vb0 + bb * SHM_V, pa0, pa1, pa2, pa3, onesB);
      }
      if (j + 1 < NT) NA_SWRITE(bb ^ 1);
      __syncthreads();
    }
    bf16* Ow = BI + (size_t)(r0 + wid * 32) * D + 768 + h * 64;
#pragma unroll
    for (int r = 0; r < 16; ++r) { const int orow = crow(r, hi);
      const float lsum = __int_as_float(__builtin_amdgcn_ds_bpermute((hi * 32) << 2, __float_as_int(o[2][r]))); const float rl = __builtin_amdgcn_rcpf(lsum);
#pragma unroll
      for (int d0 = 0; d0 < 2; ++d0) Ow[(size_t)orow * D + d0 * 32 + r32] = f2bf(o[d0][r] * rl); }
    __syncthreads();
#undef NA_KROW
#undef NA_SLOAD
#undef NA_SWRITE
  }
}

#define LAS __attribute__((address_space(3)))
#define XB_TMO      128
#define XB_XCNT(j)  (256  + 64 * (j))
#define XB_XSUB(j)  (1280 + 64 * (j))
#define XB_XGEN(j)  (2304 + 64 * (j))
#define XB_TOP      3328
#define XB_TOPGEN   3392
#define XCD_BAR_WORDS 3456
#define XB_SPIN_CAP (1u << 24)
__device__ __forceinline__ unsigned xb_ld(unsigned* p)              { return __hip_atomic_load(p, __ATOMIC_RELAXED, __HIP_MEMORY_SCOPE_AGENT); }
__device__ __forceinline__ unsigned xb_add(unsigned* p, unsigned v) { return __hip_atomic_fetch_add(p, v, __ATOMIC_RELAXED, __HIP_MEMORY_SCOPE_AGENT); }
__device__ __forceinline__ unsigned xb_xcc_id() { return (unsigned)__builtin_amdgcn_s_getreg((3 << 11) | 20) & 0xFu; }
#define XB_SPIN(cond, bar) do { unsigned _sp = 0; while (cond) { __builtin_amdgcn_s_sleep(1); \
    if ((++_sp & 255u) == 0u) { if (xb_ld(&(bar)[XB_TMO])) break; if (_sp > XB_SPIN_CAP) { atomicAdd(&(bar)[XB_TMO], 1u); break; } } } } while (0)
struct XcdBarrier { unsigned* bar; unsigned x; volatile LAS unsigned* st; };
__device__ __forceinline__ XcdBarrier xcd_barrier_post(unsigned* bar, volatile LAS unsigned* st) {
    XcdBarrier b; b.bar = bar; b.x = xb_xcc_id(); b.st = st;
    if (threadIdx.x == 0) (void)xb_add(&bar[XB_XCNT(b.x)], 1u);
    return b;
}
__device__ __forceinline__ void xcd_barrier_complete(unsigned* bar, unsigned x, unsigned& nloc, unsigned& nx) {
    const unsigned G = gridDim.x * gridDim.y * gridDim.z;
    unsigned sum, cnt, mine, sp = 0u;
    for (;;) {
        sum = 0u; cnt = 0u; mine = 0u;
#pragma unroll
        for (unsigned j = 0; j < 16; ++j) { const unsigned c = xb_ld(&bar[XB_XCNT(j)]); sum += c; cnt += (c > 0u) ? 1u : 0u; }
        mine = xb_ld(&bar[XB_XCNT(x)]);
        if (sum == G) break;
        __builtin_amdgcn_s_sleep(1);
        if ((++sp & 255u) == 0u) { if (xb_ld(&bar[XB_TMO])) break; if (sp > XB_SPIN_CAP) { atomicAdd(&bar[XB_TMO], 1u); break; } }
    }
    nloc = mine > 0u ? mine : 1u; nx = cnt > 0u ? cnt : 1u;
}
__device__ __forceinline__ void xcd_barrier(const XcdBarrier& b) {
    asm volatile("s_waitcnt vmcnt(0)" ::: "memory");
    __syncthreads();
    if (threadIdx.x == 0) {
        unsigned* bar = b.bar; unsigned bx = b.x; asm volatile("" : "+s"(bar), "+s"(bx));
        __builtin_amdgcn_s_waitcnt(0);
        unsigned nloc = b.st[0], nx = b.st[1];
        if (nloc == 0u) { xcd_barrier_complete(bar, bx, nloc, nx); b.st[0] = nloc; b.st[1] = nx; }
        const unsigned old = xb_add(&bar[XB_XSUB(bx)], 1u);
        const unsigned gen = old / nloc;
        if (old + 1u == (gen + 1u) * nloc) {
            __builtin_amdgcn_fence(__ATOMIC_RELEASE, "agent");
            asm volatile("s_waitcnt vmcnt(0)" ::: "memory");
            const unsigned og = xb_add(&bar[XB_TOP], 1u);
            const unsigned tg = og / nx;
            if (og + 1u == (tg + 1u) * nx) xb_add(&bar[XB_TOPGEN], 1u);
            else XB_SPIN(xb_ld(&bar[XB_TOPGEN]) == tg, bar);
            __builtin_amdgcn_fence(__ATOMIC_ACQUIRE, "agent");
            xb_add(&bar[XB_XGEN(bx)], 1u);
            asm volatile("s_waitcnt vmcnt(0)" ::: "memory");
        } else {
            XB_SPIN(xb_ld(&bar[XB_XGEN(bx)]) == gen, bar);
            __builtin_amdgcn_fence(__ATOMIC_ACQUIRE, "agent");
            asm volatile("s_waitcnt vmcnt(0)" ::: "memory");
        }
    }
    __syncthreads();
}

constexpr int LDS_BYTES = 147456;
constexpr int BARW_OFF = 131072 + 512;
constexpr int CW_BAR = 4096;

#ifndef ATTN_V2
#define ATTN_V2 1
#endif
#ifndef REP_GEMM
#define REP_GEMM 1
#endif
#ifndef REP_ATTN
#define REP_ATTN 1
#endif
#ifndef REP_SMALL
#define REP_SMALL 1
#endif
#ifndef REP_CVT
#define REP_CVT 1
#endif
#ifndef REP_MD
#define REP_MD 1
#endif
#ifndef FA_WI
#define FA_WI 0
#endif
#define REPEAT_L(n, stmt) do { if ((n) == 1) { stmt; } else { int n_ = (n); asm volatile("" : "+s"(n_)); for (int rep_ = 0; rep_ < n_; ++rep_) { stmt; __syncthreads(); } } } while (0)
#define REPEAT(n, stmt) do { _Pragma("unroll") for (int rep_ = 0; rep_ < (n); ++rep_) { stmt; if ((n) > 1) __syncthreads(); } } while (0)
template <int l>
DI void layer_program(const XcdBarrier& bar, unsigned char* lds) {
#define GBAR() xcd_barrier(bar)
    const bool last = (l == 1);
    const int nrows = last ? TL : T;
    const float lam_init = last ? 0.35550906759096924f : 0.2f;
    if (l == 0) { REPEAT(REP_SMALL, ph_mod1(PP, l)); GBAR(); }
    REPEAT(REP_GEMM, ph_proj_fast(PP, l, lds));
    GBAR();
    REPEAT(REP_GEMM, ph_qkvraw_fast(PP, l, lds));
    REPEAT(REP_SMALL, ph_conv(PP, l, nrows, lds));
    GBAR();
#if ATTN_V2
#if REP_MD > 1
    { int n_ = REP_MD; asm volatile("" : "+s"(n_)); for (int rep_ = 0; rep_ < n_ - 1; ++rep_) { ph_attn_fast2<96, FA_WI>((const bf16*)(PP.ws + WS_MQ), (const bf16*)(PP.ws + WS_MK), (const bf16*)(PP.ws + WS_MV), (const float*)(PP.ws + WS_QBM), 4, 1, (bf16*)(PP.ws + WS_BI), D, 256, 0, SEQ, true, lds); __syncthreads(); ph_attn_fast2<32, FA_WI>((const bf16*)(PP.ws + WS_DQ), (const bf16*)(PP.ws + WS_DK), (const bf16*)(PP.ws + WS_DV), (const float*)(PP.ws + WS_QBD), 8, 2, (bf16*)(PP.ws + WS_DO), 512, 0, 0, SEQ, true, lds); __syncthreads(); } }
#endif
    ph_attn_fast2<96>((const bf16*)(PP.ws + WS_MQ), (const bf16*)(PP.ws + WS_MK), (const bf16*)(PP.ws + WS_MV), (const float*)(PP.ws + WS_QBM), 4, 1, (bf16*)(PP.ws + WS_BI), D, 256, 0, SEQ, true, lds);
    ph_attn_fast2<32>((const bf16*)(PP.ws + WS_DQ), (const bf16*)(PP.ws + WS_DK), (const bf16*)(PP.ws + WS_DV), (const float*)(PP.ws + WS_QBD), 8, 2, (bf16*)(PP.ws + WS_DO), 512, 0, 0, SEQ, true, lds);
    REPEAT(REP_ATTN, ph_na_fast2(PP, l, lds));
    if (!last) {
      ph_attn_fast2<96>((const bf16*)(PP.ws + WS_MQ), (const bf16*)(PP.ws + WS_MK), (const bf16*)(PP.ws + WS_MV), (const float*)(PP.ws + WS_QBM), 4, 1, (bf16*)(PP.ws + WS_BI), D, 256, TL, CTX, false, lds);
      ph_attn_fast2<32>((const bf16*)(PP.ws + WS_DQ), (const bf16*)(PP.ws + WS_DK), (const bf16*)(PP.ws + WS_DV), (const float*)(PP.ws + WS_QBD), 8, 2, (bf16*)(PP.ws + WS_DO), 512, 0, TL, CTX, false, lds);
      ph_attn_fast2<64>((const bf16*)(PP.ws + WS_NQ), (const bf16*)(PP.ws + WS_NK), (const bf16*)(PP.ws + WS_NV), (const float*)(PP.ws + WS_QBN), 4, 1, (bf16*)(PP.ws + WS_BI), D, 768, TL, CTX, false, lds);
    }
    GBAR();
#else
    REPEAT(REP_ATTN, ph_attn_fast<96>((const bf16*)(PP.ws + WS_MQ), (const bf16*)(PP.ws + WS_MK), (const bf16*)(PP.ws + WS_MV), 4, 1, (bf16*)(PP.ws + WS_BI), D, 256, 0, SEQ, true, lds));
    REPEAT(REP_ATTN, ph_attn_fast<32>((const bf16*)(PP.ws + WS_DQ), (const bf16*)(PP.ws + WS_DK), (const bf16*)(PP.ws + WS_DV), 8, 2, (bf16*)(PP.ws + WS_DO), 512, 0, 0, SEQ, true, lds));
    REPEAT(REP_ATTN, ph_na_fast(PP, l, lds));
    if (!last) {
      ph_attn_fast<96>((const bf16*)(PP.ws + WS_MQ), (const bf16*)(PP.ws + WS_MK), (const bf16*)(PP.ws + WS_MV), 4, 1, (bf16*)(PP.ws + WS_BI), D, 256, TL, CTX, false, lds);
      ph_attn_fast<32>((const bf16*)(PP.ws + WS_DQ), (const bf16*)(PP.ws + WS_DK), (const bf16*)(PP.ws + WS_DV), 8, 2, (bf16*)(PP.ws + WS_DO), 512, 0, TL, CTX, false, lds);
      ph_attn_fast<64>((const bf16*)(PP.ws + WS_NQ), (const bf16*)(PP.ws + WS_NK), (const bf16*)(PP.ws + WS_NV), 4, 1, (bf16*)(PP.ws + WS_BI), D, 768, TL, CTX, false, lds);
    }
    GBAR();
#endif
    REPEAT(REP_SMALL, ph_diffcombine_fast(PP, l, nrows, lam_init));
    GBAR();
    REPEAT(REP_GEMM, ph_branch_fast(PP, l, nrows, lds));
    GBAR();
    REPEAT(REP_GEMM, ph_merge_fast(PP, l, nrows, lds));
    GBAR();
    REPEAT((l == 0 ? REP_GEMM : 1), ph_wo_fast(PP, l, nrows, lds));
    GBAR();
    ph_mod2_router_fast(PP, l, nrows, lds);
    GBAR();
    REPEAT(REP_GEMM, ph_moe1_fast(PP, l, lds));
    GBAR();
    REPEAT(REP_GEMM, ph_moe2_fast(PP, l, lds));
    GBAR();
    ph_combine(PP, l, nrows, lds);
    if (l == 0) GBAR();
}

__global__ void __launch_bounds__(512, 2) fwd(Params p) {
  extern __shared__ __attribute__((aligned(16))) unsigned char lds[];
  if (threadIdx.x < 4) ((unsigned*)(lds + BARW_OFF))[threadIdx.x] = 0u;
  __syncthreads();
  XcdBarrier bar = xcd_barrier_post((unsigned*)(PP.ws + WS_CTL) + CW_BAR, (volatile LAS unsigned*)(lds + BARW_OFF));
  ph_ada_fast(PP, lds);
  __syncthreads();
  REPEAT(REP_CVT, ph_convert(PP, lds));
  GBAR();
  layer_program<0>(bar, lds);
  layer_program<1>(bar, lds);
}

extern "C" void kernel_launch(void* const* d_in, const int* in_sizes, int n_in, void* d_out, int out_size, void* d_ws, size_t ws_size, hipStream_t stream) {
  static int grid = 0;
  if (grid == 0) {
    if (n_in != N_IN || ws_size < WS_END) { fprintf(stderr, "kernel_launch: n_in %d ws %zu need %zu\n", n_in, ws_size, (size_t)WS_END); grid = -1; return; }
    int dev = 0, cus = 0;
    if (hipGetDevice(&dev) != hipSuccess || hipDeviceGetAttribute(&cus, hipDeviceAttributeMultiprocessorCount, dev) != hipSuccess) { grid = -1; return; }
    if (hipFuncSetAttribute((const void*)fwd, hipFuncAttributeMaxDynamicSharedMemorySize, LDS_BYTES) != hipSuccess) { fprintf(stderr, "kernel_launch: hipFuncSetAttribute failed\n"); grid = -1; return; }
    int per_cu = 0;
    if (hipOccupancyMaxActiveBlocksPerMultiprocessor(&per_cu, (const void*)fwd, 512, LDS_BYTES) != hipSuccess || per_cu < 1) fprintf(stderr, "kernel_launch: occupancy query says %d\n", per_cu);
    (void)hipGetLastError();
    grid = cus;
  }
  if (grid < 0) return;
  Params p{};
  for (int i = 0; i < N_IN; ++i) p.in[i] = (const float*)d_in[i];
  p.out = (float*)d_out; p.ws = (unsigned char*)d_ws;
  (void)hipMemsetAsync((char*)d_ws + WS_CTL, 0, 1 * MiB, stream);
  (void)hipMemsetAsync((char*)d_ws + WS_QKV_T, 0, (size_t)2 * 1024 * 384 * 2, stream);
  (void)hipMemsetAsync((char*)d_ws + WS_WIN_T, 0, (size_t)2 * PLD * D * 2, stream);
  hipLaunchKernelGGL(fwd, dim3(grid), dim3(512), LDS_BYTES, stream, p);
}
```

```cpp
#include <hip/hip_runtime.h>
#include <cstdio>
#include <cstdint>

typedef unsigned short bf16;
#ifndef FAST_ATTN
#define FAST_ATTN 1
#endif
#if FAST_ATTN
#define ATTN_FN ph_attn_fast
#define ATTN_LDS , lds
#else
#define ATTN_FN ph_attn_naive
#define ATTN_LDS
#endif
#ifndef FAST_NA
#define FAST_NA 1
#endif
#ifndef FAST_SMALL
#define FAST_SMALL 1
#endif
#ifndef FAST_ROUTER
#define FAST_ROUTER 1
#endif
#ifndef FAST_PROJ
#define FAST_PROJ 1
#endif
#ifndef FAST_QKV
#define FAST_QKV 1
#endif
#ifndef FAST_MERGE
#define FAST_MERGE 1
#endif
#ifndef FAST_WO
#define FAST_WO 1
#endif
#ifndef FAST_MOE
#define FAST_MOE 1
#endif
#define DI __device__ __forceinline__

constexpr int D = 1024, NB = 8, SEQ = 4096, CTX = 256, GW = 64;
constexpr int TL = NB * SEQ;
constexpr int TC = NB * CTX;
constexpr int T = TL + TC;
constexpr int NH = 4;
constexpr int INW = 2400, PLD = 2560;
constexpr int OFF_B = 512, OFF_C = 864, OFF_D = 1632;
constexpr int NE = 32, DFF = 1024;
constexpr int MAXROWS = 4 * T + NE * 256;
constexpr float EPS = 1e-6f;
constexpr float LOG2E = 1.4426950408889634f;

enum { I_X = 0, I_C, I_CTX, I_CCTX, I_ADAW, I_ADAB, I_N1G, I_N2G, I_WIN, I_CONVW, I_CONVB, I_CLNG, I_CLNB, I_CONVOUT,
       I_CQG, I_CKVG, I_WUQ, I_WUKV, I_QNG, I_KNG, I_MLAOUT, I_DQNG, I_DKNG, I_DLAM, I_DSUBG, I_DIFFOUT, I_NQNG, I_NKNG,
       I_RPB, I_NAOUT, I_GATEW, I_GATEB, I_WO, I_RW, I_RB, I_WGU, I_BGU, I_WDN, I_BDN, N_IN };

constexpr size_t MiB = 1u << 20;
constexpr size_t al(size_t x) { return (x + 255) / 256 * 256; }
constexpr size_t WS_CTL = 0;
constexpr size_t WS_MOD = 1 * MiB;
constexpr size_t WS_ROPE = WS_MOD + al(2 * 9 * 6144 * 4);
constexpr size_t WS_ROUTE = WS_ROPE + al(4096 * 32 * 4);
constexpr size_t WS_ROWTOK = WS_ROUTE + al((size_t)T * 4 * 16);
constexpr size_t WS_HS = WS_ROWTOK + al((size_t)NE * T * 4);
constexpr size_t WS_WGUS = WS_HS + al((size_t)T * 4);
constexpr size_t WS_HS1 = WS_WGUS + al((size_t)2 * NE * 2048 * 4);
constexpr size_t WS_WINS = WS_HS1 + al((size_t)T * 4);
constexpr size_t WS_GATES = WS_WINS + al((size_t)2 * PLD * 4);
constexpr size_t WS_WIN_T = WS_GATES + al((size_t)2 * 4096 * 4);
constexpr size_t WS_QKV_T = WS_WIN_T + al((size_t)2 * PLD * D * 2);
constexpr size_t WS_WB_T = WS_QKV_T + al((size_t)2 * 1024 * 384 * 2);
constexpr size_t WS_GATE_T = WS_WB_T + al((size_t)2 * 4 * 1024 * 256 * 2);
constexpr size_t WS_WO_T = WS_GATE_T + al((size_t)2 * 4096 * D * 2);
constexpr size_t WS_WGU_T = WS_WO_T + al((size_t)2 * D * D * 2);
constexpr size_t WS_WDN_T = WS_WGU_T + al((size_t)2 * NE * 2048 * D * 2);
constexpr size_t WS_H = WS_WDN_T + al((size_t)2 * NE * D * DFF * 2);
constexpr size_t WS_H2 = WS_H + al((size_t)T * D * 2);
constexpr size_t WS_XF = WS_H2 + al((size_t)T * D * 2);
constexpr size_t WS_SCR = WS_XF + al((size_t)T * D * 4);
constexpr size_t WS_PROJ = WS_SCR;
constexpr size_t WS_CU = WS_PROJ + al((size_t)T * PLD * 2);
constexpr size_t WS_AQ = WS_CU + al((size_t)T * 256 * 2);
constexpr size_t WS_QKVRAW = WS_AQ + al((size_t)T * 384 * 2);
constexpr size_t WS_MQ = WS_QKVRAW + al((size_t)T * 1024 * 2);
constexpr size_t WS_MK = WS_MQ + al((size_t)T * 384 * 2);
constexpr size_t WS_MV = WS_MK + al((size_t)T * 384 * 2);
constexpr size_t WS_DQ = WS_MV + al((size_t)T * 256 * 2);
constexpr size_t WS_DK = WS_DQ + al((size_t)T * 256 * 2);
constexpr size_t WS_DV = WS_DK + al((size_t)T * 256 * 2);
constexpr size_t WS_NQ = WS_DV + al((size_t)T * 256 * 2);
constexpr size_t WS_NK = WS_NQ + al((size_t)T * 256 * 2);
constexpr size_t WS_NV = WS_NK + al((size_t)T * 256 * 2);
constexpr size_t WS_BI = WS_NV + al((size_t)T * 256 * 2);
constexpr size_t WS_DO = WS_BI + al((size_t)T * D * 2);
constexpr size_t WS_QBM = WS_DO + al((size_t)T * 512 * 2);
constexpr size_t WS_QBD = WS_QBM + al((size_t)T * 4 * 4);
constexpr size_t WS_QBN = WS_QBD + al((size_t)T * 8 * 4);
constexpr size_t WS_KPE = WS_QBN + al((size_t)T * 4 * 4);
constexpr size_t WS_YB = WS_KPE + al((size_t)T * 32 * 2);
constexpr size_t WS_YM = WS_YB + al((size_t)T * 4096 * 2);
constexpr size_t WS_MIX_END = WS_YM + al((size_t)T * D * 2);
constexpr size_t WS_ACT = WS_SCR;
constexpr size_t WS_YE = WS_ACT + al((size_t)MAXROWS * D * 2);
constexpr size_t WS_MOE_END = WS_YE + al((size_t)MAXROWS * D * 2);
constexpr size_t WS_END = WS_MIX_END > WS_MOE_END ? WS_MIX_END : WS_MOE_END;
static_assert(WS_END <= (size_t)2048 * MiB, "workspace budget (>= 2 GiB guaranteed)");
constexpr int CW_BIASMAX = 2048;
constexpr int CW_CNT = 1024;

struct Params {
  const float* in[N_IN];
  float* out;
  unsigned char* ws;
};
typedef const __attribute__((address_space(4))) Params& PRef;
typedef const __attribute__((address_space(4))) Params* PPtr;
__device__ __forceinline__ PPtr opq_params() { PPtr pp = (PPtr)__builtin_amdgcn_kernarg_segment_ptr(); asm volatile("" : "+s"(pp)); return pp; }
#define PP (*opq_params())

DI float bf2f(bf16 v) { return __uint_as_float(((unsigned)v) << 16); }
DI bf16 f2bf(float f) { unsigned u = __float_as_uint(f); u += 0x7fffu + ((u >> 16) & 1u); return (bf16)(u >> 16); }
DI float sigmoidf_(float x) { return 1.f / (1.f + __expf(-x)); }
DI float wave_sum_l(float v, int lane) {
#pragma unroll
  for (int o = 1; o < 64; o <<= 1) v += __int_as_float(__builtin_amdgcn_ds_bpermute((lane ^ o) << 2, __float_as_int(v)));
  return v;
}
#define wave_sum(v) wave_sum_l((v), lane)
DI unsigned cvt_pk_bf16_(float lo, float hi) { unsigned r; asm volatile("v_cvt_pk_bf16_f32 %0, %1, %2" : "=v"(r) : "v"(lo), "v"(hi)); return r; }
DI float seg_sum(float v, int lane, int width) {
#pragma unroll
  for (int o = 1; o < 64; o <<= 1) if (o < width) v += __int_as_float(__builtin_amdgcn_ds_bpermute((lane ^ o) << 2, __float_as_int(v)));
  return v;
}
DI float lane_xor(float v, int lane, int o) { return __int_as_float(__builtin_amdgcn_ds_bpermute((lane ^ o) << 2, __float_as_int(v))); }

DI void quant_row_i8(const float (&v)[16], signed char* dst, float* scale_out, int lane) {
  float mx = 0.f;
#pragma unroll
  for (int i = 0; i < 16; ++i) mx = fmaxf(mx, fabsf(v[i]));
#pragma unroll
  for (int o = 1; o < 64; o <<= 1) mx = fmaxf(mx, lane_xor(mx, lane, o));
  const float sc = mx > 0.f ? mx * (1.f / 127.f) : 1.f, inv = 1.f / sc; if (lane == 0) *scale_out = sc;
#pragma unroll
  for (int j = 0; j < 4; ++j) { unsigned b = 0;
#pragma unroll
    for (int i = 0; i < 4; ++i) b |= ((unsigned)(int)rintf(v[4 * j + i] * inv) & 255u) << (8 * i);
    *(unsigned*)(dst + j * 256 + lane * 4) = b; }
}
DI void ld4(const bf16* p, float (&x)[4]) { const uint2 u = *(const uint2*)p; x[0] = __uint_as_float(u.x << 16); x[1] = __uint_as_float(u.x & 0xffff0000u); x[2] = __uint_as_float(u.y << 16); x[3] = __uint_as_float(u.y & 0xffff0000u); }
DI void st4(bf16* p, const float (&x)[4]) { uint2 u; u.x = cvt_pk_bf16_(x[0], x[1]); u.y = cvt_pk_bf16_(x[2], x[3]); *(uint2*)p = u; }

DI int opq_bid() { int b = blockIdx.x; asm volatile("" : "+s"(b)); return b; }
DI int opq_nblk() { int g = gridDim.x; asm volatile("" : "+s"(g)); return g; }
DI int opq_tid() { int t = threadIdx.x; asm volatile("" : "+v"(t)); return t; }
#define GTID ((int)(bid_ * 512 + tid_))
#define NTHR ((int)(nblk_ * 512))
#define SUB ((int)(tid_ >> 8))
#define T256 ((int)(tid_ & 255))
DI int modidx(int r) { return r < TL ? (r >> 12) : NB; }


DI const float* stream_row(PRef p, int l, int r, bool after_mixer) {
  if (l == 0 && !after_mixer) return r < TL ? p.in[I_X] + (size_t)r * D : p.in[I_CTX] + (size_t)(r - TL) * D;
  return (const float*)(p.ws + WS_XF) + (size_t)r * D;
}
DI void ph_mod1(PRef p, int l) {
  const int tid_ = opq_tid(); const int bid_ = opq_bid(), nblk_ = opq_nblk(); (void)bid_; (void)nblk_;
  const int lane = tid_ & 63, gw = GTID >> 6, ngw = NTHR >> 6;
  const float* MOD = (const float*)(p.ws + WS_MOD);
  bf16* H = (bf16*)(p.ws + WS_H);
  const float* g = p.in[I_N1G] + l * D;
  float4 c0, c1, c2, c3;
  { const float* x = stream_row(p, l, min(gw, T - 1), false) + lane * 4; c0 = *(const float4*)(x); c1 = *(const float4*)(x + 256); c2 = *(const float4*)(x + 512); c3 = *(const float4*)(x + 768); }
  for (int r = gw; r < T; r += ngw) {
    float4 n0, n1, n2, n3;
    { const float* x = stream_row(p, l, min(r + ngw, T - 1), false) + lane * 4; n0 = *(const float4*)(x); n1 = *(const float4*)(x + 256); n2 = *(const float4*)(x + 512); n3 = *(const float4*)(x + 768); }
    float v[16]; float ss = 0.f;
    { const float4 t4[4] = {c0, c1, c2, c3};
#pragma unroll
    for (int j = 0; j < 4; ++j) { const float4 t = t4[j]; v[4 * j] = t.x; v[4 * j + 1] = t.y; v[4 * j + 2] = t.z; v[4 * j + 3] = t.w; ss += t.x * t.x + t.y * t.y + t.z * t.z + t.w * t.w; } }
    c0 = n0; c1 = n1; c2 = n2; c3 = n3;
    ss = wave_sum(ss);
    const float rstd = rsqrtf(ss * (1.f / D) + EPS);
    const float* md = MOD + ((size_t)l * 9 + modidx(r)) * 6144;
#pragma unroll
    for (int j = 0; j < 4; ++j)
#pragma unroll
      for (int i = 0; i < 4; ++i) { const int c = j * 256 + lane * 4 + i; v[4 * j + i] = v[4 * j + i] * rstd * g[c] * (1.f + md[1024 + c]) + md[c]; }
    quant_row_i8(v, (signed char*)H + (size_t)r * D, (float*)(p.ws + WS_HS1) + r, lane);
  }
}

struct RowId { DI int operator()(int m) const { return m; } };
struct RowGather { const int* idx; DI int operator()(int m) const { return idx[m]; } };
#define ZERO_ACC(acc) do { _Pragma("unroll") for (int i_ = 0; i_ < 4; ++i_) _Pragma("unroll") for (int j_ = 0; j_ < 4; ++j_) acc[i_][j_] = 0.f; } while (0)


DI void ph_conv(PRef p, int l, int nrows, unsigned char* lds) {
  const int tid_ = opq_tid(); const int bid_ = opq_bid(), nblk_ = opq_nblk(); (void)bid_; (void)nblk_;
  const int lane = tid_ & 63, gw = GTID >> 6, ngw = NTHR >> 6;
  const bf16* __restrict__ CU = (const bf16*)(p.ws + WS_CU); bf16* __restrict__ BI = (bf16*)(p.ws + WS_BI);
  const float* cw = p.in[I_CONVW] + l * 31 * 256; const float* cb = p.in[I_CONVB] + l * 256;
  float4* wl = (float4*)lds;
  for (int k = tid_; k < 31 * 64; k += 512) wl[k] = *(const float4*)(cw + 4 * k);
  __syncthreads();
  const float4 bias = *(const float4*)(cb + lane * 4), lg = *(const float4*)(p.in[I_CLNG] + l * 256 + lane * 4), lb = *(const float4*)(p.in[I_CLNB] + l * 256 + lane * 4);
  for (int r = gw; r < nrows; r += ngw) {
    int lo, hi; if (r < TL) { lo = r & ~(SEQ - 1); hi = lo + SEQ; } else { lo = TL + ((r - TL) & ~(CTX - 1)); hi = lo + CTX; }
    const bf16* up = CU + (long)(r - 15) * 256 + lane * 4; asm volatile("" : "+v"(up));
    uint2 u[31];
#pragma unroll
    for (int j = 0; j < 31; ++j) { const int rr = r + j - 15; u[j] = make_uint2(0u, 0u); if (rr >= lo && rr < hi) u[j] = *(const uint2*)(up + j * 256); }
    float a[4] = {bias.x, bias.y, bias.z, bias.w};
#pragma unroll
    for (int j = 0; j < 31; ++j) { const float4 w = wl[j * 64 + lane];
      a[0] += __uint_as_float(u[j].x << 16) * w.x; a[1] += __uint_as_float(u[j].x & 0xffff0000u) * w.y; a[2] += __uint_as_float(u[j].y << 16) * w.z; a[3] += __uint_as_float(u[j].y & 0xffff0000u) * w.w; }
    const float mu = seg_sum(a[0] + a[1] + a[2] + a[3], lane, 64) * (1.f / 256.f);
    float q2 = 0.f;
#pragma unroll
    for (int c = 0; c < 4; ++c) { a[c] -= mu; q2 += a[c] * a[c]; }
    const float rs = rsqrtf(seg_sum(q2, lane, 64) * (1.f / 256.f) + EPS);
    float y[4] = {a[0] * rs * lg.x + lb.x, a[1] * rs * lg.y + lb.y, a[2] * rs * lg.z + lb.z, a[3] * rs * lg.w + lb.w};
#pragma unroll
    for (int c = 0; c < 4; ++c) y[c] = y[c] * sigmoidf_(y[c]);
    st4(BI + (size_t)r * D + lane * 4, y);
  }
  __syncthreads();
}


DI void expert_offsets(const unsigned* cnt, int* off  ) { int a = 0; for (int e = 0; e < NE; ++e) { off[e] = a; a += ((int)cnt[e] + 255) & ~255; } off[NE] = a; }
DI void expert_offsets_wave(const unsigned* cnt, int* off  , int lane) {
  const int v = lane < NE ? (((int)cnt[lane < NE ? lane : 0] + 255) & ~255) : 0; int inc = v;
#pragma unroll
  for (int d = 1; d < 32; d <<= 1) { const int o = __builtin_amdgcn_ds_bpermute(((lane - d) & 63) << 2, inc); if (lane >= d) inc += o; }
  if (lane < NE) off[lane] = inc - v;
  if (lane == NE - 1) off[NE] = inc;
}
DI void ph_combine(PRef p, int l, int nrows, unsigned char* lds) {
  const int tid_ = opq_tid(); const int bid_ = opq_bid(), nblk_ = opq_nblk();
  int* off = (int*)(lds + 32768);
  const unsigned* cnt = (const unsigned*)(p.ws + WS_CTL) + CW_CNT + l * 64;
  if (tid_ < 64) expert_offsets_wave(cnt, off, tid_);
  __syncthreads();
  const int lane = tid_ & 63, gw = GTID >> 6, ngw = NTHR >> 6;
  const float* MOD = (const float*)(p.ws + WS_MOD); float* XF = (float*)(p.ws + WS_XF); const bf16* YE = (const bf16*)(p.ws + WS_YE); const int* ROUTE = (const int*)(p.ws + WS_ROUTE);
  bf16* H = (bf16*)(p.ws + WS_H); const float* g1n = p.in[I_N1G] + D;
  for (int r = gw; r < nrows; r += ngw) {
    const float* md = MOD + ((size_t)l * 9 + modidx(r)) * 6144 + 5 * 1024;
    float* dst = (l == 1) ? p.out + (size_t)r * D : XF + (size_t)r * D;
    const float* xs = XF + (size_t)r * D;
    float acc[16];
#pragma unroll
    for (int i = 0; i < 16; ++i) acc[i] = 0.f;
#pragma unroll
    for (int k = 0; k < 4; ++k) { const int* rt = ROUTE + ((size_t)r * 4 + k) * 4; const float w = __int_as_float(rt[2]); const bf16* y = YE + (size_t)(off[rt[0]] + rt[1]) * D;
#pragma unroll
      for (int j = 0; j < 4; ++j) { const uint2 u = *(const uint2*)(y + j * 256 + lane * 4);
        acc[4 * j] += w * __uint_as_float(u.x << 16); acc[4 * j + 1] += w * __uint_as_float(u.x & 0xffff0000u); acc[4 * j + 2] += w * __uint_as_float(u.y << 16); acc[4 * j + 3] += w * __uint_as_float(u.y & 0xffff0000u); } }
    float ss = 0.f;
#pragma unroll
    for (int j = 0; j < 4; ++j) { const int c = j * 256 + lane * 4; const float4 x4 = *(const float4*)(xs + c), m4 = *(const float4*)(md + c);
      acc[4 * j] = x4.x + m4.x * acc[4 * j]; acc[4 * j + 1] = x4.y + m4.y * acc[4 * j + 1]; acc[4 * j + 2] = x4.z + m4.z * acc[4 * j + 2]; acc[4 * j + 3] = x4.w + m4.w * acc[4 * j + 3];
      *(float4*)(dst + c) = make_float4(acc[4 * j], acc[4 * j + 1], acc[4 * j + 2], acc[4 * j + 3]);
      ss += acc[4 * j] * acc[4 * j] + acc[4 * j + 1] * acc[4 * j + 1] + acc[4 * j + 2] * acc[4 * j + 2] + acc[4 * j + 3] * acc[4 * j + 3]; }
    if (l == 0) {
      ss = seg_sum(ss, lane, 64); const float rstd = rsqrtf(ss * (1.f / D) + EPS);
      const float* m1 = MOD + ((size_t)9 + modidx(r)) * 6144;
#pragma unroll
      for (int j = 0; j < 4; ++j) { const int c = j * 256 + lane * 4; const float4 gg = *(const float4*)(g1n + c), s4 = *(const float4*)(m1 + 1024 + c), h4 = *(const float4*)(m1 + c);
        acc[4 * j] = acc[4 * j] * rstd * gg.x * (1.f + s4.x) + h4.x; acc[4 * j + 1] = acc[4 * j + 1] * rstd * gg.y * (1.f + s4.y) + h4.y; acc[4 * j + 2] = acc[4 * j + 2] * rstd * gg.z * (1.f + s4.z) + h4.z; acc[4 * j + 3] = acc[4 * j + 3] * rstd * gg.w * (1.f + s4.w) + h4.w; }
      quant_row_i8(acc, (signed char*)H + (size_t)r * D, (float*)(p.ws + WS_HS1) + r, lane);
    }
  }
}

namespace pg8 {
#define PG8_LAS __attribute__((address_space(3)))
typedef unsigned short bf16_t;
typedef short bf16x8 __attribute__((ext_vector_type(8)));
typedef float f32x4 __attribute__((ext_vector_type(4)));
typedef unsigned u32x4 __attribute__((ext_vector_type(4)));
typedef unsigned u32x2 __attribute__((ext_vector_type(2)));
typedef int i32x4v __attribute__((ext_vector_type(4)));
constexpr int BM = 256, BK = 64, HALF = 128, HTB = HALF * BK * 2, STAGE_BYTES = 8 * HTB;
__host__ __device__ __forceinline__ int lds_byte(int r, int c) { const int st = (r >> 4) * 2 + (c >> 5), rr = r & 15, cc = c & 31, ob = rr * 64 + cc * 2; return st * 1024 + (ob ^ (((ob >> 9) & 1) << 5)); }
__host__ __device__ __forceinline__ void stage_rc(int b, int& R, int& C) { const int st = b / 1024, sb = b % 1024, swz = sb ^ (((sb >> 9) & 1) << 5); R = (st >> 1) * 16 + swz / 64; C = (st & 1) * 32 + (swz % 64) / 2; }
__host__ __device__ __forceinline__ int perm32(int rho) { const int n = rho >> 4, i = rho & 15; return 8 * (i >> 2) + 4 * n + (i & 3); }
__device__ __forceinline__ unsigned cvt_pk_bf16(float lo, float hi) { unsigned r; asm volatile("v_cvt_pk_bf16_f32 %0, %1, %2" : "=v"(r) : "v"(lo), "v"(hi)); return r; }

struct Unit { int pm, pn, aux, nvalid; const char* A; const char* B; const int* rows; };

template <class Epi, class Sched, bool GATHER, bool I8 = false>
__device__ __forceinline__ void gemm_phase(PG8_LAS unsigned char* lds, const int lda_, const int K_, const Sched& S, const Epi& E) {
    const int lda = I8 ? lda_ / 2 : lda_, K = I8 ? K_ / 2 : K_;
    const int tid = opq_tid(), wid = __builtin_amdgcn_readfirstlane(tid >> 6), lane = tid & 63, wr = wid >> 2, wc = wid & 3, fr = lane & 15, fq = lane >> 4;
    const int nt = K / BK;
    unsigned voffA[2], voffB[2];
#pragma unroll
    for (int i = 0; i < 2; ++i) { int R, C; stage_rc(tid * 16 + i * 8192, R, C); const int Rb = Epi::PERM ? ((R & ~31) + perm32(R & 31)) : R;
        voffA[i] = GATHER ? (unsigned)(R * 65536 + C * 2) : (unsigned)(R * lda + C) * 2u; voffB[i] = (unsigned)(Rb * K + C) * 2u; }
    const size_t kstep = (size_t)(BK * 2);
    const size_t hstepA = GATHER ? 0 : (size_t)HALF * lda * 2, hstepB = (size_t)HALF * K * 2;
    const unsigned ldsw = (unsigned)wid * 1024u;
    const int aoff = lds_byte(wr * 64 + fr, fq * 8), boff = lds_byte(wc * 32 + fr, fq * 8);
#define PG8_SA(b, h) (((b) * 2 + (h)) * HTB)
#define PG8_SB(b, h) ((4 + (b) * 2 + (h)) * HTB)
#define PG8_STAGE(bufoff, gbase, voff) do { _Pragma("unroll") for (int _i = 0; _i < 2; ++_i) \
        __builtin_amdgcn_global_load_lds((const unsigned*)((const char*)(gbase) + (voff)[_i]), (PG8_LAS unsigned*)(lds + (bufoff) + ldsw + _i * 8192), 16, 0, 0); } while (0)
#define PG8_LDA(dst, b, h) do { _Pragma("unroll") for (int m = 0; m < 4; ++m) _Pragma("unroll") for (int k = 0; k < 2; ++k) dst[m][k] = *(const PG8_LAS bf16x8*)(lds + PG8_SA(b, h) + aoff + m * 2048 + k * 1024); } while (0)
#define PG8_LDB(dst, b, h) do { _Pragma("unroll") for (int n = 0; n < 2; ++n) _Pragma("unroll") for (int k = 0; k < 2; ++k) dst[n][k] = *(const PG8_LAS bf16x8*)(lds + PG8_SB(b, h) + boff + n * 2048 + k * 1024); } while (0)
#define PG8_MMA(ai, bj, At, Bt) do { __builtin_amdgcn_s_setprio(1); _Pragma("unroll") for (int m = 0; m < 4; ++m) _Pragma("unroll") for (int n = 0; n < 2; ++n) _Pragma("unroll") for (int k = 0; k < 2; ++k) { \
        if constexpr (I8) acc[ai][bj][m][n] = __builtin_bit_cast(f32x4, __builtin_amdgcn_mfma_i32_16x16x64_i8(__builtin_bit_cast(i32x4v, Bt[n][k]), __builtin_bit_cast(i32x4v, At[m][k]), __builtin_bit_cast(i32x4v, acc[ai][bj][m][n]), 0, 0, 0)); \
        else acc[ai][bj][m][n] = __builtin_amdgcn_mfma_f32_16x16x32_bf16(Bt[n][k], At[m][k], acc[ai][bj][m][n], 0, 0, 0); } __builtin_amdgcn_s_setprio(0); } while (0)
#define PG8_WAIT_V(n) asm volatile("s_waitcnt vmcnt(" #n ")" ::: "memory")
#define PG8_WAIT_L(n) asm volatile("s_waitcnt lgkmcnt(" #n ")" ::: "memory")
#define PG8_BAR __builtin_amdgcn_s_barrier()
#define PG8_SCHED __builtin_amdgcn_sched_barrier(0)
#define PG8_LOADROWS(dst, u) do { _Pragma("unroll") for (int h_ = 0; h_ < 2; ++h_) _Pragma("unroll") for (int i_ = 0; i_ < 2; ++i_) \
        { const int ri_ = h_ * HALF + (int)(voffA[i_] >> 16); dst[h_][i_] = (unsigned)((u).rows[ri_ < (u).nvalid ? ri_ : 0]) * (unsigned)(lda * 2) + (voffA[i_] & 0xffffu); } } while (0)
#define PG8_STAGE_A(bufoff, gbase, h, NEXT) do { if constexpr (GATHER) { PG8_STAGE(bufoff, gbase, ((NEXT) ? vn[h] : vc[h])); } else { PG8_STAGE(bufoff, (gbase) + (h) * hstepA, voffA); } } while (0)
    Unit cur, nxt; int ui = 0;
    if (!S.next(0, cur)) return;
    f32x4 acc[2][2][4][2];
#pragma unroll
    for (int a = 0; a < 2; ++a)
#pragma unroll
        for (int b = 0; b < 2; ++b)
#pragma unroll
            for (int m = 0; m < 4; ++m)
#pragma unroll
                for (int n = 0; n < 2; ++n) acc[a][b][m][n] = (f32x4){0.f, 0.f, 0.f, 0.f};
    bf16x8 At[4][2], B0[2][2], B1[2][2];
    unsigned vc[2][2], vn[2][2];
    if constexpr (GATHER) { PG8_LOADROWS(vc, cur);
#pragma unroll
        for (int h = 0; h < 2; ++h) { vn[h][0] = vc[h][0]; vn[h][1] = vc[h][1]; } }
    const char* cA = cur.A; const char* cB = cur.B;
    PG8_STAGE(PG8_SB(0, 0), cB, voffB); PG8_STAGE(PG8_SB(0, 1), cB + hstepB, voffB); PG8_STAGE_A(PG8_SA(0, 0), cA, 0, false); PG8_STAGE_A(PG8_SA(0, 1), cA, 1, false);
    if (wr == 1) PG8_BAR;
    PG8_WAIT_V(2); PG8_BAR;
    PG8_STAGE(PG8_SB(1, 0), cB + kstep, voffB); PG8_STAGE_A(PG8_SA(1, 0), cA + kstep, 0, false); PG8_STAGE(PG8_SB(1, 1), cB + hstepB + kstep, voffB);
    PG8_WAIT_V(6); PG8_BAR;
    for (;;) {
        const bool has_next = S.next(ui + 1, nxt);
        const char* nA = has_next ? nxt.A : cA; const char* nB = has_next ? nxt.B : cB;
        if constexpr (GATHER) { if (has_next) { PG8_LOADROWS(vn, nxt); } }
#pragma unroll 1
        for (int t = 0; t < nt; t += 2) {
            const bool last = (t == nt - 2);
            const char* a1 = cA + (size_t)(t + 1) * kstep;
            const char* a2 = last ? nA : cA + (size_t)(t + 2) * kstep; const char* b2 = last ? nB : cB + (size_t)(t + 2) * kstep;
            const char* a3 = a2 + kstep; const char* b3 = b2 + kstep;
            PG8_LDB(B0, 0, 0); PG8_LDB(B1, 0, 1); PG8_SCHED; PG8_LDA(At, 0, 0); PG8_STAGE_A(PG8_SA(1, 1), a1, 1, false);
            PG8_WAIT_V(8); PG8_WAIT_L(0); PG8_BAR; PG8_MMA(0, 0, At, B0); PG8_MMA(0, 1, At, B1); PG8_BAR; PG8_SCHED;
            PG8_LDA(At, 0, 1); PG8_STAGE(PG8_SB(0, 0), b2, voffB); PG8_STAGE(PG8_SB(0, 1), b2 + hstepB, voffB); PG8_STAGE_A(PG8_SA(0, 0), a2, 0, last);
            PG8_WAIT_V(8); PG8_WAIT_L(0); PG8_BAR; PG8_MMA(1, 0, At, B0); PG8_MMA(1, 1, At, B1); PG8_BAR; PG8_SCHED;
            PG8_LDB(B0, 1, 0); PG8_LDB(B1, 1, 1); PG8_SCHED; PG8_LDA(At, 1, 0); PG8_STAGE_A(PG8_SA(0, 1), a2, 1, last);
            PG8_WAIT_V(8); PG8_WAIT_L(0); PG8_BAR; PG8_MMA(0, 0, At, B0); PG8_MMA(0, 1, At, B1); PG8_BAR; PG8_SCHED;
            PG8_LDA(At, 1, 1); PG8_STAGE(PG8_SB(1, 0), b3, voffB); PG8_STAGE(PG8_SB(1, 1), b3 + hstepB, voffB); PG8_STAGE_A(PG8_SA(1, 0), a3, 0, last);
            PG8_WAIT_V(8); PG8_WAIT_L(0); PG8_BAR; PG8_MMA(1, 0, At, B0); PG8_MMA(1, 1, At, B1); PG8_BAR; PG8_SCHED;
        }
        if (wr == 0) PG8_BAR;
        { const int l2 = opq_tid() & 63; E(acc, cur, wr, wc, l2 & 15, l2 >> 4); }
        if (!has_next) break;
#pragma unroll
        for (int a = 0; a < 2; ++a)
#pragma unroll
            for (int b = 0; b < 2; ++b)
#pragma unroll
                for (int m = 0; m < 4; ++m)
#pragma unroll
                    for (int n = 0; n < 2; ++n) acc[a][b][m][n] = (f32x4){0.f, 0.f, 0.f, 0.f};
        cur = nxt; cA = nA; cB = nB; ++ui;
        if constexpr (GATHER) {
#pragma unroll
            for (int h = 0; h < 2; ++h) { vc[h][0] = vn[h][0]; vc[h][1] = vn[h][1]; } }
        if (wr == 1) PG8_BAR;
    }
    PG8_WAIT_V(0);
    PG8_BAR;
#undef PG8_STAGE_A
#undef PG8_SA
#undef PG8_SB
#undef PG8_STAGE
#undef PG8_LDA
#undef PG8_LDB
#undef PG8_MMA
#undef PG8_WAIT_V
#undef PG8_WAIT_L
#undef PG8_BAR
#undef PG8_SCHED
#undef PG8_LOADROWS
}
}

struct SchedDense {
    const char* A; const char* Bt; int nM, nN, G, c; size_t tstepA, tstepB; bool rev = false;
    DI void init(const void* A_, int lda, const void* Bt_, int K, int M, int N, int G_, int c_) { A = (const char*)A_; Bt = (const char*)Bt_; nM = M / 256; nN = N / 256; G = G_; c = c_; tstepA = (size_t)256 * lda * 2; tstepB = (size_t)256 * K * 2; }
    DI bool next(int i, pg8::Unit& u) const {
        const int L = i * G + c; if (L >= nM * nN) return false;
        const int nig = 8 * nN, gid = L / nig, fm = gid * 8, gsz = (nM - fm) < 8 ? (nM - fm) : 8, w = L - gid * nig;
        u.pm = fm + (w % gsz); if (rev) u.pm = nM - 1 - u.pm; u.pn = w / gsz; u.aux = 0; u.nvalid = 256; u.A = A + (size_t)u.pm * tstepA; u.B = Bt + (size_t)u.pn * tstepB; u.rows = nullptr; return true; }
};
struct SchedBranch {
    const char* A; const char* Bt; int nM, G, c;
    DI void init(const void* A_, const void* Bt_, int M, int G_, int c_) { A = (const char*)A_; Bt = (const char*)Bt_; nM = M / 256; G = G_; c = c_; }
    DI bool next(int i, pg8::Unit& u) const {
        const int L = i * G + c; if (L >= nM * 16) return false;
        u.pm = L >> 4; const int b = (L >> 2) & 3; u.pn = L & 3; u.aux = b; u.nvalid = 256;
        u.A = A + (size_t)u.pm * 256 * (D * 2) + b * 512; u.B = Bt + ((size_t)b * 1024 + u.pn * 256) * 512; u.rows = nullptr; return true; }
};
struct SchedMoe {
    bool rev = false; const char* A; const char* Bt; const int* rowtok; const int* off; const int* cnt; int nN, G, c, ntiles; size_t tstepA, estepB, tstepB; bool gather;
    DI bool next(int i, pg8::Unit& u) const {
        int rt, pn;
        if (G == 256) {
            const int v = i * 32 + (c >> 3), rl = v / nN; pn = v - rl * nN; rt = rl * 8 + (c & 7); if (rt >= ntiles) return false; }
        else { const int L = i * G + c; if (L >= ntiles * nN) return false; rt = L / nN; pn = L - rt * nN; }
        if (rev) rt = ntiles - 1 - rt;
        u.pm = rt; u.pn = pn; const int r0 = rt * 256; int e = 0;
#pragma unroll 1
        for (int k = 1; k < NE; ++k) e += (off[k] <= r0) ? 1 : 0;
        u.aux = e; u.A = gather ? A : A + (size_t)rt * tstepA; u.B = Bt + (size_t)e * estepB + (size_t)u.pn * tstepB;
        const int rin = r0 - off[e]; u.rows = rowtok + (size_t)e * T + rin; u.nvalid = cnt[e] - rin; return true; }
};

struct EpiStoreBf16 {
    static constexpr bool PERM = true;
    bf16* O; int ldc; int auxstride; const float* bias; int biasstride;
    DI void operator()(const pg8::f32x4 (&acc)[2][2][4][2], const pg8::Unit& u, int wr, int wc, int fr, int fq) const {
        const int row0 = u.pm * 256 + wr * 64 + fr, col0 = u.aux * auxstride + u.pn * 256 + wc * 32 + 8 * fq, bcol0 = u.pn * 256 + wc * 32 + 8 * fq;
        pg8::f32x4 bv[2][2];
#pragma unroll
        for (int bj = 0; bj < 2; ++bj)
#pragma unroll
            for (int n = 0; n < 2; ++n) bv[bj][n] = bias ? *(const pg8::f32x4*)(bias + (size_t)u.aux * biasstride + bcol0 + bj * 128 + 4 * n) : (pg8::f32x4){0.f, 0.f, 0.f, 0.f};
#pragma unroll
        for (int ai = 0; ai < 2; ++ai)
#pragma unroll
            for (int m = 0; m < 4; ++m) { bf16* rowp = O + (size_t)(row0 + ai * 128 + m * 16) * ldc + col0;
#pragma unroll
                for (int bj = 0; bj < 2; ++bj) { const pg8::f32x4 v0 = acc[ai][bj][m][0] + bv[bj][0], v1 = acc[ai][bj][m][1] + bv[bj][1];
                    pg8::u32x4 w; w.x = pg8::cvt_pk_bf16(v0[0], v0[1]); w.y = pg8::cvt_pk_bf16(v0[2], v0[3]); w.z = pg8::cvt_pk_bf16(v1[0], v1[1]); w.w = pg8::cvt_pk_bf16(v1[2], v1[3]);
                    *(pg8::u32x4*)(rowp + bj * 128) = w; } }
    }
};
DI float sigm_fast(float x) { return __builtin_amdgcn_rcpf(1.f + __builtin_amdgcn_exp2f(-LOG2E * x)); }
struct EpiMerge {
    static constexpr bool PERM = false;
    const bf16* YB; bf16* YM; const float* gb; const float* HS1; const float* GATES;
    DI void operator()(const pg8::f32x4 (&acc)[2][2][4][2], const pg8::Unit& u, int wr, int wc, int fr, int fq) const {
        const int row0 = u.pm * 256 + wr * 64 + fr, col = u.pn * 64 + wc * 16 + fq * 4;
        pg8::f32x4 bv[2][2];
#pragma unroll
        for (int bj = 0; bj < 2; ++bj)
#pragma unroll
            for (int n = 0; n < 2; ++n) bv[bj][n] = *(const pg8::f32x4*)(gb + (2 * bj + n) * 1024 + col);
#pragma unroll
        for (int ai = 0; ai < 2; ++ai)
#pragma unroll
            for (int m = 0; m < 4; ++m) { const size_t r = (size_t)(row0 + ai * 128 + m * 16); const float sa = HS1[r]; pg8::f32x4 y = (pg8::f32x4){0.f, 0.f, 0.f, 0.f};
#pragma unroll
                for (int bj = 0; bj < 2; ++bj)
#pragma unroll
                    for (int n = 0; n < 2; ++n) { const pg8::u32x2 yb = *(const pg8::u32x2*)(YB + r * 4096 + (2 * bj + n) * 1024 + col); const pg8::i32x4v iv = __builtin_bit_cast(pg8::i32x4v, acc[ai][bj][m][n]);
                        const pg8::f32x4 cs = *(const pg8::f32x4*)(GATES + u.pn * 256 + 128 * bj + 32 * wc + 16 * n + 4 * fq);
                        const pg8::f32x4 g = (pg8::f32x4){(float)iv[0] * sa * cs[0], (float)iv[1] * sa * cs[1], (float)iv[2] * sa * cs[2], (float)iv[3] * sa * cs[3]} + bv[bj][n];
                        y[0] += sigm_fast(g[0]) * __uint_as_float(yb.x << 16); y[1] += sigm_fast(g[1]) * __uint_as_float(yb.x & 0xffff0000u);
                        y[2] += sigm_fast(g[2]) * __uint_as_float(yb.y << 16); y[3] += sigm_fast(g[3]) * __uint_as_float(yb.y & 0xffff0000u); }
                pg8::u32x2 w; w.x = pg8::cvt_pk_bf16(y[0], y[1]); w.y = pg8::cvt_pk_bf16(y[2], y[3]); *(pg8::u32x2*)(YM + r * 1024 + col) = w; }
    }
};
struct EpiWo {
    static constexpr bool PERM = false;
    const float* xlat; const float* xctx; float* XF; const float* modg;
    DI void operator()(const pg8::f32x4 (&acc)[2][2][4][2], const pg8::Unit& u, int wr, int wc, int fr, int fq) const {
        const int row0 = u.pm * 256 + wr * 64 + fr, col0 = u.pn * 256 + wc * 32 + 4 * fq;
        const float* g = modg + (size_t)modidx(u.pm * 256) * 6144 + col0;
        pg8::f32x4 gv[2][2];
#pragma unroll
        for (int bj = 0; bj < 2; ++bj)
#pragma unroll
            for (int n = 0; n < 2; ++n) gv[bj][n] = *(const pg8::f32x4*)(g + bj * 128 + n * 16);
#pragma unroll
        for (int ai = 0; ai < 2; ++ai)
#pragma unroll
            for (int mp = 0; mp < 2; ++mp) { pg8::f32x4 t[2][2][2];
#pragma unroll
                for (int mm = 0; mm < 2; ++mm) { const int r = row0 + ai * 128 + (2 * mp + mm) * 16; const float* xs = (r < TL ? xlat + (size_t)r * D : xctx + (size_t)(r - TL) * D) + col0;
#pragma unroll
                    for (int bj = 0; bj < 2; ++bj)
#pragma unroll
                        for (int n = 0; n < 2; ++n) t[mm][bj][n] = *(const pg8::f32x4*)(xs + bj * 128 + n * 16); }
#pragma unroll
                for (int mm = 0; mm < 2; ++mm) { const int m = 2 * mp + mm; const int r = row0 + ai * 128 + m * 16; float* xo = XF + (size_t)r * D + col0;
#pragma unroll
                    for (int bj = 0; bj < 2; ++bj)
#pragma unroll
                        for (int n = 0; n < 2; ++n) *(pg8::f32x4*)(xo + bj * 128 + n * 16) = t[mm][bj][n] + gv[bj][n] * acc[ai][bj][m][n]; } }
    }
};
struct EpiProjFused {
    static constexpr bool PERM = true;
    bf16 *CU, *AQ, *DQ, *DK, *DV, *NQ, *NK, *NV, *KPE; float *QBD, *QBN; const float* ROPE;
    const float *cqg, *ckvg, *dqg, *dkg, *nqg, *nkg;
    float kbd, kbn, nbias; float* P;
    const float* HS1; const float* WINS;
    DI static float red4(float v, int lane) { v += lane_xor(v, lane, 16); v += lane_xor(v, lane, 32); return v; }
    DI static void st8(bf16* dst, const float (&x)[8]) { pg8::u32x4 w; w.x = pg8::cvt_pk_bf16(x[0], x[1]); w.y = pg8::cvt_pk_bf16(x[2], x[3]); w.z = pg8::cvt_pk_bf16(x[4], x[5]); w.w = pg8::cvt_pk_bf16(x[6], x[7]); *(pg8::u32x4*)dst = w; }
    DI void operator()(const pg8::f32x4 (&acc)[2][2][4][2], const pg8::Unit& u, int wr, int wc, int fr, int fq) const {
        const int t = u.pn, lane = fr + 16 * fq, row0 = u.pm * 256 + wr * 64 + fr; const bool lat = u.pm < TL / 256;
        float* SL = P + 2048;
        { const int te = (wr * 4 + wc) * 64 + lane; const float* src = te < 256 ? HS1 + u.pm * 256 + te : WINS + 256 * t + (te - 256); SL[te] = *src;
          asm volatile("s_waitcnt lgkmcnt(0)" ::: "memory"); __builtin_amdgcn_s_barrier(); asm volatile("" ::: "memory"); }
        const float* sap = SL + wr * 64 + fr; const float* sbp = SL + 256 + 32 * wc + 8 * fq;
#define GET8(ai, bj, m, x) do { const float sa_ = sap[(ai) * 128 + (m) * 16]; _Pragma("unroll") for (int n_ = 0; n_ < 2; ++n_) { const pg8::i32x4v iv_ = __builtin_bit_cast(pg8::i32x4v, acc[ai][bj][m][n_]); \
        const pg8::f32x4 sb_ = *(const pg8::f32x4*)(sbp + 128 * (bj) + 4 * n_); _Pragma("unroll") for (int j_ = 0; j_ < 4; ++j_) x[4 * n_ + j_] = (float)iv_[j_] * sa_ * sb_[j_]; } } while (0)
        if (t < 2) {
#pragma unroll
            for (int ai = 0; ai < 2; ++ai)
#pragma unroll
                for (int m = 0; m < 4; ++m) { float a[8], g[8], o[8]; GET8(ai, 0, m, a); GET8(ai, 1, m, g);
#pragma unroll
                    for (int i = 0; i < 8; ++i) o[i] = a[i] * sigm_fast(g[i]);
                    st8(CU + (size_t)(row0 + ai * 128 + m * 16) * 256 + 128 * t + 32 * wc + 8 * fq, o); }
        } else if (t < 5) {
#pragma unroll
            for (int bj = 0; bj < 2; ++bj) { const int ds = (t - 2) * 8 + bj * 4 + wc, head = ds / 6, kind = ds - head * 6;
                const bool isq = kind < 2, isv = kind >= 4; const float* gp = (isq ? dqg : dkg) + 8 * fq; float gg[8];
#pragma unroll
                for (int i = 0; i < 8; ++i) gg[i] = gp[i];
#pragma unroll
                for (int ai = 0; ai < 2; ++ai)
#pragma unroll
                    for (int m = 0; m < 4; ++m) { const int r = row0 + ai * 128 + m * 16; float x[8]; GET8(ai, bj, m, x);
                        if (isv) { st8(DV + (size_t)r * 256 + head * 64 + (kind - 4) * 32 + 8 * fq, x); continue; }
                        float ss = 0.f;
#pragma unroll
                        for (int i = 0; i < 8; ++i) ss += x[i] * x[i];
                        const float rs = rsqrtf(red4(ss, lane) * (1.f / 32.f) + EPS);
#pragma unroll
                        for (int i = 0; i < 8; ++i) x[i] = x[i] * rs * gg[i];
                        float pt[8];
#pragma unroll
                        for (int i = 0; i < 8; ++i) pt[i] = lane_xor(x[i], lane, 32);
                        if (lat) { const float* rp = ROPE + (size_t)(r & (SEQ - 1)) * 32 + 8 * (fq & 1); const bool first = fq < 2;
                            const pg8::f32x4 c0 = *(const pg8::f32x4*)rp, c1 = *(const pg8::f32x4*)(rp + 4), s0 = *(const pg8::f32x4*)(rp + 16), s1 = *(const pg8::f32x4*)(rp + 20);
#pragma unroll
                            for (int i = 0; i < 8; ++i) { const float cs = i < 4 ? c0[i & 3] : c1[i & 3], sn = i < 4 ? s0[i & 3] : s1[i & 3]; x[i] = first ? x[i] * cs - pt[i] * sn : x[i] * cs + pt[i] * sn; } }
                        if (isq) { float qn = 0.f;
#pragma unroll
                            for (int i = 0; i < 8; ++i) { x[i] *= 0.17677669529663687f * LOG2E; qn += x[i] * x[i]; }
                            qn = red4(qn, lane); if (fq == 0) QBD[(size_t)r * 8 + head * 2 + kind] = -(sqrtf(qn) * kbd + 0.05f); }
                        st8((isq ? DQ : DK) + (size_t)r * 256 + head * 64 + (kind & 1) * 32 + 8 * fq, x); } }
        } else if (t < 7) {
            const int pi = (t - 5) * 4 + wc, head = pi >> 1; const bool isq = (pi & 1) == 0; const float* gp = (isq ? nqg : nkg) + 8 * fq; float g0[8], g1[8];
#pragma unroll
            for (int i = 0; i < 8; ++i) { g0[i] = gp[i]; g1[i] = gp[32 + i]; }
#pragma unroll
            for (int ai = 0; ai < 2; ++ai)
#pragma unroll
                for (int m = 0; m < 4; ++m) { const int r = row0 + ai * 128 + m * 16; float x0[8], x1[8]; GET8(ai, 0, m, x0); GET8(ai, 1, m, x1); float ss = 0.f;
#pragma unroll
                    for (int i = 0; i < 8; ++i) ss += x0[i] * x0[i] + x1[i] * x1[i];
                    const float rs = rsqrtf(red4(ss, lane) * (1.f / 64.f) + EPS) * (isq ? 0.125f * LOG2E : 1.f); float qn = 0.f;
#pragma unroll
                    for (int i = 0; i < 8; ++i) { x0[i] = x0[i] * rs * g0[i]; x1[i] = x1[i] * rs * g1[i]; qn += x0[i] * x0[i] + x1[i] * x1[i]; }
                    if (isq) { qn = red4(qn, lane); if (fq == 0) QBN[(size_t)r * 4 + head] = -(sqrtf(qn) * kbn + nbias); }
                    bf16* dst = (isq ? NQ : NK) + (size_t)r * 256 + head * 64 + 8 * fq; st8(dst, x0); st8(dst + 32, x1); }
        } else if (t == 7) {
#pragma unroll
            for (int bj = 0; bj < 2; ++bj) { const int sl = bj * 4 + wc, head = sl >> 1, half = sl & 1;
#pragma unroll
                for (int ai = 0; ai < 2; ++ai)
#pragma unroll
                    for (int m = 0; m < 4; ++m) { float x[8]; GET8(ai, bj, m, x); st8(NV + (size_t)(row0 + ai * 128 + m * 16) * 256 + head * 64 + half * 32 + 8 * fq, x); } }
        } else {
            const int nsl = t == 8 ? 6 : 4;
#pragma unroll
            for (int bj = 0; bj < 2; ++bj) { const int sl = bj * 4 + wc;
#pragma unroll
                for (int ai = 0; ai < 2; ++ai)
#pragma unroll
                    for (int m = 0; m < 4; ++m) { float x[8]; GET8(ai, bj, m, x); float ss = 0.f;
#pragma unroll
                        for (int i = 0; i < 8; ++i) ss += x[i] * x[i];
                        ss = red4(ss, lane); if (fq == 0) P[(ai * 128 + wr * 64 + m * 16 + fr) * 8 + sl] = sl < nsl ? ss : 0.f; } }
            asm volatile("s_waitcnt lgkmcnt(0)" ::: "memory"); __builtin_amdgcn_s_barrier(); asm volatile("" ::: "memory");
#pragma unroll
            for (int bj = 0; bj < 2; ++bj) { const int sl = bj * 4 + wc; const float* gp = (t == 8 ? cqg : ckvg) + 32 * (sl < nsl ? sl : 0) + 8 * fq; float gg[8];
#pragma unroll
                for (int i = 0; i < 8; ++i) gg[i] = gp[i];
#pragma unroll
                for (int ai = 0; ai < 2; ++ai)
#pragma unroll
                    for (int m = 0; m < 4; ++m) { const int rl = ai * 128 + wr * 64 + m * 16 + fr, r = u.pm * 256 + rl; float x[8]; GET8(ai, bj, m, x);
                        const pg8::f32x4 p0 = *(const pg8::f32x4*)(P + rl * 8), p1 = *(const pg8::f32x4*)(P + rl * 8 + 4);
                        const float tot = (p0[0] + p0[1]) + (p0[2] + p0[3]) + (p1[0] + p1[1]) + (p1[2] + p1[3]);
                        const float rs = rsqrtf(tot * (t == 8 ? 1.f / 192.f : 1.f / 128.f) + EPS);
                        if (sl < nsl) {
#pragma unroll
                            for (int i = 0; i < 8; ++i) x[i] = x[i] * rs * gg[i];
                            st8(AQ + (size_t)r * 384 + (t == 8 ? 0 : 192) + 32 * sl + 8 * fq, x); }
                        else if (t == 8 && sl == 6) st8(KPE + (size_t)r * 32 + 8 * fq, x);
                        else if (t == 9 && sl < 6) {
#pragma unroll
                            for (int i = 0; i < 8; ++i) x[i] = 0.f;
                            st8(AQ + (size_t)r * 384 + 320 + 32 * (sl - 4) + 8 * fq, x); } } }
            asm volatile("s_waitcnt lgkmcnt(0)" ::: "memory"); __builtin_amdgcn_s_barrier(); asm volatile("" ::: "memory");
        }
#undef GET8
    }
};
struct EpiQkvFused {
    static constexpr bool PERM = true;
    bf16 *MQ, *MK, *MV; const bf16* KPE; float* QBM; const float* ROPE; const float *gq, *gk; float nbconst; float* P;
    DI static float red4(float v, int lane) { v += lane_xor(v, lane, 16); v += lane_xor(v, lane, 32); return v; }
    DI static void st8(bf16* dst, const float (&x)[8]) { pg8::u32x4 w; w.x = pg8::cvt_pk_bf16(x[0], x[1]); w.y = pg8::cvt_pk_bf16(x[2], x[3]); w.z = pg8::cvt_pk_bf16(x[4], x[5]); w.w = pg8::cvt_pk_bf16(x[6], x[7]); *(pg8::u32x4*)dst = w; }
    DI void rope8(float (&x)[8], int r, int fq, int lane) const {
        float pt[8];
#pragma unroll
        for (int i = 0; i < 8; ++i) pt[i] = lane_xor(x[i], lane, 32);
        const float* rp = ROPE + (size_t)(r & (SEQ - 1)) * 32 + 8 * (fq & 1); const bool first = fq < 2;
        const pg8::f32x4 c0 = *(const pg8::f32x4*)rp, c1 = *(const pg8::f32x4*)(rp + 4), s0 = *(const pg8::f32x4*)(rp + 16), s1 = *(const pg8::f32x4*)(rp + 20);
#pragma unroll
        for (int i = 0; i < 8; ++i) { const float cs = i < 4 ? c0[i & 3] : c1[i & 3], sn = i < 4 ? s0[i & 3] : s1[i & 3]; x[i] = first ? x[i] * cs - pt[i] * sn : x[i] * cs + pt[i] * sn; }
    }
    DI void operator()(const pg8::f32x4 (&acc)[2][2][4][2], const pg8::Unit& u, int wr, int wc, int fr, int fq) const {
        const int t = u.pn, lane = fr + 16 * fq, row0 = u.pm * 256 + wr * 64 + fr; const bool lat = u.pm < TL / 256;
#define GET8(ai, bj, m, x) do { _Pragma("unroll") for (int n_ = 0; n_ < 2; ++n_) _Pragma("unroll") for (int j_ = 0; j_ < 4; ++j_) x[4 * n_ + j_] = acc[ai][bj][m][n_][j_]; } while (0)
        if (t < 2) {
#pragma unroll
            for (int bj = 0; bj < 2; ++bj)
#pragma unroll
                for (int ai = 0; ai < 2; ++ai)
#pragma unroll
                    for (int m = 0; m < 4; ++m) { float x[8]; GET8(ai, bj, m, x); float ss = 0.f;
#pragma unroll
                        for (int i = 0; i < 8; ++i) ss += x[i] * x[i];
                        ss = red4(ss, lane); if (fq == 0) P[(ai * 128 + wr * 64 + m * 16 + fr) * 8 + bj * 4 + wc] = wc < 3 ? ss : 0.f; }
            asm volatile("s_waitcnt lgkmcnt(0)" ::: "memory"); __builtin_amdgcn_s_barrier(); asm volatile("" ::: "memory");
            if (wc < 3) {
#pragma unroll
                for (int bj = 0; bj < 2; ++bj) { const int head = 2 * t + bj; const float* gp = gq + 32 * wc + 8 * fq; asm volatile("" : "+v"(gp)); float gg[8];
#pragma unroll
                    for (int i = 0; i < 8; ++i) gg[i] = gp[i];
#pragma unroll
                    for (int ai = 0; ai < 2; ++ai)
#pragma unroll
                        for (int m = 0; m < 4; ++m) { const int rl = ai * 128 + wr * 64 + m * 16 + fr, r = u.pm * 256 + rl; float x[8]; GET8(ai, bj, m, x);
                            const pg8::f32x4 pp = *(const pg8::f32x4*)(P + rl * 8 + bj * 4);
                            const float rs = rsqrtf((pp[0] + pp[1] + pp[2]) * (1.f / 96.f) + EPS);
#pragma unroll
                            for (int i = 0; i < 8; ++i) x[i] = x[i] * rs * gg[i];
                            if (wc == 2 && lat) rope8(x, r, fq, lane);
#pragma unroll
                            for (int i = 0; i < 8; ++i) x[i] *= 0.10206207261596577f * LOG2E;
                            st8(MQ + (size_t)r * 384 + head * 96 + 32 * wc + 8 * fq, x);
                            if (wc == 0 && fq == 0) QBM[(size_t)r * 4 + head] = nbconst; } }
            }
            asm volatile("s_waitcnt lgkmcnt(0)" ::: "memory"); __builtin_amdgcn_s_barrier(); asm volatile("" ::: "memory");
        } else if (wc < 2) {
            const int head = 2 * (t - 2) + wc;
#pragma unroll
            for (int ai = 0; ai < 2; ++ai)
#pragma unroll
                for (int m = 0; m < 4; ++m) { const int r = row0 + ai * 128 + m * 16; float xp[8];
                    { const uint4 kq = *(const uint4*)(KPE + (size_t)r * 32 + 8 * fq); const unsigned w[4] = {kq.x, kq.y, kq.z, kq.w};
#pragma unroll
                      for (int i = 0; i < 4; ++i) { xp[2 * i] = __uint_as_float(w[i] << 16); xp[2 * i + 1] = __uint_as_float(w[i] & 0xffff0000u); } }
                    float ss = 0.f;
#pragma unroll
                    for (int n = 0; n < 2; ++n)
#pragma unroll
                        for (int j = 0; j < 4; ++j) ss += acc[ai][0][m][n][j] * acc[ai][0][m][n][j] + acc[ai][1][m][n][j] * acc[ai][1][m][n][j] + xp[4 * n + j] * xp[4 * n + j];
                    const float rs = rsqrtf(red4(ss, lane) * (1.f / 96.f) + EPS);
                    const float* gp = gk + 8 * fq; asm volatile("" : "+v"(gp));
                    bf16* dst = MK + (size_t)r * 384 + head * 96 + 8 * fq;
#pragma unroll
                    for (int bj = 0; bj < 2; ++bj) { float x[8]; GET8(ai, bj, m, x);
#pragma unroll
                        for (int i = 0; i < 8; ++i) x[i] = x[i] * rs * gp[32 * bj + i];
                        st8(dst + 32 * bj, x); }
#pragma unroll
                    for (int i = 0; i < 8; ++i) xp[i] = xp[i] * rs * gp[64 + i];
                    if (lat) rope8(xp, r, fq, lane);
                    st8(dst + 64, xp); }
        } else {
            const int head = 2 * (t - 2) + wc - 2;
#pragma unroll
            for (int bj = 0; bj < 2; ++bj)
#pragma unroll
                for (int ai = 0; ai < 2; ++ai)
#pragma unroll
                    for (int m = 0; m < 4; ++m) { float x[8]; GET8(ai, bj, m, x); st8(MV + (size_t)(row0 + ai * 128 + m * 16) * 256 + head * 64 + 32 * bj + 8 * fq, x); }
        }
#undef GET8
    }
};
struct EpiMoeActI8 {
    static constexpr bool PERM = true;
    bf16* ACT; const float* bgu; const float* HS; const float* WGUS;
    DI void operator()(const pg8::f32x4 (&acc)[2][2][4][2], const pg8::Unit& u, int wr, int wc, int fr, int fq) const {
        const int rl0 = wr * 64 + fr, row0 = u.pm * 256 + rl0, col0 = u.pn * 128 + wc * 32 + 8 * fq;
        const float* b = bgu + (size_t)u.aux * 2048 + col0;
        const pg8::f32x4 bg0 = *(const pg8::f32x4*)(b), bg1 = *(const pg8::f32x4*)(b + 4), bu0 = *(const pg8::f32x4*)(b + 1024), bu1 = *(const pg8::f32x4*)(b + 1028);
        const float* cs = WGUS + (size_t)u.aux * 2048 + u.pn * 256 + wc * 32 + 8 * fq;
        const pg8::f32x4 sg0 = *(const pg8::f32x4*)(cs), sg1 = *(const pg8::f32x4*)(cs + 4), su0 = *(const pg8::f32x4*)(cs + 128), su1 = *(const pg8::f32x4*)(cs + 132);
        int tk[2][4]; float sas[2][4];
#pragma unroll
        for (int ai = 0; ai < 2; ++ai)
#pragma unroll
            for (int m = 0; m < 4; ++m) { const int rl = rl0 + ai * 128 + m * 16; tk[ai][m] = u.rows[rl < u.nvalid ? rl : 0]; }
#pragma unroll
        for (int ai = 0; ai < 2; ++ai)
#pragma unroll
            for (int m = 0; m < 4; ++m) sas[ai][m] = HS[tk[ai][m]];
#pragma unroll
        for (int ai = 0; ai < 2; ++ai)
#pragma unroll
            for (int m = 0; m < 4; ++m) { const float sa = sas[ai][m]; float a[8];
#pragma unroll
                for (int n = 0; n < 2; ++n) { const pg8::i32x4v ig = __builtin_bit_cast(pg8::i32x4v, acc[ai][0][m][n]), iu = __builtin_bit_cast(pg8::i32x4v, acc[ai][1][m][n]);
#pragma unroll
                    for (int j = 0; j < 4; ++j) { const float gg = (float)ig[j] * sa * (n ? sg1[j] : sg0[j]) + (n ? bg1[j] : bg0[j]), uu = (float)iu[j] * sa * (n ? su1[j] : su0[j]) + (n ? bu1[j] : bu0[j]);
                        const float g = fminf(gg, 7.f), uc = fminf(fmaxf(uu, -7.f), 7.f); a[4 * n + j] = (uc + 1.f) * (g * sigm_fast(1.702f * g)); } }
                pg8::u32x4 w; w.x = pg8::cvt_pk_bf16(a[0], a[1]); w.y = pg8::cvt_pk_bf16(a[2], a[3]); w.z = pg8::cvt_pk_bf16(a[4], a[5]); w.w = pg8::cvt_pk_bf16(a[6], a[7]);
                *(pg8::u32x4*)(ACT + (size_t)(row0 + ai * 128 + m * 16) * D + col0) = w; }
    }
};
struct EpiMoeAct {
    static constexpr bool PERM = true;
    bf16* ACT; const float* bgu;
    DI void operator()(const pg8::f32x4 (&acc)[2][2][4][2], const pg8::Unit& u, int wr, int wc, int fr, int fq) const {
        const int row0 = u.pm * 256 + wr * 64 + fr, col0 = u.pn * 128 + wc * 32 + 8 * fq;
        const float* b = bgu + (size_t)u.aux * 2048 + col0;
        const pg8::f32x4 bg0 = *(const pg8::f32x4*)(b), bg1 = *(const pg8::f32x4*)(b + 4), bu0 = *(const pg8::f32x4*)(b + 1024), bu1 = *(const pg8::f32x4*)(b + 1028);
#pragma unroll
        for (int ai = 0; ai < 2; ++ai)
#pragma unroll
            for (int m = 0; m < 4; ++m) { float a[8];
#pragma unroll
                for (int n = 0; n < 2; ++n) { const pg8::f32x4 gg = acc[ai][0][m][n] + (n ? bg1 : bg0), uu = acc[ai][1][m][n] + (n ? bu1 : bu0);
#pragma unroll
                    for (int j = 0; j < 4; ++j) { const float g = fminf(gg[j], 7.f), uc = fminf(fmaxf(uu[j], -7.f), 7.f); a[4 * n + j] = (uc + 1.f) * (g * sigm_fast(1.702f * g)); } }
                pg8::u32x4 w; w.x = pg8::cvt_pk_bf16(a[0], a[1]); w.y = pg8::cvt_pk_bf16(a[2], a[3]); w.z = pg8::cvt_pk_bf16(a[4], a[5]); w.w = pg8::cvt_pk_bf16(a[6], a[7]);
                *(pg8::u32x4*)(ACT + (size_t)(row0 + ai * 128 + m * 16) * D + col0) = w; }
    }
};

struct MapId { int off; DI int operator()(int n) const { return n + off; } };
struct MapProj { DI int operator()(int s) const {
    int t, slot;
    if (s < 512) { const int isg = s >> 8, ch = s & 255; t = ch >> 7; slot = isg * 4 + ((ch >> 5) & 3); }
    else if (s < OFF_C) { const int m = s - OFF_B; if (m < 192) { t = 8; slot = m >> 5; } else if (m < 320) { t = 9; slot = (m - 192) >> 5; } else { t = 8; slot = 6; } }
    else if (s < OFF_D) { const int m = s - OFF_C, head = m / 192, w = m - head * 192, ds = head * 6 + (w >> 5); t = 2 + (ds >> 3); slot = ds & 7; }
    else { const int m = s - OFF_D, head = m / 192, w = m - head * 192;
      if (w < 128) { const int pi = head * 2 + (w >> 6); t = 5 + (pi >> 2); slot = ((w >> 5) & 1) * 4 + (pi & 3); } else { t = 7; slot = head * 2 + ((w - 128) >> 5); } }
    return 256 * t + (slot >> 2) * 128 + (slot & 3) * 32 + (s & 31); } };
struct MapQ  { DI int operator()(int s) const { const int head = s / 96, w = s - head * 96; return 256 * (head >> 1) + 128 * (head & 1) + 32 * (w >> 5) + (s & 31); } };
struct MapKV { DI int operator()(int s) const { const int head = s >> 7, w = s & 127, isv = w >> 6, half = (w >> 5) & 1; return 256 * (2 + (head >> 1)) + 128 * half + 32 * (2 * isv + (head & 1)) + (s & 31); } };
struct MapGate { DI int operator()(int s) const { const int b = s >> 10, w = s & 1023, pn = w >> 6, lc = w & 63; return 256 * pn + 128 * (b >> 1) + 32 * (lc >> 4) + 16 * (b & 1) + (lc & 15); } };
struct MapGu { DI int operator()(int s) const { const int isu = s >> 10, c = s & 1023; return 256 * (c >> 7) + 128 * isu + (c & 127); } };
struct CvtItem { const float* W; bf16* WT; int N, ldk, kdst0, mapt, mapoff, item; };
DI CvtItem cvt_decode(PRef p, int it) {
    constexpr int I_WIN_ = (D / 64) * (INW / 32), I_UQ_ = 3 * 12, I_UKV_ = 2 * 16, I_BR_ = 4 * 32, I_GATE_ = 16 * 128, I_WO_ = 16 * 32, I_GU_ = 16 * 64, I_DN_ = 16 * 32;
    constexpr int PER_L = I_UQ_ + I_UKV_ + 4 * I_BR_ + I_WO_ + NE * I_DN_;
    unsigned char* ws = p.ws; CvtItem c; (void)I_WIN_; (void)I_GATE_; c.mapt = 0; c.mapoff = 0; c.kdst0 = 0;
    const int l = it / PER_L; int r = it - l * PER_L;
    if (r < I_UQ_) { c.W = p.in[I_WUQ] + (size_t)l * 192 * 384; c.N = 384; c.WT = (bf16*)(ws + WS_QKV_T) + (size_t)l * 1024 * 384; c.ldk = 384; c.mapt = 4; c.item = r; return c; } r -= I_UQ_;
    if (r < I_UKV_) { c.W = p.in[I_WUKV] + (size_t)l * 128 * 512; c.N = 512; c.WT = (bf16*)(ws + WS_QKV_T) + (size_t)l * 1024 * 384; c.ldk = 384; c.kdst0 = 192; c.mapt = 5; c.item = r; return c; } r -= I_UKV_;
    if (r < 4 * I_BR_) { const int b = r / I_BR_; c.W = (b == 0 ? p.in[I_CONVOUT] : b == 1 ? p.in[I_MLAOUT] : b == 2 ? p.in[I_DIFFOUT] : p.in[I_NAOUT]) + (size_t)l * 256 * D; c.N = D;
        c.WT = (bf16*)(ws + WS_WB_T) + ((size_t)l * 4 + b) * 1024 * 256; c.ldk = 256; c.item = r - b * I_BR_; return c; } r -= 4 * I_BR_;
    if (r < I_WO_) { c.W = p.in[I_WO] + (size_t)l * D * D; c.N = D; c.WT = (bf16*)(ws + WS_WO_T) + (size_t)l * D * D; c.ldk = D; c.item = r; return c; } r -= I_WO_;
    const int e = r / I_DN_; r -= e * I_DN_; (void)I_GU_;
    c.W = p.in[I_WDN] + ((size_t)l * NE + e) * DFF * D; c.N = D; c.WT = (bf16*)(ws + WS_WDN_T) + ((size_t)l * NE + e) * D * DFF; c.ldk = DFF; c.item = r; return c;
}
DI void cvt_load(const CvtItem& c, float (&v)[32], int lane) {
    const int nblk = c.N / 32, kb = c.item / nblk, nb = c.item - kb * nblk;
    const float* src = c.W + (size_t)(64 * kb + (lane >> 5)) * c.N + 32 * nb + (lane & 31);
#pragma unroll
    for (int i = 0; i < 32; ++i) v[i] = src[(size_t)(2 * i) * c.N];
}
DI void cvt_store(const CvtItem& c, const float (&v)[32], float* scr, int lane) {
    const int nblk = c.N / 32, kb = c.item / nblk, nb = c.item - kb * nblk, k0 = 64 * kb, n0 = 32 * nb;
#pragma unroll
    for (int i = 0; i < 32; ++i) scr[(2 * i + (lane >> 5)) * 33 + (lane & 31)] = v[i];
    asm volatile("s_waitcnt lgkmcnt(0)" ::: "memory");
    const int cc = lane & 7;
#pragma unroll
    for (int j = 0; j < 4; ++j) { const int n = (lane >> 3) + 8 * j; const float* s = scr + (8 * cc) * 33 + n;
        pg8::u32x4 o; o.x = pg8::cvt_pk_bf16(s[0 * 33], s[1 * 33]); o.y = pg8::cvt_pk_bf16(s[2 * 33], s[3 * 33]); o.z = pg8::cvt_pk_bf16(s[4 * 33], s[5 * 33]); o.w = pg8::cvt_pk_bf16(s[6 * 33], s[7 * 33]);
        const int sn = n0 + n; const int row = c.mapt == 0 ? sn + c.mapoff : (c.mapt == 1 ? MapGate()(sn) : (c.mapt == 2 ? MapGu()(sn) : (c.mapt == 3 ? MapProj()(sn) : (c.mapt == 4 ? MapQ()(sn) : MapKV()(sn)))));
        *(pg8::u32x4*)(c.WT + (size_t)row * c.ldk + c.kdst0 + k0 + 8 * cc) = o; }
    asm volatile("s_waitcnt lgkmcnt(0)" ::: "memory");
}
DI void ph_convert(PRef p, unsigned char* lds) {
    const int tid_ = opq_tid(); const int bid_ = opq_bid(), nblk_ = opq_nblk(); const int lane = tid_ & 63, wave = __builtin_amdgcn_readfirstlane(tid_ >> 6);
    float* scr = (float*)(lds + wave * 8704);
    const int gw = bid_ * 8 + wave, ngw = nblk_ * 8;
    constexpr int PER_L = 3 * 12 + 2 * 16 + 4 * 4 * 32 + 16 * 32 + NE * (16 * 32);
    const int total = 2 * PER_L;
    float va[32], vb[32];
    int it = gw;
    CvtItem ca, cb;
    if (it < total) { ca = cvt_decode(p, it); cvt_load(ca, va, lane); }
    for (; it < total; it += 2 * ngw) {
        const int i1 = it + ngw, i2 = it + 2 * ngw;
        if (i1 < total) { cb = cvt_decode(p, i1); cvt_load(cb, vb, lane); }
        cvt_store(ca, va, scr, lane);
        if (i2 < total) { ca = cvt_decode(p, i2); cvt_load(ca, va, lane); }
        if (i1 < total) cvt_store(cb, vb, scr, lane);
    }
    __syncthreads();
    { float* red = (float*)lds;
      const int n = tid_ & 31, kg = tid_ >> 5; signed char* W8 = (signed char*)(p.ws + WS_WGU_T); float* WS_ = (float*)(p.ws + WS_WGUS);
      float xa[64], xb[64];
#define I8_DECODE(it, src_, N_, dst_, sca_, kind_, nb_) const float* src_; int N_, kind_, nb_; signed char* dst_; float* sca_; \
        if ((it) < 4096) { const int le_ = (it) >> 6; nb_ = (it) & 63; src_ = p.in[I_WGU] + (size_t)le_ * D * 2048; N_ = 2048; dst_ = W8 + (size_t)le_ * 2048 * D * 2; sca_ = WS_ + (size_t)le_ * 2048; kind_ = 0; } \
        else if ((it) < 4096 + 150) { const int l_ = ((it) - 4096) / 75; nb_ = ((it) - 4096) - l_ * 75; src_ = p.in[I_WIN] + (size_t)l_ * D * INW; N_ = INW; dst_ = (signed char*)(p.ws + WS_WIN_T) + (size_t)l_ * PLD * D * 2; sca_ = (float*)(p.ws + WS_WINS) + l_ * PLD; kind_ = 1; } \
        else { const int l_ = ((it) - 4246) >> 7; nb_ = ((it) - 4246) & 127; src_ = p.in[I_GATEW] + (size_t)l_ * D * 4096; N_ = 4096; dst_ = (signed char*)(p.ws + WS_GATE_T) + (size_t)l_ * 4096 * D * 2; sca_ = (float*)(p.ws + WS_GATES) + l_ * 4096; kind_ = 2; }
#define GU_LOAD(dst, it) do { I8_DECODE(it, src_, N_, d8_, sc8_, kind_, nb_); (void)d8_; (void)sc8_; (void)kind_; const float* s2_ = src_ + (size_t)(64 * kg) * N_ + 32 * nb_ + n; \
        _Pragma("unroll") for (int i = 0; i < 64; ++i) dst[i] = s2_[(size_t)i * N_]; } while (0)
#define GU_EMIT(src, it) do { I8_DECODE(it, src_, N_, d8_, sc8_, kind_, nb_); (void)src_; float m_ = 0.f; _Pragma("unroll") for (int i = 0; i < 64; ++i) m_ = fmaxf(m_, fabsf(src[i])); \
        red[kg * 32 + n] = m_; __syncthreads(); \
        if (tid_ < 32) { float mm_ = 0.f; _Pragma("unroll") for (int g = 0; g < 16; ++g) mm_ = fmaxf(mm_, red[g * 32 + tid_]); red[512 + tid_] = mm_ > 0.f ? mm_ * (1.f / 127.f) : 1.f; } \
        __syncthreads(); const float sc_ = red[512 + n], inv_ = 1.f / sc_; const int col_ = 32 * nb_ + n; const int row_ = kind_ == 0 ? MapGu()(col_) : (kind_ == 1 ? MapProj()(col_) : MapGate()(col_)); \
        if (kg == 0) sc8_[row_] = sc_; \
        signed char* dst_ = d8_ + (size_t)row_ * D + 64 * kg; \
        _Pragma("unroll") for (int q = 0; q < 4; ++q) { unsigned w_[4]; _Pragma("unroll") for (int d = 0; d < 4; ++d) { unsigned b_ = 0; _Pragma("unroll") for (int i = 0; i < 4; ++i) { \
            const int v_ = (int)rintf(src[16 * q + 4 * d + i] * inv_); b_ |= ((unsigned)v_ & 255u) << (8 * i); } w_[d] = b_; } \
            *(uint4*)(dst_ + 16 * q) = make_uint4(w_[0], w_[1], w_[2], w_[3]); } \
        __syncthreads(); } while (0)
      const int nit = 2 * NE * 64 + 150 + 256; int it2 = bid_;
      if (it2 < nit) GU_LOAD(xa, it2);
      for (; it2 < nit; it2 += 2 * nblk_) { const int j1 = it2 + nblk_, j2 = it2 + 2 * nblk_;
        if (j1 < nit) GU_LOAD(xb, j1);
        GU_EMIT(xa, it2);
        if (j2 < nit) GU_LOAD(xa, j2);
        if (j1 < nit) GU_EMIT(xb, j1); }
#undef GU_LOAD
#undef GU_EMIT
#undef I8_DECODE
    }
}

#define LDSP ((PG8_LAS unsigned char*)lds)
DI void ph_proj_fast(PRef p, int l, unsigned char* lds) {
    const int bid_ = opq_bid(), nblk_ = opq_nblk(); const int tid0 = opq_tid(), lane0 = tid0 & 63;
    SchedDense S; S.init(p.ws + WS_H, D / 2, (const bf16*)(p.ws + WS_WIN_T) + (size_t)l * PLD * D, D / 2, T, PLD, nblk_, bid_);
    EpiProjFused E;
    E.CU = (bf16*)(p.ws + WS_CU); E.AQ = (bf16*)(p.ws + WS_AQ); E.DQ = (bf16*)(p.ws + WS_DQ); E.DK = (bf16*)(p.ws + WS_DK); E.DV = (bf16*)(p.ws + WS_DV);
    E.NQ = (bf16*)(p.ws + WS_NQ); E.NK = (bf16*)(p.ws + WS_NK); E.NV = (bf16*)(p.ws + WS_NV); E.KPE = (bf16*)(p.ws + WS_KPE);
    E.QBD = (float*)(p.ws + WS_QBD); E.QBN = (float*)(p.ws + WS_QBN); E.ROPE = (const float*)(p.ws + WS_ROPE);
    E.cqg = p.in[I_CQG] + l * 192; E.ckvg = p.in[I_CKVG] + l * 128; E.dqg = p.in[I_DQNG] + l * 32; E.dkg = p.in[I_DKNG] + l * 32; E.nqg = p.in[I_NQNG] + l * 64; E.nkg = p.in[I_NKNG] + l * 64;
    { float m = lane0 < 32 ? fabsf(p.in[I_DKNG][l * 32 + lane0]) : 0.f;
#pragma unroll
      for (int o = 1; o < 64; o <<= 1) m = fmaxf(m, lane_xor(m, lane0, o));
      float m2 = fabsf(p.in[I_NKNG][l * 64 + lane0]);
#pragma unroll
      for (int o = 1; o < 64; o <<= 1) m2 = fmaxf(m2, lane_xor(m2, lane0, o));
      float t0 = 5.656854249f * 1.004f * m, t1 = 8.f * 1.004f * m2, t2 = __int_as_float(((const int*)(p.ws + WS_CTL))[CW_BIASMAX + l]) * LOG2E + 0.05f;
      asm volatile("" : "+v"(t0), "+v"(t1), "+v"(t2));
      const int b0 = __builtin_amdgcn_readfirstlane(__float_as_int(t0)), b1 = __builtin_amdgcn_readfirstlane(__float_as_int(t1)), b2 = __builtin_amdgcn_readfirstlane(__float_as_int(t2));
      E.kbd = __int_as_float(b0); E.kbn = __int_as_float(b1); E.nbias = __int_as_float(b2); }
    E.P = (float*)(lds + 131072 + 4096); E.HS1 = (const float*)(p.ws + WS_HS1); E.WINS = (const float*)(p.ws + WS_WINS) + l * PLD;
    pg8::gemm_phase<EpiProjFused, SchedDense, false, true>(LDSP, D, D, S, E);
}
DI void ph_qkvraw_fast(PRef p, int l, unsigned char* lds) {
    const int bid_ = opq_bid(), nblk_ = opq_nblk(); const int lane0 = opq_tid() & 63;
    SchedDense S; S.init(p.ws + WS_AQ, 384, (const bf16*)(p.ws + WS_QKV_T) + (size_t)l * 1024 * 384, 384, T, 1024, nblk_, bid_);
    EpiQkvFused E; E.MQ = (bf16*)(p.ws + WS_MQ); E.MK = (bf16*)(p.ws + WS_MK); E.MV = (bf16*)(p.ws + WS_MV); E.KPE = (const bf16*)(p.ws + WS_KPE); E.QBM = (float*)(p.ws + WS_QBM);
    E.ROPE = (const float*)(p.ws + WS_ROPE); E.gq = p.in[I_QNG] + l * 96; E.gk = p.in[I_KNG] + l * 96; E.P = (float*)(lds + 131072 + 4096);
    { float mq = 0.f, mk = 0.f;
      for (int i = lane0; i < 96; i += 64) { mq = fmaxf(mq, fabsf(E.gq[i])); mk = fmaxf(mk, fabsf(E.gk[i])); }
#pragma unroll
      for (int o = 1; o < 64; o <<= 1) { mq = fmaxf(mq, lane_xor(mq, lane0, o)); mk = fmaxf(mk, lane_xor(mk, lane0, o)); }
      E.nbconst = __int_as_float(__builtin_amdgcn_readfirstlane(__float_as_int(-(96.f * 0.10206207261596577f * LOG2E * mq * mk * 1.004f + 0.05f)))); }
    pg8::gemm_phase<EpiQkvFused, SchedDense, false>(LDSP, 384, 384, S, E);
}
DI void ph_branch_fast(PRef p, int l, int nrows, unsigned char* lds) {
    const int bid_ = opq_bid(), nblk_ = opq_nblk();
    SchedBranch S; S.init(p.ws + WS_BI, (const bf16*)(p.ws + WS_WB_T) + (size_t)l * 4 * 1024 * 256, nrows, nblk_, bid_);
    EpiStoreBf16 E{(bf16*)(p.ws + WS_YB), 4096, 1024, nullptr, 0};
    pg8::gemm_phase<EpiStoreBf16, SchedBranch, false>(LDSP, D, 256, S, E);
}
DI void ph_merge_fast(PRef p, int l, int nrows, unsigned char* lds) {
    const int bid_ = opq_bid(), nblk_ = opq_nblk();
    SchedDense S; S.init(p.ws + WS_H, D / 2, (const bf16*)(p.ws + WS_GATE_T) + (size_t)l * 4096 * D, D / 2, nrows, 4096, nblk_, bid_);
    S.rev = true;
    EpiMerge E{(const bf16*)(p.ws + WS_YB), (bf16*)(p.ws + WS_YM), p.in[I_GATEB] + l * 4096, (const float*)(p.ws + WS_HS1), (const float*)(p.ws + WS_GATES) + l * 4096};
    pg8::gemm_phase<EpiMerge, SchedDense, false, true>(LDSP, D, D, S, E);
}
DI void ph_wo_fast(PRef p, int l, int nrows, unsigned char* lds) {
    const int bid_ = opq_bid(), nblk_ = opq_nblk();
    SchedDense S; S.init(p.ws + WS_YM, D, (const bf16*)(p.ws + WS_WO_T) + (size_t)l * D * D, D, nrows, D, nblk_, bid_);
    const float* XFc = (const float*)(p.ws + WS_XF);
    EpiWo E{l == 0 ? p.in[I_X] : XFc, l == 0 ? p.in[I_CTX] : XFc + (size_t)TL * D, (float*)(p.ws + WS_XF), (const float*)(p.ws + WS_MOD) + (size_t)l * 9 * 6144 + 2048};
    pg8::gemm_phase<EpiWo, SchedDense, false>(LDSP, D, D, S, E);
}
DI void moe_offsets(PRef p, int l, int* off, int tid) {
    const unsigned* cnt = (const unsigned*)(p.ws + WS_CTL) + CW_CNT + l * 64;
    if (tid < 64) expert_offsets_wave(cnt, off, tid);
    if (tid < NE) off[40 + tid] = (int)cnt[tid];
    __syncthreads();
}
DI void ph_moe1_fast(PRef p, int l, unsigned char* lds) {
    const int tid_ = opq_tid(); const int bid_ = opq_bid(), nblk_ = opq_nblk(); (void)bid_; (void)nblk_; int* off = (int*)(lds + 131072 + 1024); moe_offsets(p, l, off, tid_);
    SchedMoe S; S.A = (const char*)(p.ws + WS_H2); S.Bt = (const char*)((const bf16*)(p.ws + WS_WGU_T) + (size_t)l * NE * 2048 * D); S.rowtok = (const int*)(p.ws + WS_ROWTOK); S.off = off; S.cnt = off + 40;
    S.nN = 8; S.G = nblk_; S.c = bid_; S.ntiles = off[NE] >> 8; S.tstepA = 0; S.estepB = (size_t)2048 * D * 2  ; S.tstepB = (size_t)256 * D  ; S.gather = true;
    EpiMoeActI8 E{(bf16*)(p.ws + WS_ACT), p.in[I_BGU] + (size_t)l * NE * 2048, (const float*)(p.ws + WS_HS), (const float*)(p.ws + WS_WGUS) + (size_t)l * NE * 2048};
    pg8::gemm_phase<EpiMoeActI8, SchedMoe, true, true>(LDSP, D, D, S, E);
}
DI void ph_moe2_fast(PRef p, int l, unsigned char* lds) {
    const int tid_ = opq_tid(); const int bid_ = opq_bid(), nblk_ = opq_nblk(); (void)bid_; (void)nblk_; int* off = (int*)(lds + 131072 + 1024); moe_offsets(p, l, off, tid_);
    SchedMoe S; S.A = (const char*)(p.ws + WS_ACT); S.Bt = (const char*)((const bf16*)(p.ws + WS_WDN_T) + (size_t)l * NE * D * DFF); S.rowtok = (const int*)(p.ws + WS_ROWTOK); S.off = off; S.cnt = off + 40;
    S.nN = 4; S.G = nblk_; S.c = bid_; S.ntiles = off[NE] >> 8; S.tstepA = (size_t)256 * D * 2; S.estepB = (size_t)D * DFF * 2; S.tstepB = (size_t)256 * DFF * 2; S.gather = false;
    S.rev = true;
    EpiStoreBf16 E{(bf16*)(p.ws + WS_YE), D, 0, p.in[I_BDN] + (size_t)l * NE * D, D};
    pg8::gemm_phase<EpiStoreBf16, SchedMoe, false>(LDSP, DFF, DFF, S, E);
}

namespace fa {
using bf16x8 = __attribute__((ext_vector_type(8))) short;
using s16x4  = __attribute__((ext_vector_type(4))) short;
using f32x16 = __attribute__((ext_vector_type(16))) float;
using u32x4  = __attribute__((ext_vector_type(4))) unsigned;
constexpr int SHM_K = 64 * 256, SHM_V = 64 * 256;
constexpr float THR2 = 11.5f;
#define FA_KSWZ(row, colB) ((row) * 256 + ((colB) ^ (((row) & 7) << 4)))
#define FA_SBAR() __builtin_amdgcn_sched_barrier(0)
DI int crow(int r, int hi) { return (r & 3) + 8 * (r >> 2) + 4 * hi; }
DI unsigned cvtpk(float lo, float hi) { unsigned r; asm volatile("v_cvt_pk_bf16_f32 %0, %1, %2" : "=v"(r) : "v"(lo), "v"(hi)); return r; }
DI int v_st(int k, int c) { const int kk = k;        return ((kk >> 3) * 4 + (c >> 5)) * 512 + ((kk & 7) * 32 + (c & 31)) * 2; }
DI int v_rd_base(int lane) { return ((lane & 3) << 3) | (((lane >> 2) & 3) << 6) | (((lane >> 4) & 1) << 5) | (((lane >> 5) & 1) << 8); }
constexpr int v_rd_off(int d0, int ks, int half) { return d0 * 512 + ks * 4096 + half * 2048; }
template <int OFF> DI s16x4 tr_read(int vb) { s16x4 r; asm volatile("ds_read_b64_tr_b16 %0, %1 offset:%2" : "=&v"(r) : "v"(vb), "i"(OFF) : "memory"); return r; }
template <int D0> DI void pv_one(f32x16& od, int vb, bf16x8 pa0, bf16x8 pa1, bf16x8 pa2, bf16x8 pa3) {
  const s16x4 l0 = tr_read<v_rd_off(D0, 0, 0)>(vb), h0 = tr_read<v_rd_off(D0, 0, 1)>(vb), l1 = tr_read<v_rd_off(D0, 1, 0)>(vb), h1 = tr_read<v_rd_off(D0, 1, 1)>(vb);
  const s16x4 l2 = tr_read<v_rd_off(D0, 2, 0)>(vb), h2 = tr_read<v_rd_off(D0, 2, 1)>(vb), l3 = tr_read<v_rd_off(D0, 3, 0)>(vb), h3 = tr_read<v_rd_off(D0, 3, 1)>(vb);
  asm volatile("s_waitcnt lgkmcnt(0)" ::: "memory"); FA_SBAR();
#define FA_PK(L, H) (bf16x8){L[0], L[1], L[2], L[3], H[0], H[1], H[2], H[3]}
  od = __builtin_amdgcn_mfma_f32_32x32x16_bf16(pa0, FA_PK(l0, h0), od, 0, 0, 0);
  od = __builtin_amdgcn_mfma_f32_32x32x16_bf16(pa1, FA_PK(l1, h1), od, 0, 0, 0);
  od = __builtin_amdgcn_mfma_f32_32x32x16_bf16(pa2, FA_PK(l2, h2), od, 0, 0, 0);
  od = __builtin_amdgcn_mfma_f32_32x32x16_bf16(pa3, FA_PK(l3, h3), od, 0, 0, 0);
#undef FA_PK
}

}


DI void ph_ada_fast(PRef p, unsigned char* lds) {
  const int tid_ = opq_tid(); const int bid_ = opq_bid(), nblk_ = opq_nblk();
  float* MOD = (float*)(p.ws + WS_MOD);
  { float* ROPE = (float*)(p.ws + WS_ROPE);
    for (int idx = GTID; idx < SEQ * 16; idx += NTHR) { const int sq = idx >> 4, i = idx & 15; const float pos = (i < 8) ? (float)(sq >> 6) : (float)(sq & 63);
      const float inv = powf(10000.f, -(float)(2 * (i & 7)) / 16.f); const float th = pos * inv; ROPE[sq * 32 + i] = cosf(th); ROPE[sq * 32 + 16 + i] = sinf(th); } }
  if (bid_ == 0) { for (int k = tid_; k < 2 * NH * 15 * 31; k += 512) { const float v = fmaxf(p.in[I_RPB][k], 0.f); atomicMax((int*)(p.ws + WS_CTL) + CW_BIASMAX + k / (NH * 15 * 31), __float_as_int(v)); } }
  float* sc = (float*)lds;
  float* red = (float*)(lds + 40960);
  for (int k = tid_; k < 9 * D; k += 512) { const int i = k >> 10, kk = k & 1023; const float v = i < 8 ? p.in[I_C][i * D + kk] : p.in[I_CCTX][kk]; sc[k] = v * sigmoidf_(v); }
  __syncthreads();
  const int nn = tid_ & 63, kg = tid_ >> 6;
  for (int it = bid_; it < 2 * 96; it += nblk_) {
    const int l = it / 96, n0 = (it - l * 96) * 64;
    const float* W = p.in[I_ADAW] + (size_t)l * D * 6144 + n0 + nn;
    float acc[9];
#pragma unroll
    for (int i = 0; i < 9; ++i) acc[i] = 0.f;
#pragma unroll 8
    for (int k = kg * 128; k < kg * 128 + 128; ++k) { const float w = W[(size_t)k * 6144];
#pragma unroll
      for (int i = 0; i < 9; ++i) acc[i] += sc[i * D + k] * w; }
#pragma unroll
    for (int i = 0; i < 9; ++i) red[(kg * 9 + i) * 64 + nn] = acc[i];
    __syncthreads();
    for (int o = tid_; o < 9 * 64; o += 512) { const int i = o >> 6, n = o & 63; float s = 0.f;
#pragma unroll
      for (int g = 0; g < 8; ++g) s += red[(g * 9 + i) * 64 + n];
      MOD[((size_t)l * 9 + i) * 6144 + n0 + n] = s + p.in[I_ADAB][l * 6144 + n0 + n]; }
    __syncthreads();
  }
}


DI void ld32(const bf16* __restrict__ src, float (&x)[32]) {
#pragma unroll
  for (int q = 0; q < 4; ++q) { const uint4 u = *(const uint4*)(src + 8 * q); const unsigned w[4] = {u.x, u.y, u.z, u.w};
#pragma unroll
    for (int i = 0; i < 4; ++i) { x[8 * q + 2 * i] = __uint_as_float(w[i] << 16); x[8 * q + 2 * i + 1] = __uint_as_float(w[i] & 0xffff0000u); } }
}
DI void st32(bf16* __restrict__ dst, const float (&x)[32]) {
#pragma unroll
  for (int q = 0; q < 4; ++q) { uint4 u; u.x = cvt_pk_bf16_(x[8 * q], x[8 * q + 1]); u.y = cvt_pk_bf16_(x[8 * q + 2], x[8 * q + 3]); u.z = cvt_pk_bf16_(x[8 * q + 4], x[8 * q + 5]); u.w = cvt_pk_bf16_(x[8 * q + 6], x[8 * q + 7]); *(uint4*)(dst + 8 * q) = u; }
}


DI void ph_diffcombine_fast(PRef p, int l, int nrows, float lam_init) {
  const int tid_ = opq_tid(); const int bid_ = opq_bid(), nblk_ = opq_nblk();
  const int lane = tid_ & 63, gw = GTID >> 6, ngw = NTHR >> 6;
  const bf16* __restrict__ DO_ = (const bf16*)(p.ws + WS_DO); bf16* __restrict__ BI = (bf16*)(p.ws + WS_BI);
  const float* lv = p.in[I_DLAM] + l * 128;
  const float t1 = seg_sum(lane < 32 ? lv[lane] * lv[32 + lane] : 0.f, lane, 64), t2 = seg_sum(lane < 32 ? lv[64 + lane] * lv[96 + lane] : 0.f, lane, 64);
  const float lam = expf(t1) - expf(t2) + lam_init;
  const int h = lane >> 4, d = 4 * (lane & 15);
  float g[4];
#pragma unroll
  for (int i = 0; i < 4; ++i) g[i] = p.in[I_DSUBG][l * 64 + d + i] * (1.f - lam_init);
#pragma unroll 4
  for (int r = gw; r < nrows; r += ngw) {
    float a[4], b[4], v[4]; ld4(DO_ + (size_t)r * 512 + (2 * h) * 64 + d, a); ld4(DO_ + (size_t)r * 512 + (2 * h + 1) * 64 + d, b);
#pragma unroll
    for (int i = 0; i < 4; ++i) v[i] = a[i] - lam * b[i];
    const float ss = seg_sum(v[0] * v[0] + v[1] * v[1] + v[2] * v[2] + v[3] * v[3], lane, 16); const float rs = rsqrtf(ss * (1.f / 64.f) + EPS);
#pragma unroll
    for (int i = 0; i < 4; ++i) v[i] = v[i] * rs * g[i];
    st4(BI + (size_t)r * D + 512 + h * 64 + d, v);
  }
}

DI void ph_mod2_router_fast(PRef p, int l, int nrows, unsigned char* lds) {
  const int tid_ = opq_tid(); const int bid_ = opq_bid(), nblk_ = opq_nblk();
  const int lane = tid_ & 63, wave = tid_ >> 6;
  float* rwT = (float*)lds;
  unsigned* lcnt = (unsigned*)(lds + 131072 + 2048);
  int* rbuf = (int*)(lds + 131072 + 4096);
  const float* rw = p.in[I_RW] + (size_t)l * D * NE;
  for (int q = tid_; q < D * NE / 4; q += 512) { const float4 v = *(const float4*)(rw + (size_t)q * 4); const int c = q >> 3, e = (q & 7) * 4;
    rwT[(e + 0) * D + c] = v.x; rwT[(e + 1) * D + c] = v.y; rwT[(e + 2) * D + c] = v.z; rwT[(e + 3) * D + c] = v.w; }
  if (tid_ < 64) lcnt[tid_] = 0u;
  __syncthreads();
  const float* MOD = (const float*)(p.ws + WS_MOD); const float* XF = (const float*)(p.ws + WS_XF);
  bf16* H2 = (bf16*)(p.ws + WS_H2); float* HS = (float*)(p.ws + WS_HS); const float* g = p.in[I_N2G] + l * D; const float* rb = p.in[I_RB] + l * NE;
  int* ROUTE = (int*)(p.ws + WS_ROUTE); unsigned* cnt = (unsigned*)(p.ws + WS_CTL) + CW_CNT + l * 64; int* ROWTOK = (int*)(p.ws + WS_ROWTOK);
  const int per = (nrows + nblk_ - 1) / nblk_, rlo = bid_ * per, rhi = min(rlo + per, nrows);
  float4 cx0, cx1, cx2, cx3;
  { const int r = min(rlo + wave, nrows - 1); const float* x = XF + (size_t)r * D + lane * 4; cx0 = *(const float4*)(x); cx1 = *(const float4*)(x + 256); cx2 = *(const float4*)(x + 512); cx3 = *(const float4*)(x + 768); }
  for (int r = rlo + wave; r < rhi; r += 8) {
    float4 nx0, nx1, nx2, nx3;
    { const int rn = min(r + 8, nrows - 1); const float* x = XF + (size_t)rn * D + lane * 4; nx0 = *(const float4*)(x); nx1 = *(const float4*)(x + 256); nx2 = *(const float4*)(x + 512); nx3 = *(const float4*)(x + 768); }
    float v[16]; float ss = 0.f;
    { const float4 t4[4] = {cx0, cx1, cx2, cx3};
#pragma unroll
    for (int j = 0; j < 4; ++j) { const float4 t = t4[j]; v[4 * j] = t.x; v[4 * j + 1] = t.y; v[4 * j + 2] = t.z; v[4 * j + 3] = t.w; ss += t.x * t.x + t.y * t.y + t.z * t.z + t.w * t.w; } }
    cx0 = nx0; cx1 = nx1; cx2 = nx2; cx3 = nx3;
    ss = seg_sum(ss, lane, 64);
    const float rstd = rsqrtf(ss * (1.f / D) + EPS);
    const float* md = MOD + ((size_t)l * 9 + modidx(r)) * 6144;
#pragma unroll
    for (int j = 0; j < 4; ++j) { const int c = j * 256 + lane * 4; const float4 gg = *(const float4*)(g + c), s4 = *(const float4*)(md + 4 * 1024 + c), h4 = *(const float4*)(md + 3 * 1024 + c);
      v[4 * j] = v[4 * j] * rstd * gg.x * (1.f + s4.x) + h4.x; v[4 * j + 1] = v[4 * j + 1] * rstd * gg.y * (1.f + s4.y) + h4.y;
      v[4 * j + 2] = v[4 * j + 2] * rstd * gg.z * (1.f + s4.z) + h4.z; v[4 * j + 3] = v[4 * j + 3] * rstd * gg.w * (1.f + s4.w) + h4.w;
      }
    { float mx = 0.f;
#pragma unroll
      for (int i = 0; i < 16; ++i) mx = fmaxf(mx, fabsf(v[i]));
#pragma unroll
      for (int o = 1; o < 64; o <<= 1) mx = fmaxf(mx, lane_xor(mx, lane, o));
      const float sc = mx > 0.f ? mx * (1.f / 127.f) : 1.f, inv = 1.f / sc; if (lane == 0) HS[r] = sc;
#pragma unroll
      for (int j = 0; j < 4; ++j) { unsigned b = 0;
#pragma unroll
        for (int i = 0; i < 4; ++i) b |= ((unsigned)(int)rintf(v[4 * j + i] * inv) & 255u) << (8 * i);
        *(unsigned*)((signed char*)H2 + (size_t)r * D + j * 256 + lane * 4) = b; } }
    float lg[NE];
#pragma unroll
    for (int e = 0; e < NE; ++e) { float s = 0.f;
#pragma unroll
      for (int j = 0; j < 4; ++j) { const float4 w = *(const float4*)(rwT + e * D + j * 256 + lane * 4); s += v[4 * j] * w.x + v[4 * j + 1] * w.y + v[4 * j + 2] * w.z + v[4 * j + 3] * w.w; }
      lg[e] = s; }
#pragma unroll
    for (int e = 0; e < NE; ++e) lg[e] = seg_sum(lg[e], lane, 64) + rb[e];
    int te[4]; float tv[4];
#pragma unroll
    for (int k = 0; k < 4; ++k) { float best = -3.4e38f; int bi = 0;
#pragma unroll
      for (int e = 0; e < NE; ++e) { const bool taken = (k > 0 && te[0] == e) || (k > 1 && te[1] == e) || (k > 2 && te[2] == e); if (!taken && lg[e] > best) { best = lg[e]; bi = e; } }
      te[k] = bi; tv[k] = best; }
    const float mx = tv[0]; float ex[4], se = 0.f;
#pragma unroll
    for (int k = 0; k < 4; ++k) { ex[k] = expf(tv[k] - mx); se += ex[k]; }
    if (lane == 0) { int* rt = rbuf + (r - rlo) * 12;
#pragma unroll
      for (int k = 0; k < 4; ++k) { rt[3 * k] = te[k]; rt[3 * k + 1] = (int)atomicAdd(&lcnt[te[k]], 1u); rt[3 * k + 2] = __float_as_int(ex[k] / se); } }
  }
  __syncthreads();
  if (tid_ < NE) lcnt[32 + tid_] = lcnt[tid_] ? atomicAdd(&cnt[tid_], lcnt[tid_]) : 0u;
  __syncthreads();
  for (int q = tid_; q < (rhi - rlo) * 4; q += 512) { const int lr = q >> 2, k = q & 3; const int* rt = rbuf + lr * 12 + 3 * k; int* o = ROUTE + ((size_t)(rlo + lr) * 4 + k) * 4;
    const int pos = rt[1] + (int)lcnt[32 + rt[0]];
    o[0] = rt[0]; o[1] = pos; o[2] = rt[2]; o[3] = 0; ROWTOK[(size_t)rt[0] * T + pos] = rlo + lr; }
}


namespace fa {
DI void expcvt(f32x16& p0, f32x16& p1, bf16x8& pa0, bf16x8& pa1, bf16x8& pa2, bf16x8& pa3) {
#pragma unroll
  for (int r = 0; r < 16; ++r) p0[r] = __builtin_amdgcn_exp2f(p0[r]);
#pragma unroll
  for (int r = 0; r < 16; ++r) p1[r] = __builtin_amdgcn_exp2f(p1[r]);
#define FA_PK4(P, BASE, OUT) do { unsigned a0 = cvtpk(P[BASE + 0], P[BASE + 1]), a1 = cvtpk(P[BASE + 2], P[BASE + 3]);   \
    unsigned b0 = cvtpk(P[BASE + 4], P[BASE + 5]), b1 = cvtpk(P[BASE + 6], P[BASE + 7]);                              \
    u32x4 w = {a0, a1, b0, b1}; OUT = *reinterpret_cast<bf16x8*>(&w); } while (0)
  FA_PK4(p0, 0, pa0); FA_PK4(p0, 8, pa1); FA_PK4(p1, 0, pa2); FA_PK4(p1, 8, pa3);
#undef FA_PK4
}
template <int ND0, int KST = 0>
DI void qkt2(f32x16& p0, f32x16& p1, const char* Ks, const bf16x8* qr, const f32x16& nbt, int r32, int hi) {
#pragma unroll
  for (int d0 = 0; d0 < ND0; ++d0) { const int cb = (d0 * 16 + hi * 8) * 2;
    bf16x8 b0 = *reinterpret_cast<const bf16x8*>(Ks + (KST ? r32 * KST + cb : FA_KSWZ(r32, cb)));
    bf16x8 b1 = *reinterpret_cast<const bf16x8*>(Ks + (KST ? (32 + r32) * KST + cb : FA_KSWZ(32 + r32, cb)));
    p0 = __builtin_amdgcn_mfma_f32_32x32x16_bf16(b0, qr[d0], d0 == 0 ? nbt : p0, 0, 0, 0);
    p1 = __builtin_amdgcn_mfma_f32_32x32x16_bf16(b1, qr[d0], d0 == 0 ? nbt : p1, 0, 0, 0); }
}
DI void pv3(f32x16* o, int vb, bf16x8 pa0, bf16x8 pa1, bf16x8 pa2, bf16x8 pa3) { pv_one<0>(o[0], vb, pa0, pa1, pa2, pa3); pv_one<1>(o[1], vb, pa0, pa1, pa2, pa3); pv_one<2>(o[2], vb, pa0, pa1, pa2, pa3); }
DI void fill_ones(char* V_lds, int tid) {
  const int b = tid >> 8, t = tid & 255, key = t >> 2, c8 = (t & 3) * 8;
  u32x4 w = {c8 == 0 ? 0x00003F80u : 0u, 0u, 0u, 0u};
  *(u32x4*)(V_lds + b * SHM_V + v_st(key, 64 + c8)) = w;
}
template <int DQK>
DI void attn_unit2(const bf16* __restrict__ Qb, int ldq, const bf16* __restrict__ Kh, int ldk, const bf16* __restrict__ Vh, const float* __restrict__ nbp, int nbs, int kva, int kvb, int NT,
                   bf16* __restrict__ Ob, int ldo, char* lds, int tid) {
  constexpr int ND0 = DQK / 16;
  const int wid = tid >> 6, lane = tid & 63, r32 = lane & 31, hi = lane >> 5;
  char* V_lds = lds; char* K_lds = lds + 2 * SHM_V;
  f32x16 o[3] = {}; bf16x8 qr[ND0];
  const bf16* Qw = Qb + (long)(wid * 32 + r32) * ldq + hi * 8;
#pragma unroll
  for (int d0 = 0; d0 < ND0; ++d0) qr[d0] = *reinterpret_cast<const bf16x8*>(Qw + d0 * 16);
  const float nb = nbp[(long)(wid * 32 + r32) * nbs];
  f32x16 nbt;
#pragma unroll
  for (int r = 0; r < 16; ++r) nbt[r] = nb;
  const int sr = tid >> 4, sc = (tid & 15) * 8; const bool kact = sc < DQK, vact = sc < 64;
  const int vst0 = v_st(sr, sc & 63), vst1 = v_st(32 + sr, sc & 63);
  const int vb0 = (int)(uintptr_t)V_lds + v_rd_base(lane);
  struct { bf16x8 vs0, vs1, ks0, ks1; } sr_[2];
#define FA_KROW(j) ((j) < 4 ? kva + 64 * (j) : kvb + 64 * ((j) - 4))
#define FA_SLOAD(i, j) do { const long kr_ = FA_KROW(j); \
    if (vact) { sr_[i].vs0 = *reinterpret_cast<const bf16x8*>(&Vh[(kr_ + sr) * 256 + sc]); sr_[i].vs1 = *reinterpret_cast<const bf16x8*>(&Vh[(kr_ + 32 + sr) * 256 + sc]); } \
    if (kact) { sr_[i].ks0 = *reinterpret_cast<const bf16x8*>(&Kh[(kr_ + sr) * ldk + sc]); sr_[i].ks1 = *reinterpret_cast<const bf16x8*>(&Kh[(kr_ + 32 + sr) * ldk + sc]); } } while (0)
#define FA_SWRITE(b, i) do { if (vact) { *(bf16x8*)(V_lds + (b) * SHM_V + vst0) = sr_[i].vs0; *(bf16x8*)(V_lds + (b) * SHM_V + vst1) = sr_[i].vs1; } \
    if (kact) { const int kc = sc * 2; *(bf16x8*)(K_lds + (b) * SHM_K + FA_KSWZ(sr, kc)) = sr_[i].ks0; *(bf16x8*)(K_lds + (b) * SHM_K + FA_KSWZ(32 + sr, kc)) = sr_[i].ks1; } } while (0)
  f32x16 pA0, pA1, pB0, pB1; bf16x8 pa0, pa1, pa2, pa3;
  FA_SLOAD(0, 0); asm volatile("s_waitcnt vmcnt(0)" ::: "memory"); FA_SWRITE(0, 0); __syncthreads();
  qkt2<ND0>(pA0, pA1, K_lds, qr, nbt, r32, hi);
  FA_SLOAD(1, 1); if (2 < NT) FA_SLOAD(0, 2);
  FA_SWRITE(1, 1); __syncthreads();
  for (int j = 1; j + 1 < NT; j += 2) {
    FA_SBAR(); qkt2<ND0>(pB0, pB1, K_lds + SHM_K, qr, nbt, r32, hi);
    expcvt(pA0, pA1, pa0, pa1, pa2, pa3); FA_SBAR();
    FA_SLOAD(1, j + 2); FA_SBAR();
    pv3(o, vb0, pa0, pa1, pa2, pa3);
    __syncthreads(); FA_SWRITE(0, 0); __syncthreads();
    FA_SBAR(); qkt2<ND0>(pA0, pA1, K_lds, qr, nbt, r32, hi);
    expcvt(pB0, pB1, pa0, pa1, pa2, pa3); FA_SBAR();
    if (j + 3 < NT) FA_SLOAD(0, j + 3); FA_SBAR();
    pv3(o, vb0 + SHM_V, pa0, pa1, pa2, pa3);
    __syncthreads(); FA_SWRITE(1, 1); __syncthreads();
  }
  FA_SBAR(); qkt2<ND0>(pB0, pB1, K_lds + SHM_K, qr, nbt, r32, hi);
  expcvt(pA0, pA1, pa0, pa1, pa2, pa3); FA_SBAR();
  pv3(o, vb0, pa0, pa1, pa2, pa3);
  expcvt(pB0, pB1, pa0, pa1, pa2, pa3); FA_SBAR();
  pv3(o, vb0 + SHM_V, pa0, pa1, pa2, pa3);
  bf16* Ow = Ob + (long)(wid * 32) * ldo;
#pragma unroll
  for (int r = 0; r < 16; ++r) { const int orow = crow(r, hi);
    const float lsum = __int_as_float(__builtin_amdgcn_ds_bpermute((hi * 32) << 2, __float_as_int(o[2][r]))); const float rl = __builtin_amdgcn_rcpf(lsum);
#pragma unroll
    for (int d0 = 0; d0 < 2; ++d0) Ow[(long)orow * ldo + d0 * 32 + r32] = f2bf(o[d0][r] * rl); }
  __syncthreads();
#undef FA_KROW
#undef FA_SLOAD
#undef FA_SWRITE
}
typedef float f32x2v __attribute__((ext_vector_type(2)));
typedef __bf16 bf16x2v __attribute__((ext_vector_type(2)));
DI unsigned cvtpk_b(float lo, float hi) { f32x2v v = {lo, hi}; bf16x2v b = __builtin_convertvector(v, bf16x2v); return __builtin_bit_cast(unsigned, b); }
DI void expcvt_b(f32x16& p0, f32x16& p1, bf16x8& pa0, bf16x8& pa1, bf16x8& pa2, bf16x8& pa3) {
#pragma unroll
  for (int r = 0; r < 16; ++r) p0[r] = __builtin_amdgcn_exp2f(p0[r]);
#pragma unroll
  for (int r = 0; r < 16; ++r) p1[r] = __builtin_amdgcn_exp2f(p1[r]);
#define FA_PK4(P, BASE, OUT) do { u32x4 w = {cvtpk_b(P[BASE + 0], P[BASE + 1]), cvtpk_b(P[BASE + 2], P[BASE + 3]), cvtpk_b(P[BASE + 4], P[BASE + 5]), cvtpk_b(P[BASE + 6], P[BASE + 7])}; \
    OUT = *reinterpret_cast<bf16x8*>(&w); } while (0)
  FA_PK4(p0, 0, pa0); FA_PK4(p0, 8, pa1); FA_PK4(p1, 0, pa2); FA_PK4(p1, 8, pa3);
#undef FA_PK4
}
template <int NM> DI void step_pipeline() {
  __builtin_amdgcn_sched_group_barrier(0x100, 4, 0);
#pragma unroll
  for (int i = 0; i < NM; ++i) {
    __builtin_amdgcn_sched_group_barrier(0x008, 1, 0);
    __builtin_amdgcn_sched_group_barrier(0x400, 2, 0);
    __builtin_amdgcn_sched_group_barrier(0x002, 2, 0);
    __builtin_amdgcn_sched_group_barrier(0x100, 2, 0);
  }
}
template <int OFF> DI s16x4 tr_rd(int vb) { return __builtin_amdgcn_ds_read_tr16_b64_v4i16((__attribute__((address_space(3))) s16x4*)(vb + OFF)); }
template <int D0> DI void pv_one_b(f32x16& od, int vb, bf16x8 pa0, bf16x8 pa1, bf16x8 pa2, bf16x8 pa3) {
  const s16x4 l0 = tr_rd<v_rd_off(D0, 0, 0)>(vb), h0 = tr_rd<v_rd_off(D0, 0, 1)>(vb), l1 = tr_rd<v_rd_off(D0, 1, 0)>(vb), h1 = tr_rd<v_rd_off(D0, 1, 1)>(vb);
  const s16x4 l2 = tr_rd<v_rd_off(D0, 2, 0)>(vb), h2 = tr_rd<v_rd_off(D0, 2, 1)>(vb), l3 = tr_rd<v_rd_off(D0, 3, 0)>(vb), h3 = tr_rd<v_rd_off(D0, 3, 1)>(vb);
#define FA_PK(L, H) (bf16x8){L[0], L[1], L[2], L[3], H[0], H[1], H[2], H[3]}
  od = __builtin_amdgcn_mfma_f32_32x32x16_bf16(pa0, FA_PK(l0, h0), od, 0, 0, 0);
  od = __builtin_amdgcn_mfma_f32_32x32x16_bf16(pa1, FA_PK(l1, h1), od, 0, 0, 0);
  od = __builtin_amdgcn_mfma_f32_32x32x16_bf16(pa2, FA_PK(l2, h2), od, 0, 0, 0);
  od = __builtin_amdgcn_mfma_f32_32x32x16_bf16(pa3, FA_PK(l3, h3), od, 0, 0, 0);
#undef FA_PK
}
DI void pv3b(f32x16* o, int vb, bf16x8 pa0, bf16x8 pa1, bf16x8 pa2, bf16x8 pa3, bf16x8 onesB) { pv_one_b<0>(o[0], vb, pa0, pa1, pa2, pa3); pv_one_b<1>(o[1], vb, pa0, pa1, pa2, pa3);
  o[2] = __builtin_amdgcn_mfma_f32_32x32x16_bf16(pa0, onesB, o[2], 0, 0, 0); o[2] = __builtin_amdgcn_mfma_f32_32x32x16_bf16(pa1, onesB, o[2], 0, 0, 0);
  o[2] = __builtin_amdgcn_mfma_f32_32x32x16_bf16(pa2, onesB, o[2], 0, 0, 0); o[2] = __builtin_amdgcn_mfma_f32_32x32x16_bf16(pa3, onesB, o[2], 0, 0, 0); }
#ifndef FS_SPREAD
#define FS_SPREAD 1
#endif
#ifndef FS_AH
#define FS_AH 2
#endif
template <int NM> constexpr int fs_ec(int s) { const int e = (FS_SPREAD && NM >= 24) ? s + (s + 2) / 3 : 2 * s; return e < 32 ? e : 32; }
template <int NM> constexpr int fs_cc(int s) { const int c = s >= 1 ? fs_ec<NM>(s - 1) / 2 : 0; return c < 16 ? c : 16; }
DI s16x4 tr_rd2(int vb, int off) { return __builtin_amdgcn_ds_read_tr16_b64_v4i16((__attribute__((address_space(3))) s16x4*)(vb + off)); }
template <int ND0, int WI, int KST = 0>
DI void fused_step(f32x16& pn0, f32x16& pn1, f32x16& pc0, f32x16& pc1, bf16x8& an0, bf16x8& an1, bf16x8& an2, bf16x8& an3, bf16x8 ac0, bf16x8 ac1, bf16x8 ac2, bf16x8 ac3,
                   f32x16* o, const char* Ks, int vb, const bf16x8* qr, const f32x16& nbt, int r32, int hi, bf16x8 onesB) {
  constexpr int NQ = 2 * ND0, NM = NQ + 12, AH = FS_AH;
  bf16x8 kf[NQ]; s16x4 vl[8], vh[8]; unsigned w[16];
  bf16x8 kz_; s16x4 vz_; if (WI & (4 | 16 | 32)) { asm volatile("v_mov_b32 %0, 0" : "=v"(vz_[0])); u32x4 z4_ = {0u, 0u, 0u, 0u}; asm volatile("" : "+v"(z4_)); kz_ = *reinterpret_cast<bf16x8*>(&z4_); vz_ = (s16x4){0, 0, 0, 0}; asm volatile("" : "+v"(vz_)); }
#define FS_ISSUE(m) do { if ((WI & 4) || ((WI & 16) && (m) < NQ) || ((WI & 32) && (m) >= NQ)) { if ((m) < NQ) kf[(m) < NQ ? (m) : 0] = kz_; else if ((m) - NQ < 8) { const int q_ = (m) - NQ; vl[q_ >= 0 ? q_ : 0] = vz_; vh[q_ >= 0 ? q_ : 0] = vz_; } } else if ((m) < NQ) { kf[(m) < NQ ? (m) : 0] = *reinterpret_cast<const bf16x8*>(Ks + (KST ? (((m) & 1) * 32 + r32) * KST + ((((m) >> 1) * 16 + hi * 8) * 2) : FA_KSWZ(((m) & 1) * 32 + r32, ((((m) >> 1) * 16 + hi * 8) * 2)))); } \
    else if ((m) - NQ < 8) { const int q_ = (m) - NQ; vl[q_ >= 0 ? q_ : 0] = tr_rd2(vb, v_rd_off(q_ >> 2, q_ & 3, 0)); vh[q_ >= 0 ? q_ : 0] = tr_rd2(vb, v_rd_off(q_ >> 2, q_ & 3, 1)); } } while (0)
#define FS_PC(v) ((v) < 16 ? pc0[(v) & 15] : pc1[(v) & 15])
#pragma unroll
  for (int m = 0; m < AH; ++m) FS_ISSUE(m);
#pragma unroll
  for (int s_ = 0; s_ < NM; ++s_) {
    if (s_ + AH < NM) FS_ISSUE(s_ + AH);
    if (s_ < NQ) { const int d0 = s_ >> 1;
      if ((s_ & 1) == 0) pn0 = __builtin_amdgcn_mfma_f32_32x32x16_bf16(kf[s_ < NQ ? s_ : 0], qr[d0 < ND0 ? d0 : 0], d0 == 0 ? nbt : pn0, 0, 0, 0);
      else pn1 = __builtin_amdgcn_mfma_f32_32x32x16_bf16(kf[s_ < NQ ? s_ : 0], qr[d0 < ND0 ? d0 : 0], d0 == 0 ? nbt : pn1, 0, 0, 0);
    } else { const int q = s_ - NQ, blk = q >> 2, ks = q & 3; const int qi = (q >= 0 && q < 8) ? q : 0; const s16x4 L = vl[qi], H = vh[qi];
      const bf16x8 B = blk == 2 ? onesB : (bf16x8){L[0], L[1], L[2], L[3], H[0], H[1], H[2], H[3]};       const bf16x8 A = ks == 0 ? ac0 : (ks == 1 ? ac1 : (ks == 2 ? ac2 : ac3));
      o[blk >= 0 ? blk : 0] = __builtin_amdgcn_mfma_f32_32x32x16_bf16(A, B, o[blk >= 0 ? blk : 0], 0, 0, 0); }
#pragma unroll
    for (int v = fs_ec<NM>(s_); v < ((WI & 2) ? 0 : fs_ec<NM>(s_ + 1)); ++v) { float e0 = FS_PC(v); asm volatile("" : "+v"(e0)); e0 = __builtin_amdgcn_exp2f(e0); asm volatile("" : "+v"(e0));
      if (v < 16) pc0[v & 15] = e0; else pc1[v & 15] = e0; }
#pragma unroll
    for (int k = fs_cc<NM>(s_); k < ((WI & 2) ? 0 : fs_cc<NM>(s_ + 1)); ++k) { unsigned wk = cvtpk_b(FS_PC(2 * k), FS_PC(2 * k + 1)); asm volatile("" : "+v"(wk)); w[k & 15] = wk; }
    FA_SBAR();
  }
#pragma unroll
  for (int k = fs_cc<NM>(NM); k < ((WI & 2) ? 0 : 16); ++k) w[k] = cvtpk_b(FS_PC(2 * k), FS_PC(2 * k + 1));
  if (WI & 2) { an0 = ac0; an1 = ac1; an2 = ac2; an3 = ac3; } else
  { u32x4 t0 = {w[0], w[1], w[2], w[3]}, t1 = {w[4], w[5], w[6], w[7]}, t2 = {w[8], w[9], w[10], w[11]}, t3 = {w[12], w[13], w[14], w[15]};
    an0 = *reinterpret_cast<bf16x8*>(&t0); an1 = *reinterpret_cast<bf16x8*>(&t1); an2 = *reinterpret_cast<bf16x8*>(&t2); an3 = *reinterpret_cast<bf16x8*>(&t3); }
#undef FS_ISSUE
#undef FS_PC
}
template <int DQK, int WI>
DI void attn_unit3(const bf16* __restrict__ Qb, int ldq, const bf16* __restrict__ Kh, int ldk, const bf16* __restrict__ Vh, const float* __restrict__ nbp, int nbs, int kva, int kvb, int NT,
                   bf16* __restrict__ Ob, int ldo, char* lds, int tid) {
  constexpr int ND0 = DQK / 16;
  const int wid = tid >> 6, lane = tid & 63, r32 = lane & 31, hi = lane >> 5;
  char* V_lds = lds; char* K_lds = lds + 2 * SHM_V;
  f32x16 o[3] = {}; bf16x8 qr[ND0];
  const bf16* Qw = Qb + (long)(wid * 32 + r32) * ldq + hi * 8;
#pragma unroll
  for (int d0 = 0; d0 < ND0; ++d0) qr[d0] = *reinterpret_cast<const bf16x8*>(Qw + d0 * 16);
  const float nb = nbp[(long)(wid * 32 + r32) * nbs];
  f32x16 nbt;
#pragma unroll
  for (int r = 0; r < 16; ++r) nbt[r] = nb;
  const int sr = tid >> 4, sc = (tid & 15) * 8; const bool kact = sc < DQK, vact = sc < 64;
  const int vst0 = v_st(sr, sc & 63), vst1 = v_st(32 + sr, sc & 63);
  const int vb0 = (int)(uintptr_t)V_lds + v_rd_base(lane);
  bf16x8 vs0, vs1, ks0, ks1;
#define FA_KROW(j) ((j) < 4 ? kva + 64 * (j) : kvb + 64 * ((j) - 4))
#define FA_LOADK(j) do { if (kact) { const long kr_ = FA_KROW(j); ks0 = *reinterpret_cast<const bf16x8*>(&Kh[(kr_ + sr) * ldk + sc]); ks1 = *reinterpret_cast<const bf16x8*>(&Kh[(kr_ + 32 + sr) * ldk + sc]); } } while (0)
#define FA_LOADV(j) do { if (vact) { const long kr_ = FA_KROW(j); vs0 = *reinterpret_cast<const bf16x8*>(&Vh[(kr_ + sr) * 256 + sc]); vs1 = *reinterpret_cast<const bf16x8*>(&Vh[(kr_ + 32 + sr) * 256 + sc]); } } while (0)
#define FA_WRITEK(b) do { if (kact) { const int kc = sc * 2; *(bf16x8*)(K_lds + (b) * SHM_K + FA_KSWZ(sr, kc)) = ks0; *(bf16x8*)(K_lds + (b) * SHM_K + FA_KSWZ(32 + sr, kc)) = ks1; } } while (0)
#define FA_WRITEV(b) do { if (vact) { *(bf16x8*)(V_lds + (b) * SHM_V + vst0) = vs0; *(bf16x8*)(V_lds + (b) * SHM_V + vst1) = vs1; } } while (0)
  f32x16 pE0, pE1, pO0, pO1; bf16x8 ae0, ae1, ae2, ae3, ao0, ao1, ao2, ao3;
  bf16x8 onesB; { const unsigned ov = r32 == 0 ? 0x3F803F80u : 0u; u32x4 t = {ov, ov, ov, ov}; onesB = *reinterpret_cast<bf16x8*>(&t); }
  FA_LOADK(0); asm volatile("s_waitcnt vmcnt(0)" ::: "memory"); FA_WRITEK(0); __syncthreads();
  FA_LOADK(1);
  qkt2<ND0>(pE0, pE1, K_lds, qr, nbt, r32, hi);
  __syncthreads(); FA_WRITEK(1); __syncthreads(); FA_LOADK(2); FA_LOADV(0);
  FA_SBAR(); qkt2<ND0>(pO0, pO1, K_lds + SHM_K, qr, nbt, r32, hi); expcvt(pE0, pE1, ae0, ae1, ae2, ae3); FA_SBAR();
  __syncthreads(); FA_WRITEK(0); FA_WRITEV(0); __syncthreads(); if (3 < NT) FA_LOADK(3); FA_LOADV(1);
#define FA_SY() do { if (!(WI & 1)) __syncthreads(); } while (0)
#define FA_IO(x) do { if (!(WI & 8)) { x; } } while (0)
  for (int j = 1; j + 2 < NT; j += 2) {
    FA_SBAR(); asm volatile("" : "+v"(pO0), "+v"(pO1));
    fused_step<ND0, WI>(pE0, pE1, pO0, pO1, ao0, ao1, ao2, ao3, ae0, ae1, ae2, ae3, o, K_lds, vb0, qr, nbt, r32, hi, onesB);
    FA_SY(); FA_IO(FA_WRITEK(1); FA_WRITEV(1)); FA_SY(); FA_IO(if (j + 3 < NT) FA_LOADK(j + 3); FA_LOADV(j + 1));
    FA_SBAR(); asm volatile("" : "+v"(pE0), "+v"(pE1));
    fused_step<ND0, WI>(pO0, pO1, pE0, pE1, ae0, ae1, ae2, ae3, ao0, ao1, ao2, ao3, o, K_lds + SHM_K, vb0 + SHM_V, qr, nbt, r32, hi, onesB);
    FA_SY(); FA_IO(if (j + 3 < NT) FA_WRITEK(0); FA_WRITEV(0)); FA_SY(); FA_IO(if (j + 4 < NT) FA_LOADK(j + 4); if (j + 2 < NT) FA_LOADV(j + 2));
  }
#undef FA_SY
#undef FA_IO
  FA_SBAR(); expcvt(pO0, pO1, ao0, ao1, ao2, ao3); pv3b(o, vb0, ae0, ae1, ae2, ae3, onesB); FA_SBAR();
  __syncthreads(); FA_WRITEV(1); __syncthreads();
  pv3b(o, vb0 + SHM_V, ao0, ao1, ao2, ao3, onesB);
  bf16* Ow = Ob + (long)(wid * 32) * ldo;
#pragma unroll
  for (int r = 0; r < 16; ++r) { const int orow = crow(r, hi);
    const float lsum = __int_as_float(__builtin_amdgcn_ds_bpermute((hi * 32) << 2, __float_as_int(o[2][r]))); const float rl = __builtin_amdgcn_rcpf(lsum);
#pragma unroll
    for (int d0 = 0; d0 < 2; ++d0) Ow[(long)orow * ldo + d0 * 32 + r32] = f2bf(o[d0][r] * rl); }
  __syncthreads();
#undef FA_KROW
#undef FA_LOADK
#undef FA_LOADV
#undef FA_WRITEK
#undef FA_WRITEV
}
template <int DQK>
DI void attn_unit4(const bf16* __restrict__ Qb, int ldq, const bf16* __restrict__ Kh, int ldk, const bf16* __restrict__ Vh, const float* __restrict__ nbp, int nbs, int kva, int kvb, int NT,
                   bf16* __restrict__ Ob, int ldo, char* lds, int tid, bool prefetched, const bf16* Knext) {
  constexpr int ND0 = DQK / 16, CPR = DQK / 8 + 1, KST = CPR * 16, KSZ = 64 * KST;
  const int wid = __builtin_amdgcn_readfirstlane(tid >> 6), lane = tid & 63, r32 = lane & 31, hi = lane >> 5;
  char* V_lds = lds; char* K_lds = lds + 3 * SHM_V;
  f32x16 o[3] = {}; bf16x8 qr[ND0];
  const bf16* Qw = Qb + (long)(wid * 32 + r32) * ldq + hi * 8;
#pragma unroll
  for (int d0 = 0; d0 < ND0; ++d0) qr[d0] = *reinterpret_cast<const bf16x8*>(Qw + d0 * 16);
  const float nb = nbp[(long)(wid * 32 + r32) * nbs];
  f32x16 nbt;
#pragma unroll
  for (int r = 0; r < 16; ++r) nbt[r] = nb;
  const int vb0 = (int)(uintptr_t)V_lds + v_rd_base(lane);
  bf16x8 onesB; { const unsigned ov = r32 == 0 ? 0x3F803F80u : 0u; u32x4 t = {ov, ov, ov, ov}; onesB = *reinterpret_cast<bf16x8*>(&t); }
  unsigned kof0, kof1, vof;
  { const int c0 = 64 * wid + lane, c1 = c0 + 512; const int ra = c0 / CPR, ca = c0 - ra * CPR, rb = c1 / CPR, cb = c1 - rb * CPR;
    kof0 = (unsigned)(ra * ldk + (ca < CPR - 1 ? ca : 0) * 8) * 2u; kof1 = (unsigned)(rb * ldk + (cb < CPR - 1 ? cb : 0) * 8) * 2u;
    vof = (unsigned)((wid * 8 + ((lane & 31) >> 2)) * 256 + (lane >> 5) * 32 + (lane & 3) * 8) * 2u; }
  const bool k0act = wid < CPR, k1act = wid + 8 < CPR;
  const unsigned kl0 = (unsigned)(uintptr_t)K_lds + (unsigned)wid * 1024u, vl0 = (unsigned)(uintptr_t)V_lds + (unsigned)wid * 2048u;
#define FA_LAS __attribute__((address_space(3)))
#define FA_KROW(j) ((j) < 4 ? kva + 64 * (j) : kvb + 64 * ((j) - 4))
#define FA_DMAK(t, slot) do { const char* kb_ = (const char*)(Kh + (long)FA_KROW(t) * ldk); const unsigned kd_ = kl0 + (unsigned)(slot) * (unsigned)KSZ; \
    if (k0act) __builtin_amdgcn_global_load_lds((const unsigned*)(kb_ + kof0), (FA_LAS unsigned*)kd_, 16, 0, 0); \
    if (k1act) __builtin_amdgcn_global_load_lds((const unsigned*)(kb_ + kof1), (FA_LAS unsigned*)(kd_ + 8192u), 16, 0, 0); } while (0)
#define FA_DMAV(t, slot) do { const char* vb_ = (const char*)(Vh + (long)FA_KROW(t) * 256); \
    __builtin_amdgcn_global_load_lds((const unsigned*)(vb_ + vof), (FA_LAS unsigned*)(vl0 + (unsigned)(slot) * (unsigned)SHM_V), 16, 0, 0); } while (0)
#define FA_NX(s) ((s) == 2 ? 0 : (s) + 1)
#define FA_END(n) do { asm volatile("s_waitcnt vmcnt(" #n ")" ::: "memory"); __builtin_amdgcn_s_barrier(); } while (0)
  f32x16 pE0, pE1, pO0, pO1; bf16x8 ae0, ae1, ae2, ae3, ao0, ao1, ao2, ao3;
  if (!prefetched) { FA_DMAK(0, 0); FA_DMAK(1, 1); }
  FA_END(0);
#pragma unroll
  for (int d0 = 0; d0 < ND0; ++d0) asm volatile("" : "+v"(qr[d0]));
  asm volatile("" : "+v"(nbt));
  if (2 < NT) FA_DMAK(2, 2); FA_DMAV(0, 0);
  qkt2<ND0, KST>(pE0, pE1, K_lds, qr, nbt, r32, hi);
  FA_END(1);
  if (3 < NT) FA_DMAK(3, 0); FA_DMAV(1, 1);
  FA_SBAR(); qkt2<ND0, KST>(pO0, pO1, K_lds + KSZ, qr, nbt, r32, hi); expcvt(pE0, pE1, ae0, ae1, ae2, ae3); FA_SBAR();
  FA_END(1);
  int sj = 1;
  for (int j = 1; j + 2 < NT; j += 2) {
    { const int s1 = FA_NX(sj), s2 = FA_NX(s1);
      if (j + 3 < NT) FA_DMAK(j + 3, sj); FA_DMAV(j + 1, s1);
      FA_SBAR(); asm volatile("" : "+v"(pO0), "+v"(pO1));
      fused_step<ND0, 0, KST>(pE0, pE1, pO0, pO1, ao0, ao1, ao2, ao3, ae0, ae1, ae2, ae3, o, K_lds + s1 * KSZ, vb0 + s2 * SHM_V, qr, nbt, r32, hi, onesB);
      FA_END(1); sj = s1; }
    { const int s1 = FA_NX(sj), s2 = FA_NX(s1);
      if (j + 4 < NT) FA_DMAK(j + 4, sj); if (j + 2 < NT) FA_DMAV(j + 2, s1);
      FA_SBAR(); asm volatile("" : "+v"(pE0), "+v"(pE1));
      fused_step<ND0, 0, KST>(pO0, pO1, pE0, pE1, ae0, ae1, ae2, ae3, ao0, ao1, ao2, ao3, o, K_lds + s1 * KSZ, vb0 + s2 * SHM_V, qr, nbt, r32, hi, onesB);
      FA_END(1); sj = s1; }
  }
  { const int s2 = FA_NX(FA_NX(sj));
    if (Knext) { const char* kb_ = (const char*)Knext;
      if (k0act) __builtin_amdgcn_global_load_lds((const unsigned*)(kb_ + kof0), (FA_LAS unsigned*)kl0, 16, 0, 0);
      if (k1act) __builtin_amdgcn_global_load_lds((const unsigned*)(kb_ + kof1), (FA_LAS unsigned*)(kl0 + 8192u), 16, 0, 0);
      kb_ += (size_t)64 * ldk * 2;
      if (k0act) __builtin_amdgcn_global_load_lds((const unsigned*)(kb_ + kof0), (FA_LAS unsigned*)(kl0 + (unsigned)KSZ), 16, 0, 0);
      if (k1act) __builtin_amdgcn_global_load_lds((const unsigned*)(kb_ + kof1), (FA_LAS unsigned*)(kl0 + (unsigned)KSZ + 8192u), 16, 0, 0); }
    FA_SBAR(); expcvt(pO0, pO1, ao0, ao1, ao2, ao3); pv3b(o, vb0 + s2 * SHM_V, ae0, ae1, ae2, ae3, onesB); FA_SBAR();
    if (!Knext || !k0act) { FA_END(0); } else if (k1act) { FA_END(4); } else { FA_END(2); }
    sj = FA_NX(sj); }
  { const int s2 = FA_NX(FA_NX(sj)); pv3b(o, vb0 + s2 * SHM_V, ao0, ao1, ao2, ao3, onesB); }
  bf16* Ow = Ob + (long)(wid * 32) * ldo;
#pragma unroll
  for (int r = 0; r < 16; ++r) { const int orow = crow(r, hi);
    const float lsum = __int_as_float(__builtin_amdgcn_ds_bpermute((hi * 32) << 2, __float_as_int(o[2][r]))); const float rl = __builtin_amdgcn_rcpf(lsum);
#pragma unroll
    for (int d0 = 0; d0 < 2; ++d0) Ow[(long)orow * ldo + d0 * 32 + r32] = f2bf(o[d0][r] * rl); }
  __syncthreads();
#undef FA_KROW
#undef FA_DMAK
#undef FA_DMAV
#undef FA_NX
#undef FA_END
}
}

template <int DQK, int WI = 0>
DI void ph_attn_fast2(const bf16* Q, const bf16* K, const bf16* V, const float* QB, int nhv, int vdiv, bf16* O, int ldo, int ooff, int qbase, int nq_per_b, bool with_latent, unsigned char* lds) {
  const int tid_ = opq_tid(); const int bid_ = opq_bid(), nblk_ = opq_nblk();
  const int chunks = nq_per_b / 256, npairs = NB * nhv, nunits = npairs * chunks;
  const bool xmap = (nblk_ == 256) && (chunks == 16);
#define AT_DECODE(i, ok, pair, ch) do { if (xmap) { const int v = (i) * 32 + (bid_ >> 3); ok = v < nhv * 16; pair = (v >> 4) * 8 + (bid_ & 7); ch = v & 15; } \
    else { const int u = (i) * nblk_ + bid_; ok = u < nunits; pair = u / chunks; ch = u - pair * chunks; } } while (0)
  bool ok, pre = false; int pair, ch;
  AT_DECODE(0, ok, pair, ch);
  for (int i = 0; ok; ++i) {
    bool okn; int pairn, chn;
    AT_DECODE(i + 1, okn, pairn, chn); (void)chn;
    const int b = pair / nhv, hv = pair - b * nhv;
    const int r0 = qbase + b * nq_per_b + ch * 256;
    int tu_ = tid_; asm volatile("" : "+v"(tu_));
    if constexpr (WI == 0) {
      const int bn = pairn / nhv, hvn = pairn - bn * nhv;
      const bf16* Kn = okn ? K + hvn * DQK + (size_t)(TL + bn * CTX) * (nhv * DQK) : nullptr;
      fa::attn_unit4<DQK>(Q + (size_t)r0 * (nhv * DQK) + hv * DQK, nhv * DQK, K + hv * DQK, nhv * DQK, V + (hv / vdiv) * 64, QB + (size_t)r0 * nhv + hv, nhv, TL + b * CTX, b * SEQ, with_latent ? 68 : 4,
                        O + (size_t)r0 * ldo + ooff + hv * 64, ldo, (char*)lds, tu_, pre, Kn);
      pre = okn;
    } else {
      fa::attn_unit3<DQK, WI>(Q + (size_t)r0 * (nhv * DQK) + hv * DQK, nhv * DQK, K + hv * DQK, nhv * DQK, V + (hv / vdiv) * 64, QB + (size_t)r0 * nhv + hv, nhv, TL + b * CTX, b * SEQ, with_latent ? 68 : 4,
                        O + (size_t)r0 * ldo + ooff + hv * 64, ldo, (char*)lds, tu_);
    }
    ok = okn; pair = pairn; ch = chn;
  }
#undef AT_DECODE
}

DI void ph_na_fast2(PRef p, int l, unsigned char* lds8) {
  using namespace fa;
  const int tid_ = opq_tid(); const int bid_ = opq_bid(), nblk_ = opq_nblk();
  char* lds = (char*)lds8;
  const bf16* __restrict__ Q = (const bf16*)(p.ws + WS_NQ); const bf16* __restrict__ K = (const bf16*)(p.ws + WS_NK); const bf16* __restrict__ V = (const bf16*)(p.ws + WS_NV); bf16* __restrict__ BI = (bf16*)(p.ws + WS_BI);
  const float* __restrict__ QB = (const float*)(p.ws + WS_QBN);
  const float* rpb = p.in[I_RPB] + (size_t)l * NH * 15 * 31;
  const int wid = __builtin_amdgcn_readfirstlane(tid_ >> 6), lane = tid_ & 63, r32 = lane & 31, hi = lane >> 5;
  char* V_lds = lds; char* K_lds = lds + 2 * SHM_V;
  float* tbl = (float*)(lds + 2 * SHM_V + 2 * SHM_K + 2048);
  bf16x8 onesB; { const unsigned ov = r32 == 0 ? 0x3F803F80u : 0u; u32x4 t = {ov, ov, ov, ov}; onesB = *reinterpret_cast<bf16x8*>(&t); }
  const int sr = tid_ >> 4, sc = (tid_ & 15) * 8; const bool act = sc < 64;
  const int vst0 = v_st(sr, sc & 63), vst1 = v_st(32 + sr, sc & 63);
  const int vb0 = (int)(uintptr_t)V_lds + v_rd_base(lane);
  const bool xmap = (nblk_ == 256);
  for (int i = 0;; ++i) {
    int pair, g;
    if (xmap) { const int v = i * 32 + (bid_ >> 3); if (v >= 64) break; pair = (v >> 4) * 8 + (bid_ & 7); g = v & 15; }
    else { const int u = i * nblk_ + bid_; if (u >= NB * NH * 16) break; pair = u >> 4; g = u & 15; }
    const int b = pair >> 2, h = pair & 3;
    for (int k = tid_; k < 15 * 32; k += 512) { const int ii = k >> 5, jj = k & 31; tbl[k] = jj < 31 ? rpb[(h * 15 + ii) * 31 + jj] * LOG2E : 0.f; }
    const int lo = min(max(4 * g - 4, 0), 56), hiR = min(max(4 * g + 3 - 4, 0), 56) + 7, NT = 4 + (hiR - lo + 1);
    const int qrow = 4 * g + (wid >> 1), rs_w = min(max(qrow - 4, 0), 56), qc = 32 * (wid & 1) + r32, ws0 = min(max(qc - 8, 0), 48);
    const int r0 = b * SEQ + g * 256;
    const bf16* Kh = K + h * 64; const bf16* Vh = V + h * 64;
    unsigned vmask = 0u;
#pragma unroll
    for (int r = 0; r < 16; ++r) { const int kc = crow(r, hi); vmask |= ((unsigned)(kc - ws0) < 16u ? 1u : 0u) << r; vmask |= ((unsigned)(kc + 32 - ws0) < 16u ? 1u : 0u) << (16 + r); }
    const int bbase = 4 * hi - qc + 15;
    f32x16 o[3] = {}; bf16x8 qr[4];
    const bf16* Qw = Q + (size_t)(r0 + wid * 32 + r32) * 256 + h * 64 + hi * 8;
#pragma unroll
    for (int d0 = 0; d0 < 4; ++d0) qr[d0] = *reinterpret_cast<const bf16x8*>(Qw + d0 * 16);
    const float nb = QB[(size_t)(r0 + wid * 32 + r32) * 4 + h];
    f32x16 nbt;
#pragma unroll
    for (int r = 0; r < 16; ++r) nbt[r] = nb;
    bf16x8 vs0, vs1, ks0, ks1;
#define NA_KROW(j) ((j) < 4 ? TL + b * CTX + 64 * (j) : b * SEQ + (lo + (j) - 4) * 64)
#define NA_SLOAD(j) do { if (act) { const long kr_ = NA_KROW(j); vs0 = *reinterpret_cast<const bf16x8*>(&Vh[(kr_ + sr) * 256 + sc]); vs1 = *reinterpret_cast<const bf16x8*>(&Vh[(kr_ + 32 + sr) * 256 + sc]); \
      ks0 = *reinterpret_cast<const bf16x8*>(&Kh[(kr_ + sr) * 256 + sc]); ks1 = *reinterpret_cast<const bf16x8*>(&Kh[(kr_ + 32 + sr) * 256 + sc]); } } while (0)
#define NA_SWRITE(bb) do { if (act) { *(bf16x8*)(V_lds + (bb) * SHM_V + vst0) = vs0; *(bf16x8*)(V_lds + (bb) * SHM_V + vst1) = vs1; const int kc_ = sc * 2; \
      *(bf16x8*)(K_lds + (bb) * SHM_K + FA_KSWZ(sr, kc_)) = ks0; *(bf16x8*)(K_lds + (bb) * SHM_K + FA_KSWZ(32 + sr, kc_)) = ks1; } } while (0)
    NA_SLOAD(0); NA_SWRITE(0); __syncthreads();
    for (int j = 0; j < NT; ++j) {
      const int bb = j & 1;
      if (j + 1 < NT) NA_SLOAD(j + 1);
      const int kr = lo + j - 4;
      const bool wvalid = (j < 4) || (kr >= rs_w && kr < rs_w + 8);
      if (wvalid) {
        f32x16 p0, p1; bf16x8 pa0, pa1, pa2, pa3;
        qkt2<4>(p0, p1, K_lds + bb * SHM_K, qr, nbt, r32, hi);
        if (j >= 4) {
          const float* brow = tbl + (kr - qrow + 7) * 32 + bbase;
#pragma unroll
          for (int r = 0; r < 16; ++r) { const int co = (r & 3) + 8 * (r >> 2);
            p0[r] = ((vmask >> r) & 1u) ? p0[r] + brow[co] : -1e30f; p1[r] = ((vmask >> (16 + r)) & 1u) ? p1[r] + brow[co + 32] : -1e30f; }
        }
        expcvt_b(p0, p1, pa0, pa1, pa2, pa3);
        pv3b(o, vb0 + bb * SHM_V, pa0, pa1, pa2, pa3, onesB);
      }
      if (j + 1 < NT) NA_SWRITE(bb ^ 1);
      __syncthreads();
    }
    bf16* Ow = BI + (size_t)(r0 + wid * 32) * D + 768 + h * 64;
#pragma unroll
    for (int r = 0; r < 16; ++r) { const int orow = crow(r, hi);
      const float lsum = __int_as_float(__builtin_amdgcn_ds_bpermute((hi * 32) << 2, __float_as_int(o[2][r]))); const float rl = __builtin_amdgcn_rcpf(lsum);
#pragma unroll
      for (int d0 = 0; d0 < 2; ++d0) Ow[(size_t)orow * D + d0 * 32 + r32] = f2bf(o[d0][r] * rl); }
    __syncthreads();
#undef NA_KROW
#undef NA_SLOAD
#undef NA_SWRITE
  }
}

#define LAS __attribute__((address_space(3)))
#define XB_TMO      128
#define XB_XCNT(j)  (256  + 64 * (j))
#define XB_XSUB(j)  (1280 + 64 * (j))
#define XB_XGEN(j)  (2304 + 64 * (j))
#define XB_TOP      3328
#define XB_TOPGEN   3392
#define XCD_BAR_WORDS 3456
#define XB_SPIN_CAP (1u << 24)
__device__ __forceinline__ unsigned xb_ld(unsigned* p)              { return __hip_atomic_load(p, __ATOMIC_RELAXED, __HIP_MEMORY_SCOPE_AGENT); }
__device__ __forceinline__ unsigned xb_add(unsigned* p, unsigned v) { return __hip_atomic_fetch_add(p, v, __ATOMIC_RELAXED, __HIP_MEMORY_SCOPE_AGENT); }
__device__ __forceinline__ unsigned xb_xcc_id() { return (unsigned)__builtin_amdgcn_s_getreg((3 << 11) | 20) & 0xFu; }
#define XB_SPIN(cond, bar) do { unsigned _sp = 0; while (cond) { __builtin_amdgcn_s_sleep(1); \
    if ((++_sp & 255u) == 0u) { if (xb_ld(&(bar)[XB_TMO])) break; if (_sp > XB_SPIN_CAP) { atomicAdd(&(bar)[XB_TMO], 1u); break; } } } } while (0)
struct XcdBarrier { unsigned* bar; unsigned x; volatile LAS unsigned* st; };
__device__ __forceinline__ XcdBarrier xcd_barrier_post(unsigned* bar, volatile LAS unsigned* st) {
    XcdBarrier b; b.bar = bar; b.x = xb_xcc_id(); b.st = st;
    if (threadIdx.x == 0) (void)xb_add(&bar[XB_XCNT(b.x)], 1u);
    return b;
}
__device__ __forceinline__ void xcd_barrier_complete(unsigned* bar, unsigned x, unsigned& nloc, unsigned& nx) {
    const unsigned G = gridDim.x * gridDim.y * gridDim.z;
    unsigned sum, cnt, mine, sp = 0u;
    for (;;) {
        sum = 0u; cnt = 0u; mine = 0u;
#pragma unroll
        for (unsigned j = 0; j < 16; ++j) { const unsigned c = xb_ld(&bar[XB_XCNT(j)]); sum += c; cnt += (c > 0u) ? 1u : 0u; }
        mine = xb_ld(&bar[XB_XCNT(x)]);
        if (sum == G) break;
        __builtin_amdgcn_s_sleep(1);
        if ((++sp & 255u) == 0u) { if (xb_ld(&bar[XB_TMO])) break; if (sp > XB_SPIN_CAP) { atomicAdd(&bar[XB_TMO], 1u); break; } }
    }
    nloc = mine > 0u ? mine : 1u; nx = cnt > 0u ? cnt : 1u;
}
__device__ __forceinline__ void xcd_barrier(const XcdBarrier& b) {
    asm volatile("s_waitcnt vmcnt(0)" ::: "memory");
    __syncthreads();
    if (threadIdx.x == 0) {
        unsigned* bar = b.bar; unsigned bx = b.x; asm volatile("" : "+s"(bar), "+s"(bx));
        __builtin_amdgcn_s_waitcnt(0);
        unsigned nloc = b.st[0], nx = b.st[1];
        if (nloc == 0u) { xcd_barrier_complete(bar, bx, nloc, nx); b.st[0] = nloc; b.st[1] = nx; }
        const unsigned old = xb_add(&bar[XB_XSUB(bx)], 1u);
        const unsigned gen = old / nloc;
        if (old + 1u == (gen + 1u) * nloc) {
            __builtin_amdgcn_fence(__ATOMIC_RELEASE, "agent");
            asm volatile("s_waitcnt vmcnt(0)" ::: "memory");
            const unsigned og = xb_add(&bar[XB_TOP], 1u);
            const unsigned tg = og / nx;
            if (og + 1u == (tg + 1u) * nx) xb_add(&bar[XB_TOPGEN], 1u);
            else XB_SPIN(xb_ld(&bar[XB_TOPGEN]) == tg, bar);
            __builtin_amdgcn_fence(__ATOMIC_ACQUIRE, "agent");
            xb_add(&bar[XB_XGEN(bx)], 1u);
            asm volatile("s_waitcnt vmcnt(0)" ::: "memory");
        } else {
            XB_SPIN(xb_ld(&bar[XB_XGEN(bx)]) == gen, bar);
            __builtin_amdgcn_fence(__ATOMIC_ACQUIRE, "agent");
            asm volatile("s_waitcnt vmcnt(0)" ::: "memory");
        }
    }
    __syncthreads();
}

constexpr int LDS_BYTES = 147456;
constexpr int BARW_OFF = 131072 + 512;
constexpr int CW_BAR = 4096;

#ifndef ATTN_V2
#define ATTN_V2 1
#endif
#ifndef REP_GEMM
#define REP_GEMM 1
#endif
#ifndef REP_ATTN
#define REP_ATTN 1
#endif
#ifndef REP_SMALL
#define REP_SMALL 1
#endif
#ifndef REP_CVT
#define REP_CVT 1
#endif
#ifndef REP_MD
#define REP_MD 1
#endif
#ifndef FA_WI
#define FA_WI 0
#endif
#define REPEAT_L(n, stmt) do { if ((n) == 1) { stmt; } else { int n_ = (n); asm volatile("" : "+s"(n_)); for (int rep_ = 0; rep_ < n_; ++rep_) { stmt; __syncthreads(); } } } while (0)
#define REPEAT(n, stmt) do { _Pragma("unroll") for (int rep_ = 0; rep_ < (n); ++rep_) { stmt; if ((n) > 1) __syncthreads(); } } while (0)
template <int l>
DI void layer_program(const XcdBarrier& bar, unsigned char* lds) {
#define GBAR() xcd_barrier(bar)
    const bool last = (l == 1);
    const int nrows = last ? TL : T;
    const float lam_init = last ? 0.35550906759096924f : 0.2f;
    if (l == 0) { REPEAT(REP_SMALL, ph_mod1(PP, l)); GBAR(); }
    REPEAT(REP_GEMM, ph_proj_fast(PP, l, lds));
    GBAR();
    REPEAT(REP_GEMM, ph_qkvraw_fast(PP, l, lds));
    REPEAT(REP_SMALL, ph_conv(PP, l, nrows, lds));
    GBAR();
#if ATTN_V2
#if REP_MD > 1
    { int n_ = REP_MD; asm volatile("" : "+s"(n_)); for (int rep_ = 0; rep_ < n_ - 1; ++rep_) { ph_attn_fast2<96, FA_WI>((const bf16*)(PP.ws + WS_MQ), (const bf16*)(PP.ws + WS_MK), (const bf16*)(PP.ws + WS_MV), (const float*)(PP.ws + WS_QBM), 4, 1, (bf16*)(PP.ws + WS_BI), D, 256, 0, SEQ, true, lds); __syncthreads(); ph_attn_fast2<32, FA_WI>((const bf16*)(PP.ws + WS_DQ), (const bf16*)(PP.ws + WS_DK), (const bf16*)(PP.ws + WS_DV), (const float*)(PP.ws + WS_QBD), 8, 2, (bf16*)(PP.ws + WS_DO), 512, 0, 0, SEQ, true, lds); __syncthreads(); } }
#endif
    ph_attn_fast2<96>((const bf16*)(PP.ws + WS_MQ), (const bf16*)(PP.ws + WS_MK), (const bf16*)(PP.ws + WS_MV), (const float*)(PP.ws + WS_QBM), 4, 1, (bf16*)(PP.ws + WS_BI), D, 256, 0, SEQ, true, lds);
    ph_attn_fast2<32>((const bf16*)(PP.ws + WS_DQ), (const bf16*)(PP.ws + WS_DK), (const bf16*)(PP.ws + WS_DV), (const float*)(PP.ws + WS_QBD), 8, 2, (bf16*)(PP.ws + WS_DO), 512, 0, 0, SEQ, true, lds);
    REPEAT(REP_ATTN, ph_na_fast2(PP, l, lds));
    if (!last) {
      ph_attn_fast2<96>((const bf16*)(PP.ws + WS_MQ), (const bf16*)(PP.ws + WS_MK), (const bf16*)(PP.ws + WS_MV), (const float*)(PP.ws + WS_QBM), 4, 1, (bf16*)(PP.ws + WS_BI), D, 256, TL, CTX, false, lds);
      ph_attn_fast2<32>((const bf16*)(PP.ws + WS_DQ), (const bf16*)(PP.ws + WS_DK), (const bf16*)(PP.ws + WS_DV), (const float*)(PP.ws + WS_QBD), 8, 2, (bf16*)(PP.ws + WS_DO), 512, 0, TL, CTX, false, lds);
      ph_attn_fast2<64>((const bf16*)(PP.ws + WS_NQ), (const bf16*)(PP.ws + WS_NK), (const bf16*)(PP.ws + WS_NV), (const float*)(PP.ws + WS_QBN), 4, 1, (bf16*)(PP.ws + WS_BI), D, 768, TL, CTX, false, lds);
    }
    GBAR();
#else
    REPEAT(REP_ATTN, ph_attn_fast<96>((const bf16*)(PP.ws + WS_MQ), (const bf16*)(PP.ws + WS_MK), (const bf16*)(PP.ws + WS_MV), 4, 1, (bf16*)(PP.ws + WS_BI), D, 256, 0, SEQ, true, lds));
    REPEAT(REP_ATTN, ph_attn_fast<32>((const bf16*)(PP.ws + WS_DQ), (const bf16*)(PP.ws + WS_DK), (const bf16*)(PP.ws + WS_DV), 8, 2, (bf16*)(PP.ws + WS_DO), 512, 0, 0, SEQ, true, lds));
    REPEAT(REP_ATTN, ph_na_fast(PP, l, lds));
    if (!last) {
      ph_attn_fast<96>((const bf16*)(PP.ws + WS_MQ), (const bf16*)(PP.ws + WS_MK), (const bf16*)(PP.ws + WS_MV), 4, 1, (bf16*)(PP.ws + WS_BI), D, 256, TL, CTX, false, lds);
      ph_attn_fast<32>((const bf16*)(PP.ws + WS_DQ), (const bf16*)(PP.ws + WS_DK), (const bf16*)(PP.ws + WS_DV), 8, 2, (bf16*)(PP.ws + WS_DO), 512, 0, TL, CTX, false, lds);
      ph_attn_fast<64>((const bf16*)(PP.ws + WS_NQ), (const bf16*)(PP.ws + WS_NK), (const bf16*)(PP.ws + WS_NV), 4, 1, (bf16*)(PP.ws + WS_BI), D, 768, TL, CTX, false, lds);
    }
    GBAR();
#endif
    REPEAT(REP_SMALL, ph_diffcombine_fast(PP, l, nrows, lam_init));
    GBAR();
    REPEAT(REP_GEMM, ph_branch_fast(PP, l, nrows, lds));
    GBAR();
    REPEAT(REP_GEMM, ph_merge_fast(PP, l, nrows, lds));
    GBAR();
    REPEAT((l == 0 ? REP_GEMM : 1), ph_wo_fast(PP, l, nrows, lds));
    GBAR();
    ph_mod2_router_fast(PP, l, nrows, lds);
    GBAR();
    REPEAT(REP_GEMM, ph_moe1_fast(PP, l, lds));
    GBAR();
    REPEAT(REP_GEMM, ph_moe2_fast(PP, l, lds));
    GBAR();
    ph_combine(PP, l, nrows, lds);
    if (l == 0) GBAR();
}

__global__ void __launch_bounds__(512, 2) fwd(Params p) {
  extern __shared__ __attribute__((aligned(16))) unsigned char lds[];
  if (threadIdx.x < 4) ((unsigned*)(lds + BARW_OFF))[threadIdx.x] = 0u;
  __syncthreads();
  XcdBarrier bar = xcd_barrier_post((unsigned*)(PP.ws + WS_CTL) + CW_BAR, (volatile LAS unsigned*)(lds + BARW_OFF));
  ph_ada_fast(PP, lds);
  __syncthreads();
  REPEAT(REP_CVT, ph_convert(PP, lds));
  GBAR();
  layer_program<0>(bar, lds);
  layer_program<1>(bar, lds);
}

extern "C" void kernel_launch(void* const* d_in, const int* in_sizes, int n_in, void* d_out, int out_size, void* d_ws, size_t ws_size, hipStream_t stream) {
  static int grid = 0;
  if (grid == 0) {
    if (n_in != N_IN || ws_size < WS_END) { fprintf(stderr, "kernel_launch: n_in %d ws %zu need %zu\n", n_in, ws_size, (size_t)WS_END); grid = -1; return; }
    int dev = 0, cus = 0;
    if (hipGetDevice(&dev) != hipSuccess || hipDeviceGetAttribute(&cus, hipDeviceAttributeMultiprocessorCount, dev) != hipSuccess) { grid = -1; return; }
    if (hipFuncSetAttribute((const void*)fwd, hipFuncAttributeMaxDynamicSharedMemorySize, LDS_BYTES) != hipSuccess) { fprintf(stderr, "kernel_launch: hipFuncSetAttribute failed\n"); grid = -1; return; }
    int per_cu = 0;
    if (hipOccupancyMaxActiveBlocksPerMultiprocessor(&per_cu, (const void*)fwd, 512, LDS_BYTES) != hipSuccess || per_cu < 1) fprintf(stderr, "kernel_launch: occupancy query says %d\n", per_cu);
    (void)hipGetLastError();
    grid = cus;
  }
  if (grid < 0) return;
  Params p{};
  for (int i = 0; i < N_IN; ++i) p.in[i] = (const float*)d_in[i];
  p.out = (float*)d_out; p.ws = (unsigned char*)d_ws;
  (void)hipMemsetAsync((char*)d_ws + WS_CTL, 0, 1 * MiB, stream);
  static_assert(WS_QKV_T > WS_WIN_T && WS_WB_T > WS_QKV_T, "the two images are laid out back to back");
  (void)hipMemsetAsync((char*)d_ws + WS_WIN_T, 0, WS_WB_T - WS_WIN_T, stream);
  hipLaunchKernelGGL(fwd, dim3(grid), dim3(512), LDS_BYTES, stream, p);
}
```
